# Optimizing an MI355X kernel written in HIP

```python
import math
import jax, jax.numpy as jnp
from jax import lax
import numpy as np

D_MODEL = 1024
BATCH = 32
SEQ = 256
DEPTH = 1
DEC_BATCH = 2
DEC_SEQ = 4096
PAST_LEN = 512

GRID_W = 64
N_HEADS = 8
QK_NOPE = 64
ROPE_DIM = 32
QK_DIM = QK_NOPE + ROPE_DIM
V_DIM = 64
Q_LORA = 384
KV_LORA = 256
D_ATT = N_HEADS * V_DIM
D_HY = D_MODEL - D_ATT
D_MIX = D_ATT + D_HY
D_IN = Q_LORA + KV_LORA + ROPE_DIM + 3 * D_HY
HY_ORDER = 2
FILT_BANDS = 16
FILT_EMB = 1 + 2 * FILT_BANDS
FILT_HIDDEN = 64
DECAY_TARGET = 1e-2
FAST_DECAY_PCT = 0.3
SLOW_DECAY_PCT = 1.5
DECAY_SHIFT = 0.05
D_FF = 2816
ROPE_THETA = 10000.0
Q_BLOCK = 128
EPS = 1e-6

kernel_name = 'hybrid_mla_hyena_prefix_dit_step'


def _rms(x, g):
    xf = x.astype(jnp.float32)
    y = xf * lax.rsqrt(jnp.mean(xf * xf, axis=-1, keepdims=True) + EPS)
    return (y * g.astype(jnp.float32)).astype(x.dtype)


def _dwconv3(x, w, b):
    xp = jnp.pad(x, ((0, 0), (1, 1), (0, 0)))
    return xp[:, :-2] * w[0] + xp[:, 1:-1] * w[1] + xp[:, 2:] * w[2] + b


def _modulation(cvec, p):
    m = jax.nn.silu(cvec) @ p['w_ada'] + p['b_ada']
    return m.reshape(cvec.shape[0], 6, 1, D_MODEL)


def _axial_rope_tables(n):
    rows = n // GRID_W
    row = jnp.repeat(jnp.arange(rows), GRID_W).astype(jnp.float32)
    col = jnp.tile(jnp.arange(GRID_W), rows).astype(jnp.float32)
    quarter = ROPE_DIM // 4
    freqs = ROPE_THETA ** (-jnp.arange(quarter, dtype=jnp.float32) / quarter)
    ang_r = row[:, None] * freqs
    ang_c = col[:, None] * freqs
    ang = jnp.concatenate([ang_r, ang_r, ang_c, ang_c], axis=-1)
    return jnp.cos(ang)[:, None, :], jnp.sin(ang)[:, None, :]


def _rope(x, cos, sin):
    a, b, cc, d = jnp.split(x, 4, axis=-1)
    rot = jnp.concatenate([-b, a, -d, cc], axis=-1)
    return (x.astype(jnp.float32) * cos + rot.astype(jnp.float32) * sin).astype(x.dtype)


def _rope_heads(t, cos, sin):
    return jnp.concatenate([t[..., :QK_NOPE], _rope(t[..., QK_NOPE:], cos, sin)], axis=-1)


def _attention(q, k, v):
    b, lq, h, dk = q.shape
    scale = dk ** -0.5
    kf = k.astype(jnp.float32)
    vf = v.astype(jnp.float32)
    qb = jnp.moveaxis(q.reshape(b, lq // Q_BLOCK, Q_BLOCK, h, dk), 1, 0)

    def block(qblk):
        s = jnp.einsum('bqhd,bkhd->bhqk', qblk.astype(jnp.float32), kf) * scale
        return jnp.einsum('bhqk,bkhd->bqhd', jax.nn.softmax(s, axis=-1), vf)

    o = jnp.moveaxis(lax.map(block, qb), 0, 1).reshape(b, lq, h * v.shape[-1])
    return o.astype(v.dtype)


def _project(h, p):
    b, n, _ = h.shape
    proj = h @ p['w_in']
    q_c, kv_c, k_pe, hy = jnp.split(proj, [Q_LORA, Q_LORA + KV_LORA, Q_LORA + KV_LORA + ROPE_DIM], axis=-1)
    q = (_rms(q_c, p['g_qa']) @ p['w_uq']).reshape(b, n, N_HEADS, QK_DIM)
    q = _rms(q, p['g_q'])
    kv_c = _rms(kv_c, p['g_kva'])
    return q, kv_c, k_pe, hy


def _mla_keys_values(kv_c, k_pe, p):
    b, n, _ = kv_c.shape
    kv = (kv_c @ p['w_ukv']).reshape(b, n, N_HEADS, QK_NOPE + V_DIM)
    k_nope, v = jnp.split(kv, [QK_NOPE], axis=-1)
    k = jnp.concatenate([k_nope, jnp.broadcast_to(k_pe[:, :, None, :], (b, n, N_HEADS, ROPE_DIM))], axis=-1)
    return _rms(k, p['g_k']), v


def _hyena_filters(n, p):
    t = jnp.linspace(0.0, 1.0, n, dtype=jnp.float32)[:, None]
    w = 2.0 * math.pi * jnp.arange(n, dtype=jnp.float32)[:, None] / n
    bands = jnp.linspace(1e-4, FILT_BANDS - 1, FILT_BANDS, dtype=jnp.float32)
    z = jnp.concatenate([t, jnp.cos(bands * w), -jnp.sin(bands * w)], axis=-1)
    h = jnp.sin(p['filt_freq1'] * (z @ p['filt_w1'] + p['filt_b1']))
    h = jnp.sin(p['filt_freq2'] * (h @ p['filt_w2'] + p['filt_b2']))
    h = (h @ p['filt_w3']).astype(jnp.float32).reshape(n, HY_ORDER, 2, D_HY)
    max_decay = math.log(DECAY_TARGET) / FAST_DECAY_PCT
    min_decay = math.log(DECAY_TARGET) / SLOW_DECAY_PCT
    deltas = jnp.abs(jnp.linspace(min_decay, max_decay, D_HY, dtype=jnp.float32))
    window = jnp.exp(-t * deltas) + DECAY_SHIFT
    return h * window[:, None, None, :]


def _long_conv_bidir(u, h_fwd, h_bwd, skip):
    n = u.shape[1]
    kern = jnp.concatenate([h_fwd, jnp.zeros((1, D_HY), jnp.float32), jnp.flip(h_bwd[1:], axis=0)], axis=0)
    uf = u.astype(jnp.float32)
    y = jnp.fft.irfft(jnp.fft.rfft(uf, n=2 * n, axis=1) * jnp.fft.rfft(kern, axis=0)[None], n=2 * n, axis=1)[:, :n]
    return (y + uf * skip.astype(jnp.float32)).astype(u.dtype)


def _hyena(u, p):
    n = u.shape[1]
    u = _dwconv3(u, p['hy_conv_w'], p['hy_conv_b'])
    v, x1, x2 = jnp.split(u, 3, axis=-1)
    h = _hyena_filters(n, p)
    z = x1 * _long_conv_bidir(v, h[:, 0, 0], h[:, 0, 1], p['filt_bias'][0])
    return x2 * _long_conv_bidir(z, h[:, 1, 0], h[:, 1, 1], p['filt_bias'][1])


def _merge(attn, hy, p):
    mix = jnp.concatenate([_rms(attn, p['g_out_att']), _rms(hy, p['g_out_hy'])], axis=-1)
    return mix @ p['w_out']


def _ffn(h, p):
    u = _dwconv3(h @ p['w_up'], p['ffn_conv_w'], p['ffn_conv_b'])
    a, g = jnp.split(u, 2, axis=-1)
    return (jax.nn.silu(a) * g) @ p['w_down']


def _context_layer(x, c_ctx, p):
    m = _modulation(c_ctx[None], p)
    h = _rms(x, p['g_mix']) * (1 + m[:, 1]) + m[:, 0]
    q, kv_c, k_pe, hy = _project(h, p)
    k, v = _mla_keys_values(kv_c, k_pe, p)
    x = x + m[:, 2] * _merge(_attention(q, k, v), _hyena(hy, p), p)
    h = _rms(x, p['g_ffn']) * (1 + m[:, 4]) + m[:, 3]
    x = x + m[:, 5] * _ffn(h, p)
    return x, kv_c, k_pe


def _latent_layer(x, c, ckv_ctx, kpe_ctx, p):
    n = x.shape[1]
    m = _modulation(c, p)
    h = _rms(x, p['g_mix']) * (1 + m[:, 1]) + m[:, 0]
    q, kv_c, k_pe, hy = _project(h, p)
    cos, sin = _axial_rope_tables(n)
    q = _rope_heads(q, cos, sin)
    k_lat, v_lat = _mla_keys_values(kv_c, k_pe, p)
    k_lat = _rope_heads(k_lat, cos, sin)
    k_ctx, v_ctx = _mla_keys_values(ckv_ctx, kpe_ctx, p)
    attn = _attention(q, jnp.concatenate([k_lat, k_ctx], axis=1), jnp.concatenate([v_lat, v_ctx], axis=1))
    x = x + m[:, 2] * _merge(attn, _hyena(hy, p), p)
    h = _rms(x, p['g_ffn']) * (1 + m[:, 4]) + m[:, 3]
    return x + m[:, 5] * _ffn(h, p)


def setup_inputs(seed: int = 0) -> dict:
    key = jax.random.key(seed)
    ks = iter(jax.random.split(key, 40))

    def nrm(shape, scale):
        return jax.random.normal(next(ks), shape, jnp.float32) * scale

    def gain(shape):
        return 1.0 + nrm(shape, 0.02)

    L = DEPTH
    return {
        'x_prompt': nrm((BATCH, SEQ, D_MODEL), 1.0),
        'x_sample': nrm((DEC_BATCH, DEC_SEQ, D_MODEL), 1.0),
        'cache_ckv': nrm((DEC_BATCH, DEPTH, PAST_LEN, KV_LORA), 1.0),
        'cache_kpe': nrm((DEC_BATCH, DEPTH, PAST_LEN, ROPE_DIM), 1.0),
        'c': nrm((DEC_BATCH, D_MODEL), 1.0),
        'c_ctx': nrm((D_MODEL,), 1.0),
        'w_ada': nrm((L, D_MODEL, 6 * D_MODEL), 0.5 * D_MODEL ** -0.5),
        'b_ada': nrm((L, 6 * D_MODEL), 0.01),
        'g_mix': gain((L, D_MODEL)),
        'w_in': nrm((L, D_MODEL, D_IN), D_MODEL ** -0.5),
        'g_qa': gain((L, Q_LORA)),
        'w_uq': nrm((L, Q_LORA, N_HEADS * QK_DIM), Q_LORA ** -0.5),
        'g_kva': gain((L, KV_LORA)),
        'w_ukv': nrm((L, KV_LORA, N_HEADS * (QK_NOPE + V_DIM)), KV_LORA ** -0.5),
        'g_q': gain((L, QK_DIM)),
        'g_k': gain((L, QK_DIM)),
        'hy_conv_w': nrm((L, 3, 3 * D_HY), 0.5),
        'hy_conv_b': nrm((L, 3 * D_HY), 0.01),
        'filt_w1': nrm((L, FILT_EMB, FILT_HIDDEN), FILT_EMB ** -0.5),
        'filt_b1': nrm((L, FILT_HIDDEN), 0.1),
        'filt_freq1': gain((L, FILT_HIDDEN)),
        'filt_w2': nrm((L, FILT_HIDDEN, FILT_HIDDEN), FILT_HIDDEN ** -0.5),
        'filt_b2': nrm((L, FILT_HIDDEN), 0.1),
        'filt_freq2': gain((L, FILT_HIDDEN)),
        'filt_w3': nrm((L, FILT_HIDDEN, HY_ORDER * 2 * D_HY), 0.05 * FILT_HIDDEN ** -0.5),
        'filt_bias': nrm((L, HY_ORDER, D_HY), 1.0),
        'g_out_att': gain((L, D_ATT)),
        'g_out_hy': gain((L, D_HY)),
        'w_out': nrm((L, D_MIX, D_MODEL), D_MIX ** -0.5),
        'g_ffn': gain((L, D_MODEL)),
        'w_up': nrm((L, D_MODEL, 2 * D_FF), D_MODEL ** -0.5),
        'ffn_conv_w': nrm((L, 3, 2 * D_FF), 0.5),
        'ffn_conv_b': nrm((L, 2 * D_FF), 0.01),
        'w_down': nrm((L, D_FF, D_MODEL), D_FF ** -0.5),
    }


def reference(x_prompt, x_sample, cache_ckv, cache_kpe, c, c_ctx, w_ada, b_ada, g_mix, w_in, g_qa, w_uq,
              g_kva, w_ukv, g_q, g_k, hy_conv_w, hy_conv_b, filt_w1, filt_b1, filt_freq1, filt_w2, filt_b2,
              filt_freq2, filt_w3, filt_bias, g_out_att, g_out_hy, w_out, g_ffn, w_up, ffn_conv_w, ffn_conv_b,
              w_down):
    y_prompt = x_prompt
    y_sample = x_sample
    ckv_list = []
    kpe_list = []
    for l in range(DEPTH):
        p = {
            'w_ada': w_ada[l], 'b_ada': b_ada[l], 'g_mix': g_mix[l], 'w_in': w_in[l],
            'g_qa': g_qa[l], 'w_uq': w_uq[l], 'g_kva': g_kva[l], 'w_ukv': w_ukv[l],
            'g_q': g_q[l], 'g_k': g_k[l], 'hy_conv_w': hy_conv_w[l], 'hy_conv_b': hy_conv_b[l],
            'filt_w1': filt_w1[l], 'filt_b1': filt_b1[l], 'filt_freq1': filt_freq1[l],
            'filt_w2': filt_w2[l], 'filt_b2': filt_b2[l], 'filt_freq2': filt_freq2[l],
            'filt_w3': filt_w3[l], 'filt_bias': filt_bias[l], 'g_out_att': g_out_att[l],
            'g_out_hy': g_out_hy[l], 'w_out': w_out[l], 'g_ffn': g_ffn[l], 'w_up': w_up[l],
            'ffn_conv_w': ffn_conv_w[l], 'ffn_conv_b': ffn_conv_b[l], 'w_down': w_down[l],
        }
        y_prompt, ckv_l, kpe_l = _context_layer(y_prompt, c_ctx, p)
        ckv_list.append(ckv_l)
        kpe_list.append(kpe_l)
        y_sample = _latent_layer(y_sample, c, cache_ckv[:, l], cache_kpe[:, l], p)
    new_ckv = jnp.stack(ckv_list, axis=1)
    new_kpe = jnp.stack(kpe_list, axis=1)
    return (y_prompt, y_sample, new_ckv, new_kpe)
```

```cpp
#include <hip/hip_runtime.h>
#include <hip/hip_cooperative_groups.h>
#include <cstdio>
namespace cg = cooperative_groups;

#define DBG_STOP 15
#define DBG_NOHY 0
#define DBG_OFF OFF_QRAW
#define DBG_OFF2 OFF_KRAW
#define DBG_CNT 12582912
#define DBG_CNT2 0
#ifndef ONE_LAUNCH
#define ONE_LAUNCH 1
#endif

typedef unsigned short bf16_t;
typedef short bf16x8 __attribute__((ext_vector_type(8)));
typedef float f32x4 __attribute__((ext_vector_type(4)));
typedef float f32x16 __attribute__((ext_vector_type(16)));

constexpr int D = 1024, NTOK = 16384, NCTX = 8192, SEQC = 256, SEQL = 4096;
constexpr int DIN = 2208, DINP = 2304, QL = 384, KVL = 256, DFF = 2816;
constexpr int NROWKV = 17408;
constexpr size_t MiB = 1048576;

constexpr size_t OFF_WIN = 0;
constexpr size_t OFF_WUQ = OFF_WIN + (size_t)DINP * 1024 * 2;
constexpr size_t OFF_WUKV = OFF_WUQ + (size_t)768 * 384 * 2;
constexpr size_t OFF_WOUT = OFF_WUKV + (size_t)1024 * 256 * 2;
constexpr size_t OFF_WUP = OFF_WOUT + (size_t)1024 * 1024 * 2;
constexpr size_t OFF_WDOWN = OFF_WUP + (size_t)5632 * 1024 * 2;
constexpr size_t OFF_MOD = OFF_WDOWN + (size_t)1024 * 2816 * 2;
static_assert(OFF_MOD + 3 * 6144 * 4 <= 25 * MiB, "A region");
constexpr size_t OFF_RLAT = 25 * MiB;
constexpr size_t OFF_RCTX = 41 * MiB;
constexpr size_t OFF_H = 42 * MiB;
constexpr size_t OFF_ZT = 42 * MiB;
constexpr size_t OFF_QA = 58 * MiB;
constexpr size_t OFF_KPE = 70 * MiB;
constexpr size_t OFF_PROJ = 74 * MiB;
constexpr size_t OFF_QRAW = 74 * MiB;
constexpr size_t OFF_Y2T = 98 * MiB;
constexpr size_t OFF_ATTN = 74 * MiB;
constexpr size_t OFF_U = 74 * MiB;
constexpr size_t OFF_HYT = 116 * MiB;
constexpr size_t OFF_Q = 116 * MiB;
constexpr size_t OFF_KC = 140 * MiB;
constexpr size_t OFF_KL = 152 * MiB;
constexpr size_t OFF_CKVN = 164 * MiB;
constexpr size_t OFF_KRAW = 173 * MiB;
constexpr size_t OFF_VTC = 190 * MiB;
constexpr size_t OFF_VTL = 198 * MiB;
constexpr size_t OFF_ACT = 162 * MiB;

constexpr int OUT_YS = 0;
constexpr int OUT_CKV = 16777216;
constexpr int OUT_KPE = 16777216 + 2097152;

constexpr int SMEM_BYTES = 51200;

struct Params {
  const float *x_prompt, *x_sample, *cache_ckv, *cache_kpe, *c, *c_ctx, *w_ada, *b_ada, *g_mix, *w_in, *g_qa, *w_uq,
      *g_kva, *w_ukv, *g_q, *g_k, *hy_conv_w, *hy_conv_b, *filt_w1, *filt_b1, *filt_freq1, *filt_w2, *filt_b2,
      *filt_freq2, *filt_w3, *filt_bias, *g_out_att, *g_out_hy, *w_out, *g_ffn, *w_up, *ffn_conv_w, *ffn_conv_b, *w_down;
  float* out;
  char* ws;
};

typedef __bf16 bf16x2_t __attribute__((ext_vector_type(2)));
__device__ __forceinline__ unsigned pack2(float lo, float hi) {
  bf16x2_t v;
  v[0] = (__bf16)lo;
  v[1] = (__bf16)hi;
  return __builtin_bit_cast(unsigned, v);
}
__device__ __forceinline__ float bflo(unsigned u) { return __uint_as_float(u << 16); }
__device__ __forceinline__ float bfhi(unsigned u) { return __uint_as_float(u & 0xffff0000u); }
__device__ __forceinline__ float bf2f(bf16_t h) { return __uint_as_float(((unsigned)h) << 16); }
__device__ __forceinline__ bf16_t f2bf(float f) { return (bf16_t)(pack2(f, 0.f) & 0xffffu); }
__device__ __forceinline__ float wave_sum(float v) {
#pragma unroll
  for (int o = 32; o >= 1; o >>= 1) v += __shfl_xor(v, o);
  return v;
}
__device__ __forceinline__ float sin_turns(float t) { t -= floorf(t); return __builtin_amdgcn_sinf(t); }
__device__ __forceinline__ float cos_turns(float t) { t -= floorf(t); return __builtin_amdgcn_cosf(t); }
__device__ __forceinline__ float sin_rad(float x) { return sin_turns(x * 0.15915494309189535f); }
__device__ __forceinline__ const float* xrow(const Params& p, int row) {
  return row < NCTX ? p.x_prompt + (size_t)row * D : p.x_sample + (size_t)(row - NCTX) * D;
}
__device__ __forceinline__ int modidx(int row) { return row < NCTX ? 0 : 1 + ((row - NCTX) >> 12); }

template <bool SWAP, class Epi>
__device__ __forceinline__ void gemm_tile(const bf16_t* __restrict__ A, int lda, const bf16_t* __restrict__ Bt, int ldb,
                                          int K, int m0, int n0, char* smem, const Epi& epi) {
  const int tid = threadIdx.x, lane = tid & 63, wid = tid >> 6, wr = wid >> 1, wc = wid & 1;
  const int fr = lane & 15, fq = lane >> 4;
  bf16_t* sA = (bf16_t*)smem;
  bf16_t* sB = sA + 128 * 72;
  f32x4 acc[4][4];
#pragma unroll
  for (int m = 0; m < 4; ++m)
#pragma unroll
    for (int n = 0; n < 4; ++n) acc[m][n] = (f32x4){0.f, 0.f, 0.f, 0.f};
  const int lr = tid >> 3, lc = (tid & 7) * 8;
  const bf16_t* ga = A + (size_t)(m0 + lr) * lda + lc;
  const bf16_t* gb = Bt + (size_t)(n0 + lr) * ldb + lc;
  const size_t sa32 = (size_t)32 * lda, sb32 = (size_t)32 * ldb;
  uint4 ra0 = *(const uint4*)(ga), ra1 = *(const uint4*)(ga + sa32), ra2 = *(const uint4*)(ga + 2 * sa32), ra3 = *(const uint4*)(ga + 3 * sa32);
  uint4 rb0 = *(const uint4*)(gb), rb1 = *(const uint4*)(gb + sb32), rb2 = *(const uint4*)(gb + 2 * sb32), rb3 = *(const uint4*)(gb + 3 * sb32);
  const int nk = K >> 6;
  bf16_t* wa = sA + lr * 72 + lc;
  bf16_t* wb = sB + lr * 72 + lc;
  for (int kt = 0; kt < nk; ++kt) {
    __syncthreads();
    *(uint4*)(wa) = ra0; *(uint4*)(wa + 32 * 72) = ra1; *(uint4*)(wa + 64 * 72) = ra2; *(uint4*)(wa + 96 * 72) = ra3;
    *(uint4*)(wb) = rb0; *(uint4*)(wb + 32 * 72) = rb1; *(uint4*)(wb + 64 * 72) = rb2; *(uint4*)(wb + 96 * 72) = rb3;
    __syncthreads();
    if (kt + 1 < nk) {
      ga += 64;
      gb += 64;
      ra0 = *(const uint4*)(ga); ra1 = *(const uint4*)(ga + sa32); ra2 = *(const uint4*)(ga + 2 * sa32); ra3 = *(const uint4*)(ga + 3 * sa32);
      rb0 = *(const uint4*)(gb); rb1 = *(const uint4*)(gb + sb32); rb2 = *(const uint4*)(gb + 2 * sb32); rb3 = *(const uint4*)(gb + 3 * sb32);
    }
#pragma unroll
    for (int ks = 0; ks < 2; ++ks) {
      bf16x8 af[4], bfr[4];
#pragma unroll
      for (int m = 0; m < 4; ++m) af[m] = *(const bf16x8*)(sA + (wr * 64 + m * 16 + fr) * 72 + ks * 32 + fq * 8);
#pragma unroll
      for (int n = 0; n < 4; ++n) bfr[n] = *(const bf16x8*)(sB + (wc * 64 + n * 16 + fr) * 72 + ks * 32 + fq * 8);
#pragma unroll
      for (int m = 0; m < 4; ++m)
#pragma unroll
        for (int n = 0; n < 4; ++n) {
          if (SWAP) acc[m][n] = __builtin_amdgcn_mfma_f32_16x16x32_bf16(bfr[n], af[m], acc[m][n], 0, 0, 0);
          else acc[m][n] = __builtin_amdgcn_mfma_f32_16x16x32_bf16(af[m], bfr[n], acc[m][n], 0, 0, 0);
        }
    }
  }
#pragma unroll
  for (int m = 0; m < 4; ++m)
#pragma unroll
    for (int n = 0; n < 4; ++n) {
      if (SWAP) epi(m0 + wr * 64 + m * 16 + fr, n0 + wc * 64 + n * 16 + fq * 4, acc[m][n]);
      else epi(m0 + wr * 64 + m * 16 + fq * 4, n0 + wc * 64 + n * 16 + fr, acc[m][n]);
    }
}

__device__ void transpose_item(const float* __restrict__ W, int K, int N, bf16_t* __restrict__ WT, int tile, int ntn, char* smem) {
  float* s = (float*)smem;
  const int tk = tile / ntn, tn = tile % ntn, tid = threadIdx.x;
  const int k0 = tk * 64, n0 = tn * 64;
  __syncthreads();
  {
    const int r = tid >> 4, c4 = (tid & 15) * 4;
#pragma unroll
    for (int i = 0; i < 4; ++i) {
      const int k = r + 16 * i;
      float4 v = make_float4(0.f, 0.f, 0.f, 0.f);
      if (n0 + c4 < N) v = *(const float4*)(W + (size_t)(k0 + k) * N + n0 + c4);
      s[k * 65 + c4 + 0] = v.x; s[k * 65 + c4 + 1] = v.y; s[k * 65 + c4 + 2] = v.z; s[k * 65 + c4 + 3] = v.w;
    }
  }
  __syncthreads();
  {
    const int n = tid >> 2, kc = (tid & 3) * 16;
    unsigned o[8];
#pragma unroll
    for (int i = 0; i < 8; ++i) o[i] = pack2(s[(kc + 2 * i) * 65 + n], s[(kc + 2 * i + 1) * 65 + n]);
    uint4* dst = (uint4*)(WT + (size_t)(n0 + n) * K + k0 + kc);
    dst[0] = make_uint4(o[0], o[1], o[2], o[3]);
    dst[1] = make_uint4(o[4], o[5], o[6], o[7]);
  }
}

__device__ void mod_item(const Params& p, int item, char* smem) {
  float* s = (float*)smem;
  float* red = s + 3072;
  const int tid = threadIdx.x;
  __syncthreads();
  for (int e = tid; e < 3072; e += 256) {
    const int v = e >> 10, k = e & 1023;
    const float x = (v == 0) ? p.c_ctx[k] : p.c[(v - 1) * D + k];
    s[e] = x / (1.f + __expf(-x));
  }
  __syncthreads();
  const int jl = tid & 63, kq = tid >> 6, j = item * 64 + jl, k0 = kq * 256;
  float a0 = 0.f, a1 = 0.f, a2 = 0.f;
#pragma unroll 8
  for (int k = 0; k < 256; ++k) {
    const float w = p.w_ada[(size_t)(k0 + k) * 6144 + j];
    a0 += s[k0 + k] * w; a1 += s[1024 + k0 + k] * w; a2 += s[2048 + k0 + k] * w;
  }
  red[(kq * 3 + 0) * 64 + jl] = a0; red[(kq * 3 + 1) * 64 + jl] = a1; red[(kq * 3 + 2) * 64 + jl] = a2;
  __syncthreads();
  if (tid < 192) {
    const int v = tid >> 6;
    const float r = red[(0 * 3 + v) * 64 + jl] + red[(1 * 3 + v) * 64 + jl] + red[(2 * 3 + v) * 64 + jl] + red[(3 * 3 + v) * 64 + jl];
    ((float*)(p.ws + OFF_MOD))[v * 6144 + j] = r + p.b_ada[j];
  }
}

__device__ void filter_item(const Params& p, int item, char* smem) {
  int n, p0; bf16_t* R;
  if (item < 256) { n = 4096; p0 = item * 16; R = (bf16_t*)(p.ws + OFF_RLAT); }
  else { n = 256; p0 = (item - 256) * 16; R = (bf16_t*)(p.ws + OFF_RCTX); }
  const int n2 = 2 * n, tid = threadIdx.x;
  float* z = (float*)smem;
  float* h1 = z + 16 * 36;
  float* h2 = h1 + 16 * 64;
  __syncthreads();
#pragma unroll 1
  for (int e = tid; e < 16 * 33; e += 256) {
    const int pp = e / 33, f = e % 33, pos = p0 + pp;
    float val;
    if (f == 0) val = (float)pos / (float)(n - 1);
    else {
      const int k = (f - 1) & 15;
      const float band = 1e-4f + (float)k * ((15.f - 1e-4f) / 15.f);
      const float turns = band * ((float)pos / (float)n);
      val = (f <= 16) ? cos_turns(turns) : -sin_turns(turns);
    }
    z[pp * 36 + f] = val;
  }
  __syncthreads();
#pragma unroll 1
  for (int e = tid; e < 1024; e += 256) {
    const int pp = e >> 6, j = e & 63;
    float a = p.filt_b1[j];
#pragma unroll 3
    for (int f = 0; f < 33; ++f) a += z[pp * 36 + f] * p.filt_w1[f * 64 + j];
    h1[e] = sin_rad(p.filt_freq1[j] * a);
  }
  __syncthreads();
#pragma unroll 1
  for (int e = tid; e < 1024; e += 256) {
    const int pp = e >> 6, j = e & 63;
    float a = p.filt_b2[j];
#pragma unroll 4
    for (int k = 0; k < 64; ++k) a += h1[pp * 64 + k] * p.filt_w2[k * 64 + j];
    h2[j * 16 + pp] = sin_rad(p.filt_freq2[j] * a);
  }
  __syncthreads();
  const float mind = -3.0701134573253946f, maxd = -15.350567286626973f;
#pragma unroll 1
  for (int ci = 0; ci < 8; ++ci) {
    const int col = tid + 256 * ci, o = col >> 10, dir = (col >> 9) & 1, c = col & 511;
    float acc[16];
#pragma unroll
    for (int i = 0; i < 16; ++i) acc[i] = 0.f;
#pragma unroll 4
    for (int k = 0; k < 64; ++k) {
      const float w = p.filt_w3[k * 2048 + col];
      const float4 ha = *(const float4*)(h2 + k * 16), hb = *(const float4*)(h2 + k * 16 + 4), hc = *(const float4*)(h2 + k * 16 + 8), hd = *(const float4*)(h2 + k * 16 + 12);
      acc[0] += ha.x * w; acc[1] += ha.y * w; acc[2] += ha.z * w; acc[3] += ha.w * w;
      acc[4] += hb.x * w; acc[5] += hb.y * w; acc[6] += hb.z * w; acc[7] += hb.w * w;
      acc[8] += hc.x * w; acc[9] += hc.y * w; acc[10] += hc.z * w; acc[11] += hc.w * w;
      acc[12] += hd.x * w; acc[13] += hd.y * w; acc[14] += hd.z * w; acc[15] += hd.w * w;
    }
    const float delta = fabsf(mind + (float)c * ((maxd - mind) / 511.f));
    bf16_t* Rrow = R + (size_t)(o * 512 + c) * n2;
#pragma unroll
    for (int i = 0; i < 16; ++i) {
      const int pos = p0 + i;
      const float t = (float)pos / (float)(n - 1);
      float val = acc[i] * (__expf(-t * delta) + 0.05f);
      int idx = dir == 0 ? (n - 1 - pos) : (n - 1 + pos);
      if (dir == 1 && pos == 0) { idx = n2 - 1; val = 0.f; }
      Rrow[idx] = f2bf(val);
    }
  }
}

__device__ void cache_item(const Params& p, int item) {
  const int tid = threadIdx.x, r0 = item * 32;
  bf16_t* ckvn = (bf16_t*)(p.ws + OFF_CKVN);
#pragma unroll 2
  for (int e = tid; e < 32 * 64; e += 256) {
    const int r = r0 + (e >> 6), c4 = (e & 63) * 4;
    const float4 v = *(const float4*)(p.cache_ckv + (size_t)r * 256 + c4);
    *(uint2*)(ckvn + (size_t)(NTOK + r) * 256 + c4) = make_uint2(pack2(v.x, v.y), pack2(v.z, v.w));
  }
}

template <int WHICH>
__device__ void rmsmod_phase(const Params& p) {
  const int lane = threadIdx.x & 63, wid = threadIdx.x >> 6;
  const int gw = blockIdx.x * 4 + wid, tw = gridDim.x * 4;
  const float* g = WHICH == 0 ? p.g_mix : p.g_ffn;
  const float* mod = (const float*)(p.ws + OFF_MOD);
  bf16_t* h = (bf16_t*)(p.ws + OFF_H);
  for (int row = gw; row < NTOK; row += tw) {
    const float* src = WHICH == 0 ? xrow(p, row) : p.out + (size_t)row * D;
    float4 v[4];
    float ss = 0.f;
#pragma unroll
    for (int i = 0; i < 4; ++i) {
      v[i] = ((const float4*)src)[lane + 64 * i];
      ss += v[i].x * v[i].x + v[i].y * v[i].y + v[i].z * v[i].z + v[i].w * v[i].w;
    }
    ss = wave_sum(ss);
    const float r = rsqrtf(ss * (1.f / 1024.f) + 1e-6f);
    const float* mv = mod + modidx(row) * 6144 + (WHICH == 0 ? 0 : 3 * 1024);
#pragma unroll
    for (int i = 0; i < 4; ++i) {
      const int e = 4 * (lane + 64 * i);
      const float4 g4 = *(const float4*)(g + e), sh = *(const float4*)(mv + e), sc = *(const float4*)(mv + 1024 + e);
      const float y0 = v[i].x * r * g4.x * (1.f + sc.x) + sh.x, y1 = v[i].y * r * g4.y * (1.f + sc.y) + sh.y;
      const float y2 = v[i].z * r * g4.z * (1.f + sc.z) + sh.z, y3 = v[i].w * r * g4.w * (1.f + sc.w) + sh.w;
      *(uint2*)(h + (size_t)row * D + e) = make_uint2(pack2(y0, y1), pack2(y2, y3));
    }
  }
}

struct EpiIn {
  float* proj; bf16_t* hyT;
  __device__ __forceinline__ void operator()(int row0, int col, const f32x4& v) const {
    if (col < 672) {
#pragma unroll
      for (int j = 0; j < 4; ++j) proj[(size_t)(row0 + j) * 672 + col] = v[j];
    } else if (col < DIN) {
      *(uint2*)(hyT + (size_t)(col - 672) * NTOK + row0) = make_uint2(pack2(v[0], v[1]), pack2(v[2], v[3]));
    }
  }
};
struct EpiQ {
  bf16_t* q;
  __device__ __forceinline__ void operator()(int row, int col0, const f32x4& v) const {
    *(uint2*)(q + (size_t)row * 768 + col0) = make_uint2(pack2(v[0], v[1]), pack2(v[2], v[3]));
  }
};
struct EpiKV {
  bf16_t *kraw, *vtc, *vtl;
  __device__ __forceinline__ void operator()(int row0, int col, const f32x4& v) const {
    const int head = col >> 7, cc = col & 127;
    if (cc < 64) {
#pragma unroll
      for (int j = 0; j < 4; ++j) kraw[(size_t)(row0 + j) * 512 + head * 64 + cc] = f2bf(v[j]);
    } else {
      const int dv = cc - 64;
      bf16_t* dst;
      if (row0 < NCTX) dst = vtc + ((size_t)((row0 >> 8) * 8 + head) * 64 + dv) * 256 + (row0 & 255);
      else if (row0 < NTOK) { const int r = row0 - NCTX; dst = vtl + ((size_t)((r >> 12) * 8 + head) * 64 + dv) * 4608 + (r & 4095); }
      else { const int r = row0 - NTOK; dst = vtl + ((size_t)((r >> 9) * 8 + head) * 64 + dv) * 4608 + 4096 + (r & 511); }
      *(uint2*)dst = make_uint2(pack2(v[0], v[1]), pack2(v[2], v[3]));
    }
  }
};
struct EpiOut {
  const Params* p;
  __device__ __forceinline__ void operator()(int row, int col0, const f32x4& v) const {
    const float4 x = *(const float4*)(xrow(*p, row) + col0);
    const float4 m = *(const float4*)((const float*)(p->ws + OFF_MOD) + modidx(row) * 6144 + 2 * 1024 + col0);
    *(float4*)(p->out + (size_t)row * D + col0) = make_float4(x.x + m.x * v[0], x.y + m.y * v[1], x.z + m.z * v[2], x.w + m.w * v[3]);
  }
};
struct EpiU {
  bf16_t* u;
  __device__ __forceinline__ void operator()(int row, int col0, const f32x4& v) const {
    *(uint2*)(u + (size_t)row * 5632 + col0) = make_uint2(pack2(v[0], v[1]), pack2(v[2], v[3]));
  }
};
struct EpiY {
  const Params* p; int half;
  __device__ __forceinline__ void operator()(int row, int col0, const f32x4& v) const {
    const int grow = half * 8192 + row;
    float4* dst = (float4*)(p->out + (size_t)grow * D + col0);
    const float4 x = *dst;
    const float4 m = *(const float4*)((const float*)(p->ws + OFF_MOD) + modidx(grow) * 6144 + 5 * 1024 + col0);
    *dst = make_float4(x.x + m.x * v[0], x.y + m.y * v[1], x.z + m.z * v[2], x.w + m.w * v[3]);
  }
};

__device__ void token_item(const Params& p, int item) {
  const int lane = threadIdx.x & 63, wid = threadIdx.x >> 6;
  const float* proj = (const float*)(p.ws + OFF_PROJ);
  bf16_t* qa = (bf16_t*)(p.ws + OFF_QA);
  bf16_t* ckvn = (bf16_t*)(p.ws + OFF_CKVN);
  float* kpe = (float*)(p.ws + OFF_KPE);
  for (int tt = 0; tt < 16; ++tt) {
    const int token = item * 64 + wid * 16 + tt;
    const float* pr = proj + (size_t)token * 672;
    float2 q[3];
    float ss = 0.f;
#pragma unroll
    for (int i = 0; i < 3; ++i) { q[i] = *(const float2*)(pr + lane * 2 + 128 * i); ss += q[i].x * q[i].x + q[i].y * q[i].y; }
    ss = wave_sum(ss);
    const float r = rsqrtf(ss * (1.f / 384.f) + 1e-6f);
#pragma unroll
    for (int i = 0; i < 3; ++i) {
      const int e = lane * 2 + 128 * i;
      *(unsigned*)(qa + (size_t)token * 384 + e) = pack2(q[i].x * r * p.g_qa[e], q[i].y * r * p.g_qa[e + 1]);
    }
    const float4 kv = *(const float4*)(pr + 384 + lane * 4);
    float s2 = wave_sum(kv.x * kv.x + kv.y * kv.y + kv.z * kv.z + kv.w * kv.w);
    const float r2 = rsqrtf(s2 * (1.f / 256.f) + 1e-6f);
    const float4 g = *(const float4*)(p.g_kva + lane * 4);
    const float4 y = make_float4(kv.x * r2 * g.x, kv.y * r2 * g.y, kv.z * r2 * g.z, kv.w * r2 * g.w);
    *(uint2*)(ckvn + (size_t)token * 256 + lane * 4) = make_uint2(pack2(y.x, y.y), pack2(y.z, y.w));
    if (token < NCTX) *(float4*)(p.out + OUT_CKV + (size_t)token * 256 + lane * 4) = y;
    if (lane < 32) {
      const float kp = pr[640 + lane];
      kpe[(size_t)token * 32 + lane] = kp;
      if (token < NCTX) p.out[OUT_KPE + (size_t)token * 32 + lane] = kp;
    }
  }
}

template <int ORDER>
__device__ void hyena_item(const Params& p, int grp, int c, char* smem) {
  const int tid = threadIdx.x, lane = tid & 63, wid = tid >> 6, fr = lane & 15, fq = lane >> 4;
  const int n = grp ? SEQL : SEQC, nb = n >> 6, L = n;
  const bf16_t* Rrow = (const bf16_t*)(p.ws + (grp ? OFF_RLAT : OFF_RCTX)) + (size_t)(ORDER * 512 + c) * (2 * n);
  const bf16_t* hyT = (const bf16_t*)(p.ws + OFF_HYT);
  bf16_t* sU = (bf16_t*)smem;
  unsigned* sR0 = (unsigned*)(smem + 18432);
  unsigned* sR1 = (unsigned*)(smem + 18432 + 16384);
  const int tok0 = grp * 8192;
  __syncthreads();
  for (int ch = tid; ch < (2 * n) / 8; ch += 256) *(uint4*)((bf16_t*)sR0 + ch * 8) = *(const uint4*)(Rrow + ch * 8);
  if (ORDER == 0) {
    const bf16_t* raw = hyT + (size_t)c * NTOK + tok0;
    const float w0 = p.hy_conv_w[c], w1 = p.hy_conv_w[1536 + c], w2 = p.hy_conv_w[3072 + c], b = p.hy_conv_b[c];
    for (int ch = tid; ch < 1024; ch += 256) {
      const int t = ch * 8, pos = t & (L - 1);
      const uint4 rv = *(const uint4*)(raw + t);
      float x[10];
      x[0] = pos == 0 ? 0.f : bf2f(raw[t - 1]);
      x[1] = bflo(rv.x); x[2] = bfhi(rv.x); x[3] = bflo(rv.y); x[4] = bfhi(rv.y);
      x[5] = bflo(rv.z); x[6] = bfhi(rv.z); x[7] = bflo(rv.w); x[8] = bfhi(rv.w);
      x[9] = (pos + 8 == L) ? 0.f : bf2f(raw[t + 8]);
      float u[8];
#pragma unroll
      for (int i = 0; i < 8; ++i) u[i] = w0 * x[i] + w1 * x[i + 1] + w2 * x[i + 2] + b;
      *(uint4*)(sU + (ch >> 3) * 72 + (ch & 7) * 8) = make_uint4(pack2(u[0], u[1]), pack2(u[2], u[3]), pack2(u[4], u[5]), pack2(u[6], u[7]));
    }
  } else {
    const bf16_t* zr = (const bf16_t*)(p.ws + OFF_ZT) + (size_t)c * NTOK + tok0;
    for (int ch = tid; ch < 1024; ch += 256) *(uint4*)(sU + (ch >> 3) * 72 + (ch & 7) * 8) = *(const uint4*)(zr + ch * 8);
  }
  __syncthreads();
  for (int k = tid; k < n; k += 256) {
    const unsigned a = sR0[k], b2 = (k + 1 < n) ? sR0[k + 1] : 0u;
    sR1[k] = (a >> 16) | (b2 << 16);
  }
  __syncthreads();

  f32x4 acc[4][2];
#pragma unroll
  for (int m = 0; m < 4; ++m) { acc[m][0] = (f32x4){0.f, 0.f, 0.f, 0.f}; acc[m][1] = (f32x4){0.f, 0.f, 0.f, 0.f}; }
  const unsigned* abase = (fr & 1) ? (sR0 + ((n - 1 - fr) >> 1) + 4 * fq) : (sR1 + ((n - 2 - fr) >> 1) + 4 * fq);
  const int col0 = 32 * wid + fr, col1 = col0 + 16;
  const int i0 = col0 & (nb - 1), i1 = col1 & (nb - 1);
  for (int d = -(nb - 1); d <= nb - 1; ++d) {
    const bool v0 = (unsigned)(i0 - d) < (unsigned)nb, v1 = (unsigned)(i1 - d) < (unsigned)nb;
    const bool any0 = __ballot(v0) != 0ull, any1 = __ballot(v1) != 0ull;
    if (!any0 && !any1) continue;
    bf16x8 F[6];
    const unsigned* ap = abase - 32 * d + 16;
#pragma unroll
    for (int idx = 0; idx < 6; ++idx) {
      const unsigned* q = ap - 8 * idx;
      union { unsigned u[4]; bf16x8 v; } cv;
      cv.u[0] = q[0]; cv.u[1] = q[1]; cv.u[2] = q[2]; cv.u[3] = q[3];
      F[idx] = cv.v;
    }
#pragma unroll
    for (int nt = 0; nt < 2; ++nt) {
      if (!(nt ? any1 : any0)) continue;
      const bool vv = nt ? v1 : v0;
      const bf16_t* up = sU + ((nt ? col1 : col0) - d) * 72 + fq * 8;
#pragma unroll
      for (int ks = 0; ks < 2; ++ks) {
        bf16x8 bf = (bf16x8){0, 0, 0, 0, 0, 0, 0, 0};
        if (vv) bf = *(const bf16x8*)(up + ks * 32);
#pragma unroll
        for (int m = 0; m < 4; ++m)
          acc[m][nt] = __builtin_amdgcn_mfma_f32_16x16x32_bf16(F[m + 2 - 2 * ks], bf, acc[m][nt], 0, 0, 0);
      }
    }
  }
  const float skip = p.filt_bias[ORDER * 512 + c];
  const int gcol = (ORDER == 0 ? 512 : 1024) + c;
  const bf16_t* graw = hyT + (size_t)gcol * NTOK + tok0;
  const float w0 = p.hy_conv_w[gcol], w1 = p.hy_conv_w[1536 + gcol], w2 = p.hy_conv_w[3072 + gcol], b = p.hy_conv_b[gcol];
  bf16_t* outT = (bf16_t*)(p.ws + (ORDER == 0 ? OFF_ZT : OFF_Y2T)) + (size_t)c * NTOK + tok0;
#pragma unroll
  for (int nt = 0; nt < 2; ++nt) {
    const int col = nt ? col1 : col0;
#pragma unroll
    for (int m = 0; m < 4; ++m) {
      const int t = col * 64 + 16 * m + 4 * fq, pos = t & (L - 1);
      const uint2 uu = *(const uint2*)(sU + col * 72 + 16 * m + 4 * fq);
      const uint2 gv = *(const uint2*)(graw + t);
      float x[6];
      x[0] = pos == 0 ? 0.f : bf2f(graw[t - 1]);
      x[1] = bflo(gv.x); x[2] = bfhi(gv.x); x[3] = bflo(gv.y); x[4] = bfhi(gv.y);
      x[5] = (pos + 4 == L) ? 0.f : bf2f(graw[t + 4]);
      const float u4[4] = {bflo(uu.x), bfhi(uu.x), bflo(uu.y), bfhi(uu.y)};
      float o[4];
#pragma unroll
      for (int j = 0; j < 4; ++j) {
        const float gate = w0 * x[j] + w1 * x[j + 1] + w2 * x[j + 2] + b;
        o[j] = gate * (acc[m][nt][j] + skip * u4[j]);
      }
      *(uint2*)(outT + t) = make_uint2(pack2(o[0], o[1]), pack2(o[2], o[3]));
    }
  }
}

__device__ __forceinline__ void rope32(float* y  , int pos) {
  const float prow = (float)(pos >> 6), pcol = (float)(pos & 63);
  const float fr[8] = {1.f, 0.31622776601683794f, 0.1f, 0.031622776601683794f, 0.01f, 0.0031622776601683794f, 0.001f, 0.00031622776601683794f};
#pragma unroll
  for (int i = 0; i < 8; ++i) {
    const float tr = prow * fr[i] * 0.15915494309189535f, tc = pcol * fr[i] * 0.15915494309189535f;
    const float sr = sin_turns(tr), cr = cos_turns(tr), sc = sin_turns(tc), cc = cos_turns(tc);
    const float a = y[i], b = y[8 + i], c2 = y[16 + i], d2 = y[24 + i];
    y[i] = a * cr - b * sr; y[8 + i] = b * cr + a * sr;
    y[16 + i] = c2 * cc - d2 * sc; y[24 + i] = d2 * cc + c2 * sc;
  }
}
__device__ __forceinline__ void unpack8(const uint4& v, float* x) {
  x[0] = bflo(v.x); x[1] = bfhi(v.x); x[2] = bflo(v.y); x[3] = bfhi(v.y);
  x[4] = bflo(v.z); x[5] = bfhi(v.z); x[6] = bflo(v.w); x[7] = bfhi(v.w);
}
__device__ __forceinline__ float sumsq8(const uint4& v) {
  float x[8];
  unpack8(v, x);
  return x[0] * x[0] + x[1] * x[1] + x[2] * x[2] + x[3] * x[3] + x[4] * x[4] + x[5] * x[5] + x[6] * x[6] + x[7] * x[7];
}
__device__ __forceinline__ uint4 scale8(const uint4& v, float r, const float* __restrict__ g) {
  float x[8];
  unpack8(v, x);
  const float4 g0 = *(const float4*)g, g1 = *(const float4*)(g + 4);
  return make_uint4(pack2(x[0] * r * g0.x, x[1] * r * g0.y), pack2(x[2] * r * g0.z, x[3] * r * g0.w),
                    pack2(x[4] * r * g1.x, x[5] * r * g1.y), pack2(x[6] * r * g1.z, x[7] * r * g1.w));
}
__device__ void qk_item(const Params& p, int item) {
  const int tid = threadIdx.x;
  if (item < 512) {
    const int idx = item * 256 + tid, row = idx >> 3, h = idx & 7;
    const bf16_t* src = (const bf16_t*)(p.ws + OFF_QRAW) + (size_t)row * 768 + h * 96;
    bf16_t* dst = (bf16_t*)(p.ws + OFF_Q) + (size_t)row * 768 + h * 96;
    uint4 raw[12];
#pragma unroll
    for (int i = 0; i < 12; ++i) raw[i] = *(const uint4*)(src + 8 * i);
    float ss = 0.f;
#pragma unroll
    for (int i = 0; i < 12; ++i) ss += sumsq8(raw[i]);
    const float r = rsqrtf(ss * (1.f / 96.f) + 1e-6f);
    const float qs = 0.10206207261596575f * 1.4426950408889634f;
#pragma unroll
    for (int i = 0; i < 8; ++i) *(uint4*)(dst + 8 * i) = scale8(raw[i], r * qs, p.g_q + 8 * i);
    float y[32];
#pragma unroll
    for (int i = 0; i < 4; ++i) unpack8(raw[8 + i], y + 8 * i);
#pragma unroll
    for (int i = 0; i < 32; ++i) y[i] = y[i] * r * p.g_q[64 + i];
    if (row >= NCTX) rope32(y, (row - NCTX) & 4095);
#pragma unroll
    for (int i = 0; i < 4; ++i)
      *(uint4*)(dst + 64 + 8 * i) = make_uint4(pack2(y[8 * i] * qs, y[8 * i + 1] * qs), pack2(y[8 * i + 2] * qs, y[8 * i + 3] * qs),
                                               pack2(y[8 * i + 4] * qs, y[8 * i + 5] * qs), pack2(y[8 * i + 6] * qs, y[8 * i + 7] * qs));
  } else {
    const int idx = (item - 512) * 256 + tid, row = idx >> 3, h = idx & 7;
    const bf16_t* src = (const bf16_t*)(p.ws + OFF_KRAW) + (size_t)row * 512 + h * 64;
    uint4 raw[8];
#pragma unroll
    for (int i = 0; i < 8; ++i) raw[i] = *(const uint4*)(src + 8 * i);
    const float* kp = row < NTOK ? (const float*)(p.ws + OFF_KPE) + (size_t)row * 32 : p.cache_kpe + (size_t)(row - NTOK) * 32;
    float y[32];
#pragma unroll
    for (int i = 0; i < 8; ++i) {
      const float4 v = *(const float4*)(kp + 4 * i);
      y[4 * i] = v.x; y[4 * i + 1] = v.y; y[4 * i + 2] = v.z; y[4 * i + 3] = v.w;
    }
    float ss = 0.f;
#pragma unroll
    for (int i = 0; i < 8; ++i) ss += sumsq8(raw[i]);
#pragma unroll
    for (int i = 0; i < 32; ++i) ss += y[i] * y[i];
    const float r = rsqrtf(ss * (1.f / 96.f) + 1e-6f);
#pragma unroll
    for (int i = 0; i < 32; ++i) y[i] = y[i] * r * p.g_k[64 + i];
    bf16_t* dst;
    if (row < NCTX) dst = (bf16_t*)(p.ws + OFF_KC) + ((size_t)((row >> 8) * 8 + h) * 256 + (row & 255)) * 96;
    else if (row < NTOK) {
      const int rr = row - NCTX;
      rope32(y, rr & 4095);
      dst = (bf16_t*)(p.ws + OFF_KL) + ((size_t)((rr >> 12) * 8 + h) * 4608 + (rr & 4095)) * 96;
    } else {
      const int rr = row - NTOK;
      dst = (bf16_t*)(p.ws + OFF_KL) + ((size_t)((rr >> 9) * 8 + h) * 4608 + 4096 + (rr & 511)) * 96;
    }
#pragma unroll
    for (int i = 0; i < 8; ++i) *(uint4*)(dst + 8 * i) = scale8(raw[i], r, p.g_k + 8 * i);
#pragma unroll
    for (int i = 0; i < 4; ++i)
      *(uint4*)(dst + 64 + 8 * i) = make_uint4(pack2(y[8 * i], y[8 * i + 1]), pack2(y[8 * i + 2], y[8 * i + 3]),
                                               pack2(y[8 * i + 4], y[8 * i + 5]), pack2(y[8 * i + 6], y[8 * i + 7]));
  }
}

__device__ void attn_item(const Params& p, int item, char* smem) {
  const int tid = threadIdx.x, lane = tid & 63, wid = tid >> 6, lr = lane & 31, lh = lane >> 5;
  int nkeys, h, tokbase; const bf16_t *Kp, *Vp;
  if (item < 512) {
    const int b = item >> 8, rem = item & 255; h = rem >> 5; const int qb = rem & 31;
    nkeys = 4608; tokbase = NCTX + b * 4096 + qb * 128;
    Kp = (const bf16_t*)(p.ws + OFF_KL) + (size_t)(b * 8 + h) * 4608 * 96;
    Vp = (const bf16_t*)(p.ws + OFF_VTL) + (size_t)(b * 8 + h) * 64 * 4608;
  } else {
    const int it = item - 512, b = it >> 4; h = (it & 15) >> 1; const int qb = it & 1;
    nkeys = 256; tokbase = b * 256 + qb * 128;
    Kp = (const bf16_t*)(p.ws + OFF_KC) + (size_t)(b * 8 + h) * 256 * 96;
    Vp = (const bf16_t*)(p.ws + OFF_VTC) + (size_t)(b * 8 + h) * 64 * 256;
  }
  bf16_t* sK = (bf16_t*)smem;
  bf16_t* sV = sK + 64 * 104;
  const int token = tokbase + 32 * wid + lr;
  const bf16_t* qsrc = (const bf16_t*)(p.ws + OFF_Q) + (size_t)token * 768 + h * 96 + 8 * lh;
  bf16x8 qf[6];
#pragma unroll
  for (int ks = 0; ks < 6; ++ks) qf[ks] = *(const bf16x8*)(qsrc + 16 * ks);
  f32x16 oacc[2];
#pragma unroll
  for (int j = 0; j < 16; ++j) { oacc[0][j] = 0.f; oacc[1][j] = 0.f; }
  float mrun = -1e30f, lsum = 0.f;
  const int kk0 = tid / 12, kc0 = tid % 12, kk1 = (tid + 256) / 12, kc1 = (tid + 256) % 12, kk2 = (tid + 512) / 12, kc2 = (tid + 512) % 12;
  const int vd0 = tid >> 3, vc0 = tid & 7, vd1 = vd0 + 32;
  const bf16_t* gk0 = Kp + (size_t)kk0 * 96 + kc0 * 8;
  const bf16_t* gk1 = Kp + (size_t)kk1 * 96 + kc1 * 8;
  const bf16_t* gk2 = Kp + (size_t)kk2 * 96 + kc2 * 8;
  const bf16_t* gv0 = Vp + (size_t)vd0 * nkeys + vc0 * 8;
  const bf16_t* gv1 = Vp + (size_t)vd1 * nkeys + vc0 * 8;
  uint4 rk0 = *(const uint4*)gk0, rk1 = *(const uint4*)gk1, rk2 = *(const uint4*)gk2;
  uint4 rv0 = *(const uint4*)gv0, rv1 = *(const uint4*)gv1;
  const int nt = nkeys >> 6;
  for (int kt = 0; kt < nt; ++kt) {
    __syncthreads();
    *(uint4*)(sK + kk0 * 104 + kc0 * 8) = rk0; *(uint4*)(sK + kk1 * 104 + kc1 * 8) = rk1; *(uint4*)(sK + kk2 * 104 + kc2 * 8) = rk2;
    *(uint4*)(sV + vd0 * 72 + vc0 * 8) = rv0; *(uint4*)(sV + vd1 * 72 + vc0 * 8) = rv1;
    __syncthreads();
    if (kt + 1 < nt) {
      gk0 += 64 * 96; gk1 += 64 * 96; gk2 += 64 * 96; gv0 += 64; gv1 += 64;
      rk0 = *(const uint4*)gk0; rk1 = *(const uint4*)gk1; rk2 = *(const uint4*)gk2;
      rv0 = *(const uint4*)gv0; rv1 = *(const uint4*)gv1;
    }
    f32x16 sacc[2];
#pragma unroll
    for (int kb = 0; kb < 2; ++kb) {
#pragma unroll
      for (int j = 0; j < 16; ++j) sacc[kb][j] = 0.f;
#pragma unroll
      for (int ks = 0; ks < 6; ++ks) {
        const bf16x8 a = *(const bf16x8*)(sK + (32 * kb + lr) * 104 + 16 * ks + 8 * lh);
        sacc[kb] = __builtin_amdgcn_mfma_f32_32x32x16_bf16(a, qf[ks], sacc[kb], 0, 0, 0);
      }
    }
    float mx = sacc[0][0];
#pragma unroll
    for (int j = 1; j < 16; ++j) mx = fmaxf(mx, sacc[0][j]);
#pragma unroll
    for (int j = 0; j < 16; ++j) mx = fmaxf(mx, sacc[1][j]);
    mx = fmaxf(mx, __shfl_xor(mx, 32));
    const float mnew = fmaxf(mrun, mx);
    const float alpha = __builtin_amdgcn_exp2f(mrun - mnew);
    mrun = mnew;
    float ps = 0.f;
#pragma unroll
    for (int kb = 0; kb < 2; ++kb)
#pragma unroll
      for (int j = 0; j < 16; ++j) { const float e = __builtin_amdgcn_exp2f(sacc[kb][j] - mnew); sacc[kb][j] = e; ps += e; }
    lsum = lsum * alpha + ps;
#pragma unroll
    for (int j = 0; j < 16; ++j) { oacc[0][j] *= alpha; oacc[1][j] *= alpha; }
#pragma unroll
    for (int s = 0; s < 4; ++s) {
      const int kb = s >> 1, jb = 8 * (s & 1);
      union { unsigned u[4]; bf16x8 v; } pf;
      pf.u[0] = pack2(sacc[kb][jb + 0], sacc[kb][jb + 1]); pf.u[1] = pack2(sacc[kb][jb + 2], sacc[kb][jb + 3]);
      pf.u[2] = pack2(sacc[kb][jb + 4], sacc[kb][jb + 5]); pf.u[3] = pack2(sacc[kb][jb + 6], sacc[kb][jb + 7]);
#pragma unroll
      for (int mt = 0; mt < 2; ++mt) {
        const bf16_t* vp = sV + (32 * mt + lr) * 72 + 16 * s + 4 * lh;
        union { uint2 d[2]; bf16x8 v; } av;
        av.d[0] = *(const uint2*)vp;
        av.d[1] = *(const uint2*)(vp + 8);
        oacc[mt] = __builtin_amdgcn_mfma_f32_32x32x16_bf16(av.v, pf.v, oacc[mt], 0, 0, 0);
      }
    }
  }
  lsum += __shfl_xor(lsum, 32);
  const float inv = 1.f / lsum;
  bf16_t* dst = (bf16_t*)(p.ws + OFF_ATTN) + (size_t)token * 512 + h * 64;
#pragma unroll
  for (int mt = 0; mt < 2; ++mt)
#pragma unroll
    for (int jg = 0; jg < 4; ++jg) {
      const int dv0 = 32 * mt + 8 * jg + 4 * lh;
      *(uint2*)(dst + dv0) = make_uint2(pack2(oacc[mt][4 * jg] * inv, oacc[mt][4 * jg + 1] * inv),
                                        pack2(oacc[mt][4 * jg + 2] * inv, oacc[mt][4 * jg + 3] * inv));
    }
}

__device__ void merge_item(const Params& p, int item, char* smem) {
  const int tid = threadIdx.x, lane = tid & 63, wid = tid >> 6, t0 = item * 32;
  bf16_t* mix = (bf16_t*)(p.ws + OFF_H);
  const bf16_t* attn = (const bf16_t*)(p.ws + OFF_ATTN);
  for (int tt = 0; tt < 8; ++tt) {
    const int token = t0 + wid * 8 + tt;
    float x[8];
    unpack8(*(const uint4*)(attn + (size_t)token * 512 + lane * 8), x);
    float ss = 0.f;
#pragma unroll
    for (int i = 0; i < 8; ++i) ss += x[i] * x[i];
    ss = wave_sum(ss);
    const float r = rsqrtf(ss * (1.f / 512.f) + 1e-6f);
    const float4 g0 = *(const float4*)(p.g_out_att + lane * 8), g1 = *(const float4*)(p.g_out_att + lane * 8 + 4);
    *(uint4*)(mix + (size_t)token * D + lane * 8) =
        make_uint4(pack2(x[0] * r * g0.x, x[1] * r * g0.y), pack2(x[2] * r * g0.z, x[3] * r * g0.w),
                   pack2(x[4] * r * g1.x, x[5] * r * g1.y), pack2(x[6] * r * g1.z, x[7] * r * g1.w));
  }
  bf16_t* sT = (bf16_t*)smem;
  const bf16_t* y2T = (const bf16_t*)(p.ws + OFF_Y2T);
  __syncthreads();
  for (int ch = tid; ch < 2048; ch += 256) {
    const int c = ch >> 2, q4 = ch & 3;
    const uint4 v = *(const uint4*)(y2T + (size_t)c * NTOK + t0 + q4 * 8);
    bf16_t* d = sT + (q4 * 8) * 520 + c;
    d[0 * 520] = (bf16_t)(v.x & 0xffff); d[1 * 520] = (bf16_t)(v.x >> 16);
    d[2 * 520] = (bf16_t)(v.y & 0xffff); d[3 * 520] = (bf16_t)(v.y >> 16);
    d[4 * 520] = (bf16_t)(v.z & 0xffff); d[5 * 520] = (bf16_t)(v.z >> 16);
    d[6 * 520] = (bf16_t)(v.w & 0xffff); d[7 * 520] = (bf16_t)(v.w >> 16);
  }
  __syncthreads();
  {
    const int tt = tid >> 3, part = tid & 7;
    uint4 v[8];
    float ss = 0.f;
#pragma unroll
    for (int i = 0; i < 8; ++i) {
      v[i] = *(const uint4*)(sT + tt * 520 + part * 64 + 8 * i);
      float x[8];
      unpack8(v[i], x);
#pragma unroll
      for (int e = 0; e < 8; ++e) ss += x[e] * x[e];
    }
    ss += __shfl_xor(ss, 1); ss += __shfl_xor(ss, 2); ss += __shfl_xor(ss, 4);
    const float r = rsqrtf(ss * (1.f / 512.f) + 1e-6f);
#pragma unroll
    for (int i = 0; i < 8; ++i) {
      float x[8];
      unpack8(v[i], x);
      const int c0 = part * 64 + 8 * i;
      const float4 g0 = *(const float4*)(p.g_out_hy + c0), g1 = *(const float4*)(p.g_out_hy + c0 + 4);
      *(uint4*)(mix + (size_t)(t0 + tt) * D + 512 + c0) =
          make_uint4(pack2(x[0] * r * g0.x, x[1] * r * g0.y), pack2(x[2] * r * g0.z, x[3] * r * g0.w),
                     pack2(x[4] * r * g1.x, x[5] * r * g1.y), pack2(x[6] * r * g1.z, x[7] * r * g1.w));
    }
  }
}

__device__ void act_item(const Params& p, int item, int half) {
  const int idx = item * 256 + threadIdx.x;
  if (idx >= 1024 * 352) return;
  const int j = (idx % 352) * 8, r0 = (idx / 352) * 8;
  const int L = half ? SEQL : SEQC;
  const bf16_t* u = (const bf16_t*)(p.ws + OFF_U);
  bf16_t* act = (bf16_t*)(p.ws + OFF_ACT);
  float wa[3][8], wg[3][8], ba[8], bg[8];
#pragma unroll
  for (int t = 0; t < 3; ++t)
#pragma unroll
    for (int e = 0; e < 8; ++e) { wa[t][e] = p.ffn_conv_w[t * 5632 + j + e]; wg[t][e] = p.ffn_conv_w[t * 5632 + 2816 + j + e]; }
#pragma unroll
  for (int e = 0; e < 8; ++e) { ba[e] = p.ffn_conv_b[j + e]; bg[e] = p.ffn_conv_b[2816 + j + e]; }
  float pa[8], pg[8], ca[8], cg_[8], na[8], ng[8];
  if ((r0 & (L - 1)) == 0) {
#pragma unroll
    for (int e = 0; e < 8; ++e) { pa[e] = 0.f; pg[e] = 0.f; }
  } else {
    unpack8(*(const uint4*)(u + (size_t)(r0 - 1) * 5632 + j), pa);
    unpack8(*(const uint4*)(u + (size_t)(r0 - 1) * 5632 + 2816 + j), pg);
  }
  unpack8(*(const uint4*)(u + (size_t)r0 * 5632 + j), ca);
  unpack8(*(const uint4*)(u + (size_t)r0 * 5632 + 2816 + j), cg_);
#pragma unroll
  for (int i = 0; i < 8; ++i) {
    const int r = r0 + i;
    if (((r + 1) & (L - 1)) == 0) {
#pragma unroll
      for (int e = 0; e < 8; ++e) { na[e] = 0.f; ng[e] = 0.f; }
    } else {
      unpack8(*(const uint4*)(u + (size_t)(r + 1) * 5632 + j), na);
      unpack8(*(const uint4*)(u + (size_t)(r + 1) * 5632 + 2816 + j), ng);
    }
    float o[8];
#pragma unroll
    for (int e = 0; e < 8; ++e) {
      const float a = wa[0][e] * pa[e] + wa[1][e] * ca[e] + wa[2][e] * na[e] + ba[e];
      const float g = wg[0][e] * pg[e] + wg[1][e] * cg_[e] + wg[2][e] * ng[e] + bg[e];
      o[e] = a / (1.f + __expf(-a)) * g;
    }
    *(uint4*)(act + (size_t)r * 2816 + j) = make_uint4(pack2(o[0], o[1]), pack2(o[2], o[3]), pack2(o[4], o[5]), pack2(o[6], o[7]));
#pragma unroll
    for (int e = 0; e < 8; ++e) { pa[e] = ca[e]; pg[e] = cg_[e]; ca[e] = na[e]; cg_[e] = ng[e]; }
  }
}

template <int ph>
__device__ __forceinline__ void run_phase(const Params& p, char* smem) {
  const int bid = blockIdx.x, G = gridDim.x;
  char* ws = p.ws;
  if constexpr (ph == 0) {
    for (int it = bid; it < 272 + 96 + 32 + 3080; it += G) {
      if (it < 272) filter_item(p, it, smem);
      else if (it < 368) mod_item(p, it - 272, smem);
      else if (it < 400) cache_item(p, it - 368);
      else {
        int t = it - 400;
        if (t < 576) transpose_item(p.w_in, 1024, DIN, (bf16_t*)(ws + OFF_WIN), t, 36, smem);
        else if ((t -= 576) < 72) transpose_item(p.w_uq, 384, 768, (bf16_t*)(ws + OFF_WUQ), t, 12, smem);
        else if ((t -= 72) < 64) transpose_item(p.w_ukv, 256, 1024, (bf16_t*)(ws + OFF_WUKV), t, 16, smem);
        else if ((t -= 64) < 256) transpose_item(p.w_out, 1024, 1024, (bf16_t*)(ws + OFF_WOUT), t, 16, smem);
        else if ((t -= 256) < 1408) transpose_item(p.w_up, 1024, 5632, (bf16_t*)(ws + OFF_WUP), t, 88, smem);
        else { t -= 1408; transpose_item(p.w_down, 2816, 1024, (bf16_t*)(ws + OFF_WDOWN), t, 16, smem); }
      }
    }
  } else if constexpr (ph == 1) {
    rmsmod_phase<0>(p);
  } else if constexpr (ph == 2) {
    EpiIn epi{(float*)(ws + OFF_PROJ), (bf16_t*)(ws + OFF_HYT)};
    for (int t = bid; t < 128 * 18; t += G)
      gemm_tile<false>((const bf16_t*)(ws + OFF_H), 1024, (const bf16_t*)(ws + OFF_WIN), 1024, 1024, (t / 18) * 128, (t % 18) * 128, smem, epi);
  } else if constexpr (ph == 3) {
    for (int it = bid; it < 1024 + 256; it += G) {
      if (it < 512) hyena_item<0>(p, 1, it, smem);
      else if (it < 1024) hyena_item<0>(p, 0, it - 512, smem);
      else token_item(p, it - 1024);
    }
  } else if constexpr (ph == 4) {
    EpiQ eq{(bf16_t*)(ws + OFF_QRAW)};
    EpiKV ekv{(bf16_t*)(ws + OFF_KRAW), (bf16_t*)(ws + OFF_VTC), (bf16_t*)(ws + OFF_VTL)};
    for (int it = bid; it < 512 + 768 + 1088 + 512; it += G) {
      if (it < 512) { if (!DBG_NOHY) hyena_item<1>(p, 1, it, smem); }
      else if (it < 1280) { const int t = it - 512; gemm_tile<true>((const bf16_t*)(ws + OFF_QA), 384, (const bf16_t*)(ws + OFF_WUQ), 384, 384, (t / 6) * 128, (t % 6) * 128, smem, eq); }
      else if (it < 2368) { const int t = it - 1280; gemm_tile<false>((const bf16_t*)(ws + OFF_CKVN), 256, (const bf16_t*)(ws + OFF_WUKV), 256, 256, (t / 8) * 128, (t % 8) * 128, smem, ekv); }
      else if (!DBG_NOHY) hyena_item<1>(p, 0, it - 2368, smem);
    }
  } else if constexpr (ph == 5) {
    for (int it = bid; it < 512 + 544; it += G) qk_item(p, it);
  } else if constexpr (ph == 6) {
    for (int it = bid; it < 1024; it += G) attn_item(p, it, smem);
  } else if constexpr (ph == 7) {
    for (int it = bid; it < 512; it += G) merge_item(p, it, smem);
  } else if constexpr (ph == 8) {
    EpiOut epi{&p};
    for (int t = bid; t < 128 * 8; t += G)
      gemm_tile<true>((const bf16_t*)(ws + OFF_H), 1024, (const bf16_t*)(ws + OFF_WOUT), 1024, 1024, (t / 8) * 128, (t % 8) * 128, smem, epi);
  } else if constexpr (ph == 9) {
    rmsmod_phase<1>(p);
  } else if constexpr (ph == 10 || ph == 13) {
    constexpr int half = ph == 10 ? 0 : 1;
    EpiU epi{(bf16_t*)(ws + OFF_U)};
    for (int t = bid; t < 64 * 44; t += G)
      gemm_tile<true>((const bf16_t*)(ws + OFF_H) + (size_t)half * 8192 * 1024, 1024, (const bf16_t*)(ws + OFF_WUP), 1024, 1024, (t / 44) * 128, (t % 44) * 128, smem, epi);
  } else if constexpr (ph == 11 || ph == 14) {
    for (int it = bid; it < 1408; it += G) act_item(p, it, ph == 11 ? 0 : 1);
  } else if constexpr (ph == 12 || ph == 15) {
    EpiY epi{&p, ph == 12 ? 0 : 1};
    for (int t = bid; t < 64 * 8; t += G)
      gemm_tile<true>((const bf16_t*)(ws + OFF_ACT), 2816, (const bf16_t*)(ws + OFF_WDOWN), 2816, 2816, (t / 8) * 128, (t % 8) * 128, smem, epi);
  }
}

#if ONE_LAUNCH
template <int PH>
__device__ __forceinline__ void run_all(const Params& p, char* smem, cg::grid_group& grid) {
  run_phase<PH>(p, smem);
  if constexpr (PH < 15) { grid.sync(); run_all<PH + 1>(p, smem, grid); }
}
__global__ void __launch_bounds__(256, 2) mega_kernel(Params p) {
  __shared__ __attribute__((aligned(16))) char smem[SMEM_BYTES];
  cg::grid_group grid = cg::this_grid();
  run_all<0>(p, smem, grid);
}
#else
template <int PH>
__global__ void __launch_bounds__(256, 2) phase_kernel(Params p) {
  __shared__ __attribute__((aligned(16))) char smem[SMEM_BYTES];
  run_phase<PH>(p, smem);
}
#ifndef DBG_STOP
#define DBG_STOP 15
#endif
__global__ void dump_kernel(Params p, size_t off, int count) {
  const bf16_t* src = (const bf16_t*)(p.ws + off);
  const bf16_t* src2 = (const bf16_t*)(p.ws + DBG_OFF2);
  for (int i = blockIdx.x * 256 + threadIdx.x; i < 16777216; i += gridDim.x * 256)
    p.out[i] = i < DBG_CNT ? bf2f(src[i]) : (i - DBG_CNT < DBG_CNT2 ? bf2f(src2[i - DBG_CNT]) : 0.f);
}
template <int PH>
static void launch_all(const Params& p, hipStream_t stream) {
  phase_kernel<PH><<<512, 256, 0, stream>>>(p);
  if constexpr (PH < DBG_STOP) launch_all<PH + 1>(p, stream);
}
#endif

extern "C" void kernel_launch(void* const* d_in, const int* in_sizes, int n_in, void* d_out, int out_size, void* d_ws,
                              size_t ws_size, hipStream_t stream) {
  Params p{};
  const float** pp = (const float**)&p;
  for (int i = 0; i < 34; ++i) pp[i] = (const float*)d_in[i];
  p.out = (float*)d_out;
  p.ws = (char*)d_ws;
#if ONE_LAUNCH
  static int grid_blocks = 0;
  if (!grid_blocks) {
    int dev = 0, cus = 0, per_cu = 0;
    hipGetDevice(&dev);
    hipDeviceGetAttribute(&cus, hipDeviceAttributeMultiprocessorCount, dev);
    hipOccupancyMaxActiveBlocksPerMultiprocessor(&per_cu, mega_kernel, 256, 0);
    grid_blocks = cus * per_cu;
  }
  void* args[] = {&p};
  hipError_t e = hipLaunchCooperativeKernel((void*)mega_kernel, dim3(grid_blocks), dim3(256), args, 0, stream);
  if (e != hipSuccess) fprintf(stderr, "cooperative launch failed: %s (grid %d)\n", hipGetErrorString(e), grid_blocks);
#else
  launch_all<0>(p, stream);
#if DBG_STOP < 15
  dump_kernel<<<1024, 256, 0, stream>>>(p, DBG_OFF, DBG_CNT);
#endif
#endif
}
```

```cpp
#include <hip/hip_runtime.h>
#include <hip/hip_cooperative_groups.h>
#include <cstdio>
namespace cg = cooperative_groups;

#define DBG_STOP 15
#define DBG_NOHY 0
#define DBG_OFF OFF_QRAW
#define DBG_OFF2 OFF_KRAW
#define DBG_CNT 12582912
#define DBG_CNT2 0
#ifndef ONE_LAUNCH
#define ONE_LAUNCH 1
#endif

typedef unsigned short bf16_t;
typedef short bf16x8 __attribute__((ext_vector_type(8)));
typedef float f32x4 __attribute__((ext_vector_type(4)));
typedef float f32x16 __attribute__((ext_vector_type(16)));

constexpr int D = 1024, NTOK = 16384, NCTX = 8192, SEQC = 256, SEQL = 4096;
constexpr int DIN = 2208, DINP = 2304, QL = 384, KVL = 256, DFF = 2816;
constexpr int NROWKV = 17408;
constexpr size_t MiB = 1048576;

constexpr size_t OFF_WIN = 0;
constexpr size_t OFF_WUQ = OFF_WIN + (size_t)DINP * 1024 * 2;
constexpr size_t OFF_WUKV = OFF_WUQ + (size_t)768 * 384 * 2;
constexpr size_t OFF_WOUT = OFF_WUKV + (size_t)1024 * 256 * 2;
constexpr size_t OFF_WUP = OFF_WOUT + (size_t)1024 * 1024 * 2;
constexpr size_t OFF_WDOWN = OFF_WUP + (size_t)5632 * 1024 * 2;
constexpr size_t OFF_MOD = OFF_WDOWN + (size_t)1024 * 2816 * 2;
static_assert(OFF_MOD + 3 * 6144 * 4 <= 25 * MiB, "A region");
constexpr size_t OFF_RLAT = 25 * MiB;
constexpr size_t OFF_RCTX = 41 * MiB;
constexpr size_t OFF_H = 42 * MiB;
constexpr size_t OFF_ZT = 42 * MiB;
constexpr size_t OFF_QA = 58 * MiB;
constexpr size_t OFF_KPE = 70 * MiB;
constexpr size_t OFF_PROJ = 74 * MiB;
constexpr size_t OFF_QRAW = 74 * MiB;
constexpr size_t OFF_Y2T = 98 * MiB;
constexpr size_t OFF_ATTN = 74 * MiB;
constexpr size_t OFF_U = 74 * MiB;
constexpr size_t OFF_HYT = 116 * MiB;
constexpr size_t OFF_Q = 116 * MiB;
constexpr size_t OFF_KC = 140 * MiB;
constexpr size_t OFF_KL = 152 * MiB;
constexpr size_t OFF_CKVN = 164 * MiB;
constexpr size_t OFF_KRAW = 173 * MiB;
constexpr size_t OFF_VTC = 190 * MiB;
constexpr size_t OFF_VTL = 198 * MiB;
constexpr size_t OFF_ACT = 162 * MiB;

constexpr int OUT_YS = 0;
constexpr int OUT_CKV = 16777216;
constexpr int OUT_KPE = 16777216 + 2097152;

constexpr int SMEM_BYTES = 51200;

struct Params {
  const float *x_prompt, *x_sample, *cache_ckv, *cache_kpe, *c, *c_ctx, *w_ada, *b_ada, *g_mix, *w_in, *g_qa, *w_uq,
      *g_kva, *w_ukv, *g_q, *g_k, *hy_conv_w, *hy_conv_b, *filt_w1, *filt_b1, *filt_freq1, *filt_w2, *filt_b2,
      *filt_freq2, *filt_w3, *filt_bias, *g_out_att, *g_out_hy, *w_out, *g_ffn, *w_up, *ffn_conv_w, *ffn_conv_b, *w_down;
  float* out;
  char* ws;
};

typedef __bf16 bf16x2_t __attribute__((ext_vector_type(2)));
__device__ __forceinline__ unsigned pack2(float lo, float hi) {
  bf16x2_t v;
  v[0] = (__bf16)lo;
  v[1] = (__bf16)hi;
  return __builtin_bit_cast(unsigned, v);
}
__device__ __forceinline__ float bflo(unsigned u) { return __uint_as_float(u << 16); }
__device__ __forceinline__ float bfhi(unsigned u) { return __uint_as_float(u & 0xffff0000u); }
__device__ __forceinline__ float bf2f(bf16_t h) { return __uint_as_float(((unsigned)h) << 16); }
__device__ __forceinline__ bf16_t f2bf(float f) { return (bf16_t)(pack2(f, 0.f) & 0xffffu); }
__device__ __forceinline__ float wave_sum(float v) {
#pragma unroll
  for (int o = 32; o >= 1; o >>= 1) v += __shfl_xor(v, o);
  return v;
}
__device__ __forceinline__ float sin_turns(float t) { t -= floorf(t); return __builtin_amdgcn_sinf(t); }
__device__ __forceinline__ float cos_turns(float t) { t -= floorf(t); return __builtin_amdgcn_cosf(t); }
__device__ __forceinline__ float sin_rad(float x) { return sin_turns(x * 0.15915494309189535f); }
__device__ __forceinline__ const float* xrow(const Params& p, int row) {
  return row < NCTX ? p.x_prompt + (size_t)row * D : p.x_sample + (size_t)(row - NCTX) * D;
}
__device__ __forceinline__ int modidx(int row) { return row < NCTX ? 0 : 1 + ((row - NCTX) >> 12); }

template <bool SWAP, class Epi>
__device__ __forceinline__ void gemm_tile(const bf16_t* __restrict__ A, int lda, const bf16_t* __restrict__ Bt, int ldb,
                                          int K, int m0, int n0, char* smem, const Epi& epi) {
  const int tid = threadIdx.x, lane = tid & 63, wid = tid >> 6, wr = wid >> 1, wc = wid & 1;
  const int fr = lane & 15, fq = lane >> 4;
  bf16_t* sA = (bf16_t*)smem;
  bf16_t* sB = sA + 128 * 72;
  f32x4 acc[4][4];
#pragma unroll
  for (int m = 0; m < 4; ++m)
#pragma unroll
    for (int n = 0; n < 4; ++n) acc[m][n] = (f32x4){0.f, 0.f, 0.f, 0.f};
  const int lr = tid >> 3, lc = (tid & 7) * 8;
  const bf16_t* ga = A + (size_t)(m0 + lr) * lda + lc;
  const bf16_t* gb = Bt + (size_t)(n0 + lr) * ldb + lc;
  const size_t sa32 = (size_t)32 * lda, sb32 = (size_t)32 * ldb;
  uint4 ra0 = *(const uint4*)(ga), ra1 = *(const uint4*)(ga + sa32), ra2 = *(const uint4*)(ga + 2 * sa32), ra3 = *(const uint4*)(ga + 3 * sa32);
  uint4 rb0 = *(const uint4*)(gb), rb1 = *(const uint4*)(gb + sb32), rb2 = *(const uint4*)(gb + 2 * sb32), rb3 = *(const uint4*)(gb + 3 * sb32);
  const int nk = K >> 6;
  bf16_t* wa = sA + lr * 72 + lc;
  bf16_t* wb = sB + lr * 72 + lc;
  for (int kt = 0; kt < nk; ++kt) {
    __syncthreads();
    *(uint4*)(wa) = ra0; *(uint4*)(wa + 32 * 72) = ra1; *(uint4*)(wa + 64 * 72) = ra2; *(uint4*)(wa + 96 * 72) = ra3;
    *(uint4*)(wb) = rb0; *(uint4*)(wb + 32 * 72) = rb1; *(uint4*)(wb + 64 * 72) = rb2; *(uint4*)(wb + 96 * 72) = rb3;
    __syncthreads();
    if (kt + 1 < nk) {
      ga += 64;
      gb += 64;
      ra0 = *(const uint4*)(ga); ra1 = *(const uint4*)(ga + sa32); ra2 = *(const uint4*)(ga + 2 * sa32); ra3 = *(const uint4*)(ga + 3 * sa32);
      rb0 = *(const uint4*)(gb); rb1 = *(const uint4*)(gb + sb32); rb2 = *(const uint4*)(gb + 2 * sb32); rb3 = *(const uint4*)(gb + 3 * sb32);
    }
#pragma unroll
    for (int ks = 0; ks < 2; ++ks) {
      bf16x8 af[4], bfr[4];
#pragma unroll
      for (int m = 0; m < 4; ++m) af[m] = *(const bf16x8*)(sA + (wr * 64 + m * 16 + fr) * 72 + ks * 32 + fq * 8);
#pragma unroll
      for (int n = 0; n < 4; ++n) bfr[n] = *(const bf16x8*)(sB + (wc * 64 + n * 16 + fr) * 72 + ks * 32 + fq * 8);
#pragma unroll
      for (int m = 0; m < 4; ++m)
#pragma unroll
        for (int n = 0; n < 4; ++n) {
          if (SWAP) acc[m][n] = __builtin_amdgcn_mfma_f32_16x16x32_bf16(bfr[n], af[m], acc[m][n], 0, 0, 0);
          else acc[m][n] = __builtin_amdgcn_mfma_f32_16x16x32_bf16(af[m], bfr[n], acc[m][n], 0, 0, 0);
        }
    }
  }
#pragma unroll
  for (int m = 0; m < 4; ++m)
#pragma unroll
    for (int n = 0; n < 4; ++n) {
      if (SWAP) epi(m0 + wr * 64 + m * 16 + fr, n0 + wc * 64 + n * 16 + fq * 4, acc[m][n]);
      else epi(m0 + wr * 64 + m * 16 + fq * 4, n0 + wc * 64 + n * 16 + fr, acc[m][n]);
    }
}

__device__ void transpose_item(const float* __restrict__ W, int K, int N, bf16_t* __restrict__ WT, int tile, int ntn, char* smem) {
  float* s = (float*)smem;
  const int tk = tile / ntn, tn = tile % ntn, tid = threadIdx.x;
  const int k0 = tk * 64, n0 = tn * 64;
  __syncthreads();
  {
    const int r = tid >> 4, c4 = (tid & 15) * 4;
#pragma unroll
    for (int i = 0; i < 4; ++i) {
      const int k = r + 16 * i;
      float4 v = make_float4(0.f, 0.f, 0.f, 0.f);
      if (n0 + c4 < N) v = *(const float4*)(W + (size_t)(k0 + k) * N + n0 + c4);
      s[k * 65 + c4 + 0] = v.x; s[k * 65 + c4 + 1] = v.y; s[k * 65 + c4 + 2] = v.z; s[k * 65 + c4 + 3] = v.w;
    }
  }
  __syncthreads();
  {
    const int n = tid >> 2, kc = (tid & 3) * 16;
    unsigned o[8];
#pragma unroll
    for (int i = 0; i < 8; ++i) o[i] = pack2(s[(kc + 2 * i) * 65 + n], s[(kc + 2 * i + 1) * 65 + n]);
    uint4* dst = (uint4*)(WT + (size_t)(n0 + n) * K + k0 + kc);
    dst[0] = make_uint4(o[0], o[1], o[2], o[3]);
    dst[1] = make_uint4(o[4], o[5], o[6], o[7]);
  }
}

__device__ void mod_item(const Params& p, int item, char* smem) {
  float* s = (float*)smem;
  float* red = s + 3072;
  const int tid = threadIdx.x;
  __syncthreads();
  for (int e = tid; e < 3072; e += 256) {
    const int v = e >> 10, k = e & 1023;
    const float x = (v == 0) ? p.c_ctx[k] : p.c[(v - 1) * D + k];
    s[e] = x / (1.f + __expf(-x));
  }
  __syncthreads();
  const int jl = tid & 63, kq = tid >> 6, j = item * 64 + jl, k0 = kq * 256;
  float a0 = 0.f, a1 = 0.f, a2 = 0.f;
#pragma unroll 8
  for (int k = 0; k < 256; ++k) {
    const float w = p.w_ada[(size_t)(k0 + k) * 6144 + j];
    a0 += s[k0 + k] * w; a1 += s[1024 + k0 + k] * w; a2 += s[2048 + k0 + k] * w;
  }
  red[(kq * 3 + 0) * 64 + jl] = a0; red[(kq * 3 + 1) * 64 + jl] = a1; red[(kq * 3 + 2) * 64 + jl] = a2;
  __syncthreads();
  if (tid < 192) {
    const int v = tid >> 6;
    const float r = red[(0 * 3 + v) * 64 + jl] + red[(1 * 3 + v) * 64 + jl] + red[(2 * 3 + v) * 64 + jl] + red[(3 * 3 + v) * 64 + jl];
    ((float*)(p.ws + OFF_MOD))[v * 6144 + j] = r + p.b_ada[j];
  }
}

__device__ void filter_item(const Params& p, int item, char* smem) {
  int n, p0; bf16_t* R;
  if (item < 256) { n = 4096; p0 = item * 16; R = (bf16_t*)(p.ws + OFF_RLAT); }
  else { n = 256; p0 = (item - 256) * 16; R = (bf16_t*)(p.ws + OFF_RCTX); }
  const int n2 = 2 * n, tid = threadIdx.x;
  float* z = (float*)smem;
  float* h1 = z + 16 * 36;
  float* h2 = h1 + 16 * 64;
  __syncthreads();
#pragma unroll 1
  for (int e = tid; e < 16 * 33; e += 256) {
    const int pp = e / 33, f = e % 33, pos = p0 + pp;
    float val;
    if (f == 0) val = (float)pos / (float)(n - 1);
    else {
      const int k = (f - 1) & 15;
      const float band = 1e-4f + (float)k * ((15.f - 1e-4f) / 15.f);
      const float turns = band * ((float)pos / (float)n);
      val = (f <= 16) ? cos_turns(turns) : -sin_turns(turns);
    }
    z[pp * 36 + f] = val;
  }
  __syncthreads();
#pragma unroll 1
  for (int e = tid; e < 1024; e += 256) {
    const int pp = e >> 6, j = e & 63;
    float a = p.filt_b1[j];
#pragma unroll 3
    for (int f = 0; f < 33; ++f) a += z[pp * 36 + f] * p.filt_w1[f * 64 + j];
    h1[e] = sin_rad(p.filt_freq1[j] * a);
  }
  __syncthreads();
#pragma unroll 1
  for (int e = tid; e < 1024; e += 256) {
    const int pp = e >> 6, j = e & 63;
    float a = p.filt_b2[j];
#pragma unroll 4
    for (int k = 0; k < 64; ++k) a += h1[pp * 64 + k] * p.filt_w2[k * 64 + j];
    h2[j * 16 + pp] = sin_rad(p.filt_freq2[j] * a);
  }
  __syncthreads();
  const float mind = -3.0701134573253946f, maxd = -15.350567286626973f;
#pragma unroll 1
  for (int ci = 0; ci < 8; ++ci) {
    const int col = tid + 256 * ci, o = col >> 10, dir = (col >> 9) & 1, c = col & 511;
    float acc[16];
#pragma unroll
    for (int i = 0; i < 16; ++i) acc[i] = 0.f;
#pragma unroll 4
    for (int k = 0; k < 64; ++k) {
      const float w = p.filt_w3[k * 2048 + col];
      const float4 ha = *(const float4*)(h2 + k * 16), hb = *(const float4*)(h2 + k * 16 + 4), hc = *(const float4*)(h2 + k * 16 + 8), hd = *(const float4*)(h2 + k * 16 + 12);
      acc[0] += ha.x * w; acc[1] += ha.y * w; acc[2] += ha.z * w; acc[3] += ha.w * w;
      acc[4] += hb.x * w; acc[5] += hb.y * w; acc[6] += hb.z * w; acc[7] += hb.w * w;
      acc[8] += hc.x * w; acc[9] += hc.y * w; acc[10] += hc.z * w; acc[11] += hc.w * w;
      acc[12] += hd.x * w; acc[13] += hd.y * w; acc[14] += hd.z * w; acc[15] += hd.w * w;
    }
    const float delta = fabsf(mind + (float)c * ((maxd - mind) / 511.f));
    bf16_t* Rrow = R + (size_t)(o * 512 + c) * n2;
#pragma unroll
    for (int i = 0; i < 16; ++i) {
      const int pos = p0 + i;
      const float t = (float)pos / (float)(n - 1);
      float val = acc[i] * (__expf(-t * delta) + 0.05f);
      int idx = dir == 0 ? (n - 1 - pos) : (n - 1 + pos);
      if (dir == 1 && pos == 0) { idx = n2 - 1; val = 0.f; }
      Rrow[idx] = f2bf(val);
    }
  }
}

__device__ void cache_item(const Params& p, int item) {
  const int tid = threadIdx.x, r0 = item * 32;
  bf16_t* ckvn = (bf16_t*)(p.ws + OFF_CKVN);
#pragma unroll 2
  for (int e = tid; e < 32 * 64; e += 256) {
    const int r = r0 + (e >> 6), c4 = (e & 63) * 4;
    const float4 v = *(const float4*)(p.cache_ckv + (size_t)r * 256 + c4);
    *(uint2*)(ckvn + (size_t)(NTOK + r) * 256 + c4) = make_uint2(pack2(v.x, v.y), pack2(v.z, v.w));
  }
}

template <int WHICH>
__device__ void rmsmod_phase(const Params& p) {
  const int lane = threadIdx.x & 63, wid = threadIdx.x >> 6;
  const int gw = blockIdx.x * 4 + wid, tw = gridDim.x * 4;
  const float* g = WHICH == 0 ? p.g_mix : p.g_ffn;
  const float* mod = (const float*)(p.ws + OFF_MOD);
  bf16_t* h = (bf16_t*)(p.ws + OFF_H);
  for (int row = gw; row < NTOK; row += tw) {
    const float* src = WHICH == 0 ? xrow(p, row) : p.out + (size_t)row * D;
    float4 v[4];
    float ss = 0.f;
#pragma unroll
    for (int i = 0; i < 4; ++i) {
      v[i] = ((const float4*)src)[lane + 64 * i];
      ss += v[i].x * v[i].x + v[i].y * v[i].y + v[i].z * v[i].z + v[i].w * v[i].w;
    }
    ss = wave_sum(ss);
    const float r = rsqrtf(ss * (1.f / 1024.f) + 1e-6f);
    const float* mv = mod + modidx(row) * 6144 + (WHICH == 0 ? 0 : 3 * 1024);
#pragma unroll
    for (int i = 0; i < 4; ++i) {
      const int e = 4 * (lane + 64 * i);
      const float4 g4 = *(const float4*)(g + e), sh = *(const float4*)(mv + e), sc = *(const float4*)(mv + 1024 + e);
      const float y0 = v[i].x * r * g4.x * (1.f + sc.x) + sh.x, y1 = v[i].y * r * g4.y * (1.f + sc.y) + sh.y;
      const float y2 = v[i].z * r * g4.z * (1.f + sc.z) + sh.z, y3 = v[i].w * r * g4.w * (1.f + sc.w) + sh.w;
      *(uint2*)(h + (size_t)row * D + e) = make_uint2(pack2(y0, y1), pack2(y2, y3));
    }
  }
}

struct EpiIn {
  float* proj; bf16_t* hyT;
  __device__ __forceinline__ void operator()(int row0, int col, const f32x4& v) const {
    if (col < 672) {
#pragma unroll
      for (int j = 0; j < 4; ++j) proj[(size_t)(row0 + j) * 672 + col] = v[j];
    } else if (col < DIN) {
      *(uint2*)(hyT + (size_t)(col - 672) * NTOK + row0) = make_uint2(pack2(v[0], v[1]), pack2(v[2], v[3]));
    }
  }
};
struct EpiQ {
  bf16_t* q;
  __device__ __forceinline__ void operator()(int row, int col0, const f32x4& v) const {
    *(uint2*)(q + (size_t)row * 768 + col0) = make_uint2(pack2(v[0], v[1]), pack2(v[2], v[3]));
  }
};
struct EpiKV {
  bf16_t *kraw, *vtc, *vtl;
  __device__ __forceinline__ void operator()(int row0, int col, const f32x4& v) const {
    const int head = col >> 7, cc = col & 127;
    if (cc < 64) {
#pragma unroll
      for (int j = 0; j < 4; ++j) kraw[(size_t)(row0 + j) * 512 + head * 64 + cc] = f2bf(v[j]);
    } else {
      const int dv = cc - 64;
      bf16_t* dst;
      if (row0 < NCTX) dst = vtc + ((size_t)((row0 >> 8) * 8 + head) * 64 + dv) * 256 + (row0 & 255);
      else if (row0 < NTOK) { const int r = row0 - NCTX; dst = vtl + ((size_t)((r >> 12) * 8 + head) * 64 + dv) * 4608 + (r & 4095); }
      else { const int r = row0 - NTOK; dst = vtl + ((size_t)((r >> 9) * 8 + head) * 64 + dv) * 4608 + 4096 + (r & 511); }
      *(uint2*)dst = make_uint2(pack2(v[0], v[1]), pack2(v[2], v[3]));
    }
  }
};
struct EpiOut {
  const Params* p;
  __device__ __forceinline__ void operator()(int row, int col0, const f32x4& v) const {
    const float4 x = *(const float4*)(xrow(*p, row) + col0);
    const float4 m = *(const float4*)((const float*)(p->ws + OFF_MOD) + modidx(row) * 6144 + 2 * 1024 + col0);
    *(float4*)(p->out + (size_t)row * D + col0) = make_float4(x.x + m.x * v[0], x.y + m.y * v[1], x.z + m.z * v[2], x.w + m.w * v[3]);
  }
};
struct EpiU {
  bf16_t* u;
  __device__ __forceinline__ void operator()(int row, int col0, const f32x4& v) const {
    *(uint2*)(u + (size_t)row * 5632 + col0) = make_uint2(pack2(v[0], v[1]), pack2(v[2], v[3]));
  }
};
struct EpiY {
  const Params* p; int half;
  __device__ __forceinline__ void operator()(int row, int col0, const f32x4& v) const {
    const int grow = half * 8192 + row;
    float4* dst = (float4*)(p->out + (size_t)grow * D + col0);
    const float4 x = *dst;
    const float4 m = *(const float4*)((const float*)(p->ws + OFF_MOD) + modidx(grow) * 6144 + 5 * 1024 + col0);
    *dst = make_float4(x.x + m.x * v[0], x.y + m.y * v[1], x.z + m.z * v[2], x.w + m.w * v[3]);
  }
};

__device__ void token_item(const Params& p, int item) {
  const int lane = threadIdx.x & 63, wid = threadIdx.x >> 6;
  const float* proj = (const float*)(p.ws + OFF_PROJ);
  bf16_t* qa = (bf16_t*)(p.ws + OFF_QA);
  bf16_t* ckvn = (bf16_t*)(p.ws + OFF_CKVN);
  float* kpe = (float*)(p.ws + OFF_KPE);
  for (int tt = 0; tt < 16; ++tt) {
    const int token = item * 64 + wid * 16 + tt;
    const float* pr = proj + (size_t)token * 672;
    float2 q[3];
    float ss = 0.f;
#pragma unroll
    for (int i = 0; i < 3; ++i) { q[i] = *(const float2*)(pr + lane * 2 + 128 * i); ss += q[i].x * q[i].x + q[i].y * q[i].y; }
    ss = wave_sum(ss);
    const float r = rsqrtf(ss * (1.f / 384.f) + 1e-6f);
#pragma unroll
    for (int i = 0; i < 3; ++i) {
      const int e = lane * 2 + 128 * i;
      *(unsigned*)(qa + (size_t)token * 384 + e) = pack2(q[i].x * r * p.g_qa[e], q[i].y * r * p.g_qa[e + 1]);
    }
    const float4 kv = *(const float4*)(pr + 384 + lane * 4);
    float s2 = wave_sum(kv.x * kv.x + kv.y * kv.y + kv.z * kv.z + kv.w * kv.w);
    const float r2 = rsqrtf(s2 * (1.f / 256.f) + 1e-6f);
    const float4 g = *(const float4*)(p.g_kva + lane * 4);
    const float4 y = make_float4(kv.x * r2 * g.x, kv.y * r2 * g.y, kv.z * r2 * g.z, kv.w * r2 * g.w);
    *(uint2*)(ckvn + (size_t)token * 256 + lane * 4) = make_uint2(pack2(y.x, y.y), pack2(y.z, y.w));
    if (token < NCTX) *(float4*)(p.out + OUT_CKV + (size_t)token * 256 + lane * 4) = y;
    if (lane < 32) {
      const float kp = pr[640 + lane];
      kpe[(size_t)token * 32 + lane] = kp;
      if (token < NCTX) p.out[OUT_KPE + (size_t)token * 32 + lane] = kp;
    }
  }
}

template <int ORDER>
__device__ void hyena_item(const Params& p, int grp, int c, char* smem) {
  const int tid = threadIdx.x, lane = tid & 63, wid = tid >> 6, fr = lane & 15, fq = lane >> 4;
  const int n = grp ? SEQL : SEQC, nb = n >> 6, L = n;
  const bf16_t* Rrow = (const bf16_t*)(p.ws + (grp ? OFF_RLAT : OFF_RCTX)) + (size_t)(ORDER * 512 + c) * (2 * n);
  const bf16_t* hyT = (const bf16_t*)(p.ws + OFF_HYT);
  bf16_t* sU = (bf16_t*)smem;
  unsigned* sR0 = (unsigned*)(smem + 18432);
  unsigned* sR1 = (unsigned*)(smem + 18432 + 16384);
  const int tok0 = grp * 8192;
  __syncthreads();
  for (int ch = tid; ch < (2 * n) / 8; ch += 256) *(uint4*)((bf16_t*)sR0 + ch * 8) = *(const uint4*)(Rrow + ch * 8);
  if (ORDER == 0) {
    const bf16_t* raw = hyT + (size_t)c * NTOK + tok0;
    const float w0 = p.hy_conv_w[c], w1 = p.hy_conv_w[1536 + c], w2 = p.hy_conv_w[3072 + c], b = p.hy_conv_b[c];
    for (int ch = tid; ch < 1024; ch += 256) {
      const int t = ch * 8, pos = t & (L - 1);
      const uint4 rv = *(const uint4*)(raw + t);
      float x[10];
      x[0] = pos == 0 ? 0.f : bf2f(raw[t - 1]);
      x[1] = bflo(rv.x); x[2] = bfhi(rv.x); x[3] = bflo(rv.y); x[4] = bfhi(rv.y);
      x[5] = bflo(rv.z); x[6] = bfhi(rv.z); x[7] = bflo(rv.w); x[8] = bfhi(rv.w);
      x[9] = (pos + 8 == L) ? 0.f : bf2f(raw[t + 8]);
      float u[8];
#pragma unroll
      for (int i = 0; i < 8; ++i) u[i] = w0 * x[i] + w1 * x[i + 1] + w2 * x[i + 2] + b;
      *(uint4*)(sU + (ch >> 3) * 72 + (ch & 7) * 8) = make_uint4(pack2(u[0], u[1]), pack2(u[2], u[3]), pack2(u[4], u[5]), pack2(u[6], u[7]));
    }
  } else {
    const bf16_t* zr = (const bf16_t*)(p.ws + OFF_ZT) + (size_t)c * NTOK + tok0;
    for (int ch = tid; ch < 1024; ch += 256) *(uint4*)(sU + (ch >> 3) * 72 + (ch & 7) * 8) = *(const uint4*)(zr + ch * 8);
  }
  __syncthreads();
  for (int k = tid; k < n; k += 256) {
    const unsigned a = sR0[k], b2 = (k + 1 < n) ? sR0[k + 1] : 0u;
    sR1[k] = (a >> 16) | (b2 << 16);
  }
  __syncthreads();

  f32x4 acc[4][2];
#pragma unroll
  for (int m = 0; m < 4; ++m) { acc[m][0] = (f32x4){0.f, 0.f, 0.f, 0.f}; acc[m][1] = (f32x4){0.f, 0.f, 0.f, 0.f}; }
  const unsigned* abase = (fr & 1) ? (sR0 + ((n - 1 - fr) >> 1) + 4 * fq) : (sR1 + ((n - 2 - fr) >> 1) + 4 * fq);
  const int col0 = 32 * wid + fr, col1 = col0 + 16;
  const int i0 = col0 & (nb - 1), i1 = col1 & (nb - 1);
  for (int d = -(nb - 1); d <= nb - 1; ++d) {
    const bool v0 = (unsigned)(i0 - d) < (unsigned)nb, v1 = (unsigned)(i1 - d) < (unsigned)nb;
    const bool any0 = __ballot(v0) != 0ull, any1 = __ballot(v1) != 0ull;
    if (!any0 && !any1) continue;
    bf16x8 F[6];
    const unsigned* ap = abase - 32 * d + 16;
#pragma unroll
    for (int idx = 0; idx < 6; ++idx) {
      const unsigned* q = ap - 8 * idx;
      union { unsigned u[4]; bf16x8 v; } cv;
      cv.u[0] = q[0]; cv.u[1] = q[1]; cv.u[2] = q[2]; cv.u[3] = q[3];
      F[idx] = cv.v;
    }
#pragma unroll
    for (int nt = 0; nt < 2; ++nt) {
      if (!(nt ? any1 : any0)) continue;
      const bool vv = nt ? v1 : v0;
      const bf16_t* up = sU + ((nt ? col1 : col0) - d) * 72 + fq * 8;
#pragma unroll
      for (int ks = 0; ks < 2; ++ks) {
        bf16x8 bf = (bf16x8){0, 0, 0, 0, 0, 0, 0, 0};
        if (vv) bf = *(const bf16x8*)(up + ks * 32);
#pragma unroll
        for (int m = 0; m < 4; ++m)
          acc[m][nt] = __builtin_amdgcn_mfma_f32_16x16x32_bf16(F[m + 2 - 2 * ks], bf, acc[m][nt], 0, 0, 0);
      }
    }
  }
  const float skip = p.filt_bias[ORDER * 512 + c];
  const int gcol = (ORDER == 0 ? 512 : 1024) + c;
  const bf16_t* graw = hyT + (size_t)gcol * NTOK + tok0;
  const float w0 = p.hy_conv_w[gcol], w1 = p.hy_conv_w[1536 + gcol], w2 = p.hy_conv_w[3072 + gcol], b = p.hy_conv_b[gcol];
  bf16_t* outT = (bf16_t*)(p.ws + (ORDER == 0 ? OFF_ZT : OFF_Y2T)) + (size_t)c * NTOK + tok0;
#pragma unroll
  for (int nt = 0; nt < 2; ++nt) {
    const int col = nt ? col1 : col0;
#pragma unroll
    for (int m = 0; m < 4; ++m) {
      const int t = col * 64 + 16 * m + 4 * fq, pos = t & (L - 1);
      const uint2 uu = *(const uint2*)(sU + col * 72 + 16 * m + 4 * fq);
      const uint2 gv = *(const uint2*)(graw + t);
      float x[6];
      x[0] = pos == 0 ? 0.f : bf2f(graw[t - 1]);
      x[1] = bflo(gv.x); x[2] = bfhi(gv.x); x[3] = bflo(gv.y); x[4] = bfhi(gv.y);
      x[5] = (pos + 4 == L) ? 0.f : bf2f(graw[t + 4]);
      const float u4[4] = {bflo(uu.x), bfhi(uu.x), bflo(uu.y), bfhi(uu.y)};
      float o[4];
#pragma unroll
      for (int j = 0; j < 4; ++j) {
        const float gate = w0 * x[j] + w1 * x[j + 1] + w2 * x[j + 2] + b;
        o[j] = gate * (acc[m][nt][j] + skip * u4[j]);
      }
      *(uint2*)(outT + t) = make_uint2(pack2(o[0], o[1]), pack2(o[2], o[3]));
    }
  }
}

__device__ __forceinline__ void rope32(float* y  , int pos) {
  const float prow = (float)(pos >> 6), pcol = (float)(pos & 63);
  const float fr[8] = {1.f, 0.31622776601683794f, 0.1f, 0.031622776601683794f, 0.01f, 0.0031622776601683794f, 0.001f, 0.00031622776601683794f};
#pragma unroll
  for (int i = 0; i < 8; ++i) {
    const float tr = prow * fr[i] * 0.15915494309189535f, tc = pcol * fr[i] * 0.15915494309189535f;
    const float sr = sin_turns(tr), cr = cos_turns(tr), sc = sin_turns(tc), cc = cos_turns(tc);
    const float a = y[i], b = y[8 + i], c2 = y[16 + i], d2 = y[24 + i];
    y[i] = a * cr - b * sr; y[8 + i] = b * cr + a * sr;
    y[16 + i] = c2 * cc - d2 * sc; y[24 + i] = d2 * cc + c2 * sc;
  }
}
__device__ __forceinline__ void unpack8(const uint4& v, float* x) {
  x[0] = bflo(v.x); x[1] = bfhi(v.x); x[2] = bflo(v.y); x[3] = bfhi(v.y);
  x[4] = bflo(v.z); x[5] = bfhi(v.z); x[6] = bflo(v.w); x[7] = bfhi(v.w);
}
__device__ __forceinline__ float sumsq8(const uint4& v) {
  float x[8];
  unpack8(v, x);
  return x[0] * x[0] + x[1] * x[1] + x[2] * x[2] + x[3] * x[3] + x[4] * x[4] + x[5] * x[5] + x[6] * x[6] + x[7] * x[7];
}
__device__ __forceinline__ uint4 scale8(const uint4& v, float r, const float* __restrict__ g) {
  float x[8];
  unpack8(v, x);
  const float4 g0 = *(const float4*)g, g1 = *(const float4*)(g + 4);
  return make_uint4(pack2(x[0] * r * g0.x, x[1] * r * g0.y), pack2(x[2] * r * g0.z, x[3] * r * g0.w),
                    pack2(x[4] * r * g1.x, x[5] * r * g1.y), pack2(x[6] * r * g1.z, x[7] * r * g1.w));
}
__device__ void qk_item(const Params& p, int item) {
  const int tid = threadIdx.x;
  if (item < 512) {
    const int idx = item * 256 + tid, row = idx >> 3, h = idx & 7;
    const bf16_t* src = (const bf16_t*)(p.ws + OFF_QRAW) + (size_t)row * 768 + h * 96;
    bf16_t* dst = (bf16_t*)(p.ws + OFF_Q) + (size_t)row * 768 + h * 96;
    uint4 raw[12];
#pragma unroll
    for (int i = 0; i < 12; ++i) raw[i] = *(const uint4*)(src + 8 * i);
    float ss = 0.f;
#pragma unroll
    for (int i = 0; i < 12; ++i) ss += sumsq8(raw[i]);
    const float r = rsqrtf(ss * (1.f / 96.f) + 1e-6f);
    const float qs = 0.10206207261596575f * 1.4426950408889634f;
#pragma unroll
    for (int i = 0; i < 8; ++i) *(uint4*)(dst + 8 * i) = scale8(raw[i], r * qs, p.g_q + 8 * i);
    float y[32];
#pragma unroll
    for (int i = 0; i < 4; ++i) unpack8(raw[8 + i], y + 8 * i);
#pragma unroll
    for (int i = 0; i < 32; ++i) y[i] = y[i] * r * p.g_q[64 + i];
    if (row >= NCTX) rope32(y, (row - NCTX) & 4095);
#pragma unroll
    for (int i = 0; i < 4; ++i)
      *(uint4*)(dst + 64 + 8 * i) = make_uint4(pack2(y[8 * i] * qs, y[8 * i + 1] * qs), pack2(y[8 * i + 2] * qs, y[8 * i + 3] * qs),
                                               pack2(y[8 * i + 4] * qs, y[8 * i + 5] * qs), pack2(y[8 * i + 6] * qs, y[8 * i + 7] * qs));
  } else {
    const int idx = (item - 512) * 256 + tid, row = idx >> 3, h = idx & 7;
    const bf16_t* src = (const bf16_t*)(p.ws + OFF_KRAW) + (size_t)row * 512 + h * 64;
    uint4 raw[8];
#pragma unroll
    for (int i = 0; i < 8; ++i) raw[i] = *(const uint4*)(src + 8 * i);
    const float* kp = row < NTOK ? (const float*)(p.ws + OFF_KPE) + (size_t)row * 32 : p.cache_kpe + (size_t)(row - NTOK) * 32;
    float y[32];
#pragma unroll
    for (int i = 0; i < 8; ++i) {
      const float4 v = *(const float4*)(kp + 4 * i);
      y[4 * i] = v.x; y[4 * i + 1] = v.y; y[4 * i + 2] = v.z; y[4 * i + 3] = v.w;
    }
    float ss = 0.f;
#pragma unroll
    for (int i = 0; i < 8; ++i) ss += sumsq8(raw[i]);
#pragma unroll
    for (int i = 0; i < 32; ++i) ss += y[i] * y[i];
    const float r = rsqrtf(ss * (1.f / 96.f) + 1e-6f);
#pragma unroll
    for (int i = 0; i < 32; ++i) y[i] = y[i] * r * p.g_k[64 + i];
    bf16_t* dst;
    if (row < NCTX) dst = (bf16_t*)(p.ws + OFF_KC) + ((size_t)((row >> 8) * 8 + h) * 256 + (row & 255)) * 96;
    else if (row < NTOK) {
      const int rr = row - NCTX;
      rope32(y, rr & 4095);
      dst = (bf16_t*)(p.ws + OFF_KL) + ((size_t)((rr >> 12) * 8 + h) * 4608 + (rr & 4095)) * 96;
    } else {
      const int rr = row - NTOK;
      dst = (bf16_t*)(p.ws + OFF_KL) + ((size_t)((rr >> 9) * 8 + h) * 4608 + 4096 + (rr & 511)) * 96;
    }
#pragma unroll
    for (int i = 0; i < 8; ++i) *(uint4*)(dst + 8 * i) = scale8(raw[i], r, p.g_k + 8 * i);
#pragma unroll
    for (int i = 0; i < 4; ++i)
      *(uint4*)(dst + 64 + 8 * i) = make_uint4(pack2(y[8 * i], y[8 * i + 1]), pack2(y[8 * i + 2], y[8 * i + 3]),
                                               pack2(y[8 * i + 4], y[8 * i + 5]), pack2(y[8 * i + 6], y[8 * i + 7]));
  }
}

__device__ void attn_item(const Params& p, int item, char* smem) {
  const int tid = threadIdx.x, lane = tid & 63, wid = tid >> 6, lr = lane & 31, lh = lane >> 5;
  int nkeys, h, tokbase; const bf16_t *Kp, *Vp;
  if (item < 512) {
    const int b = item >> 8, rem = item & 255; h = rem >> 5; const int qb = rem & 31;
    nkeys = 4608; tokbase = NCTX + b * 4096 + qb * 128;
    Kp = (const bf16_t*)(p.ws + OFF_KL) + (size_t)(b * 8 + h) * 4608 * 96;
    Vp = (const bf16_t*)(p.ws + OFF_VTL) + (size_t)(b * 8 + h) * 64 * 4608;
  } else {
    const int it = item - 512, b = it >> 4; h = (it & 15) >> 1; const int qb = it & 1;
    nkeys = 256; tokbase = b * 256 + qb * 128;
    Kp = (const bf16_t*)(p.ws + OFF_KC) + (size_t)(b * 8 + h) * 256 * 96;
    Vp = (const bf16_t*)(p.ws + OFF_VTC) + (size_t)(b * 8 + h) * 64 * 256;
  }
  bf16_t* sK = (bf16_t*)smem;
  bf16_t* sV = sK + 64 * 104;
  const int token = tokbase + 32 * wid + lr;
  const bf16_t* qsrc = (const bf16_t*)(p.ws + OFF_Q) + (size_t)token * 768 + h * 96 + 8 * lh;
  bf16x8 qf[6];
#pragma unroll
  for (int ks = 0; ks < 6; ++ks) qf[ks] = *(const bf16x8*)(qsrc + 16 * ks);
  f32x16 oacc[2];
#pragma unroll
  for (int j = 0; j < 16; ++j) { oacc[0][j] = 0.f; oacc[1][j] = 0.f; }
  float mrun = -1e30f, lsum = 0.f;
  const int kk0 = tid / 12, kc0 = tid % 12, kk1 = (tid + 256) / 12, kc1 = (tid + 256) % 12, kk2 = (tid + 512) / 12, kc2 = (tid + 512) % 12;
  const int vd0 = tid >> 3, vc0 = tid & 7, vd1 = vd0 + 32;
  const bf16_t* gk0 = Kp + (size_t)kk0 * 96 + kc0 * 8;
  const bf16_t* gk1 = Kp + (size_t)kk1 * 96 + kc1 * 8;
  const bf16_t* gk2 = Kp + (size_t)kk2 * 96 + kc2 * 8;
  const bf16_t* gv0 = Vp + (size_t)vd0 * nkeys + vc0 * 8;
  const bf16_t* gv1 = Vp + (size_t)vd1 * nkeys + vc0 * 8;
  uint4 rk0 = *(const uint4*)gk0, rk1 = *(const uint4*)gk1, rk2 = *(const uint4*)gk2;
  uint4 rv0 = *(const uint4*)gv0, rv1 = *(const uint4*)gv1;
  const int nt = nkeys >> 6;
  for (int kt = 0; kt < nt; ++kt) {
    __syncthreads();
    *(uint4*)(sK + kk0 * 104 + kc0 * 8) = rk0; *(uint4*)(sK + kk1 * 104 + kc1 * 8) = rk1; *(uint4*)(sK + kk2 * 104 + kc2 * 8) = rk2;
    *(uint4*)(sV + vd0 * 72 + vc0 * 8) = rv0; *(uint4*)(sV + vd1 * 72 + vc0 * 8) = rv1;
    __syncthreads();
    if (kt + 1 < nt) {
      gk0 += 64 * 96; gk1 += 64 * 96; gk2 += 64 * 96; gv0 += 64; gv1 += 64;
      rk0 = *(const uint4*)gk0; rk1 = *(const uint4*)gk1; rk2 = *(const uint4*)gk2;
      rv0 = *(const uint4*)gv0; rv1 = *(const uint4*)gv1;
    }
    f32x16 sacc[2];
#pragma unroll
    for (int kb = 0; kb < 2; ++kb) {
#pragma unroll
      for (int j = 0; j < 16; ++j) sacc[kb][j] = 0.f;
#pragma unroll
      for (int ks = 0; ks < 6; ++ks) {
        const bf16x8 a = *(const bf16x8*)(sK + (32 * kb + lr) * 104 + 16 * ks + 8 * lh);
        sacc[kb] = __builtin_amdgcn_mfma_f32_32x32x16_bf16(a, qf[ks], sacc[kb], 0, 0, 0);
      }
    }
    float mx = sacc[0][0];
#pragma unroll
    for (int j = 1; j < 16; ++j) mx = fmaxf(mx, sacc[0][j]);
#pragma unroll
    for (int j = 0; j < 16; ++j) mx = fmaxf(mx, sacc[1][j]);
    mx = fmaxf(mx, __shfl_xor(mx, 32));
    const float mnew = fmaxf(mrun, mx);
    const float alpha = __builtin_amdgcn_exp2f(mrun - mnew);
    mrun = mnew;
    float ps = 0.f;
#pragma unroll
    for (int kb = 0; kb < 2; ++kb)
#pragma unroll
      for (int j = 0; j < 16; ++j) { const float e = __builtin_amdgcn_exp2f(sacc[kb][j] - mnew); sacc[kb][j] = e; ps += e; }
    lsum = lsum * alpha + ps;
#pragma unroll
    for (int j = 0; j < 16; ++j) { oacc[0][j] *= alpha; oacc[1][j] *= alpha; }
#pragma unroll
    for (int s = 0; s < 4; ++s) {
      const int kb = s >> 1, jb = 8 * (s & 1);
      union { unsigned u[4]; bf16x8 v; } pf;
      pf.u[0] = pack2(sacc[kb][jb + 0], sacc[kb][jb + 1]); pf.u[1] = pack2(sacc[kb][jb + 2], sacc[kb][jb + 3]);
      pf.u[2] = pack2(sacc[kb][jb + 4], sacc[kb][jb + 5]); pf.u[3] = pack2(sacc[kb][jb + 6], sacc[kb][jb + 7]);
#pragma unroll
      for (int mt = 0; mt < 2; ++mt) {
        const bf16_t* vp = sV + (32 * mt + lr) * 72 + 16 * s + 4 * lh;
        union { uint2 d[2]; bf16x8 v; } av;
        av.d[0] = *(const uint2*)vp;
        av.d[1] = *(const uint2*)(vp + 8);
        oacc[mt] = __builtin_amdgcn_mfma_f32_32x32x16_bf16(av.v, pf.v, oacc[mt], 0, 0, 0);
      }
    }
  }
  lsum += __shfl_xor(lsum, 32);
  const float inv = 1.f / lsum;
  bf16_t* dst = (bf16_t*)(p.ws + OFF_ATTN) + (size_t)token * 512 + h * 64;
#pragma unroll
  for (int mt = 0; mt < 2; ++mt)
#pragma unroll
    for (int jg = 0; jg < 4; ++jg) {
      const int dv0 = 32 * mt + 8 * jg + 4 * lh;
      *(uint2*)(dst + dv0) = make_uint2(pack2(oacc[mt][4 * jg] * inv, oacc[mt][4 * jg + 1] * inv),
                                        pack2(oacc[mt][4 * jg + 2] * inv, oacc[mt][4 * jg + 3] * inv));
    }
}

__device__ void merge_item(const Params& p, int item, char* smem) {
  const int tid = threadIdx.x, lane = tid & 63, wid = tid >> 6, t0 = item * 32;
  bf16_t* mix = (bf16_t*)(p.ws + OFF_H);
  const bf16_t* attn = (const bf16_t*)(p.ws + OFF_ATTN);
  for (int tt = 0; tt < 8; ++tt) {
    const int token = t0 + wid * 8 + tt;
    float x[8];
    unpack8(*(const uint4*)(attn + (size_t)token * 512 + lane * 8), x);
    float ss = 0.f;
#pragma unroll
    for (int i = 0; i < 8; ++i) ss += x[i] * x[i];
    ss = wave_sum(ss);
    const float r = rsqrtf(ss * (1.f / 512.f) + 1e-6f);
    const float4 g0 = *(const float4*)(p.g_out_att + lane * 8), g1 = *(const float4*)(p.g_out_att + lane * 8 + 4);
    *(uint4*)(mix + (size_t)token * D + lane * 8) =
        make_uint4(pack2(x[0] * r * g0.x, x[1] * r * g0.y), pack2(x[2] * r * g0.z, x[3] * r * g0.w),
                   pack2(x[4] * r * g1.x, x[5] * r * g1.y), pack2(x[6] * r * g1.z, x[7] * r * g1.w));
  }
  bf16_t* sT = (bf16_t*)smem;
  const bf16_t* y2T = (const bf16_t*)(p.ws + OFF_Y2T);
  __syncthreads();
  for (int ch = tid; ch < 2048; ch += 256) {
    const int c = ch >> 2, q4 = ch & 3;
    const uint4 v = *(const uint4*)(y2T + (size_t)c * NTOK + t0 + q4 * 8);
    bf16_t* d = sT + (q4 * 8) * 520 + c;
    d[0 * 520] = (bf16_t)(v.x & 0xffff); d[1 * 520] = (bf16_t)(v.x >> 16);
    d[2 * 520] = (bf16_t)(v.y & 0xffff); d[3 * 520] = (bf16_t)(v.y >> 16);
    d[4 * 520] = (bf16_t)(v.z & 0xffff); d[5 * 520] = (bf16_t)(v.z >> 16);
    d[6 * 520] = (bf16_t)(v.w & 0xffff); d[7 * 520] = (bf16_t)(v.w >> 16);
  }
  __syncthreads();
  {
    const int tt = tid >> 3, part = tid & 7;
    uint4 v[8];
    float ss = 0.f;
#pragma unroll
    for (int i = 0; i < 8; ++i) {
      v[i] = *(const uint4*)(sT + tt * 520 + part * 64 + 8 * i);
      float x[8];
      unpack8(v[i], x);
#pragma unroll
      for (int e = 0; e < 8; ++e) ss += x[e] * x[e];
    }
    ss += __shfl_xor(ss, 1); ss += __shfl_xor(ss, 2); ss += __shfl_xor(ss, 4);
    const float r = rsqrtf(ss * (1.f / 512.f) + 1e-6f);
#pragma unroll
    for (int i = 0; i < 8; ++i) {
      float x[8];
      unpack8(v[i], x);
      const int c0 = part * 64 + 8 * i;
      const float4 g0 = *(const float4*)(p.g_out_hy + c0), g1 = *(const float4*)(p.g_out_hy + c0 + 4);
      *(uint4*)(mix + (size_t)(t0 + tt) * D + 512 + c0) =
          make_uint4(pack2(x[0] * r * g0.x, x[1] * r * g0.y), pack2(x[2] * r * g0.z, x[3] * r * g0.w),
                     pack2(x[4] * r * g1.x, x[5] * r * g1.y), pack2(x[6] * r * g1.z, x[7] * r * g1.w));
    }
  }
}

__device__ void act_item(const Params& p, int item, int half) {
  const int idx = item * 256 + threadIdx.x;
  if (idx >= 1024 * 352) return;
  const int j = (idx % 352) * 8, r0 = (idx / 352) * 8;
  const int L = half ? SEQL : SEQC;
  const bf16_t* u = (const bf16_t*)(p.ws + OFF_U);
  bf16_t* act = (bf16_t*)(p.ws + OFF_ACT);
  float wa[3][8], wg[3][8], ba[8], bg[8];
#pragma unroll
  for (int t = 0; t < 3; ++t)
#pragma unroll
    for (int e = 0; e < 8; ++e) { wa[t][e] = p.ffn_conv_w[t * 5632 + j + e]; wg[t][e] = p.ffn_conv_w[t * 5632 + 2816 + j + e]; }
#pragma unroll
  for (int e = 0; e < 8; ++e) { ba[e] = p.ffn_conv_b[j + e]; bg[e] = p.ffn_conv_b[2816 + j + e]; }
  float pa[8], pg[8], ca[8], cg_[8], na[8], ng[8];
  if ((r0 & (L - 1)) == 0) {
#pragma unroll
    for (int e = 0; e < 8; ++e) { pa[e] = 0.f; pg[e] = 0.f; }
  } else {
    unpack8(*(const uint4*)(u + (size_t)(r0 - 1) * 5632 + j), pa);
    unpack8(*(const uint4*)(u + (size_t)(r0 - 1) * 5632 + 2816 + j), pg);
  }
  unpack8(*(const uint4*)(u + (size_t)r0 * 5632 + j), ca);
  unpack8(*(const uint4*)(u + (size_t)r0 * 5632 + 2816 + j), cg_);
#pragma unroll
  for (int i = 0; i < 8; ++i) {
    const int r = r0 + i;
    if (((r + 1) & (L - 1)) == 0) {
#pragma unroll
      for (int e = 0; e < 8; ++e) { na[e] = 0.f; ng[e] = 0.f; }
    } else {
      unpack8(*(const uint4*)(u + (size_t)(r + 1) * 5632 + j), na);
      unpack8(*(const uint4*)(u + (size_t)(r + 1) * 5632 + 2816 + j), ng);
    }
    float o[8];
#pragma unroll
    for (int e = 0; e < 8; ++e) {
      const float a = wa[0][e] * pa[e] + wa[1][e] * ca[e] + wa[2][e] * na[e] + ba[e];
      const float g = wg[0][e] * pg[e] + wg[1][e] * cg_[e] + wg[2][e] * ng[e] + bg[e];
      o[e] = a / (1.f + __expf(-a)) * g;
    }
    *(uint4*)(act + (size_t)r * 2816 + j) = make_uint4(pack2(o[0], o[1]), pack2(o[2], o[3]), pack2(o[4], o[5]), pack2(o[6], o[7]));
#pragma unroll
    for (int e = 0; e < 8; ++e) { pa[e] = ca[e]; pg[e] = cg_[e]; ca[e] = na[e]; cg_[e] = ng[e]; }
  }
}


#define XB_TMO      128
#define XB_XCNT(j)  (256  + 64 * (j))
#define XB_XSUB(j)  (1280 + 64 * (j))
#define XB_XGEN(j)  (2304 + 64 * (j))
#define XB_TOP      3328
#define XB_TOPGEN   3392
#define XCD_BAR_WORDS 3456
#define XB_SPIN_CAP (1u << 20)
#define LAS __attribute__((address_space(3)))
__device__ __forceinline__ unsigned xb_ld(unsigned* p) { return __hip_atomic_load(p, __ATOMIC_RELAXED, __HIP_MEMORY_SCOPE_AGENT); }
__device__ __forceinline__ unsigned xb_add(unsigned* p, unsigned v) { return __hip_atomic_fetch_add(p, v, __ATOMIC_RELAXED, __HIP_MEMORY_SCOPE_AGENT); }
__device__ __forceinline__ unsigned xb_xcc_id() { return (unsigned)__builtin_amdgcn_s_getreg((3 << 11) | 20) & 0xFu; }
#define XB_SPIN(cond, bar) do { unsigned _sp = 0; while (cond) { __builtin_amdgcn_s_sleep(1); \
    if ((++_sp & 255u) == 0u) { if (xb_ld(&(bar)[XB_TMO])) break; if (_sp > XB_SPIN_CAP) { atomicAdd(&(bar)[XB_TMO], 1u); break; } } } } while (0)
struct XcdBarrier { unsigned* bar; unsigned x; volatile LAS unsigned* st; };
__device__ __forceinline__ XcdBarrier xcd_barrier_post(unsigned* bar, volatile LAS unsigned* st) {
  XcdBarrier b; b.bar = bar; b.x = xb_xcc_id(); b.st = st;
  if (threadIdx.x == 0) (void)xb_add(&bar[XB_XCNT(b.x)], 1u);
  return b;
}
__device__ __forceinline__ void xcd_barrier_complete(unsigned* bar, unsigned x, unsigned& nloc, unsigned& nx) {
  const unsigned G = gridDim.x * gridDim.y * gridDim.z;
  unsigned sum, cnt, mine, sp = 0u;
  for (;;) {
    sum = 0u; cnt = 0u; mine = 0u;
#pragma unroll
    for (unsigned j = 0; j < 16; ++j) { const unsigned c = xb_ld(&bar[XB_XCNT(j)]); sum += c; cnt += (c > 0u) ? 1u : 0u; mine = (j == x) ? c : mine; }
    if (sum == G) break;
    __builtin_amdgcn_s_sleep(1);
    if ((++sp & 255u) == 0u) { if (xb_ld(&bar[XB_TMO])) break; if (sp > XB_SPIN_CAP) { atomicAdd(&bar[XB_TMO], 1u); break; } }
  }
  nloc = mine > 0u ? mine : 1u; nx = cnt > 0u ? cnt : 1u;
}
__device__ __forceinline__ void xcd_barrier(const XcdBarrier& b) {
  asm volatile("s_waitcnt vmcnt(0)" ::: "memory");
  __syncthreads();
  if (threadIdx.x == 0) {
    unsigned* bar = b.bar;
    __builtin_amdgcn_s_waitcnt(0);
    unsigned nloc = b.st[0], nx = b.st[1];
    if (nloc == 0u) { xcd_barrier_complete(bar, b.x, nloc, nx); b.st[0] = nloc; b.st[1] = nx; }
    const unsigned old = xb_add(&bar[XB_XSUB(b.x)], 1u);
    const unsigned gen = old / nloc;
    if (old + 1u == (gen + 1u) * nloc) {
      __builtin_amdgcn_fence(__ATOMIC_RELEASE, "agent");
      asm volatile("s_waitcnt vmcnt(0)" ::: "memory");
      const unsigned og = xb_add(&bar[XB_TOP], 1u);
      const unsigned tg = og / nx;
      if (og + 1u == (tg + 1u) * nx) xb_add(&bar[XB_TOPGEN], 1u);
      else XB_SPIN(xb_ld(&bar[XB_TOPGEN]) == tg, bar);
      __builtin_amdgcn_fence(__ATOMIC_ACQUIRE, "agent");
      xb_add(&bar[XB_XGEN(b.x)], 1u);
      asm volatile("s_waitcnt vmcnt(0)" ::: "memory");
    } else {
      XB_SPIN(xb_ld(&bar[XB_XGEN(b.x)]) == gen, bar);
      __builtin_amdgcn_fence(__ATOMIC_ACQUIRE, "agent");
      asm volatile("s_waitcnt vmcnt(0)" ::: "memory");
    }
  }
  __syncthreads();
}
constexpr size_t OFF_BAR = 25 * MiB - 16384;
static_assert(OFF_MOD + 3 * 6144 * 4 <= OFF_BAR, "bar");

template <int ph>
__device__ __forceinline__ void run_phase(const Params& p, char* smem) {
  const int bid = blockIdx.x, G = gridDim.x;
  char* ws = p.ws;
  if constexpr (ph == 0) {
    for (int it = bid; it < 272 + 96 + 32 + 3080; it += G) {
      if (it < 272) filter_item(p, it, smem);
      else if (it < 368) mod_item(p, it - 272, smem);
      else if (it < 400) cache_item(p, it - 368);
      else {
        int t = it - 400;
        if (t < 576) transpose_item(p.w_in, 1024, DIN, (bf16_t*)(ws + OFF_WIN), t, 36, smem);
        else if ((t -= 576) < 72) transpose_item(p.w_uq, 384, 768, (bf16_t*)(ws + OFF_WUQ), t, 12, smem);
        else if ((t -= 72) < 64) transpose_item(p.w_ukv, 256, 1024, (bf16_t*)(ws + OFF_WUKV), t, 16, smem);
        else if ((t -= 64) < 256) transpose_item(p.w_out, 1024, 1024, (bf16_t*)(ws + OFF_WOUT), t, 16, smem);
        else if ((t -= 256) < 1408) transpose_item(p.w_up, 1024, 5632, (bf16_t*)(ws + OFF_WUP), t, 88, smem);
        else { t -= 1408; transpose_item(p.w_down, 2816, 1024, (bf16_t*)(ws + OFF_WDOWN), t, 16, smem); }
      }
    }
  } else if constexpr (ph == 1) {
    rmsmod_phase<0>(p);
  } else if constexpr (ph == 2) {
    EpiIn epi{(float*)(ws + OFF_PROJ), (bf16_t*)(ws + OFF_HYT)};
    for (int t = bid; t < 128 * 18; t += G)
      gemm_tile<false>((const bf16_t*)(ws + OFF_H), 1024, (const bf16_t*)(ws + OFF_WIN), 1024, 1024, (t / 18) * 128, (t % 18) * 128, smem, epi);
  } else if constexpr (ph == 3) {
    for (int it = bid; it < 1024 + 256; it += G) {
      if (it < 512) hyena_item<0>(p, 1, it, smem);
      else if (it < 1024) hyena_item<0>(p, 0, it - 512, smem);
      else token_item(p, it - 1024);
    }
  } else if constexpr (ph == 4) {
    EpiQ eq{(bf16_t*)(ws + OFF_QRAW)};
    EpiKV ekv{(bf16_t*)(ws + OFF_KRAW), (bf16_t*)(ws + OFF_VTC), (bf16_t*)(ws + OFF_VTL)};
    for (int it = bid; it < 512 + 768 + 1088 + 512; it += G) {
      if (it < 512) { if (!DBG_NOHY) hyena_item<1>(p, 1, it, smem); }
      else if (it < 1280) { const int t = it - 512; gemm_tile<true>((const bf16_t*)(ws + OFF_QA), 384, (const bf16_t*)(ws + OFF_WUQ), 384, 384, (t / 6) * 128, (t % 6) * 128, smem, eq); }
      else if (it < 2368) { const int t = it - 1280; gemm_tile<false>((const bf16_t*)(ws + OFF_CKVN), 256, (const bf16_t*)(ws + OFF_WUKV), 256, 256, (t / 8) * 128, (t % 8) * 128, smem, ekv); }
      else if (!DBG_NOHY) hyena_item<1>(p, 0, it - 2368, smem);
    }
  } else if constexpr (ph == 5) {
    for (int it = bid; it < 512 + 544; it += G) qk_item(p, it);
  } else if constexpr (ph == 6) {
    for (int it = bid; it < 1024; it += G) attn_item(p, it, smem);
  } else if constexpr (ph == 7) {
    for (int it = bid; it < 512; it += G) merge_item(p, it, smem);
  } else if constexpr (ph == 8) {
    EpiOut epi{&p};
    for (int t = bid; t < 128 * 8; t += G)
      gemm_tile<true>((const bf16_t*)(ws + OFF_H), 1024, (const bf16_t*)(ws + OFF_WOUT), 1024, 1024, (t / 8) * 128, (t % 8) * 128, smem, epi);
  } else if constexpr (ph == 9) {
    rmsmod_phase<1>(p);
  } else if constexpr (ph == 10 || ph == 13) {
    constexpr int half = ph == 10 ? 0 : 1;
    EpiU epi{(bf16_t*)(ws + OFF_U)};
    for (int t = bid; t < 64 * 44; t += G)
      gemm_tile<true>((const bf16_t*)(ws + OFF_H) + (size_t)half * 8192 * 1024, 1024, (const bf16_t*)(ws + OFF_WUP), 1024, 1024, (t / 44) * 128, (t % 44) * 128, smem, epi);
  } else if constexpr (ph == 11 || ph == 14) {
    for (int it = bid; it < 1408; it += G) act_item(p, it, ph == 11 ? 0 : 1);
  } else if constexpr (ph == 12 || ph == 15) {
    EpiY epi{&p, ph == 12 ? 0 : 1};
    for (int t = bid; t < 64 * 8; t += G)
      gemm_tile<true>((const bf16_t*)(ws + OFF_ACT), 2816, (const bf16_t*)(ws + OFF_WDOWN), 2816, 2816, (t / 8) * 128, (t % 8) * 128, smem, epi);
  }
}

#if ONE_LAUNCH
template <int PH>
__device__ __forceinline__ void run_all(const Params& p, char* smem, cg::grid_group& grid, const XcdBarrier& xb) {
  run_phase<PH>(p, smem);
  if constexpr (PH < 15) {
    if constexpr (PH == 0) grid.sync(); else xcd_barrier(xb);
    run_all<PH + 1>(p, smem, grid, xb);
  }
}
__global__ void __launch_bounds__(256, 2) mega_kernel(Params p) {
  __shared__ __attribute__((aligned(16))) char smem[SMEM_BYTES];
  __shared__ uint4 xb_words;
  cg::grid_group grid = cg::this_grid();
  if (threadIdx.x == 0) xb_words = make_uint4(0u, 0u, 0u, 0u);
  __syncthreads();
  XcdBarrier xb = xcd_barrier_post((unsigned*)(p.ws + OFF_BAR), (volatile LAS unsigned*)&xb_words);
  run_all<0>(p, smem, grid, xb);
}
#else
template <int PH>
__global__ void __launch_bounds__(256, 2) phase_kernel(Params p) {
  __shared__ __attribute__((aligned(16))) char smem[SMEM_BYTES];
  run_phase<PH>(p, smem);
}
#ifndef DBG_STOP
#define DBG_STOP 15
#endif
__global__ void dump_kernel(Params p, size_t off, int count) {
  const bf16_t* src = (const bf16_t*)(p.ws + off);
  const bf16_t* src2 = (const bf16_t*)(p.ws + DBG_OFF2);
  for (int i = blockIdx.x * 256 + threadIdx.x; i < 16777216; i += gridDim.x * 256)
    p.out[i] = i < DBG_CNT ? bf2f(src[i]) : (i - DBG_CNT < DBG_CNT2 ? bf2f(src2[i - DBG_CNT]) : 0.f);
}
template <int PH>
static void launch_all(const Params& p, hipStream_t stream) {
  phase_kernel<PH><<<512, 256, 0, stream>>>(p);
  if constexpr (PH < DBG_STOP) launch_all<PH + 1>(p, stream);
}
#endif

extern "C" void kernel_launch(void* const* d_in, const int* in_sizes, int n_in, void* d_out, int out_size, void* d_ws,
                              size_t ws_size, hipStream_t stream) {
  Params p{};
  const float** pp = (const float**)&p;
  for (int i = 0; i < 34; ++i) pp[i] = (const float*)d_in[i];
  p.out = (float*)d_out;
  p.ws = (char*)d_ws;
#if ONE_LAUNCH
  (void)hipMemsetAsync((char*)d_ws + OFF_BAR, 0, XCD_BAR_WORDS * 4, stream);
  static int grid_blocks = 0;
  if (!grid_blocks) {
    int dev = 0, cus = 0, per_cu = 0;
    hipGetDevice(&dev);
    hipDeviceGetAttribute(&cus, hipDeviceAttributeMultiprocessorCount, dev);
    hipOccupancyMaxActiveBlocksPerMultiprocessor(&per_cu, mega_kernel, 256, 0);
    grid_blocks = cus * per_cu;
  }
  void* args[] = {&p};
  hipError_t e = hipLaunchCooperativeKernel((void*)mega_kernel, dim3(grid_blocks), dim3(256), args, 0, stream);
  if (e != hipSuccess) fprintf(stderr, "cooperative launch failed: %s (grid %d)\n", hipGetErrorString(e), grid_blocks);
#else
  launch_all<0>(p, stream);
#if DBG_STOP < 15
  dump_kernel<<<1024, 256, 0, stream>>>(p, DBG_OFF, DBG_CNT);
#endif
#endif
}
```

```cpp
#include <hip/hip_runtime.h>
#include <hip/hip_cooperative_groups.h>
#include <cstdio>
namespace cg = cooperative_groups;

#define DBG_STOP 15
#define DBG_NOHY 0
#ifndef DBL_MASK
#define DBL_MASK 0
#endif
#define DBG_OFF OFF_QRAW
#define DBG_OFF2 OFF_KRAW
#define DBG_CNT 12582912
#define DBG_CNT2 0
#ifndef ONE_LAUNCH
#define ONE_LAUNCH 1
#endif

typedef unsigned short bf16_t;
typedef short bf16x8 __attribute__((ext_vector_type(8)));
typedef float f32x4 __attribute__((ext_vector_type(4)));
typedef float f32x16 __attribute__((ext_vector_type(16)));

constexpr int D = 1024, NTOK = 16384, NCTX = 8192, SEQC = 256, SEQL = 4096;
constexpr int DIN = 2208, DINP = 2304, QL = 384, KVL = 256, DFF = 2816;
constexpr int NROWKV = 17408;
constexpr size_t MiB = 1048576;

constexpr size_t OFF_WIN = 0;
constexpr size_t OFF_WUQ = OFF_WIN + (size_t)DINP * 1024 * 2;
constexpr size_t OFF_WUKV = OFF_WUQ + (size_t)768 * 384 * 2;
constexpr size_t OFF_WOUT = OFF_WUKV + (size_t)1024 * 256 * 2;
constexpr size_t OFF_WUP = OFF_WOUT + (size_t)1024 * 1024 * 2;
constexpr size_t OFF_WDOWN = OFF_WUP + (size_t)5632 * 1024 * 2;
constexpr size_t OFF_MOD = OFF_WDOWN + (size_t)1024 * 2816 * 2;
static_assert(OFF_MOD + 3 * 6144 * 4 <= 25 * MiB, "A region");
constexpr size_t OFF_RLAT = 25 * MiB;
constexpr size_t OFF_RCTX = 41 * MiB;
constexpr size_t OFF_H = 42 * MiB;
constexpr size_t OFF_ZT = 42 * MiB;
constexpr size_t OFF_QA = 58 * MiB;
constexpr size_t OFF_KPE = 70 * MiB;
constexpr size_t OFF_PROJ = 74 * MiB;
constexpr size_t OFF_QRAW = 74 * MiB;
constexpr size_t OFF_Y2T = 98 * MiB;
constexpr size_t OFF_ATTN = 74 * MiB;
constexpr size_t OFF_U = 74 * MiB;
constexpr size_t OFF_HYT = 116 * MiB;
constexpr size_t OFF_Q = 116 * MiB;
constexpr size_t OFF_KC = 140 * MiB;
constexpr size_t OFF_KL = 152 * MiB;
constexpr size_t OFF_CKVN = 164 * MiB;
constexpr size_t OFF_KRAW = 173 * MiB;
constexpr size_t OFF_VTC = 190 * MiB;
constexpr size_t OFF_VTL = 198 * MiB;
constexpr size_t OFF_ACT = 162 * MiB;

constexpr int OUT_YS = 0;
constexpr int OUT_CKV = 16777216;
constexpr int OUT_KPE = 16777216 + 2097152;

constexpr int SMEM_BYTES = 51200;

struct Params {
  const float *x_prompt, *x_sample, *cache_ckv, *cache_kpe, *c, *c_ctx, *w_ada, *b_ada, *g_mix, *w_in, *g_qa, *w_uq,
      *g_kva, *w_ukv, *g_q, *g_k, *hy_conv_w, *hy_conv_b, *filt_w1, *filt_b1, *filt_freq1, *filt_w2, *filt_b2,
      *filt_freq2, *filt_w3, *filt_bias, *g_out_att, *g_out_hy, *w_out, *g_ffn, *w_up, *ffn_conv_w, *ffn_conv_b, *w_down;
  float* out;
  char* ws;
};

typedef __bf16 bf16x2_t __attribute__((ext_vector_type(2)));
__device__ __forceinline__ unsigned pack2(float lo, float hi) {
  bf16x2_t v;
  v[0] = (__bf16)lo;
  v[1] = (__bf16)hi;
  return __builtin_bit_cast(unsigned, v);
}
__device__ __forceinline__ float bflo(unsigned u) { return __uint_as_float(u << 16); }
__device__ __forceinline__ float bfhi(unsigned u) { return __uint_as_float(u & 0xffff0000u); }
__device__ __forceinline__ float bf2f(bf16_t h) { return __uint_as_float(((unsigned)h) << 16); }
__device__ __forceinline__ bf16_t f2bf(float f) { return (bf16_t)(pack2(f, 0.f) & 0xffffu); }
__device__ __forceinline__ float wave_sum(float v) {
#pragma unroll
  for (int o = 32; o >= 1; o >>= 1) v += __shfl_xor(v, o);
  return v;
}
__device__ __forceinline__ int ltid() { int t = threadIdx.x; asm volatile("" : "+v"(t)); return t; }
__device__ __forceinline__ float sin_turns(float t) { t -= floorf(t); return __builtin_amdgcn_sinf(t); }
__device__ __forceinline__ float cos_turns(float t) { t -= floorf(t); return __builtin_amdgcn_cosf(t); }
__device__ __forceinline__ float sin_rad(float x) { return sin_turns(x * 0.15915494309189535f); }
__device__ __forceinline__ const float* xrow(const Params& p, int row) {
  return row < NCTX ? p.x_prompt + (size_t)row * D : p.x_sample + (size_t)(row - NCTX) * D;
}
__device__ __forceinline__ int modidx(int row) { return row < NCTX ? 0 : 1 + ((row - NCTX) >> 12); }

template <bool SWAP, class Epi>
__device__ __forceinline__ void gemm_tile(const bf16_t* __restrict__ A, int lda, const bf16_t* __restrict__ Bt, int ldb,
                                          int K, int m0, int n0, char* smem, const Epi& epi) {
  const int tid = ltid(), lane = tid & 63, wid = tid >> 6, wr = wid >> 1, wc = wid & 1;
  const int fr = lane & 15, fq = lane >> 4;
  bf16_t* sA = (bf16_t*)smem;
  bf16_t* sB = sA + 128 * 72;
  f32x4 acc[4][4];
#pragma unroll
  for (int m = 0; m < 4; ++m)
#pragma unroll
    for (int n = 0; n < 4; ++n) acc[m][n] = (f32x4){0.f, 0.f, 0.f, 0.f};
  const int lr = tid >> 3, lc = (tid & 7) * 8;
  const bf16_t* ga = A + (size_t)(m0 + lr) * lda + lc;
  const bf16_t* gb = Bt + (size_t)(n0 + lr) * ldb + lc;
  const size_t sa32 = (size_t)32 * lda, sb32 = (size_t)32 * ldb;
  uint4 ra0 = *(const uint4*)(ga), ra1 = *(const uint4*)(ga + sa32), ra2 = *(const uint4*)(ga + 2 * sa32), ra3 = *(const uint4*)(ga + 3 * sa32);
  uint4 rb0 = *(const uint4*)(gb), rb1 = *(const uint4*)(gb + sb32), rb2 = *(const uint4*)(gb + 2 * sb32), rb3 = *(const uint4*)(gb + 3 * sb32);
  const int nk = K >> 6;
  bf16_t* wa = sA + lr * 72 + lc;
  bf16_t* wb = sB + lr * 72 + lc;
  for (int kt = 0; kt < nk; ++kt) {
    __syncthreads();
    *(uint4*)(wa) = ra0; *(uint4*)(wa + 32 * 72) = ra1; *(uint4*)(wa + 64 * 72) = ra2; *(uint4*)(wa + 96 * 72) = ra3;
    *(uint4*)(wb) = rb0; *(uint4*)(wb + 32 * 72) = rb1; *(uint4*)(wb + 64 * 72) = rb2; *(uint4*)(wb + 96 * 72) = rb3;
    __syncthreads();
    if (kt + 1 < nk) {
      ga += 64;
      gb += 64;
      ra0 = *(const uint4*)(ga); ra1 = *(const uint4*)(ga + sa32); ra2 = *(const uint4*)(ga + 2 * sa32); ra3 = *(const uint4*)(ga + 3 * sa32);
      rb0 = *(const uint4*)(gb); rb1 = *(const uint4*)(gb + sb32); rb2 = *(const uint4*)(gb + 2 * sb32); rb3 = *(const uint4*)(gb + 3 * sb32);
    }
#pragma unroll
    for (int ks = 0; ks < 2; ++ks) {
      bf16x8 af[4], bfr[4];
#pragma unroll
      for (int m = 0; m < 4; ++m) af[m] = *(const bf16x8*)(sA + (wr * 64 + m * 16 + fr) * 72 + ks * 32 + fq * 8);
#pragma unroll
      for (int n = 0; n < 4; ++n) bfr[n] = *(const bf16x8*)(sB + (wc * 64 + n * 16 + fr) * 72 + ks * 32 + fq * 8);
#pragma unroll
      for (int m = 0; m < 4; ++m)
#pragma unroll
        for (int n = 0; n < 4; ++n) {
          if (SWAP) acc[m][n] = __builtin_amdgcn_mfma_f32_16x16x32_bf16(bfr[n], af[m], acc[m][n], 0, 0, 0);
          else acc[m][n] = __builtin_amdgcn_mfma_f32_16x16x32_bf16(af[m], bfr[n], acc[m][n], 0, 0, 0);
        }
    }
  }
#pragma unroll
  for (int m = 0; m < 4; ++m)
#pragma unroll
    for (int n = 0; n < 4; ++n) {
      if (SWAP) epi(m0 + wr * 64 + m * 16 + fr, n0 + wc * 64 + n * 16 + fq * 4, acc[m][n]);
      else epi(m0 + wr * 64 + m * 16 + fq * 4, n0 + wc * 64 + n * 16 + fr, acc[m][n]);
    }
}

__device__ __forceinline__ void transpose_item(const float* __restrict__ W, int K, int N, bf16_t* __restrict__ WT, int tile, int ntn, char* smem) {
  float* s = (float*)smem;
  const int tk = tile / ntn, tn = tile % ntn, tid = ltid();
  const int k0 = tk * 64, n0 = tn * 64;
  __syncthreads();
  {
    const int r = tid >> 4, c4 = (tid & 15) * 4;
#pragma unroll
    for (int i = 0; i < 4; ++i) {
      const int k = r + 16 * i;
      float4 v = make_float4(0.f, 0.f, 0.f, 0.f);
      if (n0 + c4 < N) v = *(const float4*)(W + (size_t)(k0 + k) * N + n0 + c4);
      s[k * 65 + c4 + 0] = v.x; s[k * 65 + c4 + 1] = v.y; s[k * 65 + c4 + 2] = v.z; s[k * 65 + c4 + 3] = v.w;
    }
  }
  __syncthreads();
  {
    const int n = tid >> 2, kc = (tid & 3) * 16;
    unsigned o[8];
#pragma unroll
    for (int i = 0; i < 8; ++i) o[i] = pack2(s[(kc + 2 * i) * 65 + n], s[(kc + 2 * i + 1) * 65 + n]);
    uint4* dst = (uint4*)(WT + (size_t)(n0 + n) * K + k0 + kc);
    dst[0] = make_uint4(o[0], o[1], o[2], o[3]);
    dst[1] = make_uint4(o[4], o[5], o[6], o[7]);
  }
}

__device__ __forceinline__ void mod_item(const Params& p, int item, char* smem) {
  float* s = (float*)smem;
  float* red = s + 3072;
  const int tid = ltid();
  __syncthreads();
  for (int e = tid; e < 3072; e += 256) {
    const int v = e >> 10, k = e & 1023;
    const float x = (v == 0) ? p.c_ctx[k] : p.c[(v - 1) * D + k];
    s[e] = x / (1.f + __expf(-x));
  }
  __syncthreads();
  const int jl = tid & 63, kq = tid >> 6, j = item * 64 + jl, k0 = kq * 256;
  float a0 = 0.f, a1 = 0.f, a2 = 0.f;
#pragma unroll 8
  for (int k = 0; k < 256; ++k) {
    const float w = p.w_ada[(size_t)(k0 + k) * 6144 + j];
    a0 += s[k0 + k] * w; a1 += s[1024 + k0 + k] * w; a2 += s[2048 + k0 + k] * w;
  }
  red[(kq * 3 + 0) * 64 + jl] = a0; red[(kq * 3 + 1) * 64 + jl] = a1; red[(kq * 3 + 2) * 64 + jl] = a2;
  __syncthreads();
  if (tid < 192) {
    const int v = tid >> 6;
    const float r = red[(0 * 3 + v) * 64 + jl] + red[(1 * 3 + v) * 64 + jl] + red[(2 * 3 + v) * 64 + jl] + red[(3 * 3 + v) * 64 + jl];
    ((float*)(p.ws + OFF_MOD))[v * 6144 + j] = r + p.b_ada[j];
  }
}

__device__ __forceinline__ void filter_item(const Params& p, int item, char* smem) {
  int n, p0; bf16_t* R;
  if (item < 256) { n = 4096; p0 = item * 16; R = (bf16_t*)(p.ws + OFF_RLAT); }
  else { n = 256; p0 = (item - 256) * 16; R = (bf16_t*)(p.ws + OFF_RCTX); }
  const int n2 = 2 * n, tid = ltid();
  float* z = (float*)smem;
  float* h1 = z + 16 * 36;
  float* h2 = h1 + 16 * 64;
  __syncthreads();
#pragma unroll 1
  for (int e = tid; e < 16 * 33; e += 256) {
    const int pp = e / 33, f = e % 33, pos = p0 + pp;
    float val;
    if (f == 0) val = (float)pos / (float)(n - 1);
    else {
      const int k = (f - 1) & 15;
      const float band = 1e-4f + (float)k * ((15.f - 1e-4f) / 15.f);
      const float turns = band * ((float)pos / (float)n);
      val = (f <= 16) ? cos_turns(turns) : -sin_turns(turns);
    }
    z[pp * 36 + f] = val;
  }
  __syncthreads();
#pragma unroll 1
  for (int e = tid; e < 1024; e += 256) {
    const int pp = e >> 6, j = e & 63;
    float a = p.filt_b1[j];
#pragma unroll 3
    for (int f = 0; f < 33; ++f) a += z[pp * 36 + f] * p.filt_w1[f * 64 + j];
    h1[e] = sin_rad(p.filt_freq1[j] * a);
  }
  __syncthreads();
#pragma unroll 1
  for (int e = tid; e < 1024; e += 256) {
    const int pp = e >> 6, j = e & 63;
    float a = p.filt_b2[j];
#pragma unroll 4
    for (int k = 0; k < 64; ++k) a += h1[pp * 64 + k] * p.filt_w2[k * 64 + j];
    h2[j * 16 + pp] = sin_rad(p.filt_freq2[j] * a);
  }
  __syncthreads();
  const float mind = -3.0701134573253946f, maxd = -15.350567286626973f;
#pragma unroll 1
  for (int ci = 0; ci < 8; ++ci) {
    const int col = tid + 256 * ci, o = col >> 10, dir = (col >> 9) & 1, c = col & 511;
    float acc[16];
#pragma unroll
    for (int i = 0; i < 16; ++i) acc[i] = 0.f;
#pragma unroll 4
    for (int k = 0; k < 64; ++k) {
      const float w = p.filt_w3[k * 2048 + col];
      const float4 ha = *(const float4*)(h2 + k * 16), hb = *(const float4*)(h2 + k * 16 + 4), hc = *(const float4*)(h2 + k * 16 + 8), hd = *(const float4*)(h2 + k * 16 + 12);
      acc[0] += ha.x * w; acc[1] += ha.y * w; acc[2] += ha.z * w; acc[3] += ha.w * w;
      acc[4] += hb.x * w; acc[5] += hb.y * w; acc[6] += hb.z * w; acc[7] += hb.w * w;
      acc[8] += hc.x * w; acc[9] += hc.y * w; acc[10] += hc.z * w; acc[11] += hc.w * w;
      acc[12] += hd.x * w; acc[13] += hd.y * w; acc[14] += hd.z * w; acc[15] += hd.w * w;
    }
    const float delta = fabsf(mind + (float)c * ((maxd - mind) / 511.f));
    bf16_t* Rrow = R + (size_t)(o * 512 + c) * n2;
#pragma unroll
    for (int i = 0; i < 16; ++i) {
      const int pos = p0 + i;
      const float t = (float)pos / (float)(n - 1);
      float val = acc[i] * (__expf(-t * delta) + 0.05f);
      int idx = dir == 0 ? (n - 1 - pos) : (n - 1 + pos);
      if (dir == 1 && pos == 0) { idx = n2 - 1; val = 0.f; }
      Rrow[idx] = f2bf(val);
    }
  }
}

__device__ __forceinline__ void cache_item(const Params& p, int item) {
  const int tid = ltid(), r0 = item * 32;
  bf16_t* ckvn = (bf16_t*)(p.ws + OFF_CKVN);
#pragma unroll 2
  for (int e = tid; e < 32 * 64; e += 256) {
    const int r = r0 + (e >> 6), c4 = (e & 63) * 4;
    const float4 v = *(const float4*)(p.cache_ckv + (size_t)r * 256 + c4);
    *(uint2*)(ckvn + (size_t)(NTOK + r) * 256 + c4) = make_uint2(pack2(v.x, v.y), pack2(v.z, v.w));
  }
}

template <int WHICH>
__device__ __forceinline__ void rmsmod_phase(const Params& p) {
  const int tid = ltid(), lane = tid & 63, wid = tid >> 6;
  const int gw = blockIdx.x * 4 + wid, tw = gridDim.x * 4;
  const float* g = WHICH == 0 ? p.g_mix : p.g_ffn;
  const float* mod = (const float*)(p.ws + OFF_MOD);
  bf16_t* h = (bf16_t*)(p.ws + OFF_H);
  for (int row = gw; row < NTOK; row += tw) {
    const float* src = WHICH == 0 ? xrow(p, row) : p.out + (size_t)row * D;
    float4 v[4];
    float ss = 0.f;
#pragma unroll
    for (int i = 0; i < 4; ++i) {
      v[i] = ((const float4*)src)[lane + 64 * i];
      ss += v[i].x * v[i].x + v[i].y * v[i].y + v[i].z * v[i].z + v[i].w * v[i].w;
    }
    ss = wave_sum(ss);
    const float r = rsqrtf(ss * (1.f / 1024.f) + 1e-6f);
    const float* mv = mod + modidx(row) * 6144 + (WHICH == 0 ? 0 : 3 * 1024);
#pragma unroll
    for (int i = 0; i < 4; ++i) {
      const int e = 4 * (lane + 64 * i);
      const float4 g4 = *(const float4*)(g + e), sh = *(const float4*)(mv + e), sc = *(const float4*)(mv + 1024 + e);
      const float y0 = v[i].x * r * g4.x * (1.f + sc.x) + sh.x, y1 = v[i].y * r * g4.y * (1.f + sc.y) + sh.y;
      const float y2 = v[i].z * r * g4.z * (1.f + sc.z) + sh.z, y3 = v[i].w * r * g4.w * (1.f + sc.w) + sh.w;
      *(uint2*)(h + (size_t)row * D + e) = make_uint2(pack2(y0, y1), pack2(y2, y3));
    }
  }
}

struct EpiIn {
  float* proj; bf16_t* hyT;
  __device__ __forceinline__ void operator()(int row0, int col, const f32x4& v) const {
    if (col < 672) {
#pragma unroll
      for (int j = 0; j < 4; ++j) proj[(size_t)(row0 + j) * 672 + col] = v[j];
    } else if (col < DIN) {
      *(uint2*)(hyT + (size_t)(col - 672) * NTOK + row0) = make_uint2(pack2(v[0], v[1]), pack2(v[2], v[3]));
    }
  }
};
struct EpiQ {
  bf16_t* q;
  __device__ __forceinline__ void operator()(int row, int col0, const f32x4& v) const {
    *(uint2*)(q + (size_t)row * 768 + col0) = make_uint2(pack2(v[0], v[1]), pack2(v[2], v[3]));
  }
};
struct EpiKV {
  bf16_t *kraw, *vtc, *vtl;
  __device__ __forceinline__ void operator()(int row0, int col, const f32x4& v) const {
    const int head = col >> 7, cc = col & 127;
    if (cc < 64) {
#pragma unroll
      for (int j = 0; j < 4; ++j) kraw[(size_t)(row0 + j) * 512 + head * 64 + cc] = f2bf(v[j]);
    } else {
      const int dv = cc - 64;
      bf16_t* dst;
      if (row0 < NCTX) dst = vtc + ((size_t)((row0 >> 8) * 8 + head) * 64 + dv) * 256 + (row0 & 255);
      else if (row0 < NTOK) { const int r = row0 - NCTX; dst = vtl + ((size_t)((r >> 12) * 8 + head) * 64 + dv) * 4608 + (r & 4095); }
      else { const int r = row0 - NTOK; dst = vtl + ((size_t)((r >> 9) * 8 + head) * 64 + dv) * 4608 + 4096 + (r & 511); }
      *(uint2*)dst = make_uint2(pack2(v[0], v[1]), pack2(v[2], v[3]));
    }
  }
};
struct EpiOut {
  const Params* p;
  __device__ __forceinline__ void operator()(int row, int col0, const f32x4& v) const {
    const float4 x = *(const float4*)(xrow(*p, row) + col0);
    const float4 m = *(const float4*)((const float*)(p->ws + OFF_MOD) + modidx(row) * 6144 + 2 * 1024 + col0);
    *(float4*)(p->out + (size_t)row * D + col0) = make_float4(x.x + m.x * v[0], x.y + m.y * v[1], x.z + m.z * v[2], x.w + m.w * v[3]);
  }
};
struct EpiU {
  bf16_t* u;
  __device__ __forceinline__ void operator()(int row, int col0, const f32x4& v) const {
    *(uint2*)(u + (size_t)row * 5632 + col0) = make_uint2(pack2(v[0], v[1]), pack2(v[2], v[3]));
  }
};
struct EpiY {
  const Params* p; int half;
  __device__ __forceinline__ void operator()(int row, int col0, const f32x4& v) const {
    const int grow = half * 8192 + row;
    float4* dst = (float4*)(p->out + (size_t)grow * D + col0);
    const float4 x = *dst;
    const float4 m = *(const float4*)((const float*)(p->ws + OFF_MOD) + modidx(grow) * 6144 + 5 * 1024 + col0);
    *dst = make_float4(x.x + m.x * v[0], x.y + m.y * v[1], x.z + m.z * v[2], x.w + m.w * v[3]);
  }
};

__device__ __forceinline__ void token_item(const Params& p, int item) {
  const int tid = ltid(), lane = tid & 63, wid = tid >> 6;
  const float* proj = (const float*)(p.ws + OFF_PROJ);
  bf16_t* qa = (bf16_t*)(p.ws + OFF_QA);
  bf16_t* ckvn = (bf16_t*)(p.ws + OFF_CKVN);
  float* kpe = (float*)(p.ws + OFF_KPE);
  for (int tt = 0; tt < 16; ++tt) {
    const int token = item * 64 + wid * 16 + tt;
    const float* pr = proj + (size_t)token * 672;
    float2 q[3];
    float ss = 0.f;
#pragma unroll
    for (int i = 0; i < 3; ++i) { q[i] = *(const float2*)(pr + lane * 2 + 128 * i); ss += q[i].x * q[i].x + q[i].y * q[i].y; }
    ss = wave_sum(ss);
    const float r = rsqrtf(ss * (1.f / 384.f) + 1e-6f);
#pragma unroll
    for (int i = 0; i < 3; ++i) {
      const int e = lane * 2 + 128 * i;
      *(unsigned*)(qa + (size_t)token * 384 + e) = pack2(q[i].x * r * p.g_qa[e], q[i].y * r * p.g_qa[e + 1]);
    }
    const float4 kv = *(const float4*)(pr + 384 + lane * 4);
    float s2 = wave_sum(kv.x * kv.x + kv.y * kv.y + kv.z * kv.z + kv.w * kv.w);
    const float r2 = rsqrtf(s2 * (1.f / 256.f) + 1e-6f);
    const float4 g = *(const float4*)(p.g_kva + lane * 4);
    const float4 y = make_float4(kv.x * r2 * g.x, kv.y * r2 * g.y, kv.z * r2 * g.z, kv.w * r2 * g.w);
    *(uint2*)(ckvn + (size_t)token * 256 + lane * 4) = make_uint2(pack2(y.x, y.y), pack2(y.z, y.w));
    if (token < NCTX) *(float4*)(p.out + OUT_CKV + (size_t)token * 256 + lane * 4) = y;
    if (lane < 32) {
      const float kp = pr[640 + lane];
      kpe[(size_t)token * 32 + lane] = kp;
      if (token < NCTX) p.out[OUT_KPE + (size_t)token * 32 + lane] = kp;
    }
  }
}

template <int ORDER>
__device__ __forceinline__ void hyena_item(const Params& p, int grp, int c, char* smem) {
  const int tid = ltid(), lane = tid & 63, wid = tid >> 6, fr = lane & 15, fq = lane >> 4;
  const int n = grp ? SEQL : SEQC, nb = n >> 6, L = n;
  const bf16_t* Rrow = (const bf16_t*)(p.ws + (grp ? OFF_RLAT : OFF_RCTX)) + (size_t)(ORDER * 512 + c) * (2 * n);
  const bf16_t* hyT = (const bf16_t*)(p.ws + OFF_HYT);
  bf16_t* sU = (bf16_t*)smem;
  unsigned* sR0 = (unsigned*)(smem + 18432);
  unsigned* sR1 = (unsigned*)(smem + 18432 + 16384);
  const int tok0 = grp * 8192;
  __syncthreads();
  for (int ch = tid; ch < (2 * n) / 8; ch += 256) *(uint4*)((bf16_t*)sR0 + ch * 8) = *(const uint4*)(Rrow + ch * 8);
  if (ORDER == 0) {
    const bf16_t* raw = hyT + (size_t)c * NTOK + tok0;
    const float w0 = p.hy_conv_w[c], w1 = p.hy_conv_w[1536 + c], w2 = p.hy_conv_w[3072 + c], b = p.hy_conv_b[c];
    for (int ch = tid; ch < 1024; ch += 256) {
      const int t = ch * 8, pos = t & (L - 1);
      const uint4 rv = *(const uint4*)(raw + t);
      float x[10];
      x[0] = pos == 0 ? 0.f : bf2f(raw[t - 1]);
      x[1] = bflo(rv.x); x[2] = bfhi(rv.x); x[3] = bflo(rv.y); x[4] = bfhi(rv.y);
      x[5] = bflo(rv.z); x[6] = bfhi(rv.z); x[7] = bflo(rv.w); x[8] = bfhi(rv.w);
      x[9] = (pos + 8 == L) ? 0.f : bf2f(raw[t + 8]);
      float u[8];
#pragma unroll
      for (int i = 0; i < 8; ++i) u[i] = w0 * x[i] + w1 * x[i + 1] + w2 * x[i + 2] + b;
      *(uint4*)(sU + (ch >> 3) * 72 + (ch & 7) * 8) = make_uint4(pack2(u[0], u[1]), pack2(u[2], u[3]), pack2(u[4], u[5]), pack2(u[6], u[7]));
    }
  } else {
    const bf16_t* zr = (const bf16_t*)(p.ws + OFF_ZT) + (size_t)c * NTOK + tok0;
    for (int ch = tid; ch < 1024; ch += 256) *(uint4*)(sU + (ch >> 3) * 72 + (ch & 7) * 8) = *(const uint4*)(zr + ch * 8);
  }
  __syncthreads();
  for (int k = tid; k < n; k += 256) {
    const unsigned a = sR0[k], b2 = (k + 1 < n) ? sR0[k + 1] : 0u;
    sR1[k] = (a >> 16) | (b2 << 16);
  }
  __syncthreads();

  f32x4 acc[4][2];
#pragma unroll
  for (int m = 0; m < 4; ++m) { acc[m][0] = (f32x4){0.f, 0.f, 0.f, 0.f}; acc[m][1] = (f32x4){0.f, 0.f, 0.f, 0.f}; }
  const unsigned* abase = (fr & 1) ? (sR0 + ((n - 1 - fr) >> 1) + 4 * fq) : (sR1 + ((n - 2 - fr) >> 1) + 4 * fq);
  const int col0 = 32 * wid + fr, col1 = col0 + 16;
  const int i0 = col0 & (nb - 1), i1 = col1 & (nb - 1);
  for (int d = -(nb - 1); d <= nb - 1; ++d) {
    const bool v0 = (unsigned)(i0 - d) < (unsigned)nb, v1 = (unsigned)(i1 - d) < (unsigned)nb;
    const bool any0 = __ballot(v0) != 0ull, any1 = __ballot(v1) != 0ull;
    if (!any0 && !any1) continue;
    bf16x8 F[6];
    const unsigned* ap = abase - 32 * d + 16;
#pragma unroll
    for (int idx = 0; idx < 6; ++idx) {
      const unsigned* q = ap - 8 * idx;
      union { unsigned u[4]; bf16x8 v; } cv;
      cv.u[0] = q[0]; cv.u[1] = q[1]; cv.u[2] = q[2]; cv.u[3] = q[3];
      F[idx] = cv.v;
    }
#pragma unroll
    for (int nt = 0; nt < 2; ++nt) {
      if (!(nt ? any1 : any0)) continue;
      const bool vv = nt ? v1 : v0;
      const bf16_t* up = sU + ((nt ? col1 : col0) - d) * 72 + fq * 8;
#pragma unroll
      for (int ks = 0; ks < 2; ++ks) {
        bf16x8 bf = (bf16x8){0, 0, 0, 0, 0, 0, 0, 0};
        if (vv) bf = *(const bf16x8*)(up + ks * 32);
#pragma unroll
        for (int m = 0; m < 4; ++m)
          acc[m][nt] = __builtin_amdgcn_mfma_f32_16x16x32_bf16(F[m + 2 - 2 * ks], bf, acc[m][nt], 0, 0, 0);
      }
    }
  }
  const float skip = p.filt_bias[ORDER * 512 + c];
  const int gcol = (ORDER == 0 ? 512 : 1024) + c;
  const bf16_t* graw = hyT + (size_t)gcol * NTOK + tok0;
  const float w0 = p.hy_conv_w[gcol], w1 = p.hy_conv_w[1536 + gcol], w2 = p.hy_conv_w[3072 + gcol], b = p.hy_conv_b[gcol];
  bf16_t* outT = (bf16_t*)(p.ws + (ORDER == 0 ? OFF_ZT : OFF_Y2T)) + (size_t)c * NTOK + tok0;
#pragma unroll
  for (int nt = 0; nt < 2; ++nt) {
    const int col = nt ? col1 : col0;
#pragma unroll
    for (int m = 0; m < 4; ++m) {
      const int t = col * 64 + 16 * m + 4 * fq, pos = t & (L - 1);
      const uint2 uu = *(const uint2*)(sU + col * 72 + 16 * m + 4 * fq);
      const uint2 gv = *(const uint2*)(graw + t);
      float x[6];
      x[0] = pos == 0 ? 0.f : bf2f(graw[t - 1]);
      x[1] = bflo(gv.x); x[2] = bfhi(gv.x); x[3] = bflo(gv.y); x[4] = bfhi(gv.y);
      x[5] = (pos + 4 == L) ? 0.f : bf2f(graw[t + 4]);
      const float u4[4] = {bflo(uu.x), bfhi(uu.x), bflo(uu.y), bfhi(uu.y)};
      float o[4];
#pragma unroll
      for (int j = 0; j < 4; ++j) {
        const float gate = w0 * x[j] + w1 * x[j + 1] + w2 * x[j + 2] + b;
        o[j] = gate * (acc[m][nt][j] + skip * u4[j]);
      }
      *(uint2*)(outT + t) = make_uint2(pack2(o[0], o[1]), pack2(o[2], o[3]));
    }
  }
}

__device__ __forceinline__ void rope32(float* y  , int pos) {
  const float prow = (float)(pos >> 6), pcol = (float)(pos & 63);
  const float fr[8] = {1.f, 0.31622776601683794f, 0.1f, 0.031622776601683794f, 0.01f, 0.0031622776601683794f, 0.001f, 0.00031622776601683794f};
#pragma unroll
  for (int i = 0; i < 8; ++i) {
    const float tr = prow * fr[i] * 0.15915494309189535f, tc = pcol * fr[i] * 0.15915494309189535f;
    const float sr = sin_turns(tr), cr = cos_turns(tr), sc = sin_turns(tc), cc = cos_turns(tc);
    const float a = y[i], b = y[8 + i], c2 = y[16 + i], d2 = y[24 + i];
    y[i] = a * cr - b * sr; y[8 + i] = b * cr + a * sr;
    y[16 + i] = c2 * cc - d2 * sc; y[24 + i] = d2 * cc + c2 * sc;
  }
}
__device__ __forceinline__ void unpack8(const uint4& v, float* x) {
  x[0] = bflo(v.x); x[1] = bfhi(v.x); x[2] = bflo(v.y); x[3] = bfhi(v.y);
  x[4] = bflo(v.z); x[5] = bfhi(v.z); x[6] = bflo(v.w); x[7] = bfhi(v.w);
}
__device__ __forceinline__ float sumsq8(const uint4& v) {
  float x[8];
  unpack8(v, x);
  return x[0] * x[0] + x[1] * x[1] + x[2] * x[2] + x[3] * x[3] + x[4] * x[4] + x[5] * x[5] + x[6] * x[6] + x[7] * x[7];
}
__device__ __forceinline__ uint4 scale8(const uint4& v, float r, const float* __restrict__ g) {
  float x[8];
  unpack8(v, x);
  const float4 g0 = *(const float4*)g, g1 = *(const float4*)(g + 4);
  return make_uint4(pack2(x[0] * r * g0.x, x[1] * r * g0.y), pack2(x[2] * r * g0.z, x[3] * r * g0.w),
                    pack2(x[4] * r * g1.x, x[5] * r * g1.y), pack2(x[6] * r * g1.z, x[7] * r * g1.w));
}
__device__ __forceinline__ void qk_item(const Params& p, int item) {
  const int tid = ltid();
  if (item < 512) {
    const int idx = item * 256 + tid, row = idx >> 3, h = idx & 7;
    const bf16_t* src = (const bf16_t*)(p.ws + OFF_QRAW) + (size_t)row * 768 + h * 96;
    bf16_t* dst = (bf16_t*)(p.ws + OFF_Q) + (size_t)row * 768 + h * 96;
    uint4 raw[12];
#pragma unroll
    for (int i = 0; i < 12; ++i) raw[i] = *(const uint4*)(src + 8 * i);
    float ss = 0.f;
#pragma unroll
    for (int i = 0; i < 12; ++i) ss += sumsq8(raw[i]);
    const float r = rsqrtf(ss * (1.f / 96.f) + 1e-6f);
    const float qs = 0.10206207261596575f * 1.4426950408889634f;
#pragma unroll
    for (int i = 0; i < 8; ++i) *(uint4*)(dst + 8 * i) = scale8(raw[i], r * qs, p.g_q + 8 * i);
    float y[32];
#pragma unroll
    for (int i = 0; i < 4; ++i) unpack8(raw[8 + i], y + 8 * i);
#pragma unroll
    for (int i = 0; i < 32; ++i) y[i] = y[i] * r * p.g_q[64 + i];
    if (row >= NCTX) rope32(y, (row - NCTX) & 4095);
#pragma unroll
    for (int i = 0; i < 4; ++i)
      *(uint4*)(dst + 64 + 8 * i) = make_uint4(pack2(y[8 * i] * qs, y[8 * i + 1] * qs), pack2(y[8 * i + 2] * qs, y[8 * i + 3] * qs),
                                               pack2(y[8 * i + 4] * qs, y[8 * i + 5] * qs), pack2(y[8 * i + 6] * qs, y[8 * i + 7] * qs));
  } else {
    const int idx = (item - 512) * 256 + tid, row = idx >> 3, h = idx & 7;
    const bf16_t* src = (const bf16_t*)(p.ws + OFF_KRAW) + (size_t)row * 512 + h * 64;
    uint4 raw[8];
#pragma unroll
    for (int i = 0; i < 8; ++i) raw[i] = *(const uint4*)(src + 8 * i);
    const float* kp = row < NTOK ? (const float*)(p.ws + OFF_KPE) + (size_t)row * 32 : p.cache_kpe + (size_t)(row - NTOK) * 32;
    float y[32];
#pragma unroll
    for (int i = 0; i < 8; ++i) {
      const float4 v = *(const float4*)(kp + 4 * i);
      y[4 * i] = v.x; y[4 * i + 1] = v.y; y[4 * i + 2] = v.z; y[4 * i + 3] = v.w;
    }
    float ss = 0.f;
#pragma unroll
    for (int i = 0; i < 8; ++i) ss += sumsq8(raw[i]);
#pragma unroll
    for (int i = 0; i < 32; ++i) ss += y[i] * y[i];
    const float r = rsqrtf(ss * (1.f / 96.f) + 1e-6f);
#pragma unroll
    for (int i = 0; i < 32; ++i) y[i] = y[i] * r * p.g_k[64 + i];
    bf16_t* dst;
    if (row < NCTX) dst = (bf16_t*)(p.ws + OFF_KC) + ((size_t)((row >> 8) * 8 + h) * 256 + (row & 255)) * 96;
    else if (row < NTOK) {
      const int rr = row - NCTX;
      rope32(y, rr & 4095);
      dst = (bf16_t*)(p.ws + OFF_KL) + ((size_t)((rr >> 12) * 8 + h) * 4608 + (rr & 4095)) * 96;
    } else {
      const int rr = row - NTOK;
      dst = (bf16_t*)(p.ws + OFF_KL) + ((size_t)((rr >> 9) * 8 + h) * 4608 + 4096 + (rr & 511)) * 96;
    }
#pragma unroll
    for (int i = 0; i < 8; ++i) *(uint4*)(dst + 8 * i) = scale8(raw[i], r, p.g_k + 8 * i);
#pragma unroll
    for (int i = 0; i < 4; ++i)
      *(uint4*)(dst + 64 + 8 * i) = make_uint4(pack2(y[8 * i], y[8 * i + 1]), pack2(y[8 * i + 2], y[8 * i + 3]),
                                               pack2(y[8 * i + 4], y[8 * i + 5]), pack2(y[8 * i + 6], y[8 * i + 7]));
  }
}

__device__ __forceinline__ void attn_item(const Params& p, int item, char* smem) {
  const int tid = ltid(), lane = tid & 63, wid = tid >> 6, lr = lane & 31, lh = lane >> 5;
  int nkeys, h, tokbase; const bf16_t *Kp, *Vp;
  if (item < 512) {
    const int b = item >> 8, rem = item & 255; h = rem >> 5; const int qb = rem & 31;
    nkeys = 4608; tokbase = NCTX + b * 4096 + qb * 128;
    Kp = (const bf16_t*)(p.ws + OFF_KL) + (size_t)(b * 8 + h) * 4608 * 96;
    Vp = (const bf16_t*)(p.ws + OFF_VTL) + (size_t)(b * 8 + h) * 64 * 4608;
  } else {
    const int it = item - 512, b = it >> 4; h = (it & 15) >> 1; const int qb = it & 1;
    nkeys = 256; tokbase = b * 256 + qb * 128;
    Kp = (const bf16_t*)(p.ws + OFF_KC) + (size_t)(b * 8 + h) * 256 * 96;
    Vp = (const bf16_t*)(p.ws + OFF_VTC) + (size_t)(b * 8 + h) * 64 * 256;
  }
  bf16_t* sK = (bf16_t*)smem;
  bf16_t* sV = sK + 64 * 104;
  const int token = tokbase + 32 * wid + lr;
  const bf16_t* qsrc = (const bf16_t*)(p.ws + OFF_Q) + (size_t)token * 768 + h * 96 + 8 * lh;
  bf16x8 qf[6];
#pragma unroll
  for (int ks = 0; ks < 6; ++ks) qf[ks] = *(const bf16x8*)(qsrc + 16 * ks);
  f32x16 oacc[2];
#pragma unroll
  for (int j = 0; j < 16; ++j) { oacc[0][j] = 0.f; oacc[1][j] = 0.f; }
  float mrun = -1e30f, lsum = 0.f;
  const int kk0 = tid / 12, kc0 = tid % 12, kk1 = (tid + 256) / 12, kc1 = (tid + 256) % 12, kk2 = (tid + 512) / 12, kc2 = (tid + 512) % 12;
  const int vd0 = tid >> 3, vc0 = tid & 7, vd1 = vd0 + 32;
  const bf16_t* gk0 = Kp + (size_t)kk0 * 96 + kc0 * 8;
  const bf16_t* gk1 = Kp + (size_t)kk1 * 96 + kc1 * 8;
  const bf16_t* gk2 = Kp + (size_t)kk2 * 96 + kc2 * 8;
  const bf16_t* gv0 = Vp + (size_t)vd0 * nkeys + vc0 * 8;
  const bf16_t* gv1 = Vp + (size_t)vd1 * nkeys + vc0 * 8;
  uint4 rk0 = *(const uint4*)gk0, rk1 = *(const uint4*)gk1, rk2 = *(const uint4*)gk2;
  uint4 rv0 = *(const uint4*)gv0, rv1 = *(const uint4*)gv1;
  const int nt = nkeys >> 6;
  for (int kt = 0; kt < nt; ++kt) {
    __syncthreads();
    *(uint4*)(sK + kk0 * 104 + kc0 * 8) = rk0; *(uint4*)(sK + kk1 * 104 + kc1 * 8) = rk1; *(uint4*)(sK + kk2 * 104 + kc2 * 8) = rk2;
    *(uint4*)(sV + vd0 * 72 + vc0 * 8) = rv0; *(uint4*)(sV + vd1 * 72 + vc0 * 8) = rv1;
    __syncthreads();
    if (kt + 1 < nt) {
      gk0 += 64 * 96; gk1 += 64 * 96; gk2 += 64 * 96; gv0 += 64; gv1 += 64;
      rk0 = *(const uint4*)gk0; rk1 = *(const uint4*)gk1; rk2 = *(const uint4*)gk2;
      rv0 = *(const uint4*)gv0; rv1 = *(const uint4*)gv1;
    }
    f32x16 sacc[2];
#pragma unroll
    for (int kb = 0; kb < 2; ++kb) {
#pragma unroll
      for (int j = 0; j < 16; ++j) sacc[kb][j] = 0.f;
#pragma unroll
      for (int ks = 0; ks < 6; ++ks) {
        const bf16x8 a = *(const bf16x8*)(sK + (32 * kb + lr) * 104 + 16 * ks + 8 * lh);
        sacc[kb] = __builtin_amdgcn_mfma_f32_32x32x16_bf16(a, qf[ks], sacc[kb], 0, 0, 0);
      }
    }
    float mx = sacc[0][0];
#pragma unroll
    for (int j = 1; j < 16; ++j) mx = fmaxf(mx, sacc[0][j]);
#pragma unroll
    for (int j = 0; j < 16; ++j) mx = fmaxf(mx, sacc[1][j]);
    mx = fmaxf(mx, __shfl_xor(mx, 32));
    const float mnew = fmaxf(mrun, mx);
    const float alpha = __builtin_amdgcn_exp2f(mrun - mnew);
    mrun = mnew;
    float ps = 0.f;
#pragma unroll
    for (int kb = 0; kb < 2; ++kb)
#pragma unroll
      for (int j = 0; j < 16; ++j) { const float e = __builtin_amdgcn_exp2f(sacc[kb][j] - mnew); sacc[kb][j] = e; ps += e; }
    lsum = lsum * alpha + ps;
#pragma unroll
    for (int j = 0; j < 16; ++j) { oacc[0][j] *= alpha; oacc[1][j] *= alpha; }
#pragma unroll
    for (int s = 0; s < 4; ++s) {
      const int kb = s >> 1, jb = 8 * (s & 1);
      union { unsigned u[4]; bf16x8 v; } pf;
      pf.u[0] = pack2(sacc[kb][jb + 0], sacc[kb][jb + 1]); pf.u[1] = pack2(sacc[kb][jb + 2], sacc[kb][jb + 3]);
      pf.u[2] = pack2(sacc[kb][jb + 4], sacc[kb][jb + 5]); pf.u[3] = pack2(sacc[kb][jb + 6], sacc[kb][jb + 7]);
#pragma unroll
      for (int mt = 0; mt < 2; ++mt) {
        const bf16_t* vp = sV + (32 * mt + lr) * 72 + 16 * s + 4 * lh;
        union { uint2 d[2]; bf16x8 v; } av;
        av.d[0] = *(const uint2*)vp;
        av.d[1] = *(const uint2*)(vp + 8);
        oacc[mt] = __builtin_amdgcn_mfma_f32_32x32x16_bf16(av.v, pf.v, oacc[mt], 0, 0, 0);
      }
    }
  }
  lsum += __shfl_xor(lsum, 32);
  const float inv = 1.f / lsum;
  bf16_t* dst = (bf16_t*)(p.ws + OFF_ATTN) + (size_t)token * 512 + h * 64;
#pragma unroll
  for (int mt = 0; mt < 2; ++mt)
#pragma unroll
    for (int jg = 0; jg < 4; ++jg) {
      const int dv0 = 32 * mt + 8 * jg + 4 * lh;
      *(uint2*)(dst + dv0) = make_uint2(pack2(oacc[mt][4 * jg] * inv, oacc[mt][4 * jg + 1] * inv),
                                        pack2(oacc[mt][4 * jg + 2] * inv, oacc[mt][4 * jg + 3] * inv));
    }
}

__device__ __forceinline__ void merge_item(const Params& p, int item, char* smem) {
  const int tid = ltid(), lane = tid & 63, wid = tid >> 6, t0 = item * 32;
  bf16_t* mix = (bf16_t*)(p.ws + OFF_H);
  const bf16_t* attn = (const bf16_t*)(p.ws + OFF_ATTN);
  for (int tt = 0; tt < 8; ++tt) {
    const int token = t0 + wid * 8 + tt;
    float x[8];
    unpack8(*(const uint4*)(attn + (size_t)token * 512 + lane * 8), x);
    float ss = 0.f;
#pragma unroll
    for (int i = 0; i < 8; ++i) ss += x[i] * x[i];
    ss = wave_sum(ss);
    const float r = rsqrtf(ss * (1.f / 512.f) + 1e-6f);
    const float4 g0 = *(const float4*)(p.g_out_att + lane * 8), g1 = *(const float4*)(p.g_out_att + lane * 8 + 4);
    *(uint4*)(mix + (size_t)token * D + lane * 8) =
        make_uint4(pack2(x[0] * r * g0.x, x[1] * r * g0.y), pack2(x[2] * r * g0.z, x[3] * r * g0.w),
                   pack2(x[4] * r * g1.x, x[5] * r * g1.y), pack2(x[6] * r * g1.z, x[7] * r * g1.w));
  }
  bf16_t* sT = (bf16_t*)smem;
  const bf16_t* y2T = (const bf16_t*)(p.ws + OFF_Y2T);
  __syncthreads();
  for (int ch = tid; ch < 2048; ch += 256) {
    const int c = ch >> 2, q4 = ch & 3;
    const uint4 v = *(const uint4*)(y2T + (size_t)c * NTOK + t0 + q4 * 8);
    bf16_t* d = sT + (q4 * 8) * 520 + c;
    d[0 * 520] = (bf16_t)(v.x & 0xffff); d[1 * 520] = (bf16_t)(v.x >> 16);
    d[2 * 520] = (bf16_t)(v.y & 0xffff); d[3 * 520] = (bf16_t)(v.y >> 16);
    d[4 * 520] = (bf16_t)(v.z & 0xffff); d[5 * 520] = (bf16_t)(v.z >> 16);
    d[6 * 520] = (bf16_t)(v.w & 0xffff); d[7 * 520] = (bf16_t)(v.w >> 16);
  }
  __syncthreads();
  {
    const int tt = tid >> 3, part = tid & 7;
    uint4 v[8];
    float ss = 0.f;
#pragma unroll
    for (int i = 0; i < 8; ++i) {
      v[i] = *(const uint4*)(sT + tt * 520 + part * 64 + 8 * i);
      float x[8];
      unpack8(v[i], x);
#pragma unroll
      for (int e = 0; e < 8; ++e) ss += x[e] * x[e];
    }
    ss += __shfl_xor(ss, 1); ss += __shfl_xor(ss, 2); ss += __shfl_xor(ss, 4);
    const float r = rsqrtf(ss * (1.f / 512.f) + 1e-6f);
#pragma unroll
    for (int i = 0; i < 8; ++i) {
      float x[8];
      unpack8(v[i], x);
      const int c0 = part * 64 + 8 * i;
      const float4 g0 = *(const float4*)(p.g_out_hy + c0), g1 = *(const float4*)(p.g_out_hy + c0 + 4);
      *(uint4*)(mix + (size_t)(t0 + tt) * D + 512 + c0) =
          make_uint4(pack2(x[0] * r * g0.x, x[1] * r * g0.y), pack2(x[2] * r * g0.z, x[3] * r * g0.w),
                     pack2(x[4] * r * g1.x, x[5] * r * g1.y), pack2(x[6] * r * g1.z, x[7] * r * g1.w));
    }
  }
}

__device__ __forceinline__ void act_item(const Params& p, int item, int half) {
  const int idx = item * 256 + ltid();
  if (idx >= 1024 * 352) return;
  const int j = (idx % 352) * 8, r0 = (idx / 352) * 8;
  const int L = half ? SEQL : SEQC;
  const bf16_t* u = (const bf16_t*)(p.ws + OFF_U);
  bf16_t* act = (bf16_t*)(p.ws + OFF_ACT);
  float wa[3][8], wg[3][8], ba[8], bg[8];
#pragma unroll
  for (int t = 0; t < 3; ++t)
#pragma unroll
    for (int e = 0; e < 8; ++e) { wa[t][e] = p.ffn_conv_w[t * 5632 + j + e]; wg[t][e] = p.ffn_conv_w[t * 5632 + 2816 + j + e]; }
#pragma unroll
  for (int e = 0; e < 8; ++e) { ba[e] = p.ffn_conv_b[j + e]; bg[e] = p.ffn_conv_b[2816 + j + e]; }
  float pa[8], pg[8], ca[8], cg_[8], na[8], ng[8];
  if ((r0 & (L - 1)) == 0) {
#pragma unroll
    for (int e = 0; e < 8; ++e) { pa[e] = 0.f; pg[e] = 0.f; }
  } else {
    unpack8(*(const uint4*)(u + (size_t)(r0 - 1) * 5632 + j), pa);
    unpack8(*(const uint4*)(u + (size_t)(r0 - 1) * 5632 + 2816 + j), pg);
  }
  unpack8(*(const uint4*)(u + (size_t)r0 * 5632 + j), ca);
  unpack8(*(const uint4*)(u + (size_t)r0 * 5632 + 2816 + j), cg_);
#pragma unroll
  for (int i = 0; i < 8; ++i) {
    const int r = r0 + i;
    if (((r + 1) & (L - 1)) == 0) {
#pragma unroll
      for (int e = 0; e < 8; ++e) { na[e] = 0.f; ng[e] = 0.f; }
    } else {
      unpack8(*(const uint4*)(u + (size_t)(r + 1) * 5632 + j), na);
      unpack8(*(const uint4*)(u + (size_t)(r + 1) * 5632 + 2816 + j), ng);
    }
    float o[8];
#pragma unroll
    for (int e = 0; e < 8; ++e) {
      const float a = wa[0][e] * pa[e] + wa[1][e] * ca[e] + wa[2][e] * na[e] + ba[e];
      const float g = wg[0][e] * pg[e] + wg[1][e] * cg_[e] + wg[2][e] * ng[e] + bg[e];
      o[e] = a / (1.f + __expf(-a)) * g;
    }
    *(uint4*)(act + (size_t)r * 2816 + j) = make_uint4(pack2(o[0], o[1]), pack2(o[2], o[3]), pack2(o[4], o[5]), pack2(o[6], o[7]));
#pragma unroll
    for (int e = 0; e < 8; ++e) { pa[e] = ca[e]; pg[e] = cg_[e]; ca[e] = na[e]; cg_[e] = ng[e]; }
  }
}


#define XB_TMO      128
#define XB_XCNT(j)  (256  + 64 * (j))
#define XB_XSUB(j)  (1280 + 64 * (j))
#define XB_XGEN(j)  (2304 + 64 * (j))
#define XB_TOP      3328
#define XB_TOPGEN   3392
#define XCD_BAR_WORDS 3456
#define XB_SPIN_CAP (1u << 20)
#define LAS __attribute__((address_space(3)))
__device__ __forceinline__ unsigned xb_ld(unsigned* p) { return __hip_atomic_load(p, __ATOMIC_RELAXED, __HIP_MEMORY_SCOPE_AGENT); }
__device__ __forceinline__ unsigned xb_add(unsigned* p, unsigned v) { return __hip_atomic_fetch_add(p, v, __ATOMIC_RELAXED, __HIP_MEMORY_SCOPE_AGENT); }
__device__ __forceinline__ unsigned xb_xcc_id() { return (unsigned)__builtin_amdgcn_s_getreg((3 << 11) | 20) & 0xFu; }
#define XB_SPIN(cond, bar) do { unsigned _sp = 0; while (cond) { __builtin_amdgcn_s_sleep(1); \
    if ((++_sp & 255u) == 0u) { if (xb_ld(&(bar)[XB_TMO])) break; if (_sp > XB_SPIN_CAP) { atomicAdd(&(bar)[XB_TMO], 1u); break; } } } } while (0)
struct XcdBarrier { unsigned* bar; unsigned x; volatile LAS unsigned* st; };
__device__ __forceinline__ XcdBarrier xcd_barrier_post(unsigned* bar, volatile LAS unsigned* st) {
  XcdBarrier b; b.bar = bar; b.x = xb_xcc_id(); b.st = st;
  if (threadIdx.x == 0) (void)xb_add(&bar[XB_XCNT(b.x)], 1u);
  return b;
}
__device__ __forceinline__ void xcd_barrier_complete(unsigned* bar, unsigned x, unsigned& nloc, unsigned& nx) {
  const unsigned G = gridDim.x * gridDim.y * gridDim.z;
  unsigned sum, cnt, mine, sp = 0u;
  for (;;) {
    sum = 0u; cnt = 0u; mine = 0u;
#pragma unroll
    for (unsigned j = 0; j < 16; ++j) { const unsigned c = xb_ld(&bar[XB_XCNT(j)]); sum += c; cnt += (c > 0u) ? 1u : 0u; mine = (j == x) ? c : mine; }
    if (sum == G) break;
    __builtin_amdgcn_s_sleep(1);
    if ((++sp & 255u) == 0u) { if (xb_ld(&bar[XB_TMO])) break; if (sp > XB_SPIN_CAP) { atomicAdd(&bar[XB_TMO], 1u); break; } }
  }
  nloc = mine > 0u ? mine : 1u; nx = cnt > 0u ? cnt : 1u;
}
__device__ __forceinline__ void xcd_barrier(const XcdBarrier& b) {
  asm volatile("s_waitcnt vmcnt(0)" ::: "memory");
  __syncthreads();
  if (threadIdx.x == 0) {
    unsigned* bar = b.bar;
    __builtin_amdgcn_s_waitcnt(0);
    unsigned nloc = b.st[0], nx = b.st[1];
    if (nloc == 0u) { xcd_barrier_complete(bar, b.x, nloc, nx); b.st[0] = nloc; b.st[1] = nx; }
    const unsigned old = xb_add(&bar[XB_XSUB(b.x)], 1u);
    const unsigned gen = old / nloc;
    if (old + 1u == (gen + 1u) * nloc) {
      __builtin_amdgcn_fence(__ATOMIC_RELEASE, "agent");
      asm volatile("s_waitcnt vmcnt(0)" ::: "memory");
      const unsigned og = xb_add(&bar[XB_TOP], 1u);
      const unsigned tg = og / nx;
      if (og + 1u == (tg + 1u) * nx) xb_add(&bar[XB_TOPGEN], 1u);
      else XB_SPIN(xb_ld(&bar[XB_TOPGEN]) == tg, bar);
      __builtin_amdgcn_fence(__ATOMIC_ACQUIRE, "agent");
      xb_add(&bar[XB_XGEN(b.x)], 1u);
      asm volatile("s_waitcnt vmcnt(0)" ::: "memory");
    } else {
      XB_SPIN(xb_ld(&bar[XB_XGEN(b.x)]) == gen, bar);
      __builtin_amdgcn_fence(__ATOMIC_ACQUIRE, "agent");
      asm volatile("s_waitcnt vmcnt(0)" ::: "memory");
    }
  }
  __syncthreads();
}
constexpr size_t OFF_BAR = 25 * MiB - 16384;
static_assert(OFF_MOD + 3 * 6144 * 4 <= OFF_BAR, "bar");

template <int ph>
__device__ __forceinline__ void run_phase(const Params& p, char* smem) {
  const int bid = blockIdx.x, G = gridDim.x;
  char* ws = p.ws;
  if constexpr (ph == 0) {
    for (int it = bid; it < 272 + 96 + 32 + 3080; it += G) {
      if (it < 272) filter_item(p, it, smem);
      else if (it < 368) mod_item(p, it - 272, smem);
      else if (it < 400) cache_item(p, it - 368);
      else {
        int t = it - 400;
        if (t < 576) transpose_item(p.w_in, 1024, DIN, (bf16_t*)(ws + OFF_WIN), t, 36, smem);
        else if ((t -= 576) < 72) transpose_item(p.w_uq, 384, 768, (bf16_t*)(ws + OFF_WUQ), t, 12, smem);
        else if ((t -= 72) < 64) transpose_item(p.w_ukv, 256, 1024, (bf16_t*)(ws + OFF_WUKV), t, 16, smem);
        else if ((t -= 64) < 256) transpose_item(p.w_out, 1024, 1024, (bf16_t*)(ws + OFF_WOUT), t, 16, smem);
        else if ((t -= 256) < 1408) transpose_item(p.w_up, 1024, 5632, (bf16_t*)(ws + OFF_WUP), t, 88, smem);
        else { t -= 1408; transpose_item(p.w_down, 2816, 1024, (bf16_t*)(ws + OFF_WDOWN), t, 16, smem); }
      }
    }
  } else if constexpr (ph == 1) {
    rmsmod_phase<0>(p);
  } else if constexpr (ph == 2) {
    EpiIn epi{(float*)(ws + OFF_PROJ), (bf16_t*)(ws + OFF_HYT)};
    for (int t = bid; t < 128 * 18; t += G)
      gemm_tile<false>((const bf16_t*)(ws + OFF_H), 1024, (const bf16_t*)(ws + OFF_WIN), 1024, 1024, (t / 18) * 128, (t % 18) * 128, smem, epi);
  } else if constexpr (ph == 3) {
    for (int it = bid; it < 512; it += G) hyena_item<0>(p, 1, it, smem);
    for (int it = bid; it < 512; it += G) hyena_item<0>(p, 0, it, smem);
    for (int it = bid; it < 256; it += G) token_item(p, it);
  } else if constexpr (ph == 4) {
    EpiQ eq{(bf16_t*)(ws + OFF_QRAW)};
    EpiKV ekv{(bf16_t*)(ws + OFF_KRAW), (bf16_t*)(ws + OFF_VTC), (bf16_t*)(ws + OFF_VTL)};
    for (int it = bid; it < 512; it += G) hyena_item<1>(p, 1, it, smem);
    for (int t = bid; t < 768; t += G) gemm_tile<true>((const bf16_t*)(ws + OFF_QA), 384, (const bf16_t*)(ws + OFF_WUQ), 384, 384, (t / 6) * 128, (t % 6) * 128, smem, eq);
    for (int t = bid; t < 1088; t += G) gemm_tile<false>((const bf16_t*)(ws + OFF_CKVN), 256, (const bf16_t*)(ws + OFF_WUKV), 256, 256, (t / 8) * 128, (t % 8) * 128, smem, ekv);
    for (int it = bid; it < 512; it += G) hyena_item<1>(p, 0, it, smem);
  } else if constexpr (ph == 5) {
    for (int it = bid; it < 512 + 544; it += G) qk_item(p, it);
  } else if constexpr (ph == 6) {
    for (int it = bid; it < 1024; it += G) attn_item(p, it, smem);
  } else if constexpr (ph == 7) {
    for (int it = bid; it < 512; it += G) merge_item(p, it, smem);
  } else if constexpr (ph == 8) {
    EpiOut epi{&p};
    for (int t = bid; t < 128 * 8; t += G)
      gemm_tile<true>((const bf16_t*)(ws + OFF_H), 1024, (const bf16_t*)(ws + OFF_WOUT), 1024, 1024, (t / 8) * 128, (t % 8) * 128, smem, epi);
  } else if constexpr (ph == 9) {
    rmsmod_phase<1>(p);
  } else if constexpr (ph == 10 || ph == 13) {
    constexpr int half = ph == 10 ? 0 : 1;
    EpiU epi{(bf16_t*)(ws + OFF_U)};
    for (int t = bid; t < 64 * 44; t += G)
      gemm_tile<true>((const bf16_t*)(ws + OFF_H) + (size_t)half * 8192 * 1024, 1024, (const bf16_t*)(ws + OFF_WUP), 1024, 1024, (t / 44) * 128, (t % 44) * 128, smem, epi);
  } else if constexpr (ph == 11 || ph == 14) {
    for (int it = bid; it < 1408; it += G) act_item(p, it, ph == 11 ? 0 : 1);
  } else if constexpr (ph == 12 || ph == 15) {
    EpiY epi{&p, ph == 12 ? 0 : 1};
    for (int t = bid; t < 64 * 8; t += G)
      gemm_tile<true>((const bf16_t*)(ws + OFF_ACT), 2816, (const bf16_t*)(ws + OFF_WDOWN), 2816, 2816, (t / 8) * 128, (t % 8) * 128, smem, epi);
  }
}

#if ONE_LAUNCH
template <int PH>
__device__ __forceinline__ void run_all(const Params& p, char* smem, cg::grid_group& grid, const XcdBarrier& xb) {
  run_phase<PH>(p, smem);
  if constexpr (((DBL_MASK >> PH) & 1) != 0) { xcd_barrier(xb); run_phase<PH>(p, smem); }
  if constexpr (PH < 15) {
    if constexpr (PH == 0) grid.sync(); else xcd_barrier(xb);
    run_all<PH + 1>(p, smem, grid, xb);
  }
}
__global__ void __launch_bounds__(256, 2) mega_kernel(Params p) {
  __shared__ __attribute__((aligned(16))) char smem[SMEM_BYTES];
  __shared__ uint4 xb_words;
  cg::grid_group grid = cg::this_grid();
  if (threadIdx.x == 0) xb_words = make_uint4(0u, 0u, 0u, 0u);
  __syncthreads();
  XcdBarrier xb = xcd_barrier_post((unsigned*)(p.ws + OFF_BAR), (volatile LAS unsigned*)&xb_words);
  run_all<0>(p, smem, grid, xb);
}
#else
template <int PH>
__global__ void __launch_bounds__(256, 2) phase_kernel(Params p) {
  __shared__ __attribute__((aligned(16))) char smem[SMEM_BYTES];
  run_phase<PH>(p, smem);
}
#ifndef DBG_STOP
#define DBG_STOP 15
#endif
__global__ void dump_kernel(Params p, size_t off, int count) {
  const bf16_t* src = (const bf16_t*)(p.ws + off);
  const bf16_t* src2 = (const bf16_t*)(p.ws + DBG_OFF2);
  for (int i = blockIdx.x * 256 + threadIdx.x; i < 16777216; i += gridDim.x * 256)
    p.out[i] = i < DBG_CNT ? bf2f(src[i]) : (i - DBG_CNT < DBG_CNT2 ? bf2f(src2[i - DBG_CNT]) : 0.f);
}
template <int PH>
static void launch_all(const Params& p, hipStream_t stream) {
  phase_kernel<PH><<<512, 256, 0, stream>>>(p);
  if constexpr (PH < DBG_STOP) launch_all<PH + 1>(p, stream);
}
#endif

extern "C" void kernel_launch(void* const* d_in, const int* in_sizes, int n_in, void* d_out, int out_size, void* d_ws,
                              size_t ws_size, hipStream_t stream) {
  Params p{};
  const float** pp = (const float**)&p;
  for (int i = 0; i < 34; ++i) pp[i] = (const float*)d_in[i];
  p.out = (float*)d_out;
  p.ws = (char*)d_ws;
#if ONE_LAUNCH
  (void)hipMemsetAsync((char*)d_ws + OFF_BAR, 0, XCD_BAR_WORDS * 4, stream);
  static int grid_blocks = 0;
  if (!grid_blocks) {
    int dev = 0, cus = 0, per_cu = 0;
    hipGetDevice(&dev);
    hipDeviceGetAttribute(&cus, hipDeviceAttributeMultiprocessorCount, dev);
    hipOccupancyMaxActiveBlocksPerMultiprocessor(&per_cu, mega_kernel, 256, 0);
    grid_blocks = cus * per_cu;
  }
  void* args[] = {&p};
  hipError_t e = hipLaunchCooperativeKernel((void*)mega_kernel, dim3(grid_blocks), dim3(256), args, 0, stream);
  if (e != hipSuccess) fprintf(stderr, "cooperative launch failed: %s (grid %d)\n", hipGetErrorString(e), grid_blocks);
#else
  launch_all<0>(p, stream);
#if DBG_STOP < 15
  dump_kernel<<<1024, 256, 0, stream>>>(p, DBG_OFF, DBG_CNT);
#endif
#endif
}
```

```cpp
#include <hip/hip_runtime.h>
#include <hip/hip_cooperative_groups.h>
#include <cstdio>
namespace cg = cooperative_groups;

#define DBG_STOP 15
#define DBG_NOHY 0
#ifndef DBL_MASK
#define DBL_MASK 0
#endif
#define DBG_OFF OFF_QRAW
#define DBG_OFF2 OFF_KRAW
#define DBG_CNT 12582912
#define DBG_CNT2 0
#ifndef ONE_LAUNCH
#define ONE_LAUNCH 1
#endif

typedef unsigned short bf16_t;
typedef short bf16x8 __attribute__((ext_vector_type(8)));
typedef float f32x4 __attribute__((ext_vector_type(4)));
typedef float f32x16 __attribute__((ext_vector_type(16)));

constexpr int D = 1024, NTOK = 16384, NCTX = 8192, SEQC = 256, SEQL = 4096;
constexpr int DIN = 2208, DINP = 2304, QL = 384, KVL = 256, DFF = 2816;
constexpr int NROWKV = 17408;
constexpr size_t MiB = 1048576;

constexpr size_t OFF_WIN = 0;
constexpr size_t OFF_WUQ = OFF_WIN + (size_t)DINP * 1024 * 2;
constexpr size_t OFF_WUKV = OFF_WUQ + (size_t)768 * 384 * 2;
constexpr size_t OFF_WOUT = OFF_WUKV + (size_t)1024 * 256 * 2;
constexpr size_t OFF_WUP = OFF_WOUT + (size_t)1024 * 1024 * 2;
constexpr size_t OFF_WDOWN = OFF_WUP + (size_t)5632 * 1024 * 2;
constexpr size_t OFF_MOD = OFF_WDOWN + (size_t)1024 * 2816 * 2;
static_assert(OFF_MOD + 3 * 6144 * 4 <= 25 * MiB, "A region");
constexpr size_t OFF_RLAT = 25 * MiB;
constexpr size_t OFF_RCTX = 41 * MiB;
constexpr size_t OFF_H = 42 * MiB;
constexpr size_t OFF_ZT = 42 * MiB;
constexpr size_t OFF_QA = 58 * MiB;
constexpr size_t OFF_KPE = 70 * MiB;
constexpr size_t OFF_PROJ = 74 * MiB;
constexpr size_t OFF_QRAW = 74 * MiB;
constexpr size_t OFF_Y2T = 98 * MiB;
constexpr size_t OFF_ATTN = 74 * MiB;
constexpr size_t OFF_U = 74 * MiB;
constexpr size_t OFF_HYT = 116 * MiB;
constexpr size_t OFF_Q = 116 * MiB;
constexpr size_t OFF_KC = 140 * MiB;
constexpr size_t OFF_KL = 152 * MiB;
constexpr size_t OFF_CKVN = 164 * MiB;
constexpr size_t OFF_KRAW = 173 * MiB;
constexpr size_t OFF_VTC = 190 * MiB;
constexpr size_t OFF_VTL = 198 * MiB;
constexpr size_t OFF_ACT = 162 * MiB;

constexpr int OUT_YS = 0;
constexpr int OUT_CKV = 16777216;
constexpr int OUT_KPE = 16777216 + 2097152;

constexpr int SMEM_BYTES = 51200;

struct Params {
  const float *x_prompt, *x_sample, *cache_ckv, *cache_kpe, *c, *c_ctx, *w_ada, *b_ada, *g_mix, *w_in, *g_qa, *w_uq,
      *g_kva, *w_ukv, *g_q, *g_k, *hy_conv_w, *hy_conv_b, *filt_w1, *filt_b1, *filt_freq1, *filt_w2, *filt_b2,
      *filt_freq2, *filt_w3, *filt_bias, *g_out_att, *g_out_hy, *w_out, *g_ffn, *w_up, *ffn_conv_w, *ffn_conv_b, *w_down;
  float* out;
  char* ws;
};

typedef __bf16 bf16x2_t __attribute__((ext_vector_type(2)));
__device__ __forceinline__ unsigned pack2(float lo, float hi) {
  bf16x2_t v;
  v[0] = (__bf16)lo;
  v[1] = (__bf16)hi;
  return __builtin_bit_cast(unsigned, v);
}
__device__ __forceinline__ float bflo(unsigned u) { return __uint_as_float(u << 16); }
__device__ __forceinline__ float bfhi(unsigned u) { return __uint_as_float(u & 0xffff0000u); }
__device__ __forceinline__ float bf2f(bf16_t h) { return __uint_as_float(((unsigned)h) << 16); }
__device__ __forceinline__ bf16_t f2bf(float f) { return (bf16_t)(pack2(f, 0.f) & 0xffffu); }
__device__ __forceinline__ float wave_sum(float v) {
#pragma unroll
  for (int o = 32; o >= 1; o >>= 1) v += __shfl_xor(v, o);
  return v;
}
__device__ __forceinline__ int ltid() { int t = threadIdx.x; asm volatile("" : "+v"(t)); return t; }
__device__ __forceinline__ float sin_turns(float t) { t -= floorf(t); return __builtin_amdgcn_sinf(t); }
__device__ __forceinline__ float cos_turns(float t) { t -= floorf(t); return __builtin_amdgcn_cosf(t); }
__device__ __forceinline__ float sin_rad(float x) { return sin_turns(x * 0.15915494309189535f); }
__device__ __forceinline__ const float* xrow(const Params& p, int row) {
  return row < NCTX ? p.x_prompt + (size_t)row * D : p.x_sample + (size_t)(row - NCTX) * D;
}
__device__ __forceinline__ int modidx(int row) { return row < NCTX ? 0 : 1 + ((row - NCTX) >> 12); }

template <bool SWAP, class Epi>
__device__ __forceinline__ void gemm_tile(const bf16_t* __restrict__ A, int lda, const bf16_t* __restrict__ Bt, int ldb,
                                          int K, int m0, int n0, char* smem, const Epi& epi) {
  const int tid = ltid(), lane = tid & 63, wid = tid >> 6, wr = wid >> 1, wc = wid & 1;
  const int fr = lane & 15, fq = lane >> 4;
  bf16_t* sA = (bf16_t*)smem;
  bf16_t* sB = sA + 128 * 72;
  f32x4 acc[4][4];
#pragma unroll
  for (int m = 0; m < 4; ++m)
#pragma unroll
    for (int n = 0; n < 4; ++n) acc[m][n] = (f32x4){0.f, 0.f, 0.f, 0.f};
  const int lr = tid >> 3, lc = (tid & 7) * 8;
  const bf16_t* ga = A + (size_t)(m0 + lr) * lda + lc;
  const bf16_t* gb = Bt + (size_t)(n0 + lr) * ldb + lc;
  const size_t sa32 = (size_t)32 * lda, sb32 = (size_t)32 * ldb;
  uint4 ra0 = *(const uint4*)(ga), ra1 = *(const uint4*)(ga + sa32), ra2 = *(const uint4*)(ga + 2 * sa32), ra3 = *(const uint4*)(ga + 3 * sa32);
  uint4 rb0 = *(const uint4*)(gb), rb1 = *(const uint4*)(gb + sb32), rb2 = *(const uint4*)(gb + 2 * sb32), rb3 = *(const uint4*)(gb + 3 * sb32);
  const int nk = K >> 6;
  bf16_t* wa = sA + lr * 72 + lc;
  bf16_t* wb = sB + lr * 72 + lc;
  for (int kt = 0; kt < nk; ++kt) {
    __syncthreads();
    *(uint4*)(wa) = ra0; *(uint4*)(wa + 32 * 72) = ra1; *(uint4*)(wa + 64 * 72) = ra2; *(uint4*)(wa + 96 * 72) = ra3;
    *(uint4*)(wb) = rb0; *(uint4*)(wb + 32 * 72) = rb1; *(uint4*)(wb + 64 * 72) = rb2; *(uint4*)(wb + 96 * 72) = rb3;
    __syncthreads();
    if (kt + 1 < nk) {
      ga += 64;
      gb += 64;
      ra0 = *(const uint4*)(ga); ra1 = *(const uint4*)(ga + sa32); ra2 = *(const uint4*)(ga + 2 * sa32); ra3 = *(const uint4*)(ga + 3 * sa32);
      rb0 = *(const uint4*)(gb); rb1 = *(const uint4*)(gb + sb32); rb2 = *(const uint4*)(gb + 2 * sb32); rb3 = *(const uint4*)(gb + 3 * sb32);
    }
#pragma unroll
    for (int ks = 0; ks < 2; ++ks) {
      bf16x8 af[4], bfr[4];
#pragma unroll
      for (int m = 0; m < 4; ++m) af[m] = *(const bf16x8*)(sA + (wr * 64 + m * 16 + fr) * 72 + ks * 32 + fq * 8);
#pragma unroll
      for (int n = 0; n < 4; ++n) bfr[n] = *(const bf16x8*)(sB + (wc * 64 + n * 16 + fr) * 72 + ks * 32 + fq * 8);
#pragma unroll
      for (int m = 0; m < 4; ++m)
#pragma unroll
        for (int n = 0; n < 4; ++n) {
          if (SWAP) acc[m][n] = __builtin_amdgcn_mfma_f32_16x16x32_bf16(bfr[n], af[m], acc[m][n], 0, 0, 0);
          else acc[m][n] = __builtin_amdgcn_mfma_f32_16x16x32_bf16(af[m], bfr[n], acc[m][n], 0, 0, 0);
        }
    }
  }
#pragma unroll
  for (int m = 0; m < 4; ++m)
#pragma unroll
    for (int n = 0; n < 4; ++n) {
      if (SWAP) epi(m0 + wr * 64 + m * 16 + fr, n0 + wc * 64 + n * 16 + fq * 4, acc[m][n]);
      else epi(m0 + wr * 64 + m * 16 + fq * 4, n0 + wc * 64 + n * 16 + fr, acc[m][n]);
    }
}

__device__ __forceinline__ void transpose_item(const float* __restrict__ W, int K, int N, bf16_t* __restrict__ WT, int tile, int ntn, char* smem) {
  float* s = (float*)smem;
  const int tk = tile / ntn, tn = tile % ntn, tid = ltid();
  const int k0 = tk * 64, n0 = tn * 64;
  __syncthreads();
  {
    const int r = tid >> 4, c4 = (tid & 15) * 4;
#pragma unroll
    for (int i = 0; i < 4; ++i) {
      const int k = r + 16 * i;
      float4 v = make_float4(0.f, 0.f, 0.f, 0.f);
      if (n0 + c4 < N) v = *(const float4*)(W + (size_t)(k0 + k) * N + n0 + c4);
      s[k * 65 + c4 + 0] = v.x; s[k * 65 + c4 + 1] = v.y; s[k * 65 + c4 + 2] = v.z; s[k * 65 + c4 + 3] = v.w;
    }
  }
  __syncthreads();
  {
    const int n = tid >> 2, kc = (tid & 3) * 16;
    unsigned o[8];
#pragma unroll
    for (int i = 0; i < 8; ++i) o[i] = pack2(s[(kc + 2 * i) * 65 + n], s[(kc + 2 * i + 1) * 65 + n]);
    uint4* dst = (uint4*)(WT + (size_t)(n0 + n) * K + k0 + kc);
    dst[0] = make_uint4(o[0], o[1], o[2], o[3]);
    dst[1] = make_uint4(o[4], o[5], o[6], o[7]);
  }
}

__device__ __forceinline__ void mod_item(const Params& p, int item, char* smem) {
  float* s = (float*)smem;
  float* red = s + 3072;
  const int tid = ltid();
  __syncthreads();
  for (int e = tid; e < 3072; e += 256) {
    const int v = e >> 10, k = e & 1023;
    const float x = (v == 0) ? p.c_ctx[k] : p.c[(v - 1) * D + k];
    s[e] = x / (1.f + __expf(-x));
  }
  __syncthreads();
  const int jl = tid & 63, kq = tid >> 6, j = item * 64 + jl, k0 = kq * 256;
  float a0 = 0.f, a1 = 0.f, a2 = 0.f;
#pragma unroll 8
  for (int k = 0; k < 256; ++k) {
    const float w = p.w_ada[(size_t)(k0 + k) * 6144 + j];
    a0 += s[k0 + k] * w; a1 += s[1024 + k0 + k] * w; a2 += s[2048 + k0 + k] * w;
  }
  red[(kq * 3 + 0) * 64 + jl] = a0; red[(kq * 3 + 1) * 64 + jl] = a1; red[(kq * 3 + 2) * 64 + jl] = a2;
  __syncthreads();
  if (tid < 192) {
    const int v = tid >> 6;
    const float r = red[(0 * 3 + v) * 64 + jl] + red[(1 * 3 + v) * 64 + jl] + red[(2 * 3 + v) * 64 + jl] + red[(3 * 3 + v) * 64 + jl];
    ((float*)(p.ws + OFF_MOD))[v * 6144 + j] = r + p.b_ada[j];
  }
}

__device__ __forceinline__ void filter_item(const Params& p, int item, char* smem) {
  int n, p0; bf16_t* R;
  if (item < 256) { n = 4096; p0 = item * 16; R = (bf16_t*)(p.ws + OFF_RLAT); }
  else { n = 256; p0 = (item - 256) * 16; R = (bf16_t*)(p.ws + OFF_RCTX); }
  const int n2 = 2 * n, tid = ltid();
  float* z = (float*)smem;
  float* h1 = z + 16 * 36;
  float* h2 = h1 + 16 * 64;
  __syncthreads();
#pragma unroll 1
  for (int e = tid; e < 16 * 33; e += 256) {
    const int pp = e / 33, f = e % 33, pos = p0 + pp;
    float val;
    if (f == 0) val = (float)pos / (float)(n - 1);
    else {
      const int k = (f - 1) & 15;
      const float band = 1e-4f + (float)k * ((15.f - 1e-4f) / 15.f);
      const float turns = band * ((float)pos / (float)n);
      val = (f <= 16) ? cos_turns(turns) : -sin_turns(turns);
    }
    z[pp * 36 + f] = val;
  }
  __syncthreads();
#pragma unroll 1
  for (int e = tid; e < 1024; e += 256) {
    const int pp = e >> 6, j = e & 63;
    float a = p.filt_b1[j];
#pragma unroll 3
    for (int f = 0; f < 33; ++f) a += z[pp * 36 + f] * p.filt_w1[f * 64 + j];
    h1[e] = sin_rad(p.filt_freq1[j] * a);
  }
  __syncthreads();
#pragma unroll 1
  for (int e = tid; e < 1024; e += 256) {
    const int pp = e >> 6, j = e & 63;
    float a = p.filt_b2[j];
#pragma unroll 4
    for (int k = 0; k < 64; ++k) a += h1[pp * 64 + k] * p.filt_w2[k * 64 + j];
    h2[j * 16 + pp] = sin_rad(p.filt_freq2[j] * a);
  }
  __syncthreads();
  const float mind = -3.0701134573253946f, maxd = -15.350567286626973f;
#pragma unroll 1
  for (int ci = 0; ci < 8; ++ci) {
    const int col = tid + 256 * ci, o = col >> 10, dir = (col >> 9) & 1, c = col & 511;
    float acc[16];
#pragma unroll
    for (int i = 0; i < 16; ++i) acc[i] = 0.f;
#pragma unroll 4
    for (int k = 0; k < 64; ++k) {
      const float w = p.filt_w3[k * 2048 + col];
      const float4 ha = *(const float4*)(h2 + k * 16), hb = *(const float4*)(h2 + k * 16 + 4), hc = *(const float4*)(h2 + k * 16 + 8), hd = *(const float4*)(h2 + k * 16 + 12);
      acc[0] += ha.x * w; acc[1] += ha.y * w; acc[2] += ha.z * w; acc[3] += ha.w * w;
      acc[4] += hb.x * w; acc[5] += hb.y * w; acc[6] += hb.z * w; acc[7] += hb.w * w;
      acc[8] += hc.x * w; acc[9] += hc.y * w; acc[10] += hc.z * w; acc[11] += hc.w * w;
      acc[12] += hd.x * w; acc[13] += hd.y * w; acc[14] += hd.z * w; acc[15] += hd.w * w;
    }
    const float delta = fabsf(mind + (float)c * ((maxd - mind) / 511.f));
    bf16_t* Rrow = R + (size_t)(o * 512 + c) * n2;
#pragma unroll
    for (int i = 0; i < 16; ++i) {
      const int pos = p0 + i;
      const float t = (float)pos / (float)(n - 1);
      float val = acc[i] * (__expf(-t * delta) + 0.05f);
      int idx = dir == 0 ? (n - 1 - pos) : (n - 1 + pos);
      if (dir == 1 && pos == 0) { idx = n2 - 1; val = 0.f; }
      Rrow[idx] = f2bf(val);
    }
  }
}

__device__ __forceinline__ void cache_item(const Params& p, int item) {
  const int tid = ltid(), r0 = item * 32;
  bf16_t* ckvn = (bf16_t*)(p.ws + OFF_CKVN);
#pragma unroll 2
  for (int e = tid; e < 32 * 64; e += 256) {
    const int r = r0 + (e >> 6), c4 = (e & 63) * 4;
    const float4 v = *(const float4*)(p.cache_ckv + (size_t)r * 256 + c4);
    *(uint2*)(ckvn + (size_t)(NTOK + r) * 256 + c4) = make_uint2(pack2(v.x, v.y), pack2(v.z, v.w));
  }
}

template <int WHICH>
__device__ __forceinline__ void rmsmod_phase(const Params& p) {
  const int tid = ltid(), lane = tid & 63, wid = tid >> 6;
  const int gw = blockIdx.x * 4 + wid, tw = gridDim.x * 4;
  const float* g = WHICH == 0 ? p.g_mix : p.g_ffn;
  const float* mod = (const float*)(p.ws + OFF_MOD);
  bf16_t* h = (bf16_t*)(p.ws + OFF_H);
  for (int row = gw; row < NTOK; row += tw) {
    const float* src = WHICH == 0 ? xrow(p, row) : p.out + (size_t)row * D;
    float4 v[4];
    float ss = 0.f;
#pragma unroll
    for (int i = 0; i < 4; ++i) {
      v[i] = ((const float4*)src)[lane + 64 * i];
      ss += v[i].x * v[i].x + v[i].y * v[i].y + v[i].z * v[i].z + v[i].w * v[i].w;
    }
    ss = wave_sum(ss);
    const float r = rsqrtf(ss * (1.f / 1024.f) + 1e-6f);
    const float* mv = mod + modidx(row) * 6144 + (WHICH == 0 ? 0 : 3 * 1024);
#pragma unroll
    for (int i = 0; i < 4; ++i) {
      const int e = 4 * (lane + 64 * i);
      const float4 g4 = *(const float4*)(g + e), sh = *(const float4*)(mv + e), sc = *(const float4*)(mv + 1024 + e);
      const float y0 = v[i].x * r * g4.x * (1.f + sc.x) + sh.x, y1 = v[i].y * r * g4.y * (1.f + sc.y) + sh.y;
      const float y2 = v[i].z * r * g4.z * (1.f + sc.z) + sh.z, y3 = v[i].w * r * g4.w * (1.f + sc.w) + sh.w;
      *(uint2*)(h + (size_t)row * D + e) = make_uint2(pack2(y0, y1), pack2(y2, y3));
    }
  }
}

struct EpiIn {
  float* proj; bf16_t* hyT;
  __device__ __forceinline__ void operator()(int row0, int col, const f32x4& v) const {
    if (col < 672) {
#pragma unroll
      for (int j = 0; j < 4; ++j) proj[(size_t)(row0 + j) * 672 + col] = v[j];
    } else if (col < DIN) {
      *(uint2*)(hyT + (size_t)(col - 672) * NTOK + row0) = make_uint2(pack2(v[0], v[1]), pack2(v[2], v[3]));
    }
  }
};
struct EpiQ {
  bf16_t* q;
  __device__ __forceinline__ void operator()(int row, int col0, const f32x4& v) const {
    *(uint2*)(q + (size_t)row * 768 + col0) = make_uint2(pack2(v[0], v[1]), pack2(v[2], v[3]));
  }
};
struct EpiKV {
  bf16_t *kraw, *vtc, *vtl;
  __device__ __forceinline__ void operator()(int row0, int col, const f32x4& v) const {
    const int head = col >> 7, cc = col & 127;
    if (cc < 64) {
#pragma unroll
      for (int j = 0; j < 4; ++j) kraw[(size_t)(row0 + j) * 512 + head * 64 + cc] = f2bf(v[j]);
    } else {
      const int dv = cc - 64;
      bf16_t* dst;
      if (row0 < NCTX) dst = vtc + ((size_t)((row0 >> 8) * 8 + head) * 64 + dv) * 256 + (row0 & 255);
      else if (row0 < NTOK) { const int r = row0 - NCTX; dst = vtl + ((size_t)((r >> 12) * 8 + head) * 64 + dv) * 4608 + (r & 4095); }
      else { const int r = row0 - NTOK; dst = vtl + ((size_t)((r >> 9) * 8 + head) * 64 + dv) * 4608 + 4096 + (r & 511); }
      *(uint2*)dst = make_uint2(pack2(v[0], v[1]), pack2(v[2], v[3]));
    }
  }
};
struct EpiOut {
  const Params* p;
  __device__ __forceinline__ void operator()(int row, int col0, const f32x4& v) const {
    const float4 x = *(const float4*)(xrow(*p, row) + col0);
    const float4 m = *(const float4*)((const float*)(p->ws + OFF_MOD) + modidx(row) * 6144 + 2 * 1024 + col0);
    *(float4*)(p->out + (size_t)row * D + col0) = make_float4(x.x + m.x * v[0], x.y + m.y * v[1], x.z + m.z * v[2], x.w + m.w * v[3]);
  }
};
struct EpiU {
  bf16_t* u;
  __device__ __forceinline__ void operator()(int row, int col0, const f32x4& v) const {
    *(uint2*)(u + (size_t)row * 5632 + col0) = make_uint2(pack2(v[0], v[1]), pack2(v[2], v[3]));
  }
};
struct EpiY {
  const Params* p; int half;
  __device__ __forceinline__ void operator()(int row, int col0, const f32x4& v) const {
    const int grow = half * 8192 + row;
    float4* dst = (float4*)(p->out + (size_t)grow * D + col0);
    const float4 x = *dst;
    const float4 m = *(const float4*)((const float*)(p->ws + OFF_MOD) + modidx(grow) * 6144 + 5 * 1024 + col0);
    *dst = make_float4(x.x + m.x * v[0], x.y + m.y * v[1], x.z + m.z * v[2], x.w + m.w * v[3]);
  }
};

__device__ __forceinline__ void token_item(const Params& p, int item) {
  const int tid = ltid(), lane = tid & 63, wid = tid >> 6;
  const float* proj = (const float*)(p.ws + OFF_PROJ);
  bf16_t* qa = (bf16_t*)(p.ws + OFF_QA);
  bf16_t* ckvn = (bf16_t*)(p.ws + OFF_CKVN);
  float* kpe = (float*)(p.ws + OFF_KPE);
  for (int tt = 0; tt < 16; ++tt) {
    const int token = item * 64 + wid * 16 + tt;
    const float* pr = proj + (size_t)token * 672;
    float2 q[3];
    float ss = 0.f;
#pragma unroll
    for (int i = 0; i < 3; ++i) { q[i] = *(const float2*)(pr + lane * 2 + 128 * i); ss += q[i].x * q[i].x + q[i].y * q[i].y; }
    ss = wave_sum(ss);
    const float r = rsqrtf(ss * (1.f / 384.f) + 1e-6f);
#pragma unroll
    for (int i = 0; i < 3; ++i) {
      const int e = lane * 2 + 128 * i;
      *(unsigned*)(qa + (size_t)token * 384 + e) = pack2(q[i].x * r * p.g_qa[e], q[i].y * r * p.g_qa[e + 1]);
    }
    const float4 kv = *(const float4*)(pr + 384 + lane * 4);
    float s2 = wave_sum(kv.x * kv.x + kv.y * kv.y + kv.z * kv.z + kv.w * kv.w);
    const float r2 = rsqrtf(s2 * (1.f / 256.f) + 1e-6f);
    const float4 g = *(const float4*)(p.g_kva + lane * 4);
    const float4 y = make_float4(kv.x * r2 * g.x, kv.y * r2 * g.y, kv.z * r2 * g.z, kv.w * r2 * g.w);
    *(uint2*)(ckvn + (size_t)token * 256 + lane * 4) = make_uint2(pack2(y.x, y.y), pack2(y.z, y.w));
    if (token < NCTX) *(float4*)(p.out + OUT_CKV + (size_t)token * 256 + lane * 4) = y;
    if (lane < 32) {
      const float kp = pr[640 + lane];
      kpe[(size_t)token * 32 + lane] = kp;
      if (token < NCTX) p.out[OUT_KPE + (size_t)token * 32 + lane] = kp;
    }
  }
}

template <int ORDER>
__device__ __forceinline__ void hyena_item(const Params& p, int grp, int c, char* smem) {
  const int tid = ltid(), lane = tid & 63, wid = tid >> 6, fr = lane & 15, fq = lane >> 4;
  const int n = grp ? SEQL : SEQC, nb = n >> 6, L = n;
  const bf16_t* Rrow = (const bf16_t*)(p.ws + (grp ? OFF_RLAT : OFF_RCTX)) + (size_t)(ORDER * 512 + c) * (2 * n);
  const bf16_t* hyT = (const bf16_t*)(p.ws + OFF_HYT);
  bf16_t* sU = (bf16_t*)smem;
  unsigned* sR0 = (unsigned*)(smem + 18432);
  unsigned* sR1 = (unsigned*)(smem + 18432 + 16384);
  const int tok0 = grp * 8192;
  __syncthreads();
  for (int ch = tid; ch < (2 * n) / 8; ch += 256) *(uint4*)((bf16_t*)sR0 + ch * 8) = *(const uint4*)(Rrow + ch * 8);
  if (ORDER == 0) {
    const bf16_t* raw = hyT + (size_t)c * NTOK + tok0;
    const float w0 = p.hy_conv_w[c], w1 = p.hy_conv_w[1536 + c], w2 = p.hy_conv_w[3072 + c], b = p.hy_conv_b[c];
    for (int ch = tid; ch < 1024; ch += 256) {
      const int t = ch * 8, pos = t & (L - 1);
      const uint4 rv = *(const uint4*)(raw + t);
      float x[10];
      x[0] = pos == 0 ? 0.f : bf2f(raw[t - 1]);
      x[1] = bflo(rv.x); x[2] = bfhi(rv.x); x[3] = bflo(rv.y); x[4] = bfhi(rv.y);
      x[5] = bflo(rv.z); x[6] = bfhi(rv.z); x[7] = bflo(rv.w); x[8] = bfhi(rv.w);
      x[9] = (pos + 8 == L) ? 0.f : bf2f(raw[t + 8]);
      float u[8];
#pragma unroll
      for (int i = 0; i < 8; ++i) u[i] = w0 * x[i] + w1 * x[i + 1] + w2 * x[i + 2] + b;
      *(uint4*)(sU + (ch >> 3) * 72 + (ch & 7) * 8) = make_uint4(pack2(u[0], u[1]), pack2(u[2], u[3]), pack2(u[4], u[5]), pack2(u[6], u[7]));
    }
  } else {
    const bf16_t* zr = (const bf16_t*)(p.ws + OFF_ZT) + (size_t)c * NTOK + tok0;
    for (int ch = tid; ch < 1024; ch += 256) *(uint4*)(sU + (ch >> 3) * 72 + (ch & 7) * 8) = *(const uint4*)(zr + ch * 8);
  }
  __syncthreads();
  for (int k = tid; k < n; k += 256) {
    const unsigned a = sR0[k], b2 = (k + 1 < n) ? sR0[k + 1] : 0u;
    sR1[k] = (a >> 16) | (b2 << 16);
  }
  __syncthreads();

  f32x4 acc[4][2];
#pragma unroll
  for (int m = 0; m < 4; ++m) { acc[m][0] = (f32x4){0.f, 0.f, 0.f, 0.f}; acc[m][1] = (f32x4){0.f, 0.f, 0.f, 0.f}; }
  const unsigned* abase = (fr & 1) ? (sR0 + ((n - 1 - fr) >> 1) + 4 * fq) : (sR1 + ((n - 2 - fr) >> 1) + 4 * fq);
  const int col0 = 32 * wid + fr, col1 = col0 + 16;
  const int i0 = col0 & (nb - 1), i1 = col1 & (nb - 1);
  for (int d = -(nb - 1); d <= nb - 1; ++d) {
    const bool v0 = (unsigned)(i0 - d) < (unsigned)nb, v1 = (unsigned)(i1 - d) < (unsigned)nb;
    const bool any0 = __ballot(v0) != 0ull, any1 = __ballot(v1) != 0ull;
    if (!any0 && !any1) continue;
    bf16x8 F[6];
    const unsigned* ap = abase - 32 * d + 16;
#pragma unroll
    for (int idx = 0; idx < 6; ++idx) {
      const unsigned* q = ap - 8 * idx;
      union { unsigned u[4]; bf16x8 v; } cv;
      cv.u[0] = q[0]; cv.u[1] = q[1]; cv.u[2] = q[2]; cv.u[3] = q[3];
      F[idx] = cv.v;
    }
#pragma unroll
    for (int nt = 0; nt < 2; ++nt) {
      if (!(nt ? any1 : any0)) continue;
      const bool vv = nt ? v1 : v0;
      const bf16_t* up = sU + ((nt ? col1 : col0) - d) * 72 + fq * 8;
#pragma unroll
      for (int ks = 0; ks < 2; ++ks) {
        bf16x8 bf = (bf16x8){0, 0, 0, 0, 0, 0, 0, 0};
        if (vv) bf = *(const bf16x8*)(up + ks * 32);
#pragma unroll
        for (int m = 0; m < 4; ++m)
          acc[m][nt] = __builtin_amdgcn_mfma_f32_16x16x32_bf16(F[m + 2 - 2 * ks], bf, acc[m][nt], 0, 0, 0);
      }
    }
  }
  const float skip = p.filt_bias[ORDER * 512 + c];
  const int gcol = (ORDER == 0 ? 512 : 1024) + c;
  const bf16_t* graw = hyT + (size_t)gcol * NTOK + tok0;
  const float w0 = p.hy_conv_w[gcol], w1 = p.hy_conv_w[1536 + gcol], w2 = p.hy_conv_w[3072 + gcol], b = p.hy_conv_b[gcol];
  bf16_t* outT = (bf16_t*)(p.ws + (ORDER == 0 ? OFF_ZT : OFF_Y2T)) + (size_t)c * NTOK + tok0;
#pragma unroll
  for (int nt = 0; nt < 2; ++nt) {
    const int col = nt ? col1 : col0;
#pragma unroll
    for (int m = 0; m < 4; ++m) {
      const int t = col * 64 + 16 * m + 4 * fq, pos = t & (L - 1);
      const uint2 uu = *(const uint2*)(sU + col * 72 + 16 * m + 4 * fq);
      const uint2 gv = *(const uint2*)(graw + t);
      float x[6];
      x[0] = pos == 0 ? 0.f : bf2f(graw[t - 1]);
      x[1] = bflo(gv.x); x[2] = bfhi(gv.x); x[3] = bflo(gv.y); x[4] = bfhi(gv.y);
      x[5] = (pos + 4 == L) ? 0.f : bf2f(graw[t + 4]);
      const float u4[4] = {bflo(uu.x), bfhi(uu.x), bflo(uu.y), bfhi(uu.y)};
      float o[4];
#pragma unroll
      for (int j = 0; j < 4; ++j) {
        const float gate = w0 * x[j] + w1 * x[j + 1] + w2 * x[j + 2] + b;
        o[j] = gate * (acc[m][nt][j] + skip * u4[j]);
      }
      *(uint2*)(outT + t) = make_uint2(pack2(o[0], o[1]), pack2(o[2], o[3]));
    }
  }
}

__device__ __forceinline__ void rope32(float* y  , int pos) {
  const float prow = (float)(pos >> 6), pcol = (float)(pos & 63);
  const float fr[8] = {1.f, 0.31622776601683794f, 0.1f, 0.031622776601683794f, 0.01f, 0.0031622776601683794f, 0.001f, 0.00031622776601683794f};
#pragma unroll
  for (int i = 0; i < 8; ++i) {
    const float tr = prow * fr[i] * 0.15915494309189535f, tc = pcol * fr[i] * 0.15915494309189535f;
    const float sr = sin_turns(tr), cr = cos_turns(tr), sc = sin_turns(tc), cc = cos_turns(tc);
    const float a = y[i], b = y[8 + i], c2 = y[16 + i], d2 = y[24 + i];
    y[i] = a * cr - b * sr; y[8 + i] = b * cr + a * sr;
    y[16 + i] = c2 * cc - d2 * sc; y[24 + i] = d2 * cc + c2 * sc;
  }
}
__device__ __forceinline__ void unpack8(const uint4& v, float* x) {
  x[0] = bflo(v.x); x[1] = bfhi(v.x); x[2] = bflo(v.y); x[3] = bfhi(v.y);
  x[4] = bflo(v.z); x[5] = bfhi(v.z); x[6] = bflo(v.w); x[7] = bfhi(v.w);
}
__device__ __forceinline__ float sumsq8(const uint4& v) {
  float x[8];
  unpack8(v, x);
  return x[0] * x[0] + x[1] * x[1] + x[2] * x[2] + x[3] * x[3] + x[4] * x[4] + x[5] * x[5] + x[6] * x[6] + x[7] * x[7];
}
__device__ __forceinline__ uint4 scale8(const uint4& v, float r, const float* __restrict__ g) {
  float x[8];
  unpack8(v, x);
  const float4 g0 = *(const float4*)g, g1 = *(const float4*)(g + 4);
  return make_uint4(pack2(x[0] * r * g0.x, x[1] * r * g0.y), pack2(x[2] * r * g0.z, x[3] * r * g0.w),
                    pack2(x[4] * r * g1.x, x[5] * r * g1.y), pack2(x[6] * r * g1.z, x[7] * r * g1.w));
}
__device__ __forceinline__ void qk_item(const Params& p, int item) {
  const int tid = ltid();
  if (item < 512) {
    const int idx = item * 256 + tid, row = idx >> 3, h = idx & 7;
    const bf16_t* src = (const bf16_t*)(p.ws + OFF_QRAW) + (size_t)row * 768 + h * 96;
    bf16_t* dst = (bf16_t*)(p.ws + OFF_Q) + (size_t)row * 768 + h * 96;
    uint4 raw[12];
#pragma unroll
    for (int i = 0; i < 12; ++i) raw[i] = *(const uint4*)(src + 8 * i);
    float ss = 0.f;
#pragma unroll
    for (int i = 0; i < 12; ++i) ss += sumsq8(raw[i]);
    const float r = rsqrtf(ss * (1.f / 96.f) + 1e-6f);
    const float qs = 0.10206207261596575f * 1.4426950408889634f;
#pragma unroll
    for (int i = 0; i < 8; ++i) *(uint4*)(dst + 8 * i) = scale8(raw[i], r * qs, p.g_q + 8 * i);
    float y[32];
#pragma unroll
    for (int i = 0; i < 4; ++i) unpack8(raw[8 + i], y + 8 * i);
#pragma unroll
    for (int i = 0; i < 32; ++i) y[i] = y[i] * r * p.g_q[64 + i];
    if (row >= NCTX) rope32(y, (row - NCTX) & 4095);
#pragma unroll
    for (int i = 0; i < 4; ++i)
      *(uint4*)(dst + 64 + 8 * i) = make_uint4(pack2(y[8 * i] * qs, y[8 * i + 1] * qs), pack2(y[8 * i + 2] * qs, y[8 * i + 3] * qs),
                                               pack2(y[8 * i + 4] * qs, y[8 * i + 5] * qs), pack2(y[8 * i + 6] * qs, y[8 * i + 7] * qs));
  } else {
    const int idx = (item - 512) * 256 + tid, row = idx >> 3, h = idx & 7;
    const bf16_t* src = (const bf16_t*)(p.ws + OFF_KRAW) + (size_t)row * 512 + h * 64;
    uint4 raw[8];
#pragma unroll
    for (int i = 0; i < 8; ++i) raw[i] = *(const uint4*)(src + 8 * i);
    const float* kp = row < NTOK ? (const float*)(p.ws + OFF_KPE) + (size_t)row * 32 : p.cache_kpe + (size_t)(row - NTOK) * 32;
    float y[32];
#pragma unroll
    for (int i = 0; i < 8; ++i) {
      const float4 v = *(const float4*)(kp + 4 * i);
      y[4 * i] = v.x; y[4 * i + 1] = v.y; y[4 * i + 2] = v.z; y[4 * i + 3] = v.w;
    }
    float ss = 0.f;
#pragma unroll
    for (int i = 0; i < 8; ++i) ss += sumsq8(raw[i]);
#pragma unroll
    for (int i = 0; i < 32; ++i) ss += y[i] * y[i];
    const float r = rsqrtf(ss * (1.f / 96.f) + 1e-6f);
#pragma unroll
    for (int i = 0; i < 32; ++i) y[i] = y[i] * r * p.g_k[64 + i];
    bf16_t* dst;
    if (row < NCTX) dst = (bf16_t*)(p.ws + OFF_KC) + ((size_t)((row >> 8) * 8 + h) * 256 + (row & 255)) * 96;
    else if (row < NTOK) {
      const int rr = row - NCTX;
      rope32(y, rr & 4095);
      dst = (bf16_t*)(p.ws + OFF_KL) + ((size_t)((rr >> 12) * 8 + h) * 4608 + (rr & 4095)) * 96;
    } else {
      const int rr = row - NTOK;
      dst = (bf16_t*)(p.ws + OFF_KL) + ((size_t)((rr >> 9) * 8 + h) * 4608 + 4096 + (rr & 511)) * 96;
    }
#pragma unroll
    for (int i = 0; i < 8; ++i) *(uint4*)(dst + 8 * i) = scale8(raw[i], r, p.g_k + 8 * i);
#pragma unroll
    for (int i = 0; i < 4; ++i)
      *(uint4*)(dst + 64 + 8 * i) = make_uint4(pack2(y[8 * i], y[8 * i + 1]), pack2(y[8 * i + 2], y[8 * i + 3]),
                                               pack2(y[8 * i + 4], y[8 * i + 5]), pack2(y[8 * i + 6], y[8 * i + 7]));
  }
}

__device__ __forceinline__ void attn_item(const Params& p, int item, char* smem) {
  const int tid = ltid(), lane = tid & 63, wid = tid >> 6, lr = lane & 31, lh = lane >> 5;
  int nkeys, h, tokbase; const bf16_t *Kp, *Vp;
  if (item < 512) {
    const int b = item >> 8, rem = item & 255; h = rem >> 5; const int qb = rem & 31;
    nkeys = 4608; tokbase = NCTX + b * 4096 + qb * 128;
    Kp = (const bf16_t*)(p.ws + OFF_KL) + (size_t)(b * 8 + h) * 4608 * 96;
    Vp = (const bf16_t*)(p.ws + OFF_VTL) + (size_t)(b * 8 + h) * 64 * 4608;
  } else {
    const int it = item - 512, b = it >> 4; h = (it & 15) >> 1; const int qb = it & 1;
    nkeys = 256; tokbase = b * 256 + qb * 128;
    Kp = (const bf16_t*)(p.ws + OFF_KC) + (size_t)(b * 8 + h) * 256 * 96;
    Vp = (const bf16_t*)(p.ws + OFF_VTC) + (size_t)(b * 8 + h) * 64 * 256;
  }
  bf16_t* sK = (bf16_t*)smem;
  bf16_t* sV = sK + 64 * 104;
  const int token = tokbase + 32 * wid + lr;
  const bf16_t* qsrc = (const bf16_t*)(p.ws + OFF_Q) + (size_t)token * 768 + h * 96 + 8 * lh;
  bf16x8 qf[6];
#pragma unroll
  for (int ks = 0; ks < 6; ++ks) qf[ks] = *(const bf16x8*)(qsrc + 16 * ks);
  f32x16 oacc[2];
#pragma unroll
  for (int j = 0; j < 16; ++j) { oacc[0][j] = 0.f; oacc[1][j] = 0.f; }
  float mrun = -1e30f, lsum = 0.f;
  const int kk0 = tid / 12, kc0 = tid % 12, kk1 = (tid + 256) / 12, kc1 = (tid + 256) % 12, kk2 = (tid + 512) / 12, kc2 = (tid + 512) % 12;
  const int vd0 = tid >> 3, vc0 = tid & 7, vd1 = vd0 + 32;
  const bf16_t* gk0 = Kp + (size_t)kk0 * 96 + kc0 * 8;
  const bf16_t* gk1 = Kp + (size_t)kk1 * 96 + kc1 * 8;
  const bf16_t* gk2 = Kp + (size_t)kk2 * 96 + kc2 * 8;
  const bf16_t* gv0 = Vp + (size_t)vd0 * nkeys + vc0 * 8;
  const bf16_t* gv1 = Vp + (size_t)vd1 * nkeys + vc0 * 8;
  uint4 rk0 = *(const uint4*)gk0, rk1 = *(const uint4*)gk1, rk2 = *(const uint4*)gk2;
  uint4 rv0 = *(const uint4*)gv0, rv1 = *(const uint4*)gv1;
  const int nt = nkeys >> 6;
  for (int kt = 0; kt < nt; ++kt) {
    __syncthreads();
    *(uint4*)(sK + kk0 * 104 + kc0 * 8) = rk0; *(uint4*)(sK + kk1 * 104 + kc1 * 8) = rk1; *(uint4*)(sK + kk2 * 104 + kc2 * 8) = rk2;
    *(uint4*)(sV + vd0 * 72 + vc0 * 8) = rv0; *(uint4*)(sV + vd1 * 72 + vc0 * 8) = rv1;
    __syncthreads();
    if (kt + 1 < nt) {
      gk0 += 64 * 96; gk1 += 64 * 96; gk2 += 64 * 96; gv0 += 64; gv1 += 64;
      rk0 = *(const uint4*)gk0; rk1 = *(const uint4*)gk1; rk2 = *(const uint4*)gk2;
      rv0 = *(const uint4*)gv0; rv1 = *(const uint4*)gv1;
    }
    f32x16 sacc[2];
#pragma unroll
    for (int kb = 0; kb < 2; ++kb) {
#pragma unroll
      for (int j = 0; j < 16; ++j) sacc[kb][j] = 0.f;
#pragma unroll
      for (int ks = 0; ks < 6; ++ks) {
        const bf16x8 a = *(const bf16x8*)(sK + (32 * kb + lr) * 104 + 16 * ks + 8 * lh);
        sacc[kb] = __builtin_amdgcn_mfma_f32_32x32x16_bf16(a, qf[ks], sacc[kb], 0, 0, 0);
      }
    }
    float mx = sacc[0][0];
#pragma unroll
    for (int j = 1; j < 16; ++j) mx = fmaxf(mx, sacc[0][j]);
#pragma unroll
    for (int j = 0; j < 16; ++j) mx = fmaxf(mx, sacc[1][j]);
    mx = fmaxf(mx, __shfl_xor(mx, 32));
    const float mnew = fmaxf(mrun, mx);
    const float alpha = __builtin_amdgcn_exp2f(mrun - mnew);
    mrun = mnew;
    float ps = 0.f;
#pragma unroll
    for (int kb = 0; kb < 2; ++kb)
#pragma unroll
      for (int j = 0; j < 16; ++j) { const float e = __builtin_amdgcn_exp2f(sacc[kb][j] - mnew); sacc[kb][j] = e; ps += e; }
    lsum = lsum * alpha + ps;
#pragma unroll
    for (int j = 0; j < 16; ++j) { oacc[0][j] *= alpha; oacc[1][j] *= alpha; }
#pragma unroll
    for (int s = 0; s < 4; ++s) {
      const int kb = s >> 1, jb = 8 * (s & 1);
      union { unsigned u[4]; bf16x8 v; } pf;
      pf.u[0] = pack2(sacc[kb][jb + 0], sacc[kb][jb + 1]); pf.u[1] = pack2(sacc[kb][jb + 2], sacc[kb][jb + 3]);
      pf.u[2] = pack2(sacc[kb][jb + 4], sacc[kb][jb + 5]); pf.u[3] = pack2(sacc[kb][jb + 6], sacc[kb][jb + 7]);
#pragma unroll
      for (int mt = 0; mt < 2; ++mt) {
        const bf16_t* vp = sV + (32 * mt + lr) * 72 + 16 * s + 4 * lh;
        union { uint2 d[2]; bf16x8 v; } av;
        av.d[0] = *(const uint2*)vp;
        av.d[1] = *(const uint2*)(vp + 8);
        oacc[mt] = __builtin_amdgcn_mfma_f32_32x32x16_bf16(av.v, pf.v, oacc[mt], 0, 0, 0);
      }
    }
  }
  lsum += __shfl_xor(lsum, 32);
  const float inv = 1.f / lsum;
  bf16_t* dst = (bf16_t*)(p.ws + OFF_ATTN) + (size_t)token * 512 + h * 64;
#pragma unroll
  for (int mt = 0; mt < 2; ++mt)
#pragma unroll
    for (int jg = 0; jg < 4; ++jg) {
      const int dv0 = 32 * mt + 8 * jg + 4 * lh;
      *(uint2*)(dst + dv0) = make_uint2(pack2(oacc[mt][4 * jg] * inv, oacc[mt][4 * jg + 1] * inv),
                                        pack2(oacc[mt][4 * jg + 2] * inv, oacc[mt][4 * jg + 3] * inv));
    }
}

__device__ __forceinline__ void merge_item(const Params& p, int item, char* smem) {
  const int tid = ltid(), lane = tid & 63, wid = tid >> 6, t0 = item * 32;
  bf16_t* mix = (bf16_t*)(p.ws + OFF_H);
  const bf16_t* attn = (const bf16_t*)(p.ws + OFF_ATTN);
  for (int tt = 0; tt < 8; ++tt) {
    const int token = t0 + wid * 8 + tt;
    float x[8];
    unpack8(*(const uint4*)(attn + (size_t)token * 512 + lane * 8), x);
    float ss = 0.f;
#pragma unroll
    for (int i = 0; i < 8; ++i) ss += x[i] * x[i];
    ss = wave_sum(ss);
    const float r = rsqrtf(ss * (1.f / 512.f) + 1e-6f);
    const float4 g0 = *(const float4*)(p.g_out_att + lane * 8), g1 = *(const float4*)(p.g_out_att + lane * 8 + 4);
    *(uint4*)(mix + (size_t)token * D + lane * 8) =
        make_uint4(pack2(x[0] * r * g0.x, x[1] * r * g0.y), pack2(x[2] * r * g0.z, x[3] * r * g0.w),
                   pack2(x[4] * r * g1.x, x[5] * r * g1.y), pack2(x[6] * r * g1.z, x[7] * r * g1.w));
  }
  bf16_t* sT = (bf16_t*)smem;
  const bf16_t* y2T = (const bf16_t*)(p.ws + OFF_Y2T);
  __syncthreads();
  for (int ch = tid; ch < 2048; ch += 256) {
    const int c = ch >> 2, q4 = ch & 3;
    const uint4 v = *(const uint4*)(y2T + (size_t)c * NTOK + t0 + q4 * 8);
    bf16_t* d = sT + (q4 * 8) * 520 + c;
    d[0 * 520] = (bf16_t)(v.x & 0xffff); d[1 * 520] = (bf16_t)(v.x >> 16);
    d[2 * 520] = (bf16_t)(v.y & 0xffff); d[3 * 520] = (bf16_t)(v.y >> 16);
    d[4 * 520] = (bf16_t)(v.z & 0xffff); d[5 * 520] = (bf16_t)(v.z >> 16);
    d[6 * 520] = (bf16_t)(v.w & 0xffff); d[7 * 520] = (bf16_t)(v.w >> 16);
  }
  __syncthreads();
  {
    const int tt = tid >> 3, part = tid & 7;
    uint4 v[8];
    float ss = 0.f;
#pragma unroll
    for (int i = 0; i < 8; ++i) {
      v[i] = *(const uint4*)(sT + tt * 520 + part * 64 + 8 * i);
      float x[8];
      unpack8(v[i], x);
#pragma unroll
      for (int e = 0; e < 8; ++e) ss += x[e] * x[e];
    }
    ss += __shfl_xor(ss, 1); ss += __shfl_xor(ss, 2); ss += __shfl_xor(ss, 4);
    const float r = rsqrtf(ss * (1.f / 512.f) + 1e-6f);
#pragma unroll
    for (int i = 0; i < 8; ++i) {
      float x[8];
      unpack8(v[i], x);
      const int c0 = part * 64 + 8 * i;
      const float4 g0 = *(const float4*)(p.g_out_hy + c0), g1 = *(const float4*)(p.g_out_hy + c0 + 4);
      *(uint4*)(mix + (size_t)(t0 + tt) * D + 512 + c0) =
          make_uint4(pack2(x[0] * r * g0.x, x[1] * r * g0.y), pack2(x[2] * r * g0.z, x[3] * r * g0.w),
                     pack2(x[4] * r * g1.x, x[5] * r * g1.y), pack2(x[6] * r * g1.z, x[7] * r * g1.w));
    }
  }
}

__device__ __forceinline__ void act_item(const Params& p, int item, int half) {
  const int idx = item * 256 + ltid();
  if (idx >= 1024 * 352) return;
  const int j = (idx % 352) * 8, r0 = (idx / 352) * 8;
  const int L = half ? SEQL : SEQC;
  const bf16_t* u = (const bf16_t*)(p.ws + OFF_U);
  bf16_t* act = (bf16_t*)(p.ws + OFF_ACT);
  float wa[3][8], wg[3][8], ba[8], bg[8];
#pragma unroll
  for (int t = 0; t < 3; ++t)
#pragma unroll
    for (int e = 0; e < 8; ++e) { wa[t][e] = p.ffn_conv_w[t * 5632 + j + e]; wg[t][e] = p.ffn_conv_w[t * 5632 + 2816 + j + e]; }
#pragma unroll
  for (int e = 0; e < 8; ++e) { ba[e] = p.ffn_conv_b[j + e]; bg[e] = p.ffn_conv_b[2816 + j + e]; }
  float pa[8], pg[8], ca[8], cg_[8], na[8], ng[8];
  if ((r0 & (L - 1)) == 0) {
#pragma unroll
    for (int e = 0; e < 8; ++e) { pa[e] = 0.f; pg[e] = 0.f; }
  } else {
    unpack8(*(const uint4*)(u + (size_t)(r0 - 1) * 5632 + j), pa);
    unpack8(*(const uint4*)(u + (size_t)(r0 - 1) * 5632 + 2816 + j), pg);
  }
  unpack8(*(const uint4*)(u + (size_t)r0 * 5632 + j), ca);
  unpack8(*(const uint4*)(u + (size_t)r0 * 5632 + 2816 + j), cg_);
#pragma unroll
  for (int i = 0; i < 8; ++i) {
    const int r = r0 + i;
    if (((r + 1) & (L - 1)) == 0) {
#pragma unroll
      for (int e = 0; e < 8; ++e) { na[e] = 0.f; ng[e] = 0.f; }
    } else {
      unpack8(*(const uint4*)(u + (size_t)(r + 1) * 5632 + j), na);
      unpack8(*(const uint4*)(u + (size_t)(r + 1) * 5632 + 2816 + j), ng);
    }
    float o[8];
#pragma unroll
    for (int e = 0; e < 8; ++e) {
      const float a = wa[0][e] * pa[e] + wa[1][e] * ca[e] + wa[2][e] * na[e] + ba[e];
      const float g = wg[0][e] * pg[e] + wg[1][e] * cg_[e] + wg[2][e] * ng[e] + bg[e];
      o[e] = a / (1.f + __expf(-a)) * g;
    }
    *(uint4*)(act + (size_t)r * 2816 + j) = make_uint4(pack2(o[0], o[1]), pack2(o[2], o[3]), pack2(o[4], o[5]), pack2(o[6], o[7]));
#pragma unroll
    for (int e = 0; e < 8; ++e) { pa[e] = ca[e]; pg[e] = cg_[e]; ca[e] = na[e]; cg_[e] = ng[e]; }
  }
}


#define XB_TMO      128
#define XB_XCNT(j)  (256  + 64 * (j))
#define XB_XSUB(j)  (1280 + 64 * (j))
#define XB_XGEN(j)  (2304 + 64 * (j))
#define XB_TOP      3328
#define XB_TOPGEN   3392
#define XCD_BAR_WORDS 3456
#define XB_SPIN_CAP (1u << 20)
#define LAS __attribute__((address_space(3)))
__device__ __forceinline__ unsigned xb_ld(unsigned* p) { return __hip_atomic_load(p, __ATOMIC_RELAXED, __HIP_MEMORY_SCOPE_AGENT); }
__device__ __forceinline__ unsigned xb_add(unsigned* p, unsigned v) { return __hip_atomic_fetch_add(p, v, __ATOMIC_RELAXED, __HIP_MEMORY_SCOPE_AGENT); }
__device__ __forceinline__ unsigned xb_xcc_id() { return (unsigned)__builtin_amdgcn_s_getreg((3 << 11) | 20) & 0xFu; }
#define XB_SPIN(cond, bar) do { unsigned _sp = 0; while (cond) { __builtin_amdgcn_s_sleep(1); \
    if ((++_sp & 255u) == 0u) { if (xb_ld(&(bar)[XB_TMO])) break; if (_sp > XB_SPIN_CAP) { atomicAdd(&(bar)[XB_TMO], 1u); break; } } } } while (0)
struct XcdBarrier { unsigned* bar; unsigned x; volatile LAS unsigned* st; };
__device__ __forceinline__ XcdBarrier xcd_barrier_post(unsigned* bar, volatile LAS unsigned* st) {
  XcdBarrier b; b.bar = bar; b.x = xb_xcc_id(); b.st = st;
  if (threadIdx.x == 0) (void)xb_add(&bar[XB_XCNT(b.x)], 1u);
  return b;
}
__device__ __forceinline__ void xcd_barrier_complete(unsigned* bar, unsigned x, unsigned& nloc, unsigned& nx) {
  const unsigned G = gridDim.x * gridDim.y * gridDim.z;
  unsigned sum, cnt, mine, sp = 0u;
  for (;;) {
    sum = 0u; cnt = 0u; mine = 0u;
#pragma unroll
    for (unsigned j = 0; j < 16; ++j) { const unsigned c = xb_ld(&bar[XB_XCNT(j)]); sum += c; cnt += (c > 0u) ? 1u : 0u; mine = (j == x) ? c : mine; }
    if (sum == G) break;
    __builtin_amdgcn_s_sleep(1);
    if ((++sp & 255u) == 0u) { if (xb_ld(&bar[XB_TMO])) break; if (sp > XB_SPIN_CAP) { atomicAdd(&bar[XB_TMO], 1u); break; } }
  }
  nloc = mine > 0u ? mine : 1u; nx = cnt > 0u ? cnt : 1u;
}
__device__ __forceinline__ void xcd_barrier(const XcdBarrier& b) {
  asm volatile("s_waitcnt vmcnt(0)" ::: "memory");
  __syncthreads();
  if (threadIdx.x == 0) {
    unsigned* bar = b.bar;
    __builtin_amdgcn_s_waitcnt(0);
    unsigned nloc = b.st[0], nx = b.st[1];
    if (nloc == 0u) { xcd_barrier_complete(bar, b.x, nloc, nx); b.st[0] = nloc; b.st[1] = nx; }
    const unsigned old = xb_add(&bar[XB_XSUB(b.x)], 1u);
    const unsigned gen = old / nloc;
    if (old + 1u == (gen + 1u) * nloc) {
      __builtin_amdgcn_fence(__ATOMIC_RELEASE, "agent");
      asm volatile("s_waitcnt vmcnt(0)" ::: "memory");
      const unsigned og = xb_add(&bar[XB_TOP], 1u);
      const unsigned tg = og / nx;
      if (og + 1u == (tg + 1u) * nx) xb_add(&bar[XB_TOPGEN], 1u);
      else XB_SPIN(xb_ld(&bar[XB_TOPGEN]) == tg, bar);
      __builtin_amdgcn_fence(__ATOMIC_ACQUIRE, "agent");
      xb_add(&bar[XB_XGEN(b.x)], 1u);
      asm volatile("s_waitcnt vmcnt(0)" ::: "memory");
    } else {
      XB_SPIN(xb_ld(&bar[XB_XGEN(b.x)]) == gen, bar);
      __builtin_amdgcn_fence(__ATOMIC_ACQUIRE, "agent");
      asm volatile("s_waitcnt vmcnt(0)" ::: "memory");
    }
  }
  __syncthreads();
}
constexpr size_t OFF_BAR = 25 * MiB - 16384;
static_assert(OFF_MOD + 3 * 6144 * 4 <= OFF_BAR, "bar");

template <int ph>
__device__ __forceinline__ void run_phase(const Params& p, char* smem) {
  const int bid = blockIdx.x, G = gridDim.x;
  char* ws = p.ws;
  if constexpr (ph == 0) {
    for (int it = bid; it < 272 + 96 + 32 + 3080; it += G) {
      if (it < 272) filter_item(p, it, smem);
      else if (it < 368) mod_item(p, it - 272, smem);
      else if (it < 400) cache_item(p, it - 368);
      else {
        int t = it - 400;
        if (t < 576) transpose_item(p.w_in, 1024, DIN, (bf16_t*)(ws + OFF_WIN), t, 36, smem);
        else if ((t -= 576) < 72) transpose_item(p.w_uq, 384, 768, (bf16_t*)(ws + OFF_WUQ), t, 12, smem);
        else if ((t -= 72) < 64) transpose_item(p.w_ukv, 256, 1024, (bf16_t*)(ws + OFF_WUKV), t, 16, smem);
        else if ((t -= 64) < 256) transpose_item(p.w_out, 1024, 1024, (bf16_t*)(ws + OFF_WOUT), t, 16, smem);
        else if ((t -= 256) < 1408) transpose_item(p.w_up, 1024, 5632, (bf16_t*)(ws + OFF_WUP), t, 88, smem);
        else { t -= 1408; transpose_item(p.w_down, 2816, 1024, (bf16_t*)(ws + OFF_WDOWN), t, 16, smem); }
      }
    }
  } else if constexpr (ph == 1) {
    rmsmod_phase<0>(p);
  } else if constexpr (ph == 2) {
    EpiIn epi{(float*)(ws + OFF_PROJ), (bf16_t*)(ws + OFF_HYT)};
    for (int t = bid; t < 128 * 18; t += G)
      gemm_tile<false>((const bf16_t*)(ws + OFF_H), 1024, (const bf16_t*)(ws + OFF_WIN), 1024, 1024, (t / 18) * 128, (t % 18) * 128, smem, epi);
  } else if constexpr (ph == 3) {
    for (int it = bid; it < 512; it += G) hyena_item<0>(p, 1, it, smem);
    for (int it = bid; it < 512; it += G) hyena_item<0>(p, 0, it, smem);
    for (int it = bid; it < 256; it += G) token_item(p, it);
  } else if constexpr (ph == 4) {
    EpiQ eq{(bf16_t*)(ws + OFF_QRAW)};
    EpiKV ekv{(bf16_t*)(ws + OFF_KRAW), (bf16_t*)(ws + OFF_VTC), (bf16_t*)(ws + OFF_VTL)};
    for (int it = bid; it < 512; it += G) hyena_item<1>(p, 1, it, smem);
    for (int t = bid; t < 768; t += G) gemm_tile<true>((const bf16_t*)(ws + OFF_QA), 384, (const bf16_t*)(ws + OFF_WUQ), 384, 384, (t / 6) * 128, (t % 6) * 128, smem, eq);
    for (int t = bid; t < 1088; t += G) gemm_tile<false>((const bf16_t*)(ws + OFF_CKVN), 256, (const bf16_t*)(ws + OFF_WUKV), 256, 256, (t / 8) * 128, (t % 8) * 128, smem, ekv);
    for (int it = bid; it < 512; it += G) hyena_item<1>(p, 0, it, smem);
  } else if constexpr (ph == 5) {
    for (int it = bid; it < 512 + 544; it += G) qk_item(p, it);
  } else if constexpr (ph == 6) {
    for (int it = bid; it < 1024; it += G) attn_item(p, it, smem);
  } else if constexpr (ph == 7) {
    for (int it = bid; it < 512; it += G) merge_item(p, it, smem);
  } else if constexpr (ph == 8) {
    EpiOut epi{&p};
    for (int t = bid; t < 128 * 8; t += G)
      gemm_tile<true>((const bf16_t*)(ws + OFF_H), 1024, (const bf16_t*)(ws + OFF_WOUT), 1024, 1024, (t / 8) * 128, (t % 8) * 128, smem, epi);
  } else if constexpr (ph == 9) {
    rmsmod_phase<1>(p);
  } else if constexpr (ph == 10 || ph == 13) {
    constexpr int half = ph == 10 ? 0 : 1;
    EpiU epi{(bf16_t*)(ws + OFF_U)};
    for (int t = bid; t < 64 * 44; t += G)
      gemm_tile<true>((const bf16_t*)(ws + OFF_H) + (size_t)half * 8192 * 1024, 1024, (const bf16_t*)(ws + OFF_WUP), 1024, 1024, (t / 44) * 128, (t % 44) * 128, smem, epi);
  } else if constexpr (ph == 11 || ph == 14) {
    for (int it = bid; it < 1408; it += G) act_item(p, it, ph == 11 ? 0 : 1);
  } else if constexpr (ph == 12 || ph == 15) {
    EpiY epi{&p, ph == 12 ? 0 : 1};
    for (int t = bid; t < 64 * 8; t += G)
      gemm_tile<true>((const bf16_t*)(ws + OFF_ACT), 2816, (const bf16_t*)(ws + OFF_WDOWN), 2816, 2816, (t / 8) * 128, (t % 8) * 128, smem, epi);
  }
}

#if ONE_LAUNCH
template <int PH>
__device__ __forceinline__ void run_all(const Params& p, char* smem, cg::grid_group& grid, const XcdBarrier& xb) {
  run_phase<PH>(p, smem);
  if constexpr (((DBL_MASK >> PH) & 1) != 0) { xcd_barrier(xb); run_phase<PH>(p, smem); }
  if constexpr (PH < 15) {
    xcd_barrier(xb);
    run_all<PH + 1>(p, smem, grid, xb);
  }
}
__global__ void __launch_bounds__(256, 2) mega_kernel(Params p) {
  __shared__ __attribute__((aligned(16))) char smem[SMEM_BYTES];
  __shared__ uint4 xb_words;
  cg::grid_group grid = cg::this_grid();
  if (threadIdx.x == 0) xb_words = make_uint4(0u, 0u, 0u, 0u);
  __syncthreads();
  XcdBarrier xb = xcd_barrier_post((unsigned*)(p.ws + OFF_BAR), (volatile LAS unsigned*)&xb_words);
  if (p.ws == nullptr) grid.sync();
  run_all<0>(p, smem, grid, xb);
}
#else
template <int PH>
__global__ void __launch_bounds__(256, 2) phase_kernel(Params p) {
  __shared__ __attribute__((aligned(16))) char smem[SMEM_BYTES];
  run_phase<PH>(p, smem);
}
#ifndef DBG_STOP
#define DBG_STOP 15
#endif
__global__ void dump_kernel(Params p, size_t off, int count) {
  const bf16_t* src = (const bf16_t*)(p.ws + off);
  const bf16_t* src2 = (const bf16_t*)(p.ws + DBG_OFF2);
  for (int i = blockIdx.x * 256 + threadIdx.x; i < 16777216; i += gridDim.x * 256)
    p.out[i] = i < DBG_CNT ? bf2f(src[i]) : (i - DBG_CNT < DBG_CNT2 ? bf2f(src2[i - DBG_CNT]) : 0.f);
}
template <int PH>
static void launch_all(const Params& p, hipStream_t stream) {
  phase_kernel<PH><<<512, 256, 0, stream>>>(p);
  if constexpr (PH < DBG_STOP) launch_all<PH + 1>(p, stream);
}
#endif

extern "C" void kernel_launch(void* const* d_in, const int* in_sizes, int n_in, void* d_out, int out_size, void* d_ws,
                              size_t ws_size, hipStream_t stream) {
  Params p{};
  const float** pp = (const float**)&p;
  for (int i = 0; i < 34; ++i) pp[i] = (const float*)d_in[i];
  p.out = (float*)d_out;
  p.ws = (char*)d_ws;
#if ONE_LAUNCH
  (void)hipMemsetAsync((char*)d_ws + OFF_BAR, 0, XCD_BAR_WORDS * 4, stream);
  static int grid_blocks = 0;
  if (!grid_blocks) {
    int dev = 0, cus = 0, per_cu = 0;
    hipGetDevice(&dev);
    hipDeviceGetAttribute(&cus, hipDeviceAttributeMultiprocessorCount, dev);
    hipOccupancyMaxActiveBlocksPerMultiprocessor(&per_cu, mega_kernel, 256, 0);
    grid_blocks = cus * per_cu;
  }
  void* args[] = {&p};
  hipError_t e = hipLaunchCooperativeKernel((void*)mega_kernel, dim3(grid_blocks), dim3(256), args, 0, stream);
  if (e != hipSuccess) fprintf(stderr, "cooperative launch failed: %s (grid %d)\n", hipGetErrorString(e), grid_blocks);
#else
  launch_all<0>(p, stream);
#if DBG_STOP < 15
  dump_kernel<<<1024, 256, 0, stream>>>(p, DBG_OFF, DBG_CNT);
#endif
#endif
}
```

```cpp
#include <hip/hip_runtime.h>
#include <hip/hip_cooperative_groups.h>
#include <cstdio>
namespace cg = cooperative_groups;

#define DBG_STOP 15
#define DBG_NOHY 0
#ifndef DBL_MASK
#define DBL_MASK 0
#endif
#define DBG_OFF OFF_QRAW
#define DBG_OFF2 OFF_KRAW
#define DBG_CNT 12582912
#define DBG_CNT2 0
#ifndef ONE_LAUNCH
#define ONE_LAUNCH 1
#endif

typedef unsigned short bf16_t;
typedef short bf16x8 __attribute__((ext_vector_type(8)));
typedef float f32x4 __attribute__((ext_vector_type(4)));
typedef float f32x16 __attribute__((ext_vector_type(16)));

constexpr int D = 1024, NTOK = 16384, NCTX = 8192, SEQC = 256, SEQL = 4096;
constexpr int DIN = 2208, DINP = 2304, QL = 384, KVL = 256, DFF = 2816;
constexpr int NROWKV = 17408;
constexpr size_t MiB = 1048576;

constexpr size_t OFF_WIN = 0;
constexpr size_t OFF_WUQ = OFF_WIN + (size_t)DINP * 1024 * 2;
constexpr size_t OFF_WUKV = OFF_WUQ + (size_t)768 * 384 * 2;
constexpr size_t OFF_WOUT = OFF_WUKV + (size_t)1024 * 256 * 2;
constexpr size_t OFF_WUP = OFF_WOUT + (size_t)1024 * 1024 * 2;
constexpr size_t OFF_WDOWN = OFF_WUP + (size_t)5632 * 1024 * 2;
constexpr size_t OFF_MOD = OFF_WDOWN + (size_t)1024 * 2816 * 2;
static_assert(OFF_MOD + 3 * 6144 * 4 <= 25 * MiB, "A region");
constexpr size_t OFF_RLAT = 25 * MiB;
constexpr size_t OFF_RCTX = 41 * MiB;
constexpr size_t OFF_H = 42 * MiB;
constexpr size_t OFF_ZT = 42 * MiB;
constexpr size_t OFF_QA = 58 * MiB;
constexpr size_t OFF_KPE = 70 * MiB;
constexpr size_t OFF_PROJ = 74 * MiB;
constexpr size_t OFF_QRAW = 74 * MiB;
constexpr size_t OFF_Y2T = 98 * MiB;
constexpr size_t OFF_ATTN = 74 * MiB;
constexpr size_t OFF_U = 74 * MiB;
constexpr size_t OFF_HYT = 116 * MiB;
constexpr size_t OFF_Q = 116 * MiB;
constexpr size_t OFF_KC = 140 * MiB;
constexpr size_t OFF_KL = 152 * MiB;
constexpr size_t OFF_CKVN = 164 * MiB;
constexpr size_t OFF_KRAW = 173 * MiB;
constexpr size_t OFF_VTC = 190 * MiB;
constexpr size_t OFF_VTL = 198 * MiB;
constexpr size_t OFF_ACT = 162 * MiB;

constexpr int OUT_YS = 0;
constexpr int OUT_CKV = 16777216;
constexpr int OUT_KPE = 16777216 + 2097152;

constexpr int SMEM_BYTES = 51200;

struct Params {
  const float *x_prompt, *x_sample, *cache_ckv, *cache_kpe, *c, *c_ctx, *w_ada, *b_ada, *g_mix, *w_in, *g_qa, *w_uq,
      *g_kva, *w_ukv, *g_q, *g_k, *hy_conv_w, *hy_conv_b, *filt_w1, *filt_b1, *filt_freq1, *filt_w2, *filt_b2,
      *filt_freq2, *filt_w3, *filt_bias, *g_out_att, *g_out_hy, *w_out, *g_ffn, *w_up, *ffn_conv_w, *ffn_conv_b, *w_down;
  float* out;
  char* ws;
};

typedef __bf16 bf16x2_t __attribute__((ext_vector_type(2)));
__device__ __forceinline__ unsigned pack2(float lo, float hi) {
  bf16x2_t v;
  v[0] = (__bf16)lo;
  v[1] = (__bf16)hi;
  return __builtin_bit_cast(unsigned, v);
}
__device__ __forceinline__ float bflo(unsigned u) { return __uint_as_float(u << 16); }
__device__ __forceinline__ float bfhi(unsigned u) { return __uint_as_float(u & 0xffff0000u); }
__device__ __forceinline__ float bf2f(bf16_t h) { return __uint_as_float(((unsigned)h) << 16); }
__device__ __forceinline__ bf16_t f2bf(float f) { return (bf16_t)(pack2(f, 0.f) & 0xffffu); }
__device__ __forceinline__ float wave_sum(float v) {
#pragma unroll
  for (int o = 32; o >= 1; o >>= 1) v += __shfl_xor(v, o);
  return v;
}
__device__ __forceinline__ int ltid() { int t = threadIdx.x; asm volatile("" : "+v"(t)); return t; }
__device__ __forceinline__ float sin_turns(float t) { t -= floorf(t); return __builtin_amdgcn_sinf(t); }
__device__ __forceinline__ float cos_turns(float t) { t -= floorf(t); return __builtin_amdgcn_cosf(t); }
__device__ __forceinline__ float sin_rad(float x) { return sin_turns(x * 0.15915494309189535f); }
__device__ __forceinline__ const float* xrow(const Params& p, int row) {
  return row < NCTX ? p.x_prompt + (size_t)row * D : p.x_sample + (size_t)(row - NCTX) * D;
}
__device__ __forceinline__ int modidx(int row) { return row < NCTX ? 0 : 1 + ((row - NCTX) >> 12); }

template <bool SWAP>
__device__ __forceinline__ void gemm_main(const bf16_t* __restrict__ A, int lda, const bf16_t* __restrict__ Bt, int ldb,
                                          int K, int m0, int n0, char* smem, f32x4 (&acc)[4][4]) {
  const int tid = ltid(), lane = tid & 63, wid = tid >> 6, wr = wid >> 1, wc = wid & 1;
  const int fr = lane & 15, fq = lane >> 4;
  bf16_t* sA = (bf16_t*)smem;
  bf16_t* sB = sA + 128 * 72;
#pragma unroll
  for (int m = 0; m < 4; ++m)
#pragma unroll
    for (int n = 0; n < 4; ++n) acc[m][n] = (f32x4){0.f, 0.f, 0.f, 0.f};
  const int lr = tid >> 3, lc = (tid & 7) * 8;
  const bf16_t* ga = A + (size_t)(m0 + lr) * lda + lc;
  const bf16_t* gb = Bt + (size_t)(n0 + lr) * ldb + lc;
  const size_t sa32 = (size_t)32 * lda, sb32 = (size_t)32 * ldb;
  uint4 ra0 = *(const uint4*)(ga), ra1 = *(const uint4*)(ga + sa32), ra2 = *(const uint4*)(ga + 2 * sa32), ra3 = *(const uint4*)(ga + 3 * sa32);
  uint4 rb0 = *(const uint4*)(gb), rb1 = *(const uint4*)(gb + sb32), rb2 = *(const uint4*)(gb + 2 * sb32), rb3 = *(const uint4*)(gb + 3 * sb32);
  const int nk = K >> 6;
  bf16_t* wa = sA + lr * 72 + lc;
  bf16_t* wb = sB + lr * 72 + lc;
  for (int kt = 0; kt < nk; ++kt) {
    __syncthreads();
    *(uint4*)(wa) = ra0; *(uint4*)(wa + 32 * 72) = ra1; *(uint4*)(wa + 64 * 72) = ra2; *(uint4*)(wa + 96 * 72) = ra3;
    *(uint4*)(wb) = rb0; *(uint4*)(wb + 32 * 72) = rb1; *(uint4*)(wb + 64 * 72) = rb2; *(uint4*)(wb + 96 * 72) = rb3;
    __syncthreads();
    if (kt + 1 < nk) {
      ga += 64;
      gb += 64;
      ra0 = *(const uint4*)(ga); ra1 = *(const uint4*)(ga + sa32); ra2 = *(const uint4*)(ga + 2 * sa32); ra3 = *(const uint4*)(ga + 3 * sa32);
      rb0 = *(const uint4*)(gb); rb1 = *(const uint4*)(gb + sb32); rb2 = *(const uint4*)(gb + 2 * sb32); rb3 = *(const uint4*)(gb + 3 * sb32);
    }
    __builtin_amdgcn_sched_barrier(0);
#pragma unroll
    for (int ks = 0; ks < 2; ++ks) {
      bf16x8 af[4], bfr[4];
#pragma unroll
      for (int m = 0; m < 4; ++m) af[m] = *(const bf16x8*)(sA + (wr * 64 + m * 16 + fr) * 72 + ks * 32 + fq * 8);
#pragma unroll
      for (int n = 0; n < 4; ++n) bfr[n] = *(const bf16x8*)(sB + (wc * 64 + n * 16 + fr) * 72 + ks * 32 + fq * 8);
#pragma unroll
      for (int m = 0; m < 4; ++m)
#pragma unroll
        for (int n = 0; n < 4; ++n) {
          if (SWAP) acc[m][n] = __builtin_amdgcn_mfma_f32_16x16x32_bf16(bfr[n], af[m], acc[m][n], 0, 0, 0);
          else acc[m][n] = __builtin_amdgcn_mfma_f32_16x16x32_bf16(af[m], bfr[n], acc[m][n], 0, 0, 0);
        }
    }
  }
}
template <bool SWAP, class Epi>
__device__ __forceinline__ void gemm_tile(const bf16_t* __restrict__ A, int lda, const bf16_t* __restrict__ Bt, int ldb,
                                          int K, int m0, int n0, char* smem, const Epi& epi) {
  f32x4 acc[4][4];
  gemm_main<SWAP>(A, lda, Bt, ldb, K, m0, n0, smem, acc);
  const int tid = ltid(), lane = tid & 63, wid = tid >> 6, wr = wid >> 1, wc = wid & 1;
  const int fr = lane & 15, fq = lane >> 4;
#pragma unroll
  for (int m = 0; m < 4; ++m)
#pragma unroll
    for (int n = 0; n < 4; ++n) {
      if (SWAP) epi(m0 + wr * 64 + m * 16 + fr, n0 + wc * 64 + n * 16 + fq * 4, acc[m][n]);
      else epi(m0 + wr * 64 + m * 16 + fq * 4, n0 + wc * 64 + n * 16 + fr, acc[m][n]);
    }
}

constexpr size_t OFF_EDGE = 162 * MiB;
__device__ __forceinline__ void gemm_up_act_tile(const Params& p, int m0, int n0, char* smem) {
  f32x4 acc[4][4];
  gemm_main<true>((const bf16_t*)(p.ws + OFF_H), 1024, (const bf16_t*)(p.ws + OFF_WUP), 1024, 1024, m0, n0, smem, acc);
  const int tid = ltid(), lane = tid & 63, wid = tid >> 6, wr = wid >> 1, wc = wid & 1;
  const int fr = lane & 15, fq = lane >> 4;
  bf16_t* act = (bf16_t*)(p.ws + OFF_U);
  bf16_t* edge = (bf16_t*)(p.ws + OFF_EDGE);
  const int rowbase = m0 + wr * 64, wt = rowbase >> 6;
  const int upl = (lane + 63) & 63, upl2 = (lane + 15) & 63, dnl = (lane + 1) & 63, dnl2 = (lane + 49) & 63;
#pragma unroll
  for (int i = 0; i < 2; ++i) {
    const int cperm = n0 + wc * 64 + 32 * i;
    const int j0 = (cperm >> 5) * 16 + 4 * fq;
    const float4 wa0 = *(const float4*)(p.ffn_conv_w + j0), wa1 = *(const float4*)(p.ffn_conv_w + 5632 + j0), wa2 = *(const float4*)(p.ffn_conv_w + 11264 + j0);
    const float4 wg0 = *(const float4*)(p.ffn_conv_w + 2816 + j0), wg1 = *(const float4*)(p.ffn_conv_w + 5632 + 2816 + j0), wg2 = *(const float4*)(p.ffn_conv_w + 11264 + 2816 + j0);
    const float4 ba = *(const float4*)(p.ffn_conv_b + j0), bg = *(const float4*)(p.ffn_conv_b + 2816 + j0);
    const float w0a[4] = {wa0.x, wa0.y, wa0.z, wa0.w}, w1a[4] = {wa1.x, wa1.y, wa1.z, wa1.w}, w2a[4] = {wa2.x, wa2.y, wa2.z, wa2.w};
    const float w0g[4] = {wg0.x, wg0.y, wg0.z, wg0.w}, w1g[4] = {wg1.x, wg1.y, wg1.z, wg1.w}, w2g[4] = {wg2.x, wg2.y, wg2.z, wg2.w};
    const float bba[4] = {ba.x, ba.y, ba.z, ba.w}, bbg[4] = {bg.x, bg.y, bg.z, bg.w};
#pragma unroll
    for (int m = 0; m < 4; ++m) {
      float o[4];
#pragma unroll
      for (int e = 0; e < 4; ++e) {
        const float a = acc[m][2 * i][e], g = acc[m][2 * i + 1][e];
        const float au1 = __shfl(a, upl), gu1 = __shfl(g, upl), ad1 = __shfl(a, dnl), gd1 = __shfl(g, dnl);
        float au2 = 0.f, gu2 = 0.f, ad2 = 0.f, gd2 = 0.f;
        if (m > 0) { au2 = __shfl(acc[m - 1][2 * i][e], upl2); gu2 = __shfl(acc[m - 1][2 * i + 1][e], upl2); }
        if (m < 3) { ad2 = __shfl(acc[m + 1][2 * i][e], dnl2); gd2 = __shfl(acc[m + 1][2 * i + 1][e], dnl2); }
        const float au = fr > 0 ? au1 : au2, gu = fr > 0 ? gu1 : gu2, ad = fr < 15 ? ad1 : ad2, gd = fr < 15 ? gd1 : gd2;
        const float ca = w0a[e] * au + w1a[e] * a + w2a[e] * ad + bba[e];
        const float cgv = w0g[e] * gu + w1g[e] * g + w2g[e] * gd + bbg[e];
        o[e] = ca / (1.f + __expf(-ca)) * cgv;
      }
      const int lr64 = m * 16 + fr, row = rowbase + lr64;
      if (lr64 >= 1 && lr64 <= 62) *(uint2*)(act + (size_t)row * 2816 + j0) = make_uint2(pack2(o[0], o[1]), pack2(o[2], o[3]));
      if (lr64 <= 1 || lr64 >= 62) {
        const int slot = lr64 <= 1 ? lr64 : lr64 - 60;
        bf16_t* er = edge + (size_t)(wt * 4 + slot) * 5632;
        *(uint2*)(er + j0) = make_uint2(pack2(acc[m][2 * i][0], acc[m][2 * i][1]), pack2(acc[m][2 * i][2], acc[m][2 * i][3]));
        *(uint2*)(er + 2816 + j0) = make_uint2(pack2(acc[m][2 * i + 1][0], acc[m][2 * i + 1][1]), pack2(acc[m][2 * i + 1][2], acc[m][2 * i + 1][3]));
      }
    }
  }
}

__device__ __forceinline__ void transpose_item(const float* __restrict__ W, int K, int N, bf16_t* __restrict__ WT, int tile, int ntn, char* smem, bool perm = false) {
  float* s = (float*)smem;
  const int tk = tile / ntn, tn = tile % ntn, tid = ltid();
  const int k0 = tk * 64, n0 = tn * 64;
  __syncthreads();
  {
    const int r = tid >> 4, c4 = (tid & 15) * 4;
#pragma unroll
    for (int i = 0; i < 4; ++i) {
      const int k = r + 16 * i;
      float4 v = make_float4(0.f, 0.f, 0.f, 0.f);
      if (n0 + c4 < N) v = *(const float4*)(W + (size_t)(k0 + k) * N + n0 + c4);
      s[k * 65 + c4 + 0] = v.x; s[k * 65 + c4 + 1] = v.y; s[k * 65 + c4 + 2] = v.z; s[k * 65 + c4 + 3] = v.w;
    }
  }
  __syncthreads();
  {
    const int n = tid >> 2, kc = (tid & 3) * 16;
    unsigned o[8];
#pragma unroll
    for (int i = 0; i < 8; ++i) o[i] = pack2(s[(kc + 2 * i) * 65 + n], s[(kc + 2 * i + 1) * 65 + n]);
    int nr = n0 + n;
    if (perm) { const int hf = nr >= 2816 ? 1 : 0, cc = nr - hf * 2816; nr = 32 * (cc >> 4) + 16 * hf + (cc & 15); }
    uint4* dst = (uint4*)(WT + (size_t)nr * K + k0 + kc);
    dst[0] = make_uint4(o[0], o[1], o[2], o[3]);
    dst[1] = make_uint4(o[4], o[5], o[6], o[7]);
  }
}

__device__ __forceinline__ void mod_item(const Params& p, int item, char* smem) {
  float* s = (float*)smem;
  float* red = s + 3072;
  const int tid = ltid();
  __syncthreads();
  for (int e = tid; e < 3072; e += 256) {
    const int v = e >> 10, k = e & 1023;
    const float x = (v == 0) ? p.c_ctx[k] : p.c[(v - 1) * D + k];
    s[e] = x / (1.f + __expf(-x));
  }
  __syncthreads();
  const int jl = tid & 63, kq = tid >> 6, j = item * 64 + jl, k0 = kq * 256;
  float a0 = 0.f, a1 = 0.f, a2 = 0.f;
#pragma unroll 8
  for (int k = 0; k < 256; ++k) {
    const float w = p.w_ada[(size_t)(k0 + k) * 6144 + j];
    a0 += s[k0 + k] * w; a1 += s[1024 + k0 + k] * w; a2 += s[2048 + k0 + k] * w;
  }
  red[(kq * 3 + 0) * 64 + jl] = a0; red[(kq * 3 + 1) * 64 + jl] = a1; red[(kq * 3 + 2) * 64 + jl] = a2;
  __syncthreads();
  if (tid < 192) {
    const int v = tid >> 6;
    const float r = red[(0 * 3 + v) * 64 + jl] + red[(1 * 3 + v) * 64 + jl] + red[(2 * 3 + v) * 64 + jl] + red[(3 * 3 + v) * 64 + jl];
    ((float*)(p.ws + OFF_MOD))[v * 6144 + j] = r + p.b_ada[j];
  }
}

__device__ __forceinline__ void filter_item(const Params& p, int item, char* smem) {
  int n, p0; bf16_t* R;
  if (item < 256) { n = 4096; p0 = item * 16; R = (bf16_t*)(p.ws + OFF_RLAT); }
  else { n = 256; p0 = (item - 256) * 16; R = (bf16_t*)(p.ws + OFF_RCTX); }
  const int n2 = 2 * n, tid = ltid();
  float* z = (float*)smem;
  float* h1 = z + 16 * 36;
  float* h2 = h1 + 16 * 64;
  __syncthreads();
#pragma unroll 1
  for (int e = tid; e < 16 * 33; e += 256) {
    const int pp = e / 33, f = e % 33, pos = p0 + pp;
    float val;
    if (f == 0) val = (float)pos / (float)(n - 1);
    else {
      const int k = (f - 1) & 15;
      const float band = 1e-4f + (float)k * ((15.f - 1e-4f) / 15.f);
      const float turns = band * ((float)pos / (float)n);
      val = (f <= 16) ? cos_turns(turns) : -sin_turns(turns);
    }
    z[pp * 36 + f] = val;
  }
  __syncthreads();
#pragma unroll 1
  for (int e = tid; e < 1024; e += 256) {
    const int pp = e >> 6, j = e & 63;
    float a = p.filt_b1[j];
#pragma unroll 3
    for (int f = 0; f < 33; ++f) a += z[pp * 36 + f] * p.filt_w1[f * 64 + j];
    h1[e] = sin_rad(p.filt_freq1[j] * a);
  }
  __syncthreads();
#pragma unroll 1
  for (int e = tid; e < 1024; e += 256) {
    const int pp = e >> 6, j = e & 63;
    float a = p.filt_b2[j];
#pragma unroll 4
    for (int k = 0; k < 64; ++k) a += h1[pp * 64 + k] * p.filt_w2[k * 64 + j];
    h2[j * 16 + pp] = sin_rad(p.filt_freq2[j] * a);
  }
  __syncthreads();
  const float mind = -3.0701134573253946f, maxd = -15.350567286626973f;
#pragma unroll 1
  for (int ci = 0; ci < 8; ++ci) {
    const int col = tid + 256 * ci, o = col >> 10, dir = (col >> 9) & 1, c = col & 511;
    float acc[16];
#pragma unroll
    for (int i = 0; i < 16; ++i) acc[i] = 0.f;
#pragma unroll 4
    for (int k = 0; k < 64; ++k) {
      const float w = p.filt_w3[k * 2048 + col];
      const float4 ha = *(const float4*)(h2 + k * 16), hb = *(const float4*)(h2 + k * 16 + 4), hc = *(const float4*)(h2 + k * 16 + 8), hd = *(const float4*)(h2 + k * 16 + 12);
      acc[0] += ha.x * w; acc[1] += ha.y * w; acc[2] += ha.z * w; acc[3] += ha.w * w;
      acc[4] += hb.x * w; acc[5] += hb.y * w; acc[6] += hb.z * w; acc[7] += hb.w * w;
      acc[8] += hc.x * w; acc[9] += hc.y * w; acc[10] += hc.z * w; acc[11] += hc.w * w;
      acc[12] += hd.x * w; acc[13] += hd.y * w; acc[14] += hd.z * w; acc[15] += hd.w * w;
    }
    const float delta = fabsf(mind + (float)c * ((maxd - mind) / 511.f));
    bf16_t* Rrow = R + (size_t)(o * 512 + c) * n2;
#pragma unroll
    for (int i = 0; i < 16; ++i) {
      const int pos = p0 + i;
      const float t = (float)pos / (float)(n - 1);
      float val = acc[i] * (__expf(-t * delta) + 0.05f);
      int idx = dir == 0 ? (n - 1 - pos) : (n - 1 + pos);
      if (dir == 1 && pos == 0) { idx = n2 - 1; val = 0.f; }
      Rrow[idx] = f2bf(val);
    }
  }
}

__device__ __forceinline__ void cache_item(const Params& p, int item) {
  const int tid = ltid(), r0 = item * 32;
  bf16_t* ckvn = (bf16_t*)(p.ws + OFF_CKVN);
#pragma unroll 2
  for (int e = tid; e < 32 * 64; e += 256) {
    const int r = r0 + (e >> 6), c4 = (e & 63) * 4;
    const float4 v = *(const float4*)(p.cache_ckv + (size_t)r * 256 + c4);
    *(uint2*)(ckvn + (size_t)(NTOK + r) * 256 + c4) = make_uint2(pack2(v.x, v.y), pack2(v.z, v.w));
  }
}

template <int WHICH>
__device__ __forceinline__ void rmsmod_phase(const Params& p) {
  const int tid = ltid(), lane = tid & 63, wid = tid >> 6;
  const int gw = blockIdx.x * 4 + wid, tw = gridDim.x * 4;
  const float* g = WHICH == 0 ? p.g_mix : p.g_ffn;
  const float* mod = (const float*)(p.ws + OFF_MOD);
  bf16_t* h = (bf16_t*)(p.ws + OFF_H);
  for (int row = gw; row < NTOK; row += tw) {
    const float* src = WHICH == 0 ? xrow(p, row) : p.out + (size_t)row * D;
    float4 v[4];
    float ss = 0.f;
#pragma unroll
    for (int i = 0; i < 4; ++i) {
      v[i] = ((const float4*)src)[lane + 64 * i];
      ss += v[i].x * v[i].x + v[i].y * v[i].y + v[i].z * v[i].z + v[i].w * v[i].w;
    }
    ss = wave_sum(ss);
    const float r = rsqrtf(ss * (1.f / 1024.f) + 1e-6f);
    const float* mv = mod + modidx(row) * 6144 + (WHICH == 0 ? 0 : 3 * 1024);
#pragma unroll
    for (int i = 0; i < 4; ++i) {
      const int e = 4 * (lane + 64 * i);
      const float4 g4 = *(const float4*)(g + e), sh = *(const float4*)(mv + e), sc = *(const float4*)(mv + 1024 + e);
      const float y0 = v[i].x * r * g4.x * (1.f + sc.x) + sh.x, y1 = v[i].y * r * g4.y * (1.f + sc.y) + sh.y;
      const float y2 = v[i].z * r * g4.z * (1.f + sc.z) + sh.z, y3 = v[i].w * r * g4.w * (1.f + sc.w) + sh.w;
      *(uint2*)(h + (size_t)row * D + e) = make_uint2(pack2(y0, y1), pack2(y2, y3));
    }
  }
}

struct EpiIn {
  float* proj; bf16_t* hyT;
  __device__ __forceinline__ void operator()(int row0, int col, const f32x4& v) const {
    if (col < 672) {
#pragma unroll
      for (int j = 0; j < 4; ++j) proj[(size_t)(row0 + j) * 672 + col] = v[j];
    } else if (col < DIN) {
      *(uint2*)(hyT + (size_t)(col - 672) * NTOK + row0) = make_uint2(pack2(v[0], v[1]), pack2(v[2], v[3]));
    }
  }
};
struct EpiQ {
  bf16_t* q;
  __device__ __forceinline__ void operator()(int row, int col0, const f32x4& v) const {
    *(uint2*)(q + (size_t)row * 768 + col0) = make_uint2(pack2(v[0], v[1]), pack2(v[2], v[3]));
  }
};
struct EpiKV {
  bf16_t *kraw, *vtc, *vtl;
  __device__ __forceinline__ void operator()(int row0, int col, const f32x4& v) const {
    const int head = col >> 7, cc = col & 127;
    if (cc < 64) {
#pragma unroll
      for (int j = 0; j < 4; ++j) kraw[(size_t)(row0 + j) * 512 + head * 64 + cc] = f2bf(v[j]);
    } else {
      const int dv = cc - 64;
      bf16_t* dst;
      if (row0 < NCTX) dst = vtc + ((size_t)((row0 >> 8) * 8 + head) * 64 + dv) * 256 + (row0 & 255);
      else if (row0 < NTOK) { const int r = row0 - NCTX; dst = vtl + ((size_t)((r >> 12) * 8 + head) * 64 + dv) * 4608 + (r & 4095); }
      else { const int r = row0 - NTOK; dst = vtl + ((size_t)((r >> 9) * 8 + head) * 64 + dv) * 4608 + 4096 + (r & 511); }
      *(uint2*)dst = make_uint2(pack2(v[0], v[1]), pack2(v[2], v[3]));
    }
  }
};
struct EpiOut {
  const Params* p;
  __device__ __forceinline__ void operator()(int row, int col0, const f32x4& v) const {
    const float4 x = *(const float4*)(xrow(*p, row) + col0);
    const float4 m = *(const float4*)((const float*)(p->ws + OFF_MOD) + modidx(row) * 6144 + 2 * 1024 + col0);
    *(float4*)(p->out + (size_t)row * D + col0) = make_float4(x.x + m.x * v[0], x.y + m.y * v[1], x.z + m.z * v[2], x.w + m.w * v[3]);
  }
};
struct EpiU {
  bf16_t* u;
  __device__ __forceinline__ void operator()(int row, int col0, const f32x4& v) const {
    *(uint2*)(u + (size_t)row * 5632 + col0) = make_uint2(pack2(v[0], v[1]), pack2(v[2], v[3]));
  }
};
struct EpiY {
  const Params* p; int half;
  __device__ __forceinline__ void operator()(int row, int col0, const f32x4& v) const {
    const int grow = half * 8192 + row;
    float4* dst = (float4*)(p->out + (size_t)grow * D + col0);
    const float4 x = *dst;
    const float4 m = *(const float4*)((const float*)(p->ws + OFF_MOD) + modidx(grow) * 6144 + 5 * 1024 + col0);
    *dst = make_float4(x.x + m.x * v[0], x.y + m.y * v[1], x.z + m.z * v[2], x.w + m.w * v[3]);
  }
};

__device__ __forceinline__ void token_item(const Params& p, int item) {
  const int tid = ltid(), lane = tid & 63, wid = tid >> 6;
  const float* proj = (const float*)(p.ws + OFF_PROJ);
  bf16_t* qa = (bf16_t*)(p.ws + OFF_QA);
  bf16_t* ckvn = (bf16_t*)(p.ws + OFF_CKVN);
  float* kpe = (float*)(p.ws + OFF_KPE);
  for (int tt = 0; tt < 16; ++tt) {
    const int token = item * 64 + wid * 16 + tt;
    const float* pr = proj + (size_t)token * 672;
    float2 q[3];
    float ss = 0.f;
#pragma unroll
    for (int i = 0; i < 3; ++i) { q[i] = *(const float2*)(pr + lane * 2 + 128 * i); ss += q[i].x * q[i].x + q[i].y * q[i].y; }
    ss = wave_sum(ss);
    const float r = rsqrtf(ss * (1.f / 384.f) + 1e-6f);
#pragma unroll
    for (int i = 0; i < 3; ++i) {
      const int e = lane * 2 + 128 * i;
      *(unsigned*)(qa + (size_t)token * 384 + e) = pack2(q[i].x * r * p.g_qa[e], q[i].y * r * p.g_qa[e + 1]);
    }
    const float4 kv = *(const float4*)(pr + 384 + lane * 4);
    float s2 = wave_sum(kv.x * kv.x + kv.y * kv.y + kv.z * kv.z + kv.w * kv.w);
    const float r2 = rsqrtf(s2 * (1.f / 256.f) + 1e-6f);
    const float4 g = *(const float4*)(p.g_kva + lane * 4);
    const float4 y = make_float4(kv.x * r2 * g.x, kv.y * r2 * g.y, kv.z * r2 * g.z, kv.w * r2 * g.w);
    *(uint2*)(ckvn + (size_t)token * 256 + lane * 4) = make_uint2(pack2(y.x, y.y), pack2(y.z, y.w));
    if (token < NCTX) *(float4*)(p.out + OUT_CKV + (size_t)token * 256 + lane * 4) = y;
    if (lane < 32) {
      const float kp = pr[640 + lane];
      kpe[(size_t)token * 32 + lane] = kp;
      if (token < NCTX) p.out[OUT_KPE + (size_t)token * 32 + lane] = kp;
    }
  }
}

template <int ORDER>
__device__ __forceinline__ void hyena_item(const Params& p, int grp, int c, char* smem) {
  const int tid = ltid(), lane = tid & 63, wid = tid >> 6, fr = lane & 15, fq = lane >> 4;
  const int n = grp ? SEQL : SEQC, nb = n >> 6, L = n;
  const bf16_t* Rrow = (const bf16_t*)(p.ws + (grp ? OFF_RLAT : OFF_RCTX)) + (size_t)(ORDER * 512 + c) * (2 * n);
  const bf16_t* hyT = (const bf16_t*)(p.ws + OFF_HYT);
  bf16_t* sU = (bf16_t*)smem;
  unsigned* sR0 = (unsigned*)(smem + 18432);
  unsigned* sR1 = (unsigned*)(smem + 18432 + 16384);
  const int tok0 = grp * 8192;
  __syncthreads();
  for (int ch = tid; ch < (2 * n) / 8; ch += 256) *(uint4*)((bf16_t*)sR0 + ch * 8) = *(const uint4*)(Rrow + ch * 8);
  if (ORDER == 0) {
    const bf16_t* raw = hyT + (size_t)c * NTOK + tok0;
    const float w0 = p.hy_conv_w[c], w1 = p.hy_conv_w[1536 + c], w2 = p.hy_conv_w[3072 + c], b = p.hy_conv_b[c];
    for (int ch = tid; ch < 1024; ch += 256) {
      const int t = ch * 8, pos = t & (L - 1);
      const uint4 rv = *(const uint4*)(raw + t);
      float x[10];
      x[0] = pos == 0 ? 0.f : bf2f(raw[t - 1]);
      x[1] = bflo(rv.x); x[2] = bfhi(rv.x); x[3] = bflo(rv.y); x[4] = bfhi(rv.y);
      x[5] = bflo(rv.z); x[6] = bfhi(rv.z); x[7] = bflo(rv.w); x[8] = bfhi(rv.w);
      x[9] = (pos + 8 == L) ? 0.f : bf2f(raw[t + 8]);
      float u[8];
#pragma unroll
      for (int i = 0; i < 8; ++i) u[i] = w0 * x[i] + w1 * x[i + 1] + w2 * x[i + 2] + b;
      *(uint4*)(sU + (ch >> 3) * 72 + (ch & 7) * 8) = make_uint4(pack2(u[0], u[1]), pack2(u[2], u[3]), pack2(u[4], u[5]), pack2(u[6], u[7]));
    }
  } else {
    const bf16_t* zr = (const bf16_t*)(p.ws + OFF_ZT) + (size_t)c * NTOK + tok0;
    for (int ch = tid; ch < 1024; ch += 256) *(uint4*)(sU + (ch >> 3) * 72 + (ch & 7) * 8) = *(const uint4*)(zr + ch * 8);
  }
  __syncthreads();
  for (int k = tid; k < n; k += 256) {
    const unsigned a = sR0[k], b2 = (k + 1 < n) ? sR0[k + 1] : 0u;
    sR1[k] = (a >> 16) | (b2 << 16);
  }
  __syncthreads();

  f32x4 acc[4][2];
#pragma unroll
  for (int m = 0; m < 4; ++m) { acc[m][0] = (f32x4){0.f, 0.f, 0.f, 0.f}; acc[m][1] = (f32x4){0.f, 0.f, 0.f, 0.f}; }
  const unsigned* abase = (fr & 1) ? (sR0 + ((n - 1 - fr) >> 1) + 4 * fq) : (sR1 + ((n - 2 - fr) >> 1) + 4 * fq);
  const int col0 = 32 * wid + fr, col1 = col0 + 16;
  const int i0 = col0 & (nb - 1), i1 = col1 & (nb - 1);
  for (int d = -(nb - 1); d <= nb - 1; ++d) {
    const bool v0 = (unsigned)(i0 - d) < (unsigned)nb, v1 = (unsigned)(i1 - d) < (unsigned)nb;
    const bool any0 = __ballot(v0) != 0ull, any1 = __ballot(v1) != 0ull;
    if (!any0 && !any1) continue;
    bf16x8 F[6];
    const unsigned* ap = abase - 32 * d + 16;
#pragma unroll
    for (int idx = 0; idx < 6; ++idx) {
      const unsigned* q = ap - 8 * idx;
      union { unsigned u[4]; bf16x8 v; } cv;
      cv.u[0] = q[0]; cv.u[1] = q[1]; cv.u[2] = q[2]; cv.u[3] = q[3];
      F[idx] = cv.v;
    }
#pragma unroll
    for (int nt = 0; nt < 2; ++nt) {
      if (!(nt ? any1 : any0)) continue;
      const bool vv = nt ? v1 : v0;
      const bf16_t* up = sU + ((nt ? col1 : col0) - d) * 72 + fq * 8;
#pragma unroll
      for (int ks = 0; ks < 2; ++ks) {
        bf16x8 bf = (bf16x8){0, 0, 0, 0, 0, 0, 0, 0};
        if (vv) bf = *(const bf16x8*)(up + ks * 32);
#pragma unroll
        for (int m = 0; m < 4; ++m)
          acc[m][nt] = __builtin_amdgcn_mfma_f32_16x16x32_bf16(F[m + 2 - 2 * ks], bf, acc[m][nt], 0, 0, 0);
      }
    }
  }
  const float skip = p.filt_bias[ORDER * 512 + c];
  const int gcol = (ORDER == 0 ? 512 : 1024) + c;
  const bf16_t* graw = hyT + (size_t)gcol * NTOK + tok0;
  const float w0 = p.hy_conv_w[gcol], w1 = p.hy_conv_w[1536 + gcol], w2 = p.hy_conv_w[3072 + gcol], b = p.hy_conv_b[gcol];
  bf16_t* outT = (bf16_t*)(p.ws + (ORDER == 0 ? OFF_ZT : OFF_Y2T)) + (size_t)c * NTOK + tok0;
#pragma unroll
  for (int nt = 0; nt < 2; ++nt) {
    const int col = nt ? col1 : col0;
#pragma unroll
    for (int m = 0; m < 4; ++m) {
      const int t = col * 64 + 16 * m + 4 * fq, pos = t & (L - 1);
      const uint2 uu = *(const uint2*)(sU + col * 72 + 16 * m + 4 * fq);
      const uint2 gv = *(const uint2*)(graw + t);
      float x[6];
      x[0] = pos == 0 ? 0.f : bf2f(graw[t - 1]);
      x[1] = bflo(gv.x); x[2] = bfhi(gv.x); x[3] = bflo(gv.y); x[4] = bfhi(gv.y);
      x[5] = (pos + 4 == L) ? 0.f : bf2f(graw[t + 4]);
      const float u4[4] = {bflo(uu.x), bfhi(uu.x), bflo(uu.y), bfhi(uu.y)};
      float o[4];
#pragma unroll
      for (int j = 0; j < 4; ++j) {
        const float gate = w0 * x[j] + w1 * x[j + 1] + w2 * x[j + 2] + b;
        o[j] = gate * (acc[m][nt][j] + skip * u4[j]);
      }
      *(uint2*)(outT + t) = make_uint2(pack2(o[0], o[1]), pack2(o[2], o[3]));
    }
  }
}

__device__ __forceinline__ void rope32(float* y  , int pos) {
  const float prow = (float)(pos >> 6), pcol = (float)(pos & 63);
  const float fr[8] = {1.f, 0.31622776601683794f, 0.1f, 0.031622776601683794f, 0.01f, 0.0031622776601683794f, 0.001f, 0.00031622776601683794f};
#pragma unroll
  for (int i = 0; i < 8; ++i) {
    const float tr = prow * fr[i] * 0.15915494309189535f, tc = pcol * fr[i] * 0.15915494309189535f;
    const float sr = sin_turns(tr), cr = cos_turns(tr), sc = sin_turns(tc), cc = cos_turns(tc);
    const float a = y[i], b = y[8 + i], c2 = y[16 + i], d2 = y[24 + i];
    y[i] = a * cr - b * sr; y[8 + i] = b * cr + a * sr;
    y[16 + i] = c2 * cc - d2 * sc; y[24 + i] = d2 * cc + c2 * sc;
  }
}
__device__ __forceinline__ void unpack8(const uint4& v, float* x) {
  x[0] = bflo(v.x); x[1] = bfhi(v.x); x[2] = bflo(v.y); x[3] = bfhi(v.y);
  x[4] = bflo(v.z); x[5] = bfhi(v.z); x[6] = bflo(v.w); x[7] = bfhi(v.w);
}
__device__ __forceinline__ float sumsq8(const uint4& v) {
  float x[8];
  unpack8(v, x);
  return x[0] * x[0] + x[1] * x[1] + x[2] * x[2] + x[3] * x[3] + x[4] * x[4] + x[5] * x[5] + x[6] * x[6] + x[7] * x[7];
}
__device__ __forceinline__ uint4 scale8(const uint4& v, float r, const float* __restrict__ g) {
  float x[8];
  unpack8(v, x);
  const float4 g0 = *(const float4*)g, g1 = *(const float4*)(g + 4);
  return make_uint4(pack2(x[0] * r * g0.x, x[1] * r * g0.y), pack2(x[2] * r * g0.z, x[3] * r * g0.w),
                    pack2(x[4] * r * g1.x, x[5] * r * g1.y), pack2(x[6] * r * g1.z, x[7] * r * g1.w));
}
__device__ __forceinline__ void qk_item(const Params& p, int item) {
  const int tid = ltid();
  if (item < 512) {
    const int idx = item * 256 + tid, row = idx >> 3, h = idx & 7;
    const bf16_t* src = (const bf16_t*)(p.ws + OFF_QRAW) + (size_t)row * 768 + h * 96;
    bf16_t* dst = (bf16_t*)(p.ws + OFF_Q) + (size_t)row * 768 + h * 96;
    uint4 raw[12];
#pragma unroll
    for (int i = 0; i < 12; ++i) raw[i] = *(const uint4*)(src + 8 * i);
    float ss = 0.f;
#pragma unroll
    for (int i = 0; i < 12; ++i) ss += sumsq8(raw[i]);
    const float r = rsqrtf(ss * (1.f / 96.f) + 1e-6f);
    const float qs = 0.10206207261596575f * 1.4426950408889634f;
#pragma unroll
    for (int i = 0; i < 8; ++i) *(uint4*)(dst + 8 * i) = scale8(raw[i], r * qs, p.g_q + 8 * i);
    float y[32];
#pragma unroll
    for (int i = 0; i < 4; ++i) unpack8(raw[8 + i], y + 8 * i);
#pragma unroll
    for (int i = 0; i < 32; ++i) y[i] = y[i] * r * p.g_q[64 + i];
    if (row >= NCTX) rope32(y, (row - NCTX) & 4095);
#pragma unroll
    for (int i = 0; i < 4; ++i)
      *(uint4*)(dst + 64 + 8 * i) = make_uint4(pack2(y[8 * i] * qs, y[8 * i + 1] * qs), pack2(y[8 * i + 2] * qs, y[8 * i + 3] * qs),
                                               pack2(y[8 * i + 4] * qs, y[8 * i + 5] * qs), pack2(y[8 * i + 6] * qs, y[8 * i + 7] * qs));
  } else {
    const int idx = (item - 512) * 256 + tid, row = idx >> 3, h = idx & 7;
    const bf16_t* src = (const bf16_t*)(p.ws + OFF_KRAW) + (size_t)row * 512 + h * 64;
    uint4 raw[8];
#pragma unroll
    for (int i = 0; i < 8; ++i) raw[i] = *(const uint4*)(src + 8 * i);
    const float* kp = row < NTOK ? (const float*)(p.ws + OFF_KPE) + (size_t)row * 32 : p.cache_kpe + (size_t)(row - NTOK) * 32;
    float y[32];
#pragma unroll
    for (int i = 0; i < 8; ++i) {
      const float4 v = *(const float4*)(kp + 4 * i);
      y[4 * i] = v.x; y[4 * i + 1] = v.y; y[4 * i + 2] = v.z; y[4 * i + 3] = v.w;
    }
    float ss = 0.f;
#pragma unroll
    for (int i = 0; i < 8; ++i) ss += sumsq8(raw[i]);
#pragma unroll
    for (int i = 0; i < 32; ++i) ss += y[i] * y[i];
    const float r = rsqrtf(ss * (1.f / 96.f) + 1e-6f);
#pragma unroll
    for (int i = 0; i < 32; ++i) y[i] = y[i] * r * p.g_k[64 + i];
    bf16_t* dst;
    if (row < NCTX) dst = (bf16_t*)(p.ws + OFF_KC) + ((size_t)((row >> 8) * 8 + h) * 256 + (row & 255)) * 96;
    else if (row < NTOK) {
      const int rr = row - NCTX;
      rope32(y, rr & 4095);
      dst = (bf16_t*)(p.ws + OFF_KL) + ((size_t)((rr >> 12) * 8 + h) * 4608 + (rr & 4095)) * 96;
    } else {
      const int rr = row - NTOK;
      dst = (bf16_t*)(p.ws + OFF_KL) + ((size_t)((rr >> 9) * 8 + h) * 4608 + 4096 + (rr & 511)) * 96;
    }
#pragma unroll
    for (int i = 0; i < 8; ++i) *(uint4*)(dst + 8 * i) = scale8(raw[i], r, p.g_k + 8 * i);
#pragma unroll
    for (int i = 0; i < 4; ++i)
      *(uint4*)(dst + 64 + 8 * i) = make_uint4(pack2(y[8 * i], y[8 * i + 1]), pack2(y[8 * i + 2], y[8 * i + 3]),
                                               pack2(y[8 * i + 4], y[8 * i + 5]), pack2(y[8 * i + 6], y[8 * i + 7]));
  }
}

__device__ __forceinline__ void attn_item(const Params& p, int item, char* smem) {
  const int tid = ltid(), lane = tid & 63, wid = tid >> 6, lr = lane & 31, lh = lane >> 5;
  int nkeys, h, tokbase; const bf16_t *Kp, *Vp;
  if (item < 512) {
    const int b = item >> 8, rem = item & 255; h = rem >> 5; const int qb = rem & 31;
    nkeys = 4608; tokbase = NCTX + b * 4096 + qb * 128;
    Kp = (const bf16_t*)(p.ws + OFF_KL) + (size_t)(b * 8 + h) * 4608 * 96;
    Vp = (const bf16_t*)(p.ws + OFF_VTL) + (size_t)(b * 8 + h) * 64 * 4608;
  } else {
    const int it = item - 512, b = it >> 4; h = (it & 15) >> 1; const int qb = it & 1;
    nkeys = 256; tokbase = b * 256 + qb * 128;
    Kp = (const bf16_t*)(p.ws + OFF_KC) + (size_t)(b * 8 + h) * 256 * 96;
    Vp = (const bf16_t*)(p.ws + OFF_VTC) + (size_t)(b * 8 + h) * 64 * 256;
  }
  bf16_t* sK = (bf16_t*)smem;
  bf16_t* sV = sK + 64 * 104;
  const int token = tokbase + 32 * wid + lr;
  const bf16_t* qsrc = (const bf16_t*)(p.ws + OFF_Q) + (size_t)token * 768 + h * 96 + 8 * lh;
  bf16x8 qf[6];
#pragma unroll
  for (int ks = 0; ks < 6; ++ks) qf[ks] = *(const bf16x8*)(qsrc + 16 * ks);
  f32x16 oacc[2];
#pragma unroll
  for (int j = 0; j < 16; ++j) { oacc[0][j] = 0.f; oacc[1][j] = 0.f; }
  float mrun = -1e30f, lsum = 0.f;
  const int kk0 = tid / 12, kc0 = tid % 12, kk1 = (tid + 256) / 12, kc1 = (tid + 256) % 12, kk2 = (tid + 512) / 12, kc2 = (tid + 512) % 12;
  const int vd0 = tid >> 3, vc0 = tid & 7, vd1 = vd0 + 32;
  const bf16_t* gk0 = Kp + (size_t)kk0 * 96 + kc0 * 8;
  const bf16_t* gk1 = Kp + (size_t)kk1 * 96 + kc1 * 8;
  const bf16_t* gk2 = Kp + (size_t)kk2 * 96 + kc2 * 8;
  const bf16_t* gv0 = Vp + (size_t)vd0 * nkeys + vc0 * 8;
  const bf16_t* gv1 = Vp + (size_t)vd1 * nkeys + vc0 * 8;
  uint4 rk0 = *(const uint4*)gk0, rk1 = *(const uint4*)gk1, rk2 = *(const uint4*)gk2;
  uint4 rv0 = *(const uint4*)gv0, rv1 = *(const uint4*)gv1;
  const int nt = nkeys >> 6;
  for (int kt = 0; kt < nt; ++kt) {
    __syncthreads();
    *(uint4*)(sK + kk0 * 104 + kc0 * 8) = rk0; *(uint4*)(sK + kk1 * 104 + kc1 * 8) = rk1; *(uint4*)(sK + kk2 * 104 + kc2 * 8) = rk2;
    *(uint4*)(sV + vd0 * 72 + vc0 * 8) = rv0; *(uint4*)(sV + vd1 * 72 + vc0 * 8) = rv1;
    __syncthreads();
    if (kt + 1 < nt) {
      gk0 += 64 * 96; gk1 += 64 * 96; gk2 += 64 * 96; gv0 += 64; gv1 += 64;
      rk0 = *(const uint4*)gk0; rk1 = *(const uint4*)gk1; rk2 = *(const uint4*)gk2;
      rv0 = *(const uint4*)gv0; rv1 = *(const uint4*)gv1;
    }
    __builtin_amdgcn_sched_barrier(0);
    f32x16 sacc[2];
#pragma unroll
    for (int kb = 0; kb < 2; ++kb) {
#pragma unroll
      for (int j = 0; j < 16; ++j) sacc[kb][j] = 0.f;
#pragma unroll
      for (int ks = 0; ks < 6; ++ks) {
        const bf16x8 a = *(const bf16x8*)(sK + (32 * kb + lr) * 104 + 16 * ks + 8 * lh);
        sacc[kb] = __builtin_amdgcn_mfma_f32_32x32x16_bf16(a, qf[ks], sacc[kb], 0, 0, 0);
      }
    }
    float mx = sacc[0][0];
#pragma unroll
    for (int j = 1; j < 16; ++j) mx = fmaxf(mx, sacc[0][j]);
#pragma unroll
    for (int j = 0; j < 16; ++j) mx = fmaxf(mx, sacc[1][j]);
    mx = fmaxf(mx, __shfl_xor(mx, 32));
    const float mnew = fmaxf(mrun, mx);
    const float alpha = __builtin_amdgcn_exp2f(mrun - mnew);
    mrun = mnew;
    float ps = 0.f;
#pragma unroll
    for (int kb = 0; kb < 2; ++kb)
#pragma unroll
      for (int j = 0; j < 16; ++j) { const float e = __builtin_amdgcn_exp2f(sacc[kb][j] - mnew); sacc[kb][j] = e; ps += e; }
    lsum = lsum * alpha + ps;
#pragma unroll
    for (int j = 0; j < 16; ++j) { oacc[0][j] *= alpha; oacc[1][j] *= alpha; }
#pragma unroll
    for (int s = 0; s < 4; ++s) {
      const int kb = s >> 1, jb = 8 * (s & 1);
      union { unsigned u[4]; bf16x8 v; } pf;
      pf.u[0] = pack2(sacc[kb][jb + 0], sacc[kb][jb + 1]); pf.u[1] = pack2(sacc[kb][jb + 2], sacc[kb][jb + 3]);
      pf.u[2] = pack2(sacc[kb][jb + 4], sacc[kb][jb + 5]); pf.u[3] = pack2(sacc[kb][jb + 6], sacc[kb][jb + 7]);
#pragma unroll
      for (int mt = 0; mt < 2; ++mt) {
        const bf16_t* vp = sV + (32 * mt + lr) * 72 + 16 * s + 4 * lh;
        union { uint2 d[2]; bf16x8 v; } av;
        av.d[0] = *(const uint2*)vp;
        av.d[1] = *(const uint2*)(vp + 8);
        oacc[mt] = __builtin_amdgcn_mfma_f32_32x32x16_bf16(av.v, pf.v, oacc[mt], 0, 0, 0);
      }
    }
  }
  lsum += __shfl_xor(lsum, 32);
  const float inv = 1.f / lsum;
  bf16_t* dst = (bf16_t*)(p.ws + OFF_ATTN) + (size_t)token * 512 + h * 64;
#pragma unroll
  for (int mt = 0; mt < 2; ++mt)
#pragma unroll
    for (int jg = 0; jg < 4; ++jg) {
      const int dv0 = 32 * mt + 8 * jg + 4 * lh;
      *(uint2*)(dst + dv0) = make_uint2(pack2(oacc[mt][4 * jg] * inv, oacc[mt][4 * jg + 1] * inv),
                                        pack2(oacc[mt][4 * jg + 2] * inv, oacc[mt][4 * jg + 3] * inv));
    }
}

__device__ __forceinline__ void merge_item(const Params& p, int item, char* smem) {
  const int tid = ltid(), lane = tid & 63, wid = tid >> 6, t0 = item * 32;
  bf16_t* mix = (bf16_t*)(p.ws + OFF_H);
  const bf16_t* attn = (const bf16_t*)(p.ws + OFF_ATTN);
  for (int tt = 0; tt < 8; ++tt) {
    const int token = t0 + wid * 8 + tt;
    float x[8];
    unpack8(*(const uint4*)(attn + (size_t)token * 512 + lane * 8), x);
    float ss = 0.f;
#pragma unroll
    for (int i = 0; i < 8; ++i) ss += x[i] * x[i];
    ss = wave_sum(ss);
    const float r = rsqrtf(ss * (1.f / 512.f) + 1e-6f);
    const float4 g0 = *(const float4*)(p.g_out_att + lane * 8), g1 = *(const float4*)(p.g_out_att + lane * 8 + 4);
    *(uint4*)(mix + (size_t)token * D + lane * 8) =
        make_uint4(pack2(x[0] * r * g0.x, x[1] * r * g0.y), pack2(x[2] * r * g0.z, x[3] * r * g0.w),
                   pack2(x[4] * r * g1.x, x[5] * r * g1.y), pack2(x[6] * r * g1.z, x[7] * r * g1.w));
  }
  bf16_t* sT = (bf16_t*)smem;
  const bf16_t* y2T = (const bf16_t*)(p.ws + OFF_Y2T);
  __syncthreads();
  for (int ch = tid; ch < 2048; ch += 256) {
    const int c = ch >> 2, q4 = ch & 3;
    const uint4 v = *(const uint4*)(y2T + (size_t)c * NTOK + t0 + q4 * 8);
    bf16_t* d = sT + (q4 * 8) * 520 + c;
    d[0 * 520] = (bf16_t)(v.x & 0xffff); d[1 * 520] = (bf16_t)(v.x >> 16);
    d[2 * 520] = (bf16_t)(v.y & 0xffff); d[3 * 520] = (bf16_t)(v.y >> 16);
    d[4 * 520] = (bf16_t)(v.z & 0xffff); d[5 * 520] = (bf16_t)(v.z >> 16);
    d[6 * 520] = (bf16_t)(v.w & 0xffff); d[7 * 520] = (bf16_t)(v.w >> 16);
  }
  __syncthreads();
  {
    const int tt = tid >> 3, part = tid & 7;
    uint4 v[8];
    float ss = 0.f;
#pragma unroll
    for (int i = 0; i < 8; ++i) {
      v[i] = *(const uint4*)(sT + tt * 520 + part * 64 + 8 * i);
      float x[8];
      unpack8(v[i], x);
#pragma unroll
      for (int e = 0; e < 8; ++e) ss += x[e] * x[e];
    }
    ss += __shfl_xor(ss, 1); ss += __shfl_xor(ss, 2); ss += __shfl_xor(ss, 4);
    const float r = rsqrtf(ss * (1.f / 512.f) + 1e-6f);
#pragma unroll
    for (int i = 0; i < 8; ++i) {
      float x[8];
      unpack8(v[i], x);
      const int c0 = part * 64 + 8 * i;
      const float4 g0 = *(const float4*)(p.g_out_hy + c0), g1 = *(const float4*)(p.g_out_hy + c0 + 4);
      *(uint4*)(mix + (size_t)(t0 + tt) * D + 512 + c0) =
          make_uint4(pack2(x[0] * r * g0.x, x[1] * r * g0.y), pack2(x[2] * r * g0.z, x[3] * r * g0.w),
                     pack2(x[4] * r * g1.x, x[5] * r * g1.y), pack2(x[6] * r * g1.z, x[7] * r * g1.w));
    }
  }
}

__device__ __forceinline__ void actfix_item(const Params& p, int item) {
  const int idx = item * 256 + ltid();
  if (idx >= 512 * 352) return;
  const int j = (idx % 352) * 8, rowi = idx / 352, wt = rowi >> 1, which = rowi & 1;
  const int t = 64 * wt + 63 * which, L = t < NCTX ? SEQC : SEQL, pos = t & (L - 1);
  const bf16_t* edge = (const bf16_t*)(p.ws + OFF_EDGE);
  bf16_t* act = (bf16_t*)(p.ws + OFF_U);
  const bf16_t *pr, *cu, *nx;
  bool zp = false, zn = false;
  if (which == 0) { zp = pos == 0; pr = edge + (size_t)((zp ? wt : wt - 1) * 4 + 3) * 5632; cu = edge + (size_t)(wt * 4 + 0) * 5632; nx = edge + (size_t)(wt * 4 + 1) * 5632; }
  else { zn = pos == L - 1; pr = edge + (size_t)(wt * 4 + 2) * 5632; cu = edge + (size_t)(wt * 4 + 3) * 5632; nx = edge + (size_t)((zn ? wt : wt + 1) * 4 + 0) * 5632; }
  float pa[8], pg[8], ca[8], cgv[8], na[8], ng[8];
  unpack8(*(const uint4*)(pr + j), pa); unpack8(*(const uint4*)(pr + 2816 + j), pg);
  unpack8(*(const uint4*)(cu + j), ca); unpack8(*(const uint4*)(cu + 2816 + j), cgv);
  unpack8(*(const uint4*)(nx + j), na); unpack8(*(const uint4*)(nx + 2816 + j), ng);
  float o[8];
#pragma unroll
  for (int e = 0; e < 8; ++e) {
    const float pae = zp ? 0.f : pa[e], pge = zp ? 0.f : pg[e], nae = zn ? 0.f : na[e], nge = zn ? 0.f : ng[e];
    const float a = p.ffn_conv_w[j + e] * pae + p.ffn_conv_w[5632 + j + e] * ca[e] + p.ffn_conv_w[11264 + j + e] * nae + p.ffn_conv_b[j + e];
    const float g = p.ffn_conv_w[2816 + j + e] * pge + p.ffn_conv_w[5632 + 2816 + j + e] * cgv[e] + p.ffn_conv_w[11264 + 2816 + j + e] * nge + p.ffn_conv_b[2816 + j + e];
    o[e] = a / (1.f + __expf(-a)) * g;
  }
  *(uint4*)(act + (size_t)t * 2816 + j) = make_uint4(pack2(o[0], o[1]), pack2(o[2], o[3]), pack2(o[4], o[5]), pack2(o[6], o[7]));
}

#define XB_TMO      128
#define XB_XCNT(j)  (256  + 64 * (j))
#define XB_XSUB(j)  (1280 + 64 * (j))
#define XB_XGEN(j)  (2304 + 64 * (j))
#define XB_TOP      3328
#define XB_TOPGEN   3392
#define XCD_BAR_WORDS 3456
#define XB_SPIN_CAP (1u << 20)
#define LAS __attribute__((address_space(3)))
__device__ __forceinline__ unsigned xb_ld(unsigned* p) { return __hip_atomic_load(p, __ATOMIC_RELAXED, __HIP_MEMORY_SCOPE_AGENT); }
__device__ __forceinline__ unsigned xb_add(unsigned* p, unsigned v) { return __hip_atomic_fetch_add(p, v, __ATOMIC_RELAXED, __HIP_MEMORY_SCOPE_AGENT); }
__device__ __forceinline__ unsigned xb_xcc_id() { return (unsigned)__builtin_amdgcn_s_getreg((3 << 11) | 20) & 0xFu; }
#define XB_SPIN(cond, bar) do { unsigned _sp = 0; while (cond) { __builtin_amdgcn_s_sleep(1); \
    if ((++_sp & 255u) == 0u) { if (xb_ld(&(bar)[XB_TMO])) break; if (_sp > XB_SPIN_CAP) { atomicAdd(&(bar)[XB_TMO], 1u); break; } } } } while (0)
struct XcdBarrier { unsigned* bar; unsigned x; volatile LAS unsigned* st; };
__device__ __forceinline__ XcdBarrier xcd_barrier_post(unsigned* bar, volatile LAS unsigned* st) {
  XcdBarrier b; b.bar = bar; b.x = xb_xcc_id(); b.st = st;
  if (threadIdx.x == 0) (void)xb_add(&bar[XB_XCNT(b.x)], 1u);
  return b;
}
__device__ __forceinline__ void xcd_barrier_complete(unsigned* bar, unsigned x, unsigned& nloc, unsigned& nx) {
  const unsigned G = gridDim.x * gridDim.y * gridDim.z;
  unsigned sum, cnt, mine, sp = 0u;
  for (;;) {
    sum = 0u; cnt = 0u; mine = 0u;
#pragma unroll
    for (unsigned j = 0; j < 16; ++j) { const unsigned c = xb_ld(&bar[XB_XCNT(j)]); sum += c; cnt += (c > 0u) ? 1u : 0u; mine = (j == x) ? c : mine; }
    if (sum == G) break;
    __builtin_amdgcn_s_sleep(1);
    if ((++sp & 255u) == 0u) { if (xb_ld(&bar[XB_TMO])) break; if (sp > XB_SPIN_CAP) { atomicAdd(&bar[XB_TMO], 1u); break; } }
  }
  nloc = mine > 0u ? mine : 1u; nx = cnt > 0u ? cnt : 1u;
}
__device__ __forceinline__ void xcd_barrier(const XcdBarrier& b) {
  asm volatile("s_waitcnt vmcnt(0)" ::: "memory");
  __syncthreads();
  if (threadIdx.x == 0) {
    unsigned* bar = b.bar;
    __builtin_amdgcn_s_waitcnt(0);
    unsigned nloc = b.st[0], nx = b.st[1];
    if (nloc == 0u) { xcd_barrier_complete(bar, b.x, nloc, nx); b.st[0] = nloc; b.st[1] = nx; }
    const unsigned old = xb_add(&bar[XB_XSUB(b.x)], 1u);
    const unsigned gen = old / nloc;
    if (old + 1u == (gen + 1u) * nloc) {
      __builtin_amdgcn_fence(__ATOMIC_RELEASE, "agent");
      asm volatile("s_waitcnt vmcnt(0)" ::: "memory");
      const unsigned og = xb_add(&bar[XB_TOP], 1u);
      const unsigned tg = og / nx;
      if (og + 1u == (tg + 1u) * nx) xb_add(&bar[XB_TOPGEN], 1u);
      else XB_SPIN(xb_ld(&bar[XB_TOPGEN]) == tg, bar);
      __builtin_amdgcn_fence(__ATOMIC_ACQUIRE, "agent");
      xb_add(&bar[XB_XGEN(b.x)], 1u);
      asm volatile("s_waitcnt vmcnt(0)" ::: "memory");
    } else {
      XB_SPIN(xb_ld(&bar[XB_XGEN(b.x)]) == gen, bar);
      __builtin_amdgcn_fence(__ATOMIC_ACQUIRE, "agent");
      asm volatile("s_waitcnt vmcnt(0)" ::: "memory");
    }
  }
  __syncthreads();
}
constexpr size_t OFF_BAR = 25 * MiB - 16384;
static_assert(OFF_MOD + 3 * 6144 * 4 <= OFF_BAR, "bar");

template <int ph>
__device__ __forceinline__ void run_phase(const Params& p, char* smem) {
  const int bid = blockIdx.x, G = gridDim.x;
  char* ws = p.ws;
  if constexpr (ph == 0) {
    for (int it = bid; it < 272 + 96 + 32 + 3080; it += G) {
      if (it < 272) filter_item(p, it, smem);
      else if (it < 368) mod_item(p, it - 272, smem);
      else if (it < 400) cache_item(p, it - 368);
      else {
        int t = it - 400;
        if (t < 576) transpose_item(p.w_in, 1024, DIN, (bf16_t*)(ws + OFF_WIN), t, 36, smem);
        else if ((t -= 576) < 72) transpose_item(p.w_uq, 384, 768, (bf16_t*)(ws + OFF_WUQ), t, 12, smem);
        else if ((t -= 72) < 64) transpose_item(p.w_ukv, 256, 1024, (bf16_t*)(ws + OFF_WUKV), t, 16, smem);
        else if ((t -= 64) < 256) transpose_item(p.w_out, 1024, 1024, (bf16_t*)(ws + OFF_WOUT), t, 16, smem);
        else if ((t -= 256) < 1408) transpose_item(p.w_up, 1024, 5632, (bf16_t*)(ws + OFF_WUP), t, 88, smem, true);
        else { t -= 1408; transpose_item(p.w_down, 2816, 1024, (bf16_t*)(ws + OFF_WDOWN), t, 16, smem); }
      }
    }
  } else if constexpr (ph == 1) {
    rmsmod_phase<0>(p);
  } else if constexpr (ph == 2) {
    EpiIn epi{(float*)(ws + OFF_PROJ), (bf16_t*)(ws + OFF_HYT)};
    for (int t = bid; t < 128 * 18; t += G)
      gemm_tile<false>((const bf16_t*)(ws + OFF_H), 1024, (const bf16_t*)(ws + OFF_WIN), 1024, 1024, (t / 18) * 128, (t % 18) * 128, smem, epi);
  } else if constexpr (ph == 3) {
    for (int it = bid; it < 512; it += G) hyena_item<0>(p, 1, it, smem);
    for (int it = bid; it < 512; it += G) hyena_item<0>(p, 0, it, smem);
    for (int it = bid; it < 256; it += G) token_item(p, it);
  } else if constexpr (ph == 4) {
    EpiQ eq{(bf16_t*)(ws + OFF_QRAW)};
    EpiKV ekv{(bf16_t*)(ws + OFF_KRAW), (bf16_t*)(ws + OFF_VTC), (bf16_t*)(ws + OFF_VTL)};
    for (int it = bid; it < 512; it += G) hyena_item<1>(p, 1, it, smem);
    for (int t = bid; t < 768; t += G) gemm_tile<true>((const bf16_t*)(ws + OFF_QA), 384, (const bf16_t*)(ws + OFF_WUQ), 384, 384, (t / 6) * 128, (t % 6) * 128, smem, eq);
    for (int t = bid; t < 1088; t += G) gemm_tile<false>((const bf16_t*)(ws + OFF_CKVN), 256, (const bf16_t*)(ws + OFF_WUKV), 256, 256, (t / 8) * 128, (t % 8) * 128, smem, ekv);
    for (int it = bid; it < 512; it += G) hyena_item<1>(p, 0, it, smem);
  } else if constexpr (ph == 5) {
    for (int it = bid; it < 512 + 544; it += G) qk_item(p, it);
  } else if constexpr (ph == 6) {
    for (int it = bid; it < 1024; it += G) attn_item(p, it, smem);
  } else if constexpr (ph == 7) {
    for (int it = bid; it < 512; it += G) merge_item(p, it, smem);
  } else if constexpr (ph == 8) {
    EpiOut epi{&p};
    for (int t = bid; t < 128 * 8; t += G)
      gemm_tile<true>((const bf16_t*)(ws + OFF_H), 1024, (const bf16_t*)(ws + OFF_WOUT), 1024, 1024, (t / 8) * 128, (t % 8) * 128, smem, epi);
  } else if constexpr (ph == 9) {
    rmsmod_phase<1>(p);
  } else if constexpr (ph == 10) {
    for (int t = bid; t < 128 * 44; t += G) gemm_up_act_tile(p, (t / 44) * 128, (t % 44) * 128, smem);
  } else if constexpr (ph == 11) {
    for (int it = bid; it < 704; it += G) actfix_item(p, it);
  } else if constexpr (ph == 12) {
    EpiY epi{&p, 0};
    for (int t = bid; t < 128 * 8; t += G)
      gemm_tile<true>((const bf16_t*)(ws + OFF_U), 2816, (const bf16_t*)(ws + OFF_WDOWN), 2816, 2816, (t / 8) * 128, (t % 8) * 128, smem, epi);
  }
}

#if ONE_LAUNCH
template <int PH>
__device__ __forceinline__ void run_all(const Params& p, char* smem, cg::grid_group& grid, const XcdBarrier& xb) {
  run_phase<PH>(p, smem);
  if constexpr (((DBL_MASK >> PH) & 1) != 0) { xcd_barrier(xb); run_phase<PH>(p, smem); }
  if constexpr (PH < 12) {
    xcd_barrier(xb);
    run_all<PH + 1>(p, smem, grid, xb);
  }
}
__global__ void __launch_bounds__(256, 2) mega_kernel(Params p) {
  __shared__ __attribute__((aligned(16))) char smem[SMEM_BYTES];
  __shared__ uint4 xb_words;
  cg::grid_group grid = cg::this_grid();
  if (threadIdx.x == 0) xb_words = make_uint4(0u, 0u, 0u, 0u);
  __syncthreads();
  XcdBarrier xb = xcd_barrier_post((unsigned*)(p.ws + OFF_BAR), (volatile LAS unsigned*)&xb_words);
  if (p.ws == nullptr) grid.sync();
  run_all<0>(p, smem, grid, xb);
}
#else
template <int PH>
__global__ void __launch_bounds__(256, 2) phase_kernel(Params p) {
  __shared__ __attribute__((aligned(16))) char smem[SMEM_BYTES];
  run_phase<PH>(p, smem);
}
#ifndef DBG_STOP
#define DBG_STOP 15
#endif
__global__ void dump_kernel(Params p, size_t off, int count) {
  const bf16_t* src = (const bf16_t*)(p.ws + off);
  const bf16_t* src2 = (const bf16_t*)(p.ws + DBG_OFF2);
  for (int i = blockIdx.x * 256 + threadIdx.x; i < 16777216; i += gridDim.x * 256)
    p.out[i] = i < DBG_CNT ? bf2f(src[i]) : (i - DBG_CNT < DBG_CNT2 ? bf2f(src2[i - DBG_CNT]) : 0.f);
}
template <int PH>
static void launch_all(const Params& p, hipStream_t stream) {
  phase_kernel<PH><<<512, 256, 0, stream>>>(p);
  if constexpr (PH < 12) launch_all<PH + 1>(p, stream);
}
#endif

extern "C" void kernel_launch(void* const* d_in, const int* in_sizes, int n_in, void* d_out, int out_size, void* d_ws,
                              size_t ws_size, hipStream_t stream) {
  Params p{};
  const float** pp = (const float**)&p;
  for (int i = 0; i < 34; ++i) pp[i] = (const float*)d_in[i];
  p.out = (float*)d_out;
  p.ws = (char*)d_ws;
#if ONE_LAUNCH
  (void)hipMemsetAsync((char*)d_ws + OFF_BAR, 0, XCD_BAR_WORDS * 4, stream);
  static int grid_blocks = 0;
  if (!grid_blocks) {
    int dev = 0, cus = 0, per_cu = 0;
    hipGetDevice(&dev);
    hipDeviceGetAttribute(&cus, hipDeviceAttributeMultiprocessorCount, dev);
    hipOccupancyMaxActiveBlocksPerMultiprocessor(&per_cu, mega_kernel, 256, 0);
    grid_blocks = cus * per_cu;
  }
  void* args[] = {&p};
  hipError_t e = hipLaunchCooperativeKernel((void*)mega_kernel, dim3(grid_blocks), dim3(256), args, 0, stream);
  if (e != hipSuccess) fprintf(stderr, "cooperative launch failed: %s (grid %d)\n", hipGetErrorString(e), grid_blocks);
#else
  launch_all<0>(p, stream);
#if DBG_STOP < 15
  dump_kernel<<<1024, 256, 0, stream>>>(p, DBG_OFF, DBG_CNT);
#endif
#endif
}
```

```cpp
#include <hip/hip_runtime.h>
#include <hip/hip_cooperative_groups.h>
#include <cstdio>
namespace cg = cooperative_groups;

#define DBG_STOP 15
#define DBG_NOHY 0
#ifndef DBL_MASK
#define DBL_MASK 0
#endif
#define DBG_OFF OFF_QRAW
#define DBG_OFF2 OFF_KRAW
#define DBG_CNT 12582912
#define DBG_CNT2 0
#ifndef ONE_LAUNCH
#define ONE_LAUNCH 1
#endif

typedef unsigned short bf16_t;
typedef short bf16x8 __attribute__((ext_vector_type(8)));
typedef float f32x4 __attribute__((ext_vector_type(4)));
typedef float f32x16 __attribute__((ext_vector_type(16)));

constexpr int D = 1024, NTOK = 16384, NCTX = 8192, SEQC = 256, SEQL = 4096;
constexpr int DIN = 2208, DINP = 2304, QL = 384, KVL = 256, DFF = 2816;
constexpr int NROWKV = 17408;
constexpr size_t MiB = 1048576;

constexpr size_t OFF_WIN = 0;
constexpr size_t OFF_WUQ = OFF_WIN + (size_t)DINP * 1024 * 2;
constexpr size_t OFF_WUKV = OFF_WUQ + (size_t)768 * 384 * 2;
constexpr size_t OFF_WOUT = OFF_WUKV + (size_t)1024 * 256 * 2;
constexpr size_t OFF_WUP = OFF_WOUT + (size_t)1024 * 1024 * 2;
constexpr size_t OFF_WDOWN = OFF_WUP + (size_t)5632 * 1024 * 2;
constexpr size_t OFF_MOD = OFF_WDOWN + (size_t)1024 * 2816 * 2;
static_assert(OFF_MOD + 3 * 6144 * 4 <= 25 * MiB, "A region");
constexpr size_t OFF_RLAT = 25 * MiB;
constexpr size_t OFF_RCTX = 41 * MiB;
constexpr size_t OFF_H = 42 * MiB;
constexpr size_t OFF_ZT = 42 * MiB;
constexpr size_t OFF_QA = 58 * MiB;
constexpr size_t OFF_KPE = 70 * MiB;
constexpr size_t OFF_PROJ = 74 * MiB;
constexpr size_t OFF_QRAW = 74 * MiB;
constexpr size_t OFF_Y2T = 98 * MiB;
constexpr size_t OFF_ATTN = 74 * MiB;
constexpr size_t OFF_U = 74 * MiB;
constexpr size_t OFF_HYT = 116 * MiB;
constexpr size_t OFF_Q = 116 * MiB;
constexpr size_t OFF_KC = 140 * MiB;
constexpr size_t OFF_KL = 152 * MiB;
constexpr size_t OFF_CKVN = 164 * MiB;
constexpr size_t OFF_KRAW = 173 * MiB;
constexpr size_t OFF_VTC = 190 * MiB;
constexpr size_t OFF_VTL = 198 * MiB;
constexpr size_t OFF_ACT = 162 * MiB;

constexpr int OUT_YS = 0;
constexpr int OUT_CKV = 16777216;
constexpr int OUT_KPE = 16777216 + 2097152;

constexpr int SMEM_BYTES = 51200;

struct Params {
  const float *x_prompt, *x_sample, *cache_ckv, *cache_kpe, *c, *c_ctx, *w_ada, *b_ada, *g_mix, *w_in, *g_qa, *w_uq,
      *g_kva, *w_ukv, *g_q, *g_k, *hy_conv_w, *hy_conv_b, *filt_w1, *filt_b1, *filt_freq1, *filt_w2, *filt_b2,
      *filt_freq2, *filt_w3, *filt_bias, *g_out_att, *g_out_hy, *w_out, *g_ffn, *w_up, *ffn_conv_w, *ffn_conv_b, *w_down;
  float* out;
  char* ws;
};

typedef __bf16 bf16x2_t __attribute__((ext_vector_type(2)));
__device__ __forceinline__ unsigned pack2(float lo, float hi) {
  bf16x2_t v;
  v[0] = (__bf16)lo;
  v[1] = (__bf16)hi;
  return __builtin_bit_cast(unsigned, v);
}
__device__ __forceinline__ float bflo(unsigned u) { return __uint_as_float(u << 16); }
__device__ __forceinline__ float bfhi(unsigned u) { return __uint_as_float(u & 0xffff0000u); }
__device__ __forceinline__ float bf2f(bf16_t h) { return __uint_as_float(((unsigned)h) << 16); }
__device__ __forceinline__ bf16_t f2bf(float f) { return (bf16_t)(pack2(f, 0.f) & 0xffffu); }
__device__ __forceinline__ float wave_sum(float v) {
#pragma unroll
  for (int o = 32; o >= 1; o >>= 1) v += __shfl_xor(v, o);
  return v;
}
__device__ __forceinline__ int ltid() { int t = threadIdx.x; asm volatile("" : "+v"(t)); return t; }
__device__ __forceinline__ float sin_turns(float t) { t -= floorf(t); return __builtin_amdgcn_sinf(t); }
__device__ __forceinline__ float cos_turns(float t) { t -= floorf(t); return __builtin_amdgcn_cosf(t); }
__device__ __forceinline__ float sin_rad(float x) { return sin_turns(x * 0.15915494309189535f); }
__device__ __forceinline__ const float* xrow(const Params& p, int row) {
  return row < NCTX ? p.x_prompt + (size_t)row * D : p.x_sample + (size_t)(row - NCTX) * D;
}
__device__ __forceinline__ int modidx(int row) { return row < NCTX ? 0 : 1 + ((row - NCTX) >> 12); }

template <bool SWAP>
__device__ __forceinline__ void gemm_main(const bf16_t* __restrict__ A, int lda, const bf16_t* __restrict__ Bt, int ldb,
                                          int K, int m0, int n0, char* smem, f32x4 (&acc)[4][4]) {
  const int tid = ltid(), lane = tid & 63, wid = tid >> 6, wr = wid >> 1, wc = wid & 1;
  const int fr = lane & 15, fq = lane >> 4;
  bf16_t* sA = (bf16_t*)smem;
  bf16_t* sB = sA + 128 * 72;
#pragma unroll
  for (int m = 0; m < 4; ++m)
#pragma unroll
    for (int n = 0; n < 4; ++n) acc[m][n] = (f32x4){0.f, 0.f, 0.f, 0.f};
  const int lr = tid >> 3, lc = (tid & 7) * 8;
  const bf16_t* ga = A + (size_t)(m0 + lr) * lda + lc;
  const bf16_t* gb = Bt + (size_t)(n0 + lr) * ldb + lc;
  const size_t sa32 = (size_t)32 * lda, sb32 = (size_t)32 * ldb;
  uint4 ra0 = *(const uint4*)(ga), ra1 = *(const uint4*)(ga + sa32), ra2 = *(const uint4*)(ga + 2 * sa32), ra3 = *(const uint4*)(ga + 3 * sa32);
  uint4 rb0 = *(const uint4*)(gb), rb1 = *(const uint4*)(gb + sb32), rb2 = *(const uint4*)(gb + 2 * sb32), rb3 = *(const uint4*)(gb + 3 * sb32);
  const int nk = K >> 6;
  bf16_t* wa = sA + lr * 72 + lc;
  bf16_t* wb = sB + lr * 72 + lc;
  for (int kt = 0; kt < nk; ++kt) {
    __syncthreads();
    *(uint4*)(wa) = ra0; *(uint4*)(wa + 32 * 72) = ra1; *(uint4*)(wa + 64 * 72) = ra2; *(uint4*)(wa + 96 * 72) = ra3;
    *(uint4*)(wb) = rb0; *(uint4*)(wb + 32 * 72) = rb1; *(uint4*)(wb + 64 * 72) = rb2; *(uint4*)(wb + 96 * 72) = rb3;
    __syncthreads();
    if (kt + 1 < nk) {
      ga += 64;
      gb += 64;
      ra0 = *(const uint4*)(ga); ra1 = *(const uint4*)(ga + sa32); ra2 = *(const uint4*)(ga + 2 * sa32); ra3 = *(const uint4*)(ga + 3 * sa32);
      rb0 = *(const uint4*)(gb); rb1 = *(const uint4*)(gb + sb32); rb2 = *(const uint4*)(gb + 2 * sb32); rb3 = *(const uint4*)(gb + 3 * sb32);
    }
    __builtin_amdgcn_sched_barrier(0);
#pragma unroll
    for (int ks = 0; ks < 2; ++ks) {
      bf16x8 af[4], bfr[4];
#pragma unroll
      for (int m = 0; m < 4; ++m) af[m] = *(const bf16x8*)(sA + (wr * 64 + m * 16 + fr) * 72 + ks * 32 + fq * 8);
#pragma unroll
      for (int n = 0; n < 4; ++n) bfr[n] = *(const bf16x8*)(sB + (wc * 64 + n * 16 + fr) * 72 + ks * 32 + fq * 8);
      __builtin_amdgcn_s_setprio(1);
#pragma unroll
      for (int m = 0; m < 4; ++m)
#pragma unroll
        for (int n = 0; n < 4; ++n) {
          if (SWAP) acc[m][n] = __builtin_amdgcn_mfma_f32_16x16x32_bf16(bfr[n], af[m], acc[m][n], 0, 0, 0);
          else acc[m][n] = __builtin_amdgcn_mfma_f32_16x16x32_bf16(af[m], bfr[n], acc[m][n], 0, 0, 0);
        }
      __builtin_amdgcn_s_setprio(0);
    }
  }
}
template <bool SWAP, class Epi>
__device__ __forceinline__ void gemm_tile(const bf16_t* __restrict__ A, int lda, const bf16_t* __restrict__ Bt, int ldb,
                                          int K, int m0, int n0, char* smem, const Epi& epi) {
  f32x4 acc[4][4];
  gemm_main<SWAP>(A, lda, Bt, ldb, K, m0, n0, smem, acc);
  const int tid = ltid(), lane = tid & 63, wid = tid >> 6, wr = wid >> 1, wc = wid & 1;
  const int fr = lane & 15, fq = lane >> 4;
#pragma unroll
  for (int m = 0; m < 4; ++m)
#pragma unroll
    for (int n = 0; n < 4; ++n) {
      if (SWAP) epi(m0 + wr * 64 + m * 16 + fr, n0 + wc * 64 + n * 16 + fq * 4, acc[m][n]);
      else epi(m0 + wr * 64 + m * 16 + fq * 4, n0 + wc * 64 + n * 16 + fr, acc[m][n]);
    }
}

constexpr size_t OFF_EDGE = 162 * MiB;
__device__ __forceinline__ void gemm_up_act_tile(const Params& p, int m0, int n0, char* smem) {
  f32x4 acc[4][4];
  gemm_main<true>((const bf16_t*)(p.ws + OFF_H), 1024, (const bf16_t*)(p.ws + OFF_WUP), 1024, 1024, m0, n0, smem, acc);
  const int tid = ltid(), lane = tid & 63, wid = tid >> 6, wr = wid >> 1, wc = wid & 1;
  const int fr = lane & 15, fq = lane >> 4;
  bf16_t* act = (bf16_t*)(p.ws + OFF_U);
  bf16_t* edge = (bf16_t*)(p.ws + OFF_EDGE);
  const int rowbase = m0 + wr * 64, wt = rowbase >> 6;
  const int upl = (lane + 63) & 63, upl2 = (lane + 15) & 63, dnl = (lane + 1) & 63, dnl2 = (lane + 49) & 63;
#pragma unroll
  for (int i = 0; i < 2; ++i) {
    const int cperm = n0 + wc * 64 + 32 * i;
    const int j0 = (cperm >> 5) * 16 + 4 * fq;
    const float4 wa0 = *(const float4*)(p.ffn_conv_w + j0), wa1 = *(const float4*)(p.ffn_conv_w + 5632 + j0), wa2 = *(const float4*)(p.ffn_conv_w + 11264 + j0);
    const float4 wg0 = *(const float4*)(p.ffn_conv_w + 2816 + j0), wg1 = *(const float4*)(p.ffn_conv_w + 5632 + 2816 + j0), wg2 = *(const float4*)(p.ffn_conv_w + 11264 + 2816 + j0);
    const float4 ba = *(const float4*)(p.ffn_conv_b + j0), bg = *(const float4*)(p.ffn_conv_b + 2816 + j0);
    const float w0a[4] = {wa0.x, wa0.y, wa0.z, wa0.w}, w1a[4] = {wa1.x, wa1.y, wa1.z, wa1.w}, w2a[4] = {wa2.x, wa2.y, wa2.z, wa2.w};
    const float w0g[4] = {wg0.x, wg0.y, wg0.z, wg0.w}, w1g[4] = {wg1.x, wg1.y, wg1.z, wg1.w}, w2g[4] = {wg2.x, wg2.y, wg2.z, wg2.w};
    const float bba[4] = {ba.x, ba.y, ba.z, ba.w}, bbg[4] = {bg.x, bg.y, bg.z, bg.w};
#pragma unroll
    for (int m = 0; m < 4; ++m) {
      float o[4];
#pragma unroll
      for (int e = 0; e < 4; ++e) {
        const float a = acc[m][2 * i][e], g = acc[m][2 * i + 1][e];
        const float au1 = __shfl(a, upl), gu1 = __shfl(g, upl), ad1 = __shfl(a, dnl), gd1 = __shfl(g, dnl);
        float au2 = 0.f, gu2 = 0.f, ad2 = 0.f, gd2 = 0.f;
        if (m > 0) { au2 = __shfl(acc[m - 1][2 * i][e], upl2); gu2 = __shfl(acc[m - 1][2 * i + 1][e], upl2); }
        if (m < 3) { ad2 = __shfl(acc[m + 1][2 * i][e], dnl2); gd2 = __shfl(acc[m + 1][2 * i + 1][e], dnl2); }
        const float au = fr > 0 ? au1 : au2, gu = fr > 0 ? gu1 : gu2, ad = fr < 15 ? ad1 : ad2, gd = fr < 15 ? gd1 : gd2;
        const float ca = w0a[e] * au + w1a[e] * a + w2a[e] * ad + bba[e];
        const float cgv = w0g[e] * gu + w1g[e] * g + w2g[e] * gd + bbg[e];
        o[e] = ca / (1.f + __expf(-ca)) * cgv;
      }
      const int lr64 = m * 16 + fr, row = rowbase + lr64;
      if (lr64 >= 1 && lr64 <= 62) *(uint2*)(act + (size_t)row * 2816 + j0) = make_uint2(pack2(o[0], o[1]), pack2(o[2], o[3]));
      if (lr64 <= 1 || lr64 >= 62) {
        const int slot = lr64 <= 1 ? lr64 : lr64 - 60;
        bf16_t* er = edge + (size_t)(wt * 4 + slot) * 5632;
        *(uint2*)(er + j0) = make_uint2(pack2(acc[m][2 * i][0], acc[m][2 * i][1]), pack2(acc[m][2 * i][2], acc[m][2 * i][3]));
        *(uint2*)(er + 2816 + j0) = make_uint2(pack2(acc[m][2 * i + 1][0], acc[m][2 * i + 1][1]), pack2(acc[m][2 * i + 1][2], acc[m][2 * i + 1][3]));
      }
    }
  }
}

__device__ __forceinline__ void transpose_item(const float* __restrict__ W, int K, int N, bf16_t* __restrict__ WT, int tile, int ntn, char* smem, bool perm = false) {
  float* s = (float*)smem;
  const int tk = tile / ntn, tn = tile % ntn, tid = ltid();
  const int k0 = tk * 64, n0 = tn * 64;
  __syncthreads();
  {
    const int r = tid >> 4, c4 = (tid & 15) * 4;
#pragma unroll
    for (int i = 0; i < 4; ++i) {
      const int k = r + 16 * i;
      float4 v = make_float4(0.f, 0.f, 0.f, 0.f);
      if (n0 + c4 < N) v = *(const float4*)(W + (size_t)(k0 + k) * N + n0 + c4);
      s[k * 65 + c4 + 0] = v.x; s[k * 65 + c4 + 1] = v.y; s[k * 65 + c4 + 2] = v.z; s[k * 65 + c4 + 3] = v.w;
    }
  }
  __syncthreads();
  {
    const int n = tid >> 2, kc = (tid & 3) * 16;
    unsigned o[8];
#pragma unroll
    for (int i = 0; i < 8; ++i) o[i] = pack2(s[(kc + 2 * i) * 65 + n], s[(kc + 2 * i + 1) * 65 + n]);
    int nr = n0 + n;
    if (perm) { const int hf = nr >= 2816 ? 1 : 0, cc = nr - hf * 2816; nr = 32 * (cc >> 4) + 16 * hf + (cc & 15); }
    uint4* dst = (uint4*)(WT + (size_t)nr * K + k0 + kc);
    dst[0] = make_uint4(o[0], o[1], o[2], o[3]);
    dst[1] = make_uint4(o[4], o[5], o[6], o[7]);
  }
}

__device__ __forceinline__ void mod_item(const Params& p, int item, char* smem) {
  float* s = (float*)smem;
  float* red = s + 3072;
  const int tid = ltid();
  __syncthreads();
  for (int e = tid; e < 3072; e += 256) {
    const int v = e >> 10, k = e & 1023;
    const float x = (v == 0) ? p.c_ctx[k] : p.c[(v - 1) * D + k];
    s[e] = x / (1.f + __expf(-x));
  }
  __syncthreads();
  const int jl = tid & 63, kq = tid >> 6, j = item * 64 + jl, k0 = kq * 256;
  float a0 = 0.f, a1 = 0.f, a2 = 0.f;
#pragma unroll 8
  for (int k = 0; k < 256; ++k) {
    const float w = p.w_ada[(size_t)(k0 + k) * 6144 + j];
    a0 += s[k0 + k] * w; a1 += s[1024 + k0 + k] * w; a2 += s[2048 + k0 + k] * w;
  }
  red[(kq * 3 + 0) * 64 + jl] = a0; red[(kq * 3 + 1) * 64 + jl] = a1; red[(kq * 3 + 2) * 64 + jl] = a2;
  __syncthreads();
  if (tid < 192) {
    const int v = tid >> 6;
    const float r = red[(0 * 3 + v) * 64 + jl] + red[(1 * 3 + v) * 64 + jl] + red[(2 * 3 + v) * 64 + jl] + red[(3 * 3 + v) * 64 + jl];
    ((float*)(p.ws + OFF_MOD))[v * 6144 + j] = r + p.b_ada[j];
  }
}

__device__ __forceinline__ void filter_item(const Params& p, int item, char* smem) {
  int n, p0; bf16_t* R;
  if (item < 256) { n = 4096; p0 = item * 16; R = (bf16_t*)(p.ws + OFF_RLAT); }
  else { n = 256; p0 = (item - 256) * 16; R = (bf16_t*)(p.ws + OFF_RCTX); }
  const int n2 = 2 * n, tid = ltid();
  float* z = (float*)smem;
  float* h1 = z + 16 * 36;
  float* h2 = h1 + 16 * 64;
  __syncthreads();
#pragma unroll 1
  for (int e = tid; e < 16 * 33; e += 256) {
    const int pp = e / 33, f = e % 33, pos = p0 + pp;
    float val;
    if (f == 0) val = (float)pos / (float)(n - 1);
    else {
      const int k = (f - 1) & 15;
      const float band = 1e-4f + (float)k * ((15.f - 1e-4f) / 15.f);
      const float turns = band * ((float)pos / (float)n);
      val = (f <= 16) ? cos_turns(turns) : -sin_turns(turns);
    }
    z[pp * 36 + f] = val;
  }
  __syncthreads();
#pragma unroll 1
  for (int e = tid; e < 1024; e += 256) {
    const int pp = e >> 6, j = e & 63;
    float a = p.filt_b1[j];
#pragma unroll 3
    for (int f = 0; f < 33; ++f) a += z[pp * 36 + f] * p.filt_w1[f * 64 + j];
    h1[e] = sin_rad(p.filt_freq1[j] * a);
  }
  __syncthreads();
#pragma unroll 1
  for (int e = tid; e < 1024; e += 256) {
    const int pp = e >> 6, j = e & 63;
    float a = p.filt_b2[j];
#pragma unroll 4
    for (int k = 0; k < 64; ++k) a += h1[pp * 64 + k] * p.filt_w2[k * 64 + j];
    h2[j * 16 + pp] = sin_rad(p.filt_freq2[j] * a);
  }
  __syncthreads();
  const float mind = -3.0701134573253946f, maxd = -15.350567286626973f;
#pragma unroll 1
  for (int ci = 0; ci < 8; ++ci) {
    const int col = tid + 256 * ci, o = col >> 10, dir = (col >> 9) & 1, c = col & 511;
    float acc[16];
#pragma unroll
    for (int i = 0; i < 16; ++i) acc[i] = 0.f;
#pragma unroll 4
    for (int k = 0; k < 64; ++k) {
      const float w = p.filt_w3[k * 2048 + col];
      const float4 ha = *(const float4*)(h2 + k * 16), hb = *(const float4*)(h2 + k * 16 + 4), hc = *(const float4*)(h2 + k * 16 + 8), hd = *(const float4*)(h2 + k * 16 + 12);
      acc[0] += ha.x * w; acc[1] += ha.y * w; acc[2] += ha.z * w; acc[3] += ha.w * w;
      acc[4] += hb.x * w; acc[5] += hb.y * w; acc[6] += hb.z * w; acc[7] += hb.w * w;
      acc[8] += hc.x * w; acc[9] += hc.y * w; acc[10] += hc.z * w; acc[11] += hc.w * w;
      acc[12] += hd.x * w; acc[13] += hd.y * w; acc[14] += hd.z * w; acc[15] += hd.w * w;
    }
    const float delta = fabsf(mind + (float)c * ((maxd - mind) / 511.f));
    bf16_t* Rrow = R + (size_t)(o * 512 + c) * n2;
#pragma unroll
    for (int i = 0; i < 16; ++i) {
      const int pos = p0 + i;
      const float t = (float)pos / (float)(n - 1);
      float val = acc[i] * (__expf(-t * delta) + 0.05f);
      int idx = dir == 0 ? (n - 1 - pos) : (n - 1 + pos);
      if (dir == 1 && pos == 0) { idx = n2 - 1; val = 0.f; }
      Rrow[idx] = f2bf(val);
    }
  }
}

__device__ __forceinline__ void cache_item(const Params& p, int item) {
  const int tid = ltid(), r0 = item * 32;
  bf16_t* ckvn = (bf16_t*)(p.ws + OFF_CKVN);
#pragma unroll 2
  for (int e = tid; e < 32 * 64; e += 256) {
    const int r = r0 + (e >> 6), c4 = (e & 63) * 4;
    const float4 v = *(const float4*)(p.cache_ckv + (size_t)r * 256 + c4);
    *(uint2*)(ckvn + (size_t)(NTOK + r) * 256 + c4) = make_uint2(pack2(v.x, v.y), pack2(v.z, v.w));
  }
}

template <int WHICH>
__device__ __forceinline__ void rmsmod_phase(const Params& p) {
  const int tid = ltid(), lane = tid & 63, wid = tid >> 6;
  const int gw = blockIdx.x * 4 + wid, tw = gridDim.x * 4;
  const float* g = WHICH == 0 ? p.g_mix : p.g_ffn;
  const float* mod = (const float*)(p.ws + OFF_MOD);
  bf16_t* h = (bf16_t*)(p.ws + OFF_H);
  for (int row = gw; row < NTOK; row += tw) {
    const float* src = WHICH == 0 ? xrow(p, row) : p.out + (size_t)row * D;
    float4 v[4];
    float ss = 0.f;
#pragma unroll
    for (int i = 0; i < 4; ++i) {
      v[i] = ((const float4*)src)[lane + 64 * i];
      ss += v[i].x * v[i].x + v[i].y * v[i].y + v[i].z * v[i].z + v[i].w * v[i].w;
    }
    ss = wave_sum(ss);
    const float r = rsqrtf(ss * (1.f / 1024.f) + 1e-6f);
    const float* mv = mod + modidx(row) * 6144 + (WHICH == 0 ? 0 : 3 * 1024);
#pragma unroll
    for (int i = 0; i < 4; ++i) {
      const int e = 4 * (lane + 64 * i);
      const float4 g4 = *(const float4*)(g + e), sh = *(const float4*)(mv + e), sc = *(const float4*)(mv + 1024 + e);
      const float y0 = v[i].x * r * g4.x * (1.f + sc.x) + sh.x, y1 = v[i].y * r * g4.y * (1.f + sc.y) + sh.y;
      const float y2 = v[i].z * r * g4.z * (1.f + sc.z) + sh.z, y3 = v[i].w * r * g4.w * (1.f + sc.w) + sh.w;
      *(uint2*)(h + (size_t)row * D + e) = make_uint2(pack2(y0, y1), pack2(y2, y3));
    }
  }
}

struct EpiIn {
  float* proj; bf16_t* hyT;
  __device__ __forceinline__ void operator()(int row0, int col, const f32x4& v) const {
    if (col < 672) {
#pragma unroll
      for (int j = 0; j < 4; ++j) proj[(size_t)(row0 + j) * 672 + col] = v[j];
    } else if (col < DIN) {
      *(uint2*)(hyT + (size_t)(col - 672) * NTOK + row0) = make_uint2(pack2(v[0], v[1]), pack2(v[2], v[3]));
    }
  }
};
struct EpiQ {
  bf16_t* q;
  __device__ __forceinline__ void operator()(int row, int col0, const f32x4& v) const {
    *(uint2*)(q + (size_t)row * 768 + col0) = make_uint2(pack2(v[0], v[1]), pack2(v[2], v[3]));
  }
};
struct EpiKV {
  bf16_t *kraw, *vtc, *vtl;
  __device__ __forceinline__ void operator()(int row0, int col, const f32x4& v) const {
    const int head = col >> 7, cc = col & 127;
    if (cc < 64) {
#pragma unroll
      for (int j = 0; j < 4; ++j) kraw[(size_t)(row0 + j) * 512 + head * 64 + cc] = f2bf(v[j]);
    } else {
      const int dv = cc - 64;
      bf16_t* dst;
      if (row0 < NCTX) dst = vtc + ((size_t)((row0 >> 8) * 8 + head) * 64 + dv) * 256 + (row0 & 255);
      else if (row0 < NTOK) { const int r = row0 - NCTX; dst = vtl + ((size_t)((r >> 12) * 8 + head) * 64 + dv) * 4608 + (r & 4095); }
      else { const int r = row0 - NTOK; dst = vtl + ((size_t)((r >> 9) * 8 + head) * 64 + dv) * 4608 + 4096 + (r & 511); }
      *(uint2*)dst = make_uint2(pack2(v[0], v[1]), pack2(v[2], v[3]));
    }
  }
};
struct EpiOut {
  const Params* p;
  __device__ __forceinline__ void operator()(int row, int col0, const f32x4& v) const {
    const float4 x = *(const float4*)(xrow(*p, row) + col0);
    const float4 m = *(const float4*)((const float*)(p->ws + OFF_MOD) + modidx(row) * 6144 + 2 * 1024 + col0);
    *(float4*)(p->out + (size_t)row * D + col0) = make_float4(x.x + m.x * v[0], x.y + m.y * v[1], x.z + m.z * v[2], x.w + m.w * v[3]);
  }
};
struct EpiU {
  bf16_t* u;
  __device__ __forceinline__ void operator()(int row, int col0, const f32x4& v) const {
    *(uint2*)(u + (size_t)row * 5632 + col0) = make_uint2(pack2(v[0], v[1]), pack2(v[2], v[3]));
  }
};
struct EpiY {
  const Params* p; int half;
  __device__ __forceinline__ void operator()(int row, int col0, const f32x4& v) const {
    const int grow = half * 8192 + row;
    float4* dst = (float4*)(p->out + (size_t)grow * D + col0);
    const float4 x = *dst;
    const float4 m = *(const float4*)((const float*)(p->ws + OFF_MOD) + modidx(grow) * 6144 + 5 * 1024 + col0);
    *dst = make_float4(x.x + m.x * v[0], x.y + m.y * v[1], x.z + m.z * v[2], x.w + m.w * v[3]);
  }
};

__device__ __forceinline__ void token_item(const Params& p, int item) {
  const int tid = ltid(), lane = tid & 63, wid = tid >> 6;
  const float* proj = (const float*)(p.ws + OFF_PROJ);
  bf16_t* qa = (bf16_t*)(p.ws + OFF_QA);
  bf16_t* ckvn = (bf16_t*)(p.ws + OFF_CKVN);
  float* kpe = (float*)(p.ws + OFF_KPE);
  for (int tt = 0; tt < 16; ++tt) {
    const int token = item * 64 + wid * 16 + tt;
    const float* pr = proj + (size_t)token * 672;
    float2 q[3];
    float ss = 0.f;
#pragma unroll
    for (int i = 0; i < 3; ++i) { q[i] = *(const float2*)(pr + lane * 2 + 128 * i); ss += q[i].x * q[i].x + q[i].y * q[i].y; }
    ss = wave_sum(ss);
    const float r = rsqrtf(ss * (1.f / 384.f) + 1e-6f);
#pragma unroll
    for (int i = 0; i < 3; ++i) {
      const int e = lane * 2 + 128 * i;
      *(unsigned*)(qa + (size_t)token * 384 + e) = pack2(q[i].x * r * p.g_qa[e], q[i].y * r * p.g_qa[e + 1]);
    }
    const float4 kv = *(const float4*)(pr + 384 + lane * 4);
    float s2 = wave_sum(kv.x * kv.x + kv.y * kv.y + kv.z * kv.z + kv.w * kv.w);
    const float r2 = rsqrtf(s2 * (1.f / 256.f) + 1e-6f);
    const float4 g = *(const float4*)(p.g_kva + lane * 4);
    const float4 y = make_float4(kv.x * r2 * g.x, kv.y * r2 * g.y, kv.z * r2 * g.z, kv.w * r2 * g.w);
    *(uint2*)(ckvn + (size_t)token * 256 + lane * 4) = make_uint2(pack2(y.x, y.y), pack2(y.z, y.w));
    if (token < NCTX) *(float4*)(p.out + OUT_CKV + (size_t)token * 256 + lane * 4) = y;
    if (lane < 32) {
      const float kp = pr[640 + lane];
      kpe[(size_t)token * 32 + lane] = kp;
      if (token < NCTX) p.out[OUT_KPE + (size_t)token * 32 + lane] = kp;
    }
  }
}

template <int ORDER>
__device__ __forceinline__ void hyena_item(const Params& p, int grp, int c, char* smem) {
  const int tid = ltid(), lane = tid & 63, wid = tid >> 6, fr = lane & 15, fq = lane >> 4;
  const int n = grp ? SEQL : SEQC, nb = n >> 6, L = n;
  const bf16_t* Rrow = (const bf16_t*)(p.ws + (grp ? OFF_RLAT : OFF_RCTX)) + (size_t)(ORDER * 512 + c) * (2 * n);
  const bf16_t* hyT = (const bf16_t*)(p.ws + OFF_HYT);
  bf16_t* sU = (bf16_t*)smem;
  unsigned* sR0 = (unsigned*)(smem + 18432);
  unsigned* sR1 = (unsigned*)(smem + 18432 + 16384);
  const int tok0 = grp * 8192;
  __syncthreads();
  for (int ch = tid; ch < (2 * n) / 8; ch += 256) *(uint4*)((bf16_t*)sR0 + ch * 8) = *(const uint4*)(Rrow + ch * 8);
  if (ORDER == 0) {
    const bf16_t* raw = hyT + (size_t)c * NTOK + tok0;
    const float w0 = p.hy_conv_w[c], w1 = p.hy_conv_w[1536 + c], w2 = p.hy_conv_w[3072 + c], b = p.hy_conv_b[c];
    for (int ch = tid; ch < 1024; ch += 256) {
      const int t = ch * 8, pos = t & (L - 1);
      const uint4 rv = *(const uint4*)(raw + t);
      float x[10];
      x[0] = pos == 0 ? 0.f : bf2f(raw[t - 1]);
      x[1] = bflo(rv.x); x[2] = bfhi(rv.x); x[3] = bflo(rv.y); x[4] = bfhi(rv.y);
      x[5] = bflo(rv.z); x[6] = bfhi(rv.z); x[7] = bflo(rv.w); x[8] = bfhi(rv.w);
      x[9] = (pos + 8 == L) ? 0.f : bf2f(raw[t + 8]);
      float u[8];
#pragma unroll
      for (int i = 0; i < 8; ++i) u[i] = w0 * x[i] + w1 * x[i + 1] + w2 * x[i + 2] + b;
      *(uint4*)(sU + (ch >> 3) * 72 + (ch & 7) * 8) = make_uint4(pack2(u[0], u[1]), pack2(u[2], u[3]), pack2(u[4], u[5]), pack2(u[6], u[7]));
    }
  } else {
    const bf16_t* zr = (const bf16_t*)(p.ws + OFF_ZT) + (size_t)c * NTOK + tok0;
    for (int ch = tid; ch < 1024; ch += 256) *(uint4*)(sU + (ch >> 3) * 72 + (ch & 7) * 8) = *(const uint4*)(zr + ch * 8);
  }
  __syncthreads();
  for (int k = tid; k < n; k += 256) {
    const unsigned a = sR0[k], b2 = (k + 1 < n) ? sR0[k + 1] : 0u;
    sR1[k] = (a >> 16) | (b2 << 16);
  }
  __syncthreads();

  f32x4 acc[4][2];
#pragma unroll
  for (int m = 0; m < 4; ++m) { acc[m][0] = (f32x4){0.f, 0.f, 0.f, 0.f}; acc[m][1] = (f32x4){0.f, 0.f, 0.f, 0.f}; }
  const unsigned* abase = (fr & 1) ? (sR0 + ((n - 1 - fr) >> 1) + 4 * fq) : (sR1 + ((n - 2 - fr) >> 1) + 4 * fq);
  const int col0 = 32 * wid + fr, col1 = col0 + 16;
  const int i0 = col0 & (nb - 1), i1 = col1 & (nb - 1);
  for (int d = -(nb - 1); d <= nb - 1; ++d) {
    const bool v0 = (unsigned)(i0 - d) < (unsigned)nb, v1 = (unsigned)(i1 - d) < (unsigned)nb;
    const bool any0 = __ballot(v0) != 0ull, any1 = __ballot(v1) != 0ull;
    if (!any0 && !any1) continue;
    bf16x8 F[6];
    const unsigned* ap = abase - 32 * d + 16;
#pragma unroll
    for (int idx = 0; idx < 6; ++idx) {
      const unsigned* q = ap - 8 * idx;
      union { unsigned u[4]; bf16x8 v; } cv;
      cv.u[0] = q[0]; cv.u[1] = q[1]; cv.u[2] = q[2]; cv.u[3] = q[3];
      F[idx] = cv.v;
    }
#pragma unroll
    for (int nt = 0; nt < 2; ++nt) {
      if (!(nt ? any1 : any0)) continue;
      const bool vv = nt ? v1 : v0;
      const bf16_t* up = sU + ((nt ? col1 : col0) - d) * 72 + fq * 8;
#pragma unroll
      for (int ks = 0; ks < 2; ++ks) {
        bf16x8 bf = (bf16x8){0, 0, 0, 0, 0, 0, 0, 0};
        if (vv) bf = *(const bf16x8*)(up + ks * 32);
#pragma unroll
        for (int m = 0; m < 4; ++m)
          acc[m][nt] = __builtin_amdgcn_mfma_f32_16x16x32_bf16(F[m + 2 - 2 * ks], bf, acc[m][nt], 0, 0, 0);
      }
    }
  }
  const float skip = p.filt_bias[ORDER * 512 + c];
  const int gcol = (ORDER == 0 ? 512 : 1024) + c;
  const bf16_t* graw = hyT + (size_t)gcol * NTOK + tok0;
  const float w0 = p.hy_conv_w[gcol], w1 = p.hy_conv_w[1536 + gcol], w2 = p.hy_conv_w[3072 + gcol], b = p.hy_conv_b[gcol];
  bf16_t* outT = (bf16_t*)(p.ws + (ORDER == 0 ? OFF_ZT : OFF_Y2T)) + (size_t)c * NTOK + tok0;
#pragma unroll
  for (int nt = 0; nt < 2; ++nt) {
    const int col = nt ? col1 : col0;
#pragma unroll
    for (int m = 0; m < 4; ++m) {
      const int t = col * 64 + 16 * m + 4 * fq, pos = t & (L - 1);
      const uint2 uu = *(const uint2*)(sU + col * 72 + 16 * m + 4 * fq);
      const uint2 gv = *(const uint2*)(graw + t);
      float x[6];
      x[0] = pos == 0 ? 0.f : bf2f(graw[t - 1]);
      x[1] = bflo(gv.x); x[2] = bfhi(gv.x); x[3] = bflo(gv.y); x[4] = bfhi(gv.y);
      x[5] = (pos + 4 == L) ? 0.f : bf2f(graw[t + 4]);
      const float u4[4] = {bflo(uu.x), bfhi(uu.x), bflo(uu.y), bfhi(uu.y)};
      float o[4];
#pragma unroll
      for (int j = 0; j < 4; ++j) {
        const float gate = w0 * x[j] + w1 * x[j + 1] + w2 * x[j + 2] + b;
        o[j] = gate * (acc[m][nt][j] + skip * u4[j]);
      }
      *(uint2*)(outT + t) = make_uint2(pack2(o[0], o[1]), pack2(o[2], o[3]));
    }
  }
}

__device__ __forceinline__ void rope32(float* y  , int pos) {
  const float prow = (float)(pos >> 6), pcol = (float)(pos & 63);
  const float fr[8] = {1.f, 0.31622776601683794f, 0.1f, 0.031622776601683794f, 0.01f, 0.0031622776601683794f, 0.001f, 0.00031622776601683794f};
#pragma unroll
  for (int i = 0; i < 8; ++i) {
    const float tr = prow * fr[i] * 0.15915494309189535f, tc = pcol * fr[i] * 0.15915494309189535f;
    const float sr = sin_turns(tr), cr = cos_turns(tr), sc = sin_turns(tc), cc = cos_turns(tc);
    const float a = y[i], b = y[8 + i], c2 = y[16 + i], d2 = y[24 + i];
    y[i] = a * cr - b * sr; y[8 + i] = b * cr + a * sr;
    y[16 + i] = c2 * cc - d2 * sc; y[24 + i] = d2 * cc + c2 * sc;
  }
}
__device__ __forceinline__ void unpack8(const uint4& v, float* x) {
  x[0] = bflo(v.x); x[1] = bfhi(v.x); x[2] = bflo(v.y); x[3] = bfhi(v.y);
  x[4] = bflo(v.z); x[5] = bfhi(v.z); x[6] = bflo(v.w); x[7] = bfhi(v.w);
}
__device__ __forceinline__ float sumsq8(const uint4& v) {
  float x[8];
  unpack8(v, x);
  return x[0] * x[0] + x[1] * x[1] + x[2] * x[2] + x[3] * x[3] + x[4] * x[4] + x[5] * x[5] + x[6] * x[6] + x[7] * x[7];
}
__device__ __forceinline__ uint4 scale8(const uint4& v, float r, const float* __restrict__ g) {
  float x[8];
  unpack8(v, x);
  const float4 g0 = *(const float4*)g, g1 = *(const float4*)(g + 4);
  return make_uint4(pack2(x[0] * r * g0.x, x[1] * r * g0.y), pack2(x[2] * r * g0.z, x[3] * r * g0.w),
                    pack2(x[4] * r * g1.x, x[5] * r * g1.y), pack2(x[6] * r * g1.z, x[7] * r * g1.w));
}
__device__ __forceinline__ void qk_item(const Params& p, int item) {
  const int tid = ltid();
  if (item < 512) {
    const int idx = item * 256 + tid, row = idx >> 3, h = idx & 7;
    const bf16_t* src = (const bf16_t*)(p.ws + OFF_QRAW) + (size_t)row * 768 + h * 96;
    bf16_t* dst = (bf16_t*)(p.ws + OFF_Q) + (size_t)row * 768 + h * 96;
    uint4 raw[12];
#pragma unroll
    for (int i = 0; i < 12; ++i) raw[i] = *(const uint4*)(src + 8 * i);
    float ss = 0.f;
#pragma unroll
    for (int i = 0; i < 12; ++i) ss += sumsq8(raw[i]);
    const float r = rsqrtf(ss * (1.f / 96.f) + 1e-6f);
    const float qs = 0.10206207261596575f * 1.4426950408889634f;
#pragma unroll
    for (int i = 0; i < 8; ++i) *(uint4*)(dst + 8 * i) = scale8(raw[i], r * qs, p.g_q + 8 * i);
    float y[32];
#pragma unroll
    for (int i = 0; i < 4; ++i) unpack8(raw[8 + i], y + 8 * i);
#pragma unroll
    for (int i = 0; i < 32; ++i) y[i] = y[i] * r * p.g_q[64 + i];
    if (row >= NCTX) rope32(y, (row - NCTX) & 4095);
#pragma unroll
    for (int i = 0; i < 4; ++i)
      *(uint4*)(dst + 64 + 8 * i) = make_uint4(pack2(y[8 * i] * qs, y[8 * i + 1] * qs), pack2(y[8 * i + 2] * qs, y[8 * i + 3] * qs),
                                               pack2(y[8 * i + 4] * qs, y[8 * i + 5] * qs), pack2(y[8 * i + 6] * qs, y[8 * i + 7] * qs));
  } else {
    const int idx = (item - 512) * 256 + tid, row = idx >> 3, h = idx & 7;
    const bf16_t* src = (const bf16_t*)(p.ws + OFF_KRAW) + (size_t)row * 512 + h * 64;
    uint4 raw[8];
#pragma unroll
    for (int i = 0; i < 8; ++i) raw[i] = *(const uint4*)(src + 8 * i);
    const float* kp = row < NTOK ? (const float*)(p.ws + OFF_KPE) + (size_t)row * 32 : p.cache_kpe + (size_t)(row - NTOK) * 32;
    float y[32];
#pragma unroll
    for (int i = 0; i < 8; ++i) {
      const float4 v = *(const float4*)(kp + 4 * i);
      y[4 * i] = v.x; y[4 * i + 1] = v.y; y[4 * i + 2] = v.z; y[4 * i + 3] = v.w;
    }
    float ss = 0.f;
#pragma unroll
    for (int i = 0; i < 8; ++i) ss += sumsq8(raw[i]);
#pragma unroll
    for (int i = 0; i < 32; ++i) ss += y[i] * y[i];
    const float r = rsqrtf(ss * (1.f / 96.f) + 1e-6f);
#pragma unroll
    for (int i = 0; i < 32; ++i) y[i] = y[i] * r * p.g_k[64 + i];
    bf16_t* dst;
    if (row < NCTX) dst = (bf16_t*)(p.ws + OFF_KC) + ((size_t)((row >> 8) * 8 + h) * 256 + (row & 255)) * 96;
    else if (row < NTOK) {
      const int rr = row - NCTX;
      rope32(y, rr & 4095);
      dst = (bf16_t*)(p.ws + OFF_KL) + ((size_t)((rr >> 12) * 8 + h) * 4608 + (rr & 4095)) * 96;
    } else {
      const int rr = row - NTOK;
      dst = (bf16_t*)(p.ws + OFF_KL) + ((size_t)((rr >> 9) * 8 + h) * 4608 + 4096 + (rr & 511)) * 96;
    }
#pragma unroll
    for (int i = 0; i < 8; ++i) *(uint4*)(dst + 8 * i) = scale8(raw[i], r, p.g_k + 8 * i);
#pragma unroll
    for (int i = 0; i < 4; ++i)
      *(uint4*)(dst + 64 + 8 * i) = make_uint4(pack2(y[8 * i], y[8 * i + 1]), pack2(y[8 * i + 2], y[8 * i + 3]),
                                               pack2(y[8 * i + 4], y[8 * i + 5]), pack2(y[8 * i + 6], y[8 * i + 7]));
  }
}

__device__ __forceinline__ void attn_item(const Params& p, int item, char* smem) {
  const int tid = ltid(), lane = tid & 63, wid = tid >> 6, lr = lane & 31, lh = lane >> 5;
  int nkeys, h, tokbase; const bf16_t *Kp, *Vp;
  if (item < 512) {
    const int b = item >> 8, rem = item & 255; h = rem >> 5; const int qb = rem & 31;
    nkeys = 4608; tokbase = NCTX + b * 4096 + qb * 128;
    Kp = (const bf16_t*)(p.ws + OFF_KL) + (size_t)(b * 8 + h) * 4608 * 96;
    Vp = (const bf16_t*)(p.ws + OFF_VTL) + (size_t)(b * 8 + h) * 64 * 4608;
  } else {
    const int it = item - 512, b = it >> 4; h = (it & 15) >> 1; const int qb = it & 1;
    nkeys = 256; tokbase = b * 256 + qb * 128;
    Kp = (const bf16_t*)(p.ws + OFF_KC) + (size_t)(b * 8 + h) * 256 * 96;
    Vp = (const bf16_t*)(p.ws + OFF_VTC) + (size_t)(b * 8 + h) * 64 * 256;
  }
  bf16_t* sK = (bf16_t*)smem;
  bf16_t* sV = sK + 64 * 104;
  const int token = tokbase + 32 * wid + lr;
  const bf16_t* qsrc = (const bf16_t*)(p.ws + OFF_Q) + (size_t)token * 768 + h * 96 + 8 * lh;
  bf16x8 qf[6];
#pragma unroll
  for (int ks = 0; ks < 6; ++ks) qf[ks] = *(const bf16x8*)(qsrc + 16 * ks);
  f32x16 oacc[2];
#pragma unroll
  for (int j = 0; j < 16; ++j) { oacc[0][j] = 0.f; oacc[1][j] = 0.f; }
  float mrun = -1e30f, lsum = 0.f;
  const int kk0 = tid / 12, kc0 = tid % 12, kk1 = (tid + 256) / 12, kc1 = (tid + 256) % 12, kk2 = (tid + 512) / 12, kc2 = (tid + 512) % 12;
  const int vd0 = tid >> 3, vc0 = tid & 7, vd1 = vd0 + 32;
  const bf16_t* gk0 = Kp + (size_t)kk0 * 96 + kc0 * 8;
  const bf16_t* gk1 = Kp + (size_t)kk1 * 96 + kc1 * 8;
  const bf16_t* gk2 = Kp + (size_t)kk2 * 96 + kc2 * 8;
  const bf16_t* gv0 = Vp + (size_t)vd0 * nkeys + vc0 * 8;
  const bf16_t* gv1 = Vp + (size_t)vd1 * nkeys + vc0 * 8;
  uint4 rk0 = *(const uint4*)gk0, rk1 = *(const uint4*)gk1, rk2 = *(const uint4*)gk2;
  uint4 rv0 = *(const uint4*)gv0, rv1 = *(const uint4*)gv1;
  const int nt = nkeys >> 6;
  for (int kt = 0; kt < nt; ++kt) {
    __syncthreads();
    *(uint4*)(sK + kk0 * 104 + kc0 * 8) = rk0; *(uint4*)(sK + kk1 * 104 + kc1 * 8) = rk1; *(uint4*)(sK + kk2 * 104 + kc2 * 8) = rk2;
    *(uint4*)(sV + vd0 * 72 + vc0 * 8) = rv0; *(uint4*)(sV + vd1 * 72 + vc0 * 8) = rv1;
    __syncthreads();
    if (kt + 1 < nt) {
      gk0 += 64 * 96; gk1 += 64 * 96; gk2 += 64 * 96; gv0 += 64; gv1 += 64;
      rk0 = *(const uint4*)gk0; rk1 = *(const uint4*)gk1; rk2 = *(const uint4*)gk2;
      rv0 = *(const uint4*)gv0; rv1 = *(const uint4*)gv1;
    }
    __builtin_amdgcn_sched_barrier(0);
    f32x16 sacc[2];
#pragma unroll
    for (int kb = 0; kb < 2; ++kb) {
#pragma unroll
      for (int j = 0; j < 16; ++j) sacc[kb][j] = 0.f;
#pragma unroll
      for (int ks = 0; ks < 6; ++ks) {
        const bf16x8 a = *(const bf16x8*)(sK + (32 * kb + lr) * 104 + 16 * ks + 8 * lh);
        sacc[kb] = __builtin_amdgcn_mfma_f32_32x32x16_bf16(a, qf[ks], sacc[kb], 0, 0, 0);
      }
    }
    float mx = sacc[0][0];
#pragma unroll
    for (int j = 1; j < 16; ++j) mx = fmaxf(mx, sacc[0][j]);
#pragma unroll
    for (int j = 0; j < 16; ++j) mx = fmaxf(mx, sacc[1][j]);
    mx = fmaxf(mx, __shfl_xor(mx, 32));
    const float mnew = fmaxf(mrun, mx);
    const float alpha = __builtin_amdgcn_exp2f(mrun - mnew);
    mrun = mnew;
    float ps = 0.f;
#pragma unroll
    for (int kb = 0; kb < 2; ++kb)
#pragma unroll
      for (int j = 0; j < 16; ++j) { const float e = __builtin_amdgcn_exp2f(sacc[kb][j] - mnew); sacc[kb][j] = e; ps += e; }
    lsum = lsum * alpha + ps;
#pragma unroll
    for (int j = 0; j < 16; ++j) { oacc[0][j] *= alpha; oacc[1][j] *= alpha; }
#pragma unroll
    for (int s = 0; s < 4; ++s) {
      const int kb = s >> 1, jb = 8 * (s & 1);
      union { unsigned u[4]; bf16x8 v; } pf;
      pf.u[0] = pack2(sacc[kb][jb + 0], sacc[kb][jb + 1]); pf.u[1] = pack2(sacc[kb][jb + 2], sacc[kb][jb + 3]);
      pf.u[2] = pack2(sacc[kb][jb + 4], sacc[kb][jb + 5]); pf.u[3] = pack2(sacc[kb][jb + 6], sacc[kb][jb + 7]);
#pragma unroll
      for (int mt = 0; mt < 2; ++mt) {
        const bf16_t* vp = sV + (32 * mt + lr) * 72 + 16 * s + 4 * lh;
        union { uint2 d[2]; bf16x8 v; } av;
        av.d[0] = *(const uint2*)vp;
        av.d[1] = *(const uint2*)(vp + 8);
        oacc[mt] = __builtin_amdgcn_mfma_f32_32x32x16_bf16(av.v, pf.v, oacc[mt], 0, 0, 0);
      }
    }
  }
  lsum += __shfl_xor(lsum, 32);
  const float inv = 1.f / lsum;
  bf16_t* dst = (bf16_t*)(p.ws + OFF_ATTN) + (size_t)token * 512 + h * 64;
#pragma unroll
  for (int mt = 0; mt < 2; ++mt)
#pragma unroll
    for (int jg = 0; jg < 4; ++jg) {
      const int dv0 = 32 * mt + 8 * jg + 4 * lh;
      *(uint2*)(dst + dv0) = make_uint2(pack2(oacc[mt][4 * jg] * inv, oacc[mt][4 * jg + 1] * inv),
                                        pack2(oacc[mt][4 * jg + 2] * inv, oacc[mt][4 * jg + 3] * inv));
    }
}

__device__ __forceinline__ void merge_item(const Params& p, int item, char* smem) {
  const int tid = ltid(), lane = tid & 63, wid = tid >> 6, t0 = item * 32;
  bf16_t* mix = (bf16_t*)(p.ws + OFF_H);
  const bf16_t* attn = (const bf16_t*)(p.ws + OFF_ATTN);
  for (int tt = 0; tt < 8; ++tt) {
    const int token = t0 + wid * 8 + tt;
    float x[8];
    unpack8(*(const uint4*)(attn + (size_t)token * 512 + lane * 8), x);
    float ss = 0.f;
#pragma unroll
    for (int i = 0; i < 8; ++i) ss += x[i] * x[i];
    ss = wave_sum(ss);
    const float r = rsqrtf(ss * (1.f / 512.f) + 1e-6f);
    const float4 g0 = *(const float4*)(p.g_out_att + lane * 8), g1 = *(const float4*)(p.g_out_att + lane * 8 + 4);
    *(uint4*)(mix + (size_t)token * D + lane * 8) =
        make_uint4(pack2(x[0] * r * g0.x, x[1] * r * g0.y), pack2(x[2] * r * g0.z, x[3] * r * g0.w),
                   pack2(x[4] * r * g1.x, x[5] * r * g1.y), pack2(x[6] * r * g1.z, x[7] * r * g1.w));
  }
  bf16_t* sT = (bf16_t*)smem;
  const bf16_t* y2T = (const bf16_t*)(p.ws + OFF_Y2T);
  __syncthreads();
  for (int ch = tid; ch < 2048; ch += 256) {
    const int c = ch >> 2, q4 = ch & 3;
    const uint4 v = *(const uint4*)(y2T + (size_t)c * NTOK + t0 + q4 * 8);
    bf16_t* d = sT + (q4 * 8) * 520 + c;
    d[0 * 520] = (bf16_t)(v.x & 0xffff); d[1 * 520] = (bf16_t)(v.x >> 16);
    d[2 * 520] = (bf16_t)(v.y & 0xffff); d[3 * 520] = (bf16_t)(v.y >> 16);
    d[4 * 520] = (bf16_t)(v.z & 0xffff); d[5 * 520] = (bf16_t)(v.z >> 16);
    d[6 * 520] = (bf16_t)(v.w & 0xffff); d[7 * 520] = (bf16_t)(v.w >> 16);
  }
  __syncthreads();
  {
    const int tt = tid >> 3, part = tid & 7;
    uint4 v[8];
    float ss = 0.f;
#pragma unroll
    for (int i = 0; i < 8; ++i) {
      v[i] = *(const uint4*)(sT + tt * 520 + part * 64 + 8 * i);
      float x[8];
      unpack8(v[i], x);
#pragma unroll
      for (int e = 0; e < 8; ++e) ss += x[e] * x[e];
    }
    ss += __shfl_xor(ss, 1); ss += __shfl_xor(ss, 2); ss += __shfl_xor(ss, 4);
    const float r = rsqrtf(ss * (1.f / 512.f) + 1e-6f);
#pragma unroll
    for (int i = 0; i < 8; ++i) {
      float x[8];
      unpack8(v[i], x);
      const int c0 = part * 64 + 8 * i;
      const float4 g0 = *(const float4*)(p.g_out_hy + c0), g1 = *(const float4*)(p.g_out_hy + c0 + 4);
      *(uint4*)(mix + (size_t)(t0 + tt) * D + 512 + c0) =
          make_uint4(pack2(x[0] * r * g0.x, x[1] * r * g0.y), pack2(x[2] * r * g0.z, x[3] * r * g0.w),
                     pack2(x[4] * r * g1.x, x[5] * r * g1.y), pack2(x[6] * r * g1.z, x[7] * r * g1.w));
    }
  }
}

__device__ __forceinline__ void actfix_item(const Params& p, int item) {
  const int idx = item * 256 + ltid();
  if (idx >= 512 * 352) return;
  const int j = (idx % 352) * 8, rowi = idx / 352, wt = rowi >> 1, which = rowi & 1;
  const int t = 64 * wt + 63 * which, L = t < NCTX ? SEQC : SEQL, pos = t & (L - 1);
  const bf16_t* edge = (const bf16_t*)(p.ws + OFF_EDGE);
  bf16_t* act = (bf16_t*)(p.ws + OFF_U);
  const bf16_t *pr, *cu, *nx;
  bool zp = false, zn = false;
  if (which == 0) { zp = pos == 0; pr = edge + (size_t)((zp ? wt : wt - 1) * 4 + 3) * 5632; cu = edge + (size_t)(wt * 4 + 0) * 5632; nx = edge + (size_t)(wt * 4 + 1) * 5632; }
  else { zn = pos == L - 1; pr = edge + (size_t)(wt * 4 + 2) * 5632; cu = edge + (size_t)(wt * 4 + 3) * 5632; nx = edge + (size_t)((zn ? wt : wt + 1) * 4 + 0) * 5632; }
  float pa[8], pg[8], ca[8], cgv[8], na[8], ng[8];
  unpack8(*(const uint4*)(pr + j), pa); unpack8(*(const uint4*)(pr + 2816 + j), pg);
  unpack8(*(const uint4*)(cu + j), ca); unpack8(*(const uint4*)(cu + 2816 + j), cgv);
  unpack8(*(const uint4*)(nx + j), na); unpack8(*(const uint4*)(nx + 2816 + j), ng);
  float o[8];
#pragma unroll
  for (int e = 0; e < 8; ++e) {
    const float pae = zp ? 0.f : pa[e], pge = zp ? 0.f : pg[e], nae = zn ? 0.f : na[e], nge = zn ? 0.f : ng[e];
    const float a = p.ffn_conv_w[j + e] * pae + p.ffn_conv_w[5632 + j + e] * ca[e] + p.ffn_conv_w[11264 + j + e] * nae + p.ffn_conv_b[j + e];
    const float g = p.ffn_conv_w[2816 + j + e] * pge + p.ffn_conv_w[5632 + 2816 + j + e] * cgv[e] + p.ffn_conv_w[11264 + 2816 + j + e] * nge + p.ffn_conv_b[2816 + j + e];
    o[e] = a / (1.f + __expf(-a)) * g;
  }
  *(uint4*)(act + (size_t)t * 2816 + j) = make_uint4(pack2(o[0], o[1]), pack2(o[2], o[3]), pack2(o[4], o[5]), pack2(o[6], o[7]));
}

#define XB_TMO      128
#define XB_XCNT(j)  (256  + 64 * (j))
#define XB_XSUB(j)  (1280 + 64 * (j))
#define XB_XGEN(j)  (2304 + 64 * (j))
#define XB_TOP      3328
#define XB_TOPGEN   3392
#define XCD_BAR_WORDS 3456
#define XB_SPIN_CAP (1u << 20)
#define LAS __attribute__((address_space(3)))
__device__ __forceinline__ unsigned xb_ld(unsigned* p) { return __hip_atomic_load(p, __ATOMIC_RELAXED, __HIP_MEMORY_SCOPE_AGENT); }
__device__ __forceinline__ unsigned xb_add(unsigned* p, unsigned v) { return __hip_atomic_fetch_add(p, v, __ATOMIC_RELAXED, __HIP_MEMORY_SCOPE_AGENT); }
__device__ __forceinline__ unsigned xb_xcc_id() { return (unsigned)__builtin_amdgcn_s_getreg((3 << 11) | 20) & 0xFu; }
#define XB_SPIN(cond, bar) do { unsigned _sp = 0; while (cond) { __builtin_amdgcn_s_sleep(1); \
    if ((++_sp & 255u) == 0u) { if (xb_ld(&(bar)[XB_TMO])) break; if (_sp > XB_SPIN_CAP) { atomicAdd(&(bar)[XB_TMO], 1u); break; } } } } while (0)
struct XcdBarrier { unsigned* bar; unsigned x; volatile LAS unsigned* st; };
__device__ __forceinline__ XcdBarrier xcd_barrier_post(unsigned* bar, volatile LAS unsigned* st) {
  XcdBarrier b; b.bar = bar; b.x = xb_xcc_id(); b.st = st;
  if (threadIdx.x == 0) (void)xb_add(&bar[XB_XCNT(b.x)], 1u);
  return b;
}
__device__ __forceinline__ void xcd_barrier_complete(unsigned* bar, unsigned x, unsigned& nloc, unsigned& nx) {
  const unsigned G = gridDim.x * gridDim.y * gridDim.z;
  unsigned sum, cnt, mine, sp = 0u;
  for (;;) {
    sum = 0u; cnt = 0u; mine = 0u;
#pragma unroll
    for (unsigned j = 0; j < 16; ++j) { const unsigned c = xb_ld(&bar[XB_XCNT(j)]); sum += c; cnt += (c > 0u) ? 1u : 0u; mine = (j == x) ? c : mine; }
    if (sum == G) break;
    __builtin_amdgcn_s_sleep(1);
    if ((++sp & 255u) == 0u) { if (xb_ld(&bar[XB_TMO])) break; if (sp > XB_SPIN_CAP) { atomicAdd(&bar[XB_TMO], 1u); break; } }
  }
  nloc = mine > 0u ? mine : 1u; nx = cnt > 0u ? cnt : 1u;
}
__device__ __forceinline__ void xcd_barrier(const XcdBarrier& b) {
  asm volatile("s_waitcnt vmcnt(0)" ::: "memory");
  __syncthreads();
  if (threadIdx.x == 0) {
    unsigned* bar = b.bar;
    __builtin_amdgcn_s_waitcnt(0);
    unsigned nloc = b.st[0], nx = b.st[1];
    if (nloc == 0u) { xcd_barrier_complete(bar, b.x, nloc, nx); b.st[0] = nloc; b.st[1] = nx; }
    const unsigned old = xb_add(&bar[XB_XSUB(b.x)], 1u);
    const unsigned gen = old / nloc;
    if (old + 1u == (gen + 1u) * nloc) {
      __builtin_amdgcn_fence(__ATOMIC_RELEASE, "agent");
      asm volatile("s_waitcnt vmcnt(0)" ::: "memory");
      const unsigned og = xb_add(&bar[XB_TOP], 1u);
      const unsigned tg = og / nx;
      if (og + 1u == (tg + 1u) * nx) xb_add(&bar[XB_TOPGEN], 1u);
      else XB_SPIN(xb_ld(&bar[XB_TOPGEN]) == tg, bar);
      __builtin_amdgcn_fence(__ATOMIC_ACQUIRE, "agent");
      xb_add(&bar[XB_XGEN(b.x)], 1u);
      asm volatile("s_waitcnt vmcnt(0)" ::: "memory");
    } else {
      XB_SPIN(xb_ld(&bar[XB_XGEN(b.x)]) == gen, bar);
      __builtin_amdgcn_fence(__ATOMIC_ACQUIRE, "agent");
      asm volatile("s_waitcnt vmcnt(0)" ::: "memory");
    }
  }
  __syncthreads();
}
constexpr size_t OFF_BAR = 25 * MiB - 16384;
static_assert(OFF_MOD + 3 * 6144 * 4 <= OFF_BAR, "bar");

template <int ph>
__device__ __forceinline__ void run_phase(const Params& p, char* smem) {
  const int bid = blockIdx.x, G = gridDim.x;
  char* ws = p.ws;
  if constexpr (ph == 0) {
    for (int it = bid; it < 272 + 96 + 32 + 3080; it += G) {
      if (it < 272) filter_item(p, it, smem);
      else if (it < 368) mod_item(p, it - 272, smem);
      else if (it < 400) cache_item(p, it - 368);
      else {
        int t = it - 400;
        if (t < 576) transpose_item(p.w_in, 1024, DIN, (bf16_t*)(ws + OFF_WIN), t, 36, smem);
        else if ((t -= 576) < 72) transpose_item(p.w_uq, 384, 768, (bf16_t*)(ws + OFF_WUQ), t, 12, smem);
        else if ((t -= 72) < 64) transpose_item(p.w_ukv, 256, 1024, (bf16_t*)(ws + OFF_WUKV), t, 16, smem);
        else if ((t -= 64) < 256) transpose_item(p.w_out, 1024, 1024, (bf16_t*)(ws + OFF_WOUT), t, 16, smem);
        else if ((t -= 256) < 1408) transpose_item(p.w_up, 1024, 5632, (bf16_t*)(ws + OFF_WUP), t, 88, smem, true);
        else { t -= 1408; transpose_item(p.w_down, 2816, 1024, (bf16_t*)(ws + OFF_WDOWN), t, 16, smem); }
      }
    }
  } else if constexpr (ph == 1) {
    rmsmod_phase<0>(p);
  } else if constexpr (ph == 2) {
    EpiIn epi{(float*)(ws + OFF_PROJ), (bf16_t*)(ws + OFF_HYT)};
    for (int t = bid; t < 128 * 18; t += G)
      gemm_tile<false>((const bf16_t*)(ws + OFF_H), 1024, (const bf16_t*)(ws + OFF_WIN), 1024, 1024, (t / 18) * 128, (t % 18) * 128, smem, epi);
  } else if constexpr (ph == 3) {
    for (int it = bid; it < 512; it += G) hyena_item<0>(p, 1, it, smem);
    for (int it = bid; it < 512; it += G) hyena_item<0>(p, 0, it, smem);
    for (int it = bid; it < 256; it += G) token_item(p, it);
  } else if constexpr (ph == 4) {
    EpiQ eq{(bf16_t*)(ws + OFF_QRAW)};
    EpiKV ekv{(bf16_t*)(ws + OFF_KRAW), (bf16_t*)(ws + OFF_VTC), (bf16_t*)(ws + OFF_VTL)};
    for (int it = bid; it < 512; it += G) hyena_item<1>(p, 1, it, smem);
    for (int t = bid; t < 768; t += G) gemm_tile<true>((const bf16_t*)(ws + OFF_QA), 384, (const bf16_t*)(ws + OFF_WUQ), 384, 384, (t / 6) * 128, (t % 6) * 128, smem, eq);
    for (int t = bid; t < 1088; t += G) gemm_tile<false>((const bf16_t*)(ws + OFF_CKVN), 256, (const bf16_t*)(ws + OFF_WUKV), 256, 256, (t / 8) * 128, (t % 8) * 128, smem, ekv);
    for (int it = bid; it < 512; it += G) hyena_item<1>(p, 0, it, smem);
  } else if constexpr (ph == 5) {
    for (int it = bid; it < 512 + 544; it += G) qk_item(p, it);
  } else if constexpr (ph == 6) {
    for (int it = bid; it < 1024; it += G) attn_item(p, it, smem);
  } else if constexpr (ph == 7) {
    for (int it = bid; it < 512; it += G) merge_item(p, it, smem);
  } else if constexpr (ph == 8) {
    EpiOut epi{&p};
    for (int t = bid; t < 128 * 8; t += G)
      gemm_tile<true>((const bf16_t*)(ws + OFF_H), 1024, (const bf16_t*)(ws + OFF_WOUT), 1024, 1024, (t / 8) * 128, (t % 8) * 128, smem, epi);
  } else if constexpr (ph == 9) {
    rmsmod_phase<1>(p);
  } else if constexpr (ph == 10) {
    for (int t = bid; t < 128 * 44; t += G) gemm_up_act_tile(p, (t / 44) * 128, (t % 44) * 128, smem);
  } else if constexpr (ph == 11) {
    for (int it = bid; it < 704; it += G) actfix_item(p, it);
  } else if constexpr (ph == 12) {
    EpiY epi{&p, 0};
    for (int t = bid; t < 128 * 8; t += G)
      gemm_tile<true>((const bf16_t*)(ws + OFF_U), 2816, (const bf16_t*)(ws + OFF_WDOWN), 2816, 2816, (t / 8) * 128, (t % 8) * 128, smem, epi);
  }
}

#if ONE_LAUNCH
template <int PH>
__device__ __forceinline__ void run_all(const Params& p, char* smem, cg::grid_group& grid, const XcdBarrier& xb) {
  run_phase<PH>(p, smem);
  if constexpr (((DBL_MASK >> PH) & 1) != 0) { xcd_barrier(xb); run_phase<PH>(p, smem); }
  if constexpr (PH < 12) {
    xcd_barrier(xb);
    run_all<PH + 1>(p, smem, grid, xb);
  }
}
__global__ void __launch_bounds__(256, 2) mega_kernel(Params p) {
  __shared__ __attribute__((aligned(16))) char smem[SMEM_BYTES];
  __shared__ uint4 xb_words;
  cg::grid_group grid = cg::this_grid();
  if (threadIdx.x == 0) xb_words = make_uint4(0u, 0u, 0u, 0u);
  __syncthreads();
  XcdBarrier xb = xcd_barrier_post((unsigned*)(p.ws + OFF_BAR), (volatile LAS unsigned*)&xb_words);
  if (p.ws == nullptr) grid.sync();
  run_all<0>(p, smem, grid, xb);
}
#else
template <int PH>
__global__ void __launch_bounds__(256, 2) phase_kernel(Params p) {
  __shared__ __attribute__((aligned(16))) char smem[SMEM_BYTES];
  run_phase<PH>(p, smem);
}
#ifndef DBG_STOP
#define DBG_STOP 15
#endif
__global__ void dump_kernel(Params p, size_t off, int count) {
  const bf16_t* src = (const bf16_t*)(p.ws + off);
  const bf16_t* src2 = (const bf16_t*)(p.ws + DBG_OFF2);
  for (int i = blockIdx.x * 256 + threadIdx.x; i < 16777216; i += gridDim.x * 256)
    p.out[i] = i < DBG_CNT ? bf2f(src[i]) : (i - DBG_CNT < DBG_CNT2 ? bf2f(src2[i - DBG_CNT]) : 0.f);
}
template <int PH>
static void launch_all(const Params& p, hipStream_t stream) {
  phase_kernel<PH><<<512, 256, 0, stream>>>(p);
  if constexpr (PH < 12) launch_all<PH + 1>(p, stream);
}
#endif

extern "C" void kernel_launch(void* const* d_in, const int* in_sizes, int n_in, void* d_out, int out_size, void* d_ws,
                              size_t ws_size, hipStream_t stream) {
  Params p{};
  const float** pp = (const float**)&p;
  for (int i = 0; i < 34; ++i) pp[i] = (const float*)d_in[i];
  p.out = (float*)d_out;
  p.ws = (char*)d_ws;
#if ONE_LAUNCH
  (void)hipMemsetAsync((char*)d_ws + OFF_BAR, 0, XCD_BAR_WORDS * 4, stream);
  static int grid_blocks = 0;
  if (!grid_blocks) {
    int dev = 0, cus = 0, per_cu = 0;
    hipGetDevice(&dev);
    hipDeviceGetAttribute(&cus, hipDeviceAttributeMultiprocessorCount, dev);
    hipOccupancyMaxActiveBlocksPerMultiprocessor(&per_cu, mega_kernel, 256, 0);
    grid_blocks = cus * per_cu;
  }
  void* args[] = {&p};
  hipError_t e = hipLaunchCooperativeKernel((void*)mega_kernel, dim3(grid_blocks), dim3(256), args, 0, stream);
  if (e != hipSuccess) fprintf(stderr, "cooperative launch failed: %s (grid %d)\n", hipGetErrorString(e), grid_blocks);
#else
  launch_all<0>(p, stream);
#if DBG_STOP < 15
  dump_kernel<<<1024, 256, 0, stream>>>(p, DBG_OFF, DBG_CNT);
#endif
#endif
}
```

```cpp
#include <hip/hip_runtime.h>
#include <hip/hip_cooperative_groups.h>
#include <cstdio>
namespace cg = cooperative_groups;

#define DBG_STOP 15
#define DBG_NOHY 0
#ifndef DBL_MASK
#define DBL_MASK 0
#endif
#define DBG_OFF OFF_QRAW
#define DBG_OFF2 OFF_KRAW
#define DBG_CNT 12582912
#define DBG_CNT2 0
#ifndef ONE_LAUNCH
#define ONE_LAUNCH 1
#endif

typedef unsigned short bf16_t;
typedef short bf16x8 __attribute__((ext_vector_type(8)));
typedef float f32x4 __attribute__((ext_vector_type(4)));
typedef float f32x16 __attribute__((ext_vector_type(16)));

constexpr int D = 1024, NTOK = 16384, NCTX = 8192, SEQC = 256, SEQL = 4096;
constexpr int DIN = 2208, DINP = 2304, QL = 384, KVL = 256, DFF = 2816;
constexpr int NROWKV = 17408;
constexpr size_t MiB = 1048576;

constexpr size_t OFF_WIN = 0;
constexpr size_t OFF_WUQ = OFF_WIN + (size_t)DINP * 1024 * 2;
constexpr size_t OFF_WUKV = OFF_WUQ + (size_t)768 * 384 * 2;
constexpr size_t OFF_WOUT = OFF_WUKV + (size_t)1024 * 256 * 2;
constexpr size_t OFF_WUP = OFF_WOUT + (size_t)1024 * 1024 * 2;
constexpr size_t OFF_WDOWN = OFF_WUP + (size_t)5632 * 1024 * 2;
constexpr size_t OFF_MOD = OFF_WDOWN + (size_t)1024 * 2816 * 2;
static_assert(OFF_MOD + 3 * 6144 * 4 <= 25 * MiB, "A region");
constexpr size_t OFF_RLAT = 25 * MiB;
constexpr size_t OFF_RCTX = 41 * MiB;
constexpr size_t OFF_H = 42 * MiB;
constexpr size_t OFF_ZT = 42 * MiB;
constexpr size_t OFF_QA = 58 * MiB;
constexpr size_t OFF_KPE = 70 * MiB;
constexpr size_t OFF_PROJ = 74 * MiB;
constexpr size_t OFF_QRAW = 74 * MiB;
constexpr size_t OFF_Y2T = 98 * MiB;
constexpr size_t OFF_ATTN = 74 * MiB;
constexpr size_t OFF_U = 74 * MiB;
constexpr size_t OFF_HYT = 116 * MiB;
constexpr size_t OFF_Q = 116 * MiB;
constexpr size_t OFF_KC = 140 * MiB;
constexpr size_t OFF_KL = 152 * MiB;
constexpr size_t OFF_CKVN = 164 * MiB;
constexpr size_t OFF_KRAW = 173 * MiB;
constexpr size_t OFF_VTC = 190 * MiB;
constexpr size_t OFF_VTL = 198 * MiB;
constexpr size_t OFF_ACT = 162 * MiB;

constexpr int OUT_YS = 0;
constexpr int OUT_CKV = 16777216;
constexpr int OUT_KPE = 16777216 + 2097152;

constexpr int SMEM_BYTES = 51200;

struct Params {
  const float *x_prompt, *x_sample, *cache_ckv, *cache_kpe, *c, *c_ctx, *w_ada, *b_ada, *g_mix, *w_in, *g_qa, *w_uq,
      *g_kva, *w_ukv, *g_q, *g_k, *hy_conv_w, *hy_conv_b, *filt_w1, *filt_b1, *filt_freq1, *filt_w2, *filt_b2,
      *filt_freq2, *filt_w3, *filt_bias, *g_out_att, *g_out_hy, *w_out, *g_ffn, *w_up, *ffn_conv_w, *ffn_conv_b, *w_down;
  float* out;
  char* ws;
};

typedef __bf16 bf16x2_t __attribute__((ext_vector_type(2)));
__device__ __forceinline__ unsigned pack2(float lo, float hi) {
  bf16x2_t v;
  v[0] = (__bf16)lo;
  v[1] = (__bf16)hi;
  return __builtin_bit_cast(unsigned, v);
}
__device__ __forceinline__ float bflo(unsigned u) { return __uint_as_float(u << 16); }
__device__ __forceinline__ float bfhi(unsigned u) { return __uint_as_float(u & 0xffff0000u); }
__device__ __forceinline__ float bf2f(bf16_t h) { return __uint_as_float(((unsigned)h) << 16); }
__device__ __forceinline__ bf16_t f2bf(float f) { return (bf16_t)(pack2(f, 0.f) & 0xffffu); }
__device__ __forceinline__ float wave_sum(float v) {
#pragma unroll
  for (int o = 32; o >= 1; o >>= 1) v += __shfl_xor(v, o);
  return v;
}
__device__ __forceinline__ int ltid() { int t = threadIdx.x; asm volatile("" : "+v"(t)); return t; }
__device__ __forceinline__ float sin_turns(float t) { t -= floorf(t); return __builtin_amdgcn_sinf(t); }
__device__ __forceinline__ float cos_turns(float t) { t -= floorf(t); return __builtin_amdgcn_cosf(t); }
__device__ __forceinline__ float sin_rad(float x) { return sin_turns(x * 0.15915494309189535f); }
__device__ __forceinline__ const float* xrow(const Params& p, int row) {
  return row < NCTX ? p.x_prompt + (size_t)row * D : p.x_sample + (size_t)(row - NCTX) * D;
}
__device__ __forceinline__ int modidx(int row) { return row < NCTX ? 0 : 1 + ((row - NCTX) >> 12); }

template <bool SWAP>
__device__ __forceinline__ void gemm_main(const bf16_t* __restrict__ A, int lda, const bf16_t* __restrict__ Bt, int ldb,
                                          int K, int m0, int n0, char* smem, f32x4 (&acc)[4][4]) {
  const int tid = ltid(), lane = tid & 63, wid = tid >> 6, wr = wid >> 1, wc = wid & 1;
  const int fr = lane & 15, fq = lane >> 4;
  bf16_t* sA = (bf16_t*)smem;
  bf16_t* sB = sA + 128 * 64;
#pragma unroll
  for (int m = 0; m < 4; ++m)
#pragma unroll
    for (int n = 0; n < 4; ++n) acc[m][n] = (f32x4){0.f, 0.f, 0.f, 0.f};
  const int lr = tid >> 3, lc = (tid & 7) * 8;
  const bf16_t* ga = A + (size_t)(m0 + lr) * lda + lc;
  const bf16_t* gb = Bt + (size_t)(n0 + lr) * ldb + lc;
  const size_t sa32 = (size_t)32 * lda, sb32 = (size_t)32 * ldb;
  uint4 ra0 = *(const uint4*)(ga), ra1 = *(const uint4*)(ga + sa32), ra2 = *(const uint4*)(ga + 2 * sa32), ra3 = *(const uint4*)(ga + 3 * sa32);
  uint4 rb0 = *(const uint4*)(gb), rb1 = *(const uint4*)(gb + sb32), rb2 = *(const uint4*)(gb + 2 * sb32), rb3 = *(const uint4*)(gb + 3 * sb32);
  const int nk = K >> 6;
  const int wsw = (((tid & 7) ^ (lr & 7)) * 8);
  bf16_t* wa = sA + lr * 64 + wsw;
  bf16_t* wb = sB + lr * 64 + wsw;
  for (int kt = 0; kt < nk; ++kt) {
    __syncthreads();
    *(uint4*)(wa) = ra0; *(uint4*)(wa + 32 * 64) = ra1; *(uint4*)(wa + 64 * 64) = ra2; *(uint4*)(wa + 96 * 64) = ra3;
    *(uint4*)(wb) = rb0; *(uint4*)(wb + 32 * 64) = rb1; *(uint4*)(wb + 64 * 64) = rb2; *(uint4*)(wb + 96 * 64) = rb3;
    __syncthreads();
    if (kt + 1 < nk) {
      ga += 64;
      gb += 64;
      ra0 = *(const uint4*)(ga); ra1 = *(const uint4*)(ga + sa32); ra2 = *(const uint4*)(ga + 2 * sa32); ra3 = *(const uint4*)(ga + 3 * sa32);
      rb0 = *(const uint4*)(gb); rb1 = *(const uint4*)(gb + sb32); rb2 = *(const uint4*)(gb + 2 * sb32); rb3 = *(const uint4*)(gb + 3 * sb32);
    }
    __builtin_amdgcn_sched_barrier(0);
#pragma unroll
    for (int ks = 0; ks < 2; ++ks) {
      bf16x8 af[4], bfr[4];
#pragma unroll
      for (int m = 0; m < 4; ++m) af[m] = *(const bf16x8*)(sA + (wr * 64 + m * 16 + fr) * 64 + (((ks * 4 + fq) ^ (fr & 7)) * 8));
#pragma unroll
      for (int n = 0; n < 4; ++n) bfr[n] = *(const bf16x8*)(sB + (wc * 64 + n * 16 + fr) * 64 + (((ks * 4 + fq) ^ (fr & 7)) * 8));
      __builtin_amdgcn_s_setprio(1);
#pragma unroll
      for (int m = 0; m < 4; ++m)
#pragma unroll
        for (int n = 0; n < 4; ++n) {
          if (SWAP) acc[m][n] = __builtin_amdgcn_mfma_f32_16x16x32_bf16(bfr[n], af[m], acc[m][n], 0, 0, 0);
          else acc[m][n] = __builtin_amdgcn_mfma_f32_16x16x32_bf16(af[m], bfr[n], acc[m][n], 0, 0, 0);
        }
      __builtin_amdgcn_s_setprio(0);
    }
  }
}
template <bool SWAP, class Epi>
__device__ __forceinline__ void gemm_tile(const bf16_t* __restrict__ A, int lda, const bf16_t* __restrict__ Bt, int ldb,
                                          int K, int m0, int n0, char* smem, const Epi& epi) {
  f32x4 acc[4][4];
  gemm_main<SWAP>(A, lda, Bt, ldb, K, m0, n0, smem, acc);
  const int tid = ltid(), lane = tid & 63, wid = tid >> 6, wr = wid >> 1, wc = wid & 1;
  const int fr = lane & 15, fq = lane >> 4;
#pragma unroll
  for (int m = 0; m < 4; ++m)
#pragma unroll
    for (int n = 0; n < 4; ++n) {
      if (SWAP) epi(m0 + wr * 64 + m * 16 + fr, n0 + wc * 64 + n * 16 + fq * 4, acc[m][n]);
      else epi(m0 + wr * 64 + m * 16 + fq * 4, n0 + wc * 64 + n * 16 + fr, acc[m][n]);
    }
}

constexpr size_t OFF_EDGE = 162 * MiB;
__device__ __forceinline__ void gemm_up_act_tile(const Params& p, int m0, int n0, char* smem) {
  f32x4 acc[4][4];
  gemm_main<true>((const bf16_t*)(p.ws + OFF_H), 1024, (const bf16_t*)(p.ws + OFF_WUP), 1024, 1024, m0, n0, smem, acc);
  const int tid = ltid(), lane = tid & 63, wid = tid >> 6, wr = wid >> 1, wc = wid & 1;
  const int fr = lane & 15, fq = lane >> 4;
  bf16_t* act = (bf16_t*)(p.ws + OFF_U);
  bf16_t* edge = (bf16_t*)(p.ws + OFF_EDGE);
  const int rowbase = m0 + wr * 64, wt = rowbase >> 6;
  const int upl = (lane + 63) & 63, upl2 = (lane + 15) & 63, dnl = (lane + 1) & 63, dnl2 = (lane + 49) & 63;
#pragma unroll
  for (int i = 0; i < 2; ++i) {
    const int cperm = n0 + wc * 64 + 32 * i;
    const int j0 = (cperm >> 5) * 16 + 4 * fq;
    const float4 wa0 = *(const float4*)(p.ffn_conv_w + j0), wa1 = *(const float4*)(p.ffn_conv_w + 5632 + j0), wa2 = *(const float4*)(p.ffn_conv_w + 11264 + j0);
    const float4 wg0 = *(const float4*)(p.ffn_conv_w + 2816 + j0), wg1 = *(const float4*)(p.ffn_conv_w + 5632 + 2816 + j0), wg2 = *(const float4*)(p.ffn_conv_w + 11264 + 2816 + j0);
    const float4 ba = *(const float4*)(p.ffn_conv_b + j0), bg = *(const float4*)(p.ffn_conv_b + 2816 + j0);
    const float w0a[4] = {wa0.x, wa0.y, wa0.z, wa0.w}, w1a[4] = {wa1.x, wa1.y, wa1.z, wa1.w}, w2a[4] = {wa2.x, wa2.y, wa2.z, wa2.w};
    const float w0g[4] = {wg0.x, wg0.y, wg0.z, wg0.w}, w1g[4] = {wg1.x, wg1.y, wg1.z, wg1.w}, w2g[4] = {wg2.x, wg2.y, wg2.z, wg2.w};
    const float bba[4] = {ba.x, ba.y, ba.z, ba.w}, bbg[4] = {bg.x, bg.y, bg.z, bg.w};
#pragma unroll
    for (int m = 0; m < 4; ++m) {
      float o[4];
#pragma unroll
      for (int e = 0; e < 4; ++e) {
        const float a = acc[m][2 * i][e], g = acc[m][2 * i + 1][e];
        const float au1 = __shfl(a, upl), gu1 = __shfl(g, upl), ad1 = __shfl(a, dnl), gd1 = __shfl(g, dnl);
        float au2 = 0.f, gu2 = 0.f, ad2 = 0.f, gd2 = 0.f;
        if (m > 0) { au2 = __shfl(acc[m - 1][2 * i][e], upl2); gu2 = __shfl(acc[m - 1][2 * i + 1][e], upl2); }
        if (m < 3) { ad2 = __shfl(acc[m + 1][2 * i][e], dnl2); gd2 = __shfl(acc[m + 1][2 * i + 1][e], dnl2); }
        const float au = fr > 0 ? au1 : au2, gu = fr > 0 ? gu1 : gu2, ad = fr < 15 ? ad1 : ad2, gd = fr < 15 ? gd1 : gd2;
        const float ca = w0a[e] * au + w1a[e] * a + w2a[e] * ad + bba[e];
        const float cgv = w0g[e] * gu + w1g[e] * g + w2g[e] * gd + bbg[e];
        o[e] = ca / (1.f + __expf(-ca)) * cgv;
      }
      const int lr64 = m * 16 + fr, row = rowbase + lr64;
      if (lr64 >= 1 && lr64 <= 62) *(uint2*)(act + (size_t)row * 2816 + j0) = make_uint2(pack2(o[0], o[1]), pack2(o[2], o[3]));
      if (lr64 <= 1 || lr64 >= 62) {
        const int slot = lr64 <= 1 ? lr64 : lr64 - 60;
        bf16_t* er = edge + (size_t)(wt * 4 + slot) * 5632;
        *(uint2*)(er + j0) = make_uint2(pack2(acc[m][2 * i][0], acc[m][2 * i][1]), pack2(acc[m][2 * i][2], acc[m][2 * i][3]));
        *(uint2*)(er + 2816 + j0) = make_uint2(pack2(acc[m][2 * i + 1][0], acc[m][2 * i + 1][1]), pack2(acc[m][2 * i + 1][2], acc[m][2 * i + 1][3]));
      }
    }
  }
}

__device__ __forceinline__ void transpose_item(const float* __restrict__ W, int K, int N, bf16_t* __restrict__ WT, int tile, int ntn, char* smem, bool perm = false) {
  float* s = (float*)smem;
  const int tk = tile / ntn, tn = tile % ntn, tid = ltid();
  const int k0 = tk * 64, n0 = tn * 64;
  __syncthreads();
  {
    const int r = tid >> 4, c4 = (tid & 15) * 4;
#pragma unroll
    for (int i = 0; i < 4; ++i) {
      const int k = r + 16 * i;
      float4 v = make_float4(0.f, 0.f, 0.f, 0.f);
      if (n0 + c4 < N) v = *(const float4*)(W + (size_t)(k0 + k) * N + n0 + c4);
      s[k * 65 + c4 + 0] = v.x; s[k * 65 + c4 + 1] = v.y; s[k * 65 + c4 + 2] = v.z; s[k * 65 + c4 + 3] = v.w;
    }
  }
  __syncthreads();
  {
    const int n = tid >> 2, kc = (tid & 3) * 16;
    unsigned o[8];
#pragma unroll
    for (int i = 0; i < 8; ++i) o[i] = pack2(s[(kc + 2 * i) * 65 + n], s[(kc + 2 * i + 1) * 65 + n]);
    int nr = n0 + n;
    if (perm) { const int hf = nr >= 2816 ? 1 : 0, cc = nr - hf * 2816; nr = 32 * (cc >> 4) + 16 * hf + (cc & 15); }
    uint4* dst = (uint4*)(WT + (size_t)nr * K + k0 + kc);
    dst[0] = make_uint4(o[0], o[1], o[2], o[3]);
    dst[1] = make_uint4(o[4], o[5], o[6], o[7]);
  }
}

__device__ __forceinline__ void mod_item(const Params& p, int item, char* smem) {
  float* s = (float*)smem;
  float* red = s + 3072;
  const int tid = ltid();
  __syncthreads();
  for (int e = tid; e < 3072; e += 256) {
    const int v = e >> 10, k = e & 1023;
    const float x = (v == 0) ? p.c_ctx[k] : p.c[(v - 1) * D + k];
    s[e] = x / (1.f + __expf(-x));
  }
  __syncthreads();
  const int jl = tid & 63, kq = tid >> 6, j = item * 64 + jl, k0 = kq * 256;
  float a0 = 0.f, a1 = 0.f, a2 = 0.f;
#pragma unroll 8
  for (int k = 0; k < 256; ++k) {
    const float w = p.w_ada[(size_t)(k0 + k) * 6144 + j];
    a0 += s[k0 + k] * w; a1 += s[1024 + k0 + k] * w; a2 += s[2048 + k0 + k] * w;
  }
  red[(kq * 3 + 0) * 64 + jl] = a0; red[(kq * 3 + 1) * 64 + jl] = a1; red[(kq * 3 + 2) * 64 + jl] = a2;
  __syncthreads();
  if (tid < 192) {
    const int v = tid >> 6;
    const float r = red[(0 * 3 + v) * 64 + jl] + red[(1 * 3 + v) * 64 + jl] + red[(2 * 3 + v) * 64 + jl] + red[(3 * 3 + v) * 64 + jl];
    ((float*)(p.ws + OFF_MOD))[v * 6144 + j] = r + p.b_ada[j];
  }
}

__device__ __forceinline__ void filter_item(const Params& p, int item, char* smem) {
  int n, p0; bf16_t* R;
  if (item < 256) { n = 4096; p0 = item * 16; R = (bf16_t*)(p.ws + OFF_RLAT); }
  else { n = 256; p0 = (item - 256) * 16; R = (bf16_t*)(p.ws + OFF_RCTX); }
  const int n2 = 2 * n, tid = ltid();
  float* z = (float*)smem;
  float* h1 = z + 16 * 36;
  float* h2 = h1 + 16 * 64;
  __syncthreads();
#pragma unroll 1
  for (int e = tid; e < 16 * 33; e += 256) {
    const int pp = e / 33, f = e % 33, pos = p0 + pp;
    float val;
    if (f == 0) val = (float)pos / (float)(n - 1);
    else {
      const int k = (f - 1) & 15;
      const float band = 1e-4f + (float)k * ((15.f - 1e-4f) / 15.f);
      const float turns = band * ((float)pos / (float)n);
      val = (f <= 16) ? cos_turns(turns) : -sin_turns(turns);
    }
    z[pp * 36 + f] = val;
  }
  __syncthreads();
#pragma unroll 1
  for (int e = tid; e < 1024; e += 256) {
    const int pp = e >> 6, j = e & 63;
    float a = p.filt_b1[j];
#pragma unroll 3
    for (int f = 0; f < 33; ++f) a += z[pp * 36 + f] * p.filt_w1[f * 64 + j];
    h1[e] = sin_rad(p.filt_freq1[j] * a);
  }
  __syncthreads();
#pragma unroll 1
  for (int e = tid; e < 1024; e += 256) {
    const int pp = e >> 6, j = e & 63;
    float a = p.filt_b2[j];
#pragma unroll 4
    for (int k = 0; k < 64; ++k) a += h1[pp * 64 + k] * p.filt_w2[k * 64 + j];
    h2[j * 16 + pp] = sin_rad(p.filt_freq2[j] * a);
  }
  __syncthreads();
  const float mind = -3.0701134573253946f, maxd = -15.350567286626973f;
#pragma unroll 1
  for (int ci = 0; ci < 8; ++ci) {
    const int col = tid + 256 * ci, o = col >> 10, dir = (col >> 9) & 1, c = col & 511;
    float acc[16];
#pragma unroll
    for (int i = 0; i < 16; ++i) acc[i] = 0.f;
#pragma unroll 4
    for (int k = 0; k < 64; ++k) {
      const float w = p.filt_w3[k * 2048 + col];
      const float4 ha = *(const float4*)(h2 + k * 16), hb = *(const float4*)(h2 + k * 16 + 4), hc = *(const float4*)(h2 + k * 16 + 8), hd = *(const float4*)(h2 + k * 16 + 12);
      acc[0] += ha.x * w; acc[1] += ha.y * w; acc[2] += ha.z * w; acc[3] += ha.w * w;
      acc[4] += hb.x * w; acc[5] += hb.y * w; acc[6] += hb.z * w; acc[7] += hb.w * w;
      acc[8] += hc.x * w; acc[9] += hc.y * w; acc[10] += hc.z * w; acc[11] += hc.w * w;
      acc[12] += hd.x * w; acc[13] += hd.y * w; acc[14] += hd.z * w; acc[15] += hd.w * w;
    }
    const float delta = fabsf(mind + (float)c * ((maxd - mind) / 511.f));
    bf16_t* Rrow = R + (size_t)(o * 512 + c) * n2;
#pragma unroll
    for (int i = 0; i < 16; ++i) {
      const int pos = p0 + i;
      const float t = (float)pos / (float)(n - 1);
      float val = acc[i] * (__expf(-t * delta) + 0.05f);
      int idx = dir == 0 ? (n - 1 - pos) : (n - 1 + pos);
      if (dir == 1 && pos == 0) { idx = n2 - 1; val = 0.f; }
      Rrow[idx] = f2bf(val);
    }
  }
}

__device__ __forceinline__ void cache_item(const Params& p, int item) {
  const int tid = ltid(), r0 = item * 32;
  bf16_t* ckvn = (bf16_t*)(p.ws + OFF_CKVN);
#pragma unroll 2
  for (int e = tid; e < 32 * 64; e += 256) {
    const int r = r0 + (e >> 6), c4 = (e & 63) * 4;
    const float4 v = *(const float4*)(p.cache_ckv + (size_t)r * 256 + c4);
    *(uint2*)(ckvn + (size_t)(NTOK + r) * 256 + c4) = make_uint2(pack2(v.x, v.y), pack2(v.z, v.w));
  }
}

template <int WHICH>
__device__ __forceinline__ void rmsmod_phase(const Params& p) {
  const int tid = ltid(), lane = tid & 63, wid = tid >> 6;
  const int gw = blockIdx.x * 4 + wid, tw = gridDim.x * 4;
  const float* g = WHICH == 0 ? p.g_mix : p.g_ffn;
  const float* mod = (const float*)(p.ws + OFF_MOD);
  bf16_t* h = (bf16_t*)(p.ws + OFF_H);
  for (int row = gw; row < NTOK; row += tw) {
    const float* src = WHICH == 0 ? xrow(p, row) : p.out + (size_t)row * D;
    float4 v[4];
    float ss = 0.f;
#pragma unroll
    for (int i = 0; i < 4; ++i) {
      v[i] = ((const float4*)src)[lane + 64 * i];
      ss += v[i].x * v[i].x + v[i].y * v[i].y + v[i].z * v[i].z + v[i].w * v[i].w;
    }
    ss = wave_sum(ss);
    const float r = rsqrtf(ss * (1.f / 1024.f) + 1e-6f);
    const float* mv = mod + modidx(row) * 6144 + (WHICH == 0 ? 0 : 3 * 1024);
#pragma unroll
    for (int i = 0; i < 4; ++i) {
      const int e = 4 * (lane + 64 * i);
      const float4 g4 = *(const float4*)(g + e), sh = *(const float4*)(mv + e), sc = *(const float4*)(mv + 1024 + e);
      const float y0 = v[i].x * r * g4.x * (1.f + sc.x) + sh.x, y1 = v[i].y * r * g4.y * (1.f + sc.y) + sh.y;
      const float y2 = v[i].z * r * g4.z * (1.f + sc.z) + sh.z, y3 = v[i].w * r * g4.w * (1.f + sc.w) + sh.w;
      *(uint2*)(h + (size_t)row * D + e) = make_uint2(pack2(y0, y1), pack2(y2, y3));
    }
  }
}

struct EpiIn {
  float* proj; bf16_t* hyT;
  __device__ __forceinline__ void operator()(int row0, int col, const f32x4& v) const {
    if (col < 672) {
#pragma unroll
      for (int j = 0; j < 4; ++j) proj[(size_t)(row0 + j) * 672 + col] = v[j];
    } else if (col < DIN) {
      *(uint2*)(hyT + (size_t)(col - 672) * NTOK + row0) = make_uint2(pack2(v[0], v[1]), pack2(v[2], v[3]));
    }
  }
};
struct EpiQ {
  bf16_t* q;
  __device__ __forceinline__ void operator()(int row, int col0, const f32x4& v) const {
    *(uint2*)(q + (size_t)row * 768 + col0) = make_uint2(pack2(v[0], v[1]), pack2(v[2], v[3]));
  }
};
struct EpiKV {
  bf16_t *kraw, *vtc, *vtl;
  __device__ __forceinline__ void operator()(int row0, int col, const f32x4& v) const {
    const int head = col >> 7, cc = col & 127;
    if (cc < 64) {
#pragma unroll
      for (int j = 0; j < 4; ++j) kraw[(size_t)(row0 + j) * 512 + head * 64 + cc] = f2bf(v[j]);
    } else {
      const int dv = cc - 64;
      bf16_t* dst;
      if (row0 < NCTX) dst = vtc + ((size_t)((row0 >> 8) * 8 + head) * 64 + dv) * 256 + (row0 & 255);
      else if (row0 < NTOK) { const int r = row0 - NCTX; dst = vtl + ((size_t)((r >> 12) * 8 + head) * 64 + dv) * 4608 + (r & 4095); }
      else { const int r = row0 - NTOK; dst = vtl + ((size_t)((r >> 9) * 8 + head) * 64 + dv) * 4608 + 4096 + (r & 511); }
      *(uint2*)dst = make_uint2(pack2(v[0], v[1]), pack2(v[2], v[3]));
    }
  }
};
struct EpiOut {
  const Params* p;
  __device__ __forceinline__ void operator()(int row, int col0, const f32x4& v) const {
    const float4 x = *(const float4*)(xrow(*p, row) + col0);
    const float4 m = *(const float4*)((const float*)(p->ws + OFF_MOD) + modidx(row) * 6144 + 2 * 1024 + col0);
    *(float4*)(p->out + (size_t)row * D + col0) = make_float4(x.x + m.x * v[0], x.y + m.y * v[1], x.z + m.z * v[2], x.w + m.w * v[3]);
  }
};
struct EpiU {
  bf16_t* u;
  __device__ __forceinline__ void operator()(int row, int col0, const f32x4& v) const {
    *(uint2*)(u + (size_t)row * 5632 + col0) = make_uint2(pack2(v[0], v[1]), pack2(v[2], v[3]));
  }
};
struct EpiY {
  const Params* p; int half;
  __device__ __forceinline__ void operator()(int row, int col0, const f32x4& v) const {
    const int grow = half * 8192 + row;
    float4* dst = (float4*)(p->out + (size_t)grow * D + col0);
    const float4 x = *dst;
    const float4 m = *(const float4*)((const float*)(p->ws + OFF_MOD) + modidx(grow) * 6144 + 5 * 1024 + col0);
    *dst = make_float4(x.x + m.x * v[0], x.y + m.y * v[1], x.z + m.z * v[2], x.w + m.w * v[3]);
  }
};

__device__ __forceinline__ void token_item(const Params& p, int item) {
  const int tid = ltid(), lane = tid & 63, wid = tid >> 6;
  const float* proj = (const float*)(p.ws + OFF_PROJ);
  bf16_t* qa = (bf16_t*)(p.ws + OFF_QA);
  bf16_t* ckvn = (bf16_t*)(p.ws + OFF_CKVN);
  float* kpe = (float*)(p.ws + OFF_KPE);
  for (int tt = 0; tt < 16; ++tt) {
    const int token = item * 64 + wid * 16 + tt;
    const float* pr = proj + (size_t)token * 672;
    float2 q[3];
    float ss = 0.f;
#pragma unroll
    for (int i = 0; i < 3; ++i) { q[i] = *(const float2*)(pr + lane * 2 + 128 * i); ss += q[i].x * q[i].x + q[i].y * q[i].y; }
    ss = wave_sum(ss);
    const float r = rsqrtf(ss * (1.f / 384.f) + 1e-6f);
#pragma unroll
    for (int i = 0; i < 3; ++i) {
      const int e = lane * 2 + 128 * i;
      *(unsigned*)(qa + (size_t)token * 384 + e) = pack2(q[i].x * r * p.g_qa[e], q[i].y * r * p.g_qa[e + 1]);
    }
    const float4 kv = *(const float4*)(pr + 384 + lane * 4);
    float s2 = wave_sum(kv.x * kv.x + kv.y * kv.y + kv.z * kv.z + kv.w * kv.w);
    const float r2 = rsqrtf(s2 * (1.f / 256.f) + 1e-6f);
    const float4 g = *(const float4*)(p.g_kva + lane * 4);
    const float4 y = make_float4(kv.x * r2 * g.x, kv.y * r2 * g.y, kv.z * r2 * g.z, kv.w * r2 * g.w);
    *(uint2*)(ckvn + (size_t)token * 256 + lane * 4) = make_uint2(pack2(y.x, y.y), pack2(y.z, y.w));
    if (token < NCTX) *(float4*)(p.out + OUT_CKV + (size_t)token * 256 + lane * 4) = y;
    if (lane < 32) {
      const float kp = pr[640 + lane];
      kpe[(size_t)token * 32 + lane] = kp;
      if (token < NCTX) p.out[OUT_KPE + (size_t)token * 32 + lane] = kp;
    }
  }
}

template <int ORDER>
__device__ __forceinline__ void hyena_item(const Params& p, int grp, int c, char* smem) {
  const int tid = ltid(), lane = tid & 63, wid = tid >> 6, fr = lane & 15, fq = lane >> 4;
  const int n = grp ? SEQL : SEQC, nb = n >> 6, L = n;
  const bf16_t* Rrow = (const bf16_t*)(p.ws + (grp ? OFF_RLAT : OFF_RCTX)) + (size_t)(ORDER * 512 + c) * (2 * n);
  const bf16_t* hyT = (const bf16_t*)(p.ws + OFF_HYT);
  bf16_t* sU = (bf16_t*)smem;
  unsigned* sR0 = (unsigned*)(smem + 18432);
  unsigned* sR1 = (unsigned*)(smem + 18432 + 16384);
  const int tok0 = grp * 8192;
  __syncthreads();
  for (int ch = tid; ch < (2 * n) / 8; ch += 256) *(uint4*)((bf16_t*)sR0 + ch * 8) = *(const uint4*)(Rrow + ch * 8);
  if (ORDER == 0) {
    const bf16_t* raw = hyT + (size_t)c * NTOK + tok0;
    const float w0 = p.hy_conv_w[c], w1 = p.hy_conv_w[1536 + c], w2 = p.hy_conv_w[3072 + c], b = p.hy_conv_b[c];
    for (int ch = tid; ch < 1024; ch += 256) {
      const int t = ch * 8, pos = t & (L - 1);
      const uint4 rv = *(const uint4*)(raw + t);
      float x[10];
      x[0] = pos == 0 ? 0.f : bf2f(raw[t - 1]);
      x[1] = bflo(rv.x); x[2] = bfhi(rv.x); x[3] = bflo(rv.y); x[4] = bfhi(rv.y);
      x[5] = bflo(rv.z); x[6] = bfhi(rv.z); x[7] = bflo(rv.w); x[8] = bfhi(rv.w);
      x[9] = (pos + 8 == L) ? 0.f : bf2f(raw[t + 8]);
      float u[8];
#pragma unroll
      for (int i = 0; i < 8; ++i) u[i] = w0 * x[i] + w1 * x[i + 1] + w2 * x[i + 2] + b;
      *(uint4*)(sU + (ch >> 3) * 64 + (((ch & 7) ^ ((ch >> 3) & 7)) * 8)) = make_uint4(pack2(u[0], u[1]), pack2(u[2], u[3]), pack2(u[4], u[5]), pack2(u[6], u[7]));
    }
  } else {
    const bf16_t* zr = (const bf16_t*)(p.ws + OFF_ZT) + (size_t)c * NTOK + tok0;
    for (int ch = tid; ch < 1024; ch += 256) *(uint4*)(sU + (ch >> 3) * 64 + (((ch & 7) ^ ((ch >> 3) & 7)) * 8)) = *(const uint4*)(zr + ch * 8);
  }
  __syncthreads();
  for (int k = tid; k < n; k += 256) {
    const unsigned a = sR0[k], b2 = (k + 1 < n) ? sR0[k + 1] : 0u;
    sR1[k] = (a >> 16) | (b2 << 16);
  }
  __syncthreads();

  f32x4 acc[4][2];
#pragma unroll
  for (int m = 0; m < 4; ++m) { acc[m][0] = (f32x4){0.f, 0.f, 0.f, 0.f}; acc[m][1] = (f32x4){0.f, 0.f, 0.f, 0.f}; }
  const unsigned* abase = (fr & 1) ? (sR0 + ((n - 1 - fr) >> 1) + 4 * fq) : (sR1 + ((n - 2 - fr) >> 1) + 4 * fq);
  const int col0 = 32 * wid + fr, col1 = col0 + 16;
  const int i0 = col0 & (nb - 1), i1 = col1 & (nb - 1);
  for (int d = -(nb - 1); d <= nb - 1; ++d) {
    const bool v0 = (unsigned)(i0 - d) < (unsigned)nb, v1 = (unsigned)(i1 - d) < (unsigned)nb;
    const bool any0 = __ballot(v0) != 0ull, any1 = __ballot(v1) != 0ull;
    if (!any0 && !any1) continue;
    bf16x8 F[6];
    const unsigned* ap = abase - 32 * d + 16;
#pragma unroll
    for (int idx = 0; idx < 6; ++idx) {
      const unsigned* q = ap - 8 * idx;
      union { unsigned u[4]; bf16x8 v; } cv;
      cv.u[0] = q[0]; cv.u[1] = q[1]; cv.u[2] = q[2]; cv.u[3] = q[3];
      F[idx] = cv.v;
    }
#pragma unroll
    for (int nt = 0; nt < 2; ++nt) {
      if (!(nt ? any1 : any0)) continue;
      const bool vv = nt ? v1 : v0;
      const int srow = (nt ? col1 : col0) - d;
      const bf16_t* up = sU + srow * 64;
#pragma unroll
      for (int ks = 0; ks < 2; ++ks) {
        bf16x8 bf = (bf16x8){0, 0, 0, 0, 0, 0, 0, 0};
        if (vv) bf = *(const bf16x8*)(up + (((ks * 4 + fq) ^ (srow & 7)) * 8));
#pragma unroll
        for (int m = 0; m < 4; ++m)
          acc[m][nt] = __builtin_amdgcn_mfma_f32_16x16x32_bf16(F[m + 2 - 2 * ks], bf, acc[m][nt], 0, 0, 0);
      }
    }
  }
  const float skip = p.filt_bias[ORDER * 512 + c];
  const int gcol = (ORDER == 0 ? 512 : 1024) + c;
  const bf16_t* graw = hyT + (size_t)gcol * NTOK + tok0;
  const float w0 = p.hy_conv_w[gcol], w1 = p.hy_conv_w[1536 + gcol], w2 = p.hy_conv_w[3072 + gcol], b = p.hy_conv_b[gcol];
  bf16_t* outT = (bf16_t*)(p.ws + (ORDER == 0 ? OFF_ZT : OFF_Y2T)) + (size_t)c * NTOK + tok0;
#pragma unroll
  for (int nt = 0; nt < 2; ++nt) {
    const int col = nt ? col1 : col0;
#pragma unroll
    for (int m = 0; m < 4; ++m) {
      const int t = col * 64 + 16 * m + 4 * fq, pos = t & (L - 1);
      const uint2 uu = *(const uint2*)(sU + col * 64 + (((2 * m + (fq >> 1)) ^ (col & 7)) * 8) + 4 * (fq & 1));
      const uint2 gv = *(const uint2*)(graw + t);
      float x[6];
      x[0] = pos == 0 ? 0.f : bf2f(graw[t - 1]);
      x[1] = bflo(gv.x); x[2] = bfhi(gv.x); x[3] = bflo(gv.y); x[4] = bfhi(gv.y);
      x[5] = (pos + 4 == L) ? 0.f : bf2f(graw[t + 4]);
      const float u4[4] = {bflo(uu.x), bfhi(uu.x), bflo(uu.y), bfhi(uu.y)};
      float o[4];
#pragma unroll
      for (int j = 0; j < 4; ++j) {
        const float gate = w0 * x[j] + w1 * x[j + 1] + w2 * x[j + 2] + b;
        o[j] = gate * (acc[m][nt][j] + skip * u4[j]);
      }
      *(uint2*)(outT + t) = make_uint2(pack2(o[0], o[1]), pack2(o[2], o[3]));
    }
  }
}

__device__ __forceinline__ void rope32(float* y  , int pos) {
  const float prow = (float)(pos >> 6), pcol = (float)(pos & 63);
  const float fr[8] = {1.f, 0.31622776601683794f, 0.1f, 0.031622776601683794f, 0.01f, 0.0031622776601683794f, 0.001f, 0.00031622776601683794f};
#pragma unroll
  for (int i = 0; i < 8; ++i) {
    const float tr = prow * fr[i] * 0.15915494309189535f, tc = pcol * fr[i] * 0.15915494309189535f;
    const float sr = sin_turns(tr), cr = cos_turns(tr), sc = sin_turns(tc), cc = cos_turns(tc);
    const float a = y[i], b = y[8 + i], c2 = y[16 + i], d2 = y[24 + i];
    y[i] = a * cr - b * sr; y[8 + i] = b * cr + a * sr;
    y[16 + i] = c2 * cc - d2 * sc; y[24 + i] = d2 * cc + c2 * sc;
  }
}
__device__ __forceinline__ void unpack8(const uint4& v, float* x) {
  x[0] = bflo(v.x); x[1] = bfhi(v.x); x[2] = bflo(v.y); x[3] = bfhi(v.y);
  x[4] = bflo(v.z); x[5] = bfhi(v.z); x[6] = bflo(v.w); x[7] = bfhi(v.w);
}
__device__ __forceinline__ float sumsq8(const uint4& v) {
  float x[8];
  unpack8(v, x);
  return x[0] * x[0] + x[1] * x[1] + x[2] * x[2] + x[3] * x[3] + x[4] * x[4] + x[5] * x[5] + x[6] * x[6] + x[7] * x[7];
}
__device__ __forceinline__ uint4 scale8(const uint4& v, float r, const float* __restrict__ g) {
  float x[8];
  unpack8(v, x);
  const float4 g0 = *(const float4*)g, g1 = *(const float4*)(g + 4);
  return make_uint4(pack2(x[0] * r * g0.x, x[1] * r * g0.y), pack2(x[2] * r * g0.z, x[3] * r * g0.w),
                    pack2(x[4] * r * g1.x, x[5] * r * g1.y), pack2(x[6] * r * g1.z, x[7] * r * g1.w));
}
__device__ __forceinline__ void qk_item(const Params& p, int item) {
  const int tid = ltid();
  if (item < 512) {
    const int idx = item * 256 + tid, row = idx >> 3, h = idx & 7;
    const bf16_t* src = (const bf16_t*)(p.ws + OFF_QRAW) + (size_t)row * 768 + h * 96;
    bf16_t* dst = (bf16_t*)(p.ws + OFF_Q) + (size_t)row * 768 + h * 96;
    uint4 raw[12];
#pragma unroll
    for (int i = 0; i < 12; ++i) raw[i] = *(const uint4*)(src + 8 * i);
    float ss = 0.f;
#pragma unroll
    for (int i = 0; i < 12; ++i) ss += sumsq8(raw[i]);
    const float r = rsqrtf(ss * (1.f / 96.f) + 1e-6f);
    const float qs = 0.10206207261596575f * 1.4426950408889634f;
#pragma unroll
    for (int i = 0; i < 8; ++i) *(uint4*)(dst + 8 * i) = scale8(raw[i], r * qs, p.g_q + 8 * i);
    float y[32];
#pragma unroll
    for (int i = 0; i < 4; ++i) unpack8(raw[8 + i], y + 8 * i);
#pragma unroll
    for (int i = 0; i < 32; ++i) y[i] = y[i] * r * p.g_q[64 + i];
    if (row >= NCTX) rope32(y, (row - NCTX) & 4095);
#pragma unroll
    for (int i = 0; i < 4; ++i)
      *(uint4*)(dst + 64 + 8 * i) = make_uint4(pack2(y[8 * i] * qs, y[8 * i + 1] * qs), pack2(y[8 * i + 2] * qs, y[8 * i + 3] * qs),
                                               pack2(y[8 * i + 4] * qs, y[8 * i + 5] * qs), pack2(y[8 * i + 6] * qs, y[8 * i + 7] * qs));
  } else {
    const int idx = (item - 512) * 256 + tid, row = idx >> 3, h = idx & 7;
    const bf16_t* src = (const bf16_t*)(p.ws + OFF_KRAW) + (size_t)row * 512 + h * 64;
    uint4 raw[8];
#pragma unroll
    for (int i = 0; i < 8; ++i) raw[i] = *(const uint4*)(src + 8 * i);
    const float* kp = row < NTOK ? (const float*)(p.ws + OFF_KPE) + (size_t)row * 32 : p.cache_kpe + (size_t)(row - NTOK) * 32;
    float y[32];
#pragma unroll
    for (int i = 0; i < 8; ++i) {
      const float4 v = *(const float4*)(kp + 4 * i);
      y[4 * i] = v.x; y[4 * i + 1] = v.y; y[4 * i + 2] = v.z; y[4 * i + 3] = v.w;
    }
    float ss = 0.f;
#pragma unroll
    for (int i = 0; i < 8; ++i) ss += sumsq8(raw[i]);
#pragma unroll
    for (int i = 0; i < 32; ++i) ss += y[i] * y[i];
    const float r = rsqrtf(ss * (1.f / 96.f) + 1e-6f);
#pragma unroll
    for (int i = 0; i < 32; ++i) y[i] = y[i] * r * p.g_k[64 + i];
    bf16_t* dst;
    if (row < NCTX) dst = (bf16_t*)(p.ws + OFF_KC) + ((size_t)((row >> 8) * 8 + h) * 256 + (row & 255)) * 96;
    else if (row < NTOK) {
      const int rr = row - NCTX;
      rope32(y, rr & 4095);
      dst = (bf16_t*)(p.ws + OFF_KL) + ((size_t)((rr >> 12) * 8 + h) * 4608 + (rr & 4095)) * 96;
    } else {
      const int rr = row - NTOK;
      dst = (bf16_t*)(p.ws + OFF_KL) + ((size_t)((rr >> 9) * 8 + h) * 4608 + 4096 + (rr & 511)) * 96;
    }
#pragma unroll
    for (int i = 0; i < 8; ++i) *(uint4*)(dst + 8 * i) = scale8(raw[i], r, p.g_k + 8 * i);
#pragma unroll
    for (int i = 0; i < 4; ++i)
      *(uint4*)(dst + 64 + 8 * i) = make_uint4(pack2(y[8 * i], y[8 * i + 1]), pack2(y[8 * i + 2], y[8 * i + 3]),
                                               pack2(y[8 * i + 4], y[8 * i + 5]), pack2(y[8 * i + 6], y[8 * i + 7]));
  }
}

__device__ __forceinline__ void attn_item(const Params& p, int item, char* smem) {
  const int tid = ltid(), lane = tid & 63, wid = tid >> 6, lr = lane & 31, lh = lane >> 5;
  int nkeys, h, tokbase; const bf16_t *Kp, *Vp;
  if (item < 512) {
    const int b = item >> 8, rem = item & 255; h = rem >> 5; const int qb = rem & 31;
    nkeys = 4608; tokbase = NCTX + b * 4096 + qb * 128;
    Kp = (const bf16_t*)(p.ws + OFF_KL) + (size_t)(b * 8 + h) * 4608 * 96;
    Vp = (const bf16_t*)(p.ws + OFF_VTL) + (size_t)(b * 8 + h) * 64 * 4608;
  } else {
    const int it = item - 512, b = it >> 4; h = (it & 15) >> 1; const int qb = it & 1;
    nkeys = 256; tokbase = b * 256 + qb * 128;
    Kp = (const bf16_t*)(p.ws + OFF_KC) + (size_t)(b * 8 + h) * 256 * 96;
    Vp = (const bf16_t*)(p.ws + OFF_VTC) + (size_t)(b * 8 + h) * 64 * 256;
  }
  bf16_t* sK = (bf16_t*)smem;
  bf16_t* sV = sK + 64 * 104;
  const int token = tokbase + 32 * wid + lr;
  const bf16_t* qsrc = (const bf16_t*)(p.ws + OFF_Q) + (size_t)token * 768 + h * 96 + 8 * lh;
  bf16x8 qf[6];
#pragma unroll
  for (int ks = 0; ks < 6; ++ks) qf[ks] = *(const bf16x8*)(qsrc + 16 * ks);
  f32x16 oacc[2];
#pragma unroll
  for (int j = 0; j < 16; ++j) { oacc[0][j] = 0.f; oacc[1][j] = 0.f; }
  float mrun = -1e30f, lsum = 0.f;
  const int kk0 = tid / 12, kc0 = tid % 12, kk1 = (tid + 256) / 12, kc1 = (tid + 256) % 12, kk2 = (tid + 512) / 12, kc2 = (tid + 512) % 12;
  const int vd0 = tid >> 3, vc0 = tid & 7, vd1 = vd0 + 32;
  const bf16_t* gk0 = Kp + (size_t)kk0 * 96 + kc0 * 8;
  const bf16_t* gk1 = Kp + (size_t)kk1 * 96 + kc1 * 8;
  const bf16_t* gk2 = Kp + (size_t)kk2 * 96 + kc2 * 8;
  const bf16_t* gv0 = Vp + (size_t)vd0 * nkeys + vc0 * 8;
  const bf16_t* gv1 = Vp + (size_t)vd1 * nkeys + vc0 * 8;
  uint4 rk0 = *(const uint4*)gk0, rk1 = *(const uint4*)gk1, rk2 = *(const uint4*)gk2;
  uint4 rv0 = *(const uint4*)gv0, rv1 = *(const uint4*)gv1;
  const int nt = nkeys >> 6;
  for (int kt = 0; kt < nt; ++kt) {
    __syncthreads();
    *(uint4*)(sK + kk0 * 104 + kc0 * 8) = rk0; *(uint4*)(sK + kk1 * 104 + kc1 * 8) = rk1; *(uint4*)(sK + kk2 * 104 + kc2 * 8) = rk2;
    *(uint4*)(sV + vd0 * 72 + vc0 * 8) = rv0; *(uint4*)(sV + vd1 * 72 + vc0 * 8) = rv1;
    __syncthreads();
    if (kt + 1 < nt) {
      gk0 += 64 * 96; gk1 += 64 * 96; gk2 += 64 * 96; gv0 += 64; gv1 += 64;
      rk0 = *(const uint4*)gk0; rk1 = *(const uint4*)gk1; rk2 = *(const uint4*)gk2;
      rv0 = *(const uint4*)gv0; rv1 = *(const uint4*)gv1;
    }
    __builtin_amdgcn_sched_barrier(0);
    f32x16 sacc[2];
#pragma unroll
    for (int kb = 0; kb < 2; ++kb) {
#pragma unroll
      for (int j = 0; j < 16; ++j) sacc[kb][j] = 0.f;
#pragma unroll
      for (int ks = 0; ks < 6; ++ks) {
        const bf16x8 a = *(const bf16x8*)(sK + (32 * kb + lr) * 104 + 16 * ks + 8 * lh);
        sacc[kb] = __builtin_amdgcn_mfma_f32_32x32x16_bf16(a, qf[ks], sacc[kb], 0, 0, 0);
      }
    }
    float mx = sacc[0][0];
#pragma unroll
    for (int j = 1; j < 16; ++j) mx = fmaxf(mx, sacc[0][j]);
#pragma unroll
    for (int j = 0; j < 16; ++j) mx = fmaxf(mx, sacc[1][j]);
    mx = fmaxf(mx, __shfl_xor(mx, 32));
    const float mnew = fmaxf(mrun, mx);
    const float alpha = __builtin_amdgcn_exp2f(mrun - mnew);
    mrun = mnew;
    float ps = 0.f;
#pragma unroll
    for (int kb = 0; kb < 2; ++kb)
#pragma unroll
      for (int j = 0; j < 16; ++j) { const float e = __builtin_amdgcn_exp2f(sacc[kb][j] - mnew); sacc[kb][j] = e; ps += e; }
    lsum = lsum * alpha + ps;
#pragma unroll
    for (int j = 0; j < 16; ++j) { oacc[0][j] *= alpha; oacc[1][j] *= alpha; }
#pragma unroll
    for (int s = 0; s < 4; ++s) {
      const int kb = s >> 1, jb = 8 * (s & 1);
      union { unsigned u[4]; bf16x8 v; } pf;
      pf.u[0] = pack2(sacc[kb][jb + 0], sacc[kb][jb + 1]); pf.u[1] = pack2(sacc[kb][jb + 2], sacc[kb][jb + 3]);
      pf.u[2] = pack2(sacc[kb][jb + 4], sacc[kb][jb + 5]); pf.u[3] = pack2(sacc[kb][jb + 6], sacc[kb][jb + 7]);
#pragma unroll
      for (int mt = 0; mt < 2; ++mt) {
        const bf16_t* vp = sV + (32 * mt + lr) * 72 + 16 * s + 4 * lh;
        union { uint2 d[2]; bf16x8 v; } av;
        av.d[0] = *(const uint2*)vp;
        av.d[1] = *(const uint2*)(vp + 8);
        oacc[mt] = __builtin_amdgcn_mfma_f32_32x32x16_bf16(av.v, pf.v, oacc[mt], 0, 0, 0);
      }
    }
  }
  lsum += __shfl_xor(lsum, 32);
  const float inv = 1.f / lsum;
  bf16_t* dst = (bf16_t*)(p.ws + OFF_ATTN) + (size_t)token * 512 + h * 64;
#pragma unroll
  for (int mt = 0; mt < 2; ++mt)
#pragma unroll
    for (int jg = 0; jg < 4; ++jg) {
      const int dv0 = 32 * mt + 8 * jg + 4 * lh;
      *(uint2*)(dst + dv0) = make_uint2(pack2(oacc[mt][4 * jg] * inv, oacc[mt][4 * jg + 1] * inv),
                                        pack2(oacc[mt][4 * jg + 2] * inv, oacc[mt][4 * jg + 3] * inv));
    }
}

__device__ __forceinline__ void merge_item(const Params& p, int item, char* smem) {
  const int tid = ltid(), lane = tid & 63, wid = tid >> 6, t0 = item * 32;
  bf16_t* mix = (bf16_t*)(p.ws + OFF_H);
  const bf16_t* attn = (const bf16_t*)(p.ws + OFF_ATTN);
  for (int tt = 0; tt < 8; ++tt) {
    const int token = t0 + wid * 8 + tt;
    float x[8];
    unpack8(*(const uint4*)(attn + (size_t)token * 512 + lane * 8), x);
    float ss = 0.f;
#pragma unroll
    for (int i = 0; i < 8; ++i) ss += x[i] * x[i];
    ss = wave_sum(ss);
    const float r = rsqrtf(ss * (1.f / 512.f) + 1e-6f);
    const float4 g0 = *(const float4*)(p.g_out_att + lane * 8), g1 = *(const float4*)(p.g_out_att + lane * 8 + 4);
    *(uint4*)(mix + (size_t)token * D + lane * 8) =
        make_uint4(pack2(x[0] * r * g0.x, x[1] * r * g0.y), pack2(x[2] * r * g0.z, x[3] * r * g0.w),
                   pack2(x[4] * r * g1.x, x[5] * r * g1.y), pack2(x[6] * r * g1.z, x[7] * r * g1.w));
  }
  bf16_t* sT = (bf16_t*)smem;
  const bf16_t* y2T = (const bf16_t*)(p.ws + OFF_Y2T);
  __syncthreads();
  for (int ch = tid; ch < 2048; ch += 256) {
    const int c = ch >> 2, q4 = ch & 3;
    const uint4 v = *(const uint4*)(y2T + (size_t)c * NTOK + t0 + q4 * 8);
    bf16_t* d = sT + (q4 * 8) * 520 + c;
    d[0 * 520] = (bf16_t)(v.x & 0xffff); d[1 * 520] = (bf16_t)(v.x >> 16);
    d[2 * 520] = (bf16_t)(v.y & 0xffff); d[3 * 520] = (bf16_t)(v.y >> 16);
    d[4 * 520] = (bf16_t)(v.z & 0xffff); d[5 * 520] = (bf16_t)(v.z >> 16);
    d[6 * 520] = (bf16_t)(v.w & 0xffff); d[7 * 520] = (bf16_t)(v.w >> 16);
  }
  __syncthreads();
  {
    const int tt = tid >> 3, part = tid & 7;
    uint4 v[8];
    float ss = 0.f;
#pragma unroll
    for (int i = 0; i < 8; ++i) {
      v[i] = *(const uint4*)(sT + tt * 520 + part * 64 + 8 * i);
      float x[8];
      unpack8(v[i], x);
#pragma unroll
      for (int e = 0; e < 8; ++e) ss += x[e] * x[e];
    }
    ss += __shfl_xor(ss, 1); ss += __shfl_xor(ss, 2); ss += __shfl_xor(ss, 4);
    const float r = rsqrtf(ss * (1.f / 512.f) + 1e-6f);
#pragma unroll
    for (int i = 0; i < 8; ++i) {
      float x[8];
      unpack8(v[i], x);
      const int c0 = part * 64 + 8 * i;
      const float4 g0 = *(const float4*)(p.g_out_hy + c0), g1 = *(const float4*)(p.g_out_hy + c0 + 4);
      *(uint4*)(mix + (size_t)(t0 + tt) * D + 512 + c0) =
          make_uint4(pack2(x[0] * r * g0.x, x[1] * r * g0.y), pack2(x[2] * r * g0.z, x[3] * r * g0.w),
                     pack2(x[4] * r * g1.x, x[5] * r * g1.y), pack2(x[6] * r * g1.z, x[7] * r * g1.w));
    }
  }
}

__device__ __forceinline__ void actfix_item(const Params& p, int item) {
  const int idx = item * 256 + ltid();
  if (idx >= 512 * 352) return;
  const int j = (idx % 352) * 8, rowi = idx / 352, wt = rowi >> 1, which = rowi & 1;
  const int t = 64 * wt + 63 * which, L = t < NCTX ? SEQC : SEQL, pos = t & (L - 1);
  const bf16_t* edge = (const bf16_t*)(p.ws + OFF_EDGE);
  bf16_t* act = (bf16_t*)(p.ws + OFF_U);
  const bf16_t *pr, *cu, *nx;
  bool zp = false, zn = false;
  if (which == 0) { zp = pos == 0; pr = edge + (size_t)((zp ? wt : wt - 1) * 4 + 3) * 5632; cu = edge + (size_t)(wt * 4 + 0) * 5632; nx = edge + (size_t)(wt * 4 + 1) * 5632; }
  else { zn = pos == L - 1; pr = edge + (size_t)(wt * 4 + 2) * 5632; cu = edge + (size_t)(wt * 4 + 3) * 5632; nx = edge + (size_t)((zn ? wt : wt + 1) * 4 + 0) * 5632; }
  float pa[8], pg[8], ca[8], cgv[8], na[8], ng[8];
  unpack8(*(const uint4*)(pr + j), pa); unpack8(*(const uint4*)(pr + 2816 + j), pg);
  unpack8(*(const uint4*)(cu + j), ca); unpack8(*(const uint4*)(cu + 2816 + j), cgv);
  unpack8(*(const uint4*)(nx + j), na); unpack8(*(const uint4*)(nx + 2816 + j), ng);
  float o[8];
#pragma unroll
  for (int e = 0; e < 8; ++e) {
    const float pae = zp ? 0.f : pa[e], pge = zp ? 0.f : pg[e], nae = zn ? 0.f : na[e], nge = zn ? 0.f : ng[e];
    const float a = p.ffn_conv_w[j + e] * pae + p.ffn_conv_w[5632 + j + e] * ca[e] + p.ffn_conv_w[11264 + j + e] * nae + p.ffn_conv_b[j + e];
    const float g = p.ffn_conv_w[2816 + j + e] * pge + p.ffn_conv_w[5632 + 2816 + j + e] * cgv[e] + p.ffn_conv_w[11264 + 2816 + j + e] * nge + p.ffn_conv_b[2816 + j + e];
    o[e] = a / (1.f + __expf(-a)) * g;
  }
  *(uint4*)(act + (size_t)t * 2816 + j) = make_uint4(pack2(o[0], o[1]), pack2(o[2], o[3]), pack2(o[4], o[5]), pack2(o[6], o[7]));
}

#define XB_TMO      128
#define XB_XCNT(j)  (256  + 64 * (j))
#define XB_XSUB(j)  (1280 + 64 * (j))
#define XB_XGEN(j)  (2304 + 64 * (j))
#define XB_TOP      3328
#define XB_TOPGEN   3392
#define XCD_BAR_WORDS 3456
#define XB_SPIN_CAP (1u << 20)
#define LAS __attribute__((address_space(3)))
__device__ __forceinline__ unsigned xb_ld(unsigned* p) { return __hip_atomic_load(p, __ATOMIC_RELAXED, __HIP_MEMORY_SCOPE_AGENT); }
__device__ __forceinline__ unsigned xb_add(unsigned* p, unsigned v) { return __hip_atomic_fetch_add(p, v, __ATOMIC_RELAXED, __HIP_MEMORY_SCOPE_AGENT); }
__device__ __forceinline__ unsigned xb_xcc_id() { return (unsigned)__builtin_amdgcn_s_getreg((3 << 11) | 20) & 0xFu; }
#define XB_SPIN(cond, bar) do { unsigned _sp = 0; while (cond) { __builtin_amdgcn_s_sleep(1); \
    if ((++_sp & 255u) == 0u) { if (xb_ld(&(bar)[XB_TMO])) break; if (_sp > XB_SPIN_CAP) { atomicAdd(&(bar)[XB_TMO], 1u); break; } } } } while (0)
struct XcdBarrier { unsigned* bar; unsigned x; volatile LAS unsigned* st; };
__device__ __forceinline__ XcdBarrier xcd_barrier_post(unsigned* bar, volatile LAS unsigned* st) {
  XcdBarrier b; b.bar = bar; b.x = xb_xcc_id(); b.st = st;
  if (threadIdx.x == 0) (void)xb_add(&bar[XB_XCNT(b.x)], 1u);
  return b;
}
__device__ __forceinline__ void xcd_barrier_complete(unsigned* bar, unsigned x, unsigned& nloc, unsigned& nx) {
  const unsigned G = gridDim.x * gridDim.y * gridDim.z;
  unsigned sum, cnt, mine, sp = 0u;
  for (;;) {
    sum = 0u; cnt = 0u; mine = 0u;
#pragma unroll
    for (unsigned j = 0; j < 16; ++j) { const unsigned c = xb_ld(&bar[XB_XCNT(j)]); sum += c; cnt += (c > 0u) ? 1u : 0u; mine = (j == x) ? c : mine; }
    if (sum == G) break;
    __builtin_amdgcn_s_sleep(1);
    if ((++sp & 255u) == 0u) { if (xb_ld(&bar[XB_TMO])) break; if (sp > XB_SPIN_CAP) { atomicAdd(&bar[XB_TMO], 1u); break; } }
  }
  nloc = mine > 0u ? mine : 1u; nx = cnt > 0u ? cnt : 1u;
}
__device__ __forceinline__ void xcd_barrier(const XcdBarrier& b) {
  asm volatile("s_waitcnt vmcnt(0)" ::: "memory");
  __syncthreads();
  if (threadIdx.x == 0) {
    unsigned* bar = b.bar;
    __builtin_amdgcn_s_waitcnt(0);
    unsigned nloc = b.st[0], nx = b.st[1];
    if (nloc == 0u) { xcd_barrier_complete(bar, b.x, nloc, nx); b.st[0] = nloc; b.st[1] = nx; }
    const unsigned old = xb_add(&bar[XB_XSUB(b.x)], 1u);
    const unsigned gen = old / nloc;
    if (old + 1u == (gen + 1u) * nloc) {
      __builtin_amdgcn_fence(__ATOMIC_RELEASE, "agent");
      asm volatile("s_waitcnt vmcnt(0)" ::: "memory");
      const unsigned og = xb_add(&bar[XB_TOP], 1u);
      const unsigned tg = og / nx;
      if (og + 1u == (tg + 1u) * nx) xb_add(&bar[XB_TOPGEN], 1u);
      else XB_SPIN(xb_ld(&bar[XB_TOPGEN]) == tg, bar);
      __builtin_amdgcn_fence(__ATOMIC_ACQUIRE, "agent");
      xb_add(&bar[XB_XGEN(b.x)], 1u);
      asm volatile("s_waitcnt vmcnt(0)" ::: "memory");
    } else {
      XB_SPIN(xb_ld(&bar[XB_XGEN(b.x)]) == gen, bar);
      __builtin_amdgcn_fence(__ATOMIC_ACQUIRE, "agent");
      asm volatile("s_waitcnt vmcnt(0)" ::: "memory");
    }
  }
  __syncthreads();
}
constexpr size_t OFF_BAR = 25 * MiB - 16384;
static_assert(OFF_MOD + 3 * 6144 * 4 <= OFF_BAR, "bar");

template <int ph>
__device__ __forceinline__ void run_phase(const Params& p, char* smem) {
  const int bid = blockIdx.x, G = gridDim.x;
  char* ws = p.ws;
  if constexpr (ph == 0) {
    for (int it = bid; it < 272 + 96 + 32 + 3080; it += G) {
      if (it < 272) filter_item(p, it, smem);
      else if (it < 368) mod_item(p, it - 272, smem);
      else if (it < 400) cache_item(p, it - 368);
      else {
        int t = it - 400;
        if (t < 576) transpose_item(p.w_in, 1024, DIN, (bf16_t*)(ws + OFF_WIN), t, 36, smem);
        else if ((t -= 576) < 72) transpose_item(p.w_uq, 384, 768, (bf16_t*)(ws + OFF_WUQ), t, 12, smem);
        else if ((t -= 72) < 64) transpose_item(p.w_ukv, 256, 1024, (bf16_t*)(ws + OFF_WUKV), t, 16, smem);
        else if ((t -= 64) < 256) transpose_item(p.w_out, 1024, 1024, (bf16_t*)(ws + OFF_WOUT), t, 16, smem);
        else if ((t -= 256) < 1408) transpose_item(p.w_up, 1024, 5632, (bf16_t*)(ws + OFF_WUP), t, 88, smem, true);
        else { t -= 1408; transpose_item(p.w_down, 2816, 1024, (bf16_t*)(ws + OFF_WDOWN), t, 16, smem); }
      }
    }
  } else if constexpr (ph == 1) {
    rmsmod_phase<0>(p);
  } else if constexpr (ph == 2) {
    EpiIn epi{(float*)(ws + OFF_PROJ), (bf16_t*)(ws + OFF_HYT)};
    for (int t = bid; t < 128 * 18; t += G)
      gemm_tile<false>((const bf16_t*)(ws + OFF_H), 1024, (const bf16_t*)(ws + OFF_WIN), 1024, 1024, (t / 18) * 128, (t % 18) * 128, smem, epi);
  } else if constexpr (ph == 3) {
    for (int it = bid; it < 512; it += G) hyena_item<0>(p, 1, it, smem);
    for (int it = bid; it < 512; it += G) hyena_item<0>(p, 0, it, smem);
    for (int it = bid; it < 256; it += G) token_item(p, it);
  } else if constexpr (ph == 4) {
    EpiQ eq{(bf16_t*)(ws + OFF_QRAW)};
    EpiKV ekv{(bf16_t*)(ws + OFF_KRAW), (bf16_t*)(ws + OFF_VTC), (bf16_t*)(ws + OFF_VTL)};
    for (int it = bid; it < 512; it += G) hyena_item<1>(p, 1, it, smem);
    for (int t = bid; t < 768; t += G) gemm_tile<true>((const bf16_t*)(ws + OFF_QA), 384, (const bf16_t*)(ws + OFF_WUQ), 384, 384, (t / 6) * 128, (t % 6) * 128, smem, eq);
    for (int t = bid; t < 1088; t += G) gemm_tile<false>((const bf16_t*)(ws + OFF_CKVN), 256, (const bf16_t*)(ws + OFF_WUKV), 256, 256, (t / 8) * 128, (t % 8) * 128, smem, ekv);
    for (int it = bid; it < 512; it += G) hyena_item<1>(p, 0, it, smem);
  } else if constexpr (ph == 5) {
    for (int it = bid; it < 512 + 544; it += G) qk_item(p, it);
  } else if constexpr (ph == 6) {
    for (int it = bid; it < 1024; it += G) attn_item(p, it, smem);
  } else if constexpr (ph == 7) {
    for (int it = bid; it < 512; it += G) merge_item(p, it, smem);
  } else if constexpr (ph == 8) {
    EpiOut epi{&p};
    for (int t = bid; t < 128 * 8; t += G)
      gemm_tile<true>((const bf16_t*)(ws + OFF_H), 1024, (const bf16_t*)(ws + OFF_WOUT), 1024, 1024, (t / 8) * 128, (t % 8) * 128, smem, epi);
  } else if constexpr (ph == 9) {
    rmsmod_phase<1>(p);
  } else if constexpr (ph == 10) {
    for (int t = bid; t < 128 * 44; t += G) gemm_up_act_tile(p, (t / 44) * 128, (t % 44) * 128, smem);
  } else if constexpr (ph == 11) {
    for (int it = bid; it < 704; it += G) actfix_item(p, it);
  } else if constexpr (ph == 12) {
    EpiY epi{&p, 0};
    for (int t = bid; t < 128 * 8; t += G)
      gemm_tile<true>((const bf16_t*)(ws + OFF_U), 2816, (const bf16_t*)(ws + OFF_WDOWN), 2816, 2816, (t / 8) * 128, (t % 8) * 128, smem, epi);
  }
}

#if ONE_LAUNCH
template <int PH>
__device__ __forceinline__ void run_all(const Params& p, char* smem, cg::grid_group& grid, const XcdBarrier& xb) {
  run_phase<PH>(p, smem);
  if constexpr (((DBL_MASK >> PH) & 1) != 0) { xcd_barrier(xb); run_phase<PH>(p, smem); }
  if constexpr (PH < 12) {
    xcd_barrier(xb);
    run_all<PH + 1>(p, smem, grid, xb);
  }
}
__global__ void __launch_bounds__(256, 2) mega_kernel(Params p) {
  __shared__ __attribute__((aligned(16))) char smem[SMEM_BYTES];
  __shared__ uint4 xb_words;
  cg::grid_group grid = cg::this_grid();
  if (threadIdx.x == 0) xb_words = make_uint4(0u, 0u, 0u, 0u);
  __syncthreads();
  XcdBarrier xb = xcd_barrier_post((unsigned*)(p.ws + OFF_BAR), (volatile LAS unsigned*)&xb_words);
  if (p.ws == nullptr) grid.sync();
  run_all<0>(p, smem, grid, xb);
}
#else
template <int PH>
__global__ void __launch_bounds__(256, 2) phase_kernel(Params p) {
  __shared__ __attribute__((aligned(16))) char smem[SMEM_BYTES];
  run_phase<PH>(p, smem);
}
#ifndef DBG_STOP
#define DBG_STOP 15
#endif
__global__ void dump_kernel(Params p, size_t off, int count) {
  const bf16_t* src = (const bf16_t*)(p.ws + off);
  const bf16_t* src2 = (const bf16_t*)(p.ws + DBG_OFF2);
  for (int i = blockIdx.x * 256 + threadIdx.x; i < 16777216; i += gridDim.x * 256)
    p.out[i] = i < DBG_CNT ? bf2f(src[i]) : (i - DBG_CNT < DBG_CNT2 ? bf2f(src2[i - DBG_CNT]) : 0.f);
}
template <int PH>
static void launch_all(const Params& p, hipStream_t stream) {
  phase_kernel<PH><<<512, 256, 0, stream>>>(p);
  if constexpr (PH < 12) launch_all<PH + 1>(p, stream);
}
#endif

extern "C" void kernel_launch(void* const* d_in, const int* in_sizes, int n_in, void* d_out, int out_size, void* d_ws,
                              size_t ws_size, hipStream_t stream) {
  Params p{};
  const float** pp = (const float**)&p;
  for (int i = 0; i < 34; ++i) pp[i] = (const float*)d_in[i];
  p.out = (float*)d_out;
  p.ws = (char*)d_ws;
#if ONE_LAUNCH
  (void)hipMemsetAsync((char*)d_ws + OFF_BAR, 0, XCD_BAR_WORDS * 4, stream);
  static int grid_blocks = 0;
  if (!grid_blocks) {
    int dev = 0, cus = 0, per_cu = 0;
    hipGetDevice(&dev);
    hipDeviceGetAttribute(&cus, hipDeviceAttributeMultiprocessorCount, dev);
    hipOccupancyMaxActiveBlocksPerMultiprocessor(&per_cu, mega_kernel, 256, 0);
    grid_blocks = cus * per_cu;
  }
  void* args[] = {&p};
  hipError_t e = hipLaunchCooperativeKernel((void*)mega_kernel, dim3(grid_blocks), dim3(256), args, 0, stream);
  if (e != hipSuccess) fprintf(stderr, "cooperative launch failed: %s (grid %d)\n", hipGetErrorString(e), grid_blocks);
#else
  launch_all<0>(p, stream);
#if DBG_STOP < 15
  dump_kernel<<<1024, 256, 0, stream>>>(p, DBG_OFF, DBG_CNT);
#endif
#endif
}
```

```cpp
#include <hip/hip_runtime.h>
#include <hip/hip_cooperative_groups.h>
#include <cstdio>
namespace cg = cooperative_groups;

#define DBG_STOP 15
#define DBG_NOHY 0
#ifndef DBL_MASK
#define DBL_MASK 0
#endif
#define DBG_OFF OFF_QRAW
#define DBG_OFF2 OFF_KRAW
#define DBG_CNT 12582912
#define DBG_CNT2 0
#ifndef ONE_LAUNCH
#define ONE_LAUNCH 1
#endif

typedef unsigned short bf16_t;
typedef short bf16x8 __attribute__((ext_vector_type(8)));
typedef float f32x4 __attribute__((ext_vector_type(4)));
typedef float f32x16 __attribute__((ext_vector_type(16)));

constexpr int D = 1024, NTOK = 16384, NCTX = 8192, SEQC = 256, SEQL = 4096;
constexpr int DIN = 2208, DINP = 2304, QL = 384, KVL = 256, DFF = 2816;
constexpr int NROWKV = 17408;
constexpr size_t MiB = 1048576;

constexpr size_t OFF_WIN = 0;
constexpr size_t OFF_WUQ = OFF_WIN + (size_t)DINP * 1024 * 2;
constexpr size_t OFF_WUKV = OFF_WUQ + (size_t)768 * 384 * 2;
constexpr size_t OFF_WOUT = OFF_WUKV + (size_t)1024 * 256 * 2;
constexpr size_t OFF_WUP = OFF_WOUT + (size_t)1024 * 1024 * 2;
constexpr size_t OFF_WDOWN = OFF_WUP + (size_t)5632 * 1024 * 2;
constexpr size_t OFF_MOD = OFF_WDOWN + (size_t)1024 * 2816 * 2;
static_assert(OFF_MOD + 3 * 6144 * 4 <= 25 * MiB, "A region");
constexpr size_t OFF_RLAT = 25 * MiB;
constexpr size_t OFF_RCTX = 41 * MiB;
constexpr size_t OFF_H = 42 * MiB;
constexpr size_t OFF_ZT = 42 * MiB;
constexpr size_t OFF_QA = 58 * MiB;
constexpr size_t OFF_KPE = 70 * MiB;
constexpr size_t OFF_PROJ = 74 * MiB;
constexpr size_t OFF_QRAW = 74 * MiB;
constexpr size_t OFF_Y2T = 98 * MiB;
constexpr size_t OFF_ATTN = 74 * MiB;
constexpr size_t OFF_U = 74 * MiB;
constexpr size_t OFF_HYT = 116 * MiB;
constexpr size_t OFF_Q = 116 * MiB;
constexpr size_t OFF_KC = 140 * MiB;
constexpr size_t OFF_KL = 152 * MiB;
constexpr size_t OFF_CKVN = 164 * MiB;
constexpr size_t OFF_KRAW = 173 * MiB;
constexpr size_t OFF_VTC = 190 * MiB;
constexpr size_t OFF_VTL = 198 * MiB;
constexpr size_t OFF_ACT = 162 * MiB;

constexpr int OUT_YS = 0;
constexpr int OUT_CKV = 16777216;
constexpr int OUT_KPE = 16777216 + 2097152;

constexpr int SMEM_BYTES = 51200;

struct Params {
  const float *x_prompt, *x_sample, *cache_ckv, *cache_kpe, *c, *c_ctx, *w_ada, *b_ada, *g_mix, *w_in, *g_qa, *w_uq,
      *g_kva, *w_ukv, *g_q, *g_k, *hy_conv_w, *hy_conv_b, *filt_w1, *filt_b1, *filt_freq1, *filt_w2, *filt_b2,
      *filt_freq2, *filt_w3, *filt_bias, *g_out_att, *g_out_hy, *w_out, *g_ffn, *w_up, *ffn_conv_w, *ffn_conv_b, *w_down;
  float* out;
  char* ws;
};

typedef __bf16 bf16x2_t __attribute__((ext_vector_type(2)));
__device__ __forceinline__ unsigned pack2(float lo, float hi) {
  bf16x2_t v;
  v[0] = (__bf16)lo;
  v[1] = (__bf16)hi;
  return __builtin_bit_cast(unsigned, v);
}
__device__ __forceinline__ float bflo(unsigned u) { return __uint_as_float(u << 16); }
__device__ __forceinline__ float bfhi(unsigned u) { return __uint_as_float(u & 0xffff0000u); }
__device__ __forceinline__ float bf2f(bf16_t h) { return __uint_as_float(((unsigned)h) << 16); }
__device__ __forceinline__ bf16_t f2bf(float f) { return (bf16_t)(pack2(f, 0.f) & 0xffffu); }
__device__ __forceinline__ float wave_sum(float v) {
#pragma unroll
  for (int o = 32; o >= 1; o >>= 1) v += __shfl_xor(v, o);
  return v;
}
__device__ __forceinline__ int ltid() { int t = threadIdx.x; asm volatile("" : "+v"(t)); return t; }
__device__ __forceinline__ float sin_turns(float t) { t -= floorf(t); return __builtin_amdgcn_sinf(t); }
__device__ __forceinline__ float cos_turns(float t) { t -= floorf(t); return __builtin_amdgcn_cosf(t); }
__device__ __forceinline__ float sin_rad(float x) { return sin_turns(x * 0.15915494309189535f); }
__device__ __forceinline__ const float* xrow(const Params& p, int row) {
  return row < NCTX ? p.x_prompt + (size_t)row * D : p.x_sample + (size_t)(row - NCTX) * D;
}
__device__ __forceinline__ int modidx(int row) { return row < NCTX ? 0 : 1 + ((row - NCTX) >> 12); }

template <bool SWAP>
__device__ __forceinline__ void gemm_main(const bf16_t* __restrict__ A, int lda, const bf16_t* __restrict__ Bt, int ldb,
                                          int K, int m0, int n0, char* smem, f32x4 (&acc)[4][4]) {
  const int tid = ltid(), lane = tid & 63, wid = tid >> 6, wr = wid >> 1, wc = wid & 1;
  const int fr = lane & 15, fq = lane >> 4;
  bf16_t* sbase = (bf16_t*)smem;
#pragma unroll
  for (int m = 0; m < 4; ++m)
#pragma unroll
    for (int n = 0; n < 4; ++n) acc[m][n] = (f32x4){0.f, 0.f, 0.f, 0.f};
  const int lr = tid >> 3, lc = (tid & 7) * 8;
  const bf16_t* ga = A + (size_t)(m0 + lr) * lda + lc;
  const bf16_t* gb = Bt + (size_t)(n0 + lr) * ldb + lc;
  const size_t sa32 = (size_t)32 * lda, sb32 = (size_t)32 * ldb;
  uint4 ra0 = *(const uint4*)(ga), ra1 = *(const uint4*)(ga + sa32), ra2 = *(const uint4*)(ga + 2 * sa32), ra3 = *(const uint4*)(ga + 3 * sa32);
  uint4 rb0 = *(const uint4*)(gb), rb1 = *(const uint4*)(gb + sb32), rb2 = *(const uint4*)(gb + 2 * sb32), rb3 = *(const uint4*)(gb + 3 * sb32);
  const int nk = K >> 6;
  const int woff = lr * 64 + (((tid & 7) ^ (lr & 7)) * 8);
  const int aoff = (wr * 64 + fr) * 64, boff = 8192 + (wc * 64 + fr) * 64;
  __syncthreads();
  {
    bf16_t* wa = sbase + woff;
    *(uint4*)(wa) = ra0; *(uint4*)(wa + 32 * 64) = ra1; *(uint4*)(wa + 64 * 64) = ra2; *(uint4*)(wa + 96 * 64) = ra3;
    *(uint4*)(wa + 8192) = rb0; *(uint4*)(wa + 8192 + 32 * 64) = rb1; *(uint4*)(wa + 8192 + 64 * 64) = rb2; *(uint4*)(wa + 8192 + 96 * 64) = rb3;
  }
  if (nk > 1) {
    ga += 64; gb += 64;
    ra0 = *(const uint4*)(ga); ra1 = *(const uint4*)(ga + sa32); ra2 = *(const uint4*)(ga + 2 * sa32); ra3 = *(const uint4*)(ga + 3 * sa32);
    rb0 = *(const uint4*)(gb); rb1 = *(const uint4*)(gb + sb32); rb2 = *(const uint4*)(gb + 2 * sb32); rb3 = *(const uint4*)(gb + 3 * sb32);
  }
  __syncthreads();
  for (int kt = 0; kt < nk; ++kt) {
    const bf16_t* cur = sbase + (kt & 1) * 16384;
    if (kt + 1 < nk) {
      bf16_t* wa = sbase + ((kt + 1) & 1) * 16384 + woff;
      *(uint4*)(wa) = ra0; *(uint4*)(wa + 32 * 64) = ra1; *(uint4*)(wa + 64 * 64) = ra2; *(uint4*)(wa + 96 * 64) = ra3;
      *(uint4*)(wa + 8192) = rb0; *(uint4*)(wa + 8192 + 32 * 64) = rb1; *(uint4*)(wa + 8192 + 64 * 64) = rb2; *(uint4*)(wa + 8192 + 96 * 64) = rb3;
      if (kt + 2 < nk) {
        ga += 64; gb += 64;
        ra0 = *(const uint4*)(ga); ra1 = *(const uint4*)(ga + sa32); ra2 = *(const uint4*)(ga + 2 * sa32); ra3 = *(const uint4*)(ga + 3 * sa32);
        rb0 = *(const uint4*)(gb); rb1 = *(const uint4*)(gb + sb32); rb2 = *(const uint4*)(gb + 2 * sb32); rb3 = *(const uint4*)(gb + 3 * sb32);
      }
    }
    __builtin_amdgcn_sched_barrier(0);
#pragma unroll
    for (int ks = 0; ks < 2; ++ks) {
      bf16x8 af[4], bfr[4];
#pragma unroll
      for (int m = 0; m < 4; ++m) af[m] = *(const bf16x8*)(cur + aoff + m * 16 * 64 + (((ks * 4 + fq) ^ (fr & 7)) * 8));
#pragma unroll
      for (int n = 0; n < 4; ++n) bfr[n] = *(const bf16x8*)(cur + boff + n * 16 * 64 + (((ks * 4 + fq) ^ (fr & 7)) * 8));
      __builtin_amdgcn_s_setprio(1);
#pragma unroll
      for (int m = 0; m < 4; ++m)
#pragma unroll
        for (int n = 0; n < 4; ++n) {
          if (SWAP) acc[m][n] = __builtin_amdgcn_mfma_f32_16x16x32_bf16(bfr[n], af[m], acc[m][n], 0, 0, 0);
          else acc[m][n] = __builtin_amdgcn_mfma_f32_16x16x32_bf16(af[m], bfr[n], acc[m][n], 0, 0, 0);
        }
      __builtin_amdgcn_s_setprio(0);
    }
    if (kt + 1 < nk) __syncthreads();
  }
}
template <bool SWAP, class Epi>
__device__ __forceinline__ void gemm_tile(const bf16_t* __restrict__ A, int lda, const bf16_t* __restrict__ Bt, int ldb,
                                          int K, int m0, int n0, char* smem, const Epi& epi) {
  f32x4 acc[4][4];
  gemm_main<SWAP>(A, lda, Bt, ldb, K, m0, n0, smem, acc);
  const int tid = ltid(), lane = tid & 63, wid = tid >> 6, wr = wid >> 1, wc = wid & 1;
  const int fr = lane & 15, fq = lane >> 4;
#pragma unroll
  for (int m = 0; m < 4; ++m)
#pragma unroll
    for (int n = 0; n < 4; ++n) {
      if (SWAP) epi(m0 + wr * 64 + m * 16 + fr, n0 + wc * 64 + n * 16 + fq * 4, acc[m][n]);
      else epi(m0 + wr * 64 + m * 16 + fq * 4, n0 + wc * 64 + n * 16 + fr, acc[m][n]);
    }
}

template <int CTRL>
__device__ __forceinline__ float dpp_ror(float v) {
  return __int_as_float(__builtin_amdgcn_update_dpp(0, __float_as_int(v), CTRL, 0xF, 0xF, false));
}
constexpr size_t OFF_EDGE = 162 * MiB;
__device__ __forceinline__ void gemm_up_act_tile(const Params& p, int m0, int n0, char* smem) {
  f32x4 acc[4][4];
  gemm_main<true>((const bf16_t*)(p.ws + OFF_H), 1024, (const bf16_t*)(p.ws + OFF_WUP), 1024, 1024, m0, n0, smem, acc);
  const int tid = ltid(), lane = tid & 63, wid = tid >> 6, wr = wid >> 1, wc = wid & 1;
  const int fr = lane & 15, fq = lane >> 4;
  bf16_t* act = (bf16_t*)(p.ws + OFF_U);
  bf16_t* edge = (bf16_t*)(p.ws + OFF_EDGE);
  const int rowbase = m0 + wr * 64, wt = rowbase >> 6;
#pragma unroll
  for (int i = 0; i < 2; ++i) {
    const int cperm = n0 + wc * 64 + 32 * i;
    const int j0 = (cperm >> 5) * 16 + 4 * fq;
    const float4 wa0 = *(const float4*)(p.ffn_conv_w + j0), wa1 = *(const float4*)(p.ffn_conv_w + 5632 + j0), wa2 = *(const float4*)(p.ffn_conv_w + 11264 + j0);
    const float4 wg0 = *(const float4*)(p.ffn_conv_w + 2816 + j0), wg1 = *(const float4*)(p.ffn_conv_w + 5632 + 2816 + j0), wg2 = *(const float4*)(p.ffn_conv_w + 11264 + 2816 + j0);
    const float4 ba = *(const float4*)(p.ffn_conv_b + j0), bg = *(const float4*)(p.ffn_conv_b + 2816 + j0);
    const float w0a[4] = {wa0.x, wa0.y, wa0.z, wa0.w}, w1a[4] = {wa1.x, wa1.y, wa1.z, wa1.w}, w2a[4] = {wa2.x, wa2.y, wa2.z, wa2.w};
    const float w0g[4] = {wg0.x, wg0.y, wg0.z, wg0.w}, w1g[4] = {wg1.x, wg1.y, wg1.z, wg1.w}, w2g[4] = {wg2.x, wg2.y, wg2.z, wg2.w};
    const float bba[4] = {ba.x, ba.y, ba.z, ba.w}, bbg[4] = {bg.x, bg.y, bg.z, bg.w};
#pragma unroll
    for (int m = 0; m < 4; ++m) {
      float o[4];
#pragma unroll
      for (int e = 0; e < 4; ++e) {
        const float a = acc[m][2 * i][e], g = acc[m][2 * i + 1][e];
        const float au1 = dpp_ror<0x121>(a), gu1 = dpp_ror<0x121>(g), ad1 = dpp_ror<0x12F>(a), gd1 = dpp_ror<0x12F>(g);
        float au2 = 0.f, gu2 = 0.f, ad2 = 0.f, gd2 = 0.f;
        if (m > 0) { au2 = dpp_ror<0x121>(acc[m - 1][2 * i][e]); gu2 = dpp_ror<0x121>(acc[m - 1][2 * i + 1][e]); }
        if (m < 3) { ad2 = dpp_ror<0x12F>(acc[m + 1][2 * i][e]); gd2 = dpp_ror<0x12F>(acc[m + 1][2 * i + 1][e]); }
        const float au = fr > 0 ? au1 : au2, gu = fr > 0 ? gu1 : gu2, ad = fr < 15 ? ad1 : ad2, gd = fr < 15 ? gd1 : gd2;
        const float ca = w0a[e] * au + w1a[e] * a + w2a[e] * ad + bba[e];
        const float cgv = w0g[e] * gu + w1g[e] * g + w2g[e] * gd + bbg[e];
        o[e] = ca / (1.f + __expf(-ca)) * cgv;
      }
      const int lr64 = m * 16 + fr, row = rowbase + lr64;
      if (lr64 >= 1 && lr64 <= 62) *(uint2*)(act + (size_t)row * 2816 + j0) = make_uint2(pack2(o[0], o[1]), pack2(o[2], o[3]));
      if (lr64 <= 1 || lr64 >= 62) {
        const int slot = lr64 <= 1 ? lr64 : lr64 - 60;
        bf16_t* er = edge + (size_t)(wt * 4 + slot) * 5632;
        *(uint2*)(er + j0) = make_uint2(pack2(acc[m][2 * i][0], acc[m][2 * i][1]), pack2(acc[m][2 * i][2], acc[m][2 * i][3]));
        *(uint2*)(er + 2816 + j0) = make_uint2(pack2(acc[m][2 * i + 1][0], acc[m][2 * i + 1][1]), pack2(acc[m][2 * i + 1][2], acc[m][2 * i + 1][3]));
      }
    }
  }
}

__device__ __forceinline__ void transpose_item(const float* __restrict__ W, int K, int N, bf16_t* __restrict__ WT, int tile, int ntn, char* smem, bool perm = false) {
  float* s = (float*)smem;
  const int tk = tile / ntn, tn = tile % ntn, tid = ltid();
  const int k0 = tk * 64, n0 = tn * 64;
  __syncthreads();
  {
    const int r = tid >> 4, c4 = (tid & 15) * 4;
#pragma unroll
    for (int i = 0; i < 4; ++i) {
      const int k = r + 16 * i;
      float4 v = make_float4(0.f, 0.f, 0.f, 0.f);
      if (n0 + c4 < N) v = *(const float4*)(W + (size_t)(k0 + k) * N + n0 + c4);
      s[k * 65 + c4 + 0] = v.x; s[k * 65 + c4 + 1] = v.y; s[k * 65 + c4 + 2] = v.z; s[k * 65 + c4 + 3] = v.w;
    }
  }
  __syncthreads();
  {
    const int n = tid >> 2, kc = (tid & 3) * 16;
    unsigned o[8];
#pragma unroll
    for (int i = 0; i < 8; ++i) o[i] = pack2(s[(kc + 2 * i) * 65 + n], s[(kc + 2 * i + 1) * 65 + n]);
    int nr = n0 + n;
    if (perm) { const int hf = nr >= 2816 ? 1 : 0, cc = nr - hf * 2816; nr = 32 * (cc >> 4) + 16 * hf + (cc & 15); }
    uint4* dst = (uint4*)(WT + (size_t)nr * K + k0 + kc);
    dst[0] = make_uint4(o[0], o[1], o[2], o[3]);
    dst[1] = make_uint4(o[4], o[5], o[6], o[7]);
  }
}

__device__ __forceinline__ void mod_item(const Params& p, int item, char* smem) {
  float* s = (float*)smem;
  float* red = s + 3072;
  const int tid = ltid();
  __syncthreads();
  for (int e = tid; e < 3072; e += 256) {
    const int v = e >> 10, k = e & 1023;
    const float x = (v == 0) ? p.c_ctx[k] : p.c[(v - 1) * D + k];
    s[e] = x / (1.f + __expf(-x));
  }
  __syncthreads();
  const int jl = tid & 63, kq = tid >> 6, j = item * 64 + jl, k0 = kq * 256;
  float a0 = 0.f, a1 = 0.f, a2 = 0.f;
#pragma unroll 8
  for (int k = 0; k < 256; ++k) {
    const float w = p.w_ada[(size_t)(k0 + k) * 6144 + j];
    a0 += s[k0 + k] * w; a1 += s[1024 + k0 + k] * w; a2 += s[2048 + k0 + k] * w;
  }
  red[(kq * 3 + 0) * 64 + jl] = a0; red[(kq * 3 + 1) * 64 + jl] = a1; red[(kq * 3 + 2) * 64 + jl] = a2;
  __syncthreads();
  if (tid < 192) {
    const int v = tid >> 6;
    const float r = red[(0 * 3 + v) * 64 + jl] + red[(1 * 3 + v) * 64 + jl] + red[(2 * 3 + v) * 64 + jl] + red[(3 * 3 + v) * 64 + jl];
    ((float*)(p.ws + OFF_MOD))[v * 6144 + j] = r + p.b_ada[j];
  }
}

__device__ __forceinline__ void filter_item(const Params& p, int item, char* smem) {
  int n, p0; bf16_t* R;
  if (item < 256) { n = 4096; p0 = item * 16; R = (bf16_t*)(p.ws + OFF_RLAT); }
  else { n = 256; p0 = (item - 256) * 16; R = (bf16_t*)(p.ws + OFF_RCTX); }
  const int n2 = 2 * n, tid = ltid();
  float* z = (float*)smem;
  float* h1 = z + 16 * 36;
  float* h2 = h1 + 16 * 64;
  __syncthreads();
#pragma unroll 1
  for (int e = tid; e < 16 * 33; e += 256) {
    const int pp = e / 33, f = e % 33, pos = p0 + pp;
    float val;
    if (f == 0) val = (float)pos / (float)(n - 1);
    else {
      const int k = (f - 1) & 15;
      const float band = 1e-4f + (float)k * ((15.f - 1e-4f) / 15.f);
      const float turns = band * ((float)pos / (float)n);
      val = (f <= 16) ? cos_turns(turns) : -sin_turns(turns);
    }
    z[pp * 36 + f] = val;
  }
  __syncthreads();
#pragma unroll 1
  for (int e = tid; e < 1024; e += 256) {
    const int pp = e >> 6, j = e & 63;
    float a = p.filt_b1[j];
#pragma unroll 3
    for (int f = 0; f < 33; ++f) a += z[pp * 36 + f] * p.filt_w1[f * 64 + j];
    h1[e] = sin_rad(p.filt_freq1[j] * a);
  }
  __syncthreads();
#pragma unroll 1
  for (int e = tid; e < 1024; e += 256) {
    const int pp = e >> 6, j = e & 63;
    float a = p.filt_b2[j];
#pragma unroll 4
    for (int k = 0; k < 64; ++k) a += h1[pp * 64 + k] * p.filt_w2[k * 64 + j];
    h2[j * 16 + pp] = sin_rad(p.filt_freq2[j] * a);
  }
  __syncthreads();
  const float mind = -3.0701134573253946f, maxd = -15.350567286626973f;
#pragma unroll 1
  for (int ci = 0; ci < 8; ++ci) {
    const int col = tid + 256 * ci, o = col >> 10, dir = (col >> 9) & 1, c = col & 511;
    float acc[16];
#pragma unroll
    for (int i = 0; i < 16; ++i) acc[i] = 0.f;
#pragma unroll 4
    for (int k = 0; k < 64; ++k) {
      const float w = p.filt_w3[k * 2048 + col];
      const float4 ha = *(const float4*)(h2 + k * 16), hb = *(const float4*)(h2 + k * 16 + 4), hc = *(const float4*)(h2 + k * 16 + 8), hd = *(const float4*)(h2 + k * 16 + 12);
      acc[0] += ha.x * w; acc[1] += ha.y * w; acc[2] += ha.z * w; acc[3] += ha.w * w;
      acc[4] += hb.x * w; acc[5] += hb.y * w; acc[6] += hb.z * w; acc[7] += hb.w * w;
      acc[8] += hc.x * w; acc[9] += hc.y * w; acc[10] += hc.z * w; acc[11] += hc.w * w;
      acc[12] += hd.x * w; acc[13] += hd.y * w; acc[14] += hd.z * w; acc[15] += hd.w * w;
    }
    const float delta = fabsf(mind + (float)c * ((maxd - mind) / 511.f));
    bf16_t* Rrow = R + (size_t)(o * 512 + c) * n2;
#pragma unroll
    for (int i = 0; i < 16; ++i) {
      const int pos = p0 + i;
      const float t = (float)pos / (float)(n - 1);
      float val = acc[i] * (__expf(-t * delta) + 0.05f);
      int idx = dir == 0 ? (n - 1 - pos) : (n - 1 + pos);
      if (dir == 1 && pos == 0) { idx = n2 - 1; val = 0.f; }
      Rrow[idx] = f2bf(val);
    }
  }
}

__device__ __forceinline__ void cache_item(const Params& p, int item) {
  const int tid = ltid(), r0 = item * 32;
  bf16_t* ckvn = (bf16_t*)(p.ws + OFF_CKVN);
#pragma unroll 2
  for (int e = tid; e < 32 * 64; e += 256) {
    const int r = r0 + (e >> 6), c4 = (e & 63) * 4;
    const float4 v = *(const float4*)(p.cache_ckv + (size_t)r * 256 + c4);
    *(uint2*)(ckvn + (size_t)(NTOK + r) * 256 + c4) = make_uint2(pack2(v.x, v.y), pack2(v.z, v.w));
  }
}

template <int WHICH>
__device__ __forceinline__ void rmsmod_phase(const Params& p) {
  const int tid = ltid(), lane = tid & 63, wid = tid >> 6;
  const int gw = blockIdx.x * 4 + wid, tw = gridDim.x * 4;
  const float* g = WHICH == 0 ? p.g_mix : p.g_ffn;
  const float* mod = (const float*)(p.ws + OFF_MOD);
  bf16_t* h = (bf16_t*)(p.ws + OFF_H);
  for (int row = gw; row < NTOK; row += tw) {
    const float* src = WHICH == 0 ? xrow(p, row) : p.out + (size_t)row * D;
    float4 v[4];
    float ss = 0.f;
#pragma unroll
    for (int i = 0; i < 4; ++i) {
      v[i] = ((const float4*)src)[lane + 64 * i];
      ss += v[i].x * v[i].x + v[i].y * v[i].y + v[i].z * v[i].z + v[i].w * v[i].w;
    }
    ss = wave_sum(ss);
    const float r = rsqrtf(ss * (1.f / 1024.f) + 1e-6f);
    const float* mv = mod + modidx(row) * 6144 + (WHICH == 0 ? 0 : 3 * 1024);
#pragma unroll
    for (int i = 0; i < 4; ++i) {
      const int e = 4 * (lane + 64 * i);
      const float4 g4 = *(const float4*)(g + e), sh = *(const float4*)(mv + e), sc = *(const float4*)(mv + 1024 + e);
      const float y0 = v[i].x * r * g4.x * (1.f + sc.x) + sh.x, y1 = v[i].y * r * g4.y * (1.f + sc.y) + sh.y;
      const float y2 = v[i].z * r * g4.z * (1.f + sc.z) + sh.z, y3 = v[i].w * r * g4.w * (1.f + sc.w) + sh.w;
      *(uint2*)(h + (size_t)row * D + e) = make_uint2(pack2(y0, y1), pack2(y2, y3));
    }
  }
}

struct EpiIn {
  float* proj; bf16_t* hyT;
  __device__ __forceinline__ void operator()(int row0, int col, const f32x4& v) const {
    if (col < 672) {
#pragma unroll
      for (int j = 0; j < 4; ++j) proj[(size_t)(row0 + j) * 672 + col] = v[j];
    } else if (col < DIN) {
      *(uint2*)(hyT + (size_t)(col - 672) * NTOK + row0) = make_uint2(pack2(v[0], v[1]), pack2(v[2], v[3]));
    }
  }
};
struct EpiQ {
  bf16_t* q;
  __device__ __forceinline__ void operator()(int row, int col0, const f32x4& v) const {
    *(uint2*)(q + (size_t)row * 768 + col0) = make_uint2(pack2(v[0], v[1]), pack2(v[2], v[3]));
  }
};
struct EpiKV {
  bf16_t *kraw, *vtc, *vtl;
  __device__ __forceinline__ void operator()(int row0, int col, const f32x4& v) const {
    const int head = col >> 7, cc = col & 127;
    if (cc < 64) {
#pragma unroll
      for (int j = 0; j < 4; ++j) kraw[(size_t)(row0 + j) * 512 + head * 64 + cc] = f2bf(v[j]);
    } else {
      const int dv = cc - 64;
      bf16_t* dst;
      if (row0 < NCTX) dst = vtc + ((size_t)((row0 >> 8) * 8 + head) * 64 + dv) * 256 + (row0 & 255);
      else if (row0 < NTOK) { const int r = row0 - NCTX; dst = vtl + ((size_t)((r >> 12) * 8 + head) * 64 + dv) * 4608 + (r & 4095); }
      else { const int r = row0 - NTOK; dst = vtl + ((size_t)((r >> 9) * 8 + head) * 64 + dv) * 4608 + 4096 + (r & 511); }
      *(uint2*)dst = make_uint2(pack2(v[0], v[1]), pack2(v[2], v[3]));
    }
  }
};
struct EpiOut {
  const Params* p;
  __device__ __forceinline__ void operator()(int row, int col0, const f32x4& v) const {
    const float4 x = *(const float4*)(xrow(*p, row) + col0);
    const float4 m = *(const float4*)((const float*)(p->ws + OFF_MOD) + modidx(row) * 6144 + 2 * 1024 + col0);
    *(float4*)(p->out + (size_t)row * D + col0) = make_float4(x.x + m.x * v[0], x.y + m.y * v[1], x.z + m.z * v[2], x.w + m.w * v[3]);
  }
};
struct EpiU {
  bf16_t* u;
  __device__ __forceinline__ void operator()(int row, int col0, const f32x4& v) const {
    *(uint2*)(u + (size_t)row * 5632 + col0) = make_uint2(pack2(v[0], v[1]), pack2(v[2], v[3]));
  }
};
struct EpiY {
  const Params* p; int half;
  __device__ __forceinline__ void operator()(int row, int col0, const f32x4& v) const {
    const int grow = half * 8192 + row;
    float4* dst = (float4*)(p->out + (size_t)grow * D + col0);
    const float4 x = *dst;
    const float4 m = *(const float4*)((const float*)(p->ws + OFF_MOD) + modidx(grow) * 6144 + 5 * 1024 + col0);
    *dst = make_float4(x.x + m.x * v[0], x.y + m.y * v[1], x.z + m.z * v[2], x.w + m.w * v[3]);
  }
};

__device__ __forceinline__ void token_item(const Params& p, int item) {
  const int tid = ltid(), lane = tid & 63, wid = tid >> 6;
  const float* proj = (const float*)(p.ws + OFF_PROJ);
  bf16_t* qa = (bf16_t*)(p.ws + OFF_QA);
  bf16_t* ckvn = (bf16_t*)(p.ws + OFF_CKVN);
  float* kpe = (float*)(p.ws + OFF_KPE);
  for (int tt = 0; tt < 16; ++tt) {
    const int token = item * 64 + wid * 16 + tt;
    const float* pr = proj + (size_t)token * 672;
    float2 q[3];
    float ss = 0.f;
#pragma unroll
    for (int i = 0; i < 3; ++i) { q[i] = *(const float2*)(pr + lane * 2 + 128 * i); ss += q[i].x * q[i].x + q[i].y * q[i].y; }
    ss = wave_sum(ss);
    const float r = rsqrtf(ss * (1.f / 384.f) + 1e-6f);
#pragma unroll
    for (int i = 0; i < 3; ++i) {
      const int e = lane * 2 + 128 * i;
      *(unsigned*)(qa + (size_t)token * 384 + e) = pack2(q[i].x * r * p.g_qa[e], q[i].y * r * p.g_qa[e + 1]);
    }
    const float4 kv = *(const float4*)(pr + 384 + lane * 4);
    float s2 = wave_sum(kv.x * kv.x + kv.y * kv.y + kv.z * kv.z + kv.w * kv.w);
    const float r2 = rsqrtf(s2 * (1.f / 256.f) + 1e-6f);
    const float4 g = *(const float4*)(p.g_kva + lane * 4);
    const float4 y = make_float4(kv.x * r2 * g.x, kv.y * r2 * g.y, kv.z * r2 * g.z, kv.w * r2 * g.w);
    *(uint2*)(ckvn + (size_t)token * 256 + lane * 4) = make_uint2(pack2(y.x, y.y), pack2(y.z, y.w));
    if (token < NCTX) *(float4*)(p.out + OUT_CKV + (size_t)token * 256 + lane * 4) = y;
    if (lane < 32) {
      const float kp = pr[640 + lane];
      kpe[(size_t)token * 32 + lane] = kp;
      if (token < NCTX) p.out[OUT_KPE + (size_t)token * 32 + lane] = kp;
    }
  }
}

template <int ORDER>
__device__ __forceinline__ void hyena_item(const Params& p, int grp, int c, char* smem) {
  const int tid = ltid(), lane = tid & 63, wid = tid >> 6, fr = lane & 15, fq = lane >> 4;
  const int n = grp ? SEQL : SEQC, nb = n >> 6, L = n;
  const bf16_t* Rrow = (const bf16_t*)(p.ws + (grp ? OFF_RLAT : OFF_RCTX)) + (size_t)(ORDER * 512 + c) * (2 * n);
  const bf16_t* hyT = (const bf16_t*)(p.ws + OFF_HYT);
  bf16_t* sU = (bf16_t*)smem;
  unsigned* sR0 = (unsigned*)(smem + 18432);
  unsigned* sR1 = (unsigned*)(smem + 18432 + 16384);
  const int tok0 = grp * 8192;
  __syncthreads();
  for (int ch = tid; ch < (2 * n) / 8; ch += 256) *(uint4*)((bf16_t*)sR0 + ch * 8) = *(const uint4*)(Rrow + ch * 8);
  if (ORDER == 0) {
    const bf16_t* raw = hyT + (size_t)c * NTOK + tok0;
    const float w0 = p.hy_conv_w[c], w1 = p.hy_conv_w[1536 + c], w2 = p.hy_conv_w[3072 + c], b = p.hy_conv_b[c];
    for (int ch = tid; ch < 1024; ch += 256) {
      const int t = ch * 8, pos = t & (L - 1);
      const uint4 rv = *(const uint4*)(raw + t);
      float x[10];
      x[0] = pos == 0 ? 0.f : bf2f(raw[t - 1]);
      x[1] = bflo(rv.x); x[2] = bfhi(rv.x); x[3] = bflo(rv.y); x[4] = bfhi(rv.y);
      x[5] = bflo(rv.z); x[6] = bfhi(rv.z); x[7] = bflo(rv.w); x[8] = bfhi(rv.w);
      x[9] = (pos + 8 == L) ? 0.f : bf2f(raw[t + 8]);
      float u[8];
#pragma unroll
      for (int i = 0; i < 8; ++i) u[i] = w0 * x[i] + w1 * x[i + 1] + w2 * x[i + 2] + b;
      *(uint4*)(sU + (ch >> 3) * 64 + (((ch & 7) ^ ((ch >> 3) & 7)) * 8)) = make_uint4(pack2(u[0], u[1]), pack2(u[2], u[3]), pack2(u[4], u[5]), pack2(u[6], u[7]));
    }
  } else {
    const bf16_t* zr = (const bf16_t*)(p.ws + OFF_ZT) + (size_t)c * NTOK + tok0;
    for (int ch = tid; ch < 1024; ch += 256) *(uint4*)(sU + (ch >> 3) * 64 + (((ch & 7) ^ ((ch >> 3) & 7)) * 8)) = *(const uint4*)(zr + ch * 8);
  }
  __syncthreads();
  for (int k = tid; k < n; k += 256) {
    const unsigned a = sR0[k], b2 = (k + 1 < n) ? sR0[k + 1] : 0u;
    sR1[k] = (a >> 16) | (b2 << 16);
  }
  __syncthreads();

  f32x4 acc[4][2];
#pragma unroll
  for (int m = 0; m < 4; ++m) { acc[m][0] = (f32x4){0.f, 0.f, 0.f, 0.f}; acc[m][1] = (f32x4){0.f, 0.f, 0.f, 0.f}; }
  const unsigned* abase = (fr & 1) ? (sR0 + ((n - 1 - fr) >> 1) + 4 * fq) : (sR1 + ((n - 2 - fr) >> 1) + 4 * fq);
  const int col0 = 32 * wid + fr, col1 = col0 + 16;
  const int i0 = col0 & (nb - 1), i1 = col1 & (nb - 1);
  for (int d = -(nb - 1); d <= nb - 1; ++d) {
    const bool v0 = (unsigned)(i0 - d) < (unsigned)nb, v1 = (unsigned)(i1 - d) < (unsigned)nb;
    const bool any0 = __ballot(v0) != 0ull, any1 = __ballot(v1) != 0ull;
    if (!any0 && !any1) continue;
    bf16x8 F[6];
    const unsigned* ap = abase - 32 * d + 16;
#pragma unroll
    for (int idx = 0; idx < 6; ++idx) {
      const unsigned* q = ap - 8 * idx;
      union { unsigned u[4]; bf16x8 v; } cv;
      cv.u[0] = q[0]; cv.u[1] = q[1]; cv.u[2] = q[2]; cv.u[3] = q[3];
      F[idx] = cv.v;
    }
#pragma unroll
    for (int nt = 0; nt < 2; ++nt) {
      if (!(nt ? any1 : any0)) continue;
      const bool vv = nt ? v1 : v0;
      const int srow = (nt ? col1 : col0) - d;
      const bf16_t* up = sU + srow * 64;
#pragma unroll
      for (int ks = 0; ks < 2; ++ks) {
        bf16x8 bf = (bf16x8){0, 0, 0, 0, 0, 0, 0, 0};
        if (vv) bf = *(const bf16x8*)(up + (((ks * 4 + fq) ^ (srow & 7)) * 8));
#pragma unroll
        for (int m = 0; m < 4; ++m)
          acc[m][nt] = __builtin_amdgcn_mfma_f32_16x16x32_bf16(F[m + 2 - 2 * ks], bf, acc[m][nt], 0, 0, 0);
      }
    }
  }
  const float skip = p.filt_bias[ORDER * 512 + c];
  const int gcol = (ORDER == 0 ? 512 : 1024) + c;
  const bf16_t* graw = hyT + (size_t)gcol * NTOK + tok0;
  const float w0 = p.hy_conv_w[gcol], w1 = p.hy_conv_w[1536 + gcol], w2 = p.hy_conv_w[3072 + gcol], b = p.hy_conv_b[gcol];
  bf16_t* outT = (bf16_t*)(p.ws + (ORDER == 0 ? OFF_ZT : OFF_Y2T)) + (size_t)c * NTOK + tok0;
#pragma unroll
  for (int nt = 0; nt < 2; ++nt) {
    const int col = nt ? col1 : col0;
#pragma unroll
    for (int m = 0; m < 4; ++m) {
      const int t = col * 64 + 16 * m + 4 * fq, pos = t & (L - 1);
      const uint2 uu = *(const uint2*)(sU + col * 64 + (((2 * m + (fq >> 1)) ^ (col & 7)) * 8) + 4 * (fq & 1));
      const uint2 gv = *(const uint2*)(graw + t);
      float x[6];
      x[0] = pos == 0 ? 0.f : bf2f(graw[t - 1]);
      x[1] = bflo(gv.x); x[2] = bfhi(gv.x); x[3] = bflo(gv.y); x[4] = bfhi(gv.y);
      x[5] = (pos + 4 == L) ? 0.f : bf2f(graw[t + 4]);
      const float u4[4] = {bflo(uu.x), bfhi(uu.x), bflo(uu.y), bfhi(uu.y)};
      float o[4];
#pragma unroll
      for (int j = 0; j < 4; ++j) {
        const float gate = w0 * x[j] + w1 * x[j + 1] + w2 * x[j + 2] + b;
        o[j] = gate * (acc[m][nt][j] + skip * u4[j]);
      }
      *(uint2*)(outT + t) = make_uint2(pack2(o[0], o[1]), pack2(o[2], o[3]));
    }
  }
}

__device__ __forceinline__ void rope32(float* y  , int pos) {
  const float prow = (float)(pos >> 6), pcol = (float)(pos & 63);
  const float fr[8] = {1.f, 0.31622776601683794f, 0.1f, 0.031622776601683794f, 0.01f, 0.0031622776601683794f, 0.001f, 0.00031622776601683794f};
#pragma unroll
  for (int i = 0; i < 8; ++i) {
    const float tr = prow * fr[i] * 0.15915494309189535f, tc = pcol * fr[i] * 0.15915494309189535f;
    const float sr = sin_turns(tr), cr = cos_turns(tr), sc = sin_turns(tc), cc = cos_turns(tc);
    const float a = y[i], b = y[8 + i], c2 = y[16 + i], d2 = y[24 + i];
    y[i] = a * cr - b * sr; y[8 + i] = b * cr + a * sr;
    y[16 + i] = c2 * cc - d2 * sc; y[24 + i] = d2 * cc + c2 * sc;
  }
}
__device__ __forceinline__ void unpack8(const uint4& v, float* x) {
  x[0] = bflo(v.x); x[1] = bfhi(v.x); x[2] = bflo(v.y); x[3] = bfhi(v.y);
  x[4] = bflo(v.z); x[5] = bfhi(v.z); x[6] = bflo(v.w); x[7] = bfhi(v.w);
}
__device__ __forceinline__ float sumsq8(const uint4& v) {
  float x[8];
  unpack8(v, x);
  return x[0] * x[0] + x[1] * x[1] + x[2] * x[2] + x[3] * x[3] + x[4] * x[4] + x[5] * x[5] + x[6] * x[6] + x[7] * x[7];
}
__device__ __forceinline__ uint4 scale8(const uint4& v, float r, const float* __restrict__ g) {
  float x[8];
  unpack8(v, x);
  const float4 g0 = *(const float4*)g, g1 = *(const float4*)(g + 4);
  return make_uint4(pack2(x[0] * r * g0.x, x[1] * r * g0.y), pack2(x[2] * r * g0.z, x[3] * r * g0.w),
                    pack2(x[4] * r * g1.x, x[5] * r * g1.y), pack2(x[6] * r * g1.z, x[7] * r * g1.w));
}
__device__ __forceinline__ void qk_item(const Params& p, int item) {
  const int tid = ltid();
  if (item < 512) {
    const int idx = item * 256 + tid, row = idx >> 3, h = idx & 7;
    const bf16_t* src = (const bf16_t*)(p.ws + OFF_QRAW) + (size_t)row * 768 + h * 96;
    bf16_t* dst = (bf16_t*)(p.ws + OFF_Q) + (size_t)row * 768 + h * 96;
    uint4 raw[12];
#pragma unroll
    for (int i = 0; i < 12; ++i) raw[i] = *(const uint4*)(src + 8 * i);
    float ss = 0.f;
#pragma unroll
    for (int i = 0; i < 12; ++i) ss += sumsq8(raw[i]);
    const float r = rsqrtf(ss * (1.f / 96.f) + 1e-6f);
    const float qs = 0.10206207261596575f * 1.4426950408889634f;
#pragma unroll
    for (int i = 0; i < 8; ++i) *(uint4*)(dst + 8 * i) = scale8(raw[i], r * qs, p.g_q + 8 * i);
    float y[32];
#pragma unroll
    for (int i = 0; i < 4; ++i) unpack8(raw[8 + i], y + 8 * i);
#pragma unroll
    for (int i = 0; i < 32; ++i) y[i] = y[i] * r * p.g_q[64 + i];
    if (row >= NCTX) rope32(y, (row - NCTX) & 4095);
#pragma unroll
    for (int i = 0; i < 4; ++i)
      *(uint4*)(dst + 64 + 8 * i) = make_uint4(pack2(y[8 * i] * qs, y[8 * i + 1] * qs), pack2(y[8 * i + 2] * qs, y[8 * i + 3] * qs),
                                               pack2(y[8 * i + 4] * qs, y[8 * i + 5] * qs), pack2(y[8 * i + 6] * qs, y[8 * i + 7] * qs));
  } else {
    const int idx = (item - 512) * 256 + tid, row = idx >> 3, h = idx & 7;
    const bf16_t* src = (const bf16_t*)(p.ws + OFF_KRAW) + (size_t)row * 512 + h * 64;
    uint4 raw[8];
#pragma unroll
    for (int i = 0; i < 8; ++i) raw[i] = *(const uint4*)(src + 8 * i);
    const float* kp = row < NTOK ? (const float*)(p.ws + OFF_KPE) + (size_t)row * 32 : p.cache_kpe + (size_t)(row - NTOK) * 32;
    float y[32];
#pragma unroll
    for (int i = 0; i < 8; ++i) {
      const float4 v = *(const float4*)(kp + 4 * i);
      y[4 * i] = v.x; y[4 * i + 1] = v.y; y[4 * i + 2] = v.z; y[4 * i + 3] = v.w;
    }
    float ss = 0.f;
#pragma unroll
    for (int i = 0; i < 8; ++i) ss += sumsq8(raw[i]);
#pragma unroll
    for (int i = 0; i < 32; ++i) ss += y[i] * y[i];
    const float r = rsqrtf(ss * (1.f / 96.f) + 1e-6f);
#pragma unroll
    for (int i = 0; i < 32; ++i) y[i] = y[i] * r * p.g_k[64 + i];
    bf16_t* dst;
    if (row < NCTX) dst = (bf16_t*)(p.ws + OFF_KC) + ((size_t)((row >> 8) * 8 + h) * 256 + (row & 255)) * 96;
    else if (row < NTOK) {
      const int rr = row - NCTX;
      rope32(y, rr & 4095);
      dst = (bf16_t*)(p.ws + OFF_KL) + ((size_t)((rr >> 12) * 8 + h) * 4608 + (rr & 4095)) * 96;
    } else {
      const int rr = row - NTOK;
      dst = (bf16_t*)(p.ws + OFF_KL) + ((size_t)((rr >> 9) * 8 + h) * 4608 + 4096 + (rr & 511)) * 96;
    }
#pragma unroll
    for (int i = 0; i < 8; ++i) *(uint4*)(dst + 8 * i) = scale8(raw[i], r, p.g_k + 8 * i);
#pragma unroll
    for (int i = 0; i < 4; ++i)
      *(uint4*)(dst + 64 + 8 * i) = make_uint4(pack2(y[8 * i], y[8 * i + 1]), pack2(y[8 * i + 2], y[8 * i + 3]),
                                               pack2(y[8 * i + 4], y[8 * i + 5]), pack2(y[8 * i + 6], y[8 * i + 7]));
  }
}

__device__ __forceinline__ void attn_item(const Params& p, int item, char* smem) {
  const int tid = ltid(), lane = tid & 63, wid = tid >> 6, lr = lane & 31, lh = lane >> 5;
  int nkeys, h, tokbase; const bf16_t *Kp, *Vp;
  if (item < 512) {
    const int b = item >> 8, rem = item & 255; h = rem >> 5; const int qb = rem & 31;
    nkeys = 4608; tokbase = NCTX + b * 4096 + qb * 128;
    Kp = (const bf16_t*)(p.ws + OFF_KL) + (size_t)(b * 8 + h) * 4608 * 96;
    Vp = (const bf16_t*)(p.ws + OFF_VTL) + (size_t)(b * 8 + h) * 64 * 4608;
  } else {
    const int it = item - 512, b = it >> 4; h = (it & 15) >> 1; const int qb = it & 1;
    nkeys = 256; tokbase = b * 256 + qb * 128;
    Kp = (const bf16_t*)(p.ws + OFF_KC) + (size_t)(b * 8 + h) * 256 * 96;
    Vp = (const bf16_t*)(p.ws + OFF_VTC) + (size_t)(b * 8 + h) * 64 * 256;
  }
  bf16_t* sK = (bf16_t*)smem;
  bf16_t* sV = sK + 64 * 104;
  const int token = tokbase + 32 * wid + lr;
  const bf16_t* qsrc = (const bf16_t*)(p.ws + OFF_Q) + (size_t)token * 768 + h * 96 + 8 * lh;
  bf16x8 qf[6];
#pragma unroll
  for (int ks = 0; ks < 6; ++ks) qf[ks] = *(const bf16x8*)(qsrc + 16 * ks);
  f32x16 oacc[2];
#pragma unroll
  for (int j = 0; j < 16; ++j) { oacc[0][j] = 0.f; oacc[1][j] = 0.f; }
  float mrun = -1e30f, lsum = 0.f;
  const int kk0 = tid / 12, kc0 = tid % 12, kk1 = (tid + 256) / 12, kc1 = (tid + 256) % 12, kk2 = (tid + 512) / 12, kc2 = (tid + 512) % 12;
  const int vd0 = tid >> 3, vc0 = tid & 7, vd1 = vd0 + 32;
  const bf16_t* gk0 = Kp + (size_t)kk0 * 96 + kc0 * 8;
  const bf16_t* gk1 = Kp + (size_t)kk1 * 96 + kc1 * 8;
  const bf16_t* gk2 = Kp + (size_t)kk2 * 96 + kc2 * 8;
  const bf16_t* gv0 = Vp + (size_t)vd0 * nkeys + vc0 * 8;
  const bf16_t* gv1 = Vp + (size_t)vd1 * nkeys + vc0 * 8;
  uint4 rk0 = *(const uint4*)gk0, rk1 = *(const uint4*)gk1, rk2 = *(const uint4*)gk2;
  uint4 rv0 = *(const uint4*)gv0, rv1 = *(const uint4*)gv1;
  const int nt = nkeys >> 6;
  for (int kt = 0; kt < nt; ++kt) {
    __syncthreads();
    *(uint4*)(sK + kk0 * 104 + kc0 * 8) = rk0; *(uint4*)(sK + kk1 * 104 + kc1 * 8) = rk1; *(uint4*)(sK + kk2 * 104 + kc2 * 8) = rk2;
    *(uint4*)(sV + vd0 * 72 + vc0 * 8) = rv0; *(uint4*)(sV + vd1 * 72 + vc0 * 8) = rv1;
    __syncthreads();
    if (kt + 1 < nt) {
      gk0 += 64 * 96; gk1 += 64 * 96; gk2 += 64 * 96; gv0 += 64; gv1 += 64;
      rk0 = *(const uint4*)gk0; rk1 = *(const uint4*)gk1; rk2 = *(const uint4*)gk2;
      rv0 = *(const uint4*)gv0; rv1 = *(const uint4*)gv1;
    }
    __builtin_amdgcn_sched_barrier(0);
    f32x16 sacc[2];
#pragma unroll
    for (int kb = 0; kb < 2; ++kb) {
#pragma unroll
      for (int j = 0; j < 16; ++j) sacc[kb][j] = 0.f;
#pragma unroll
      for (int ks = 0; ks < 6; ++ks) {
        const bf16x8 a = *(const bf16x8*)(sK + (32 * kb + lr) * 104 + 16 * ks + 8 * lh);
        sacc[kb] = __builtin_amdgcn_mfma_f32_32x32x16_bf16(a, qf[ks], sacc[kb], 0, 0, 0);
      }
    }
    float mx = sacc[0][0];
#pragma unroll
    for (int j = 1; j < 16; ++j) mx = fmaxf(mx, sacc[0][j]);
#pragma unroll
    for (int j = 0; j < 16; ++j) mx = fmaxf(mx, sacc[1][j]);
    mx = fmaxf(mx, __shfl_xor(mx, 32));
    const float mnew = fmaxf(mrun, mx);
    const float alpha = __builtin_amdgcn_exp2f(mrun - mnew);
    mrun = mnew;
    float ps = 0.f;
#pragma unroll
    for (int kb = 0; kb < 2; ++kb)
#pragma unroll
      for (int j = 0; j < 16; ++j) { const float e = __builtin_amdgcn_exp2f(sacc[kb][j] - mnew); sacc[kb][j] = e; ps += e; }
    lsum = lsum * alpha + ps;
#pragma unroll
    for (int j = 0; j < 16; ++j) { oacc[0][j] *= alpha; oacc[1][j] *= alpha; }
#pragma unroll
    for (int s = 0; s < 4; ++s) {
      const int kb = s >> 1, jb = 8 * (s & 1);
      union { unsigned u[4]; bf16x8 v; } pf;
      pf.u[0] = pack2(sacc[kb][jb + 0], sacc[kb][jb + 1]); pf.u[1] = pack2(sacc[kb][jb + 2], sacc[kb][jb + 3]);
      pf.u[2] = pack2(sacc[kb][jb + 4], sacc[kb][jb + 5]); pf.u[3] = pack2(sacc[kb][jb + 6], sacc[kb][jb + 7]);
#pragma unroll
      for (int mt = 0; mt < 2; ++mt) {
        const bf16_t* vp = sV + (32 * mt + lr) * 72 + 16 * s + 4 * lh;
        union { uint2 d[2]; bf16x8 v; } av;
        av.d[0] = *(const uint2*)vp;
        av.d[1] = *(const uint2*)(vp + 8);
        oacc[mt] = __builtin_amdgcn_mfma_f32_32x32x16_bf16(av.v, pf.v, oacc[mt], 0, 0, 0);
      }
    }
  }
  lsum += __shfl_xor(lsum, 32);
  const float inv = 1.f / lsum;
  bf16_t* dst = (bf16_t*)(p.ws + OFF_ATTN) + (size_t)token * 512 + h * 64;
#pragma unroll
  for (int mt = 0; mt < 2; ++mt)
#pragma unroll
    for (int jg = 0; jg < 4; ++jg) {
      const int dv0 = 32 * mt + 8 * jg + 4 * lh;
      *(uint2*)(dst + dv0) = make_uint2(pack2(oacc[mt][4 * jg] * inv, oacc[mt][4 * jg + 1] * inv),
                                        pack2(oacc[mt][4 * jg + 2] * inv, oacc[mt][4 * jg + 3] * inv));
    }
}

__device__ __forceinline__ void merge_item(const Params& p, int item, char* smem) {
  const int tid = ltid(), lane = tid & 63, wid = tid >> 6, t0 = item * 32;
  bf16_t* mix = (bf16_t*)(p.ws + OFF_H);
  const bf16_t* attn = (const bf16_t*)(p.ws + OFF_ATTN);
  for (int tt = 0; tt < 8; ++tt) {
    const int token = t0 + wid * 8 + tt;
    float x[8];
    unpack8(*(const uint4*)(attn + (size_t)token * 512 + lane * 8), x);
    float ss = 0.f;
#pragma unroll
    for (int i = 0; i < 8; ++i) ss += x[i] * x[i];
    ss = wave_sum(ss);
    const float r = rsqrtf(ss * (1.f / 512.f) + 1e-6f);
    const float4 g0 = *(const float4*)(p.g_out_att + lane * 8), g1 = *(const float4*)(p.g_out_att + lane * 8 + 4);
    *(uint4*)(mix + (size_t)token * D + lane * 8) =
        make_uint4(pack2(x[0] * r * g0.x, x[1] * r * g0.y), pack2(x[2] * r * g0.z, x[3] * r * g0.w),
                   pack2(x[4] * r * g1.x, x[5] * r * g1.y), pack2(x[6] * r * g1.z, x[7] * r * g1.w));
  }
  bf16_t* sT = (bf16_t*)smem;
  const bf16_t* y2T = (const bf16_t*)(p.ws + OFF_Y2T);
  __syncthreads();
  for (int ch = tid; ch < 2048; ch += 256) {
    const int c = ch >> 2, q4 = ch & 3;
    const uint4 v = *(const uint4*)(y2T + (size_t)c * NTOK + t0 + q4 * 8);
    bf16_t* d = sT + (q4 * 8) * 520 + c;
    d[0 * 520] = (bf16_t)(v.x & 0xffff); d[1 * 520] = (bf16_t)(v.x >> 16);
    d[2 * 520] = (bf16_t)(v.y & 0xffff); d[3 * 520] = (bf16_t)(v.y >> 16);
    d[4 * 520] = (bf16_t)(v.z & 0xffff); d[5 * 520] = (bf16_t)(v.z >> 16);
    d[6 * 520] = (bf16_t)(v.w & 0xffff); d[7 * 520] = (bf16_t)(v.w >> 16);
  }
  __syncthreads();
  {
    const int tt = tid >> 3, part = tid & 7;
    uint4 v[8];
    float ss = 0.f;
#pragma unroll
    for (int i = 0; i < 8; ++i) {
      v[i] = *(const uint4*)(sT + tt * 520 + part * 64 + 8 * i);
      float x[8];
      unpack8(v[i], x);
#pragma unroll
      for (int e = 0; e < 8; ++e) ss += x[e] * x[e];
    }
    ss += __shfl_xor(ss, 1); ss += __shfl_xor(ss, 2); ss += __shfl_xor(ss, 4);
    const float r = rsqrtf(ss * (1.f / 512.f) + 1e-6f);
#pragma unroll
    for (int i = 0; i < 8; ++i) {
      float x[8];
      unpack8(v[i], x);
      const int c0 = part * 64 + 8 * i;
      const float4 g0 = *(const float4*)(p.g_out_hy + c0), g1 = *(const float4*)(p.g_out_hy + c0 + 4);
      *(uint4*)(mix + (size_t)(t0 + tt) * D + 512 + c0) =
          make_uint4(pack2(x[0] * r * g0.x, x[1] * r * g0.y), pack2(x[2] * r * g0.z, x[3] * r * g0.w),
                     pack2(x[4] * r * g1.x, x[5] * r * g1.y), pack2(x[6] * r * g1.z, x[7] * r * g1.w));
    }
  }
}

__device__ __forceinline__ void actfix_item(const Params& p, int item) {
  const int idx = item * 256 + ltid();
  if (idx >= 512 * 352) return;
  const int j = (idx % 352) * 8, rowi = idx / 352, wt = rowi >> 1, which = rowi & 1;
  const int t = 64 * wt + 63 * which, L = t < NCTX ? SEQC : SEQL, pos = t & (L - 1);
  const bf16_t* edge = (const bf16_t*)(p.ws + OFF_EDGE);
  bf16_t* act = (bf16_t*)(p.ws + OFF_U);
  const bf16_t *pr, *cu, *nx;
  bool zp = false, zn = false;
  if (which == 0) { zp = pos == 0; pr = edge + (size_t)((zp ? wt : wt - 1) * 4 + 3) * 5632; cu = edge + (size_t)(wt * 4 + 0) * 5632; nx = edge + (size_t)(wt * 4 + 1) * 5632; }
  else { zn = pos == L - 1; pr = edge + (size_t)(wt * 4 + 2) * 5632; cu = edge + (size_t)(wt * 4 + 3) * 5632; nx = edge + (size_t)((zn ? wt : wt + 1) * 4 + 0) * 5632; }
  float pa[8], pg[8], ca[8], cgv[8], na[8], ng[8];
  unpack8(*(const uint4*)(pr + j), pa); unpack8(*(const uint4*)(pr + 2816 + j), pg);
  unpack8(*(const uint4*)(cu + j), ca); unpack8(*(const uint4*)(cu + 2816 + j), cgv);
  unpack8(*(const uint4*)(nx + j), na); unpack8(*(const uint4*)(nx + 2816 + j), ng);
  float o[8];
#pragma unroll
  for (int e = 0; e < 8; ++e) {
    const float pae = zp ? 0.f : pa[e], pge = zp ? 0.f : pg[e], nae = zn ? 0.f : na[e], nge = zn ? 0.f : ng[e];
    const float a = p.ffn_conv_w[j + e] * pae + p.ffn_conv_w[5632 + j + e] * ca[e] + p.ffn_conv_w[11264 + j + e] * nae + p.ffn_conv_b[j + e];
    const float g = p.ffn_conv_w[2816 + j + e] * pge + p.ffn_conv_w[5632 + 2816 + j + e] * cgv[e] + p.ffn_conv_w[11264 + 2816 + j + e] * nge + p.ffn_conv_b[2816 + j + e];
    o[e] = a / (1.f + __expf(-a)) * g;
  }
  *(uint4*)(act + (size_t)t * 2816 + j) = make_uint4(pack2(o[0], o[1]), pack2(o[2], o[3]), pack2(o[4], o[5]), pack2(o[6], o[7]));
}

#define XB_TMO      128
#define XB_XCNT(j)  (256  + 64 * (j))
#define XB_XSUB(j)  (1280 + 64 * (j))
#define XB_XGEN(j)  (2304 + 64 * (j))
#define XB_TOP      3328
#define XB_TOPGEN   3392
#define XCD_BAR_WORDS 3456
#define XB_SPIN_CAP (1u << 20)
#define LAS __attribute__((address_space(3)))
__device__ __forceinline__ unsigned xb_ld(unsigned* p) { return __hip_atomic_load(p, __ATOMIC_RELAXED, __HIP_MEMORY_SCOPE_AGENT); }
__device__ __forceinline__ unsigned xb_add(unsigned* p, unsigned v) { return __hip_atomic_fetch_add(p, v, __ATOMIC_RELAXED, __HIP_MEMORY_SCOPE_AGENT); }
__device__ __forceinline__ unsigned xb_xcc_id() { return (unsigned)__builtin_amdgcn_s_getreg((3 << 11) | 20) & 0xFu; }
#define XB_SPIN(cond, bar) do { unsigned _sp = 0; while (cond) { __builtin_amdgcn_s_sleep(1); \
    if ((++_sp & 255u) == 0u) { if (xb_ld(&(bar)[XB_TMO])) break; if (_sp > XB_SPIN_CAP) { atomicAdd(&(bar)[XB_TMO], 1u); break; } } } } while (0)
struct XcdBarrier { unsigned* bar; unsigned x; volatile LAS unsigned* st; };
__device__ __forceinline__ XcdBarrier xcd_barrier_post(unsigned* bar, volatile LAS unsigned* st) {
  XcdBarrier b; b.bar = bar; b.x = xb_xcc_id(); b.st = st;
  if (threadIdx.x == 0) (void)xb_add(&bar[XB_XCNT(b.x)], 1u);
  return b;
}
__device__ __forceinline__ void xcd_barrier_complete(unsigned* bar, unsigned x, unsigned& nloc, unsigned& nx) {
  const unsigned G = gridDim.x * gridDim.y * gridDim.z;
  unsigned sum, cnt, mine, sp = 0u;
  for (;;) {
    sum = 0u; cnt = 0u; mine = 0u;
#pragma unroll
    for (unsigned j = 0; j < 16; ++j) { const unsigned c = xb_ld(&bar[XB_XCNT(j)]); sum += c; cnt += (c > 0u) ? 1u : 0u; mine = (j == x) ? c : mine; }
    if (sum == G) break;
    __builtin_amdgcn_s_sleep(1);
    if ((++sp & 255u) == 0u) { if (xb_ld(&bar[XB_TMO])) break; if (sp > XB_SPIN_CAP) { atomicAdd(&bar[XB_TMO], 1u); break; } }
  }
  nloc = mine > 0u ? mine : 1u; nx = cnt > 0u ? cnt : 1u;
}
__device__ __forceinline__ void xcd_barrier(const XcdBarrier& b) {
  asm volatile("s_waitcnt vmcnt(0)" ::: "memory");
  __syncthreads();
  if (threadIdx.x == 0) {
    unsigned* bar = b.bar;
    __builtin_amdgcn_s_waitcnt(0);
    unsigned nloc = b.st[0], nx = b.st[1];
    if (nloc == 0u) { xcd_barrier_complete(bar, b.x, nloc, nx); b.st[0] = nloc; b.st[1] = nx; }
    const unsigned old = xb_add(&bar[XB_XSUB(b.x)], 1u);
    const unsigned gen = old / nloc;
    if (old + 1u == (gen + 1u) * nloc) {
      __builtin_amdgcn_fence(__ATOMIC_RELEASE, "agent");
      asm volatile("s_waitcnt vmcnt(0)" ::: "memory");
      const unsigned og = xb_add(&bar[XB_TOP], 1u);
      const unsigned tg = og / nx;
      if (og + 1u == (tg + 1u) * nx) xb_add(&bar[XB_TOPGEN], 1u);
      else XB_SPIN(xb_ld(&bar[XB_TOPGEN]) == tg, bar);
      __builtin_amdgcn_fence(__ATOMIC_ACQUIRE, "agent");
      xb_add(&bar[XB_XGEN(b.x)], 1u);
      asm volatile("s_waitcnt vmcnt(0)" ::: "memory");
    } else {
      XB_SPIN(xb_ld(&bar[XB_XGEN(b.x)]) == gen, bar);
      __builtin_amdgcn_fence(__ATOMIC_ACQUIRE, "agent");
      asm volatile("s_waitcnt vmcnt(0)" ::: "memory");
    }
  }
  __syncthreads();
}
constexpr size_t OFF_BAR = 25 * MiB - 16384;
static_assert(OFF_MOD + 3 * 6144 * 4 <= OFF_BAR, "bar");

template <int ph>
__device__ __forceinline__ void run_phase(const Params& p, char* smem) {
  const int bid = blockIdx.x, G = gridDim.x;
  char* ws = p.ws;
  if constexpr (ph == 0) {
    for (int it = bid; it < 272 + 96 + 32 + 3080; it += G) {
      if (it < 272) filter_item(p, it, smem);
      else if (it < 368) mod_item(p, it - 272, smem);
      else if (it < 400) cache_item(p, it - 368);
      else {
        int t = it - 400;
        if (t < 576) transpose_item(p.w_in, 1024, DIN, (bf16_t*)(ws + OFF_WIN), t, 36, smem);
        else if ((t -= 576) < 72) transpose_item(p.w_uq, 384, 768, (bf16_t*)(ws + OFF_WUQ), t, 12, smem);
        else if ((t -= 72) < 64) transpose_item(p.w_ukv, 256, 1024, (bf16_t*)(ws + OFF_WUKV), t, 16, smem);
        else if ((t -= 64) < 256) transpose_item(p.w_out, 1024, 1024, (bf16_t*)(ws + OFF_WOUT), t, 16, smem);
        else if ((t -= 256) < 1408) transpose_item(p.w_up, 1024, 5632, (bf16_t*)(ws + OFF_WUP), t, 88, smem, true);
        else { t -= 1408; transpose_item(p.w_down, 2816, 1024, (bf16_t*)(ws + OFF_WDOWN), t, 16, smem); }
      }
    }
  } else if constexpr (ph == 1) {
    rmsmod_phase<0>(p);
  } else if constexpr (ph == 2) {
    EpiIn epi{(float*)(ws + OFF_PROJ), (bf16_t*)(ws + OFF_HYT)};
    for (int t = bid; t < 128 * 18; t += G)
      gemm_tile<false>((const bf16_t*)(ws + OFF_H), 1024, (const bf16_t*)(ws + OFF_WIN), 1024, 1024, (t / 18) * 128, (t % 18) * 128, smem, epi);
  } else if constexpr (ph == 3) {
    for (int it = bid; it < 512; it += G) hyena_item<0>(p, 1, it, smem);
    for (int it = bid; it < 512; it += G) hyena_item<0>(p, 0, it, smem);
    for (int it = bid; it < 256; it += G) token_item(p, it);
  } else if constexpr (ph == 4) {
    EpiQ eq{(bf16_t*)(ws + OFF_QRAW)};
    EpiKV ekv{(bf16_t*)(ws + OFF_KRAW), (bf16_t*)(ws + OFF_VTC), (bf16_t*)(ws + OFF_VTL)};
    for (int it = bid; it < 512; it += G) hyena_item<1>(p, 1, it, smem);
    for (int t = bid; t < 768; t += G) gemm_tile<true>((const bf16_t*)(ws + OFF_QA), 384, (const bf16_t*)(ws + OFF_WUQ), 384, 384, (t / 6) * 128, (t % 6) * 128, smem, eq);
    for (int t = bid; t < 1088; t += G) gemm_tile<false>((const bf16_t*)(ws + OFF_CKVN), 256, (const bf16_t*)(ws + OFF_WUKV), 256, 256, (t / 8) * 128, (t % 8) * 128, smem, ekv);
    for (int it = bid; it < 512; it += G) hyena_item<1>(p, 0, it, smem);
  } else if constexpr (ph == 5) {
    for (int it = bid; it < 512 + 544; it += G) qk_item(p, it);
  } else if constexpr (ph == 6) {
    for (int it = bid; it < 1024; it += G) attn_item(p, it, smem);
  } else if constexpr (ph == 7) {
    for (int it = bid; it < 512; it += G) merge_item(p, it, smem);
  } else if constexpr (ph == 8) {
    EpiOut epi{&p};
    for (int t = bid; t < 128 * 8; t += G)
      gemm_tile<true>((const bf16_t*)(ws + OFF_H), 1024, (const bf16_t*)(ws + OFF_WOUT), 1024, 1024, (t / 8) * 128, (t % 8) * 128, smem, epi);
  } else if constexpr (ph == 9) {
    rmsmod_phase<1>(p);
  } else if constexpr (ph == 10) {
    for (int t = bid; t < 128 * 44; t += G) gemm_up_act_tile(p, (t / 44) * 128, (t % 44) * 128, smem);
  } else if constexpr (ph == 11) {
    for (int it = bid; it < 704; it += G) actfix_item(p, it);
  } else if constexpr (ph == 12) {
    EpiY epi{&p, 0};
    for (int t = bid; t < 128 * 8; t += G)
      gemm_tile<true>((const bf16_t*)(ws + OFF_U), 2816, (const bf16_t*)(ws + OFF_WDOWN), 2816, 2816, (t / 8) * 128, (t % 8) * 128, smem, epi);
  }
}

#if ONE_LAUNCH
template <int PH>
__device__ __forceinline__ void run_all(const Params& p, char* smem, cg::grid_group& grid, const XcdBarrier& xb) {
  run_phase<PH>(p, smem);
  if constexpr (((DBL_MASK >> PH) & 1) != 0) { xcd_barrier(xb); run_phase<PH>(p, smem); }
  if constexpr (PH < 12) {
    xcd_barrier(xb);
    run_all<PH + 1>(p, smem, grid, xb);
  }
}
constexpr int DYN_LDS = 65536 + 64;
__global__ void __launch_bounds__(256, 2) mega_kernel(Params p) {
  extern __shared__ __attribute__((aligned(16))) char smem[];
  uint4* xb_words = (uint4*)(smem + 65536);
  cg::grid_group grid = cg::this_grid();
  if (threadIdx.x == 0) *xb_words = make_uint4(0u, 0u, 0u, 0u);
  __syncthreads();
  XcdBarrier xb = xcd_barrier_post((unsigned*)(p.ws + OFF_BAR), (volatile LAS unsigned*)xb_words);
  if (p.ws == nullptr) grid.sync();
  run_all<0>(p, smem, grid, xb);
}
#else
template <int PH>
__global__ void __launch_bounds__(256, 2) phase_kernel(Params p) {
  __shared__ __attribute__((aligned(16))) char smem[SMEM_BYTES];
  run_phase<PH>(p, smem);
}
#ifndef DBG_STOP
#define DBG_STOP 15
#endif
__global__ void dump_kernel(Params p, size_t off, int count) {
  const bf16_t* src = (const bf16_t*)(p.ws + off);
  const bf16_t* src2 = (const bf16_t*)(p.ws + DBG_OFF2);
  for (int i = blockIdx.x * 256 + threadIdx.x; i < 16777216; i += gridDim.x * 256)
    p.out[i] = i < DBG_CNT ? bf2f(src[i]) : (i - DBG_CNT < DBG_CNT2 ? bf2f(src2[i - DBG_CNT]) : 0.f);
}
template <int PH>
static void launch_all(const Params& p, hipStream_t stream) {
  phase_kernel<PH><<<512, 256, 0, stream>>>(p);
  if constexpr (PH < 12) launch_all<PH + 1>(p, stream);
}
#endif

extern "C" void kernel_launch(void* const* d_in, const int* in_sizes, int n_in, void* d_out, int out_size, void* d_ws,
                              size_t ws_size, hipStream_t stream) {
  Params p{};
  const float** pp = (const float**)&p;
  for (int i = 0; i < 34; ++i) pp[i] = (const float*)d_in[i];
  p.out = (float*)d_out;
  p.ws = (char*)d_ws;
#if ONE_LAUNCH
  (void)hipMemsetAsync((char*)d_ws + OFF_BAR, 0, XCD_BAR_WORDS * 4, stream);
  static int grid_blocks = 0;
  if (!grid_blocks) {
    int dev = 0, cus = 0, per_cu = 0;
    hipGetDevice(&dev);
    hipDeviceGetAttribute(&cus, hipDeviceAttributeMultiprocessorCount, dev);
    (void)hipFuncSetAttribute((const void*)mega_kernel, hipFuncAttributeMaxDynamicSharedMemorySize, DYN_LDS);
    (void)hipOccupancyMaxActiveBlocksPerMultiprocessor(&per_cu, mega_kernel, 256, DYN_LDS);
    if (per_cu > 2) per_cu = 2;
    grid_blocks = cus * per_cu;
  }
  void* args[] = {&p};
  hipError_t e = hipLaunchCooperativeKernel((void*)mega_kernel, dim3(grid_blocks), dim3(256), args, DYN_LDS, stream);
  if (e != hipSuccess) fprintf(stderr, "cooperative launch failed: %s (grid %d)\n", hipGetErrorString(e), grid_blocks);
#else
  launch_all<0>(p, stream);
#if DBG_STOP < 15
  dump_kernel<<<1024, 256, 0, stream>>>(p, DBG_OFF, DBG_CNT);
#endif
#endif
}
```

```cpp
#include <hip/hip_runtime.h>
#include <hip/hip_cooperative_groups.h>
#include <cstdio>
namespace cg = cooperative_groups;

#define DBG_STOP 15
#define DBG_NOHY 0
#ifndef DBL_MASK
#define DBL_MASK 0
#endif
#define DBG_OFF OFF_QRAW
#define DBG_OFF2 OFF_KRAW
#define DBG_CNT 12582912
#define DBG_CNT2 0
#ifndef ONE_LAUNCH
#define ONE_LAUNCH 1
#endif

typedef unsigned short bf16_t;
typedef short bf16x8 __attribute__((ext_vector_type(8)));
typedef float f32x4 __attribute__((ext_vector_type(4)));
typedef float f32x16 __attribute__((ext_vector_type(16)));

constexpr int D = 1024, NTOK = 16384, NCTX = 8192, SEQC = 256, SEQL = 4096;
constexpr int DIN = 2208, DINP = 2304, QL = 384, KVL = 256, DFF = 2816;
constexpr int NROWKV = 17408;
constexpr size_t MiB = 1048576;

constexpr size_t OFF_WIN = 0;
constexpr size_t OFF_WUQ = OFF_WIN + (size_t)DINP * 1024 * 2;
constexpr size_t OFF_WUKV = OFF_WUQ + (size_t)768 * 384 * 2;
constexpr size_t OFF_WOUT = OFF_WUKV + (size_t)1024 * 256 * 2;
constexpr size_t OFF_WUP = OFF_WOUT + (size_t)1024 * 1024 * 2;
constexpr size_t OFF_WDOWN = OFF_WUP + (size_t)5632 * 1024 * 2;
constexpr size_t OFF_MOD = OFF_WDOWN + (size_t)1024 * 2816 * 2;
static_assert(OFF_MOD + 3 * 6144 * 4 <= 25 * MiB, "A region");
constexpr size_t OFF_RLAT = 25 * MiB;
constexpr size_t OFF_RCTX = 41 * MiB;
constexpr size_t OFF_H = 42 * MiB;
constexpr size_t OFF_ZT = 42 * MiB;
constexpr size_t OFF_QA = 58 * MiB;
constexpr size_t OFF_KPE = 70 * MiB;
constexpr size_t OFF_PROJ = 74 * MiB;
constexpr size_t OFF_QRAW = 74 * MiB;
constexpr size_t OFF_Y2T = 98 * MiB;
constexpr size_t OFF_ATTN = 74 * MiB;
constexpr size_t OFF_U = 74 * MiB;
constexpr size_t OFF_HYT = 116 * MiB;
constexpr size_t OFF_Q = 116 * MiB;
constexpr size_t OFF_KC = 140 * MiB;
constexpr size_t OFF_KL = 152 * MiB;
constexpr size_t OFF_CKVN = 164 * MiB;
constexpr size_t OFF_KRAW = 173 * MiB;
constexpr size_t OFF_VTC = 190 * MiB;
constexpr size_t OFF_VTL = 198 * MiB;
constexpr size_t OFF_ACT = 162 * MiB;

constexpr int OUT_YS = 0;
constexpr int OUT_CKV = 16777216;
constexpr int OUT_KPE = 16777216 + 2097152;

constexpr int SMEM_BYTES = 51200;

struct Params {
  const float *x_prompt, *x_sample, *cache_ckv, *cache_kpe, *c, *c_ctx, *w_ada, *b_ada, *g_mix, *w_in, *g_qa, *w_uq,
      *g_kva, *w_ukv, *g_q, *g_k, *hy_conv_w, *hy_conv_b, *filt_w1, *filt_b1, *filt_freq1, *filt_w2, *filt_b2,
      *filt_freq2, *filt_w3, *filt_bias, *g_out_att, *g_out_hy, *w_out, *g_ffn, *w_up, *ffn_conv_w, *ffn_conv_b, *w_down;
  float* out;
  char* ws;
};

typedef __bf16 bf16x2_t __attribute__((ext_vector_type(2)));
__device__ __forceinline__ unsigned pack2(float lo, float hi) {
  bf16x2_t v;
  v[0] = (__bf16)lo;
  v[1] = (__bf16)hi;
  return __builtin_bit_cast(unsigned, v);
}
__device__ __forceinline__ float bflo(unsigned u) { return __uint_as_float(u << 16); }
__device__ __forceinline__ float bfhi(unsigned u) { return __uint_as_float(u & 0xffff0000u); }
__device__ __forceinline__ float bf2f(bf16_t h) { return __uint_as_float(((unsigned)h) << 16); }
__device__ __forceinline__ bf16_t f2bf(float f) { return (bf16_t)(pack2(f, 0.f) & 0xffffu); }
__device__ __forceinline__ float wave_sum(float v) {
#pragma unroll
  for (int o = 32; o >= 1; o >>= 1) v += __shfl_xor(v, o);
  return v;
}
__device__ __forceinline__ int ltid() { int t = threadIdx.x; asm volatile("" : "+v"(t)); return t; }
__device__ __forceinline__ float sin_turns(float t) { t -= floorf(t); return __builtin_amdgcn_sinf(t); }
__device__ __forceinline__ float cos_turns(float t) { t -= floorf(t); return __builtin_amdgcn_cosf(t); }
__device__ __forceinline__ float sin_rad(float x) { return sin_turns(x * 0.15915494309189535f); }
__device__ __forceinline__ const float* xrow(const Params& p, int row) {
  return row < NCTX ? p.x_prompt + (size_t)row * D : p.x_sample + (size_t)(row - NCTX) * D;
}
__device__ __forceinline__ int modidx(int row) { return row < NCTX ? 0 : 1 + ((row - NCTX) >> 12); }

template <bool SWAP>
__device__ __forceinline__ void gemm_main(const bf16_t* __restrict__ A, int lda, const bf16_t* __restrict__ Bt, int ldb,
                                          int K, int m0, int n0, char* smem, f32x4 (&acc)[4][4]) {
  const int tid = ltid(), lane = tid & 63, wid = tid >> 6, wr = wid >> 1, wc = wid & 1;
  const int fr = lane & 15, fq = lane >> 4;
  bf16_t* sbase = (bf16_t*)smem;
#pragma unroll
  for (int m = 0; m < 4; ++m)
#pragma unroll
    for (int n = 0; n < 4; ++n) acc[m][n] = (f32x4){0.f, 0.f, 0.f, 0.f};
  const int lr = tid >> 3, lc = (tid & 7) * 8;
  const bf16_t* ga = A + (size_t)(m0 + lr) * lda + lc;
  const bf16_t* gb = Bt + (size_t)(n0 + lr) * ldb + lc;
  const size_t sa32 = (size_t)32 * lda, sb32 = (size_t)32 * ldb;
  uint4 ra0 = *(const uint4*)(ga), ra1 = *(const uint4*)(ga + sa32), ra2 = *(const uint4*)(ga + 2 * sa32), ra3 = *(const uint4*)(ga + 3 * sa32);
  uint4 rb0 = *(const uint4*)(gb), rb1 = *(const uint4*)(gb + sb32), rb2 = *(const uint4*)(gb + 2 * sb32), rb3 = *(const uint4*)(gb + 3 * sb32);
  const int nk = K >> 6;
  const int woff = lr * 64 + (((tid & 7) ^ (lr & 7)) * 8);
  const int aoff = (wr * 64 + fr) * 64, boff = 8192 + (wc * 64 + fr) * 64;
  __syncthreads();
  {
    bf16_t* wa = sbase + woff;
    *(uint4*)(wa) = ra0; *(uint4*)(wa + 32 * 64) = ra1; *(uint4*)(wa + 64 * 64) = ra2; *(uint4*)(wa + 96 * 64) = ra3;
    *(uint4*)(wa + 8192) = rb0; *(uint4*)(wa + 8192 + 32 * 64) = rb1; *(uint4*)(wa + 8192 + 64 * 64) = rb2; *(uint4*)(wa + 8192 + 96 * 64) = rb3;
  }
  if (nk > 1) {
    ga += 64; gb += 64;
    ra0 = *(const uint4*)(ga); ra1 = *(const uint4*)(ga + sa32); ra2 = *(const uint4*)(ga + 2 * sa32); ra3 = *(const uint4*)(ga + 3 * sa32);
    rb0 = *(const uint4*)(gb); rb1 = *(const uint4*)(gb + sb32); rb2 = *(const uint4*)(gb + 2 * sb32); rb3 = *(const uint4*)(gb + 3 * sb32);
  }
  __syncthreads();
  for (int kt = 0; kt < nk; ++kt) {
    const bf16_t* cur = sbase + (kt & 1) * 16384;
    if (kt + 1 < nk) {
      bf16_t* wa = sbase + ((kt + 1) & 1) * 16384 + woff;
      *(uint4*)(wa) = ra0; *(uint4*)(wa + 32 * 64) = ra1; *(uint4*)(wa + 64 * 64) = ra2; *(uint4*)(wa + 96 * 64) = ra3;
      *(uint4*)(wa + 8192) = rb0; *(uint4*)(wa + 8192 + 32 * 64) = rb1; *(uint4*)(wa + 8192 + 64 * 64) = rb2; *(uint4*)(wa + 8192 + 96 * 64) = rb3;
      if (kt + 2 < nk) {
        ga += 64; gb += 64;
        ra0 = *(const uint4*)(ga); ra1 = *(const uint4*)(ga + sa32); ra2 = *(const uint4*)(ga + 2 * sa32); ra3 = *(const uint4*)(ga + 3 * sa32);
        rb0 = *(const uint4*)(gb); rb1 = *(const uint4*)(gb + sb32); rb2 = *(const uint4*)(gb + 2 * sb32); rb3 = *(const uint4*)(gb + 3 * sb32);
      }
    }
    __builtin_amdgcn_sched_barrier(0);
#pragma unroll
    for (int ks = 0; ks < 2; ++ks) {
      bf16x8 af[4], bfr[4];
#pragma unroll
      for (int m = 0; m < 4; ++m) af[m] = *(const bf16x8*)(cur + aoff + m * 16 * 64 + (((ks * 4 + fq) ^ (fr & 7)) * 8));
#pragma unroll
      for (int n = 0; n < 4; ++n) bfr[n] = *(const bf16x8*)(cur + boff + n * 16 * 64 + (((ks * 4 + fq) ^ (fr & 7)) * 8));
      __builtin_amdgcn_s_setprio(1);
#pragma unroll
      for (int m = 0; m < 4; ++m)
#pragma unroll
        for (int n = 0; n < 4; ++n) {
          if (SWAP) acc[m][n] = __builtin_amdgcn_mfma_f32_16x16x32_bf16(bfr[n], af[m], acc[m][n], 0, 0, 0);
          else acc[m][n] = __builtin_amdgcn_mfma_f32_16x16x32_bf16(af[m], bfr[n], acc[m][n], 0, 0, 0);
        }
      __builtin_amdgcn_s_setprio(0);
    }
    if (kt + 1 < nk) __syncthreads();
  }
}
template <bool SWAP, class Epi>
__device__ __forceinline__ void gemm_tile(const bf16_t* __restrict__ A, int lda, const bf16_t* __restrict__ Bt, int ldb,
                                          int K, int m0, int n0, char* smem, const Epi& epi) {
  f32x4 acc[4][4];
  gemm_main<SWAP>(A, lda, Bt, ldb, K, m0, n0, smem, acc);
  const int tid = ltid(), lane = tid & 63, wid = tid >> 6, wr = wid >> 1, wc = wid & 1;
  const int fr = lane & 15, fq = lane >> 4;
#pragma unroll
  for (int m = 0; m < 4; ++m)
#pragma unroll
    for (int n = 0; n < 4; ++n) {
      if (SWAP) epi(m0 + wr * 64 + m * 16 + fr, n0 + wc * 64 + n * 16 + fq * 4, acc[m][n]);
      else epi(m0 + wr * 64 + m * 16 + fq * 4, n0 + wc * 64 + n * 16 + fr, acc[m][n]);
    }
}

template <int CTRL>
__device__ __forceinline__ float dpp_ror(float v) {
  return __int_as_float(__builtin_amdgcn_update_dpp(0, __float_as_int(v), CTRL, 0xF, 0xF, false));
}
constexpr size_t OFF_EDGE = 162 * MiB;
__device__ __forceinline__ void gemm_up_act_tile(const Params& p, int m0, int n0, char* smem) {
  f32x4 acc[4][4];
  gemm_main<true>((const bf16_t*)(p.ws + OFF_H), 1024, (const bf16_t*)(p.ws + OFF_WUP), 1024, 1024, m0, n0, smem, acc);
  const int tid = ltid(), lane = tid & 63, wid = tid >> 6, wr = wid >> 1, wc = wid & 1;
  const int fr = lane & 15, fq = lane >> 4;
  bf16_t* act = (bf16_t*)(p.ws + OFF_U);
  bf16_t* edge = (bf16_t*)(p.ws + OFF_EDGE);
  const int rowbase = m0 + wr * 64, wt = rowbase >> 6;
#pragma unroll
  for (int i = 0; i < 2; ++i) {
    const int cperm = n0 + wc * 64 + 32 * i;
    const int j0 = (cperm >> 5) * 16 + 4 * fq;
    const float4 wa0 = *(const float4*)(p.ffn_conv_w + j0), wa1 = *(const float4*)(p.ffn_conv_w + 5632 + j0), wa2 = *(const float4*)(p.ffn_conv_w + 11264 + j0);
    const float4 wg0 = *(const float4*)(p.ffn_conv_w + 2816 + j0), wg1 = *(const float4*)(p.ffn_conv_w + 5632 + 2816 + j0), wg2 = *(const float4*)(p.ffn_conv_w + 11264 + 2816 + j0);
    const float4 ba = *(const float4*)(p.ffn_conv_b + j0), bg = *(const float4*)(p.ffn_conv_b + 2816 + j0);
    const float w0a[4] = {wa0.x, wa0.y, wa0.z, wa0.w}, w1a[4] = {wa1.x, wa1.y, wa1.z, wa1.w}, w2a[4] = {wa2.x, wa2.y, wa2.z, wa2.w};
    const float w0g[4] = {wg0.x, wg0.y, wg0.z, wg0.w}, w1g[4] = {wg1.x, wg1.y, wg1.z, wg1.w}, w2g[4] = {wg2.x, wg2.y, wg2.z, wg2.w};
    const float bba[4] = {ba.x, ba.y, ba.z, ba.w}, bbg[4] = {bg.x, bg.y, bg.z, bg.w};
#pragma unroll
    for (int m = 0; m < 4; ++m) {
      float o[4];
#pragma unroll
      for (int e = 0; e < 4; ++e) {
        const float a = acc[m][2 * i][e], g = acc[m][2 * i + 1][e];
        const float au1 = dpp_ror<0x121>(a), gu1 = dpp_ror<0x121>(g), ad1 = dpp_ror<0x12F>(a), gd1 = dpp_ror<0x12F>(g);
        float au2 = 0.f, gu2 = 0.f, ad2 = 0.f, gd2 = 0.f;
        if (m > 0) { au2 = dpp_ror<0x121>(acc[m - 1][2 * i][e]); gu2 = dpp_ror<0x121>(acc[m - 1][2 * i + 1][e]); }
        if (m < 3) { ad2 = dpp_ror<0x12F>(acc[m + 1][2 * i][e]); gd2 = dpp_ror<0x12F>(acc[m + 1][2 * i + 1][e]); }
        const float au = fr > 0 ? au1 : au2, gu = fr > 0 ? gu1 : gu2, ad = fr < 15 ? ad1 : ad2, gd = fr < 15 ? gd1 : gd2;
        const float ca = w0a[e] * au + w1a[e] * a + w2a[e] * ad + bba[e];
        const float cgv = w0g[e] * gu + w1g[e] * g + w2g[e] * gd + bbg[e];
        o[e] = ca * __builtin_amdgcn_rcpf(1.f + __expf(-ca)) * cgv;
      }
      const int lr64 = m * 16 + fr, row = rowbase + lr64;
      if (lr64 >= 1 && lr64 <= 62) *(uint2*)(act + (size_t)row * 2816 + j0) = make_uint2(pack2(o[0], o[1]), pack2(o[2], o[3]));
      if (lr64 <= 1 || lr64 >= 62) {
        const int slot = lr64 <= 1 ? lr64 : lr64 - 60;
        bf16_t* er = edge + (size_t)(wt * 4 + slot) * 5632;
        *(uint2*)(er + j0) = make_uint2(pack2(acc[m][2 * i][0], acc[m][2 * i][1]), pack2(acc[m][2 * i][2], acc[m][2 * i][3]));
        *(uint2*)(er + 2816 + j0) = make_uint2(pack2(acc[m][2 * i + 1][0], acc[m][2 * i + 1][1]), pack2(acc[m][2 * i + 1][2], acc[m][2 * i + 1][3]));
      }
    }
  }
}

__device__ __forceinline__ void transpose_item(const float* __restrict__ W, int K, int N, bf16_t* __restrict__ WT, int tile, int ntn, char* smem, bool perm = false) {
  float* s = (float*)smem;
  const int tk = tile / ntn, tn = tile % ntn, tid = ltid();
  const int k0 = tk * 64, n0 = tn * 64;
  __syncthreads();
  {
    const int r = tid >> 4, c4 = (tid & 15) * 4;
#pragma unroll
    for (int i = 0; i < 4; ++i) {
      const int k = r + 16 * i;
      float4 v = make_float4(0.f, 0.f, 0.f, 0.f);
      if (n0 + c4 < N) v = *(const float4*)(W + (size_t)(k0 + k) * N + n0 + c4);
      s[k * 65 + c4 + 0] = v.x; s[k * 65 + c4 + 1] = v.y; s[k * 65 + c4 + 2] = v.z; s[k * 65 + c4 + 3] = v.w;
    }
  }
  __syncthreads();
  {
    const int n = tid >> 2, kc = (tid & 3) * 16;
    unsigned o[8];
#pragma unroll
    for (int i = 0; i < 8; ++i) o[i] = pack2(s[(kc + 2 * i) * 65 + n], s[(kc + 2 * i + 1) * 65 + n]);
    int nr = n0 + n;
    if (perm) { const int hf = nr >= 2816 ? 1 : 0, cc = nr - hf * 2816; nr = 32 * (cc >> 4) + 16 * hf + (cc & 15); }
    uint4* dst = (uint4*)(WT + (size_t)nr * K + k0 + kc);
    dst[0] = make_uint4(o[0], o[1], o[2], o[3]);
    dst[1] = make_uint4(o[4], o[5], o[6], o[7]);
  }
}

__device__ __forceinline__ void mod_item(const Params& p, int item, char* smem) {
  float* s = (float*)smem;
  float* red = s + 3072;
  const int tid = ltid();
  __syncthreads();
  for (int e = tid; e < 3072; e += 256) {
    const int v = e >> 10, k = e & 1023;
    const float x = (v == 0) ? p.c_ctx[k] : p.c[(v - 1) * D + k];
    s[e] = x / (1.f + __expf(-x));
  }
  __syncthreads();
  const int jl = tid & 63, kq = tid >> 6, j = item * 64 + jl, k0 = kq * 256;
  float a0 = 0.f, a1 = 0.f, a2 = 0.f;
#pragma unroll 8
  for (int k = 0; k < 256; ++k) {
    const float w = p.w_ada[(size_t)(k0 + k) * 6144 + j];
    a0 += s[k0 + k] * w; a1 += s[1024 + k0 + k] * w; a2 += s[2048 + k0 + k] * w;
  }
  red[(kq * 3 + 0) * 64 + jl] = a0; red[(kq * 3 + 1) * 64 + jl] = a1; red[(kq * 3 + 2) * 64 + jl] = a2;
  __syncthreads();
  if (tid < 192) {
    const int v = tid >> 6;
    const float r = red[(0 * 3 + v) * 64 + jl] + red[(1 * 3 + v) * 64 + jl] + red[(2 * 3 + v) * 64 + jl] + red[(3 * 3 + v) * 64 + jl];
    ((float*)(p.ws + OFF_MOD))[v * 6144 + j] = r + p.b_ada[j];
  }
}

__device__ __forceinline__ void filter_item(const Params& p, int item, char* smem) {
  int n, p0; bf16_t* R;
  if (item < 256) { n = 4096; p0 = item * 16; R = (bf16_t*)(p.ws + OFF_RLAT); }
  else { n = 256; p0 = (item - 256) * 16; R = (bf16_t*)(p.ws + OFF_RCTX); }
  const int n2 = 2 * n, tid = ltid();
  float* z = (float*)smem;
  float* h1 = z + 16 * 36;
  float* h2 = h1 + 16 * 64;
  __syncthreads();
#pragma unroll 1
  for (int e = tid; e < 16 * 33; e += 256) {
    const int pp = e / 33, f = e % 33, pos = p0 + pp;
    float val;
    if (f == 0) val = (float)pos / (float)(n - 1);
    else {
      const int k = (f - 1) & 15;
      const float band = 1e-4f + (float)k * ((15.f - 1e-4f) / 15.f);
      const float turns = band * ((float)pos / (float)n);
      val = (f <= 16) ? cos_turns(turns) : -sin_turns(turns);
    }
    z[pp * 36 + f] = val;
  }
  __syncthreads();
#pragma unroll 1
  for (int e = tid; e < 1024; e += 256) {
    const int pp = e >> 6, j = e & 63;
    float a = p.filt_b1[j];
#pragma unroll 3
    for (int f = 0; f < 33; ++f) a += z[pp * 36 + f] * p.filt_w1[f * 64 + j];
    h1[e] = sin_rad(p.filt_freq1[j] * a);
  }
  __syncthreads();
#pragma unroll 1
  for (int e = tid; e < 1024; e += 256) {
    const int pp = e >> 6, j = e & 63;
    float a = p.filt_b2[j];
#pragma unroll 4
    for (int k = 0; k < 64; ++k) a += h1[pp * 64 + k] * p.filt_w2[k * 64 + j];
    h2[j * 16 + pp] = sin_rad(p.filt_freq2[j] * a);
  }
  __syncthreads();
  const float mind = -3.0701134573253946f, maxd = -15.350567286626973f;
#pragma unroll 1
  for (int ci = 0; ci < 8; ++ci) {
    const int col = tid + 256 * ci, o = col >> 10, dir = (col >> 9) & 1, c = col & 511;
    float acc[16];
#pragma unroll
    for (int i = 0; i < 16; ++i) acc[i] = 0.f;
#pragma unroll 4
    for (int k = 0; k < 64; ++k) {
      const float w = p.filt_w3[k * 2048 + col];
      const float4 ha = *(const float4*)(h2 + k * 16), hb = *(const float4*)(h2 + k * 16 + 4), hc = *(const float4*)(h2 + k * 16 + 8), hd = *(const float4*)(h2 + k * 16 + 12);
      acc[0] += ha.x * w; acc[1] += ha.y * w; acc[2] += ha.z * w; acc[3] += ha.w * w;
      acc[4] += hb.x * w; acc[5] += hb.y * w; acc[6] += hb.z * w; acc[7] += hb.w * w;
      acc[8] += hc.x * w; acc[9] += hc.y * w; acc[10] += hc.z * w; acc[11] += hc.w * w;
      acc[12] += hd.x * w; acc[13] += hd.y * w; acc[14] += hd.z * w; acc[15] += hd.w * w;
    }
    const float delta = fabsf(mind + (float)c * ((maxd - mind) / 511.f));
    bf16_t* Rrow = R + (size_t)(o * 512 + c) * n2;
#pragma unroll
    for (int i = 0; i < 16; ++i) {
      const int pos = p0 + i;
      const float t = (float)pos / (float)(n - 1);
      float val = acc[i] * (__expf(-t * delta) + 0.05f);
      int idx = dir == 0 ? (n - 1 - pos) : (n - 1 + pos);
      if (dir == 1 && pos == 0) { idx = n2 - 1; val = 0.f; }
      Rrow[idx] = f2bf(val);
    }
  }
}

__device__ __forceinline__ void cache_item(const Params& p, int item) {
  const int tid = ltid(), r0 = item * 32;
  bf16_t* ckvn = (bf16_t*)(p.ws + OFF_CKVN);
#pragma unroll 2
  for (int e = tid; e < 32 * 64; e += 256) {
    const int r = r0 + (e >> 6), c4 = (e & 63) * 4;
    const float4 v = *(const float4*)(p.cache_ckv + (size_t)r * 256 + c4);
    *(uint2*)(ckvn + (size_t)(NTOK + r) * 256 + c4) = make_uint2(pack2(v.x, v.y), pack2(v.z, v.w));
  }
}

template <int WHICH>
__device__ __forceinline__ void rmsmod_phase(const Params& p) {
  const int tid = ltid(), lane = tid & 63, wid = tid >> 6;
  const int gw = blockIdx.x * 4 + wid, tw = gridDim.x * 4;
  const float* g = WHICH == 0 ? p.g_mix : p.g_ffn;
  const float* mod = (const float*)(p.ws + OFF_MOD);
  bf16_t* h = (bf16_t*)(p.ws + OFF_H);
  for (int row = gw; row < NTOK; row += tw) {
    const float* src = WHICH == 0 ? xrow(p, row) : p.out + (size_t)row * D;
    float4 v[4];
    float ss = 0.f;
#pragma unroll
    for (int i = 0; i < 4; ++i) {
      v[i] = ((const float4*)src)[lane + 64 * i];
      ss += v[i].x * v[i].x + v[i].y * v[i].y + v[i].z * v[i].z + v[i].w * v[i].w;
    }
    ss = wave_sum(ss);
    const float r = rsqrtf(ss * (1.f / 1024.f) + 1e-6f);
    const float* mv = mod + modidx(row) * 6144 + (WHICH == 0 ? 0 : 3 * 1024);
#pragma unroll
    for (int i = 0; i < 4; ++i) {
      const int e = 4 * (lane + 64 * i);
      const float4 g4 = *(const float4*)(g + e), sh = *(const float4*)(mv + e), sc = *(const float4*)(mv + 1024 + e);
      const float y0 = v[i].x * r * g4.x * (1.f + sc.x) + sh.x, y1 = v[i].y * r * g4.y * (1.f + sc.y) + sh.y;
      const float y2 = v[i].z * r * g4.z * (1.f + sc.z) + sh.z, y3 = v[i].w * r * g4.w * (1.f + sc.w) + sh.w;
      *(uint2*)(h + (size_t)row * D + e) = make_uint2(pack2(y0, y1), pack2(y2, y3));
    }
  }
}

struct EpiIn {
  float* proj; bf16_t* hyT;
  __device__ __forceinline__ void operator()(int row0, int col, const f32x4& v) const {
    if (col < 672) {
#pragma unroll
      for (int j = 0; j < 4; ++j) proj[(size_t)(row0 + j) * 672 + col] = v[j];
    } else if (col < DIN) {
      *(uint2*)(hyT + (size_t)(col - 672) * NTOK + row0) = make_uint2(pack2(v[0], v[1]), pack2(v[2], v[3]));
    }
  }
};
struct EpiProj {
  float* proj;
  __device__ __forceinline__ void operator()(int row, int col0, const f32x4& v) const { *(f32x4*)(proj + (size_t)row * 672 + col0) = v; }
};
struct EpiQ {
  bf16_t* q;
  __device__ __forceinline__ void operator()(int row, int col0, const f32x4& v) const {
    *(uint2*)(q + (size_t)row * 768 + col0) = make_uint2(pack2(v[0], v[1]), pack2(v[2], v[3]));
  }
};
struct EpiKV {
  bf16_t *kraw, *vtc, *vtl;
  __device__ __forceinline__ void operator()(int row0, int col, const f32x4& v) const {
    const int head = col >> 7, cc = col & 127;
    if (cc < 64) {
#pragma unroll
      for (int j = 0; j < 4; ++j) kraw[(size_t)(row0 + j) * 512 + head * 64 + cc] = f2bf(v[j]);
    } else {
      const int dv = cc - 64;
      bf16_t* dst;
      if (row0 < NCTX) dst = vtc + ((size_t)((row0 >> 8) * 8 + head) * 64 + dv) * 256 + (row0 & 255);
      else if (row0 < NTOK) { const int r = row0 - NCTX; dst = vtl + ((size_t)((r >> 12) * 8 + head) * 64 + dv) * 4608 + (r & 4095); }
      else { const int r = row0 - NTOK; dst = vtl + ((size_t)((r >> 9) * 8 + head) * 64 + dv) * 4608 + 4096 + (r & 511); }
      *(uint2*)dst = make_uint2(pack2(v[0], v[1]), pack2(v[2], v[3]));
    }
  }
};
struct EpiOut {
  const Params* p;
  __device__ __forceinline__ void operator()(int row, int col0, const f32x4& v) const {
    const float4 x = *(const float4*)(xrow(*p, row) + col0);
    const float4 m = *(const float4*)((const float*)(p->ws + OFF_MOD) + modidx(row) * 6144 + 2 * 1024 + col0);
    *(float4*)(p->out + (size_t)row * D + col0) = make_float4(x.x + m.x * v[0], x.y + m.y * v[1], x.z + m.z * v[2], x.w + m.w * v[3]);
  }
};
struct EpiU {
  bf16_t* u;
  __device__ __forceinline__ void operator()(int row, int col0, const f32x4& v) const {
    *(uint2*)(u + (size_t)row * 5632 + col0) = make_uint2(pack2(v[0], v[1]), pack2(v[2], v[3]));
  }
};
struct EpiY {
  const Params* p; int half;
  __device__ __forceinline__ void operator()(int row, int col0, const f32x4& v) const {
    const int grow = half * 8192 + row;
    float4* dst = (float4*)(p->out + (size_t)grow * D + col0);
    const float4 x = *dst;
    const float4 m = *(const float4*)((const float*)(p->ws + OFF_MOD) + modidx(grow) * 6144 + 5 * 1024 + col0);
    *dst = make_float4(x.x + m.x * v[0], x.y + m.y * v[1], x.z + m.z * v[2], x.w + m.w * v[3]);
  }
};

__device__ __forceinline__ void token_item(const Params& p, int item) {
  const int tid = ltid(), lane = tid & 63, wid = tid >> 6;
  const float* proj = (const float*)(p.ws + OFF_PROJ);
  bf16_t* qa = (bf16_t*)(p.ws + OFF_QA);
  bf16_t* ckvn = (bf16_t*)(p.ws + OFF_CKVN);
  float* kpe = (float*)(p.ws + OFF_KPE);
  for (int tt = 0; tt < 16; ++tt) {
    const int token = item * 64 + wid * 16 + tt;
    const float* pr = proj + (size_t)token * 672;
    float2 q[3];
    float ss = 0.f;
#pragma unroll
    for (int i = 0; i < 3; ++i) { q[i] = *(const float2*)(pr + lane * 2 + 128 * i); ss += q[i].x * q[i].x + q[i].y * q[i].y; }
    ss = wave_sum(ss);
    const float r = rsqrtf(ss * (1.f / 384.f) + 1e-6f);
#pragma unroll
    for (int i = 0; i < 3; ++i) {
      const int e = lane * 2 + 128 * i;
      *(unsigned*)(qa + (size_t)token * 384 + e) = pack2(q[i].x * r * p.g_qa[e], q[i].y * r * p.g_qa[e + 1]);
    }
    const float4 kv = *(const float4*)(pr + 384 + lane * 4);
    float s2 = wave_sum(kv.x * kv.x + kv.y * kv.y + kv.z * kv.z + kv.w * kv.w);
    const float r2 = rsqrtf(s2 * (1.f / 256.f) + 1e-6f);
    const float4 g = *(const float4*)(p.g_kva + lane * 4);
    const float4 y = make_float4(kv.x * r2 * g.x, kv.y * r2 * g.y, kv.z * r2 * g.z, kv.w * r2 * g.w);
    *(uint2*)(ckvn + (size_t)token * 256 + lane * 4) = make_uint2(pack2(y.x, y.y), pack2(y.z, y.w));
    if (token < NCTX) *(float4*)(p.out + OUT_CKV + (size_t)token * 256 + lane * 4) = y;
    if (lane < 32) {
      const float kp = pr[640 + lane];
      kpe[(size_t)token * 32 + lane] = kp;
      if (token < NCTX) p.out[OUT_KPE + (size_t)token * 32 + lane] = kp;
    }
  }
}

template <int ORDER>
__device__ __forceinline__ void hyena_item(const Params& p, int grp, int c, char* smem) {
  const int tid = ltid(), lane = tid & 63, wid = tid >> 6, fr = lane & 15, fq = lane >> 4;
  const int n = grp ? SEQL : SEQC, nb = n >> 6, L = n;
  const bf16_t* Rrow = (const bf16_t*)(p.ws + (grp ? OFF_RLAT : OFF_RCTX)) + (size_t)(ORDER * 512 + c) * (2 * n);
  const bf16_t* hyT = (const bf16_t*)(p.ws + OFF_HYT);
  bf16_t* sU = (bf16_t*)smem;
  unsigned* sR0 = (unsigned*)(smem + 18432);
  unsigned* sR1 = (unsigned*)(smem + 18432 + 16384);
  const int tok0 = grp * 8192;
  __syncthreads();
  for (int ch = tid; ch < (2 * n) / 8; ch += 256) *(uint4*)((bf16_t*)sR0 + ch * 8) = *(const uint4*)(Rrow + ch * 8);
  if (ORDER == 0) {
    const bf16_t* raw = hyT + (size_t)c * NTOK + tok0;
    const float w0 = p.hy_conv_w[c], w1 = p.hy_conv_w[1536 + c], w2 = p.hy_conv_w[3072 + c], b = p.hy_conv_b[c];
    for (int ch = tid; ch < 1024; ch += 256) {
      const int t = ch * 8, pos = t & (L - 1);
      const uint4 rv = *(const uint4*)(raw + t);
      float x[10];
      x[0] = pos == 0 ? 0.f : bf2f(raw[t - 1]);
      x[1] = bflo(rv.x); x[2] = bfhi(rv.x); x[3] = bflo(rv.y); x[4] = bfhi(rv.y);
      x[5] = bflo(rv.z); x[6] = bfhi(rv.z); x[7] = bflo(rv.w); x[8] = bfhi(rv.w);
      x[9] = (pos + 8 == L) ? 0.f : bf2f(raw[t + 8]);
      float u[8];
#pragma unroll
      for (int i = 0; i < 8; ++i) u[i] = w0 * x[i] + w1 * x[i + 1] + w2 * x[i + 2] + b;
      *(uint4*)(sU + (ch >> 3) * 64 + (((ch & 7) ^ ((ch >> 3) & 7)) * 8)) = make_uint4(pack2(u[0], u[1]), pack2(u[2], u[3]), pack2(u[4], u[5]), pack2(u[6], u[7]));
    }
  } else {
    const bf16_t* zr = (const bf16_t*)(p.ws + OFF_ZT) + (size_t)c * NTOK + tok0;
    for (int ch = tid; ch < 1024; ch += 256) *(uint4*)(sU + (ch >> 3) * 64 + (((ch & 7) ^ ((ch >> 3) & 7)) * 8)) = *(const uint4*)(zr + ch * 8);
  }
  __syncthreads();
  for (int k = tid; k < n; k += 256) {
    const unsigned a = sR0[k], b2 = (k + 1 < n) ? sR0[k + 1] : 0u;
    sR1[k] = (a >> 16) | (b2 << 16);
  }
  __syncthreads();

  f32x4 acc[4][2];
#pragma unroll
  for (int m = 0; m < 4; ++m) { acc[m][0] = (f32x4){0.f, 0.f, 0.f, 0.f}; acc[m][1] = (f32x4){0.f, 0.f, 0.f, 0.f}; }
  const unsigned* abase = (fr & 1) ? (sR0 + ((n - 1 - fr) >> 1) + 4 * fq) : (sR1 + ((n - 2 - fr) >> 1) + 4 * fq);
  const int col0 = 32 * wid + fr, col1 = col0 + 16;
  const int i0 = col0 & (nb - 1), i1 = col1 & (nb - 1);
  for (int d = -(nb - 1); d <= nb - 1; ++d) {
    const bool v0 = (unsigned)(i0 - d) < (unsigned)nb, v1 = (unsigned)(i1 - d) < (unsigned)nb;
    const bool any0 = __ballot(v0) != 0ull, any1 = __ballot(v1) != 0ull;
    if (!any0 && !any1) continue;
    bf16x8 F[6];
    const unsigned* ap = abase - 32 * d + 16;
#pragma unroll
    for (int idx = 0; idx < 6; ++idx) {
      const unsigned* q = ap - 8 * idx;
      union { unsigned u[4]; bf16x8 v; } cv;
      cv.u[0] = q[0]; cv.u[1] = q[1]; cv.u[2] = q[2]; cv.u[3] = q[3];
      F[idx] = cv.v;
    }
#pragma unroll
    for (int nt = 0; nt < 2; ++nt) {
      if (!(nt ? any1 : any0)) continue;
      const bool vv = nt ? v1 : v0;
      const int srow = (nt ? col1 : col0) - d;
      const bf16_t* up = sU + srow * 64;
#pragma unroll
      for (int ks = 0; ks < 2; ++ks) {
        bf16x8 bf = (bf16x8){0, 0, 0, 0, 0, 0, 0, 0};
        if (vv) bf = *(const bf16x8*)(up + (((ks * 4 + fq) ^ (srow & 7)) * 8));
#pragma unroll
        for (int m = 0; m < 4; ++m)
          acc[m][nt] = __builtin_amdgcn_mfma_f32_16x16x32_bf16(F[m + 2 - 2 * ks], bf, acc[m][nt], 0, 0, 0);
      }
    }
  }
  const float skip = p.filt_bias[ORDER * 512 + c];
  const int gcol = (ORDER == 0 ? 512 : 1024) + c;
  const bf16_t* graw = hyT + (size_t)gcol * NTOK + tok0;
  const float w0 = p.hy_conv_w[gcol], w1 = p.hy_conv_w[1536 + gcol], w2 = p.hy_conv_w[3072 + gcol], b = p.hy_conv_b[gcol];
  bf16_t* outT = (bf16_t*)(p.ws + (ORDER == 0 ? OFF_ZT : OFF_Y2T)) + (size_t)c * NTOK + tok0;
#pragma unroll
  for (int nt = 0; nt < 2; ++nt) {
    const int col = nt ? col1 : col0;
#pragma unroll
    for (int m = 0; m < 4; ++m) {
      const int t = col * 64 + 16 * m + 4 * fq, pos = t & (L - 1);
      const uint2 uu = *(const uint2*)(sU + col * 64 + (((2 * m + (fq >> 1)) ^ (col & 7)) * 8) + 4 * (fq & 1));
      const uint2 gv = *(const uint2*)(graw + t);
      float x[6];
      x[0] = pos == 0 ? 0.f : bf2f(graw[t - 1]);
      x[1] = bflo(gv.x); x[2] = bfhi(gv.x); x[3] = bflo(gv.y); x[4] = bfhi(gv.y);
      x[5] = (pos + 4 == L) ? 0.f : bf2f(graw[t + 4]);
      const float u4[4] = {bflo(uu.x), bfhi(uu.x), bflo(uu.y), bfhi(uu.y)};
      float o[4];
#pragma unroll
      for (int j = 0; j < 4; ++j) {
        const float gate = w0 * x[j] + w1 * x[j + 1] + w2 * x[j + 2] + b;
        o[j] = gate * (acc[m][nt][j] + skip * u4[j]);
      }
      *(uint2*)(outT + t) = make_uint2(pack2(o[0], o[1]), pack2(o[2], o[3]));
    }
  }
}

__device__ __forceinline__ void rope32(float* y  , int pos) {
  const float prow = (float)(pos >> 6), pcol = (float)(pos & 63);
  const float fr[8] = {1.f, 0.31622776601683794f, 0.1f, 0.031622776601683794f, 0.01f, 0.0031622776601683794f, 0.001f, 0.00031622776601683794f};
#pragma unroll
  for (int i = 0; i < 8; ++i) {
    const float tr = prow * fr[i] * 0.15915494309189535f, tc = pcol * fr[i] * 0.15915494309189535f;
    const float sr = sin_turns(tr), cr = cos_turns(tr), sc = sin_turns(tc), cc = cos_turns(tc);
    const float a = y[i], b = y[8 + i], c2 = y[16 + i], d2 = y[24 + i];
    y[i] = a * cr - b * sr; y[8 + i] = b * cr + a * sr;
    y[16 + i] = c2 * cc - d2 * sc; y[24 + i] = d2 * cc + c2 * sc;
  }
}
__device__ __forceinline__ void unpack8(const uint4& v, float* x) {
  x[0] = bflo(v.x); x[1] = bfhi(v.x); x[2] = bflo(v.y); x[3] = bfhi(v.y);
  x[4] = bflo(v.z); x[5] = bfhi(v.z); x[6] = bflo(v.w); x[7] = bfhi(v.w);
}
__device__ __forceinline__ float sumsq8(const uint4& v) {
  float x[8];
  unpack8(v, x);
  return x[0] * x[0] + x[1] * x[1] + x[2] * x[2] + x[3] * x[3] + x[4] * x[4] + x[5] * x[5] + x[6] * x[6] + x[7] * x[7];
}
__device__ __forceinline__ uint4 scale8(const uint4& v, float r, const float* __restrict__ g) {
  float x[8];
  unpack8(v, x);
  const float4 g0 = *(const float4*)g, g1 = *(const float4*)(g + 4);
  return make_uint4(pack2(x[0] * r * g0.x, x[1] * r * g0.y), pack2(x[2] * r * g0.z, x[3] * r * g0.w),
                    pack2(x[4] * r * g1.x, x[5] * r * g1.y), pack2(x[6] * r * g1.z, x[7] * r * g1.w));
}
__device__ __forceinline__ void qk_item(const Params& p, int item) {
  const int tid = ltid();
  if (item < 512) {
    const int idx = item * 256 + tid, row = idx >> 3, h = idx & 7;
    const bf16_t* src = (const bf16_t*)(p.ws + OFF_QRAW) + (size_t)row * 768 + h * 96;
    bf16_t* dst = (bf16_t*)(p.ws + OFF_Q) + (size_t)row * 768 + h * 96;
    uint4 raw[12];
#pragma unroll
    for (int i = 0; i < 12; ++i) raw[i] = *(const uint4*)(src + 8 * i);
    float ss = 0.f;
#pragma unroll
    for (int i = 0; i < 12; ++i) ss += sumsq8(raw[i]);
    const float r = rsqrtf(ss * (1.f / 96.f) + 1e-6f);
    const float qs = 0.10206207261596575f * 1.4426950408889634f;
#pragma unroll
    for (int i = 0; i < 8; ++i) *(uint4*)(dst + 8 * i) = scale8(raw[i], r * qs, p.g_q + 8 * i);
    float y[32];
#pragma unroll
    for (int i = 0; i < 4; ++i) unpack8(raw[8 + i], y + 8 * i);
#pragma unroll
    for (int i = 0; i < 32; ++i) y[i] = y[i] * r * p.g_q[64 + i];
    if (row >= NCTX) rope32(y, (row - NCTX) & 4095);
#pragma unroll
    for (int i = 0; i < 4; ++i)
      *(uint4*)(dst + 64 + 8 * i) = make_uint4(pack2(y[8 * i] * qs, y[8 * i + 1] * qs), pack2(y[8 * i + 2] * qs, y[8 * i + 3] * qs),
                                               pack2(y[8 * i + 4] * qs, y[8 * i + 5] * qs), pack2(y[8 * i + 6] * qs, y[8 * i + 7] * qs));
  } else {
    const int idx = (item - 512) * 256 + tid, row = idx >> 3, h = idx & 7;
    const bf16_t* src = (const bf16_t*)(p.ws + OFF_KRAW) + (size_t)row * 512 + h * 64;
    uint4 raw[8];
#pragma unroll
    for (int i = 0; i < 8; ++i) raw[i] = *(const uint4*)(src + 8 * i);
    const float* kp = row < NTOK ? (const float*)(p.ws + OFF_KPE) + (size_t)row * 32 : p.cache_kpe + (size_t)(row - NTOK) * 32;
    float y[32];
#pragma unroll
    for (int i = 0; i < 8; ++i) {
      const float4 v = *(const float4*)(kp + 4 * i);
      y[4 * i] = v.x; y[4 * i + 1] = v.y; y[4 * i + 2] = v.z; y[4 * i + 3] = v.w;
    }
    float ss = 0.f;
#pragma unroll
    for (int i = 0; i < 8; ++i) ss += sumsq8(raw[i]);
#pragma unroll
    for (int i = 0; i < 32; ++i) ss += y[i] * y[i];
    const float r = rsqrtf(ss * (1.f / 96.f) + 1e-6f);
#pragma unroll
    for (int i = 0; i < 32; ++i) y[i] = y[i] * r * p.g_k[64 + i];
    bf16_t* dst;
    if (row < NCTX) dst = (bf16_t*)(p.ws + OFF_KC) + ((size_t)((row >> 8) * 8 + h) * 256 + (row & 255)) * 96;
    else if (row < NTOK) {
      const int rr = row - NCTX;
      rope32(y, rr & 4095);
      dst = (bf16_t*)(p.ws + OFF_KL) + ((size_t)((rr >> 12) * 8 + h) * 4608 + (rr & 4095)) * 96;
    } else {
      const int rr = row - NTOK;
      dst = (bf16_t*)(p.ws + OFF_KL) + ((size_t)((rr >> 9) * 8 + h) * 4608 + 4096 + (rr & 511)) * 96;
    }
#pragma unroll
    for (int i = 0; i < 8; ++i) *(uint4*)(dst + 8 * i) = scale8(raw[i], r, p.g_k + 8 * i);
#pragma unroll
    for (int i = 0; i < 4; ++i)
      *(uint4*)(dst + 64 + 8 * i) = make_uint4(pack2(y[8 * i], y[8 * i + 1]), pack2(y[8 * i + 2], y[8 * i + 3]),
                                               pack2(y[8 * i + 4], y[8 * i + 5]), pack2(y[8 * i + 6], y[8 * i + 7]));
  }
}

__device__ __forceinline__ void attn_item(const Params& p, int item, char* smem) {
  const int tid = ltid(), lane = tid & 63, wid = tid >> 6, lr = lane & 31, lh = lane >> 5;
  int nkeys, h, tokbase; const bf16_t *Kp, *Vp;
  if (item < 512) {
    const int b = item >> 8, rem = item & 255; h = rem >> 5; const int qb = rem & 31;
    nkeys = 4608; tokbase = NCTX + b * 4096 + qb * 128;
    Kp = (const bf16_t*)(p.ws + OFF_KL) + (size_t)(b * 8 + h) * 4608 * 96;
    Vp = (const bf16_t*)(p.ws + OFF_VTL) + (size_t)(b * 8 + h) * 64 * 4608;
  } else {
    const int it = item - 512, b = it >> 4; h = (it & 15) >> 1; const int qb = it & 1;
    nkeys = 256; tokbase = b * 256 + qb * 128;
    Kp = (const bf16_t*)(p.ws + OFF_KC) + (size_t)(b * 8 + h) * 256 * 96;
    Vp = (const bf16_t*)(p.ws + OFF_VTC) + (size_t)(b * 8 + h) * 64 * 256;
  }
  bf16_t* sK = (bf16_t*)smem;
  bf16_t* sV = sK + 64 * 104;
  const int token = tokbase + 32 * wid + lr;
  const bf16_t* qsrc = (const bf16_t*)(p.ws + OFF_Q) + (size_t)token * 768 + h * 96 + 8 * lh;
  bf16x8 qf[6];
#pragma unroll
  for (int ks = 0; ks < 6; ++ks) qf[ks] = *(const bf16x8*)(qsrc + 16 * ks);
  f32x16 oacc[2];
#pragma unroll
  for (int j = 0; j < 16; ++j) { oacc[0][j] = 0.f; oacc[1][j] = 0.f; }
  float mrun = -1e30f, lsum = 0.f;
  const int kk0 = tid / 12, kc0 = tid % 12, kk1 = (tid + 256) / 12, kc1 = (tid + 256) % 12, kk2 = (tid + 512) / 12, kc2 = (tid + 512) % 12;
  const int vd0 = tid >> 3, vc0 = tid & 7, vd1 = vd0 + 32;
  const bf16_t* gk0 = Kp + (size_t)kk0 * 96 + kc0 * 8;
  const bf16_t* gk1 = Kp + (size_t)kk1 * 96 + kc1 * 8;
  const bf16_t* gk2 = Kp + (size_t)kk2 * 96 + kc2 * 8;
  const bf16_t* gv0 = Vp + (size_t)vd0 * nkeys + vc0 * 8;
  const bf16_t* gv1 = Vp + (size_t)vd1 * nkeys + vc0 * 8;
  uint4 rk0 = *(const uint4*)gk0, rk1 = *(const uint4*)gk1, rk2 = *(const uint4*)gk2;
  uint4 rv0 = *(const uint4*)gv0, rv1 = *(const uint4*)gv1;
  const int nt = nkeys >> 6;
  for (int kt = 0; kt < nt; ++kt) {
    __syncthreads();
    *(uint4*)(sK + kk0 * 104 + kc0 * 8) = rk0; *(uint4*)(sK + kk1 * 104 + kc1 * 8) = rk1; *(uint4*)(sK + kk2 * 104 + kc2 * 8) = rk2;
    *(uint4*)(sV + vd0 * 72 + vc0 * 8) = rv0; *(uint4*)(sV + vd1 * 72 + vc0 * 8) = rv1;
    __syncthreads();
    if (kt + 1 < nt) {
      gk0 += 64 * 96; gk1 += 64 * 96; gk2 += 64 * 96; gv0 += 64; gv1 += 64;
      rk0 = *(const uint4*)gk0; rk1 = *(const uint4*)gk1; rk2 = *(const uint4*)gk2;
      rv0 = *(const uint4*)gv0; rv1 = *(const uint4*)gv1;
    }
    __builtin_amdgcn_sched_barrier(0);
    f32x16 sacc[2];
#pragma unroll
    for (int kb = 0; kb < 2; ++kb) {
#pragma unroll
      for (int j = 0; j < 16; ++j) sacc[kb][j] = 0.f;
#pragma unroll
      for (int ks = 0; ks < 6; ++ks) {
        const bf16x8 a = *(const bf16x8*)(sK + (32 * kb + lr) * 104 + 16 * ks + 8 * lh);
        sacc[kb] = __builtin_amdgcn_mfma_f32_32x32x16_bf16(a, qf[ks], sacc[kb], 0, 0, 0);
      }
    }
    float mx = sacc[0][0];
#pragma unroll
    for (int j = 1; j < 16; ++j) mx = fmaxf(mx, sacc[0][j]);
#pragma unroll
    for (int j = 0; j < 16; ++j) mx = fmaxf(mx, sacc[1][j]);
    mx = fmaxf(mx, __shfl_xor(mx, 32));
    const float mnew = fmaxf(mrun, mx);
    const float alpha = __builtin_amdgcn_exp2f(mrun - mnew);
    mrun = mnew;
    float ps = 0.f;
#pragma unroll
    for (int kb = 0; kb < 2; ++kb)
#pragma unroll
      for (int j = 0; j < 16; ++j) { const float e = __builtin_amdgcn_exp2f(sacc[kb][j] - mnew); sacc[kb][j] = e; ps += e; }
    lsum = lsum * alpha + ps;
    if (__ballot(alpha != 1.f) != 0ull) {
#pragma unroll
      for (int j = 0; j < 16; ++j) { oacc[0][j] *= alpha; oacc[1][j] *= alpha; }
    }
#pragma unroll
    for (int s = 0; s < 4; ++s) {
      const int kb = s >> 1, jb = 8 * (s & 1);
      union { unsigned u[4]; bf16x8 v; } pf;
      pf.u[0] = pack2(sacc[kb][jb + 0], sacc[kb][jb + 1]); pf.u[1] = pack2(sacc[kb][jb + 2], sacc[kb][jb + 3]);
      pf.u[2] = pack2(sacc[kb][jb + 4], sacc[kb][jb + 5]); pf.u[3] = pack2(sacc[kb][jb + 6], sacc[kb][jb + 7]);
#pragma unroll
      for (int mt = 0; mt < 2; ++mt) {
        const bf16_t* vp = sV + (32 * mt + lr) * 72 + 16 * s + 4 * lh;
        union { uint2 d[2]; bf16x8 v; } av;
        av.d[0] = *(const uint2*)vp;
        av.d[1] = *(const uint2*)(vp + 8);
        oacc[mt] = __builtin_amdgcn_mfma_f32_32x32x16_bf16(av.v, pf.v, oacc[mt], 0, 0, 0);
      }
    }
  }
  lsum += __shfl_xor(lsum, 32);
  const float inv = 1.f / lsum;
  bf16_t* dst = (bf16_t*)(p.ws + OFF_ATTN) + (size_t)token * 512 + h * 64;
#pragma unroll
  for (int mt = 0; mt < 2; ++mt)
#pragma unroll
    for (int jg = 0; jg < 4; ++jg) {
      const int dv0 = 32 * mt + 8 * jg + 4 * lh;
      *(uint2*)(dst + dv0) = make_uint2(pack2(oacc[mt][4 * jg] * inv, oacc[mt][4 * jg + 1] * inv),
                                        pack2(oacc[mt][4 * jg + 2] * inv, oacc[mt][4 * jg + 3] * inv));
    }
}

__device__ __forceinline__ void merge_item(const Params& p, int item, char* smem) {
  const int tid = ltid(), lane = tid & 63, wid = tid >> 6, t0 = item * 32;
  bf16_t* mix = (bf16_t*)(p.ws + OFF_H);
  const bf16_t* attn = (const bf16_t*)(p.ws + OFF_ATTN);
  for (int tt = 0; tt < 8; ++tt) {
    const int token = t0 + wid * 8 + tt;
    float x[8];
    unpack8(*(const uint4*)(attn + (size_t)token * 512 + lane * 8), x);
    float ss = 0.f;
#pragma unroll
    for (int i = 0; i < 8; ++i) ss += x[i] * x[i];
    ss = wave_sum(ss);
    const float r = rsqrtf(ss * (1.f / 512.f) + 1e-6f);
    const float4 g0 = *(const float4*)(p.g_out_att + lane * 8), g1 = *(const float4*)(p.g_out_att + lane * 8 + 4);
    *(uint4*)(mix + (size_t)token * D + lane * 8) =
        make_uint4(pack2(x[0] * r * g0.x, x[1] * r * g0.y), pack2(x[2] * r * g0.z, x[3] * r * g0.w),
                   pack2(x[4] * r * g1.x, x[5] * r * g1.y), pack2(x[6] * r * g1.z, x[7] * r * g1.w));
  }
  bf16_t* sT = (bf16_t*)smem;
  const bf16_t* y2T = (const bf16_t*)(p.ws + OFF_Y2T);
  __syncthreads();
  for (int ch = tid; ch < 2048; ch += 256) {
    const int c = ch >> 2, q4 = ch & 3;
    const uint4 v = *(const uint4*)(y2T + (size_t)c * NTOK + t0 + q4 * 8);
    bf16_t* d = sT + (q4 * 8) * 520 + c;
    d[0 * 520] = (bf16_t)(v.x & 0xffff); d[1 * 520] = (bf16_t)(v.x >> 16);
    d[2 * 520] = (bf16_t)(v.y & 0xffff); d[3 * 520] = (bf16_t)(v.y >> 16);
    d[4 * 520] = (bf16_t)(v.z & 0xffff); d[5 * 520] = (bf16_t)(v.z >> 16);
    d[6 * 520] = (bf16_t)(v.w & 0xffff); d[7 * 520] = (bf16_t)(v.w >> 16);
  }
  __syncthreads();
  {
    const int tt = tid >> 3, part = tid & 7;
    uint4 v[8];
    float ss = 0.f;
#pragma unroll
    for (int i = 0; i < 8; ++i) {
      v[i] = *(const uint4*)(sT + tt * 520 + part * 64 + 8 * i);
      float x[8];
      unpack8(v[i], x);
#pragma unroll
      for (int e = 0; e < 8; ++e) ss += x[e] * x[e];
    }
    ss += __shfl_xor(ss, 1); ss += __shfl_xor(ss, 2); ss += __shfl_xor(ss, 4);
    const float r = rsqrtf(ss * (1.f / 512.f) + 1e-6f);
#pragma unroll
    for (int i = 0; i < 8; ++i) {
      float x[8];
      unpack8(v[i], x);
      const int c0 = part * 64 + 8 * i;
      const float4 g0 = *(const float4*)(p.g_out_hy + c0), g1 = *(const float4*)(p.g_out_hy + c0 + 4);
      *(uint4*)(mix + (size_t)(t0 + tt) * D + 512 + c0) =
          make_uint4(pack2(x[0] * r * g0.x, x[1] * r * g0.y), pack2(x[2] * r * g0.z, x[3] * r * g0.w),
                     pack2(x[4] * r * g1.x, x[5] * r * g1.y), pack2(x[6] * r * g1.z, x[7] * r * g1.w));
    }
  }
}

__device__ __forceinline__ void actfix_item(const Params& p, int item) {
  const int idx = item * 256 + ltid();
  if (idx >= 512 * 352) return;
  const int j = (idx % 352) * 8, rowi = idx / 352, wt = rowi >> 1, which = rowi & 1;
  const int t = 64 * wt + 63 * which, L = t < NCTX ? SEQC : SEQL, pos = t & (L - 1);
  const bf16_t* edge = (const bf16_t*)(p.ws + OFF_EDGE);
  bf16_t* act = (bf16_t*)(p.ws + OFF_U);
  const bf16_t *pr, *cu, *nx;
  bool zp = false, zn = false;
  if (which == 0) { zp = pos == 0; pr = edge + (size_t)((zp ? wt : wt - 1) * 4 + 3) * 5632; cu = edge + (size_t)(wt * 4 + 0) * 5632; nx = edge + (size_t)(wt * 4 + 1) * 5632; }
  else { zn = pos == L - 1; pr = edge + (size_t)(wt * 4 + 2) * 5632; cu = edge + (size_t)(wt * 4 + 3) * 5632; nx = edge + (size_t)((zn ? wt : wt + 1) * 4 + 0) * 5632; }
  float pa[8], pg[8], ca[8], cgv[8], na[8], ng[8];
  unpack8(*(const uint4*)(pr + j), pa); unpack8(*(const uint4*)(pr + 2816 + j), pg);
  unpack8(*(const uint4*)(cu + j), ca); unpack8(*(const uint4*)(cu + 2816 + j), cgv);
  unpack8(*(const uint4*)(nx + j), na); unpack8(*(const uint4*)(nx + 2816 + j), ng);
  float o[8];
#pragma unroll
  for (int e = 0; e < 8; ++e) {
    const float pae = zp ? 0.f : pa[e], pge = zp ? 0.f : pg[e], nae = zn ? 0.f : na[e], nge = zn ? 0.f : ng[e];
    const float a = p.ffn_conv_w[j + e] * pae + p.ffn_conv_w[5632 + j + e] * ca[e] + p.ffn_conv_w[11264 + j + e] * nae + p.ffn_conv_b[j + e];
    const float g = p.ffn_conv_w[2816 + j + e] * pge + p.ffn_conv_w[5632 + 2816 + j + e] * cgv[e] + p.ffn_conv_w[11264 + 2816 + j + e] * nge + p.ffn_conv_b[2816 + j + e];
    o[e] = a * __builtin_amdgcn_rcpf(1.f + __expf(-a)) * g;
  }
  *(uint4*)(act + (size_t)t * 2816 + j) = make_uint4(pack2(o[0], o[1]), pack2(o[2], o[3]), pack2(o[4], o[5]), pack2(o[6], o[7]));
}

#define XB_TMO      128
#define XB_XCNT(j)  (256  + 64 * (j))
#define XB_XSUB(j)  (1280 + 64 * (j))
#define XB_XGEN(j)  (2304 + 64 * (j))
#define XB_TOP      3328
#define XB_TOPGEN   3392
#define XCD_BAR_WORDS 3456
#define XB_SPIN_CAP (1u << 20)
#define LAS __attribute__((address_space(3)))
__device__ __forceinline__ unsigned xb_ld(unsigned* p) { return __hip_atomic_load(p, __ATOMIC_RELAXED, __HIP_MEMORY_SCOPE_AGENT); }
__device__ __forceinline__ unsigned xb_add(unsigned* p, unsigned v) { return __hip_atomic_fetch_add(p, v, __ATOMIC_RELAXED, __HIP_MEMORY_SCOPE_AGENT); }
__device__ __forceinline__ unsigned xb_xcc_id() { return (unsigned)__builtin_amdgcn_s_getreg((3 << 11) | 20) & 0xFu; }
#define XB_SPIN(cond, bar) do { unsigned _sp = 0; while (cond) { __builtin_amdgcn_s_sleep(1); \
    if ((++_sp & 255u) == 0u) { if (xb_ld(&(bar)[XB_TMO])) break; if (_sp > XB_SPIN_CAP) { atomicAdd(&(bar)[XB_TMO], 1u); break; } } } } while (0)
struct XcdBarrier { unsigned* bar; unsigned x; volatile LAS unsigned* st; };
__device__ __forceinline__ XcdBarrier xcd_barrier_post(unsigned* bar, volatile LAS unsigned* st) {
  XcdBarrier b; b.bar = bar; b.x = xb_xcc_id(); b.st = st;
  if (threadIdx.x == 0) (void)xb_add(&bar[XB_XCNT(b.x)], 1u);
  return b;
}
__device__ __forceinline__ void xcd_barrier_complete(unsigned* bar, unsigned x, unsigned& nloc, unsigned& nx) {
  const unsigned G = gridDim.x * gridDim.y * gridDim.z;
  unsigned sum, cnt, mine, sp = 0u;
  for (;;) {
    sum = 0u; cnt = 0u; mine = 0u;
#pragma unroll
    for (unsigned j = 0; j < 16; ++j) { const unsigned c = xb_ld(&bar[XB_XCNT(j)]); sum += c; cnt += (c > 0u) ? 1u : 0u; mine = (j == x) ? c : mine; }
    if (sum == G) break;
    __builtin_amdgcn_s_sleep(1);
    if ((++sp & 255u) == 0u) { if (xb_ld(&bar[XB_TMO])) break; if (sp > XB_SPIN_CAP) { atomicAdd(&bar[XB_TMO], 1u); break; } }
  }
  nloc = mine > 0u ? mine : 1u; nx = cnt > 0u ? cnt : 1u;
}
__device__ __forceinline__ void xcd_barrier(const XcdBarrier& b) {
  asm volatile("s_waitcnt vmcnt(0)" ::: "memory");
  __syncthreads();
  if (threadIdx.x == 0) {
    unsigned* bar = b.bar;
    __builtin_amdgcn_s_waitcnt(0);
    unsigned nloc = b.st[0], nx = b.st[1];
    if (nloc == 0u) { xcd_barrier_complete(bar, b.x, nloc, nx); b.st[0] = nloc; b.st[1] = nx; }
    const unsigned old = xb_add(&bar[XB_XSUB(b.x)], 1u);
    const unsigned gen = old / nloc;
    if (old + 1u == (gen + 1u) * nloc) {
      __builtin_amdgcn_fence(__ATOMIC_RELEASE, "agent");
      asm volatile("s_waitcnt vmcnt(0)" ::: "memory");
      const unsigned og = xb_add(&bar[XB_TOP], 1u);
      const unsigned tg = og / nx;
      if (og + 1u == (tg + 1u) * nx) xb_add(&bar[XB_TOPGEN], 1u);
      else XB_SPIN(xb_ld(&bar[XB_TOPGEN]) == tg, bar);
      __builtin_amdgcn_fence(__ATOMIC_ACQUIRE, "agent");
      xb_add(&bar[XB_XGEN(b.x)], 1u);
      asm volatile("s_waitcnt vmcnt(0)" ::: "memory");
    } else {
      XB_SPIN(xb_ld(&bar[XB_XGEN(b.x)]) == gen, bar);
      __builtin_amdgcn_fence(__ATOMIC_ACQUIRE, "agent");
      asm volatile("s_waitcnt vmcnt(0)" ::: "memory");
    }
  }
  __syncthreads();
}
constexpr size_t OFF_BAR = 25 * MiB - 16384;
static_assert(OFF_MOD + 3 * 6144 * 4 <= OFF_BAR, "bar");

template <int ph>
__device__ __forceinline__ void run_phase(const Params& p, char* smem) {
  const int bid = blockIdx.x, G = gridDim.x;
  char* ws = p.ws;
  if constexpr (ph == 0) {
    for (int it = bid; it < 272 + 96 + 32 + 3080; it += G) {
      if (it < 272) filter_item(p, it, smem);
      else if (it < 368) mod_item(p, it - 272, smem);
      else if (it < 400) cache_item(p, it - 368);
      else {
        int t = it - 400;
        if (t < 576) transpose_item(p.w_in, 1024, DIN, (bf16_t*)(ws + OFF_WIN), t, 36, smem);
        else if ((t -= 576) < 72) transpose_item(p.w_uq, 384, 768, (bf16_t*)(ws + OFF_WUQ), t, 12, smem);
        else if ((t -= 72) < 64) transpose_item(p.w_ukv, 256, 1024, (bf16_t*)(ws + OFF_WUKV), t, 16, smem);
        else if ((t -= 64) < 256) transpose_item(p.w_out, 1024, 1024, (bf16_t*)(ws + OFF_WOUT), t, 16, smem);
        else if ((t -= 256) < 1408) transpose_item(p.w_up, 1024, 5632, (bf16_t*)(ws + OFF_WUP), t, 88, smem, true);
        else { t -= 1408; transpose_item(p.w_down, 2816, 1024, (bf16_t*)(ws + OFF_WDOWN), t, 16, smem); }
      }
    }
  } else if constexpr (ph == 1) {
    rmsmod_phase<0>(p);
  } else if constexpr (ph == 2) {
    EpiIn epi{(float*)(ws + OFF_PROJ), (bf16_t*)(ws + OFF_HYT)};
    EpiProj epr{(float*)(ws + OFF_PROJ)};
    for (int t = bid; t < 128 * 18; t += G) {
      const int nt = t % 18;
      if (nt < 5) gemm_tile<true>((const bf16_t*)(ws + OFF_H), 1024, (const bf16_t*)(ws + OFF_WIN), 1024, 1024, (t / 18) * 128, nt * 128, smem, epr);
      else gemm_tile<false>((const bf16_t*)(ws + OFF_H), 1024, (const bf16_t*)(ws + OFF_WIN), 1024, 1024, (t / 18) * 128, nt * 128, smem, epi);
    }
  } else if constexpr (ph == 3) {
    for (int it = bid; it < 512; it += G) hyena_item<0>(p, 1, it, smem);
    for (int it = bid; it < 512; it += G) hyena_item<0>(p, 0, it, smem);
    for (int it = bid; it < 256; it += G) token_item(p, it);
  } else if constexpr (ph == 4) {
    EpiQ eq{(bf16_t*)(ws + OFF_QRAW)};
    EpiKV ekv{(bf16_t*)(ws + OFF_KRAW), (bf16_t*)(ws + OFF_VTC), (bf16_t*)(ws + OFF_VTL)};
    for (int it = bid; it < 512; it += G) hyena_item<1>(p, 1, it, smem);
    for (int t = bid; t < 768; t += G) gemm_tile<true>((const bf16_t*)(ws + OFF_QA), 384, (const bf16_t*)(ws + OFF_WUQ), 384, 384, (t / 6) * 128, (t % 6) * 128, smem, eq);
    for (int t = bid; t < 1088; t += G) gemm_tile<false>((const bf16_t*)(ws + OFF_CKVN), 256, (const bf16_t*)(ws + OFF_WUKV), 256, 256, (t / 8) * 128, (t % 8) * 128, smem, ekv);
    for (int it = bid; it < 512; it += G) hyena_item<1>(p, 0, it, smem);
  } else if constexpr (ph == 5) {
    for (int it = bid; it < 512 + 544; it += G) qk_item(p, it);
  } else if constexpr (ph == 6) {
    for (int it = bid; it < 1024; it += G) attn_item(p, it, smem);
  } else if constexpr (ph == 7) {
    for (int it = bid; it < 512; it += G) merge_item(p, it, smem);
  } else if constexpr (ph == 8) {
    EpiOut epi{&p};
    for (int t = bid; t < 128 * 8; t += G)
      gemm_tile<true>((const bf16_t*)(ws + OFF_H), 1024, (const bf16_t*)(ws + OFF_WOUT), 1024, 1024, (t / 8) * 128, (t % 8) * 128, smem, epi);
  } else if constexpr (ph == 9) {
    rmsmod_phase<1>(p);
  } else if constexpr (ph == 10) {
    for (int t = bid; t < 128 * 44; t += G) gemm_up_act_tile(p, (t / 44) * 128, (t % 44) * 128, smem);
  } else if constexpr (ph == 11) {
    for (int it = bid; it < 704; it += G) actfix_item(p, it);
  } else if constexpr (ph == 12) {
    EpiY epi{&p, 0};
    for (int t = bid; t < 128 * 8; t += G)
      gemm_tile<true>((const bf16_t*)(ws + OFF_U), 2816, (const bf16_t*)(ws + OFF_WDOWN), 2816, 2816, (t / 8) * 128, (t % 8) * 128, smem, epi);
  }
}

#if ONE_LAUNCH
template <int PH>
__device__ __forceinline__ void run_all(const Params& p, char* smem, cg::grid_group& grid, const XcdBarrier& xb) {
  run_phase<PH>(p, smem);
  if constexpr (((DBL_MASK >> PH) & 1) != 0) { xcd_barrier(xb); run_phase<PH>(p, smem); }
  if constexpr (PH < 12) {
    xcd_barrier(xb);
    run_all<PH + 1>(p, smem, grid, xb);
  }
}
constexpr int DYN_LDS = 65536 + 64;
__global__ void __launch_bounds__(256, 2) mega_kernel(Params p) {
  extern __shared__ __attribute__((aligned(16))) char smem[];
  uint4* xb_words = (uint4*)(smem + 65536);
  cg::grid_group grid = cg::this_grid();
  if (threadIdx.x == 0) *xb_words = make_uint4(0u, 0u, 0u, 0u);
  __syncthreads();
  XcdBarrier xb = xcd_barrier_post((unsigned*)(p.ws + OFF_BAR), (volatile LAS unsigned*)xb_words);
  if (p.ws == nullptr) grid.sync();
  run_all<0>(p, smem, grid, xb);
}
#else
template <int PH>
__global__ void __launch_bounds__(256, 2) phase_kernel(Params p) {
  __shared__ __attribute__((aligned(16))) char smem[SMEM_BYTES];
  run_phase<PH>(p, smem);
}
#ifndef DBG_STOP
#define DBG_STOP 15
#endif
__global__ void dump_kernel(Params p, size_t off, int count) {
  const bf16_t* src = (const bf16_t*)(p.ws + off);
  const bf16_t* src2 = (const bf16_t*)(p.ws + DBG_OFF2);
  for (int i = blockIdx.x * 256 + threadIdx.x; i < 16777216; i += gridDim.x * 256)
    p.out[i] = i < DBG_CNT ? bf2f(src[i]) : (i - DBG_CNT < DBG_CNT2 ? bf2f(src2[i - DBG_CNT]) : 0.f);
}
template <int PH>
static void launch_all(const Params& p, hipStream_t stream) {
  phase_kernel<PH><<<512, 256, 0, stream>>>(p);
  if constexpr (PH < 12) launch_all<PH + 1>(p, stream);
}
#endif

extern "C" void kernel_launch(void* const* d_in, const int* in_sizes, int n_in, void* d_out, int out_size, void* d_ws,
                              size_t ws_size, hipStream_t stream) {
  Params p{};
  const float** pp = (const float**)&p;
  for (int i = 0; i < 34; ++i) pp[i] = (const float*)d_in[i];
  p.out = (float*)d_out;
  p.ws = (char*)d_ws;
#if ONE_LAUNCH
  (void)hipMemsetAsync((char*)d_ws + OFF_BAR, 0, XCD_BAR_WORDS * 4, stream);
  static int grid_blocks = 0;
  if (!grid_blocks) {
    int dev = 0, cus = 0, per_cu = 0;
    hipGetDevice(&dev);
    hipDeviceGetAttribute(&cus, hipDeviceAttributeMultiprocessorCount, dev);
    (void)hipFuncSetAttribute((const void*)mega_kernel, hipFuncAttributeMaxDynamicSharedMemorySize, DYN_LDS);
    (void)hipOccupancyMaxActiveBlocksPerMultiprocessor(&per_cu, mega_kernel, 256, DYN_LDS);
    if (per_cu > 2) per_cu = 2;
    grid_blocks = cus * per_cu;
  }
  void* args[] = {&p};
  hipError_t e = hipLaunchCooperativeKernel((void*)mega_kernel, dim3(grid_blocks), dim3(256), args, DYN_LDS, stream);
  if (e != hipSuccess) fprintf(stderr, "cooperative launch failed: %s (grid %d)\n", hipGetErrorString(e), grid_blocks);
#else
  launch_all<0>(p, stream);
#if DBG_STOP < 15
  dump_kernel<<<1024, 256, 0, stream>>>(p, DBG_OFF, DBG_CNT);
#endif
#endif
}
```

```cpp
#include <hip/hip_runtime.h>
#include <hip/hip_cooperative_groups.h>
#include <cstdio>
namespace cg = cooperative_groups;

#define DBG_STOP 15
#define DBG_NOHY 0
#ifndef DBL_MASK
#define DBL_MASK 0
#endif
#define DBG_OFF OFF_QRAW
#define DBG_OFF2 OFF_KRAW
#define DBG_CNT 12582912
#define DBG_CNT2 0
#ifndef ONE_LAUNCH
#define ONE_LAUNCH 1
#endif

typedef unsigned short bf16_t;
typedef short bf16x8 __attribute__((ext_vector_type(8)));
typedef float f32x4 __attribute__((ext_vector_type(4)));
typedef float f32x16 __attribute__((ext_vector_type(16)));

constexpr int D = 1024, NTOK = 16384, NCTX = 8192, SEQC = 256, SEQL = 4096;
constexpr int DIN = 2208, DINP = 2304, QL = 384, KVL = 256, DFF = 2816;
constexpr int NROWKV = 17408;
constexpr size_t MiB = 1048576;

constexpr size_t OFF_WIN = 0;
constexpr size_t OFF_WUQ = OFF_WIN + (size_t)DINP * 1024 * 2;
constexpr size_t OFF_WUKV = OFF_WUQ + (size_t)768 * 384 * 2;
constexpr size_t OFF_WOUT = OFF_WUKV + (size_t)1024 * 256 * 2;
constexpr size_t OFF_WUP = OFF_WOUT + (size_t)1024 * 1024 * 2;
constexpr size_t OFF_WDOWN = OFF_WUP + (size_t)5632 * 1024 * 2;
constexpr size_t OFF_MOD = OFF_WDOWN + (size_t)1024 * 2816 * 2;
static_assert(OFF_MOD + 3 * 6144 * 4 <= 25 * MiB, "A region");
constexpr size_t OFF_RLAT = 25 * MiB;
constexpr size_t OFF_RCTX = 41 * MiB;
constexpr size_t OFF_H = 42 * MiB;
constexpr size_t OFF_ZT = 42 * MiB;
constexpr size_t OFF_QA = 58 * MiB;
constexpr size_t OFF_KPE = 70 * MiB;
constexpr size_t OFF_PROJ = 74 * MiB;
constexpr size_t OFF_QRAW = 74 * MiB;
constexpr size_t OFF_Y2T = 98 * MiB;
constexpr size_t OFF_ATTN = 74 * MiB;
constexpr size_t OFF_U = 74 * MiB;
constexpr size_t OFF_HYT = 116 * MiB;
constexpr size_t OFF_Q = 116 * MiB;
constexpr size_t OFF_KC = 140 * MiB;
constexpr size_t OFF_KL = 152 * MiB;
constexpr size_t OFF_CKVN = 164 * MiB;
constexpr size_t OFF_KRAW = 173 * MiB;
constexpr size_t OFF_VTC = 190 * MiB;
constexpr size_t OFF_VTL = 198 * MiB;
constexpr size_t OFF_ACT = 162 * MiB;

constexpr int OUT_YS = 0;
constexpr int OUT_CKV = 16777216;
constexpr int OUT_KPE = 16777216 + 2097152;

constexpr int SMEM_BYTES = 51200;

struct Params {
  const float *x_prompt, *x_sample, *cache_ckv, *cache_kpe, *c, *c_ctx, *w_ada, *b_ada, *g_mix, *w_in, *g_qa, *w_uq,
      *g_kva, *w_ukv, *g_q, *g_k, *hy_conv_w, *hy_conv_b, *filt_w1, *filt_b1, *filt_freq1, *filt_w2, *filt_b2,
      *filt_freq2, *filt_w3, *filt_bias, *g_out_att, *g_out_hy, *w_out, *g_ffn, *w_up, *ffn_conv_w, *ffn_conv_b, *w_down;
  float* out;
  char* ws;
};

typedef __bf16 bf16x2_t __attribute__((ext_vector_type(2)));
__device__ __forceinline__ unsigned pack2(float lo, float hi) {
  bf16x2_t v;
  v[0] = (__bf16)lo;
  v[1] = (__bf16)hi;
  return __builtin_bit_cast(unsigned, v);
}
__device__ __forceinline__ float bflo(unsigned u) { return __uint_as_float(u << 16); }
__device__ __forceinline__ float bfhi(unsigned u) { return __uint_as_float(u & 0xffff0000u); }
__device__ __forceinline__ float bf2f(bf16_t h) { return __uint_as_float(((unsigned)h) << 16); }
__device__ __forceinline__ bf16_t f2bf(float f) { return (bf16_t)(pack2(f, 0.f) & 0xffffu); }
__device__ __forceinline__ float wave_sum(float v) {
#pragma unroll
  for (int o = 32; o >= 1; o >>= 1) v += __shfl_xor(v, o);
  return v;
}
__device__ __forceinline__ int ltid() { int t = threadIdx.x; asm volatile("" : "+v"(t)); return t; }
__device__ __forceinline__ float sin_turns(float t) { t -= floorf(t); return __builtin_amdgcn_sinf(t); }
__device__ __forceinline__ float cos_turns(float t) { t -= floorf(t); return __builtin_amdgcn_cosf(t); }
__device__ __forceinline__ float sin_rad(float x) { return sin_turns(x * 0.15915494309189535f); }
__device__ __forceinline__ const float* xrow(const Params& p, int row) {
  return row < NCTX ? p.x_prompt + (size_t)row * D : p.x_sample + (size_t)(row - NCTX) * D;
}
__device__ __forceinline__ int modidx(int row) { return row < NCTX ? 0 : 1 + ((row - NCTX) >> 12); }

template <bool SWAP>
__device__ __forceinline__ void gemm_main(const bf16_t* __restrict__ A, int lda, const bf16_t* __restrict__ Bt, int ldb,
                                          int K, int m0, int n0, char* smem, f32x4 (&acc)[4][4]) {
  const int tid = ltid(), lane = tid & 63, wid = tid >> 6, wr = wid >> 1, wc = wid & 1;
  const int fr = lane & 15, fq = lane >> 4;
  bf16_t* sbase = (bf16_t*)smem;
#pragma unroll
  for (int m = 0; m < 4; ++m)
#pragma unroll
    for (int n = 0; n < 4; ++n) acc[m][n] = (f32x4){0.f, 0.f, 0.f, 0.f};
  const int lr = tid >> 3, lc = (tid & 7) * 8;
  const bf16_t* ga = A + (size_t)(m0 + lr) * lda + lc;
  const bf16_t* gb = Bt + (size_t)(n0 + lr) * ldb + lc;
  const size_t sa32 = (size_t)32 * lda, sb32 = (size_t)32 * ldb;
  uint4 ra0 = *(const uint4*)(ga), ra1 = *(const uint4*)(ga + sa32), ra2 = *(const uint4*)(ga + 2 * sa32), ra3 = *(const uint4*)(ga + 3 * sa32);
  uint4 rb0 = *(const uint4*)(gb), rb1 = *(const uint4*)(gb + sb32), rb2 = *(const uint4*)(gb + 2 * sb32), rb3 = *(const uint4*)(gb + 3 * sb32);
  const int nk = K >> 6;
  const int woff = lr * 64 + (((tid & 7) ^ (lr & 7)) * 8);
  const int aoff = (wr * 64 + fr) * 64, boff = 8192 + (wc * 64 + fr) * 64;
  __syncthreads();
  {
    bf16_t* wa = sbase + woff;
    *(uint4*)(wa) = ra0; *(uint4*)(wa + 32 * 64) = ra1; *(uint4*)(wa + 64 * 64) = ra2; *(uint4*)(wa + 96 * 64) = ra3;
    *(uint4*)(wa + 8192) = rb0; *(uint4*)(wa + 8192 + 32 * 64) = rb1; *(uint4*)(wa + 8192 + 64 * 64) = rb2; *(uint4*)(wa + 8192 + 96 * 64) = rb3;
  }
  if (nk > 1) {
    ga += 64; gb += 64;
    ra0 = *(const uint4*)(ga); ra1 = *(const uint4*)(ga + sa32); ra2 = *(const uint4*)(ga + 2 * sa32); ra3 = *(const uint4*)(ga + 3 * sa32);
    rb0 = *(const uint4*)(gb); rb1 = *(const uint4*)(gb + sb32); rb2 = *(const uint4*)(gb + 2 * sb32); rb3 = *(const uint4*)(gb + 3 * sb32);
  }
  __syncthreads();
  for (int kt = 0; kt < nk; ++kt) {
    const bf16_t* cur = sbase + (kt & 1) * 16384;
    if (kt + 1 < nk) {
      bf16_t* wa = sbase + ((kt + 1) & 1) * 16384 + woff;
      *(uint4*)(wa) = ra0; *(uint4*)(wa + 32 * 64) = ra1; *(uint4*)(wa + 64 * 64) = ra2; *(uint4*)(wa + 96 * 64) = ra3;
      *(uint4*)(wa + 8192) = rb0; *(uint4*)(wa + 8192 + 32 * 64) = rb1; *(uint4*)(wa + 8192 + 64 * 64) = rb2; *(uint4*)(wa + 8192 + 96 * 64) = rb3;
      if (kt + 2 < nk) {
        ga += 64; gb += 64;
        ra0 = *(const uint4*)(ga); ra1 = *(const uint4*)(ga + sa32); ra2 = *(const uint4*)(ga + 2 * sa32); ra3 = *(const uint4*)(ga + 3 * sa32);
        rb0 = *(const uint4*)(gb); rb1 = *(const uint4*)(gb + sb32); rb2 = *(const uint4*)(gb + 2 * sb32); rb3 = *(const uint4*)(gb + 3 * sb32);
      }
    }
    __builtin_amdgcn_sched_barrier(0);
#pragma unroll
    for (int ks = 0; ks < 2; ++ks) {
      bf16x8 af[4], bfr[4];
#pragma unroll
      for (int m = 0; m < 4; ++m) af[m] = *(const bf16x8*)(cur + aoff + m * 16 * 64 + (((ks * 4 + fq) ^ (fr & 7)) * 8));
#pragma unroll
      for (int n = 0; n < 4; ++n) bfr[n] = *(const bf16x8*)(cur + boff + n * 16 * 64 + (((ks * 4 + fq) ^ (fr & 7)) * 8));
      __builtin_amdgcn_s_setprio(1);
#pragma unroll
      for (int m = 0; m < 4; ++m)
#pragma unroll
        for (int n = 0; n < 4; ++n) {
          if (SWAP) acc[m][n] = __builtin_amdgcn_mfma_f32_16x16x32_bf16(bfr[n], af[m], acc[m][n], 0, 0, 0);
          else acc[m][n] = __builtin_amdgcn_mfma_f32_16x16x32_bf16(af[m], bfr[n], acc[m][n], 0, 0, 0);
        }
      __builtin_amdgcn_s_setprio(0);
    }
    if (kt + 1 < nk) __syncthreads();
  }
}
template <bool SWAP, class Epi>
__device__ __forceinline__ void gemm_tile(const bf16_t* __restrict__ A, int lda, const bf16_t* __restrict__ Bt, int ldb,
                                          int K, int m0, int n0, char* smem, const Epi& epi) {
  f32x4 acc[4][4];
  gemm_main<SWAP>(A, lda, Bt, ldb, K, m0, n0, smem, acc);
  const int tid = ltid(), lane = tid & 63, wid = tid >> 6, wr = wid >> 1, wc = wid & 1;
  const int fr = lane & 15, fq = lane >> 4;
#pragma unroll
  for (int m = 0; m < 4; ++m)
#pragma unroll
    for (int n = 0; n < 4; ++n) {
      if (SWAP) epi(m0 + wr * 64 + m * 16 + fr, n0 + wc * 64 + n * 16 + fq * 4, acc[m][n]);
      else epi(m0 + wr * 64 + m * 16 + fq * 4, n0 + wc * 64 + n * 16 + fr, acc[m][n]);
    }
}

template <int CTRL>
__device__ __forceinline__ float dpp_ror(float v) {
  return __int_as_float(__builtin_amdgcn_update_dpp(0, __float_as_int(v), CTRL, 0xF, 0xF, false));
}
constexpr size_t OFF_EDGE = 162 * MiB;
__device__ __forceinline__ void gemm_up_act_tile(const Params& p, int m0, int n0, char* smem) {
  f32x4 acc[4][4];
  gemm_main<true>((const bf16_t*)(p.ws + OFF_H), 1024, (const bf16_t*)(p.ws + OFF_WUP), 1024, 1024, m0, n0, smem, acc);
  const int tid = ltid(), lane = tid & 63, wid = tid >> 6, wr = wid >> 1, wc = wid & 1;
  const int fr = lane & 15, fq = lane >> 4;
  bf16_t* act = (bf16_t*)(p.ws + OFF_U);
  bf16_t* edge = (bf16_t*)(p.ws + OFF_EDGE);
  const int rowbase = m0 + wr * 64, wt = rowbase >> 6;
#pragma unroll
  for (int i = 0; i < 2; ++i) {
    const int cperm = n0 + wc * 64 + 32 * i;
    const int j0 = (cperm >> 5) * 16 + 4 * fq;
    const float4 wa0 = *(const float4*)(p.ffn_conv_w + j0), wa1 = *(const float4*)(p.ffn_conv_w + 5632 + j0), wa2 = *(const float4*)(p.ffn_conv_w + 11264 + j0);
    const float4 wg0 = *(const float4*)(p.ffn_conv_w + 2816 + j0), wg1 = *(const float4*)(p.ffn_conv_w + 5632 + 2816 + j0), wg2 = *(const float4*)(p.ffn_conv_w + 11264 + 2816 + j0);
    const float4 ba = *(const float4*)(p.ffn_conv_b + j0), bg = *(const float4*)(p.ffn_conv_b + 2816 + j0);
    const float w0a[4] = {wa0.x, wa0.y, wa0.z, wa0.w}, w1a[4] = {wa1.x, wa1.y, wa1.z, wa1.w}, w2a[4] = {wa2.x, wa2.y, wa2.z, wa2.w};
    const float w0g[4] = {wg0.x, wg0.y, wg0.z, wg0.w}, w1g[4] = {wg1.x, wg1.y, wg1.z, wg1.w}, w2g[4] = {wg2.x, wg2.y, wg2.z, wg2.w};
    const float bba[4] = {ba.x, ba.y, ba.z, ba.w}, bbg[4] = {bg.x, bg.y, bg.z, bg.w};
#pragma unroll
    for (int m = 0; m < 4; ++m) {
      float o[4];
#pragma unroll
      for (int e = 0; e < 4; ++e) {
        const float a = acc[m][2 * i][e], g = acc[m][2 * i + 1][e];
        const float au1 = dpp_ror<0x121>(a), gu1 = dpp_ror<0x121>(g), ad1 = dpp_ror<0x12F>(a), gd1 = dpp_ror<0x12F>(g);
        float au2 = 0.f, gu2 = 0.f, ad2 = 0.f, gd2 = 0.f;
        if (m > 0) { au2 = dpp_ror<0x121>(acc[m - 1][2 * i][e]); gu2 = dpp_ror<0x121>(acc[m - 1][2 * i + 1][e]); }
        if (m < 3) { ad2 = dpp_ror<0x12F>(acc[m + 1][2 * i][e]); gd2 = dpp_ror<0x12F>(acc[m + 1][2 * i + 1][e]); }
        const float au = fr > 0 ? au1 : au2, gu = fr > 0 ? gu1 : gu2, ad = fr < 15 ? ad1 : ad2, gd = fr < 15 ? gd1 : gd2;
        const float ca = w0a[e] * au + w1a[e] * a + w2a[e] * ad + bba[e];
        const float cgv = w0g[e] * gu + w1g[e] * g + w2g[e] * gd + bbg[e];
        o[e] = ca * __builtin_amdgcn_rcpf(1.f + __expf(-ca)) * cgv;
      }
      const int lr64 = m * 16 + fr, row = rowbase + lr64;
      if (lr64 >= 1 && lr64 <= 62) *(uint2*)(act + (size_t)row * 2816 + j0) = make_uint2(pack2(o[0], o[1]), pack2(o[2], o[3]));
      if (lr64 <= 1 || lr64 >= 62) {
        const int slot = lr64 <= 1 ? lr64 : lr64 - 60;
        bf16_t* er = edge + (size_t)(wt * 4 + slot) * 5632;
        *(uint2*)(er + j0) = make_uint2(pack2(acc[m][2 * i][0], acc[m][2 * i][1]), pack2(acc[m][2 * i][2], acc[m][2 * i][3]));
        *(uint2*)(er + 2816 + j0) = make_uint2(pack2(acc[m][2 * i + 1][0], acc[m][2 * i + 1][1]), pack2(acc[m][2 * i + 1][2], acc[m][2 * i + 1][3]));
      }
    }
  }
}

__device__ __forceinline__ void transpose_item(const float* __restrict__ W, int K, int N, bf16_t* __restrict__ WT, int tile, int ntn, char* smem, bool perm = false) {
  float* s = (float*)smem;
  const int tk = tile / ntn, tn = tile % ntn, tid = ltid();
  const int k0 = tk * 64, n0 = tn * 64;
  __syncthreads();
  {
    const int r = tid >> 4, c4 = (tid & 15) * 4;
#pragma unroll
    for (int i = 0; i < 4; ++i) {
      const int k = r + 16 * i;
      float4 v = make_float4(0.f, 0.f, 0.f, 0.f);
      if (n0 + c4 < N) v = *(const float4*)(W + (size_t)(k0 + k) * N + n0 + c4);
      s[k * 65 + c4 + 0] = v.x; s[k * 65 + c4 + 1] = v.y; s[k * 65 + c4 + 2] = v.z; s[k * 65 + c4 + 3] = v.w;
    }
  }
  __syncthreads();
  {
    const int n = tid >> 2, kc = (tid & 3) * 16;
    unsigned o[8];
#pragma unroll
    for (int i = 0; i < 8; ++i) o[i] = pack2(s[(kc + 2 * i) * 65 + n], s[(kc + 2 * i + 1) * 65 + n]);
    int nr = n0 + n;
    if (perm) { const int hf = nr >= 2816 ? 1 : 0, cc = nr - hf * 2816; nr = 32 * (cc >> 4) + 16 * hf + (cc & 15); }
    uint4* dst = (uint4*)(WT + (size_t)nr * K + k0 + kc);
    dst[0] = make_uint4(o[0], o[1], o[2], o[3]);
    dst[1] = make_uint4(o[4], o[5], o[6], o[7]);
  }
}

__device__ __forceinline__ void mod_item(const Params& p, int item, char* smem) {
  float* s = (float*)smem;
  float* red = s + 3072;
  const int tid = ltid();
  __syncthreads();
  for (int e = tid; e < 3072; e += 256) {
    const int v = e >> 10, k = e & 1023;
    const float x = (v == 0) ? p.c_ctx[k] : p.c[(v - 1) * D + k];
    s[e] = x / (1.f + __expf(-x));
  }
  __syncthreads();
  const int jl = tid & 63, kq = tid >> 6, j = item * 64 + jl, k0 = kq * 256;
  float a0 = 0.f, a1 = 0.f, a2 = 0.f;
#pragma unroll 8
  for (int k = 0; k < 256; ++k) {
    const float w = p.w_ada[(size_t)(k0 + k) * 6144 + j];
    a0 += s[k0 + k] * w; a1 += s[1024 + k0 + k] * w; a2 += s[2048 + k0 + k] * w;
  }
  red[(kq * 3 + 0) * 64 + jl] = a0; red[(kq * 3 + 1) * 64 + jl] = a1; red[(kq * 3 + 2) * 64 + jl] = a2;
  __syncthreads();
  if (tid < 192) {
    const int v = tid >> 6;
    const float r = red[(0 * 3 + v) * 64 + jl] + red[(1 * 3 + v) * 64 + jl] + red[(2 * 3 + v) * 64 + jl] + red[(3 * 3 + v) * 64 + jl];
    ((float*)(p.ws + OFF_MOD))[v * 6144 + j] = r + p.b_ada[j];
  }
}

__device__ __forceinline__ void filter_item(const Params& p, int item, char* smem) {
  int n, p0; bf16_t* R;
  if (item < 256) { n = 4096; p0 = item * 16; R = (bf16_t*)(p.ws + OFF_RLAT); }
  else { n = 256; p0 = (item - 256) * 16; R = (bf16_t*)(p.ws + OFF_RCTX); }
  const int n2 = 2 * n, tid = ltid();
  float* z = (float*)smem;
  float* h1 = z + 16 * 36;
  float* h2 = h1 + 16 * 64;
  __syncthreads();
#pragma unroll 1
  for (int e = tid; e < 16 * 33; e += 256) {
    const int pp = e / 33, f = e % 33, pos = p0 + pp;
    float val;
    if (f == 0) val = (float)pos / (float)(n - 1);
    else {
      const int k = (f - 1) & 15;
      const float band = 1e-4f + (float)k * ((15.f - 1e-4f) / 15.f);
      const float turns = band * ((float)pos / (float)n);
      val = (f <= 16) ? cos_turns(turns) : -sin_turns(turns);
    }
    z[pp * 36 + f] = val;
  }
  __syncthreads();
#pragma unroll 1
  for (int e = tid; e < 1024; e += 256) {
    const int pp = e >> 6, j = e & 63;
    float a = p.filt_b1[j];
#pragma unroll 3
    for (int f = 0; f < 33; ++f) a += z[pp * 36 + f] * p.filt_w1[f * 64 + j];
    h1[e] = sin_rad(p.filt_freq1[j] * a);
  }
  __syncthreads();
#pragma unroll 1
  for (int e = tid; e < 1024; e += 256) {
    const int pp = e >> 6, j = e & 63;
    float a = p.filt_b2[j];
#pragma unroll 4
    for (int k = 0; k < 64; ++k) a += h1[pp * 64 + k] * p.filt_w2[k * 64 + j];
    h2[j * 16 + pp] = sin_rad(p.filt_freq2[j] * a);
  }
  __syncthreads();
  const float mind = -3.0701134573253946f, maxd = -15.350567286626973f;
#pragma unroll 1
  for (int ci = 0; ci < 8; ++ci) {
    const int col = tid + 256 * ci, o = col >> 10, dir = (col >> 9) & 1, c = col & 511;
    float acc[16];
#pragma unroll
    for (int i = 0; i < 16; ++i) acc[i] = 0.f;
#pragma unroll 4
    for (int k = 0; k < 64; ++k) {
      const float w = p.filt_w3[k * 2048 + col];
      const float4 ha = *(const float4*)(h2 + k * 16), hb = *(const float4*)(h2 + k * 16 + 4), hc = *(const float4*)(h2 + k * 16 + 8), hd = *(const float4*)(h2 + k * 16 + 12);
      acc[0] += ha.x * w; acc[1] += ha.y * w; acc[2] += ha.z * w; acc[3] += ha.w * w;
      acc[4] += hb.x * w; acc[5] += hb.y * w; acc[6] += hb.z * w; acc[7] += hb.w * w;
      acc[8] += hc.x * w; acc[9] += hc.y * w; acc[10] += hc.z * w; acc[11] += hc.w * w;
      acc[12] += hd.x * w; acc[13] += hd.y * w; acc[14] += hd.z * w; acc[15] += hd.w * w;
    }
    const float delta = fabsf(mind + (float)c * ((maxd - mind) / 511.f));
    bf16_t* Rrow = R + (size_t)(o * 512 + c) * n2;
#pragma unroll
    for (int i = 0; i < 16; ++i) {
      const int pos = p0 + i;
      const float t = (float)pos / (float)(n - 1);
      float val = acc[i] * (__expf(-t * delta) + 0.05f);
      int idx = dir == 0 ? (n - 1 - pos) : (n - 1 + pos);
      if (dir == 1 && pos == 0) { idx = n2 - 1; val = 0.f; }
      Rrow[idx] = f2bf(val);
    }
  }
}

__device__ __forceinline__ void cache_item(const Params& p, int item) {
  const int tid = ltid(), r0 = item * 32;
  bf16_t* ckvn = (bf16_t*)(p.ws + OFF_CKVN);
#pragma unroll 2
  for (int e = tid; e < 32 * 64; e += 256) {
    const int r = r0 + (e >> 6), c4 = (e & 63) * 4;
    const float4 v = *(const float4*)(p.cache_ckv + (size_t)r * 256 + c4);
    *(uint2*)(ckvn + (size_t)(NTOK + r) * 256 + c4) = make_uint2(pack2(v.x, v.y), pack2(v.z, v.w));
  }
}

template <int WHICH>
__device__ __forceinline__ void rmsmod_phase(const Params& p) {
  const int tid = ltid(), lane = tid & 63, wid = tid >> 6;
  const int gw = blockIdx.x * 4 + wid, tw = gridDim.x * 4;
  const float* g = WHICH == 0 ? p.g_mix : p.g_ffn;
  const float* mod = (const float*)(p.ws + OFF_MOD);
  bf16_t* h = (bf16_t*)(p.ws + OFF_H);
  float4 nv0, nv1, nv2, nv3;
  {
    const float* src = WHICH == 0 ? xrow(p, gw) : p.out + (size_t)gw * D;
    nv0 = ((const float4*)src)[lane]; nv1 = ((const float4*)src)[lane + 64]; nv2 = ((const float4*)src)[lane + 128]; nv3 = ((const float4*)src)[lane + 192];
  }
  for (int row = gw; row < NTOK; row += tw) {
    float4 v[4] = {nv0, nv1, nv2, nv3};
    if (row + tw < NTOK) {
      const float* src = WHICH == 0 ? xrow(p, row + tw) : p.out + (size_t)(row + tw) * D;
      nv0 = ((const float4*)src)[lane]; nv1 = ((const float4*)src)[lane + 64]; nv2 = ((const float4*)src)[lane + 128]; nv3 = ((const float4*)src)[lane + 192];
    }
    float ss = 0.f;
#pragma unroll
    for (int i = 0; i < 4; ++i) ss += v[i].x * v[i].x + v[i].y * v[i].y + v[i].z * v[i].z + v[i].w * v[i].w;
    ss = wave_sum(ss);
    const float r = rsqrtf(ss * (1.f / 1024.f) + 1e-6f);
    const float* mv = mod + modidx(row) * 6144 + (WHICH == 0 ? 0 : 3 * 1024);
#pragma unroll
    for (int i = 0; i < 4; ++i) {
      const int e = 4 * (lane + 64 * i);
      const float4 g4 = *(const float4*)(g + e), sh = *(const float4*)(mv + e), sc = *(const float4*)(mv + 1024 + e);
      const float y0 = v[i].x * r * g4.x * (1.f + sc.x) + sh.x, y1 = v[i].y * r * g4.y * (1.f + sc.y) + sh.y;
      const float y2 = v[i].z * r * g4.z * (1.f + sc.z) + sh.z, y3 = v[i].w * r * g4.w * (1.f + sc.w) + sh.w;
      *(uint2*)(h + (size_t)row * D + e) = make_uint2(pack2(y0, y1), pack2(y2, y3));
    }
  }
}

struct EpiIn {
  float* proj; bf16_t* hyT;
  __device__ __forceinline__ void operator()(int row0, int col, const f32x4& v) const {
    if (col < 672) {
#pragma unroll
      for (int j = 0; j < 4; ++j) proj[(size_t)(row0 + j) * 672 + col] = v[j];
    } else if (col < DIN) {
      *(uint2*)(hyT + (size_t)(col - 672) * NTOK + row0) = make_uint2(pack2(v[0], v[1]), pack2(v[2], v[3]));
    }
  }
};
struct EpiProj {
  float* proj;
  __device__ __forceinline__ void operator()(int row, int col0, const f32x4& v) const { *(f32x4*)(proj + (size_t)row * 672 + col0) = v; }
};
struct EpiQ {
  bf16_t* q;
  __device__ __forceinline__ void operator()(int row, int col0, const f32x4& v) const {
    *(uint2*)(q + (size_t)row * 768 + col0) = make_uint2(pack2(v[0], v[1]), pack2(v[2], v[3]));
  }
};
struct EpiKV {
  bf16_t *kraw, *vtc, *vtl;
  __device__ __forceinline__ void operator()(int row0, int col, const f32x4& v) const {
    const int head = col >> 7, cc = col & 127;
    if (cc < 64) {
#pragma unroll
      for (int j = 0; j < 4; ++j) kraw[(size_t)(row0 + j) * 512 + head * 64 + cc] = f2bf(v[j]);
    } else {
      const int dv = cc - 64;
      bf16_t* dst;
      if (row0 < NCTX) dst = vtc + ((size_t)((row0 >> 8) * 8 + head) * 64 + dv) * 256 + (row0 & 255);
      else if (row0 < NTOK) { const int r = row0 - NCTX; dst = vtl + ((size_t)((r >> 12) * 8 + head) * 64 + dv) * 4608 + (r & 4095); }
      else { const int r = row0 - NTOK; dst = vtl + ((size_t)((r >> 9) * 8 + head) * 64 + dv) * 4608 + 4096 + (r & 511); }
      *(uint2*)dst = make_uint2(pack2(v[0], v[1]), pack2(v[2], v[3]));
    }
  }
};
struct EpiOut {
  const Params* p;
  __device__ __forceinline__ void operator()(int row, int col0, const f32x4& v) const {
    const float4 x = *(const float4*)(xrow(*p, row) + col0);
    const float4 m = *(const float4*)((const float*)(p->ws + OFF_MOD) + modidx(row) * 6144 + 2 * 1024 + col0);
    *(float4*)(p->out + (size_t)row * D + col0) = make_float4(x.x + m.x * v[0], x.y + m.y * v[1], x.z + m.z * v[2], x.w + m.w * v[3]);
  }
};
struct EpiU {
  bf16_t* u;
  __device__ __forceinline__ void operator()(int row, int col0, const f32x4& v) const {
    *(uint2*)(u + (size_t)row * 5632 + col0) = make_uint2(pack2(v[0], v[1]), pack2(v[2], v[3]));
  }
};
struct EpiY {
  const Params* p; int half;
  __device__ __forceinline__ void operator()(int row, int col0, const f32x4& v) const {
    const int grow = half * 8192 + row;
    float4* dst = (float4*)(p->out + (size_t)grow * D + col0);
    const float4 x = *dst;
    const float4 m = *(const float4*)((const float*)(p->ws + OFF_MOD) + modidx(grow) * 6144 + 5 * 1024 + col0);
    *dst = make_float4(x.x + m.x * v[0], x.y + m.y * v[1], x.z + m.z * v[2], x.w + m.w * v[3]);
  }
};

__device__ __forceinline__ void token_item(const Params& p, int item) {
  const int tid = ltid(), lane = tid & 63, wid = tid >> 6;
  const float* proj = (const float*)(p.ws + OFF_PROJ);
  bf16_t* qa = (bf16_t*)(p.ws + OFF_QA);
  bf16_t* ckvn = (bf16_t*)(p.ws + OFF_CKVN);
  float* kpe = (float*)(p.ws + OFF_KPE);
  for (int tt = 0; tt < 8; ++tt) {
    const int token = item * 32 + wid * 8 + tt;
    const float* pr = proj + (size_t)token * 672;
    float2 q[3];
    float ss = 0.f;
#pragma unroll
    for (int i = 0; i < 3; ++i) { q[i] = *(const float2*)(pr + lane * 2 + 128 * i); ss += q[i].x * q[i].x + q[i].y * q[i].y; }
    ss = wave_sum(ss);
    const float r = rsqrtf(ss * (1.f / 384.f) + 1e-6f);
#pragma unroll
    for (int i = 0; i < 3; ++i) {
      const int e = lane * 2 + 128 * i;
      *(unsigned*)(qa + (size_t)token * 384 + e) = pack2(q[i].x * r * p.g_qa[e], q[i].y * r * p.g_qa[e + 1]);
    }
    const float4 kv = *(const float4*)(pr + 384 + lane * 4);
    float s2 = wave_sum(kv.x * kv.x + kv.y * kv.y + kv.z * kv.z + kv.w * kv.w);
    const float r2 = rsqrtf(s2 * (1.f / 256.f) + 1e-6f);
    const float4 g = *(const float4*)(p.g_kva + lane * 4);
    const float4 y = make_float4(kv.x * r2 * g.x, kv.y * r2 * g.y, kv.z * r2 * g.z, kv.w * r2 * g.w);
    *(uint2*)(ckvn + (size_t)token * 256 + lane * 4) = make_uint2(pack2(y.x, y.y), pack2(y.z, y.w));
    if (token < NCTX) *(float4*)(p.out + OUT_CKV + (size_t)token * 256 + lane * 4) = y;
    if (lane < 32) {
      const float kp = pr[640 + lane];
      kpe[(size_t)token * 32 + lane] = kp;
      if (token < NCTX) p.out[OUT_KPE + (size_t)token * 32 + lane] = kp;
    }
  }
}

template <int ORDER>
__device__ __forceinline__ void hyena_item(const Params& p, int grp, int c, char* smem) {
  const int tid = ltid(), lane = tid & 63, wid = tid >> 6, fr = lane & 15, fq = lane >> 4;
  const int n = grp ? SEQL : SEQC, nb = n >> 6, L = n;
  const bf16_t* Rrow = (const bf16_t*)(p.ws + (grp ? OFF_RLAT : OFF_RCTX)) + (size_t)(ORDER * 512 + c) * (2 * n);
  const bf16_t* hyT = (const bf16_t*)(p.ws + OFF_HYT);
  bf16_t* sU = (bf16_t*)smem;
  unsigned* sR0 = (unsigned*)(smem + 18432);
  unsigned* sR1 = (unsigned*)(smem + 18432 + 16384);
  const int tok0 = grp * 8192;
  __syncthreads();
  for (int ch = tid; ch < (2 * n) / 8; ch += 256) *(uint4*)((bf16_t*)sR0 + ch * 8) = *(const uint4*)(Rrow + ch * 8);
  if (ORDER == 0) {
    const bf16_t* raw = hyT + (size_t)c * NTOK + tok0;
    const float w0 = p.hy_conv_w[c], w1 = p.hy_conv_w[1536 + c], w2 = p.hy_conv_w[3072 + c], b = p.hy_conv_b[c];
    for (int ch = tid; ch < 1024; ch += 256) {
      const int t = ch * 8, pos = t & (L - 1);
      const uint4 rv = *(const uint4*)(raw + t);
      float x[10];
      x[0] = pos == 0 ? 0.f : bf2f(raw[t - 1]);
      x[1] = bflo(rv.x); x[2] = bfhi(rv.x); x[3] = bflo(rv.y); x[4] = bfhi(rv.y);
      x[5] = bflo(rv.z); x[6] = bfhi(rv.z); x[7] = bflo(rv.w); x[8] = bfhi(rv.w);
      x[9] = (pos + 8 == L) ? 0.f : bf2f(raw[t + 8]);
      float u[8];
#pragma unroll
      for (int i = 0; i < 8; ++i) u[i] = w0 * x[i] + w1 * x[i + 1] + w2 * x[i + 2] + b;
      *(uint4*)(sU + (ch >> 3) * 64 + (((ch & 7) ^ ((ch >> 3) & 7)) * 8)) = make_uint4(pack2(u[0], u[1]), pack2(u[2], u[3]), pack2(u[4], u[5]), pack2(u[6], u[7]));
    }
  } else {
    const bf16_t* zr = (const bf16_t*)(p.ws + OFF_ZT) + (size_t)c * NTOK + tok0;
    for (int ch = tid; ch < 1024; ch += 256) *(uint4*)(sU + (ch >> 3) * 64 + (((ch & 7) ^ ((ch >> 3) & 7)) * 8)) = *(const uint4*)(zr + ch * 8);
  }
  __syncthreads();
  for (int k = tid; k < n; k += 256) {
    const unsigned a = sR0[k], b2 = (k + 1 < n) ? sR0[k + 1] : 0u;
    sR1[k] = (a >> 16) | (b2 << 16);
  }
  __syncthreads();

  f32x4 acc[4][2];
#pragma unroll
  for (int m = 0; m < 4; ++m) { acc[m][0] = (f32x4){0.f, 0.f, 0.f, 0.f}; acc[m][1] = (f32x4){0.f, 0.f, 0.f, 0.f}; }
  const unsigned* abase = (fr & 1) ? (sR0 + ((n - 1 - fr) >> 1) + 4 * fq) : (sR1 + ((n - 2 - fr) >> 1) + 4 * fq);
  const int col0 = 32 * wid + fr, col1 = col0 + 16;
  const int i0 = col0 & (nb - 1), i1 = col1 & (nb - 1);
  for (int d = -(nb - 1); d <= nb - 1; ++d) {
    const bool v0 = (unsigned)(i0 - d) < (unsigned)nb, v1 = (unsigned)(i1 - d) < (unsigned)nb;
    const bool any0 = __ballot(v0) != 0ull, any1 = __ballot(v1) != 0ull;
    if (!any0 && !any1) continue;
    bf16x8 F[6];
    const unsigned* ap = abase - 32 * d + 16;
#pragma unroll
    for (int idx = 0; idx < 6; ++idx) {
      const unsigned* q = ap - 8 * idx;
      union { unsigned u[4]; bf16x8 v; } cv;
      cv.u[0] = q[0]; cv.u[1] = q[1]; cv.u[2] = q[2]; cv.u[3] = q[3];
      F[idx] = cv.v;
    }
#pragma unroll
    for (int nt = 0; nt < 2; ++nt) {
      if (!(nt ? any1 : any0)) continue;
      const bool vv = nt ? v1 : v0;
      const int srow = (nt ? col1 : col0) - d;
      const bf16_t* up = sU + srow * 64;
#pragma unroll
      for (int ks = 0; ks < 2; ++ks) {
        bf16x8 bf = (bf16x8){0, 0, 0, 0, 0, 0, 0, 0};
        if (vv) bf = *(const bf16x8*)(up + (((ks * 4 + fq) ^ (srow & 7)) * 8));
#pragma unroll
        for (int m = 0; m < 4; ++m)
          acc[m][nt] = __builtin_amdgcn_mfma_f32_16x16x32_bf16(F[m + 2 - 2 * ks], bf, acc[m][nt], 0, 0, 0);
      }
    }
  }
  const float skip = p.filt_bias[ORDER * 512 + c];
  const int gcol = (ORDER == 0 ? 512 : 1024) + c;
  const bf16_t* graw = hyT + (size_t)gcol * NTOK + tok0;
  const float w0 = p.hy_conv_w[gcol], w1 = p.hy_conv_w[1536 + gcol], w2 = p.hy_conv_w[3072 + gcol], b = p.hy_conv_b[gcol];
  bf16_t* outT = (bf16_t*)(p.ws + (ORDER == 0 ? OFF_ZT : OFF_Y2T)) + (size_t)c * NTOK + tok0;
#pragma unroll
  for (int nt = 0; nt < 2; ++nt) {
    const int col = nt ? col1 : col0;
#pragma unroll
    for (int m = 0; m < 4; ++m) {
      const int t = col * 64 + 16 * m + 4 * fq, pos = t & (L - 1);
      const uint2 uu = *(const uint2*)(sU + col * 64 + (((2 * m + (fq >> 1)) ^ (col & 7)) * 8) + 4 * (fq & 1));
      const uint2 gv = *(const uint2*)(graw + t);
      float x[6];
      x[0] = pos == 0 ? 0.f : bf2f(graw[t - 1]);
      x[1] = bflo(gv.x); x[2] = bfhi(gv.x); x[3] = bflo(gv.y); x[4] = bfhi(gv.y);
      x[5] = (pos + 4 == L) ? 0.f : bf2f(graw[t + 4]);
      const float u4[4] = {bflo(uu.x), bfhi(uu.x), bflo(uu.y), bfhi(uu.y)};
      float o[4];
#pragma unroll
      for (int j = 0; j < 4; ++j) {
        const float gate = w0 * x[j] + w1 * x[j + 1] + w2 * x[j + 2] + b;
        o[j] = gate * (acc[m][nt][j] + skip * u4[j]);
      }
      *(uint2*)(outT + t) = make_uint2(pack2(o[0], o[1]), pack2(o[2], o[3]));
    }
  }
}

__device__ __forceinline__ void rope32(float* y  , int pos) {
  const float prow = (float)(pos >> 6), pcol = (float)(pos & 63);
  const float fr[8] = {1.f, 0.31622776601683794f, 0.1f, 0.031622776601683794f, 0.01f, 0.0031622776601683794f, 0.001f, 0.00031622776601683794f};
#pragma unroll
  for (int i = 0; i < 8; ++i) {
    const float tr = prow * fr[i] * 0.15915494309189535f, tc = pcol * fr[i] * 0.15915494309189535f;
    const float sr = sin_turns(tr), cr = cos_turns(tr), sc = sin_turns(tc), cc = cos_turns(tc);
    const float a = y[i], b = y[8 + i], c2 = y[16 + i], d2 = y[24 + i];
    y[i] = a * cr - b * sr; y[8 + i] = b * cr + a * sr;
    y[16 + i] = c2 * cc - d2 * sc; y[24 + i] = d2 * cc + c2 * sc;
  }
}
__device__ __forceinline__ void unpack8(const uint4& v, float* x) {
  x[0] = bflo(v.x); x[1] = bfhi(v.x); x[2] = bflo(v.y); x[3] = bfhi(v.y);
  x[4] = bflo(v.z); x[5] = bfhi(v.z); x[6] = bflo(v.w); x[7] = bfhi(v.w);
}
__device__ __forceinline__ float sumsq8(const uint4& v) {
  float x[8];
  unpack8(v, x);
  return x[0] * x[0] + x[1] * x[1] + x[2] * x[2] + x[3] * x[3] + x[4] * x[4] + x[5] * x[5] + x[6] * x[6] + x[7] * x[7];
}
__device__ __forceinline__ uint4 scale8(const uint4& v, float r, const float* __restrict__ g) {
  float x[8];
  unpack8(v, x);
  const float4 g0 = *(const float4*)g, g1 = *(const float4*)(g + 4);
  return make_uint4(pack2(x[0] * r * g0.x, x[1] * r * g0.y), pack2(x[2] * r * g0.z, x[3] * r * g0.w),
                    pack2(x[4] * r * g1.x, x[5] * r * g1.y), pack2(x[6] * r * g1.z, x[7] * r * g1.w));
}
__device__ __forceinline__ void qk_item(const Params& p, int item) {
  const int tid = ltid();
  if (item < 512) {
    const int idx = item * 256 + tid, row = idx >> 3, h = idx & 7;
    const bf16_t* src = (const bf16_t*)(p.ws + OFF_QRAW) + (size_t)row * 768 + h * 96;
    bf16_t* dst = (bf16_t*)(p.ws + OFF_Q) + (size_t)row * 768 + h * 96;
    uint4 raw[12];
#pragma unroll
    for (int i = 0; i < 12; ++i) raw[i] = *(const uint4*)(src + 8 * i);
    float ss = 0.f;
#pragma unroll
    for (int i = 0; i < 12; ++i) ss += sumsq8(raw[i]);
    const float r = rsqrtf(ss * (1.f / 96.f) + 1e-6f);
    const float qs = 0.10206207261596575f * 1.4426950408889634f;
#pragma unroll
    for (int i = 0; i < 8; ++i) *(uint4*)(dst + 8 * i) = scale8(raw[i], r * qs, p.g_q + 8 * i);
    float y[32];
#pragma unroll
    for (int i = 0; i < 4; ++i) unpack8(raw[8 + i], y + 8 * i);
#pragma unroll
    for (int i = 0; i < 32; ++i) y[i] = y[i] * r * p.g_q[64 + i];
    if (row >= NCTX) rope32(y, (row - NCTX) & 4095);
#pragma unroll
    for (int i = 0; i < 4; ++i)
      *(uint4*)(dst + 64 + 8 * i) = make_uint4(pack2(y[8 * i] * qs, y[8 * i + 1] * qs), pack2(y[8 * i + 2] * qs, y[8 * i + 3] * qs),
                                               pack2(y[8 * i + 4] * qs, y[8 * i + 5] * qs), pack2(y[8 * i + 6] * qs, y[8 * i + 7] * qs));
  } else {
    const int idx = (item - 512) * 256 + tid, row = idx >> 3, h = idx & 7;
    const bf16_t* src = (const bf16_t*)(p.ws + OFF_KRAW) + (size_t)row * 512 + h * 64;
    uint4 raw[8];
#pragma unroll
    for (int i = 0; i < 8; ++i) raw[i] = *(const uint4*)(src + 8 * i);
    const float* kp = row < NTOK ? (const float*)(p.ws + OFF_KPE) + (size_t)row * 32 : p.cache_kpe + (size_t)(row - NTOK) * 32;
    float y[32];
#pragma unroll
    for (int i = 0; i < 8; ++i) {
      const float4 v = *(const float4*)(kp + 4 * i);
      y[4 * i] = v.x; y[4 * i + 1] = v.y; y[4 * i + 2] = v.z; y[4 * i + 3] = v.w;
    }
    float ss = 0.f;
#pragma unroll
    for (int i = 0; i < 8; ++i) ss += sumsq8(raw[i]);
#pragma unroll
    for (int i = 0; i < 32; ++i) ss += y[i] * y[i];
    const float r = rsqrtf(ss * (1.f / 96.f) + 1e-6f);
#pragma unroll
    for (int i = 0; i < 32; ++i) y[i] = y[i] * r * p.g_k[64 + i];
    bf16_t* dst;
    if (row < NCTX) dst = (bf16_t*)(p.ws + OFF_KC) + ((size_t)((row >> 8) * 8 + h) * 256 + (row & 255)) * 96;
    else if (row < NTOK) {
      const int rr = row - NCTX;
      rope32(y, rr & 4095);
      dst = (bf16_t*)(p.ws + OFF_KL) + ((size_t)((rr >> 12) * 8 + h) * 4608 + (rr & 4095)) * 96;
    } else {
      const int rr = row - NTOK;
      dst = (bf16_t*)(p.ws + OFF_KL) + ((size_t)((rr >> 9) * 8 + h) * 4608 + 4096 + (rr & 511)) * 96;
    }
#pragma unroll
    for (int i = 0; i < 8; ++i) *(uint4*)(dst + 8 * i) = scale8(raw[i], r, p.g_k + 8 * i);
#pragma unroll
    for (int i = 0; i < 4; ++i)
      *(uint4*)(dst + 64 + 8 * i) = make_uint4(pack2(y[8 * i], y[8 * i + 1]), pack2(y[8 * i + 2], y[8 * i + 3]),
                                               pack2(y[8 * i + 4], y[8 * i + 5]), pack2(y[8 * i + 6], y[8 * i + 7]));
  }
}

__device__ __forceinline__ void attn_item(const Params& p, int item, char* smem) {
  const int tid = ltid(), lane = tid & 63, wid = tid >> 6, lr = lane & 31, lh = lane >> 5;
  int nkeys, h, tokbase; const bf16_t *Kp, *Vp;
  if (item < 512) {
    const int b = item >> 8, rem = item & 255; h = rem >> 5; const int qb = rem & 31;
    nkeys = 4608; tokbase = NCTX + b * 4096 + qb * 128;
    Kp = (const bf16_t*)(p.ws + OFF_KL) + (size_t)(b * 8 + h) * 4608 * 96;
    Vp = (const bf16_t*)(p.ws + OFF_VTL) + (size_t)(b * 8 + h) * 64 * 4608;
  } else {
    const int it = item - 512, b = it >> 4; h = (it & 15) >> 1; const int qb = it & 1;
    nkeys = 256; tokbase = b * 256 + qb * 128;
    Kp = (const bf16_t*)(p.ws + OFF_KC) + (size_t)(b * 8 + h) * 256 * 96;
    Vp = (const bf16_t*)(p.ws + OFF_VTC) + (size_t)(b * 8 + h) * 64 * 256;
  }
  bf16_t* sK = (bf16_t*)smem;
  bf16_t* sV = sK + 64 * 104;
  const int token = tokbase + 32 * wid + lr;
  const bf16_t* qsrc = (const bf16_t*)(p.ws + OFF_Q) + (size_t)token * 768 + h * 96 + 8 * lh;
  bf16x8 qf[6];
#pragma unroll
  for (int ks = 0; ks < 6; ++ks) qf[ks] = *(const bf16x8*)(qsrc + 16 * ks);
  f32x16 oacc[2];
#pragma unroll
  for (int j = 0; j < 16; ++j) { oacc[0][j] = 0.f; oacc[1][j] = 0.f; }
  float mrun = -1e30f, lsum = 0.f;
  const int kk0 = tid / 12, kc0 = tid % 12, kk1 = (tid + 256) / 12, kc1 = (tid + 256) % 12, kk2 = (tid + 512) / 12, kc2 = (tid + 512) % 12;
  const int vd0 = tid >> 3, vc0 = tid & 7, vd1 = vd0 + 32;
  const bf16_t* gk0 = Kp + (size_t)kk0 * 96 + kc0 * 8;
  const bf16_t* gk1 = Kp + (size_t)kk1 * 96 + kc1 * 8;
  const bf16_t* gk2 = Kp + (size_t)kk2 * 96 + kc2 * 8;
  const bf16_t* gv0 = Vp + (size_t)vd0 * nkeys + vc0 * 8;
  const bf16_t* gv1 = Vp + (size_t)vd1 * nkeys + vc0 * 8;
  uint4 rk0 = *(const uint4*)gk0, rk1 = *(const uint4*)gk1, rk2 = *(const uint4*)gk2;
  uint4 rv0 = *(const uint4*)gv0, rv1 = *(const uint4*)gv1;
  const int nt = nkeys >> 6;
  for (int kt = 0; kt < nt; ++kt) {
    __syncthreads();
    *(uint4*)(sK + kk0 * 104 + kc0 * 8) = rk0; *(uint4*)(sK + kk1 * 104 + kc1 * 8) = rk1; *(uint4*)(sK + kk2 * 104 + kc2 * 8) = rk2;
    *(uint4*)(sV + vd0 * 72 + vc0 * 8) = rv0; *(uint4*)(sV + vd1 * 72 + vc0 * 8) = rv1;
    __syncthreads();
    if (kt + 1 < nt) {
      gk0 += 64 * 96; gk1 += 64 * 96; gk2 += 64 * 96; gv0 += 64; gv1 += 64;
      rk0 = *(const uint4*)gk0; rk1 = *(const uint4*)gk1; rk2 = *(const uint4*)gk2;
      rv0 = *(const uint4*)gv0; rv1 = *(const uint4*)gv1;
    }
    __builtin_amdgcn_sched_barrier(0);
    f32x16 sacc[2];
#pragma unroll
    for (int kb = 0; kb < 2; ++kb) {
#pragma unroll
      for (int j = 0; j < 16; ++j) sacc[kb][j] = 0.f;
#pragma unroll
      for (int ks = 0; ks < 6; ++ks) {
        const bf16x8 a = *(const bf16x8*)(sK + (32 * kb + lr) * 104 + 16 * ks + 8 * lh);
        sacc[kb] = __builtin_amdgcn_mfma_f32_32x32x16_bf16(a, qf[ks], sacc[kb], 0, 0, 0);
      }
    }
    float mx = sacc[0][0];
#pragma unroll
    for (int j = 1; j < 16; ++j) mx = fmaxf(mx, sacc[0][j]);
#pragma unroll
    for (int j = 0; j < 16; ++j) mx = fmaxf(mx, sacc[1][j]);
    mx = fmaxf(mx, __shfl_xor(mx, 32));
    const float mnew = fmaxf(mrun, mx);
    const float alpha = __builtin_amdgcn_exp2f(mrun - mnew);
    mrun = mnew;
    float ps = 0.f;
#pragma unroll
    for (int kb = 0; kb < 2; ++kb)
#pragma unroll
      for (int j = 0; j < 16; ++j) { const float e = __builtin_amdgcn_exp2f(sacc[kb][j] - mnew); sacc[kb][j] = e; ps += e; }
    lsum = lsum * alpha + ps;
    if (__ballot(alpha != 1.f) != 0ull) {
#pragma unroll
      for (int j = 0; j < 16; ++j) { oacc[0][j] *= alpha; oacc[1][j] *= alpha; }
    }
#pragma unroll
    for (int s = 0; s < 4; ++s) {
      const int kb = s >> 1, jb = 8 * (s & 1);
      union { unsigned u[4]; bf16x8 v; } pf;
      pf.u[0] = pack2(sacc[kb][jb + 0], sacc[kb][jb + 1]); pf.u[1] = pack2(sacc[kb][jb + 2], sacc[kb][jb + 3]);
      pf.u[2] = pack2(sacc[kb][jb + 4], sacc[kb][jb + 5]); pf.u[3] = pack2(sacc[kb][jb + 6], sacc[kb][jb + 7]);
#pragma unroll
      for (int mt = 0; mt < 2; ++mt) {
        const bf16_t* vp = sV + (32 * mt + lr) * 72 + 16 * s + 4 * lh;
        union { uint2 d[2]; bf16x8 v; } av;
        av.d[0] = *(const uint2*)vp;
        av.d[1] = *(const uint2*)(vp + 8);
        oacc[mt] = __builtin_amdgcn_mfma_f32_32x32x16_bf16(av.v, pf.v, oacc[mt], 0, 0, 0);
      }
    }
  }
  lsum += __shfl_xor(lsum, 32);
  const float inv = 1.f / lsum;
  bf16_t* dst = (bf16_t*)(p.ws + OFF_ATTN) + (size_t)token * 512 + h * 64;
#pragma unroll
  for (int mt = 0; mt < 2; ++mt)
#pragma unroll
    for (int jg = 0; jg < 4; ++jg) {
      const int dv0 = 32 * mt + 8 * jg + 4 * lh;
      *(uint2*)(dst + dv0) = make_uint2(pack2(oacc[mt][4 * jg] * inv, oacc[mt][4 * jg + 1] * inv),
                                        pack2(oacc[mt][4 * jg + 2] * inv, oacc[mt][4 * jg + 3] * inv));
    }
}

__device__ __forceinline__ void merge_item(const Params& p, int item, char* smem) {
  const int tid = ltid(), lane = tid & 63, wid = tid >> 6, t0 = item * 32;
  bf16_t* mix = (bf16_t*)(p.ws + OFF_H);
  const bf16_t* attn = (const bf16_t*)(p.ws + OFF_ATTN);
  for (int tt = 0; tt < 8; ++tt) {
    const int token = t0 + wid * 8 + tt;
    float x[8];
    unpack8(*(const uint4*)(attn + (size_t)token * 512 + lane * 8), x);
    float ss = 0.f;
#pragma unroll
    for (int i = 0; i < 8; ++i) ss += x[i] * x[i];
    ss = wave_sum(ss);
    const float r = rsqrtf(ss * (1.f / 512.f) + 1e-6f);
    const float4 g0 = *(const float4*)(p.g_out_att + lane * 8), g1 = *(const float4*)(p.g_out_att + lane * 8 + 4);
    *(uint4*)(mix + (size_t)token * D + lane * 8) =
        make_uint4(pack2(x[0] * r * g0.x, x[1] * r * g0.y), pack2(x[2] * r * g0.z, x[3] * r * g0.w),
                   pack2(x[4] * r * g1.x, x[5] * r * g1.y), pack2(x[6] * r * g1.z, x[7] * r * g1.w));
  }
  bf16_t* sT = (bf16_t*)smem;
  const bf16_t* y2T = (const bf16_t*)(p.ws + OFF_Y2T);
  __syncthreads();
  for (int ch = tid; ch < 2048; ch += 256) {
    const int c = ch >> 2, q4 = ch & 3;
    const uint4 v = *(const uint4*)(y2T + (size_t)c * NTOK + t0 + q4 * 8);
    bf16_t* d = sT + (q4 * 8) * 520 + c;
    d[0 * 520] = (bf16_t)(v.x & 0xffff); d[1 * 520] = (bf16_t)(v.x >> 16);
    d[2 * 520] = (bf16_t)(v.y & 0xffff); d[3 * 520] = (bf16_t)(v.y >> 16);
    d[4 * 520] = (bf16_t)(v.z & 0xffff); d[5 * 520] = (bf16_t)(v.z >> 16);
    d[6 * 520] = (bf16_t)(v.w & 0xffff); d[7 * 520] = (bf16_t)(v.w >> 16);
  }
  __syncthreads();
  {
    const int tt = tid >> 3, part = tid & 7;
    uint4 v[8];
    float ss = 0.f;
#pragma unroll
    for (int i = 0; i < 8; ++i) {
      v[i] = *(const uint4*)(sT + tt * 520 + part * 64 + 8 * i);
      float x[8];
      unpack8(v[i], x);
#pragma unroll
      for (int e = 0; e < 8; ++e) ss += x[e] * x[e];
    }
    ss += __shfl_xor(ss, 1); ss += __shfl_xor(ss, 2); ss += __shfl_xor(ss, 4);
    const float r = rsqrtf(ss * (1.f / 512.f) + 1e-6f);
#pragma unroll
    for (int i = 0; i < 8; ++i) {
      float x[8];
      unpack8(v[i], x);
      const int c0 = part * 64 + 8 * i;
      const float4 g0 = *(const float4*)(p.g_out_hy + c0), g1 = *(const float4*)(p.g_out_hy + c0 + 4);
      *(uint4*)(mix + (size_t)(t0 + tt) * D + 512 + c0) =
          make_uint4(pack2(x[0] * r * g0.x, x[1] * r * g0.y), pack2(x[2] * r * g0.z, x[3] * r * g0.w),
                     pack2(x[4] * r * g1.x, x[5] * r * g1.y), pack2(x[6] * r * g1.z, x[7] * r * g1.w));
    }
  }
}

__device__ __forceinline__ void actfix_item(const Params& p, int item) {
  const int idx = item * 256 + ltid();
  if (idx >= 512 * 352) return;
  const int j = (idx % 352) * 8, rowi = idx / 352, wt = rowi >> 1, which = rowi & 1;
  const int t = 64 * wt + 63 * which, L = t < NCTX ? SEQC : SEQL, pos = t & (L - 1);
  const bf16_t* edge = (const bf16_t*)(p.ws + OFF_EDGE);
  bf16_t* act = (bf16_t*)(p.ws + OFF_U);
  const bf16_t *pr, *cu, *nx;
  bool zp = false, zn = false;
  if (which == 0) { zp = pos == 0; pr = edge + (size_t)((zp ? wt : wt - 1) * 4 + 3) * 5632; cu = edge + (size_t)(wt * 4 + 0) * 5632; nx = edge + (size_t)(wt * 4 + 1) * 5632; }
  else { zn = pos == L - 1; pr = edge + (size_t)(wt * 4 + 2) * 5632; cu = edge + (size_t)(wt * 4 + 3) * 5632; nx = edge + (size_t)((zn ? wt : wt + 1) * 4 + 0) * 5632; }
  float pa[8], pg[8], ca[8], cgv[8], na[8], ng[8];
  unpack8(*(const uint4*)(pr + j), pa); unpack8(*(const uint4*)(pr + 2816 + j), pg);
  unpack8(*(const uint4*)(cu + j), ca); unpack8(*(const uint4*)(cu + 2816 + j), cgv);
  unpack8(*(const uint4*)(nx + j), na); unpack8(*(const uint4*)(nx + 2816 + j), ng);
  float o[8];
#pragma unroll
  for (int e = 0; e < 8; ++e) {
    const float pae = zp ? 0.f : pa[e], pge = zp ? 0.f : pg[e], nae = zn ? 0.f : na[e], nge = zn ? 0.f : ng[e];
    const float a = p.ffn_conv_w[j + e] * pae + p.ffn_conv_w[5632 + j + e] * ca[e] + p.ffn_conv_w[11264 + j + e] * nae + p.ffn_conv_b[j + e];
    const float g = p.ffn_conv_w[2816 + j + e] * pge + p.ffn_conv_w[5632 + 2816 + j + e] * cgv[e] + p.ffn_conv_w[11264 + 2816 + j + e] * nge + p.ffn_conv_b[2816 + j + e];
    o[e] = a * __builtin_amdgcn_rcpf(1.f + __expf(-a)) * g;
  }
  *(uint4*)(act + (size_t)t * 2816 + j) = make_uint4(pack2(o[0], o[1]), pack2(o[2], o[3]), pack2(o[4], o[5]), pack2(o[6], o[7]));
}

#define XB_TMO      128
#define XB_XCNT(j)  (256  + 64 * (j))
#define XB_XSUB(j)  (1280 + 64 * (j))
#define XB_XGEN(j)  (2304 + 64 * (j))
#define XB_TOP      3328
#define XB_TOPGEN   3392
#define XCD_BAR_WORDS 3456
#define XB_SPIN_CAP (1u << 20)
#define LAS __attribute__((address_space(3)))
__device__ __forceinline__ unsigned xb_ld(unsigned* p) { return __hip_atomic_load(p, __ATOMIC_RELAXED, __HIP_MEMORY_SCOPE_AGENT); }
__device__ __forceinline__ unsigned xb_add(unsigned* p, unsigned v) { return __hip_atomic_fetch_add(p, v, __ATOMIC_RELAXED, __HIP_MEMORY_SCOPE_AGENT); }
__device__ __forceinline__ unsigned xb_xcc_id() { return (unsigned)__builtin_amdgcn_s_getreg((3 << 11) | 20) & 0xFu; }
#define XB_SPIN(cond, bar) do { unsigned _sp = 0; while (cond) { __builtin_amdgcn_s_sleep(1); \
    if ((++_sp & 255u) == 0u) { if (xb_ld(&(bar)[XB_TMO])) break; if (_sp > XB_SPIN_CAP) { atomicAdd(&(bar)[XB_TMO], 1u); break; } } } } while (0)
struct XcdBarrier { unsigned* bar; unsigned x; volatile LAS unsigned* st; };
__device__ __forceinline__ XcdBarrier xcd_barrier_post(unsigned* bar, volatile LAS unsigned* st) {
  XcdBarrier b; b.bar = bar; b.x = xb_xcc_id(); b.st = st;
  if (threadIdx.x == 0) (void)xb_add(&bar[XB_XCNT(b.x)], 1u);
  return b;
}
__device__ __forceinline__ void xcd_barrier_complete(unsigned* bar, unsigned x, unsigned& nloc, unsigned& nx) {
  const unsigned G = gridDim.x * gridDim.y * gridDim.z;
  unsigned sum, cnt, mine, sp = 0u;
  for (;;) {
    sum = 0u; cnt = 0u; mine = 0u;
#pragma unroll
    for (unsigned j = 0; j < 16; ++j) { const unsigned c = xb_ld(&bar[XB_XCNT(j)]); sum += c; cnt += (c > 0u) ? 1u : 0u; mine = (j == x) ? c : mine; }
    if (sum == G) break;
    __builtin_amdgcn_s_sleep(1);
    if ((++sp & 255u) == 0u) { if (xb_ld(&bar[XB_TMO])) break; if (sp > XB_SPIN_CAP) { atomicAdd(&bar[XB_TMO], 1u); break; } }
  }
  nloc = mine > 0u ? mine : 1u; nx = cnt > 0u ? cnt : 1u;
}
__device__ __forceinline__ void xcd_barrier(const XcdBarrier& b) {
  asm volatile("s_waitcnt vmcnt(0)" ::: "memory");
  __syncthreads();
  if (threadIdx.x == 0) {
    unsigned* bar = b.bar;
    __builtin_amdgcn_s_waitcnt(0);
    unsigned nloc = b.st[0], nx = b.st[1];
    if (nloc == 0u) { xcd_barrier_complete(bar, b.x, nloc, nx); b.st[0] = nloc; b.st[1] = nx; }
    const unsigned old = xb_add(&bar[XB_XSUB(b.x)], 1u);
    const unsigned gen = old / nloc;
    if (old + 1u == (gen + 1u) * nloc) {
      __builtin_amdgcn_fence(__ATOMIC_RELEASE, "agent");
      asm volatile("s_waitcnt vmcnt(0)" ::: "memory");
      const unsigned og = xb_add(&bar[XB_TOP], 1u);
      const unsigned tg = og / nx;
      if (og + 1u == (tg + 1u) * nx) xb_add(&bar[XB_TOPGEN], 1u);
      else XB_SPIN(xb_ld(&bar[XB_TOPGEN]) == tg, bar);
      __builtin_amdgcn_fence(__ATOMIC_ACQUIRE, "agent");
      xb_add(&bar[XB_XGEN(b.x)], 1u);
      asm volatile("s_waitcnt vmcnt(0)" ::: "memory");
    } else {
      XB_SPIN(xb_ld(&bar[XB_XGEN(b.x)]) == gen, bar);
      __builtin_amdgcn_fence(__ATOMIC_ACQUIRE, "agent");
      asm volatile("s_waitcnt vmcnt(0)" ::: "memory");
    }
  }
  __syncthreads();
}
constexpr size_t OFF_BAR = 25 * MiB - 16384;
static_assert(OFF_MOD + 3 * 6144 * 4 <= OFF_BAR, "bar");

template <int ph>
__device__ __forceinline__ void run_phase(const Params& p, char* smem) {
  const int bid = blockIdx.x, G = gridDim.x;
  char* ws = p.ws;
  if constexpr (ph == 0) {
    for (int it = bid; it < 272 + 96 + 32 + 3080; it += G) {
      if (it < 272) filter_item(p, it, smem);
      else if (it < 368) mod_item(p, it - 272, smem);
      else if (it < 400) cache_item(p, it - 368);
      else {
        int t = it - 400;
        if (t < 576) transpose_item(p.w_in, 1024, DIN, (bf16_t*)(ws + OFF_WIN), t, 36, smem);
        else if ((t -= 576) < 72) transpose_item(p.w_uq, 384, 768, (bf16_t*)(ws + OFF_WUQ), t, 12, smem);
        else if ((t -= 72) < 64) transpose_item(p.w_ukv, 256, 1024, (bf16_t*)(ws + OFF_WUKV), t, 16, smem);
        else if ((t -= 64) < 256) transpose_item(p.w_out, 1024, 1024, (bf16_t*)(ws + OFF_WOUT), t, 16, smem);
        else if ((t -= 256) < 1408) transpose_item(p.w_up, 1024, 5632, (bf16_t*)(ws + OFF_WUP), t, 88, smem, true);
        else { t -= 1408; transpose_item(p.w_down, 2816, 1024, (bf16_t*)(ws + OFF_WDOWN), t, 16, smem); }
      }
    }
  } else if constexpr (ph == 1) {
    rmsmod_phase<0>(p);
  } else if constexpr (ph == 2) {
    EpiIn epi{(float*)(ws + OFF_PROJ), (bf16_t*)(ws + OFF_HYT)};
    EpiProj epr{(float*)(ws + OFF_PROJ)};
    for (int t = bid; t < 128 * 18; t += G) {
      const int nt = t % 18;
      if (nt < 5) gemm_tile<true>((const bf16_t*)(ws + OFF_H), 1024, (const bf16_t*)(ws + OFF_WIN), 1024, 1024, (t / 18) * 128, nt * 128, smem, epr);
      else gemm_tile<false>((const bf16_t*)(ws + OFF_H), 1024, (const bf16_t*)(ws + OFF_WIN), 1024, 1024, (t / 18) * 128, nt * 128, smem, epi);
    }
  } else if constexpr (ph == 3) {
    for (int it = bid; it < 512; it += G) hyena_item<0>(p, 1, it, smem);
    for (int it = bid; it < 512; it += G) hyena_item<0>(p, 0, it, smem);
    for (int it = G - 1 - bid; it < 512; it += G) token_item(p, it);
  } else if constexpr (ph == 4) {
    EpiQ eq{(bf16_t*)(ws + OFF_QRAW)};
    EpiKV ekv{(bf16_t*)(ws + OFF_KRAW), (bf16_t*)(ws + OFF_VTC), (bf16_t*)(ws + OFF_VTL)};
    for (int it = bid; it < 512; it += G) hyena_item<1>(p, 1, it, smem);
    for (int t = bid; t < 768; t += G) gemm_tile<true>((const bf16_t*)(ws + OFF_QA), 384, (const bf16_t*)(ws + OFF_WUQ), 384, 384, (t / 6) * 128, (t % 6) * 128, smem, eq);
    for (int t = bid; t < 1088; t += G) gemm_tile<false>((const bf16_t*)(ws + OFF_CKVN), 256, (const bf16_t*)(ws + OFF_WUKV), 256, 256, (t / 8) * 128, (t % 8) * 128, smem, ekv);
    for (int it = bid; it < 512; it += G) hyena_item<1>(p, 0, it, smem);
  } else if constexpr (ph == 5) {
    for (int it = bid; it < 512 + 544; it += G) qk_item(p, it);
  } else if constexpr (ph == 6) {
    for (int it = bid; it < 1024; it += G) attn_item(p, it, smem);
  } else if constexpr (ph == 7) {
    for (int it = bid; it < 512; it += G) merge_item(p, it, smem);
  } else if constexpr (ph == 8) {
    EpiOut epi{&p};
    for (int t = bid; t < 128 * 8; t += G)
      gemm_tile<true>((const bf16_t*)(ws + OFF_H), 1024, (const bf16_t*)(ws + OFF_WOUT), 1024, 1024, (t / 8) * 128, (t % 8) * 128, smem, epi);
  } else if constexpr (ph == 9) {
    rmsmod_phase<1>(p);
  } else if constexpr (ph == 10) {
    for (int t = bid; t < 128 * 44; t += G) gemm_up_act_tile(p, (t / 44) * 128, (t % 44) * 128, smem);
  } else if constexpr (ph == 11) {
    for (int it = bid; it < 704; it += G) actfix_item(p, it);
  } else if constexpr (ph == 12) {
    EpiY epi{&p, 0};
    for (int t = bid; t < 128 * 8; t += G)
      gemm_tile<true>((const bf16_t*)(ws + OFF_U), 2816, (const bf16_t*)(ws + OFF_WDOWN), 2816, 2816, (t / 8) * 128, (t % 8) * 128, smem, epi);
  }
}

#if ONE_LAUNCH
template <int PH>
__device__ __forceinline__ void run_all(const Params& p, char* smem, cg::grid_group& grid, const XcdBarrier& xb) {
  run_phase<PH>(p, smem);
  if constexpr (((DBL_MASK >> PH) & 1) != 0) { xcd_barrier(xb); run_phase<PH>(p, smem); }
  if constexpr (PH < 12) {
    xcd_barrier(xb);
    run_all<PH + 1>(p, smem, grid, xb);
  }
}
constexpr int DYN_LDS = 65536 + 64;
__global__ void __launch_bounds__(256, 2) mega_kernel(Params p) {
  extern __shared__ __attribute__((aligned(16))) char smem[];
  uint4* xb_words = (uint4*)(smem + 65536);
  cg::grid_group grid = cg::this_grid();
  if (threadIdx.x == 0) *xb_words = make_uint4(0u, 0u, 0u, 0u);
  __syncthreads();
  XcdBarrier xb = xcd_barrier_post((unsigned*)(p.ws + OFF_BAR), (volatile LAS unsigned*)xb_words);
  if (p.ws == nullptr) grid.sync();
  run_all<0>(p, smem, grid, xb);
}
#else
template <int PH>
__global__ void __launch_bounds__(256, 2) phase_kernel(Params p) {
  __shared__ __attribute__((aligned(16))) char smem[SMEM_BYTES];
  run_phase<PH>(p, smem);
}
#ifndef DBG_STOP
#define DBG_STOP 15
#endif
__global__ void dump_kernel(Params p, size_t off, int count) {
  const bf16_t* src = (const bf16_t*)(p.ws + off);
  const bf16_t* src2 = (const bf16_t*)(p.ws + DBG_OFF2);
  for (int i = blockIdx.x * 256 + threadIdx.x; i < 16777216; i += gridDim.x * 256)
    p.out[i] = i < DBG_CNT ? bf2f(src[i]) : (i - DBG_CNT < DBG_CNT2 ? bf2f(src2[i - DBG_CNT]) : 0.f);
}
template <int PH>
static void launch_all(const Params& p, hipStream_t stream) {
  phase_kernel<PH><<<512, 256, 0, stream>>>(p);
  if constexpr (PH < 12) launch_all<PH + 1>(p, stream);
}
#endif

extern "C" void kernel_launch(void* const* d_in, const int* in_sizes, int n_in, void* d_out, int out_size, void* d_ws,
                              size_t ws_size, hipStream_t stream) {
  Params p{};
  const float** pp = (const float**)&p;
  for (int i = 0; i < 34; ++i) pp[i] = (const float*)d_in[i];
  p.out = (float*)d_out;
  p.ws = (char*)d_ws;
#if ONE_LAUNCH
  (void)hipMemsetAsync((char*)d_ws + OFF_BAR, 0, XCD_BAR_WORDS * 4, stream);
  static int grid_blocks = 0;
  if (!grid_blocks) {
    int dev = 0, cus = 0, per_cu = 0;
    hipGetDevice(&dev);
    hipDeviceGetAttribute(&cus, hipDeviceAttributeMultiprocessorCount, dev);
    (void)hipFuncSetAttribute((const void*)mega_kernel, hipFuncAttributeMaxDynamicSharedMemorySize, DYN_LDS);
    (void)hipOccupancyMaxActiveBlocksPerMultiprocessor(&per_cu, mega_kernel, 256, DYN_LDS);
    if (per_cu > 2) per_cu = 2;
    grid_blocks = cus * per_cu;
  }
  void* args[] = {&p};
  hipError_t e = hipLaunchCooperativeKernel((void*)mega_kernel, dim3(grid_blocks), dim3(256), args, DYN_LDS, stream);
  if (e != hipSuccess) fprintf(stderr, "cooperative launch failed: %s (grid %d)\n", hipGetErrorString(e), grid_blocks);
#else
  launch_all<0>(p, stream);
#if DBG_STOP < 15
  dump_kernel<<<1024, 256, 0, stream>>>(p, DBG_OFF, DBG_CNT);
#endif
#endif
}
```

```cpp
#include <hip/hip_runtime.h>
#include <hip/hip_cooperative_groups.h>
#include <cstdio>
namespace cg = cooperative_groups;

#define DBG_STOP 15
#define DBG_NOHY 0
#ifndef DBL_MASK
#define DBL_MASK 0
#endif
#define DBG_OFF OFF_QRAW
#define DBG_OFF2 OFF_KRAW
#define DBG_CNT 12582912
#define DBG_CNT2 0
#ifndef ONE_LAUNCH
#define ONE_LAUNCH 1
#endif

typedef unsigned short bf16_t;
typedef short bf16x8 __attribute__((ext_vector_type(8)));
typedef float f32x4 __attribute__((ext_vector_type(4)));
typedef float f32x16 __attribute__((ext_vector_type(16)));

constexpr int D = 1024, NTOK = 16384, NCTX = 8192, SEQC = 256, SEQL = 4096;
constexpr int DIN = 2208, DINP = 2304, QL = 384, KVL = 256, DFF = 2816;
constexpr int NROWKV = 17408;
constexpr size_t MiB = 1048576;

constexpr size_t OFF_WIN = 0;
constexpr size_t OFF_WUQ = OFF_WIN + (size_t)DINP * 1024 * 2;
constexpr size_t OFF_WUKV = OFF_WUQ + (size_t)768 * 384 * 2;
constexpr size_t OFF_WOUT = OFF_WUKV + (size_t)1024 * 256 * 2;
constexpr size_t OFF_WUP = OFF_WOUT + (size_t)1024 * 1024 * 2;
constexpr size_t OFF_WDOWN = OFF_WUP + (size_t)5632 * 1024 * 2;
constexpr size_t OFF_MOD = OFF_WDOWN + (size_t)1024 * 2816 * 2;
static_assert(OFF_MOD + 3 * 6144 * 4 <= 25 * MiB, "A region");
constexpr size_t OFF_RLAT = 25 * MiB;
constexpr size_t OFF_RCTX = 41 * MiB;
constexpr size_t OFF_H = 42 * MiB;
constexpr size_t OFF_ZT = 42 * MiB;
constexpr size_t OFF_QA = 58 * MiB;
constexpr size_t OFF_KPE = 70 * MiB;
constexpr size_t OFF_PROJ = 74 * MiB;
constexpr size_t OFF_QRAW = 74 * MiB;
constexpr size_t OFF_Y2T = 98 * MiB;
constexpr size_t OFF_ATTN = 74 * MiB;
constexpr size_t OFF_U = 74 * MiB;
constexpr size_t OFF_HYT = 116 * MiB;
constexpr size_t OFF_Q = 116 * MiB;
constexpr size_t OFF_KC = 140 * MiB;
constexpr size_t OFF_KL = 152 * MiB;
constexpr size_t OFF_CKVN = 164 * MiB;
constexpr size_t OFF_KRAW = 173 * MiB;
constexpr size_t OFF_VTC = 190 * MiB;
constexpr size_t OFF_VTL = 198 * MiB;
constexpr size_t OFF_ACT = 162 * MiB;

constexpr int OUT_YS = 0;
constexpr int OUT_CKV = 16777216;
constexpr int OUT_KPE = 16777216 + 2097152;

constexpr int SMEM_BYTES = 51200;

struct Params {
  const float *x_prompt, *x_sample, *cache_ckv, *cache_kpe, *c, *c_ctx, *w_ada, *b_ada, *g_mix, *w_in, *g_qa, *w_uq,
      *g_kva, *w_ukv, *g_q, *g_k, *hy_conv_w, *hy_conv_b, *filt_w1, *filt_b1, *filt_freq1, *filt_w2, *filt_b2,
      *filt_freq2, *filt_w3, *filt_bias, *g_out_att, *g_out_hy, *w_out, *g_ffn, *w_up, *ffn_conv_w, *ffn_conv_b, *w_down;
  float* out;
  char* ws;
};

typedef __bf16 bf16x2_t __attribute__((ext_vector_type(2)));
__device__ __forceinline__ unsigned pack2(float lo, float hi) {
  bf16x2_t v;
  v[0] = (__bf16)lo;
  v[1] = (__bf16)hi;
  return __builtin_bit_cast(unsigned, v);
}
__device__ __forceinline__ float bflo(unsigned u) { return __uint_as_float(u << 16); }
__device__ __forceinline__ float bfhi(unsigned u) { return __uint_as_float(u & 0xffff0000u); }
__device__ __forceinline__ float bf2f(bf16_t h) { return __uint_as_float(((unsigned)h) << 16); }
__device__ __forceinline__ bf16_t f2bf(float f) { return (bf16_t)(pack2(f, 0.f) & 0xffffu); }
__device__ __forceinline__ float wave_sum(float v) {
#pragma unroll
  for (int o = 32; o >= 1; o >>= 1) v += __shfl_xor(v, o);
  return v;
}
__device__ __forceinline__ int ltid() { int t = threadIdx.x; asm volatile("" : "+v"(t)); return t; }
__device__ __forceinline__ float sin_turns(float t) { t -= floorf(t); return __builtin_amdgcn_sinf(t); }
__device__ __forceinline__ float cos_turns(float t) { t -= floorf(t); return __builtin_amdgcn_cosf(t); }
__device__ __forceinline__ float sin_rad(float x) { return sin_turns(x * 0.15915494309189535f); }
__device__ __forceinline__ const float* xrow(const Params& p, int row) {
  return row < NCTX ? p.x_prompt + (size_t)row * D : p.x_sample + (size_t)(row - NCTX) * D;
}
__device__ __forceinline__ int modidx(int row) { return row < NCTX ? 0 : 1 + ((row - NCTX) >> 12); }

template <bool SWAP>
__device__ __forceinline__ void gemm_main(const bf16_t* __restrict__ A, int lda, const bf16_t* __restrict__ Bt, int ldb,
                                          int K, int m0, int n0, char* smem, f32x4 (&acc)[4][4]) {
  const int tid = ltid(), lane = tid & 63, wid = tid >> 6, wr = wid >> 1, wc = wid & 1;
  const int fr = lane & 15, fq = lane >> 4;
  bf16_t* sbase = (bf16_t*)smem;
#pragma unroll
  for (int m = 0; m < 4; ++m)
#pragma unroll
    for (int n = 0; n < 4; ++n) acc[m][n] = (f32x4){0.f, 0.f, 0.f, 0.f};
  const int lr = tid >> 3, lc = (tid & 7) * 8;
  const bf16_t* ga = A + (size_t)(m0 + lr) * lda + lc;
  const bf16_t* gb = Bt + (size_t)(n0 + lr) * ldb + lc;
  const size_t sa32 = (size_t)32 * lda, sb32 = (size_t)32 * ldb;
  uint4 ra0 = *(const uint4*)(ga), ra1 = *(const uint4*)(ga + sa32), ra2 = *(const uint4*)(ga + 2 * sa32), ra3 = *(const uint4*)(ga + 3 * sa32);
  uint4 rb0 = *(const uint4*)(gb), rb1 = *(const uint4*)(gb + sb32), rb2 = *(const uint4*)(gb + 2 * sb32), rb3 = *(const uint4*)(gb + 3 * sb32);
  const int nk = K >> 6;
  const int woff = lr * 64 + (((tid & 7) ^ (lr & 7)) * 8);
  const int aoff = (wr * 64 + fr) * 64, boff = 8192 + (wc * 64 + fr) * 64;
  __syncthreads();
  {
    bf16_t* wa = sbase + woff;
    *(uint4*)(wa) = ra0; *(uint4*)(wa + 32 * 64) = ra1; *(uint4*)(wa + 64 * 64) = ra2; *(uint4*)(wa + 96 * 64) = ra3;
    *(uint4*)(wa + 8192) = rb0; *(uint4*)(wa + 8192 + 32 * 64) = rb1; *(uint4*)(wa + 8192 + 64 * 64) = rb2; *(uint4*)(wa + 8192 + 96 * 64) = rb3;
  }
  if (nk > 1) {
    ga += 64; gb += 64;
    ra0 = *(const uint4*)(ga); ra1 = *(const uint4*)(ga + sa32); ra2 = *(const uint4*)(ga + 2 * sa32); ra3 = *(const uint4*)(ga + 3 * sa32);
    rb0 = *(const uint4*)(gb); rb1 = *(const uint4*)(gb + sb32); rb2 = *(const uint4*)(gb + 2 * sb32); rb3 = *(const uint4*)(gb + 3 * sb32);
  }
  __syncthreads();
  for (int kt = 0; kt < nk; ++kt) {
    const bf16_t* cur = sbase + (kt & 1) * 16384;
    if (kt + 1 < nk) {
      bf16_t* wa = sbase + ((kt + 1) & 1) * 16384 + woff;
      *(uint4*)(wa) = ra0; *(uint4*)(wa + 32 * 64) = ra1; *(uint4*)(wa + 64 * 64) = ra2; *(uint4*)(wa + 96 * 64) = ra3;
      *(uint4*)(wa + 8192) = rb0; *(uint4*)(wa + 8192 + 32 * 64) = rb1; *(uint4*)(wa + 8192 + 64 * 64) = rb2; *(uint4*)(wa + 8192 + 96 * 64) = rb3;
      if (kt + 2 < nk) {
        ga += 64; gb += 64;
        ra0 = *(const uint4*)(ga); ra1 = *(const uint4*)(ga + sa32); ra2 = *(const uint4*)(ga + 2 * sa32); ra3 = *(const uint4*)(ga + 3 * sa32);
        rb0 = *(const uint4*)(gb); rb1 = *(const uint4*)(gb + sb32); rb2 = *(const uint4*)(gb + 2 * sb32); rb3 = *(const uint4*)(gb + 3 * sb32);
      }
    }
    __builtin_amdgcn_sched_barrier(0);
    {
      bf16x8 af[2][4], bfr[2][4];
#pragma unroll
      for (int ks = 0; ks < 2; ++ks) {
#pragma unroll
        for (int m = 0; m < 4; ++m) af[ks][m] = *(const bf16x8*)(cur + aoff + m * 16 * 64 + (((ks * 4 + fq) ^ (fr & 7)) * 8));
#pragma unroll
        for (int n = 0; n < 4; ++n) bfr[ks][n] = *(const bf16x8*)(cur + boff + n * 16 * 64 + (((ks * 4 + fq) ^ (fr & 7)) * 8));
      }
      __builtin_amdgcn_sched_barrier(0);
      __builtin_amdgcn_s_setprio(1);
#pragma unroll
      for (int ks = 0; ks < 2; ++ks)
#pragma unroll
        for (int m = 0; m < 4; ++m)
#pragma unroll
          for (int n = 0; n < 4; ++n) {
            if (SWAP) acc[m][n] = __builtin_amdgcn_mfma_f32_16x16x32_bf16(bfr[ks][n], af[ks][m], acc[m][n], 0, 0, 0);
            else acc[m][n] = __builtin_amdgcn_mfma_f32_16x16x32_bf16(af[ks][m], bfr[ks][n], acc[m][n], 0, 0, 0);
          }
      __builtin_amdgcn_s_setprio(0);
    }
    if (kt + 1 < nk) __syncthreads();
  }
}
template <bool SWAP, class Epi>
__device__ __forceinline__ void gemm_tile(const bf16_t* __restrict__ A, int lda, const bf16_t* __restrict__ Bt, int ldb,
                                          int K, int m0, int n0, char* smem, const Epi& epi) {
  f32x4 acc[4][4];
  gemm_main<SWAP>(A, lda, Bt, ldb, K, m0, n0, smem, acc);
  const int tid = ltid(), lane = tid & 63, wid = tid >> 6, wr = wid >> 1, wc = wid & 1;
  const int fr = lane & 15, fq = lane >> 4;
#pragma unroll
  for (int m = 0; m < 4; ++m)
#pragma unroll
    for (int n = 0; n < 4; ++n) {
      if (SWAP) epi(m0 + wr * 64 + m * 16 + fr, n0 + wc * 64 + n * 16 + fq * 4, acc[m][n]);
      else epi(m0 + wr * 64 + m * 16 + fq * 4, n0 + wc * 64 + n * 16 + fr, acc[m][n]);
    }
}

template <int CTRL>
__device__ __forceinline__ float dpp_ror(float v) {
  return __int_as_float(__builtin_amdgcn_update_dpp(0, __float_as_int(v), CTRL, 0xF, 0xF, false));
}
constexpr size_t OFF_EDGE = 162 * MiB;
__device__ __forceinline__ void gemm_up_act_tile(const Params& p, int m0, int n0, char* smem) {
  f32x4 acc[4][4];
  gemm_main<true>((const bf16_t*)(p.ws + OFF_H), 1024, (const bf16_t*)(p.ws + OFF_WUP), 1024, 1024, m0, n0, smem, acc);
  const int tid = ltid(), lane = tid & 63, wid = tid >> 6, wr = wid >> 1, wc = wid & 1;
  const int fr = lane & 15, fq = lane >> 4;
  bf16_t* act = (bf16_t*)(p.ws + OFF_U);
  bf16_t* edge = (bf16_t*)(p.ws + OFF_EDGE);
  const int rowbase = m0 + wr * 64, wt = rowbase >> 6;
#pragma unroll
  for (int i = 0; i < 2; ++i) {
    const int cperm = n0 + wc * 64 + 32 * i;
    const int j0 = (cperm >> 5) * 16 + 4 * fq;
    const float4 wa0 = *(const float4*)(p.ffn_conv_w + j0), wa1 = *(const float4*)(p.ffn_conv_w + 5632 + j0), wa2 = *(const float4*)(p.ffn_conv_w + 11264 + j0);
    const float4 wg0 = *(const float4*)(p.ffn_conv_w + 2816 + j0), wg1 = *(const float4*)(p.ffn_conv_w + 5632 + 2816 + j0), wg2 = *(const float4*)(p.ffn_conv_w + 11264 + 2816 + j0);
    const float4 ba = *(const float4*)(p.ffn_conv_b + j0), bg = *(const float4*)(p.ffn_conv_b + 2816 + j0);
    const float w0a[4] = {wa0.x, wa0.y, wa0.z, wa0.w}, w1a[4] = {wa1.x, wa1.y, wa1.z, wa1.w}, w2a[4] = {wa2.x, wa2.y, wa2.z, wa2.w};
    const float w0g[4] = {wg0.x, wg0.y, wg0.z, wg0.w}, w1g[4] = {wg1.x, wg1.y, wg1.z, wg1.w}, w2g[4] = {wg2.x, wg2.y, wg2.z, wg2.w};
    const float bba[4] = {ba.x, ba.y, ba.z, ba.w}, bbg[4] = {bg.x, bg.y, bg.z, bg.w};
#pragma unroll
    for (int m = 0; m < 4; ++m) {
      float o[4];
#pragma unroll
      for (int e = 0; e < 4; ++e) {
        const float a = acc[m][2 * i][e], g = acc[m][2 * i + 1][e];
        const float au1 = dpp_ror<0x121>(a), gu1 = dpp_ror<0x121>(g), ad1 = dpp_ror<0x12F>(a), gd1 = dpp_ror<0x12F>(g);
        float au2 = 0.f, gu2 = 0.f, ad2 = 0.f, gd2 = 0.f;
        if (m > 0) { au2 = dpp_ror<0x121>(acc[m - 1][2 * i][e]); gu2 = dpp_ror<0x121>(acc[m - 1][2 * i + 1][e]); }
        if (m < 3) { ad2 = dpp_ror<0x12F>(acc[m + 1][2 * i][e]); gd2 = dpp_ror<0x12F>(acc[m + 1][2 * i + 1][e]); }
        const float au = fr > 0 ? au1 : au2, gu = fr > 0 ? gu1 : gu2, ad = fr < 15 ? ad1 : ad2, gd = fr < 15 ? gd1 : gd2;
        const float ca = w0a[e] * au + w1a[e] * a + w2a[e] * ad + bba[e];
        const float cgv = w0g[e] * gu + w1g[e] * g + w2g[e] * gd + bbg[e];
        o[e] = ca * __builtin_amdgcn_rcpf(1.f + __expf(-ca)) * cgv;
      }
      const int lr64 = m * 16 + fr, row = rowbase + lr64;
      if (lr64 >= 1 && lr64 <= 62) *(uint2*)(act + (size_t)row * 2816 + j0) = make_uint2(pack2(o[0], o[1]), pack2(o[2], o[3]));
      if (lr64 <= 1 || lr64 >= 62) {
        const int slot = lr64 <= 1 ? lr64 : lr64 - 60;
        bf16_t* er = edge + (size_t)(wt * 4 + slot) * 5632;
        *(uint2*)(er + j0) = make_uint2(pack2(acc[m][2 * i][0], acc[m][2 * i][1]), pack2(acc[m][2 * i][2], acc[m][2 * i][3]));
        *(uint2*)(er + 2816 + j0) = make_uint2(pack2(acc[m][2 * i + 1][0], acc[m][2 * i + 1][1]), pack2(acc[m][2 * i + 1][2], acc[m][2 * i + 1][3]));
      }
    }
  }
}

__device__ __forceinline__ void transpose_item(const float* __restrict__ W, int K, int N, bf16_t* __restrict__ WT, int tile, int ntn, char* smem, bool perm = false) {
  float* s = (float*)smem;
  const int tk = tile / ntn, tn = tile % ntn, tid = ltid();
  const int k0 = tk * 64, n0 = tn * 64;
  __syncthreads();
  {
    const int r = tid >> 4, c4 = (tid & 15) * 4;
#pragma unroll
    for (int i = 0; i < 4; ++i) {
      const int k = r + 16 * i;
      float4 v = make_float4(0.f, 0.f, 0.f, 0.f);
      if (n0 + c4 < N) v = *(const float4*)(W + (size_t)(k0 + k) * N + n0 + c4);
      s[k * 65 + c4 + 0] = v.x; s[k * 65 + c4 + 1] = v.y; s[k * 65 + c4 + 2] = v.z; s[k * 65 + c4 + 3] = v.w;
    }
  }
  __syncthreads();
  {
    const int n = tid >> 2, kc = (tid & 3) * 16;
    unsigned o[8];
#pragma unroll
    for (int i = 0; i < 8; ++i) o[i] = pack2(s[(kc + 2 * i) * 65 + n], s[(kc + 2 * i + 1) * 65 + n]);
    int nr = n0 + n;
    if (perm) { const int hf = nr >= 2816 ? 1 : 0, cc = nr - hf * 2816; nr = 32 * (cc >> 4) + 16 * hf + (cc & 15); }
    uint4* dst = (uint4*)(WT + (size_t)nr * K + k0 + kc);
    dst[0] = make_uint4(o[0], o[1], o[2], o[3]);
    dst[1] = make_uint4(o[4], o[5], o[6], o[7]);
  }
}

__device__ __forceinline__ void mod_item(const Params& p, int item, char* smem) {
  float* s = (float*)smem;
  float* red = s + 3072;
  const int tid = ltid();
  __syncthreads();
  for (int e = tid; e < 3072; e += 256) {
    const int v = e >> 10, k = e & 1023;
    const float x = (v == 0) ? p.c_ctx[k] : p.c[(v - 1) * D + k];
    s[e] = x / (1.f + __expf(-x));
  }
  __syncthreads();
  const int jl = tid & 63, kq = tid >> 6, j = item * 64 + jl, k0 = kq * 256;
  float a0 = 0.f, a1 = 0.f, a2 = 0.f;
#pragma unroll 8
  for (int k = 0; k < 256; ++k) {
    const float w = p.w_ada[(size_t)(k0 + k) * 6144 + j];
    a0 += s[k0 + k] * w; a1 += s[1024 + k0 + k] * w; a2 += s[2048 + k0 + k] * w;
  }
  red[(kq * 3 + 0) * 64 + jl] = a0; red[(kq * 3 + 1) * 64 + jl] = a1; red[(kq * 3 + 2) * 64 + jl] = a2;
  __syncthreads();
  if (tid < 192) {
    const int v = tid >> 6;
    const float r = red[(0 * 3 + v) * 64 + jl] + red[(1 * 3 + v) * 64 + jl] + red[(2 * 3 + v) * 64 + jl] + red[(3 * 3 + v) * 64 + jl];
    ((float*)(p.ws + OFF_MOD))[v * 6144 + j] = r + p.b_ada[j];
  }
}

__device__ __forceinline__ void filter_item(const Params& p, int item, char* smem) {
  int n, p0; bf16_t* R;
  if (item < 256) { n = 4096; p0 = item * 16; R = (bf16_t*)(p.ws + OFF_RLAT); }
  else { n = 256; p0 = (item - 256) * 16; R = (bf16_t*)(p.ws + OFF_RCTX); }
  const int n2 = 2 * n, tid = ltid();
  float* z = (float*)smem;
  float* h1 = z + 16 * 36;
  float* h2 = h1 + 16 * 64;
  __syncthreads();
#pragma unroll 1
  for (int e = tid; e < 16 * 33; e += 256) {
    const int pp = e / 33, f = e % 33, pos = p0 + pp;
    float val;
    if (f == 0) val = (float)pos / (float)(n - 1);
    else {
      const int k = (f - 1) & 15;
      const float band = 1e-4f + (float)k * ((15.f - 1e-4f) / 15.f);
      const float turns = band * ((float)pos / (float)n);
      val = (f <= 16) ? cos_turns(turns) : -sin_turns(turns);
    }
    z[pp * 36 + f] = val;
  }
  __syncthreads();
#pragma unroll 1
  for (int e = tid; e < 1024; e += 256) {
    const int pp = e >> 6, j = e & 63;
    float a = p.filt_b1[j];
#pragma unroll 3
    for (int f = 0; f < 33; ++f) a += z[pp * 36 + f] * p.filt_w1[f * 64 + j];
    h1[e] = sin_rad(p.filt_freq1[j] * a);
  }
  __syncthreads();
#pragma unroll 1
  for (int e = tid; e < 1024; e += 256) {
    const int pp = e >> 6, j = e & 63;
    float a = p.filt_b2[j];
#pragma unroll 4
    for (int k = 0; k < 64; ++k) a += h1[pp * 64 + k] * p.filt_w2[k * 64 + j];
    h2[j * 16 + pp] = sin_rad(p.filt_freq2[j] * a);
  }
  __syncthreads();
  const float mind = -3.0701134573253946f, maxd = -15.350567286626973f;
#pragma unroll 1
  for (int ci = 0; ci < 8; ++ci) {
    const int col = tid + 256 * ci, o = col >> 10, dir = (col >> 9) & 1, c = col & 511;
    float acc[16];
#pragma unroll
    for (int i = 0; i < 16; ++i) acc[i] = 0.f;
#pragma unroll 4
    for (int k = 0; k < 64; ++k) {
      const float w = p.filt_w3[k * 2048 + col];
      const float4 ha = *(const float4*)(h2 + k * 16), hb = *(const float4*)(h2 + k * 16 + 4), hc = *(const float4*)(h2 + k * 16 + 8), hd = *(const float4*)(h2 + k * 16 + 12);
      acc[0] += ha.x * w; acc[1] += ha.y * w; acc[2] += ha.z * w; acc[3] += ha.w * w;
      acc[4] += hb.x * w; acc[5] += hb.y * w; acc[6] += hb.z * w; acc[7] += hb.w * w;
      acc[8] += hc.x * w; acc[9] += hc.y * w; acc[10] += hc.z * w; acc[11] += hc.w * w;
      acc[12] += hd.x * w; acc[13] += hd.y * w; acc[14] += hd.z * w; acc[15] += hd.w * w;
    }
    const float delta = fabsf(mind + (float)c * ((maxd - mind) / 511.f));
    bf16_t* Rrow = R + (size_t)(o * 512 + c) * n2;
#pragma unroll
    for (int i = 0; i < 16; ++i) {
      const int pos = p0 + i;
      const float t = (float)pos / (float)(n - 1);
      float val = acc[i] * (__expf(-t * delta) + 0.05f);
      int idx = dir == 0 ? (n - 1 - pos) : (n - 1 + pos);
      if (dir == 1 && pos == 0) { idx = n2 - 1; val = 0.f; }
      Rrow[idx] = f2bf(val);
    }
  }
}

__device__ __forceinline__ void cache_item(const Params& p, int item) {
  const int tid = ltid(), r0 = item * 32;
  bf16_t* ckvn = (bf16_t*)(p.ws + OFF_CKVN);
#pragma unroll 2
  for (int e = tid; e < 32 * 64; e += 256) {
    const int r = r0 + (e >> 6), c4 = (e & 63) * 4;
    const float4 v = *(const float4*)(p.cache_ckv + (size_t)r * 256 + c4);
    *(uint2*)(ckvn + (size_t)(NTOK + r) * 256 + c4) = make_uint2(pack2(v.x, v.y), pack2(v.z, v.w));
  }
}

template <int WHICH>
__device__ __forceinline__ void rmsmod_phase(const Params& p) {
  const int tid = ltid(), lane = tid & 63, wid = tid >> 6;
  const int gw = blockIdx.x * 4 + wid, tw = gridDim.x * 4;
  const float* g = WHICH == 0 ? p.g_mix : p.g_ffn;
  const float* mod = (const float*)(p.ws + OFF_MOD);
  bf16_t* h = (bf16_t*)(p.ws + OFF_H);
  float4 nv0, nv1, nv2, nv3;
  {
    const float* src = WHICH == 0 ? xrow(p, gw) : p.out + (size_t)gw * D;
    nv0 = ((const float4*)src)[lane]; nv1 = ((const float4*)src)[lane + 64]; nv2 = ((const float4*)src)[lane + 128]; nv3 = ((const float4*)src)[lane + 192];
  }
  for (int row = gw; row < NTOK; row += tw) {
    float4 v[4] = {nv0, nv1, nv2, nv3};
    if (row + tw < NTOK) {
      const float* src = WHICH == 0 ? xrow(p, row + tw) : p.out + (size_t)(row + tw) * D;
      nv0 = ((const float4*)src)[lane]; nv1 = ((const float4*)src)[lane + 64]; nv2 = ((const float4*)src)[lane + 128]; nv3 = ((const float4*)src)[lane + 192];
    }
    float ss = 0.f;
#pragma unroll
    for (int i = 0; i < 4; ++i) ss += v[i].x * v[i].x + v[i].y * v[i].y + v[i].z * v[i].z + v[i].w * v[i].w;
    ss = wave_sum(ss);
    const float r = rsqrtf(ss * (1.f / 1024.f) + 1e-6f);
    const float* mv = mod + modidx(row) * 6144 + (WHICH == 0 ? 0 : 3 * 1024);
#pragma unroll
    for (int i = 0; i < 4; ++i) {
      const int e = 4 * (lane + 64 * i);
      const float4 g4 = *(const float4*)(g + e), sh = *(const float4*)(mv + e), sc = *(const float4*)(mv + 1024 + e);
      const float y0 = v[i].x * r * g4.x * (1.f + sc.x) + sh.x, y1 = v[i].y * r * g4.y * (1.f + sc.y) + sh.y;
      const float y2 = v[i].z * r * g4.z * (1.f + sc.z) + sh.z, y3 = v[i].w * r * g4.w * (1.f + sc.w) + sh.w;
      *(uint2*)(h + (size_t)row * D + e) = make_uint2(pack2(y0, y1), pack2(y2, y3));
    }
  }
}

struct EpiIn {
  float* proj; bf16_t* hyT;
  __device__ __forceinline__ void operator()(int row0, int col, const f32x4& v) const {
    if (col < 672) {
#pragma unroll
      for (int j = 0; j < 4; ++j) proj[(size_t)(row0 + j) * 672 + col] = v[j];
    } else if (col < DIN) {
      *(uint2*)(hyT + (size_t)(col - 672) * NTOK + row0) = make_uint2(pack2(v[0], v[1]), pack2(v[2], v[3]));
    }
  }
};
struct EpiProj {
  float* proj;
  __device__ __forceinline__ void operator()(int row, int col0, const f32x4& v) const { *(f32x4*)(proj + (size_t)row * 672 + col0) = v; }
};
struct EpiQ {
  bf16_t* q;
  __device__ __forceinline__ void operator()(int row, int col0, const f32x4& v) const {
    *(uint2*)(q + (size_t)row * 768 + col0) = make_uint2(pack2(v[0], v[1]), pack2(v[2], v[3]));
  }
};
struct EpiKV {
  bf16_t *kraw, *vtc, *vtl;
  __device__ __forceinline__ void operator()(int row0, int col, const f32x4& v) const {
    const int head = col >> 7, cc = col & 127;
    if (cc < 64) {
#pragma unroll
      for (int j = 0; j < 4; ++j) kraw[(size_t)(row0 + j) * 512 + head * 64 + cc] = f2bf(v[j]);
    } else {
      const int dv = cc - 64;
      bf16_t* dst;
      if (row0 < NCTX) dst = vtc + ((size_t)((row0 >> 8) * 8 + head) * 64 + dv) * 256 + (row0 & 255);
      else if (row0 < NTOK) { const int r = row0 - NCTX; dst = vtl + ((size_t)((r >> 12) * 8 + head) * 64 + dv) * 4608 + (r & 4095); }
      else { const int r = row0 - NTOK; dst = vtl + ((size_t)((r >> 9) * 8 + head) * 64 + dv) * 4608 + 4096 + (r & 511); }
      *(uint2*)dst = make_uint2(pack2(v[0], v[1]), pack2(v[2], v[3]));
    }
  }
};
struct EpiOut {
  const Params* p;
  __device__ __forceinline__ void operator()(int row, int col0, const f32x4& v) const {
    const float4 x = *(const float4*)(xrow(*p, row) + col0);
    const float4 m = *(const float4*)((const float*)(p->ws + OFF_MOD) + modidx(row) * 6144 + 2 * 1024 + col0);
    *(float4*)(p->out + (size_t)row * D + col0) = make_float4(x.x + m.x * v[0], x.y + m.y * v[1], x.z + m.z * v[2], x.w + m.w * v[3]);
  }
};
struct EpiU {
  bf16_t* u;
  __device__ __forceinline__ void operator()(int row, int col0, const f32x4& v) const {
    *(uint2*)(u + (size_t)row * 5632 + col0) = make_uint2(pack2(v[0], v[1]), pack2(v[2], v[3]));
  }
};
struct EpiY {
  const Params* p; int half;
  __device__ __forceinline__ void operator()(int row, int col0, const f32x4& v) const {
    const int grow = half * 8192 + row;
    float4* dst = (float4*)(p->out + (size_t)grow * D + col0);
    const float4 x = *dst;
    const float4 m = *(const float4*)((const float*)(p->ws + OFF_MOD) + modidx(grow) * 6144 + 5 * 1024 + col0);
    *dst = make_float4(x.x + m.x * v[0], x.y + m.y * v[1], x.z + m.z * v[2], x.w + m.w * v[3]);
  }
};

__device__ __forceinline__ void token_item(const Params& p, int item) {
  const int tid = ltid(), lane = tid & 63, wid = tid >> 6;
  const float* proj = (const float*)(p.ws + OFF_PROJ);
  bf16_t* qa = (bf16_t*)(p.ws + OFF_QA);
  bf16_t* ckvn = (bf16_t*)(p.ws + OFF_CKVN);
  float* kpe = (float*)(p.ws + OFF_KPE);
  for (int tt = 0; tt < 8; ++tt) {
    const int token = item * 32 + wid * 8 + tt;
    const float* pr = proj + (size_t)token * 672;
    float2 q[3];
    float ss = 0.f;
#pragma unroll
    for (int i = 0; i < 3; ++i) { q[i] = *(const float2*)(pr + lane * 2 + 128 * i); ss += q[i].x * q[i].x + q[i].y * q[i].y; }
    ss = wave_sum(ss);
    const float r = rsqrtf(ss * (1.f / 384.f) + 1e-6f);
#pragma unroll
    for (int i = 0; i < 3; ++i) {
      const int e = lane * 2 + 128 * i;
      *(unsigned*)(qa + (size_t)token * 384 + e) = pack2(q[i].x * r * p.g_qa[e], q[i].y * r * p.g_qa[e + 1]);
    }
    const float4 kv = *(const float4*)(pr + 384 + lane * 4);
    float s2 = wave_sum(kv.x * kv.x + kv.y * kv.y + kv.z * kv.z + kv.w * kv.w);
    const float r2 = rsqrtf(s2 * (1.f / 256.f) + 1e-6f);
    const float4 g = *(const float4*)(p.g_kva + lane * 4);
    const float4 y = make_float4(kv.x * r2 * g.x, kv.y * r2 * g.y, kv.z * r2 * g.z, kv.w * r2 * g.w);
    *(uint2*)(ckvn + (size_t)token * 256 + lane * 4) = make_uint2(pack2(y.x, y.y), pack2(y.z, y.w));
    if (token < NCTX) *(float4*)(p.out + OUT_CKV + (size_t)token * 256 + lane * 4) = y;
    if (lane < 32) {
      const float kp = pr[640 + lane];
      kpe[(size_t)token * 32 + lane] = kp;
      if (token < NCTX) p.out[OUT_KPE + (size_t)token * 32 + lane] = kp;
    }
  }
}

template <int ORDER>
__device__ __forceinline__ void hyena_item(const Params& p, int grp, int c, char* smem) {
  const int tid = ltid(), lane = tid & 63, wid = tid >> 6, fr = lane & 15, fq = lane >> 4;
  const int n = grp ? SEQL : SEQC, nb = n >> 6, L = n;
  const bf16_t* Rrow = (const bf16_t*)(p.ws + (grp ? OFF_RLAT : OFF_RCTX)) + (size_t)(ORDER * 512 + c) * (2 * n);
  const bf16_t* hyT = (const bf16_t*)(p.ws + OFF_HYT);
  bf16_t* sU = (bf16_t*)smem;
  unsigned* sR0 = (unsigned*)(smem + 18432);
  unsigned* sR1 = (unsigned*)(smem + 18432 + 16384);
  const int tok0 = grp * 8192;
  __syncthreads();
  for (int ch = tid; ch < (2 * n) / 8; ch += 256) *(uint4*)((bf16_t*)sR0 + ch * 8) = *(const uint4*)(Rrow + ch * 8);
  if (ORDER == 0) {
    const bf16_t* raw = hyT + (size_t)c * NTOK + tok0;
    const float w0 = p.hy_conv_w[c], w1 = p.hy_conv_w[1536 + c], w2 = p.hy_conv_w[3072 + c], b = p.hy_conv_b[c];
    for (int ch = tid; ch < 1024; ch += 256) {
      const int t = ch * 8, pos = t & (L - 1);
      const uint4 rv = *(const uint4*)(raw + t);
      float x[10];
      x[0] = pos == 0 ? 0.f : bf2f(raw[t - 1]);
      x[1] = bflo(rv.x); x[2] = bfhi(rv.x); x[3] = bflo(rv.y); x[4] = bfhi(rv.y);
      x[5] = bflo(rv.z); x[6] = bfhi(rv.z); x[7] = bflo(rv.w); x[8] = bfhi(rv.w);
      x[9] = (pos + 8 == L) ? 0.f : bf2f(raw[t + 8]);
      float u[8];
#pragma unroll
      for (int i = 0; i < 8; ++i) u[i] = w0 * x[i] + w1 * x[i + 1] + w2 * x[i + 2] + b;
      *(uint4*)(sU + (ch >> 3) * 64 + (((ch & 7) ^ ((ch >> 3) & 7)) * 8)) = make_uint4(pack2(u[0], u[1]), pack2(u[2], u[3]), pack2(u[4], u[5]), pack2(u[6], u[7]));
    }
  } else {
    const bf16_t* zr = (const bf16_t*)(p.ws + OFF_ZT) + (size_t)c * NTOK + tok0;
    for (int ch = tid; ch < 1024; ch += 256) *(uint4*)(sU + (ch >> 3) * 64 + (((ch & 7) ^ ((ch >> 3) & 7)) * 8)) = *(const uint4*)(zr + ch * 8);
  }
  __syncthreads();
  for (int k = tid; k < n; k += 256) {
    const unsigned a = sR0[k], b2 = (k + 1 < n) ? sR0[k + 1] : 0u;
    sR1[k] = (a >> 16) | (b2 << 16);
  }
  __syncthreads();

  f32x4 acc[4][2];
#pragma unroll
  for (int m = 0; m < 4; ++m) { acc[m][0] = (f32x4){0.f, 0.f, 0.f, 0.f}; acc[m][1] = (f32x4){0.f, 0.f, 0.f, 0.f}; }
  const unsigned* abase = (fr & 1) ? (sR0 + ((n - 1 - fr) >> 1) + 4 * fq) : (sR1 + ((n - 2 - fr) >> 1) + 4 * fq);
  const int col0 = 32 * wid + fr, col1 = col0 + 16;
  const int i0 = col0 & (nb - 1), i1 = col1 & (nb - 1);
  for (int d = -(nb - 1); d <= nb - 1; ++d) {
    const bool v0 = (unsigned)(i0 - d) < (unsigned)nb, v1 = (unsigned)(i1 - d) < (unsigned)nb;
    const bool any0 = __ballot(v0) != 0ull, any1 = __ballot(v1) != 0ull;
    if (!any0 && !any1) continue;
    bf16x8 F[6];
    const unsigned* ap = abase - 32 * d + 16;
#pragma unroll
    for (int idx = 0; idx < 6; ++idx) {
      const unsigned* q = ap - 8 * idx;
      union { unsigned u[4]; bf16x8 v; } cv;
      cv.u[0] = q[0]; cv.u[1] = q[1]; cv.u[2] = q[2]; cv.u[3] = q[3];
      F[idx] = cv.v;
    }
#pragma unroll
    for (int nt = 0; nt < 2; ++nt) {
      if (!(nt ? any1 : any0)) continue;
      const bool vv = nt ? v1 : v0;
      const int srow = (nt ? col1 : col0) - d;
      const bf16_t* up = sU + srow * 64;
#pragma unroll
      for (int ks = 0; ks < 2; ++ks) {
        bf16x8 bf = (bf16x8){0, 0, 0, 0, 0, 0, 0, 0};
        if (vv) bf = *(const bf16x8*)(up + (((ks * 4 + fq) ^ (srow & 7)) * 8));
#pragma unroll
        for (int m = 0; m < 4; ++m)
          acc[m][nt] = __builtin_amdgcn_mfma_f32_16x16x32_bf16(F[m + 2 - 2 * ks], bf, acc[m][nt], 0, 0, 0);
      }
    }
  }
  const float skip = p.filt_bias[ORDER * 512 + c];
  const int gcol = (ORDER == 0 ? 512 : 1024) + c;
  const bf16_t* graw = hyT + (size_t)gcol * NTOK + tok0;
  const float w0 = p.hy_conv_w[gcol], w1 = p.hy_conv_w[1536 + gcol], w2 = p.hy_conv_w[3072 + gcol], b = p.hy_conv_b[gcol];
  bf16_t* outT = (bf16_t*)(p.ws + (ORDER == 0 ? OFF_ZT : OFF_Y2T)) + (size_t)c * NTOK + tok0;
#pragma unroll
  for (int nt = 0; nt < 2; ++nt) {
    const int col = nt ? col1 : col0;
#pragma unroll
    for (int m = 0; m < 4; ++m) {
      const int t = col * 64 + 16 * m + 4 * fq, pos = t & (L - 1);
      const uint2 uu = *(const uint2*)(sU + col * 64 + (((2 * m + (fq >> 1)) ^ (col & 7)) * 8) + 4 * (fq & 1));
      const uint2 gv = *(const uint2*)(graw + t);
      float x[6];
      x[0] = pos == 0 ? 0.f : bf2f(graw[t - 1]);
      x[1] = bflo(gv.x); x[2] = bfhi(gv.x); x[3] = bflo(gv.y); x[4] = bfhi(gv.y);
      x[5] = (pos + 4 == L) ? 0.f : bf2f(graw[t + 4]);
      const float u4[4] = {bflo(uu.x), bfhi(uu.x), bflo(uu.y), bfhi(uu.y)};
      float o[4];
#pragma unroll
      for (int j = 0; j < 4; ++j) {
        const float gate = w0 * x[j] + w1 * x[j + 1] + w2 * x[j + 2] + b;
        o[j] = gate * (acc[m][nt][j] + skip * u4[j]);
      }
      *(uint2*)(outT + t) = make_uint2(pack2(o[0], o[1]), pack2(o[2], o[3]));
    }
  }
}

__device__ __forceinline__ void rope32(float* y  , int pos) {
  const float prow = (float)(pos >> 6), pcol = (float)(pos & 63);
  const float fr[8] = {1.f, 0.31622776601683794f, 0.1f, 0.031622776601683794f, 0.01f, 0.0031622776601683794f, 0.001f, 0.00031622776601683794f};
#pragma unroll
  for (int i = 0; i < 8; ++i) {
    const float tr = prow * fr[i] * 0.15915494309189535f, tc = pcol * fr[i] * 0.15915494309189535f;
    const float sr = sin_turns(tr), cr = cos_turns(tr), sc = sin_turns(tc), cc = cos_turns(tc);
    const float a = y[i], b = y[8 + i], c2 = y[16 + i], d2 = y[24 + i];
    y[i] = a * cr - b * sr; y[8 + i] = b * cr + a * sr;
    y[16 + i] = c2 * cc - d2 * sc; y[24 + i] = d2 * cc + c2 * sc;
  }
}
__device__ __forceinline__ void unpack8(const uint4& v, float* x) {
  x[0] = bflo(v.x); x[1] = bfhi(v.x); x[2] = bflo(v.y); x[3] = bfhi(v.y);
  x[4] = bflo(v.z); x[5] = bfhi(v.z); x[6] = bflo(v.w); x[7] = bfhi(v.w);
}
__device__ __forceinline__ float sumsq8(const uint4& v) {
  float x[8];
  unpack8(v, x);
  return x[0] * x[0] + x[1] * x[1] + x[2] * x[2] + x[3] * x[3] + x[4] * x[4] + x[5] * x[5] + x[6] * x[6] + x[7] * x[7];
}
__device__ __forceinline__ uint4 scale8(const uint4& v, float r, const float* __restrict__ g) {
  float x[8];
  unpack8(v, x);
  const float4 g0 = *(const float4*)g, g1 = *(const float4*)(g + 4);
  return make_uint4(pack2(x[0] * r * g0.x, x[1] * r * g0.y), pack2(x[2] * r * g0.z, x[3] * r * g0.w),
                    pack2(x[4] * r * g1.x, x[5] * r * g1.y), pack2(x[6] * r * g1.z, x[7] * r * g1.w));
}
__device__ __forceinline__ void qk_item(const Params& p, int item) {
  const int tid = ltid();
  if (item < 512) {
    const int idx = item * 256 + tid, row = idx >> 3, h = idx & 7;
    const bf16_t* src = (const bf16_t*)(p.ws + OFF_QRAW) + (size_t)row * 768 + h * 96;
    bf16_t* dst = (bf16_t*)(p.ws + OFF_Q) + (size_t)row * 768 + h * 96;
    uint4 raw[12];
#pragma unroll
    for (int i = 0; i < 12; ++i) raw[i] = *(const uint4*)(src + 8 * i);
    float ss = 0.f;
#pragma unroll
    for (int i = 0; i < 12; ++i) ss += sumsq8(raw[i]);
    const float r = rsqrtf(ss * (1.f / 96.f) + 1e-6f);
    const float qs = 0.10206207261596575f * 1.4426950408889634f;
#pragma unroll
    for (int i = 0; i < 8; ++i) *(uint4*)(dst + 8 * i) = scale8(raw[i], r * qs, p.g_q + 8 * i);
    float y[32];
#pragma unroll
    for (int i = 0; i < 4; ++i) unpack8(raw[8 + i], y + 8 * i);
#pragma unroll
    for (int i = 0; i < 32; ++i) y[i] = y[i] * r * p.g_q[64 + i];
    if (row >= NCTX) rope32(y, (row - NCTX) & 4095);
#pragma unroll
    for (int i = 0; i < 4; ++i)
      *(uint4*)(dst + 64 + 8 * i) = make_uint4(pack2(y[8 * i] * qs, y[8 * i + 1] * qs), pack2(y[8 * i + 2] * qs, y[8 * i + 3] * qs),
                                               pack2(y[8 * i + 4] * qs, y[8 * i + 5] * qs), pack2(y[8 * i + 6] * qs, y[8 * i + 7] * qs));
  } else {
    const int idx = (item - 512) * 256 + tid, row = idx >> 3, h = idx & 7;
    const bf16_t* src = (const bf16_t*)(p.ws + OFF_KRAW) + (size_t)row * 512 + h * 64;
    uint4 raw[8];
#pragma unroll
    for (int i = 0; i < 8; ++i) raw[i] = *(const uint4*)(src + 8 * i);
    const float* kp = row < NTOK ? (const float*)(p.ws + OFF_KPE) + (size_t)row * 32 : p.cache_kpe + (size_t)(row - NTOK) * 32;
    float y[32];
#pragma unroll
    for (int i = 0; i < 8; ++i) {
      const float4 v = *(const float4*)(kp + 4 * i);
      y[4 * i] = v.x; y[4 * i + 1] = v.y; y[4 * i + 2] = v.z; y[4 * i + 3] = v.w;
    }
    float ss = 0.f;
#pragma unroll
    for (int i = 0; i < 8; ++i) ss += sumsq8(raw[i]);
#pragma unroll
    for (int i = 0; i < 32; ++i) ss += y[i] * y[i];
    const float r = rsqrtf(ss * (1.f / 96.f) + 1e-6f);
#pragma unroll
    for (int i = 0; i < 32; ++i) y[i] = y[i] * r * p.g_k[64 + i];
    bf16_t* dst;
    if (row < NCTX) dst = (bf16_t*)(p.ws + OFF_KC) + ((size_t)((row >> 8) * 8 + h) * 256 + (row & 255)) * 96;
    else if (row < NTOK) {
      const int rr = row - NCTX;
      rope32(y, rr & 4095);
      dst = (bf16_t*)(p.ws + OFF_KL) + ((size_t)((rr >> 12) * 8 + h) * 4608 + (rr & 4095)) * 96;
    } else {
      const int rr = row - NTOK;
      dst = (bf16_t*)(p.ws + OFF_KL) + ((size_t)((rr >> 9) * 8 + h) * 4608 + 4096 + (rr & 511)) * 96;
    }
#pragma unroll
    for (int i = 0; i < 8; ++i) *(uint4*)(dst + 8 * i) = scale8(raw[i], r, p.g_k + 8 * i);
#pragma unroll
    for (int i = 0; i < 4; ++i)
      *(uint4*)(dst + 64 + 8 * i) = make_uint4(pack2(y[8 * i], y[8 * i + 1]), pack2(y[8 * i + 2], y[8 * i + 3]),
                                               pack2(y[8 * i + 4], y[8 * i + 5]), pack2(y[8 * i + 6], y[8 * i + 7]));
  }
}

__device__ __forceinline__ void attn_item(const Params& p, int item, char* smem) {
  const int tid = ltid(), lane = tid & 63, wid = tid >> 6, lr = lane & 31, lh = lane >> 5;
  int nkeys, h, tokbase; const bf16_t *Kp, *Vp;
  if (item < 512) {
    const int b = item >> 8, rem = item & 255; h = rem >> 5; const int qb = rem & 31;
    nkeys = 4608; tokbase = NCTX + b * 4096 + qb * 128;
    Kp = (const bf16_t*)(p.ws + OFF_KL) + (size_t)(b * 8 + h) * 4608 * 96;
    Vp = (const bf16_t*)(p.ws + OFF_VTL) + (size_t)(b * 8 + h) * 64 * 4608;
  } else {
    const int it = item - 512, b = it >> 4; h = (it & 15) >> 1; const int qb = it & 1;
    nkeys = 256; tokbase = b * 256 + qb * 128;
    Kp = (const bf16_t*)(p.ws + OFF_KC) + (size_t)(b * 8 + h) * 256 * 96;
    Vp = (const bf16_t*)(p.ws + OFF_VTC) + (size_t)(b * 8 + h) * 64 * 256;
  }
  bf16_t* sK = (bf16_t*)smem;
  bf16_t* sV = sK + 64 * 104;
  const int token = tokbase + 32 * wid + lr;
  const bf16_t* qsrc = (const bf16_t*)(p.ws + OFF_Q) + (size_t)token * 768 + h * 96 + 8 * lh;
  bf16x8 qf[6];
#pragma unroll
  for (int ks = 0; ks < 6; ++ks) qf[ks] = *(const bf16x8*)(qsrc + 16 * ks);
  f32x16 oacc[2];
#pragma unroll
  for (int j = 0; j < 16; ++j) { oacc[0][j] = 0.f; oacc[1][j] = 0.f; }
  float mrun = -1e30f, lsum = 0.f;
  const int kk0 = tid / 12, kc0 = tid % 12, kk1 = (tid + 256) / 12, kc1 = (tid + 256) % 12, kk2 = (tid + 512) / 12, kc2 = (tid + 512) % 12;
  const int vd0 = tid >> 3, vc0 = tid & 7, vd1 = vd0 + 32;
  const bf16_t* gk0 = Kp + (size_t)kk0 * 96 + kc0 * 8;
  const bf16_t* gk1 = Kp + (size_t)kk1 * 96 + kc1 * 8;
  const bf16_t* gk2 = Kp + (size_t)kk2 * 96 + kc2 * 8;
  const bf16_t* gv0 = Vp + (size_t)vd0 * nkeys + vc0 * 8;
  const bf16_t* gv1 = Vp + (size_t)vd1 * nkeys + vc0 * 8;
  uint4 rk0 = *(const uint4*)gk0, rk1 = *(const uint4*)gk1, rk2 = *(const uint4*)gk2;
  uint4 rv0 = *(const uint4*)gv0, rv1 = *(const uint4*)gv1;
  const int nt = nkeys >> 6;
  for (int kt = 0; kt < nt; ++kt) {
    __syncthreads();
    *(uint4*)(sK + kk0 * 104 + kc0 * 8) = rk0; *(uint4*)(sK + kk1 * 104 + kc1 * 8) = rk1; *(uint4*)(sK + kk2 * 104 + kc2 * 8) = rk2;
    *(uint4*)(sV + vd0 * 72 + vc0 * 8) = rv0; *(uint4*)(sV + vd1 * 72 + vc0 * 8) = rv1;
    __syncthreads();
    if (kt + 1 < nt) {
      gk0 += 64 * 96; gk1 += 64 * 96; gk2 += 64 * 96; gv0 += 64; gv1 += 64;
      rk0 = *(const uint4*)gk0; rk1 = *(const uint4*)gk1; rk2 = *(const uint4*)gk2;
      rv0 = *(const uint4*)gv0; rv1 = *(const uint4*)gv1;
    }
    __builtin_amdgcn_sched_barrier(0);
    f32x16 sacc[2];
#pragma unroll
    for (int kb = 0; kb < 2; ++kb) {
#pragma unroll
      for (int j = 0; j < 16; ++j) sacc[kb][j] = 0.f;
#pragma unroll
      for (int ks = 0; ks < 6; ++ks) {
        const bf16x8 a = *(const bf16x8*)(sK + (32 * kb + lr) * 104 + 16 * ks + 8 * lh);
        sacc[kb] = __builtin_amdgcn_mfma_f32_32x32x16_bf16(a, qf[ks], sacc[kb], 0, 0, 0);
      }
    }
    float mx = sacc[0][0];
#pragma unroll
    for (int j = 1; j < 16; ++j) mx = fmaxf(mx, sacc[0][j]);
#pragma unroll
    for (int j = 0; j < 16; ++j) mx = fmaxf(mx, sacc[1][j]);
    mx = fmaxf(mx, __shfl_xor(mx, 32));
    const float mnew = fmaxf(mrun, mx);
    const float alpha = __builtin_amdgcn_exp2f(mrun - mnew);
    mrun = mnew;
    float ps = 0.f;
#pragma unroll
    for (int kb = 0; kb < 2; ++kb)
#pragma unroll
      for (int j = 0; j < 16; ++j) { const float e = __builtin_amdgcn_exp2f(sacc[kb][j] - mnew); sacc[kb][j] = e; ps += e; }
    lsum = lsum * alpha + ps;
    if (__ballot(alpha != 1.f) != 0ull) {
#pragma unroll
      for (int j = 0; j < 16; ++j) { oacc[0][j] *= alpha; oacc[1][j] *= alpha; }
    }
#pragma unroll
    for (int s = 0; s < 4; ++s) {
      const int kb = s >> 1, jb = 8 * (s & 1);
      union { unsigned u[4]; bf16x8 v; } pf;
      pf.u[0] = pack2(sacc[kb][jb + 0], sacc[kb][jb + 1]); pf.u[1] = pack2(sacc[kb][jb + 2], sacc[kb][jb + 3]);
      pf.u[2] = pack2(sacc[kb][jb + 4], sacc[kb][jb + 5]); pf.u[3] = pack2(sacc[kb][jb + 6], sacc[kb][jb + 7]);
#pragma unroll
      for (int mt = 0; mt < 2; ++mt) {
        const bf16_t* vp = sV + (32 * mt + lr) * 72 + 16 * s + 4 * lh;
        union { uint2 d[2]; bf16x8 v; } av;
        av.d[0] = *(const uint2*)vp;
        av.d[1] = *(const uint2*)(vp + 8);
        oacc[mt] = __builtin_amdgcn_mfma_f32_32x32x16_bf16(av.v, pf.v, oacc[mt], 0, 0, 0);
      }
    }
  }
  lsum += __shfl_xor(lsum, 32);
  const float inv = 1.f / lsum;
  bf16_t* dst = (bf16_t*)(p.ws + OFF_ATTN) + (size_t)token * 512 + h * 64;
#pragma unroll
  for (int mt = 0; mt < 2; ++mt)
#pragma unroll
    for (int jg = 0; jg < 4; ++jg) {
      const int dv0 = 32 * mt + 8 * jg + 4 * lh;
      *(uint2*)(dst + dv0) = make_uint2(pack2(oacc[mt][4 * jg] * inv, oacc[mt][4 * jg + 1] * inv),
                                        pack2(oacc[mt][4 * jg + 2] * inv, oacc[mt][4 * jg + 3] * inv));
    }
}

__device__ __forceinline__ void merge_item(const Params& p, int item, char* smem) {
  const int tid = ltid(), lane = tid & 63, wid = tid >> 6, t0 = item * 32;
  bf16_t* mix = (bf16_t*)(p.ws + OFF_H);
  const bf16_t* attn = (const bf16_t*)(p.ws + OFF_ATTN);
  for (int tt = 0; tt < 8; ++tt) {
    const int token = t0 + wid * 8 + tt;
    float x[8];
    unpack8(*(const uint4*)(attn + (size_t)token * 512 + lane * 8), x);
    float ss = 0.f;
#pragma unroll
    for (int i = 0; i < 8; ++i) ss += x[i] * x[i];
    ss = wave_sum(ss);
    const float r = rsqrtf(ss * (1.f / 512.f) + 1e-6f);
    const float4 g0 = *(const float4*)(p.g_out_att + lane * 8), g1 = *(const float4*)(p.g_out_att + lane * 8 + 4);
    *(uint4*)(mix + (size_t)token * D + lane * 8) =
        make_uint4(pack2(x[0] * r * g0.x, x[1] * r * g0.y), pack2(x[2] * r * g0.z, x[3] * r * g0.w),
                   pack2(x[4] * r * g1.x, x[5] * r * g1.y), pack2(x[6] * r * g1.z, x[7] * r * g1.w));
  }
  bf16_t* sT = (bf16_t*)smem;
  const bf16_t* y2T = (const bf16_t*)(p.ws + OFF_Y2T);
  __syncthreads();
  for (int ch = tid; ch < 2048; ch += 256) {
    const int c = ch >> 2, q4 = ch & 3;
    const uint4 v = *(const uint4*)(y2T + (size_t)c * NTOK + t0 + q4 * 8);
    bf16_t* d = sT + (q4 * 8) * 520 + c;
    d[0 * 520] = (bf16_t)(v.x & 0xffff); d[1 * 520] = (bf16_t)(v.x >> 16);
    d[2 * 520] = (bf16_t)(v.y & 0xffff); d[3 * 520] = (bf16_t)(v.y >> 16);
    d[4 * 520] = (bf16_t)(v.z & 0xffff); d[5 * 520] = (bf16_t)(v.z >> 16);
    d[6 * 520] = (bf16_t)(v.w & 0xffff); d[7 * 520] = (bf16_t)(v.w >> 16);
  }
  __syncthreads();
  {
    const int tt = tid >> 3, part = tid & 7;
    uint4 v[8];
    float ss = 0.f;
#pragma unroll
    for (int i = 0; i < 8; ++i) {
      v[i] = *(const uint4*)(sT + tt * 520 + part * 64 + 8 * i);
      float x[8];
      unpack8(v[i], x);
#pragma unroll
      for (int e = 0; e < 8; ++e) ss += x[e] * x[e];
    }
    ss += __shfl_xor(ss, 1); ss += __shfl_xor(ss, 2); ss += __shfl_xor(ss, 4);
    const float r = rsqrtf(ss * (1.f / 512.f) + 1e-6f);
#pragma unroll
    for (int i = 0; i < 8; ++i) {
      float x[8];
      unpack8(v[i], x);
      const int c0 = part * 64 + 8 * i;
      const float4 g0 = *(const float4*)(p.g_out_hy + c0), g1 = *(const float4*)(p.g_out_hy + c0 + 4);
      *(uint4*)(mix + (size_t)(t0 + tt) * D + 512 + c0) =
          make_uint4(pack2(x[0] * r * g0.x, x[1] * r * g0.y), pack2(x[2] * r * g0.z, x[3] * r * g0.w),
                     pack2(x[4] * r * g1.x, x[5] * r * g1.y), pack2(x[6] * r * g1.z, x[7] * r * g1.w));
    }
  }
}

__device__ __forceinline__ void actfix_item(const Params& p, int item) {
  const int idx = item * 256 + ltid();
  if (idx >= 512 * 352) return;
  const int j = (idx % 352) * 8, rowi = idx / 352, wt = rowi >> 1, which = rowi & 1;
  const int t = 64 * wt + 63 * which, L = t < NCTX ? SEQC : SEQL, pos = t & (L - 1);
  const bf16_t* edge = (const bf16_t*)(p.ws + OFF_EDGE);
  bf16_t* act = (bf16_t*)(p.ws + OFF_U);
  const bf16_t *pr, *cu, *nx;
  bool zp = false, zn = false;
  if (which == 0) { zp = pos == 0; pr = edge + (size_t)((zp ? wt : wt - 1) * 4 + 3) * 5632; cu = edge + (size_t)(wt * 4 + 0) * 5632; nx = edge + (size_t)(wt * 4 + 1) * 5632; }
  else { zn = pos == L - 1; pr = edge + (size_t)(wt * 4 + 2) * 5632; cu = edge + (size_t)(wt * 4 + 3) * 5632; nx = edge + (size_t)((zn ? wt : wt + 1) * 4 + 0) * 5632; }
  float pa[8], pg[8], ca[8], cgv[8], na[8], ng[8];
  unpack8(*(const uint4*)(pr + j), pa); unpack8(*(const uint4*)(pr + 2816 + j), pg);
  unpack8(*(const uint4*)(cu + j), ca); unpack8(*(const uint4*)(cu + 2816 + j), cgv);
  unpack8(*(const uint4*)(nx + j), na); unpack8(*(const uint4*)(nx + 2816 + j), ng);
  float o[8];
#pragma unroll
  for (int e = 0; e < 8; ++e) {
    const float pae = zp ? 0.f : pa[e], pge = zp ? 0.f : pg[e], nae = zn ? 0.f : na[e], nge = zn ? 0.f : ng[e];
    const float a = p.ffn_conv_w[j + e] * pae + p.ffn_conv_w[5632 + j + e] * ca[e] + p.ffn_conv_w[11264 + j + e] * nae + p.ffn_conv_b[j + e];
    const float g = p.ffn_conv_w[2816 + j + e] * pge + p.ffn_conv_w[5632 + 2816 + j + e] * cgv[e] + p.ffn_conv_w[11264 + 2816 + j + e] * nge + p.ffn_conv_b[2816 + j + e];
    o[e] = a * __builtin_amdgcn_rcpf(1.f + __expf(-a)) * g;
  }
  *(uint4*)(act + (size_t)t * 2816 + j) = make_uint4(pack2(o[0], o[1]), pack2(o[2], o[3]), pack2(o[4], o[5]), pack2(o[6], o[7]));
}

#define XB_TMO      128
#define XB_XCNT(j)  (256  + 64 * (j))
#define XB_XSUB(j)  (1280 + 64 * (j))
#define XB_XGEN(j)  (2304 + 64 * (j))
#define XB_TOP      3328
#define XB_TOPGEN   3392
#define XCD_BAR_WORDS 3456
#define XB_SPIN_CAP (1u << 20)
#define LAS __attribute__((address_space(3)))
__device__ __forceinline__ unsigned xb_ld(unsigned* p) { return __hip_atomic_load(p, __ATOMIC_RELAXED, __HIP_MEMORY_SCOPE_AGENT); }
__device__ __forceinline__ unsigned xb_add(unsigned* p, unsigned v) { return __hip_atomic_fetch_add(p, v, __ATOMIC_RELAXED, __HIP_MEMORY_SCOPE_AGENT); }
__device__ __forceinline__ unsigned xb_xcc_id() { return (unsigned)__builtin_amdgcn_s_getreg((3 << 11) | 20) & 0xFu; }
#define XB_SPIN(cond, bar) do { unsigned _sp = 0; while (cond) { __builtin_amdgcn_s_sleep(1); \
    if ((++_sp & 255u) == 0u) { if (xb_ld(&(bar)[XB_TMO])) break; if (_sp > XB_SPIN_CAP) { atomicAdd(&(bar)[XB_TMO], 1u); break; } } } } while (0)
struct XcdBarrier { unsigned* bar; unsigned x; volatile LAS unsigned* st; };
__device__ __forceinline__ XcdBarrier xcd_barrier_post(unsigned* bar, volatile LAS unsigned* st) {
  XcdBarrier b; b.bar = bar; b.x = xb_xcc_id(); b.st = st;
  if (threadIdx.x == 0) (void)xb_add(&bar[XB_XCNT(b.x)], 1u);
  return b;
}
__device__ __forceinline__ void xcd_barrier_complete(unsigned* bar, unsigned x, unsigned& nloc, unsigned& nx) {
  const unsigned G = gridDim.x * gridDim.y * gridDim.z;
  unsigned sum, cnt, mine, sp = 0u;
  for (;;) {
    sum = 0u; cnt = 0u; mine = 0u;
#pragma unroll
    for (unsigned j = 0; j < 16; ++j) { const unsigned c = xb_ld(&bar[XB_XCNT(j)]); sum += c; cnt += (c > 0u) ? 1u : 0u; mine = (j == x) ? c : mine; }
    if (sum == G) break;
    __builtin_amdgcn_s_sleep(1);
    if ((++sp & 255u) == 0u) { if (xb_ld(&bar[XB_TMO])) break; if (sp > XB_SPIN_CAP) { atomicAdd(&bar[XB_TMO], 1u); break; } }
  }
  nloc = mine > 0u ? mine : 1u; nx = cnt > 0u ? cnt : 1u;
}
__device__ __forceinline__ void xcd_barrier(const XcdBarrier& b) {
  asm volatile("s_waitcnt vmcnt(0)" ::: "memory");
  __syncthreads();
  if (threadIdx.x == 0) {
    unsigned* bar = b.bar;
    __builtin_amdgcn_s_waitcnt(0);
    unsigned nloc = b.st[0], nx = b.st[1];
    if (nloc == 0u) { xcd_barrier_complete(bar, b.x, nloc, nx); b.st[0] = nloc; b.st[1] = nx; }
    const unsigned old = xb_add(&bar[XB_XSUB(b.x)], 1u);
    const unsigned gen = old / nloc;
    if (old + 1u == (gen + 1u) * nloc) {
      __builtin_amdgcn_fence(__ATOMIC_RELEASE, "agent");
      asm volatile("s_waitcnt vmcnt(0)" ::: "memory");
      const unsigned og = xb_add(&bar[XB_TOP], 1u);
      const unsigned tg = og / nx;
      if (og + 1u == (tg + 1u) * nx) xb_add(&bar[XB_TOPGEN], 1u);
      else XB_SPIN(xb_ld(&bar[XB_TOPGEN]) == tg, bar);
      __builtin_amdgcn_fence(__ATOMIC_ACQUIRE, "agent");
      xb_add(&bar[XB_XGEN(b.x)], 1u);
      asm volatile("s_waitcnt vmcnt(0)" ::: "memory");
    } else {
      XB_SPIN(xb_ld(&bar[XB_XGEN(b.x)]) == gen, bar);
      __builtin_amdgcn_fence(__ATOMIC_ACQUIRE, "agent");
      asm volatile("s_waitcnt vmcnt(0)" ::: "memory");
    }
  }
  __syncthreads();
}
constexpr size_t OFF_BAR = 25 * MiB - 16384;
static_assert(OFF_MOD + 3 * 6144 * 4 <= OFF_BAR, "bar");

template <int ph>
__device__ __forceinline__ void run_phase(const Params& p, char* smem) {
  const int bid = blockIdx.x, G = gridDim.x;
  char* ws = p.ws;
  if constexpr (ph == 0) {
    for (int it = bid; it < 272 + 96 + 32 + 3080; it += G) {
      if (it < 272) filter_item(p, it, smem);
      else if (it < 368) mod_item(p, it - 272, smem);
      else if (it < 400) cache_item(p, it - 368);
      else {
        int t = it - 400;
        if (t < 576) transpose_item(p.w_in, 1024, DIN, (bf16_t*)(ws + OFF_WIN), t, 36, smem);
        else if ((t -= 576) < 72) transpose_item(p.w_uq, 384, 768, (bf16_t*)(ws + OFF_WUQ), t, 12, smem);
        else if ((t -= 72) < 64) transpose_item(p.w_ukv, 256, 1024, (bf16_t*)(ws + OFF_WUKV), t, 16, smem);
        else if ((t -= 64) < 256) transpose_item(p.w_out, 1024, 1024, (bf16_t*)(ws + OFF_WOUT), t, 16, smem);
        else if ((t -= 256) < 1408) transpose_item(p.w_up, 1024, 5632, (bf16_t*)(ws + OFF_WUP), t, 88, smem, true);
        else { t -= 1408; transpose_item(p.w_down, 2816, 1024, (bf16_t*)(ws + OFF_WDOWN), t, 16, smem); }
      }
    }
  } else if constexpr (ph == 1) {
    rmsmod_phase<0>(p);
  } else if constexpr (ph == 2) {
    EpiIn epi{(float*)(ws + OFF_PROJ), (bf16_t*)(ws + OFF_HYT)};
    EpiProj epr{(float*)(ws + OFF_PROJ)};
    for (int t = bid; t < 128 * 18; t += G) {
      const int nt = t % 18;
      if (nt < 5) gemm_tile<true>((const bf16_t*)(ws + OFF_H), 1024, (const bf16_t*)(ws + OFF_WIN), 1024, 1024, (t / 18) * 128, nt * 128, smem, epr);
      else gemm_tile<false>((const bf16_t*)(ws + OFF_H), 1024, (const bf16_t*)(ws + OFF_WIN), 1024, 1024, (t / 18) * 128, nt * 128, smem, epi);
    }
  } else if constexpr (ph == 3) {
    for (int it = bid; it < 512; it += G) hyena_item<0>(p, 1, it, smem);
    for (int it = bid; it < 512; it += G) hyena_item<0>(p, 0, it, smem);
    for (int it = G - 1 - bid; it < 512; it += G) token_item(p, it);
  } else if constexpr (ph == 4) {
    EpiQ eq{(bf16_t*)(ws + OFF_QRAW)};
    EpiKV ekv{(bf16_t*)(ws + OFF_KRAW), (bf16_t*)(ws + OFF_VTC), (bf16_t*)(ws + OFF_VTL)};
    for (int it = bid; it < 512; it += G) hyena_item<1>(p, 1, it, smem);
    for (int t = bid; t < 768; t += G) gemm_tile<true>((const bf16_t*)(ws + OFF_QA), 384, (const bf16_t*)(ws + OFF_WUQ), 384, 384, (t / 6) * 128, (t % 6) * 128, smem, eq);
    for (int t = bid; t < 1088; t += G) gemm_tile<false>((const bf16_t*)(ws + OFF_CKVN), 256, (const bf16_t*)(ws + OFF_WUKV), 256, 256, (t / 8) * 128, (t % 8) * 128, smem, ekv);
    for (int it = bid; it < 512; it += G) hyena_item<1>(p, 0, it, smem);
  } else if constexpr (ph == 5) {
    for (int it = bid; it < 512 + 544; it += G) qk_item(p, it);
  } else if constexpr (ph == 6) {
    for (int it = bid; it < 1024; it += G) attn_item(p, it, smem);
  } else if constexpr (ph == 7) {
    for (int it = bid; it < 512; it += G) merge_item(p, it, smem);
  } else if constexpr (ph == 8) {
    EpiOut epi{&p};
    for (int t = bid; t < 128 * 8; t += G)
      gemm_tile<true>((const bf16_t*)(ws + OFF_H), 1024, (const bf16_t*)(ws + OFF_WOUT), 1024, 1024, (t / 8) * 128, (t % 8) * 128, smem, epi);
  } else if constexpr (ph == 9) {
    rmsmod_phase<1>(p);
  } else if constexpr (ph == 10) {
    for (int t = bid; t < 128 * 44; t += G) gemm_up_act_tile(p, (t / 44) * 128, (t % 44) * 128, smem);
  } else if constexpr (ph == 11) {
    for (int it = bid; it < 704; it += G) actfix_item(p, it);
  } else if constexpr (ph == 12) {
    EpiY epi{&p, 0};
    for (int t = bid; t < 128 * 8; t += G)
      gemm_tile<true>((const bf16_t*)(ws + OFF_U), 2816, (const bf16_t*)(ws + OFF_WDOWN), 2816, 2816, (t / 8) * 128, (t % 8) * 128, smem, epi);
  }
}

#if ONE_LAUNCH
template <int PH>
__device__ __forceinline__ void run_all(const Params& p, char* smem, cg::grid_group& grid, const XcdBarrier& xb) {
  run_phase<PH>(p, smem);
  if constexpr (((DBL_MASK >> PH) & 1) != 0) { xcd_barrier(xb); run_phase<PH>(p, smem); }
  if constexpr (PH < 12) {
    xcd_barrier(xb);
    run_all<PH + 1>(p, smem, grid, xb);
  }
}
constexpr int DYN_LDS = 65536 + 64;
__global__ void __launch_bounds__(256, 2) mega_kernel(Params p) {
  extern __shared__ __attribute__((aligned(16))) char smem[];
  uint4* xb_words = (uint4*)(smem + 65536);
  cg::grid_group grid = cg::this_grid();
  if (threadIdx.x == 0) *xb_words = make_uint4(0u, 0u, 0u, 0u);
  __syncthreads();
  XcdBarrier xb = xcd_barrier_post((unsigned*)(p.ws + OFF_BAR), (volatile LAS unsigned*)xb_words);
  if (p.ws == nullptr) grid.sync();
  run_all<0>(p, smem, grid, xb);
}
#else
template <int PH>
__global__ void __launch_bounds__(256, 2) phase_kernel(Params p) {
  __shared__ __attribute__((aligned(16))) char smem[SMEM_BYTES];
  run_phase<PH>(p, smem);
}
#ifndef DBG_STOP
#define DBG_STOP 15
#endif
__global__ void dump_kernel(Params p, size_t off, int count) {
  const bf16_t* src = (const bf16_t*)(p.ws + off);
  const bf16_t* src2 = (const bf16_t*)(p.ws + DBG_OFF2);
  for (int i = blockIdx.x * 256 + threadIdx.x; i < 16777216; i += gridDim.x * 256)
    p.out[i] = i < DBG_CNT ? bf2f(src[i]) : (i - DBG_CNT < DBG_CNT2 ? bf2f(src2[i - DBG_CNT]) : 0.f);
}
template <int PH>
static void launch_all(const Params& p, hipStream_t stream) {
  phase_kernel<PH><<<512, 256, 0, stream>>>(p);
  if constexpr (PH < 12) launch_all<PH + 1>(p, stream);
}
#endif

extern "C" void kernel_launch(void* const* d_in, const int* in_sizes, int n_in, void* d_out, int out_size, void* d_ws,
                              size_t ws_size, hipStream_t stream) {
  Params p{};
  const float** pp = (const float**)&p;
  for (int i = 0; i < 34; ++i) pp[i] = (const float*)d_in[i];
  p.out = (float*)d_out;
  p.ws = (char*)d_ws;
#if ONE_LAUNCH
  (void)hipMemsetAsync((char*)d_ws + OFF_BAR, 0, XCD_BAR_WORDS * 4, stream);
  static int grid_blocks = 0;
  if (!grid_blocks) {
    int dev = 0, cus = 0, per_cu = 0;
    hipGetDevice(&dev);
    hipDeviceGetAttribute(&cus, hipDeviceAttributeMultiprocessorCount, dev);
    (void)hipFuncSetAttribute((const void*)mega_kernel, hipFuncAttributeMaxDynamicSharedMemorySize, DYN_LDS);
    (void)hipOccupancyMaxActiveBlocksPerMultiprocessor(&per_cu, mega_kernel, 256, DYN_LDS);
    if (per_cu > 2) per_cu = 2;
    grid_blocks = cus * per_cu;
  }
  void* args[] = {&p};
  hipError_t e = hipLaunchCooperativeKernel((void*)mega_kernel, dim3(grid_blocks), dim3(256), args, DYN_LDS, stream);
  if (e != hipSuccess) fprintf(stderr, "cooperative launch failed: %s (grid %d)\n", hipGetErrorString(e), grid_blocks);
#else
  launch_all<0>(p, stream);
#if DBG_STOP < 15
  dump_kernel<<<1024, 256, 0, stream>>>(p, DBG_OFF, DBG_CNT);
#endif
#endif
}
```

```cpp
#include <hip/hip_runtime.h>
#include <hip/hip_cooperative_groups.h>
#include <cstdio>
namespace cg = cooperative_groups;

#define DBG_STOP 15
#define DBG_NOHY 0
#ifndef DBL_MASK
#define DBL_MASK 0
#endif
#define DBG_OFF OFF_QRAW
#define DBG_OFF2 OFF_KRAW
#define DBG_CNT 12582912
#define DBG_CNT2 0
#ifndef ONE_LAUNCH
#define ONE_LAUNCH 1
#endif

typedef unsigned short bf16_t;
typedef short bf16x8 __attribute__((ext_vector_type(8)));
typedef float f32x4 __attribute__((ext_vector_type(4)));
typedef float f32x16 __attribute__((ext_vector_type(16)));

constexpr int D = 1024, NTOK = 16384, NCTX = 8192, SEQC = 256, SEQL = 4096;
constexpr int DIN = 2208, DINP = 2304, QL = 384, KVL = 256, DFF = 2816;
constexpr int NROWKV = 17408;
constexpr size_t MiB = 1048576;

constexpr size_t OFF_WIN = 0;
constexpr size_t OFF_WUQ = OFF_WIN + (size_t)DINP * 1024 * 2;
constexpr size_t OFF_WUKV = OFF_WUQ + (size_t)768 * 384 * 2;
constexpr size_t OFF_WOUT = OFF_WUKV + (size_t)1024 * 256 * 2;
constexpr size_t OFF_WUP = OFF_WOUT + (size_t)1024 * 1024 * 2;
constexpr size_t OFF_WDOWN = OFF_WUP + (size_t)5632 * 1024 * 2;
constexpr size_t OFF_MOD = OFF_WDOWN + (size_t)1024 * 2816 * 2;
static_assert(OFF_MOD + 3 * 6144 * 4 <= 25 * MiB, "A region");
constexpr size_t OFF_RLAT = 25 * MiB;
constexpr size_t OFF_RCTX = 41 * MiB;
constexpr size_t OFF_H = 42 * MiB;
constexpr size_t OFF_ZT = 42 * MiB;
constexpr size_t OFF_QA = 58 * MiB;
constexpr size_t OFF_KPE = 70 * MiB;
constexpr size_t OFF_PROJ = 74 * MiB;
constexpr size_t OFF_QRAW = 74 * MiB;
constexpr size_t OFF_Y2T = 98 * MiB;
constexpr size_t OFF_ATTN = 74 * MiB;
constexpr size_t OFF_U = 74 * MiB;
constexpr size_t OFF_HYT = 116 * MiB;
constexpr size_t OFF_Q = 116 * MiB;
constexpr size_t OFF_KC = 140 * MiB;
constexpr size_t OFF_KL = 152 * MiB;
constexpr size_t OFF_CKVN = 164 * MiB;
constexpr size_t OFF_KRAW = 173 * MiB;
constexpr size_t OFF_VTC = 190 * MiB;
constexpr size_t OFF_VTL = 198 * MiB;
constexpr size_t OFF_ACT = 162 * MiB;

constexpr int OUT_YS = 0;
constexpr int OUT_CKV = 16777216;
constexpr int OUT_KPE = 16777216 + 2097152;

constexpr int SMEM_BYTES = 51200;

struct Params {
  const float *x_prompt, *x_sample, *cache_ckv, *cache_kpe, *c, *c_ctx, *w_ada, *b_ada, *g_mix, *w_in, *g_qa, *w_uq,
      *g_kva, *w_ukv, *g_q, *g_k, *hy_conv_w, *hy_conv_b, *filt_w1, *filt_b1, *filt_freq1, *filt_w2, *filt_b2,
      *filt_freq2, *filt_w3, *filt_bias, *g_out_att, *g_out_hy, *w_out, *g_ffn, *w_up, *ffn_conv_w, *ffn_conv_b, *w_down;
  float* out;
  char* ws;
};

typedef __bf16 bf16x2_t __attribute__((ext_vector_type(2)));
__device__ __forceinline__ unsigned pack2(float lo, float hi) {
  bf16x2_t v;
  v[0] = (__bf16)lo;
  v[1] = (__bf16)hi;
  return __builtin_bit_cast(unsigned, v);
}
__device__ __forceinline__ float bflo(unsigned u) { return __uint_as_float(u << 16); }
__device__ __forceinline__ float bfhi(unsigned u) { return __uint_as_float(u & 0xffff0000u); }
__device__ __forceinline__ float bf2f(bf16_t h) { return __uint_as_float(((unsigned)h) << 16); }
__device__ __forceinline__ bf16_t f2bf(float f) { return (bf16_t)(pack2(f, 0.f) & 0xffffu); }
__device__ __forceinline__ float wave_sum(float v) {
#pragma unroll
  for (int o = 32; o >= 1; o >>= 1) v += __shfl_xor(v, o);
  return v;
}
__device__ __forceinline__ int ltid() { int t = threadIdx.x; asm volatile("" : "+v"(t)); return t; }
__device__ __forceinline__ float sin_turns(float t) { t -= floorf(t); return __builtin_amdgcn_sinf(t); }
__device__ __forceinline__ float cos_turns(float t) { t -= floorf(t); return __builtin_amdgcn_cosf(t); }
__device__ __forceinline__ float sin_rad(float x) { return sin_turns(x * 0.15915494309189535f); }
__device__ __forceinline__ const float* xrow(const Params& p, int row) {
  return row < NCTX ? p.x_prompt + (size_t)row * D : p.x_sample + (size_t)(row - NCTX) * D;
}
__device__ __forceinline__ int modidx(int row) { return row < NCTX ? 0 : 1 + ((row - NCTX) >> 12); }

template <bool SWAP>
__device__ __forceinline__ void gemm_main(const bf16_t* __restrict__ A, int lda, const bf16_t* __restrict__ Bt, int ldb,
                                          int K, int m0, int n0, char* smem, f32x4 (&acc)[4][4]) {
  const int tid = ltid(), lane = tid & 63, wid = tid >> 6, wr = wid >> 1, wc = wid & 1;
  const int fr = lane & 15, fq = lane >> 4;
  bf16_t* sbase = (bf16_t*)smem;
#pragma unroll
  for (int m = 0; m < 4; ++m)
#pragma unroll
    for (int n = 0; n < 4; ++n) acc[m][n] = (f32x4){0.f, 0.f, 0.f, 0.f};
  const int lr = tid >> 3, lc = (tid & 7) * 8;
  const bf16_t* ga = A + (size_t)(m0 + lr) * lda + lc;
  const bf16_t* gb = Bt + (size_t)(n0 + lr) * ldb + lc;
  const size_t sa32 = (size_t)32 * lda, sb32 = (size_t)32 * ldb;
  uint4 ra0 = *(const uint4*)(ga), ra1 = *(const uint4*)(ga + sa32), ra2 = *(const uint4*)(ga + 2 * sa32), ra3 = *(const uint4*)(ga + 3 * sa32);
  uint4 rb0 = *(const uint4*)(gb), rb1 = *(const uint4*)(gb + sb32), rb2 = *(const uint4*)(gb + 2 * sb32), rb3 = *(const uint4*)(gb + 3 * sb32);
  const int nk = K >> 6;
  const int woff = lr * 64 + (((tid & 7) ^ (lr & 7)) * 8);
  const int aoff = (wr * 64 + fr) * 64, boff = 8192 + (wc * 64 + fr) * 64;
  __syncthreads();
  {
    bf16_t* wa = sbase + woff;
    *(uint4*)(wa) = ra0; *(uint4*)(wa + 32 * 64) = ra1; *(uint4*)(wa + 64 * 64) = ra2; *(uint4*)(wa + 96 * 64) = ra3;
    *(uint4*)(wa + 8192) = rb0; *(uint4*)(wa + 8192 + 32 * 64) = rb1; *(uint4*)(wa + 8192 + 64 * 64) = rb2; *(uint4*)(wa + 8192 + 96 * 64) = rb3;
  }
  if (nk > 1) {
    ga += 64; gb += 64;
    ra0 = *(const uint4*)(ga); ra1 = *(const uint4*)(ga + sa32); ra2 = *(const uint4*)(ga + 2 * sa32); ra3 = *(const uint4*)(ga + 3 * sa32);
    rb0 = *(const uint4*)(gb); rb1 = *(const uint4*)(gb + sb32); rb2 = *(const uint4*)(gb + 2 * sb32); rb3 = *(const uint4*)(gb + 3 * sb32);
  }
  __syncthreads();
  for (int kt = 0; kt < nk; ++kt) {
    const bf16_t* cur = sbase + (kt & 1) * 16384;
    bf16x8 af[2][4], bfr[2][4];
#pragma unroll
    for (int ks = 0; ks < 2; ++ks) {
#pragma unroll
      for (int m = 0; m < 4; ++m) af[ks][m] = *(const bf16x8*)(cur + aoff + m * 16 * 64 + (((ks * 4 + fq) ^ (fr & 7)) * 8));
#pragma unroll
      for (int n = 0; n < 4; ++n) bfr[ks][n] = *(const bf16x8*)(cur + boff + n * 16 * 64 + (((ks * 4 + fq) ^ (fr & 7)) * 8));
    }
    __builtin_amdgcn_sched_barrier(0);
    if (kt + 1 < nk) {
      bf16_t* wa = sbase + ((kt + 1) & 1) * 16384 + woff;
      *(uint4*)(wa) = ra0; *(uint4*)(wa + 32 * 64) = ra1; *(uint4*)(wa + 64 * 64) = ra2; *(uint4*)(wa + 96 * 64) = ra3;
      *(uint4*)(wa + 8192) = rb0; *(uint4*)(wa + 8192 + 32 * 64) = rb1; *(uint4*)(wa + 8192 + 64 * 64) = rb2; *(uint4*)(wa + 8192 + 96 * 64) = rb3;
      if (kt + 2 < nk) {
        ga += 64; gb += 64;
        ra0 = *(const uint4*)(ga); ra1 = *(const uint4*)(ga + sa32); ra2 = *(const uint4*)(ga + 2 * sa32); ra3 = *(const uint4*)(ga + 3 * sa32);
        rb0 = *(const uint4*)(gb); rb1 = *(const uint4*)(gb + sb32); rb2 = *(const uint4*)(gb + 2 * sb32); rb3 = *(const uint4*)(gb + 3 * sb32);
      }
    }
    __builtin_amdgcn_sched_barrier(0);
    __builtin_amdgcn_s_setprio(1);
#pragma unroll
    for (int ks = 0; ks < 2; ++ks)
#pragma unroll
      for (int m = 0; m < 4; ++m)
#pragma unroll
        for (int n = 0; n < 4; ++n) {
          if (SWAP) acc[m][n] = __builtin_amdgcn_mfma_f32_16x16x32_bf16(bfr[ks][n], af[ks][m], acc[m][n], 0, 0, 0);
          else acc[m][n] = __builtin_amdgcn_mfma_f32_16x16x32_bf16(af[ks][m], bfr[ks][n], acc[m][n], 0, 0, 0);
        }
    __builtin_amdgcn_s_setprio(0);
    if (kt + 1 < nk) __syncthreads();
  }
}
template <bool SWAP, class Epi>
__device__ __forceinline__ void gemm_tile(const bf16_t* __restrict__ A, int lda, const bf16_t* __restrict__ Bt, int ldb,
                                          int K, int m0, int n0, char* smem, const Epi& epi) {
  f32x4 acc[4][4];
  gemm_main<SWAP>(A, lda, Bt, ldb, K, m0, n0, smem, acc);
  const int tid = ltid(), lane = tid & 63, wid = tid >> 6, wr = wid >> 1, wc = wid & 1;
  const int fr = lane & 15, fq = lane >> 4;
#pragma unroll
  for (int m = 0; m < 4; ++m)
#pragma unroll
    for (int n = 0; n < 4; ++n) {
      if (SWAP) epi(m0 + wr * 64 + m * 16 + fr, n0 + wc * 64 + n * 16 + fq * 4, acc[m][n]);
      else epi(m0 + wr * 64 + m * 16 + fq * 4, n0 + wc * 64 + n * 16 + fr, acc[m][n]);
    }
}

template <int CTRL>
__device__ __forceinline__ float dpp_ror(float v) {
  return __int_as_float(__builtin_amdgcn_update_dpp(0, __float_as_int(v), CTRL, 0xF, 0xF, false));
}
constexpr size_t OFF_EDGE = 162 * MiB;
__device__ __forceinline__ void gemm_up_act_tile(const Params& p, int m0, int n0, char* smem) {
  f32x4 acc[4][4];
  gemm_main<true>((const bf16_t*)(p.ws + OFF_H), 1024, (const bf16_t*)(p.ws + OFF_WUP), 1024, 1024, m0, n0, smem, acc);
  const int tid = ltid(), lane = tid & 63, wid = tid >> 6, wr = wid >> 1, wc = wid & 1;
  const int fr = lane & 15, fq = lane >> 4;
  bf16_t* act = (bf16_t*)(p.ws + OFF_U);
  bf16_t* edge = (bf16_t*)(p.ws + OFF_EDGE);
  const int rowbase = m0 + wr * 64, wt = rowbase >> 6;
#pragma unroll
  for (int i = 0; i < 2; ++i) {
    const int cperm = n0 + wc * 64 + 32 * i;
    const int j0 = (cperm >> 5) * 16 + 4 * fq;
    const float4 wa0 = *(const float4*)(p.ffn_conv_w + j0), wa1 = *(const float4*)(p.ffn_conv_w + 5632 + j0), wa2 = *(const float4*)(p.ffn_conv_w + 11264 + j0);
    const float4 wg0 = *(const float4*)(p.ffn_conv_w + 2816 + j0), wg1 = *(const float4*)(p.ffn_conv_w + 5632 + 2816 + j0), wg2 = *(const float4*)(p.ffn_conv_w + 11264 + 2816 + j0);
    const float4 ba = *(const float4*)(p.ffn_conv_b + j0), bg = *(const float4*)(p.ffn_conv_b + 2816 + j0);
    const float w0a[4] = {wa0.x, wa0.y, wa0.z, wa0.w}, w1a[4] = {wa1.x, wa1.y, wa1.z, wa1.w}, w2a[4] = {wa2.x, wa2.y, wa2.z, wa2.w};
    const float w0g[4] = {wg0.x, wg0.y, wg0.z, wg0.w}, w1g[4] = {wg1.x, wg1.y, wg1.z, wg1.w}, w2g[4] = {wg2.x, wg2.y, wg2.z, wg2.w};
    const float bba[4] = {ba.x, ba.y, ba.z, ba.w}, bbg[4] = {bg.x, bg.y, bg.z, bg.w};
#pragma unroll
    for (int m = 0; m < 4; ++m) {
      float o[4];
#pragma unroll
      for (int e = 0; e < 4; ++e) {
        const float a = acc[m][2 * i][e], g = acc[m][2 * i + 1][e];
        const float au1 = dpp_ror<0x121>(a), gu1 = dpp_ror<0x121>(g), ad1 = dpp_ror<0x12F>(a), gd1 = dpp_ror<0x12F>(g);
        float au2 = 0.f, gu2 = 0.f, ad2 = 0.f, gd2 = 0.f;
        if (m > 0) { au2 = dpp_ror<0x121>(acc[m - 1][2 * i][e]); gu2 = dpp_ror<0x121>(acc[m - 1][2 * i + 1][e]); }
        if (m < 3) { ad2 = dpp_ror<0x12F>(acc[m + 1][2 * i][e]); gd2 = dpp_ror<0x12F>(acc[m + 1][2 * i + 1][e]); }
        const float au = fr > 0 ? au1 : au2, gu = fr > 0 ? gu1 : gu2, ad = fr < 15 ? ad1 : ad2, gd = fr < 15 ? gd1 : gd2;
        const float ca = w0a[e] * au + w1a[e] * a + w2a[e] * ad + bba[e];
        const float cgv = w0g[e] * gu + w1g[e] * g + w2g[e] * gd + bbg[e];
        o[e] = ca * __builtin_amdgcn_rcpf(1.f + __expf(-ca)) * cgv;
      }
      const int lr64 = m * 16 + fr, row = rowbase + lr64;
      if (lr64 >= 1 && lr64 <= 62) *(uint2*)(act + (size_t)row * 2816 + j0) = make_uint2(pack2(o[0], o[1]), pack2(o[2], o[3]));
      if (lr64 <= 1 || lr64 >= 62) {
        const int slot = lr64 <= 1 ? lr64 : lr64 - 60;
        bf16_t* er = edge + (size_t)(wt * 4 + slot) * 5632;
        *(uint2*)(er + j0) = make_uint2(pack2(acc[m][2 * i][0], acc[m][2 * i][1]), pack2(acc[m][2 * i][2], acc[m][2 * i][3]));
        *(uint2*)(er + 2816 + j0) = make_uint2(pack2(acc[m][2 * i + 1][0], acc[m][2 * i + 1][1]), pack2(acc[m][2 * i + 1][2], acc[m][2 * i + 1][3]));
      }
    }
  }
}

__device__ __forceinline__ void transpose_item(const float* __restrict__ W, int K, int N, bf16_t* __restrict__ WT, int tile, int ntn, char* smem, bool perm = false) {
  float* s = (float*)smem;
  const int tk = tile / ntn, tn = tile % ntn, tid = ltid();
  const int k0 = tk * 64, n0 = tn * 64;
  __syncthreads();
  {
    const int r = tid >> 4, c4 = (tid & 15) * 4;
#pragma unroll
    for (int i = 0; i < 4; ++i) {
      const int k = r + 16 * i;
      float4 v = make_float4(0.f, 0.f, 0.f, 0.f);
      if (n0 + c4 < N) v = *(const float4*)(W + (size_t)(k0 + k) * N + n0 + c4);
      s[k * 65 + c4 + 0] = v.x; s[k * 65 + c4 + 1] = v.y; s[k * 65 + c4 + 2] = v.z; s[k * 65 + c4 + 3] = v.w;
    }
  }
  __syncthreads();
  {
    const int n = tid >> 2, kc = (tid & 3) * 16;
    unsigned o[8];
#pragma unroll
    for (int i = 0; i < 8; ++i) o[i] = pack2(s[(kc + 2 * i) * 65 + n], s[(kc + 2 * i + 1) * 65 + n]);
    int nr = n0 + n;
    if (perm) { const int hf = nr >= 2816 ? 1 : 0, cc = nr - hf * 2816; nr = 32 * (cc >> 4) + 16 * hf + (cc & 15); }
    uint4* dst = (uint4*)(WT + (size_t)nr * K + k0 + kc);
    dst[0] = make_uint4(o[0], o[1], o[2], o[3]);
    dst[1] = make_uint4(o[4], o[5], o[6], o[7]);
  }
}

__device__ __forceinline__ void mod_item(const Params& p, int item, char* smem) {
  float* s = (float*)smem;
  float* red = s + 3072;
  const int tid = ltid();
  __syncthreads();
  for (int e = tid; e < 3072; e += 256) {
    const int v = e >> 10, k = e & 1023;
    const float x = (v == 0) ? p.c_ctx[k] : p.c[(v - 1) * D + k];
    s[e] = x / (1.f + __expf(-x));
  }
  __syncthreads();
  const int jl = tid & 63, kq = tid >> 6, j = item * 64 + jl, k0 = kq * 256;
  float a0 = 0.f, a1 = 0.f, a2 = 0.f;
#pragma unroll 8
  for (int k = 0; k < 256; ++k) {
    const float w = p.w_ada[(size_t)(k0 + k) * 6144 + j];
    a0 += s[k0 + k] * w; a1 += s[1024 + k0 + k] * w; a2 += s[2048 + k0 + k] * w;
  }
  red[(kq * 3 + 0) * 64 + jl] = a0; red[(kq * 3 + 1) * 64 + jl] = a1; red[(kq * 3 + 2) * 64 + jl] = a2;
  __syncthreads();
  if (tid < 192) {
    const int v = tid >> 6;
    const float r = red[(0 * 3 + v) * 64 + jl] + red[(1 * 3 + v) * 64 + jl] + red[(2 * 3 + v) * 64 + jl] + red[(3 * 3 + v) * 64 + jl];
    ((float*)(p.ws + OFF_MOD))[v * 6144 + j] = r + p.b_ada[j];
  }
}

__device__ __forceinline__ void filter_item(const Params& p, int item, char* smem) {
  int n, p0; bf16_t* R;
  if (item < 256) { n = 4096; p0 = item * 16; R = (bf16_t*)(p.ws + OFF_RLAT); }
  else { n = 256; p0 = (item - 256) * 16; R = (bf16_t*)(p.ws + OFF_RCTX); }
  const int n2 = 2 * n, tid = ltid();
  float* z = (float*)smem;
  float* h1 = z + 16 * 36;
  float* h2 = h1 + 16 * 64;
  __syncthreads();
#pragma unroll 1
  for (int e = tid; e < 16 * 33; e += 256) {
    const int pp = e / 33, f = e % 33, pos = p0 + pp;
    float val;
    if (f == 0) val = (float)pos / (float)(n - 1);
    else {
      const int k = (f - 1) & 15;
      const float band = 1e-4f + (float)k * ((15.f - 1e-4f) / 15.f);
      const float turns = band * ((float)pos / (float)n);
      val = (f <= 16) ? cos_turns(turns) : -sin_turns(turns);
    }
    z[pp * 36 + f] = val;
  }
  __syncthreads();
#pragma unroll 1
  for (int e = tid; e < 1024; e += 256) {
    const int pp = e >> 6, j = e & 63;
    float a = p.filt_b1[j];
#pragma unroll 3
    for (int f = 0; f < 33; ++f) a += z[pp * 36 + f] * p.filt_w1[f * 64 + j];
    h1[e] = sin_rad(p.filt_freq1[j] * a);
  }
  __syncthreads();
#pragma unroll 1
  for (int e = tid; e < 1024; e += 256) {
    const int pp = e >> 6, j = e & 63;
    float a = p.filt_b2[j];
#pragma unroll 4
    for (int k = 0; k < 64; ++k) a += h1[pp * 64 + k] * p.filt_w2[k * 64 + j];
    h2[j * 16 + pp] = sin_rad(p.filt_freq2[j] * a);
  }
  __syncthreads();
  const float mind = -3.0701134573253946f, maxd = -15.350567286626973f;
#pragma unroll 1
  for (int ci = 0; ci < 8; ++ci) {
    const int col = tid + 256 * ci, o = col >> 10, dir = (col >> 9) & 1, c = col & 511;
    float acc[16];
#pragma unroll
    for (int i = 0; i < 16; ++i) acc[i] = 0.f;
#pragma unroll 4
    for (int k = 0; k < 64; ++k) {
      const float w = p.filt_w3[k * 2048 + col];
      const float4 ha = *(const float4*)(h2 + k * 16), hb = *(const float4*)(h2 + k * 16 + 4), hc = *(const float4*)(h2 + k * 16 + 8), hd = *(const float4*)(h2 + k * 16 + 12);
      acc[0] += ha.x * w; acc[1] += ha.y * w; acc[2] += ha.z * w; acc[3] += ha.w * w;
      acc[4] += hb.x * w; acc[5] += hb.y * w; acc[6] += hb.z * w; acc[7] += hb.w * w;
      acc[8] += hc.x * w; acc[9] += hc.y * w; acc[10] += hc.z * w; acc[11] += hc.w * w;
      acc[12] += hd.x * w; acc[13] += hd.y * w; acc[14] += hd.z * w; acc[15] += hd.w * w;
    }
    const float delta = fabsf(mind + (float)c * ((maxd - mind) / 511.f));
    bf16_t* Rrow = R + (size_t)(o * 512 + c) * n2;
#pragma unroll
    for (int i = 0; i < 16; ++i) {
      const int pos = p0 + i;
      const float t = (float)pos / (float)(n - 1);
      float val = acc[i] * (__expf(-t * delta) + 0.05f);
      int idx = dir == 0 ? (n - 1 - pos) : (n - 1 + pos);
      if (dir == 1 && pos == 0) { idx = n2 - 1; val = 0.f; }
      Rrow[idx] = f2bf(val);
    }
  }
}

__device__ __forceinline__ void cache_item(const Params& p, int item) {
  const int tid = ltid(), r0 = item * 32;
  bf16_t* ckvn = (bf16_t*)(p.ws + OFF_CKVN);
#pragma unroll 2
  for (int e = tid; e < 32 * 64; e += 256) {
    const int r = r0 + (e >> 6), c4 = (e & 63) * 4;
    const float4 v = *(const float4*)(p.cache_ckv + (size_t)r * 256 + c4);
    *(uint2*)(ckvn + (size_t)(NTOK + r) * 256 + c4) = make_uint2(pack2(v.x, v.y), pack2(v.z, v.w));
  }
}

template <int WHICH>
__device__ __forceinline__ void rmsmod_phase(const Params& p) {
  const int tid = ltid(), lane = tid & 63, wid = tid >> 6;
  const int gw = blockIdx.x * 4 + wid, tw = gridDim.x * 4;
  const float* g = WHICH == 0 ? p.g_mix : p.g_ffn;
  const float* mod = (const float*)(p.ws + OFF_MOD);
  bf16_t* h = (bf16_t*)(p.ws + OFF_H);
  float4 nv0, nv1, nv2, nv3;
  {
    const float* src = WHICH == 0 ? xrow(p, gw) : p.out + (size_t)gw * D;
    nv0 = ((const float4*)src)[lane]; nv1 = ((const float4*)src)[lane + 64]; nv2 = ((const float4*)src)[lane + 128]; nv3 = ((const float4*)src)[lane + 192];
  }
  for (int row = gw; row < NTOK; row += tw) {
    float4 v[4] = {nv0, nv1, nv2, nv3};
    if (row + tw < NTOK) {
      const float* src = WHICH == 0 ? xrow(p, row + tw) : p.out + (size_t)(row + tw) * D;
      nv0 = ((const float4*)src)[lane]; nv1 = ((const float4*)src)[lane + 64]; nv2 = ((const float4*)src)[lane + 128]; nv3 = ((const float4*)src)[lane + 192];
    }
    float ss = 0.f;
#pragma unroll
    for (int i = 0; i < 4; ++i) ss += v[i].x * v[i].x + v[i].y * v[i].y + v[i].z * v[i].z + v[i].w * v[i].w;
    ss = wave_sum(ss);
    const float r = rsqrtf(ss * (1.f / 1024.f) + 1e-6f);
    const float* mv = mod + modidx(row) * 6144 + (WHICH == 0 ? 0 : 3 * 1024);
#pragma unroll
    for (int i = 0; i < 4; ++i) {
      const int e = 4 * (lane + 64 * i);
      const float4 g4 = *(const float4*)(g + e), sh = *(const float4*)(mv + e), sc = *(const float4*)(mv + 1024 + e);
      const float y0 = v[i].x * r * g4.x * (1.f + sc.x) + sh.x, y1 = v[i].y * r * g4.y * (1.f + sc.y) + sh.y;
      const float y2 = v[i].z * r * g4.z * (1.f + sc.z) + sh.z, y3 = v[i].w * r * g4.w * (1.f + sc.w) + sh.w;
      *(uint2*)(h + (size_t)row * D + e) = make_uint2(pack2(y0, y1), pack2(y2, y3));
    }
  }
}

struct EpiIn {
  float* proj; bf16_t* hyT;
  __device__ __forceinline__ void operator()(int row0, int col, const f32x4& v) const {
    if (col < 672) {
#pragma unroll
      for (int j = 0; j < 4; ++j) proj[(size_t)(row0 + j) * 672 + col] = v[j];
    } else if (col < DIN) {
      *(uint2*)(hyT + (size_t)(col - 672) * NTOK + row0) = make_uint2(pack2(v[0], v[1]), pack2(v[2], v[3]));
    }
  }
};
struct EpiProj {
  float* proj;
  __device__ __forceinline__ void operator()(int row, int col0, const f32x4& v) const { *(f32x4*)(proj + (size_t)row * 672 + col0) = v; }
};
struct EpiQ {
  bf16_t* q;
  __device__ __forceinline__ void operator()(int row, int col0, const f32x4& v) const {
    *(uint2*)(q + (size_t)row * 768 + col0) = make_uint2(pack2(v[0], v[1]), pack2(v[2], v[3]));
  }
};
struct EpiKV {
  bf16_t *kraw, *vtc, *vtl;
  __device__ __forceinline__ void operator()(int row0, int col, const f32x4& v) const {
    const int head = col >> 7, cc = col & 127;
    if (cc < 64) {
#pragma unroll
      for (int j = 0; j < 4; ++j) kraw[(size_t)(row0 + j) * 512 + head * 64 + cc] = f2bf(v[j]);
    } else {
      const int dv = cc - 64;
      bf16_t* dst;
      if (row0 < NCTX) dst = vtc + ((size_t)((row0 >> 8) * 8 + head) * 64 + dv) * 256 + (row0 & 255);
      else if (row0 < NTOK) { const int r = row0 - NCTX; dst = vtl + ((size_t)((r >> 12) * 8 + head) * 64 + dv) * 4608 + (r & 4095); }
      else { const int r = row0 - NTOK; dst = vtl + ((size_t)((r >> 9) * 8 + head) * 64 + dv) * 4608 + 4096 + (r & 511); }
      *(uint2*)dst = make_uint2(pack2(v[0], v[1]), pack2(v[2], v[3]));
    }
  }
};
struct EpiOut {
  const Params* p;
  __device__ __forceinline__ void operator()(int row, int col0, const f32x4& v) const {
    const float4 x = *(const float4*)(xrow(*p, row) + col0);
    const float4 m = *(const float4*)((const float*)(p->ws + OFF_MOD) + modidx(row) * 6144 + 2 * 1024 + col0);
    *(float4*)(p->out + (size_t)row * D + col0) = make_float4(x.x + m.x * v[0], x.y + m.y * v[1], x.z + m.z * v[2], x.w + m.w * v[3]);
  }
};
struct EpiU {
  bf16_t* u;
  __device__ __forceinline__ void operator()(int row, int col0, const f32x4& v) const {
    *(uint2*)(u + (size_t)row * 5632 + col0) = make_uint2(pack2(v[0], v[1]), pack2(v[2], v[3]));
  }
};
struct EpiY {
  const Params* p; int half;
  __device__ __forceinline__ void operator()(int row, int col0, const f32x4& v) const {
    const int grow = half * 8192 + row;
    float4* dst = (float4*)(p->out + (size_t)grow * D + col0);
    const float4 x = *dst;
    const float4 m = *(const float4*)((const float*)(p->ws + OFF_MOD) + modidx(grow) * 6144 + 5 * 1024 + col0);
    *dst = make_float4(x.x + m.x * v[0], x.y + m.y * v[1], x.z + m.z * v[2], x.w + m.w * v[3]);
  }
};

__device__ __forceinline__ void token_item(const Params& p, int item) {
  const int tid = ltid(), lane = tid & 63, wid = tid >> 6;
  const float* proj = (const float*)(p.ws + OFF_PROJ);
  bf16_t* qa = (bf16_t*)(p.ws + OFF_QA);
  bf16_t* ckvn = (bf16_t*)(p.ws + OFF_CKVN);
  float* kpe = (float*)(p.ws + OFF_KPE);
  for (int tt = 0; tt < 8; ++tt) {
    const int token = item * 32 + wid * 8 + tt;
    const float* pr = proj + (size_t)token * 672;
    float2 q[3];
    float ss = 0.f;
#pragma unroll
    for (int i = 0; i < 3; ++i) { q[i] = *(const float2*)(pr + lane * 2 + 128 * i); ss += q[i].x * q[i].x + q[i].y * q[i].y; }
    ss = wave_sum(ss);
    const float r = rsqrtf(ss * (1.f / 384.f) + 1e-6f);
#pragma unroll
    for (int i = 0; i < 3; ++i) {
      const int e = lane * 2 + 128 * i;
      *(unsigned*)(qa + (size_t)token * 384 + e) = pack2(q[i].x * r * p.g_qa[e], q[i].y * r * p.g_qa[e + 1]);
    }
    const float4 kv = *(const float4*)(pr + 384 + lane * 4);
    float s2 = wave_sum(kv.x * kv.x + kv.y * kv.y + kv.z * kv.z + kv.w * kv.w);
    const float r2 = rsqrtf(s2 * (1.f / 256.f) + 1e-6f);
    const float4 g = *(const float4*)(p.g_kva + lane * 4);
    const float4 y = make_float4(kv.x * r2 * g.x, kv.y * r2 * g.y, kv.z * r2 * g.z, kv.w * r2 * g.w);
    *(uint2*)(ckvn + (size_t)token * 256 + lane * 4) = make_uint2(pack2(y.x, y.y), pack2(y.z, y.w));
    if (token < NCTX) *(float4*)(p.out + OUT_CKV + (size_t)token * 256 + lane * 4) = y;
    if (lane < 32) {
      const float kp = pr[640 + lane];
      kpe[(size_t)token * 32 + lane] = kp;
      if (token < NCTX) p.out[OUT_KPE + (size_t)token * 32 + lane] = kp;
    }
  }
}

template <int ORDER>
__device__ __forceinline__ void hyena_item(const Params& p, int grp, int c, char* smem) {
  const int tid = ltid(), lane = tid & 63, wid = tid >> 6, fr = lane & 15, fq = lane >> 4;
  const int n = grp ? SEQL : SEQC, nb = n >> 6, L = n;
  const bf16_t* Rrow = (const bf16_t*)(p.ws + (grp ? OFF_RLAT : OFF_RCTX)) + (size_t)(ORDER * 512 + c) * (2 * n);
  const bf16_t* hyT = (const bf16_t*)(p.ws + OFF_HYT);
  bf16_t* sU = (bf16_t*)smem;
  unsigned* sR0 = (unsigned*)(smem + 18432);
  unsigned* sR1 = (unsigned*)(smem + 18432 + 16384);
  const int tok0 = grp * 8192;
  __syncthreads();
  for (int ch = tid; ch < (2 * n) / 8; ch += 256) *(uint4*)((bf16_t*)sR0 + ch * 8) = *(const uint4*)(Rrow + ch * 8);
  if (ORDER == 0) {
    const bf16_t* raw = hyT + (size_t)c * NTOK + tok0;
    const float w0 = p.hy_conv_w[c], w1 = p.hy_conv_w[1536 + c], w2 = p.hy_conv_w[3072 + c], b = p.hy_conv_b[c];
    for (int ch = tid; ch < 1024; ch += 256) {
      const int t = ch * 8, pos = t & (L - 1);
      const uint4 rv = *(const uint4*)(raw + t);
      float x[10];
      x[0] = pos == 0 ? 0.f : bf2f(raw[t - 1]);
      x[1] = bflo(rv.x); x[2] = bfhi(rv.x); x[3] = bflo(rv.y); x[4] = bfhi(rv.y);
      x[5] = bflo(rv.z); x[6] = bfhi(rv.z); x[7] = bflo(rv.w); x[8] = bfhi(rv.w);
      x[9] = (pos + 8 == L) ? 0.f : bf2f(raw[t + 8]);
      float u[8];
#pragma unroll
      for (int i = 0; i < 8; ++i) u[i] = w0 * x[i] + w1 * x[i + 1] + w2 * x[i + 2] + b;
      *(uint4*)(sU + (ch >> 3) * 64 + (((ch & 7) ^ ((ch >> 3) & 7)) * 8)) = make_uint4(pack2(u[0], u[1]), pack2(u[2], u[3]), pack2(u[4], u[5]), pack2(u[6], u[7]));
    }
  } else {
    const bf16_t* zr = (const bf16_t*)(p.ws + OFF_ZT) + (size_t)c * NTOK + tok0;
    for (int ch = tid; ch < 1024; ch += 256) *(uint4*)(sU + (ch >> 3) * 64 + (((ch & 7) ^ ((ch >> 3) & 7)) * 8)) = *(const uint4*)(zr + ch * 8);
  }
  __syncthreads();
  for (int k = tid; k < n; k += 256) {
    const unsigned a = sR0[k], b2 = (k + 1 < n) ? sR0[k + 1] : 0u;
    sR1[k] = (a >> 16) | (b2 << 16);
  }
  __syncthreads();

  f32x4 acc[4][2];
#pragma unroll
  for (int m = 0; m < 4; ++m) { acc[m][0] = (f32x4){0.f, 0.f, 0.f, 0.f}; acc[m][1] = (f32x4){0.f, 0.f, 0.f, 0.f}; }
  const unsigned* abase = (fr & 1) ? (sR0 + ((n - 1 - fr) >> 1) + 4 * fq) : (sR1 + ((n - 2 - fr) >> 1) + 4 * fq);
  const int col0 = 32 * wid + fr, col1 = col0 + 16;
  const int i0 = col0 & (nb - 1), i1 = col1 & (nb - 1);
  for (int d = -(nb - 1); d <= nb - 1; ++d) {
    const bool v0 = (unsigned)(i0 - d) < (unsigned)nb, v1 = (unsigned)(i1 - d) < (unsigned)nb;
    const bool any0 = __ballot(v0) != 0ull, any1 = __ballot(v1) != 0ull;
    if (!any0 && !any1) continue;
    bf16x8 F[6];
    const unsigned* ap = abase - 32 * d + 16;
#pragma unroll
    for (int idx = 0; idx < 6; ++idx) {
      const unsigned* q = ap - 8 * idx;
      union { unsigned u[4]; bf16x8 v; } cv;
      cv.u[0] = q[0]; cv.u[1] = q[1]; cv.u[2] = q[2]; cv.u[3] = q[3];
      F[idx] = cv.v;
    }
#pragma unroll
    for (int nt = 0; nt < 2; ++nt) {
      if (!(nt ? any1 : any0)) continue;
      const bool vv = nt ? v1 : v0;
      const int srow = (nt ? col1 : col0) - d;
      const bf16_t* up = sU + srow * 64;
#pragma unroll
      for (int ks = 0; ks < 2; ++ks) {
        bf16x8 bf = (bf16x8){0, 0, 0, 0, 0, 0, 0, 0};
        if (vv) bf = *(const bf16x8*)(up + (((ks * 4 + fq) ^ (srow & 7)) * 8));
#pragma unroll
        for (int m = 0; m < 4; ++m)
          acc[m][nt] = __builtin_amdgcn_mfma_f32_16x16x32_bf16(F[m + 2 - 2 * ks], bf, acc[m][nt], 0, 0, 0);
      }
    }
  }
  const float skip = p.filt_bias[ORDER * 512 + c];
  const int gcol = (ORDER == 0 ? 512 : 1024) + c;
  const bf16_t* graw = hyT + (size_t)gcol * NTOK + tok0;
  const float w0 = p.hy_conv_w[gcol], w1 = p.hy_conv_w[1536 + gcol], w2 = p.hy_conv_w[3072 + gcol], b = p.hy_conv_b[gcol];
  bf16_t* outT = (bf16_t*)(p.ws + (ORDER == 0 ? OFF_ZT : OFF_Y2T)) + (size_t)c * NTOK + tok0;
#pragma unroll
  for (int nt = 0; nt < 2; ++nt) {
    const int col = nt ? col1 : col0;
#pragma unroll
    for (int m = 0; m < 4; ++m) {
      const int t = col * 64 + 16 * m + 4 * fq, pos = t & (L - 1);
      const uint2 uu = *(const uint2*)(sU + col * 64 + (((2 * m + (fq >> 1)) ^ (col & 7)) * 8) + 4 * (fq & 1));
      const uint2 gv = *(const uint2*)(graw + t);
      float x[6];
      x[0] = pos == 0 ? 0.f : bf2f(graw[t - 1]);
      x[1] = bflo(gv.x); x[2] = bfhi(gv.x); x[3] = bflo(gv.y); x[4] = bfhi(gv.y);
      x[5] = (pos + 4 == L) ? 0.f : bf2f(graw[t + 4]);
      const float u4[4] = {bflo(uu.x), bfhi(uu.x), bflo(uu.y), bfhi(uu.y)};
      float o[4];
#pragma unroll
      for (int j = 0; j < 4; ++j) {
        const float gate = w0 * x[j] + w1 * x[j + 1] + w2 * x[j + 2] + b;
        o[j] = gate * (acc[m][nt][j] + skip * u4[j]);
      }
      *(uint2*)(outT + t) = make_uint2(pack2(o[0], o[1]), pack2(o[2], o[3]));
    }
  }
}

__device__ __forceinline__ void rope32(float* y  , int pos) {
  const float prow = (float)(pos >> 6), pcol = (float)(pos & 63);
  const float fr[8] = {1.f, 0.31622776601683794f, 0.1f, 0.031622776601683794f, 0.01f, 0.0031622776601683794f, 0.001f, 0.00031622776601683794f};
#pragma unroll
  for (int i = 0; i < 8; ++i) {
    const float tr = prow * fr[i] * 0.15915494309189535f, tc = pcol * fr[i] * 0.15915494309189535f;
    const float sr = sin_turns(tr), cr = cos_turns(tr), sc = sin_turns(tc), cc = cos_turns(tc);
    const float a = y[i], b = y[8 + i], c2 = y[16 + i], d2 = y[24 + i];
    y[i] = a * cr - b * sr; y[8 + i] = b * cr + a * sr;
    y[16 + i] = c2 * cc - d2 * sc; y[24 + i] = d2 * cc + c2 * sc;
  }
}
__device__ __forceinline__ void unpack8(const uint4& v, float* x) {
  x[0] = bflo(v.x); x[1] = bfhi(v.x); x[2] = bflo(v.y); x[3] = bfhi(v.y);
  x[4] = bflo(v.z); x[5] = bfhi(v.z); x[6] = bflo(v.w); x[7] = bfhi(v.w);
}
__device__ __forceinline__ float sumsq8(const uint4& v) {
  float x[8];
  unpack8(v, x);
  return x[0] * x[0] + x[1] * x[1] + x[2] * x[2] + x[3] * x[3] + x[4] * x[4] + x[5] * x[5] + x[6] * x[6] + x[7] * x[7];
}
__device__ __forceinline__ uint4 scale8(const uint4& v, float r, const float* __restrict__ g) {
  float x[8];
  unpack8(v, x);
  const float4 g0 = *(const float4*)g, g1 = *(const float4*)(g + 4);
  return make_uint4(pack2(x[0] * r * g0.x, x[1] * r * g0.y), pack2(x[2] * r * g0.z, x[3] * r * g0.w),
                    pack2(x[4] * r * g1.x, x[5] * r * g1.y), pack2(x[6] * r * g1.z, x[7] * r * g1.w));
}
__device__ __forceinline__ void qk_item(const Params& p, int item) {
  const int tid = ltid();
  if (item < 512) {
    const int idx = item * 256 + tid, row = idx >> 3, h = idx & 7;
    const bf16_t* src = (const bf16_t*)(p.ws + OFF_QRAW) + (size_t)row * 768 + h * 96;
    bf16_t* dst = (bf16_t*)(p.ws + OFF_Q) + (size_t)row * 768 + h * 96;
    uint4 raw[12];
#pragma unroll
    for (int i = 0; i < 12; ++i) raw[i] = *(const uint4*)(src + 8 * i);
    float ss = 0.f;
#pragma unroll
    for (int i = 0; i < 12; ++i) ss += sumsq8(raw[i]);
    const float r = rsqrtf(ss * (1.f / 96.f) + 1e-6f);
    const float qs = 0.10206207261596575f * 1.4426950408889634f;
#pragma unroll
    for (int i = 0; i < 8; ++i) *(uint4*)(dst + 8 * i) = scale8(raw[i], r * qs, p.g_q + 8 * i);
    float y[32];
#pragma unroll
    for (int i = 0; i < 4; ++i) unpack8(raw[8 + i], y + 8 * i);
#pragma unroll
    for (int i = 0; i < 32; ++i) y[i] = y[i] * r * p.g_q[64 + i];
    if (row >= NCTX) rope32(y, (row - NCTX) & 4095);
#pragma unroll
    for (int i = 0; i < 4; ++i)
      *(uint4*)(dst + 64 + 8 * i) = make_uint4(pack2(y[8 * i] * qs, y[8 * i + 1] * qs), pack2(y[8 * i + 2] * qs, y[8 * i + 3] * qs),
                                               pack2(y[8 * i + 4] * qs, y[8 * i + 5] * qs), pack2(y[8 * i + 6] * qs, y[8 * i + 7] * qs));
  } else {
    const int idx = (item - 512) * 256 + tid, row = idx >> 3, h = idx & 7;
    const bf16_t* src = (const bf16_t*)(p.ws + OFF_KRAW) + (size_t)row * 512 + h * 64;
    uint4 raw[8];
#pragma unroll
    for (int i = 0; i < 8; ++i) raw[i] = *(const uint4*)(src + 8 * i);
    const float* kp = row < NTOK ? (const float*)(p.ws + OFF_KPE) + (size_t)row * 32 : p.cache_kpe + (size_t)(row - NTOK) * 32;
    float y[32];
#pragma unroll
    for (int i = 0; i < 8; ++i) {
      const float4 v = *(const float4*)(kp + 4 * i);
      y[4 * i] = v.x; y[4 * i + 1] = v.y; y[4 * i + 2] = v.z; y[4 * i + 3] = v.w;
    }
    float ss = 0.f;
#pragma unroll
    for (int i = 0; i < 8; ++i) ss += sumsq8(raw[i]);
#pragma unroll
    for (int i = 0; i < 32; ++i) ss += y[i] * y[i];
    const float r = rsqrtf(ss * (1.f / 96.f) + 1e-6f);
#pragma unroll
    for (int i = 0; i < 32; ++i) y[i] = y[i] * r * p.g_k[64 + i];
    bf16_t* dst;
    if (row < NCTX) dst = (bf16_t*)(p.ws + OFF_KC) + ((size_t)((row >> 8) * 8 + h) * 256 + (row & 255)) * 96;
    else if (row < NTOK) {
      const int rr = row - NCTX;
      rope32(y, rr & 4095);
      dst = (bf16_t*)(p.ws + OFF_KL) + ((size_t)((rr >> 12) * 8 + h) * 4608 + (rr & 4095)) * 96;
    } else {
      const int rr = row - NTOK;
      dst = (bf16_t*)(p.ws + OFF_KL) + ((size_t)((rr >> 9) * 8 + h) * 4608 + 4096 + (rr & 511)) * 96;
    }
#pragma unroll
    for (int i = 0; i < 8; ++i) *(uint4*)(dst + 8 * i) = scale8(raw[i], r, p.g_k + 8 * i);
#pragma unroll
    for (int i = 0; i < 4; ++i)
      *(uint4*)(dst + 64 + 8 * i) = make_uint4(pack2(y[8 * i], y[8 * i + 1]), pack2(y[8 * i + 2], y[8 * i + 3]),
                                               pack2(y[8 * i + 4], y[8 * i + 5]), pack2(y[8 * i + 6], y[8 * i + 7]));
  }
}

__device__ __forceinline__ void attn_item(const Params& p, int item, char* smem) {
  const int tid = ltid(), lane = tid & 63, wid = tid >> 6, lr = lane & 31, lh = lane >> 5;
  int nkeys, h, tokbase; const bf16_t *Kp, *Vp;
  if (item < 512) {
    const int b = item >> 8, rem = item & 255; h = rem >> 5; const int qb = rem & 31;
    nkeys = 4608; tokbase = NCTX + b * 4096 + qb * 128;
    Kp = (const bf16_t*)(p.ws + OFF_KL) + (size_t)(b * 8 + h) * 4608 * 96;
    Vp = (const bf16_t*)(p.ws + OFF_VTL) + (size_t)(b * 8 + h) * 64 * 4608;
  } else {
    const int it = item - 512, b = it >> 4; h = (it & 15) >> 1; const int qb = it & 1;
    nkeys = 256; tokbase = b * 256 + qb * 128;
    Kp = (const bf16_t*)(p.ws + OFF_KC) + (size_t)(b * 8 + h) * 256 * 96;
    Vp = (const bf16_t*)(p.ws + OFF_VTC) + (size_t)(b * 8 + h) * 64 * 256;
  }
  bf16_t* sK = (bf16_t*)smem;
  bf16_t* sV = sK + 64 * 104;
  const int token = tokbase + 32 * wid + lr;
  const bf16_t* qsrc = (const bf16_t*)(p.ws + OFF_Q) + (size_t)token * 768 + h * 96 + 8 * lh;
  bf16x8 qf[6];
#pragma unroll
  for (int ks = 0; ks < 6; ++ks) qf[ks] = *(const bf16x8*)(qsrc + 16 * ks);
  f32x16 oacc[2];
#pragma unroll
  for (int j = 0; j < 16; ++j) { oacc[0][j] = 0.f; oacc[1][j] = 0.f; }
  float mrun = -1e30f, lsum = 0.f;
  const int kk0 = tid / 12, kc0 = tid % 12, kk1 = (tid + 256) / 12, kc1 = (tid + 256) % 12, kk2 = (tid + 512) / 12, kc2 = (tid + 512) % 12;
  const int vd0 = tid >> 3, vc0 = tid & 7, vd1 = vd0 + 32;
  const bf16_t* gk0 = Kp + (size_t)kk0 * 96 + kc0 * 8;
  const bf16_t* gk1 = Kp + (size_t)kk1 * 96 + kc1 * 8;
  const bf16_t* gk2 = Kp + (size_t)kk2 * 96 + kc2 * 8;
  const bf16_t* gv0 = Vp + (size_t)vd0 * nkeys + vc0 * 8;
  const bf16_t* gv1 = Vp + (size_t)vd1 * nkeys + vc0 * 8;
  uint4 rk0 = *(const uint4*)gk0, rk1 = *(const uint4*)gk1, rk2 = *(const uint4*)gk2;
  uint4 rv0 = *(const uint4*)gv0, rv1 = *(const uint4*)gv1;
  const int nt = nkeys >> 6;
  for (int kt = 0; kt < nt; ++kt) {
    __syncthreads();
    *(uint4*)(sK + kk0 * 104 + kc0 * 8) = rk0; *(uint4*)(sK + kk1 * 104 + kc1 * 8) = rk1; *(uint4*)(sK + kk2 * 104 + kc2 * 8) = rk2;
    *(uint4*)(sV + vd0 * 72 + vc0 * 8) = rv0; *(uint4*)(sV + vd1 * 72 + vc0 * 8) = rv1;
    __syncthreads();
    if (kt + 1 < nt) {
      gk0 += 64 * 96; gk1 += 64 * 96; gk2 += 64 * 96; gv0 += 64; gv1 += 64;
      rk0 = *(const uint4*)gk0; rk1 = *(const uint4*)gk1; rk2 = *(const uint4*)gk2;
      rv0 = *(const uint4*)gv0; rv1 = *(const uint4*)gv1;
    }
    __builtin_amdgcn_sched_barrier(0);
    f32x16 sacc[2];
#pragma unroll
    for (int kb = 0; kb < 2; ++kb) {
#pragma unroll
      for (int j = 0; j < 16; ++j) sacc[kb][j] = 0.f;
#pragma unroll
      for (int ks = 0; ks < 6; ++ks) {
        const bf16x8 a = *(const bf16x8*)(sK + (32 * kb + lr) * 104 + 16 * ks + 8 * lh);
        sacc[kb] = __builtin_amdgcn_mfma_f32_32x32x16_bf16(a, qf[ks], sacc[kb], 0, 0, 0);
      }
    }
    float mx = sacc[0][0];
#pragma unroll
    for (int j = 1; j < 16; ++j) mx = fmaxf(mx, sacc[0][j]);
#pragma unroll
    for (int j = 0; j < 16; ++j) mx = fmaxf(mx, sacc[1][j]);
    mx = fmaxf(mx, __shfl_xor(mx, 32));
    const float mnew = fmaxf(mrun, mx);
    const float alpha = __builtin_amdgcn_exp2f(mrun - mnew);
    mrun = mnew;
    float ps = 0.f;
#pragma unroll
    for (int kb = 0; kb < 2; ++kb)
#pragma unroll
      for (int j = 0; j < 16; ++j) { const float e = __builtin_amdgcn_exp2f(sacc[kb][j] - mnew); sacc[kb][j] = e; ps += e; }
    lsum = lsum * alpha + ps;
    if (__ballot(alpha != 1.f) != 0ull) {
#pragma unroll
      for (int j = 0; j < 16; ++j) { oacc[0][j] *= alpha; oacc[1][j] *= alpha; }
    }
#pragma unroll
    for (int s = 0; s < 4; ++s) {
      const int kb = s >> 1, jb = 8 * (s & 1);
      union { unsigned u[4]; bf16x8 v; } pf;
      pf.u[0] = pack2(sacc[kb][jb + 0], sacc[kb][jb + 1]); pf.u[1] = pack2(sacc[kb][jb + 2], sacc[kb][jb + 3]);
      pf.u[2] = pack2(sacc[kb][jb + 4], sacc[kb][jb + 5]); pf.u[3] = pack2(sacc[kb][jb + 6], sacc[kb][jb + 7]);
#pragma unroll
      for (int mt = 0; mt < 2; ++mt) {
        const bf16_t* vp = sV + (32 * mt + lr) * 72 + 16 * s + 4 * lh;
        union { uint2 d[2]; bf16x8 v; } av;
        av.d[0] = *(const uint2*)vp;
        av.d[1] = *(const uint2*)(vp + 8);
        oacc[mt] = __builtin_amdgcn_mfma_f32_32x32x16_bf16(av.v, pf.v, oacc[mt], 0, 0, 0);
      }
    }
  }
  lsum += __shfl_xor(lsum, 32);
  const float inv = 1.f / lsum;
  bf16_t* dst = (bf16_t*)(p.ws + OFF_ATTN) + (size_t)token * 512 + h * 64;
#pragma unroll
  for (int mt = 0; mt < 2; ++mt)
#pragma unroll
    for (int jg = 0; jg < 4; ++jg) {
      const int dv0 = 32 * mt + 8 * jg + 4 * lh;
      *(uint2*)(dst + dv0) = make_uint2(pack2(oacc[mt][4 * jg] * inv, oacc[mt][4 * jg + 1] * inv),
                                        pack2(oacc[mt][4 * jg + 2] * inv, oacc[mt][4 * jg + 3] * inv));
    }
}

__device__ __forceinline__ void merge_item(const Params& p, int item, char* smem) {
  const int tid = ltid(), lane = tid & 63, wid = tid >> 6, t0 = item * 32;
  bf16_t* mix = (bf16_t*)(p.ws + OFF_H);
  const bf16_t* attn = (const bf16_t*)(p.ws + OFF_ATTN);
  for (int tt = 0; tt < 8; ++tt) {
    const int token = t0 + wid * 8 + tt;
    float x[8];
    unpack8(*(const uint4*)(attn + (size_t)token * 512 + lane * 8), x);
    float ss = 0.f;
#pragma unroll
    for (int i = 0; i < 8; ++i) ss += x[i] * x[i];
    ss = wave_sum(ss);
    const float r = rsqrtf(ss * (1.f / 512.f) + 1e-6f);
    const float4 g0 = *(const float4*)(p.g_out_att + lane * 8), g1 = *(const float4*)(p.g_out_att + lane * 8 + 4);
    *(uint4*)(mix + (size_t)token * D + lane * 8) =
        make_uint4(pack2(x[0] * r * g0.x, x[1] * r * g0.y), pack2(x[2] * r * g0.z, x[3] * r * g0.w),
                   pack2(x[4] * r * g1.x, x[5] * r * g1.y), pack2(x[6] * r * g1.z, x[7] * r * g1.w));
  }
  bf16_t* sT = (bf16_t*)smem;
  const bf16_t* y2T = (const bf16_t*)(p.ws + OFF_Y2T);
  __syncthreads();
  for (int ch = tid; ch < 2048; ch += 256) {
    const int c = ch >> 2, q4 = ch & 3;
    const uint4 v = *(const uint4*)(y2T + (size_t)c * NTOK + t0 + q4 * 8);
    bf16_t* d = sT + (q4 * 8) * 520 + c;
    d[0 * 520] = (bf16_t)(v.x & 0xffff); d[1 * 520] = (bf16_t)(v.x >> 16);
    d[2 * 520] = (bf16_t)(v.y & 0xffff); d[3 * 520] = (bf16_t)(v.y >> 16);
    d[4 * 520] = (bf16_t)(v.z & 0xffff); d[5 * 520] = (bf16_t)(v.z >> 16);
    d[6 * 520] = (bf16_t)(v.w & 0xffff); d[7 * 520] = (bf16_t)(v.w >> 16);
  }
  __syncthreads();
  {
    const int tt = tid >> 3, part = tid & 7;
    uint4 v[8];
    float ss = 0.f;
#pragma unroll
    for (int i = 0; i < 8; ++i) {
      v[i] = *(const uint4*)(sT + tt * 520 + part * 64 + 8 * i);
      float x[8];
      unpack8(v[i], x);
#pragma unroll
      for (int e = 0; e < 8; ++e) ss += x[e] * x[e];
    }
    ss += __shfl_xor(ss, 1); ss += __shfl_xor(ss, 2); ss += __shfl_xor(ss, 4);
    const float r = rsqrtf(ss * (1.f / 512.f) + 1e-6f);
#pragma unroll
    for (int i = 0; i < 8; ++i) {
      float x[8];
      unpack8(v[i], x);
      const int c0 = part * 64 + 8 * i;
      const float4 g0 = *(const float4*)(p.g_out_hy + c0), g1 = *(const float4*)(p.g_out_hy + c0 + 4);
      *(uint4*)(mix + (size_t)(t0 + tt) * D + 512 + c0) =
          make_uint4(pack2(x[0] * r * g0.x, x[1] * r * g0.y), pack2(x[2] * r * g0.z, x[3] * r * g0.w),
                     pack2(x[4] * r * g1.x, x[5] * r * g1.y), pack2(x[6] * r * g1.z, x[7] * r * g1.w));
    }
  }
}

__device__ __forceinline__ void actfix_item(const Params& p, int item) {
  const int idx = item * 256 + ltid();
  if (idx >= 512 * 352) return;
  const int j = (idx % 352) * 8, rowi = idx / 352, wt = rowi >> 1, which = rowi & 1;
  const int t = 64 * wt + 63 * which, L = t < NCTX ? SEQC : SEQL, pos = t & (L - 1);
  const bf16_t* edge = (const bf16_t*)(p.ws + OFF_EDGE);
  bf16_t* act = (bf16_t*)(p.ws + OFF_U);
  const bf16_t *pr, *cu, *nx;
  bool zp = false, zn = false;
  if (which == 0) { zp = pos == 0; pr = edge + (size_t)((zp ? wt : wt - 1) * 4 + 3) * 5632; cu = edge + (size_t)(wt * 4 + 0) * 5632; nx = edge + (size_t)(wt * 4 + 1) * 5632; }
  else { zn = pos == L - 1; pr = edge + (size_t)(wt * 4 + 2) * 5632; cu = edge + (size_t)(wt * 4 + 3) * 5632; nx = edge + (size_t)((zn ? wt : wt + 1) * 4 + 0) * 5632; }
  float pa[8], pg[8], ca[8], cgv[8], na[8], ng[8];
  unpack8(*(const uint4*)(pr + j), pa); unpack8(*(const uint4*)(pr + 2816 + j), pg);
  unpack8(*(const uint4*)(cu + j), ca); unpack8(*(const uint4*)(cu + 2816 + j), cgv);
  unpack8(*(const uint4*)(nx + j), na); unpack8(*(const uint4*)(nx + 2816 + j), ng);
  float o[8];
#pragma unroll
  for (int e = 0; e < 8; ++e) {
    const float pae = zp ? 0.f : pa[e], pge = zp ? 0.f : pg[e], nae = zn ? 0.f : na[e], nge = zn ? 0.f : ng[e];
    const float a = p.ffn_conv_w[j + e] * pae + p.ffn_conv_w[5632 + j + e] * ca[e] + p.ffn_conv_w[11264 + j + e] * nae + p.ffn_conv_b[j + e];
    const float g = p.ffn_conv_w[2816 + j + e] * pge + p.ffn_conv_w[5632 + 2816 + j + e] * cgv[e] + p.ffn_conv_w[11264 + 2816 + j + e] * nge + p.ffn_conv_b[2816 + j + e];
    o[e] = a * __builtin_amdgcn_rcpf(1.f + __expf(-a)) * g;
  }
  *(uint4*)(act + (size_t)t * 2816 + j) = make_uint4(pack2(o[0], o[1]), pack2(o[2], o[3]), pack2(o[4], o[5]), pack2(o[6], o[7]));
}

#define XB_TMO      128
#define XB_XCNT(j)  (256  + 64 * (j))
#define XB_XSUB(j)  (1280 + 64 * (j))
#define XB_XGEN(j)  (2304 + 64 * (j))
#define XB_TOP      3328
#define XB_TOPGEN   3392
#define XCD_BAR_WORDS 3456
#define XB_SPIN_CAP (1u << 20)
#define LAS __attribute__((address_space(3)))
__device__ __forceinline__ unsigned xb_ld(unsigned* p) { return __hip_atomic_load(p, __ATOMIC_RELAXED, __HIP_MEMORY_SCOPE_AGENT); }
__device__ __forceinline__ unsigned xb_add(unsigned* p, unsigned v) { return __hip_atomic_fetch_add(p, v, __ATOMIC_RELAXED, __HIP_MEMORY_SCOPE_AGENT); }
__device__ __forceinline__ unsigned xb_xcc_id() { return (unsigned)__builtin_amdgcn_s_getreg((3 << 11) | 20) & 0xFu; }
#define XB_SPIN(cond, bar) do { unsigned _sp = 0; while (cond) { __builtin_amdgcn_s_sleep(1); \
    if ((++_sp & 255u) == 0u) { if (xb_ld(&(bar)[XB_TMO])) break; if (_sp > XB_SPIN_CAP) { atomicAdd(&(bar)[XB_TMO], 1u); break; } } } } while (0)
struct XcdBarrier { unsigned* bar; unsigned x; volatile LAS unsigned* st; };
__device__ __forceinline__ XcdBarrier xcd_barrier_post(unsigned* bar, volatile LAS unsigned* st) {
  XcdBarrier b; b.bar = bar; b.x = xb_xcc_id(); b.st = st;
  if (threadIdx.x == 0) (void)xb_add(&bar[XB_XCNT(b.x)], 1u);
  return b;
}
__device__ __forceinline__ void xcd_barrier_complete(unsigned* bar, unsigned x, unsigned& nloc, unsigned& nx) {
  const unsigned G = gridDim.x * gridDim.y * gridDim.z;
  unsigned sum, cnt, mine, sp = 0u;
  for (;;) {
    sum = 0u; cnt = 0u; mine = 0u;
#pragma unroll
    for (unsigned j = 0; j < 16; ++j) { const unsigned c = xb_ld(&bar[XB_XCNT(j)]); sum += c; cnt += (c > 0u) ? 1u : 0u; mine = (j == x) ? c : mine; }
    if (sum == G) break;
    __builtin_amdgcn_s_sleep(1);
    if ((++sp & 255u) == 0u) { if (xb_ld(&bar[XB_TMO])) break; if (sp > XB_SPIN_CAP) { atomicAdd(&bar[XB_TMO], 1u); break; } }
  }
  nloc = mine > 0u ? mine : 1u; nx = cnt > 0u ? cnt : 1u;
}
__device__ __forceinline__ void xcd_barrier(const XcdBarrier& b) {
  asm volatile("s_waitcnt vmcnt(0)" ::: "memory");
  __syncthreads();
  if (threadIdx.x == 0) {
    unsigned* bar = b.bar;
    __builtin_amdgcn_s_waitcnt(0);
    unsigned nloc = b.st[0], nx = b.st[1];
    if (nloc == 0u) { xcd_barrier_complete(bar, b.x, nloc, nx); b.st[0] = nloc; b.st[1] = nx; }
    const unsigned old = xb_add(&bar[XB_XSUB(b.x)], 1u);
    const unsigned gen = old / nloc;
    if (old + 1u == (gen + 1u) * nloc) {
      __builtin_amdgcn_fence(__ATOMIC_RELEASE, "agent");
      asm volatile("s_waitcnt vmcnt(0)" ::: "memory");
      const unsigned og = xb_add(&bar[XB_TOP], 1u);
      const unsigned tg = og / nx;
      if (og + 1u == (tg + 1u) * nx) xb_add(&bar[XB_TOPGEN], 1u);
      else XB_SPIN(xb_ld(&bar[XB_TOPGEN]) == tg, bar);
      __builtin_amdgcn_fence(__ATOMIC_ACQUIRE, "agent");
      xb_add(&bar[XB_XGEN(b.x)], 1u);
      asm volatile("s_waitcnt vmcnt(0)" ::: "memory");
    } else {
      XB_SPIN(xb_ld(&bar[XB_XGEN(b.x)]) == gen, bar);
      __builtin_amdgcn_fence(__ATOMIC_ACQUIRE, "agent");
      asm volatile("s_waitcnt vmcnt(0)" ::: "memory");
    }
  }
  __syncthreads();
}
constexpr size_t OFF_BAR = 25 * MiB - 16384;
static_assert(OFF_MOD + 3 * 6144 * 4 <= OFF_BAR, "bar");

template <int ph>
__device__ __forceinline__ void run_phase(const Params& p, char* smem) {
  const int bid = blockIdx.x, G = gridDim.x;
  char* ws = p.ws;
  if constexpr (ph == 0) {
    for (int it = bid; it < 272 + 96 + 32 + 3080; it += G) {
      if (it < 272) filter_item(p, it, smem);
      else if (it < 368) mod_item(p, it - 272, smem);
      else if (it < 400) cache_item(p, it - 368);
      else {
        int t = it - 400;
        if (t < 576) transpose_item(p.w_in, 1024, DIN, (bf16_t*)(ws + OFF_WIN), t, 36, smem);
        else if ((t -= 576) < 72) transpose_item(p.w_uq, 384, 768, (bf16_t*)(ws + OFF_WUQ), t, 12, smem);
        else if ((t -= 72) < 64) transpose_item(p.w_ukv, 256, 1024, (bf16_t*)(ws + OFF_WUKV), t, 16, smem);
        else if ((t -= 64) < 256) transpose_item(p.w_out, 1024, 1024, (bf16_t*)(ws + OFF_WOUT), t, 16, smem);
        else if ((t -= 256) < 1408) transpose_item(p.w_up, 1024, 5632, (bf16_t*)(ws + OFF_WUP), t, 88, smem, true);
        else { t -= 1408; transpose_item(p.w_down, 2816, 1024, (bf16_t*)(ws + OFF_WDOWN), t, 16, smem); }
      }
    }
  } else if constexpr (ph == 1) {
    rmsmod_phase<0>(p);
  } else if constexpr (ph == 2) {
    EpiIn epi{(float*)(ws + OFF_PROJ), (bf16_t*)(ws + OFF_HYT)};
    EpiProj epr{(float*)(ws + OFF_PROJ)};
    for (int t = bid; t < 128 * 18; t += G) {
      const int nt = t % 18;
      if (nt < 5) gemm_tile<true>((const bf16_t*)(ws + OFF_H), 1024, (const bf16_t*)(ws + OFF_WIN), 1024, 1024, (t / 18) * 128, nt * 128, smem, epr);
      else gemm_tile<false>((const bf16_t*)(ws + OFF_H), 1024, (const bf16_t*)(ws + OFF_WIN), 1024, 1024, (t / 18) * 128, nt * 128, smem, epi);
    }
  } else if constexpr (ph == 3) {
    for (int it = bid; it < 512; it += G) hyena_item<0>(p, 1, it, smem);
    for (int it = bid; it < 512; it += G) hyena_item<0>(p, 0, it, smem);
    for (int it = G - 1 - bid; it < 512; it += G) token_item(p, it);
  } else if constexpr (ph == 4) {
    EpiQ eq{(bf16_t*)(ws + OFF_QRAW)};
    EpiKV ekv{(bf16_t*)(ws + OFF_KRAW), (bf16_t*)(ws + OFF_VTC), (bf16_t*)(ws + OFF_VTL)};
    for (int it = bid; it < 512; it += G) hyena_item<1>(p, 1, it, smem);
    for (int t = bid; t < 768; t += G) gemm_tile<true>((const bf16_t*)(ws + OFF_QA), 384, (const bf16_t*)(ws + OFF_WUQ), 384, 384, (t / 6) * 128, (t % 6) * 128, smem, eq);
    for (int t = bid; t < 1088; t += G) gemm_tile<false>((const bf16_t*)(ws + OFF_CKVN), 256, (const bf16_t*)(ws + OFF_WUKV), 256, 256, (t / 8) * 128, (t % 8) * 128, smem, ekv);
    for (int it = bid; it < 512; it += G) hyena_item<1>(p, 0, it, smem);
  } else if constexpr (ph == 5) {
    for (int it = bid; it < 512 + 544; it += G) qk_item(p, it);
  } else if constexpr (ph == 6) {
    for (int it = bid; it < 1024; it += G) attn_item(p, it, smem);
  } else if constexpr (ph == 7) {
    for (int it = bid; it < 512; it += G) merge_item(p, it, smem);
  } else if constexpr (ph == 8) {
    EpiOut epi{&p};
    for (int t = bid; t < 128 * 8; t += G)
      gemm_tile<true>((const bf16_t*)(ws + OFF_H), 1024, (const bf16_t*)(ws + OFF_WOUT), 1024, 1024, (t / 8) * 128, (t % 8) * 128, smem, epi);
  } else if constexpr (ph == 9) {
    rmsmod_phase<1>(p);
  } else if constexpr (ph == 10) {
    for (int t = bid; t < 128 * 44; t += G) gemm_up_act_tile(p, (t / 44) * 128, (t % 44) * 128, smem);
  } else if constexpr (ph == 11) {
    for (int it = bid; it < 704; it += G) actfix_item(p, it);
  } else if constexpr (ph == 12) {
    EpiY epi{&p, 0};
    for (int t = bid; t < 128 * 8; t += G)
      gemm_tile<true>((const bf16_t*)(ws + OFF_U), 2816, (const bf16_t*)(ws + OFF_WDOWN), 2816, 2816, (t / 8) * 128, (t % 8) * 128, smem, epi);
  }
}

#if ONE_LAUNCH
template <int PH>
__device__ __forceinline__ void run_all(const Params& p, char* smem, cg::grid_group& grid, const XcdBarrier& xb) {
  run_phase<PH>(p, smem);
  if constexpr (((DBL_MASK >> PH) & 1) != 0) { xcd_barrier(xb); run_phase<PH>(p, smem); }
  if constexpr (PH < 12) {
    xcd_barrier(xb);
    run_all<PH + 1>(p, smem, grid, xb);
  }
}
constexpr int DYN_LDS = 65536 + 64;
__global__ void __launch_bounds__(256, 2) mega_kernel(Params p) {
  extern __shared__ __attribute__((aligned(16))) char smem[];
  uint4* xb_words = (uint4*)(smem + 65536);
  cg::grid_group grid = cg::this_grid();
  if (threadIdx.x == 0) *xb_words = make_uint4(0u, 0u, 0u, 0u);
  __syncthreads();
  XcdBarrier xb = xcd_barrier_post((unsigned*)(p.ws + OFF_BAR), (volatile LAS unsigned*)xb_words);
  if (p.ws == nullptr) grid.sync();
  run_all<0>(p, smem, grid, xb);
}
#else
template <int PH>
__global__ void __launch_bounds__(256, 2) phase_kernel(Params p) {
  __shared__ __attribute__((aligned(16))) char smem[SMEM_BYTES];
  run_phase<PH>(p, smem);
}
#ifndef DBG_STOP
#define DBG_STOP 15
#endif
__global__ void dump_kernel(Params p, size_t off, int count) {
  const bf16_t* src = (const bf16_t*)(p.ws + off);
  const bf16_t* src2 = (const bf16_t*)(p.ws + DBG_OFF2);
  for (int i = blockIdx.x * 256 + threadIdx.x; i < 16777216; i += gridDim.x * 256)
    p.out[i] = i < DBG_CNT ? bf2f(src[i]) : (i - DBG_CNT < DBG_CNT2 ? bf2f(src2[i - DBG_CNT]) : 0.f);
}
template <int PH>
static void launch_all(const Params& p, hipStream_t stream) {
  phase_kernel<PH><<<512, 256, 0, stream>>>(p);
  if constexpr (PH < 12) launch_all<PH + 1>(p, stream);
}
#endif

extern "C" void kernel_launch(void* const* d_in, const int* in_sizes, int n_in, void* d_out, int out_size, void* d_ws,
                              size_t ws_size, hipStream_t stream) {
  Params p{};
  const float** pp = (const float**)&p;
  for (int i = 0; i < 34; ++i) pp[i] = (const float*)d_in[i];
  p.out = (float*)d_out;
  p.ws = (char*)d_ws;
#if ONE_LAUNCH
  (void)hipMemsetAsync((char*)d_ws + OFF_BAR, 0, XCD_BAR_WORDS * 4, stream);
  static int grid_blocks = 0;
  if (!grid_blocks) {
    int dev = 0, cus = 0, per_cu = 0;
    hipGetDevice(&dev);
    hipDeviceGetAttribute(&cus, hipDeviceAttributeMultiprocessorCount, dev);
    (void)hipFuncSetAttribute((const void*)mega_kernel, hipFuncAttributeMaxDynamicSharedMemorySize, DYN_LDS);
    (void)hipOccupancyMaxActiveBlocksPerMultiprocessor(&per_cu, mega_kernel, 256, DYN_LDS);
    if (per_cu > 2) per_cu = 2;
    grid_blocks = cus * per_cu;
  }
  void* args[] = {&p};
  hipError_t e = hipLaunchCooperativeKernel((void*)mega_kernel, dim3(grid_blocks), dim3(256), args, DYN_LDS, stream);
  if (e != hipSuccess) fprintf(stderr, "cooperative launch failed: %s (grid %d)\n", hipGetErrorString(e), grid_blocks);
#else
  launch_all<0>(p, stream);
#if DBG_STOP < 15
  dump_kernel<<<1024, 256, 0, stream>>>(p, DBG_OFF, DBG_CNT);
#endif
#endif
}
```

```cpp
#include <hip/hip_runtime.h>
#include <hip/hip_cooperative_groups.h>
#include <cstdio>
namespace cg = cooperative_groups;

#define DBG_STOP 15
#define DBG_NOHY 0
#ifndef DBL_MASK
#define DBL_MASK 0
#endif
#define DBG_OFF OFF_QRAW
#define DBG_OFF2 OFF_KRAW
#define DBG_CNT 12582912
#define DBG_CNT2 0
#ifndef ONE_LAUNCH
#define ONE_LAUNCH 1
#endif

typedef unsigned short bf16_t;
typedef short bf16x8 __attribute__((ext_vector_type(8)));
typedef float f32x4 __attribute__((ext_vector_type(4)));
typedef float f32x16 __attribute__((ext_vector_type(16)));

constexpr int D = 1024, NTOK = 16384, NCTX = 8192, SEQC = 256, SEQL = 4096;
constexpr int DIN = 2208, DINP = 2304, QL = 384, KVL = 256, DFF = 2816;
constexpr int NROWKV = 17408;
constexpr size_t MiB = 1048576;

constexpr size_t OFF_WIN = 0;
constexpr size_t OFF_WUQ = OFF_WIN + (size_t)DINP * 1024 * 2;
constexpr size_t OFF_WUKV = OFF_WUQ + (size_t)768 * 384 * 2;
constexpr size_t OFF_WOUT = OFF_WUKV + (size_t)1024 * 256 * 2;
constexpr size_t OFF_WUP = OFF_WOUT + (size_t)1024 * 1024 * 2;
constexpr size_t OFF_WDOWN = OFF_WUP + (size_t)5632 * 1024 * 2;
constexpr size_t OFF_MOD = OFF_WDOWN + (size_t)1024 * 2816 * 2;
static_assert(OFF_MOD + 3 * 6144 * 4 <= 25 * MiB, "A region");
constexpr size_t OFF_RLAT = 25 * MiB;
constexpr size_t OFF_RCTX = 41 * MiB;
constexpr size_t OFF_H = 42 * MiB;
constexpr size_t OFF_ZT = 42 * MiB;
constexpr size_t OFF_QA = 58 * MiB;
constexpr size_t OFF_KPE = 70 * MiB;
constexpr size_t OFF_PROJ = 74 * MiB;
constexpr size_t OFF_QRAW = 74 * MiB;
constexpr size_t OFF_Y2T = 98 * MiB;
constexpr size_t OFF_ATTN = 74 * MiB;
constexpr size_t OFF_U = 74 * MiB;
constexpr size_t OFF_HYT = 116 * MiB;
constexpr size_t OFF_Q = 116 * MiB;
constexpr size_t OFF_KC = 140 * MiB;
constexpr size_t OFF_KL = 152 * MiB;
constexpr size_t OFF_CKVN = 164 * MiB;
constexpr size_t OFF_KRAW = 173 * MiB;
constexpr size_t OFF_VTC = 190 * MiB;
constexpr size_t OFF_VTL = 198 * MiB;
constexpr size_t OFF_ACT = 162 * MiB;

constexpr int OUT_YS = 0;
constexpr int OUT_CKV = 16777216;
constexpr int OUT_KPE = 16777216 + 2097152;

constexpr int SMEM_BYTES = 51200;

struct Params {
  const float *x_prompt, *x_sample, *cache_ckv, *cache_kpe, *c, *c_ctx, *w_ada, *b_ada, *g_mix, *w_in, *g_qa, *w_uq,
      *g_kva, *w_ukv, *g_q, *g_k, *hy_conv_w, *hy_conv_b, *filt_w1, *filt_b1, *filt_freq1, *filt_w2, *filt_b2,
      *filt_freq2, *filt_w3, *filt_bias, *g_out_att, *g_out_hy, *w_out, *g_ffn, *w_up, *ffn_conv_w, *ffn_conv_b, *w_down;
  float* out;
  char* ws;
};

typedef __bf16 bf16x2_t __attribute__((ext_vector_type(2)));
__device__ __forceinline__ unsigned pack2(float lo, float hi) {
  bf16x2_t v;
  v[0] = (__bf16)lo;
  v[1] = (__bf16)hi;
  return __builtin_bit_cast(unsigned, v);
}
__device__ __forceinline__ float bflo(unsigned u) { return __uint_as_float(u << 16); }
__device__ __forceinline__ float bfhi(unsigned u) { return __uint_as_float(u & 0xffff0000u); }
__device__ __forceinline__ float bf2f(bf16_t h) { return __uint_as_float(((unsigned)h) << 16); }
__device__ __forceinline__ bf16_t f2bf(float f) { return (bf16_t)(pack2(f, 0.f) & 0xffffu); }
__device__ __forceinline__ float wave_sum(float v) {
#pragma unroll
  for (int o = 32; o >= 1; o >>= 1) v += __shfl_xor(v, o);
  return v;
}
__device__ __forceinline__ int ltid() { int t = threadIdx.x; asm volatile("" : "+v"(t)); return t; }
__device__ __forceinline__ float sin_turns(float t) { t -= floorf(t); return __builtin_amdgcn_sinf(t); }
__device__ __forceinline__ float cos_turns(float t) { t -= floorf(t); return __builtin_amdgcn_cosf(t); }
__device__ __forceinline__ float sin_rad(float x) { return sin_turns(x * 0.15915494309189535f); }
__device__ __forceinline__ const float* xrow(const Params& p, int row) {
  return row < NCTX ? p.x_prompt + (size_t)row * D : p.x_sample + (size_t)(row - NCTX) * D;
}
__device__ __forceinline__ int modidx(int row) { return row < NCTX ? 0 : 1 + ((row - NCTX) >> 12); }

template <bool SWAP>
__device__ __forceinline__ void gemm_main(const bf16_t* __restrict__ A, int lda, const bf16_t* __restrict__ Bt, int ldb,
                                          int K, int m0, int n0, char* smem, f32x4 (&acc)[4][4]) {
  const int tid = ltid(), lane = tid & 63, wid = tid >> 6, wr = wid >> 1, wc = wid & 1;
  const int fr = lane & 15, fq = lane >> 4;
  bf16_t* sbase = (bf16_t*)smem;
#pragma unroll
  for (int m = 0; m < 4; ++m)
#pragma unroll
    for (int n = 0; n < 4; ++n) acc[m][n] = (f32x4){0.f, 0.f, 0.f, 0.f};
  const int lr = tid >> 3, lc = (tid & 7) * 8;
  const bf16_t* ga = A + (size_t)(m0 + lr) * lda + lc;
  const bf16_t* gb = Bt + (size_t)(n0 + lr) * ldb + lc;
  const size_t sa32 = (size_t)32 * lda, sb32 = (size_t)32 * ldb;
  uint4 ra0 = *(const uint4*)(ga), ra1 = *(const uint4*)(ga + sa32), ra2 = *(const uint4*)(ga + 2 * sa32), ra3 = *(const uint4*)(ga + 3 * sa32);
  uint4 rb0 = *(const uint4*)(gb), rb1 = *(const uint4*)(gb + sb32), rb2 = *(const uint4*)(gb + 2 * sb32), rb3 = *(const uint4*)(gb + 3 * sb32);
  const int nk = K >> 6;
  const int woff = lr * 64 + (((tid & 7) ^ (lr & 7)) * 8);
  const int aoff = (wr * 64 + fr) * 64, boff = 8192 + (wc * 64 + fr) * 64;
  __syncthreads();
  {
    bf16_t* wa = sbase + woff;
    *(uint4*)(wa) = ra0; *(uint4*)(wa + 32 * 64) = ra1; *(uint4*)(wa + 64 * 64) = ra2; *(uint4*)(wa + 96 * 64) = ra3;
    *(uint4*)(wa + 8192) = rb0; *(uint4*)(wa + 8192 + 32 * 64) = rb1; *(uint4*)(wa + 8192 + 64 * 64) = rb2; *(uint4*)(wa + 8192 + 96 * 64) = rb3;
  }
  if (nk > 1) {
    ga += 64; gb += 64;
    ra0 = *(const uint4*)(ga); ra1 = *(const uint4*)(ga + sa32); ra2 = *(const uint4*)(ga + 2 * sa32); ra3 = *(const uint4*)(ga + 3 * sa32);
    rb0 = *(const uint4*)(gb); rb1 = *(const uint4*)(gb + sb32); rb2 = *(const uint4*)(gb + 2 * sb32); rb3 = *(const uint4*)(gb + 3 * sb32);
  }
  __syncthreads();
  for (int kt = 0; kt < nk; ++kt) {
    const bf16_t* cur = sbase + (kt & 1) * 16384;
    bf16x8 af[2][4], bfr[2][4];
#pragma unroll
    for (int ks = 0; ks < 2; ++ks) {
#pragma unroll
      for (int m = 0; m < 4; ++m) af[ks][m] = *(const bf16x8*)(cur + aoff + m * 16 * 64 + (((ks * 4 + fq) ^ (fr & 7)) * 8));
#pragma unroll
      for (int n = 0; n < 4; ++n) bfr[ks][n] = *(const bf16x8*)(cur + boff + n * 16 * 64 + (((ks * 4 + fq) ^ (fr & 7)) * 8));
    }
    __builtin_amdgcn_sched_barrier(0);
    {
      bf16_t* wa = sbase + ((kt + 1) & 1) * 16384 + woff;
      *(uint4*)(wa) = ra0; *(uint4*)(wa + 32 * 64) = ra1; *(uint4*)(wa + 64 * 64) = ra2; *(uint4*)(wa + 96 * 64) = ra3;
      *(uint4*)(wa + 8192) = rb0; *(uint4*)(wa + 8192 + 32 * 64) = rb1; *(uint4*)(wa + 8192 + 64 * 64) = rb2; *(uint4*)(wa + 8192 + 96 * 64) = rb3;
      const int adv = (kt + 2 < nk) ? 64 : 0;
      ga += adv; gb += adv;
      ra0 = *(const uint4*)(ga); ra1 = *(const uint4*)(ga + sa32); ra2 = *(const uint4*)(ga + 2 * sa32); ra3 = *(const uint4*)(ga + 3 * sa32);
      rb0 = *(const uint4*)(gb); rb1 = *(const uint4*)(gb + sb32); rb2 = *(const uint4*)(gb + 2 * sb32); rb3 = *(const uint4*)(gb + 3 * sb32);
    }
#pragma unroll
    for (int ks = 0; ks < 2; ++ks)
#pragma unroll
      for (int m = 0; m < 4; ++m)
#pragma unroll
        for (int n = 0; n < 4; ++n) {
          if (SWAP) acc[m][n] = __builtin_amdgcn_mfma_f32_16x16x32_bf16(bfr[ks][n], af[ks][m], acc[m][n], 0, 0, 0);
          else acc[m][n] = __builtin_amdgcn_mfma_f32_16x16x32_bf16(af[ks][m], bfr[ks][n], acc[m][n], 0, 0, 0);
        }
#pragma unroll
    for (int i = 0; i < 8; ++i) { __builtin_amdgcn_sched_group_barrier(0x008, 2, 0); __builtin_amdgcn_sched_group_barrier(0x200, 1, 0); }
#pragma unroll
    for (int i = 0; i < 8; ++i) { __builtin_amdgcn_sched_group_barrier(0x008, 2, 0); __builtin_amdgcn_sched_group_barrier(0x020, 1, 0); }
    __builtin_amdgcn_sched_barrier(0);
    if (kt + 1 < nk) __syncthreads();
  }
}
template <bool SWAP, class Epi>
__device__ __forceinline__ void gemm_tile(const bf16_t* __restrict__ A, int lda, const bf16_t* __restrict__ Bt, int ldb,
                                          int K, int m0, int n0, char* smem, const Epi& epi) {
  f32x4 acc[4][4];
  gemm_main<SWAP>(A, lda, Bt, ldb, K, m0, n0, smem, acc);
  const int tid = ltid(), lane = tid & 63, wid = tid >> 6, wr = wid >> 1, wc = wid & 1;
  const int fr = lane & 15, fq = lane >> 4;
#pragma unroll
  for (int m = 0; m < 4; ++m)
#pragma unroll
    for (int n = 0; n < 4; ++n) {
      if (SWAP) epi(m0 + wr * 64 + m * 16 + fr, n0 + wc * 64 + n * 16 + fq * 4, acc[m][n]);
      else epi(m0 + wr * 64 + m * 16 + fq * 4, n0 + wc * 64 + n * 16 + fr, acc[m][n]);
    }
}

template <int CTRL>
__device__ __forceinline__ float dpp_ror(float v) {
  return __int_as_float(__builtin_amdgcn_update_dpp(0, __float_as_int(v), CTRL, 0xF, 0xF, false));
}
constexpr size_t OFF_EDGE = 162 * MiB;
__device__ __forceinline__ void gemm_up_act_tile(const Params& p, int m0, int n0, char* smem) {
  f32x4 acc[4][4];
  gemm_main<true>((const bf16_t*)(p.ws + OFF_H), 1024, (const bf16_t*)(p.ws + OFF_WUP), 1024, 1024, m0, n0, smem, acc);
  const int tid = ltid(), lane = tid & 63, wid = tid >> 6, wr = wid >> 1, wc = wid & 1;
  const int fr = lane & 15, fq = lane >> 4;
  bf16_t* act = (bf16_t*)(p.ws + OFF_U);
  bf16_t* edge = (bf16_t*)(p.ws + OFF_EDGE);
  const int rowbase = m0 + wr * 64, wt = rowbase >> 6;
#pragma unroll
  for (int i = 0; i < 2; ++i) {
    const int cperm = n0 + wc * 64 + 32 * i;
    const int j0 = (cperm >> 5) * 16 + 4 * fq;
    const float4 wa0 = *(const float4*)(p.ffn_conv_w + j0), wa1 = *(const float4*)(p.ffn_conv_w + 5632 + j0), wa2 = *(const float4*)(p.ffn_conv_w + 11264 + j0);
    const float4 wg0 = *(const float4*)(p.ffn_conv_w + 2816 + j0), wg1 = *(const float4*)(p.ffn_conv_w + 5632 + 2816 + j0), wg2 = *(const float4*)(p.ffn_conv_w + 11264 + 2816 + j0);
    const float4 ba = *(const float4*)(p.ffn_conv_b + j0), bg = *(const float4*)(p.ffn_conv_b + 2816 + j0);
    const float w0a[4] = {wa0.x, wa0.y, wa0.z, wa0.w}, w1a[4] = {wa1.x, wa1.y, wa1.z, wa1.w}, w2a[4] = {wa2.x, wa2.y, wa2.z, wa2.w};
    const float w0g[4] = {wg0.x, wg0.y, wg0.z, wg0.w}, w1g[4] = {wg1.x, wg1.y, wg1.z, wg1.w}, w2g[4] = {wg2.x, wg2.y, wg2.z, wg2.w};
    const float bba[4] = {ba.x, ba.y, ba.z, ba.w}, bbg[4] = {bg.x, bg.y, bg.z, bg.w};
#pragma unroll
    for (int m = 0; m < 4; ++m) {
      float o[4];
#pragma unroll
      for (int e = 0; e < 4; ++e) {
        const float a = acc[m][2 * i][e], g = acc[m][2 * i + 1][e];
        const float au1 = dpp_ror<0x121>(a), gu1 = dpp_ror<0x121>(g), ad1 = dpp_ror<0x12F>(a), gd1 = dpp_ror<0x12F>(g);
        float au2 = 0.f, gu2 = 0.f, ad2 = 0.f, gd2 = 0.f;
        if (m > 0) { au2 = dpp_ror<0x121>(acc[m - 1][2 * i][e]); gu2 = dpp_ror<0x121>(acc[m - 1][2 * i + 1][e]); }
        if (m < 3) { ad2 = dpp_ror<0x12F>(acc[m + 1][2 * i][e]); gd2 = dpp_ror<0x12F>(acc[m + 1][2 * i + 1][e]); }
        const float au = fr > 0 ? au1 : au2, gu = fr > 0 ? gu1 : gu2, ad = fr < 15 ? ad1 : ad2, gd = fr < 15 ? gd1 : gd2;
        const float ca = w0a[e] * au + w1a[e] * a + w2a[e] * ad + bba[e];
        const float cgv = w0g[e] * gu + w1g[e] * g + w2g[e] * gd + bbg[e];
        o[e] = ca * __builtin_amdgcn_rcpf(1.f + __expf(-ca)) * cgv;
      }
      const int lr64 = m * 16 + fr, row = rowbase + lr64;
      if (lr64 >= 1 && lr64 <= 62) *(uint2*)(act + (size_t)row * 2816 + j0) = make_uint2(pack2(o[0], o[1]), pack2(o[2], o[3]));
      if (lr64 <= 1 || lr64 >= 62) {
        const int slot = lr64 <= 1 ? lr64 : lr64 - 60;
        bf16_t* er = edge + (size_t)(wt * 4 + slot) * 5632;
        *(uint2*)(er + j0) = make_uint2(pack2(acc[m][2 * i][0], acc[m][2 * i][1]), pack2(acc[m][2 * i][2], acc[m][2 * i][3]));
        *(uint2*)(er + 2816 + j0) = make_uint2(pack2(acc[m][2 * i + 1][0], acc[m][2 * i + 1][1]), pack2(acc[m][2 * i + 1][2], acc[m][2 * i + 1][3]));
      }
    }
  }
}

__device__ __forceinline__ void transpose_item(const float* __restrict__ W, int K, int N, bf16_t* __restrict__ WT, int tile, int ntn, char* smem, bool perm = false) {
  float* s = (float*)smem;
  const int tk = tile / ntn, tn = tile % ntn, tid = ltid();
  const int k0 = tk * 64, n0 = tn * 64;
  __syncthreads();
  {
    const int r = tid >> 4, c4 = (tid & 15) * 4;
#pragma unroll
    for (int i = 0; i < 4; ++i) {
      const int k = r + 16 * i;
      float4 v = make_float4(0.f, 0.f, 0.f, 0.f);
      if (n0 + c4 < N) v = *(const float4*)(W + (size_t)(k0 + k) * N + n0 + c4);
      s[k * 65 + c4 + 0] = v.x; s[k * 65 + c4 + 1] = v.y; s[k * 65 + c4 + 2] = v.z; s[k * 65 + c4 + 3] = v.w;
    }
  }
  __syncthreads();
  {
    const int n = tid >> 2, kc = (tid & 3) * 16;
    unsigned o[8];
#pragma unroll
    for (int i = 0; i < 8; ++i) o[i] = pack2(s[(kc + 2 * i) * 65 + n], s[(kc + 2 * i + 1) * 65 + n]);
    int nr = n0 + n;
    if (perm) { const int hf = nr >= 2816 ? 1 : 0, cc = nr - hf * 2816; nr = 32 * (cc >> 4) + 16 * hf + (cc & 15); }
    uint4* dst = (uint4*)(WT + (size_t)nr * K + k0 + kc);
    dst[0] = make_uint4(o[0], o[1], o[2], o[3]);
    dst[1] = make_uint4(o[4], o[5], o[6], o[7]);
  }
}

__device__ __forceinline__ void mod_item(const Params& p, int item, char* smem) {
  float* s = (float*)smem;
  float* red = s + 3072;
  const int tid = ltid();
  __syncthreads();
  for (int e = tid; e < 3072; e += 256) {
    const int v = e >> 10, k = e & 1023;
    const float x = (v == 0) ? p.c_ctx[k] : p.c[(v - 1) * D + k];
    s[e] = x / (1.f + __expf(-x));
  }
  __syncthreads();
  const int jl = tid & 63, kq = tid >> 6, j = item * 64 + jl, k0 = kq * 256;
  float a0 = 0.f, a1 = 0.f, a2 = 0.f;
#pragma unroll 8
  for (int k = 0; k < 256; ++k) {
    const float w = p.w_ada[(size_t)(k0 + k) * 6144 + j];
    a0 += s[k0 + k] * w; a1 += s[1024 + k0 + k] * w; a2 += s[2048 + k0 + k] * w;
  }
  red[(kq * 3 + 0) * 64 + jl] = a0; red[(kq * 3 + 1) * 64 + jl] = a1; red[(kq * 3 + 2) * 64 + jl] = a2;
  __syncthreads();
  if (tid < 192) {
    const int v = tid >> 6;
    const float r = red[(0 * 3 + v) * 64 + jl] + red[(1 * 3 + v) * 64 + jl] + red[(2 * 3 + v) * 64 + jl] + red[(3 * 3 + v) * 64 + jl];
    ((float*)(p.ws + OFF_MOD))[v * 6144 + j] = r + p.b_ada[j];
  }
}

__device__ __forceinline__ void filter_item(const Params& p, int item, char* smem) {
  int n, p0; bf16_t* R;
  if (item < 256) { n = 4096; p0 = item * 16; R = (bf16_t*)(p.ws + OFF_RLAT); }
  else { n = 256; p0 = (item - 256) * 16; R = (bf16_t*)(p.ws + OFF_RCTX); }
  const int n2 = 2 * n, tid = ltid();
  float* z = (float*)smem;
  float* h1 = z + 16 * 36;
  float* h2 = h1 + 16 * 64;
  __syncthreads();
#pragma unroll 1
  for (int e = tid; e < 16 * 33; e += 256) {
    const int pp = e / 33, f = e % 33, pos = p0 + pp;
    float val;
    if (f == 0) val = (float)pos / (float)(n - 1);
    else {
      const int k = (f - 1) & 15;
      const float band = 1e-4f + (float)k * ((15.f - 1e-4f) / 15.f);
      const float turns = band * ((float)pos / (float)n);
      val = (f <= 16) ? cos_turns(turns) : -sin_turns(turns);
    }
    z[pp * 36 + f] = val;
  }
  __syncthreads();
#pragma unroll 1
  for (int e = tid; e < 1024; e += 256) {
    const int pp = e >> 6, j = e & 63;
    float a = p.filt_b1[j];
#pragma unroll 3
    for (int f = 0; f < 33; ++f) a += z[pp * 36 + f] * p.filt_w1[f * 64 + j];
    h1[e] = sin_rad(p.filt_freq1[j] * a);
  }
  __syncthreads();
#pragma unroll 1
  for (int e = tid; e < 1024; e += 256) {
    const int pp = e >> 6, j = e & 63;
    float a = p.filt_b2[j];
#pragma unroll 4
    for (int k = 0; k < 64; ++k) a += h1[pp * 64 + k] * p.filt_w2[k * 64 + j];
    h2[j * 16 + pp] = sin_rad(p.filt_freq2[j] * a);
  }
  __syncthreads();
  const float mind = -3.0701134573253946f, maxd = -15.350567286626973f;
#pragma unroll 1
  for (int ci = 0; ci < 8; ++ci) {
    const int col = tid + 256 * ci, o = col >> 10, dir = (col >> 9) & 1, c = col & 511;
    float acc[16];
#pragma unroll
    for (int i = 0; i < 16; ++i) acc[i] = 0.f;
#pragma unroll 4
    for (int k = 0; k < 64; ++k) {
      const float w = p.filt_w3[k * 2048 + col];
      const float4 ha = *(const float4*)(h2 + k * 16), hb = *(const float4*)(h2 + k * 16 + 4), hc = *(const float4*)(h2 + k * 16 + 8), hd = *(const float4*)(h2 + k * 16 + 12);
      acc[0] += ha.x * w; acc[1] += ha.y * w; acc[2] += ha.z * w; acc[3] += ha.w * w;
      acc[4] += hb.x * w; acc[5] += hb.y * w; acc[6] += hb.z * w; acc[7] += hb.w * w;
      acc[8] += hc.x * w; acc[9] += hc.y * w; acc[10] += hc.z * w; acc[11] += hc.w * w;
      acc[12] += hd.x * w; acc[13] += hd.y * w; acc[14] += hd.z * w; acc[15] += hd.w * w;
    }
    const float delta = fabsf(mind + (float)c * ((maxd - mind) / 511.f));
    bf16_t* Rrow = R + (size_t)(o * 512 + c) * n2;
#pragma unroll
    for (int i = 0; i < 16; ++i) {
      const int pos = p0 + i;
      const float t = (float)pos / (float)(n - 1);
      float val = acc[i] * (__expf(-t * delta) + 0.05f);
      int idx = dir == 0 ? (n - 1 - pos) : (n - 1 + pos);
      if (dir == 1 && pos == 0) { idx = n2 - 1; val = 0.f; }
      Rrow[idx] = f2bf(val);
    }
  }
}

__device__ __forceinline__ void cache_item(const Params& p, int item) {
  const int tid = ltid(), r0 = item * 32;
  bf16_t* ckvn = (bf16_t*)(p.ws + OFF_CKVN);
#pragma unroll 2
  for (int e = tid; e < 32 * 64; e += 256) {
    const int r = r0 + (e >> 6), c4 = (e & 63) * 4;
    const float4 v = *(const float4*)(p.cache_ckv + (size_t)r * 256 + c4);
    *(uint2*)(ckvn + (size_t)(NTOK + r) * 256 + c4) = make_uint2(pack2(v.x, v.y), pack2(v.z, v.w));
  }
}

template <int WHICH>
__device__ __forceinline__ void rmsmod_phase(const Params& p) {
  const int tid = ltid(), lane = tid & 63, wid = tid >> 6;
  const int gw = blockIdx.x * 4 + wid, tw = gridDim.x * 4;
  const float* g = WHICH == 0 ? p.g_mix : p.g_ffn;
  const float* mod = (const float*)(p.ws + OFF_MOD);
  bf16_t* h = (bf16_t*)(p.ws + OFF_H);
  float4 nv0, nv1, nv2, nv3;
  {
    const float* src = WHICH == 0 ? xrow(p, gw) : p.out + (size_t)gw * D;
    nv0 = ((const float4*)src)[lane]; nv1 = ((const float4*)src)[lane + 64]; nv2 = ((const float4*)src)[lane + 128]; nv3 = ((const float4*)src)[lane + 192];
  }
  for (int row = gw; row < NTOK; row += tw) {
    float4 v[4] = {nv0, nv1, nv2, nv3};
    if (row + tw < NTOK) {
      const float* src = WHICH == 0 ? xrow(p, row + tw) : p.out + (size_t)(row + tw) * D;
      nv0 = ((const float4*)src)[lane]; nv1 = ((const float4*)src)[lane + 64]; nv2 = ((const float4*)src)[lane + 128]; nv3 = ((const float4*)src)[lane + 192];
    }
    float ss = 0.f;
#pragma unroll
    for (int i = 0; i < 4; ++i) ss += v[i].x * v[i].x + v[i].y * v[i].y + v[i].z * v[i].z + v[i].w * v[i].w;
    ss = wave_sum(ss);
    const float r = rsqrtf(ss * (1.f / 1024.f) + 1e-6f);
    const float* mv = mod + modidx(row) * 6144 + (WHICH == 0 ? 0 : 3 * 1024);
#pragma unroll
    for (int i = 0; i < 4; ++i) {
      const int e = 4 * (lane + 64 * i);
      const float4 g4 = *(const float4*)(g + e), sh = *(const float4*)(mv + e), sc = *(const float4*)(mv + 1024 + e);
      const float y0 = v[i].x * r * g4.x * (1.f + sc.x) + sh.x, y1 = v[i].y * r * g4.y * (1.f + sc.y) + sh.y;
      const float y2 = v[i].z * r * g4.z * (1.f + sc.z) + sh.z, y3 = v[i].w * r * g4.w * (1.f + sc.w) + sh.w;
      *(uint2*)(h + (size_t)row * D + e) = make_uint2(pack2(y0, y1), pack2(y2, y3));
    }
  }
}

struct EpiIn {
  float* proj; bf16_t* hyT;
  __device__ __forceinline__ void operator()(int row0, int col, const f32x4& v) const {
    if (col < 672) {
#pragma unroll
      for (int j = 0; j < 4; ++j) proj[(size_t)(row0 + j) * 672 + col] = v[j];
    } else if (col < DIN) {
      *(uint2*)(hyT + (size_t)(col - 672) * NTOK + row0) = make_uint2(pack2(v[0], v[1]), pack2(v[2], v[3]));
    }
  }
};
struct EpiProj {
  float* proj;
  __device__ __forceinline__ void operator()(int row, int col0, const f32x4& v) const { *(f32x4*)(proj + (size_t)row * 672 + col0) = v; }
};
struct EpiQ {
  bf16_t* q;
  __device__ __forceinline__ void operator()(int row, int col0, const f32x4& v) const {
    *(uint2*)(q + (size_t)row * 768 + col0) = make_uint2(pack2(v[0], v[1]), pack2(v[2], v[3]));
  }
};
struct EpiKV {
  bf16_t *kraw, *vtc, *vtl;
  __device__ __forceinline__ void operator()(int row0, int col, const f32x4& v) const {
    const int head = col >> 7, cc = col & 127;
    if (cc < 64) {
#pragma unroll
      for (int j = 0; j < 4; ++j) kraw[(size_t)(row0 + j) * 512 + head * 64 + cc] = f2bf(v[j]);
    } else {
      const int dv = cc - 64;
      bf16_t* dst;
      if (row0 < NCTX) dst = vtc + ((size_t)((row0 >> 8) * 8 + head) * 64 + dv) * 256 + (row0 & 255);
      else if (row0 < NTOK) { const int r = row0 - NCTX; dst = vtl + ((size_t)((r >> 12) * 8 + head) * 64 + dv) * 4608 + (r & 4095); }
      else { const int r = row0 - NTOK; dst = vtl + ((size_t)((r >> 9) * 8 + head) * 64 + dv) * 4608 + 4096 + (r & 511); }
      *(uint2*)dst = make_uint2(pack2(v[0], v[1]), pack2(v[2], v[3]));
    }
  }
};
struct EpiOut {
  const Params* p;
  __device__ __forceinline__ void operator()(int row, int col0, const f32x4& v) const {
    const float4 x = *(const float4*)(xrow(*p, row) + col0);
    const float4 m = *(const float4*)((const float*)(p->ws + OFF_MOD) + modidx(row) * 6144 + 2 * 1024 + col0);
    *(float4*)(p->out + (size_t)row * D + col0) = make_float4(x.x + m.x * v[0], x.y + m.y * v[1], x.z + m.z * v[2], x.w + m.w * v[3]);
  }
};
struct EpiU {
  bf16_t* u;
  __device__ __forceinline__ void operator()(int row, int col0, const f32x4& v) const {
    *(uint2*)(u + (size_t)row * 5632 + col0) = make_uint2(pack2(v[0], v[1]), pack2(v[2], v[3]));
  }
};
struct EpiY {
  const Params* p; int half;
  __device__ __forceinline__ void operator()(int row, int col0, const f32x4& v) const {
    const int grow = half * 8192 + row;
    float4* dst = (float4*)(p->out + (size_t)grow * D + col0);
    const float4 x = *dst;
    const float4 m = *(const float4*)((const float*)(p->ws + OFF_MOD) + modidx(grow) * 6144 + 5 * 1024 + col0);
    *dst = make_float4(x.x + m.x * v[0], x.y + m.y * v[1], x.z + m.z * v[2], x.w + m.w * v[3]);
  }
};

__device__ __forceinline__ void token_item(const Params& p, int item) {
  const int tid = ltid(), lane = tid & 63, wid = tid >> 6;
  const float* proj = (const float*)(p.ws + OFF_PROJ);
  bf16_t* qa = (bf16_t*)(p.ws + OFF_QA);
  bf16_t* ckvn = (bf16_t*)(p.ws + OFF_CKVN);
  float* kpe = (float*)(p.ws + OFF_KPE);
  for (int tt = 0; tt < 8; ++tt) {
    const int token = item * 32 + wid * 8 + tt;
    const float* pr = proj + (size_t)token * 672;
    float2 q[3];
    float ss = 0.f;
#pragma unroll
    for (int i = 0; i < 3; ++i) { q[i] = *(const float2*)(pr + lane * 2 + 128 * i); ss += q[i].x * q[i].x + q[i].y * q[i].y; }
    ss = wave_sum(ss);
    const float r = rsqrtf(ss * (1.f / 384.f) + 1e-6f);
#pragma unroll
    for (int i = 0; i < 3; ++i) {
      const int e = lane * 2 + 128 * i;
      *(unsigned*)(qa + (size_t)token * 384 + e) = pack2(q[i].x * r * p.g_qa[e], q[i].y * r * p.g_qa[e + 1]);
    }
    const float4 kv = *(const float4*)(pr + 384 + lane * 4);
    float s2 = wave_sum(kv.x * kv.x + kv.y * kv.y + kv.z * kv.z + kv.w * kv.w);
    const float r2 = rsqrtf(s2 * (1.f / 256.f) + 1e-6f);
    const float4 g = *(const float4*)(p.g_kva + lane * 4);
    const float4 y = make_float4(kv.x * r2 * g.x, kv.y * r2 * g.y, kv.z * r2 * g.z, kv.w * r2 * g.w);
    *(uint2*)(ckvn + (size_t)token * 256 + lane * 4) = make_uint2(pack2(y.x, y.y), pack2(y.z, y.w));
    if (token < NCTX) *(float4*)(p.out + OUT_CKV + (size_t)token * 256 + lane * 4) = y;
    if (lane < 32) {
      const float kp = pr[640 + lane];
      kpe[(size_t)token * 32 + lane] = kp;
      if (token < NCTX) p.out[OUT_KPE + (size_t)token * 32 + lane] = kp;
    }
  }
}

template <int ORDER>
__device__ __forceinline__ void hyena_item(const Params& p, int grp, int c, char* smem) {
  const int tid = ltid(), lane = tid & 63, wid = tid >> 6, fr = lane & 15, fq = lane >> 4;
  const int n = grp ? SEQL : SEQC, nb = n >> 6, L = n;
  const bf16_t* Rrow = (const bf16_t*)(p.ws + (grp ? OFF_RLAT : OFF_RCTX)) + (size_t)(ORDER * 512 + c) * (2 * n);
  const bf16_t* hyT = (const bf16_t*)(p.ws + OFF_HYT);
  bf16_t* sU = (bf16_t*)smem;
  unsigned* sR0 = (unsigned*)(smem + 18432);
  unsigned* sR1 = (unsigned*)(smem + 18432 + 16384);
  const int tok0 = grp * 8192;
  __syncthreads();
  for (int ch = tid; ch < (2 * n) / 8; ch += 256) *(uint4*)((bf16_t*)sR0 + ch * 8) = *(const uint4*)(Rrow + ch * 8);
  if (ORDER == 0) {
    const bf16_t* raw = hyT + (size_t)c * NTOK + tok0;
    const float w0 = p.hy_conv_w[c], w1 = p.hy_conv_w[1536 + c], w2 = p.hy_conv_w[3072 + c], b = p.hy_conv_b[c];
    for (int ch = tid; ch < 1024; ch += 256) {
      const int t = ch * 8, pos = t & (L - 1);
      const uint4 rv = *(const uint4*)(raw + t);
      float x[10];
      x[0] = pos == 0 ? 0.f : bf2f(raw[t - 1]);
      x[1] = bflo(rv.x); x[2] = bfhi(rv.x); x[3] = bflo(rv.y); x[4] = bfhi(rv.y);
      x[5] = bflo(rv.z); x[6] = bfhi(rv.z); x[7] = bflo(rv.w); x[8] = bfhi(rv.w);
      x[9] = (pos + 8 == L) ? 0.f : bf2f(raw[t + 8]);
      float u[8];
#pragma unroll
      for (int i = 0; i < 8; ++i) u[i] = w0 * x[i] + w1 * x[i + 1] + w2 * x[i + 2] + b;
      *(uint4*)(sU + (ch >> 3) * 64 + (((ch & 7) ^ ((ch >> 3) & 7)) * 8)) = make_uint4(pack2(u[0], u[1]), pack2(u[2], u[3]), pack2(u[4], u[5]), pack2(u[6], u[7]));
    }
  } else {
    const bf16_t* zr = (const bf16_t*)(p.ws + OFF_ZT) + (size_t)c * NTOK + tok0;
    for (int ch = tid; ch < 1024; ch += 256) *(uint4*)(sU + (ch >> 3) * 64 + (((ch & 7) ^ ((ch >> 3) & 7)) * 8)) = *(const uint4*)(zr + ch * 8);
  }
  __syncthreads();
  for (int k = tid; k < n; k += 256) {
    const unsigned a = sR0[k], b2 = (k + 1 < n) ? sR0[k + 1] : 0u;
    sR1[k] = (a >> 16) | (b2 << 16);
  }
  __syncthreads();

  f32x4 acc[4][2];
#pragma unroll
  for (int m = 0; m < 4; ++m) { acc[m][0] = (f32x4){0.f, 0.f, 0.f, 0.f}; acc[m][1] = (f32x4){0.f, 0.f, 0.f, 0.f}; }
  const unsigned* abase = (fr & 1) ? (sR0 + ((n - 1 - fr) >> 1) + 4 * fq) : (sR1 + ((n - 2 - fr) >> 1) + 4 * fq);
  const int col0 = 32 * wid + fr, col1 = col0 + 16;
  const int i0 = col0 & (nb - 1), i1 = col1 & (nb - 1);
  for (int d = -(nb - 1); d <= nb - 1; ++d) {
    const bool v0 = (unsigned)(i0 - d) < (unsigned)nb, v1 = (unsigned)(i1 - d) < (unsigned)nb;
    const bool any0 = __ballot(v0) != 0ull, any1 = __ballot(v1) != 0ull;
    if (!any0 && !any1) continue;
    bf16x8 F[6];
    const unsigned* ap = abase - 32 * d + 16;
#pragma unroll
    for (int idx = 0; idx < 6; ++idx) {
      const unsigned* q = ap - 8 * idx;
      union { unsigned u[4]; bf16x8 v; } cv;
      cv.u[0] = q[0]; cv.u[1] = q[1]; cv.u[2] = q[2]; cv.u[3] = q[3];
      F[idx] = cv.v;
    }
#pragma unroll
    for (int nt = 0; nt < 2; ++nt) {
      if (!(nt ? any1 : any0)) continue;
      const bool vv = nt ? v1 : v0;
      const int srow = (nt ? col1 : col0) - d;
      const bf16_t* up = sU + srow * 64;
#pragma unroll
      for (int ks = 0; ks < 2; ++ks) {
        bf16x8 bf = (bf16x8){0, 0, 0, 0, 0, 0, 0, 0};
        if (vv) bf = *(const bf16x8*)(up + (((ks * 4 + fq) ^ (srow & 7)) * 8));
#pragma unroll
        for (int m = 0; m < 4; ++m)
          acc[m][nt] = __builtin_amdgcn_mfma_f32_16x16x32_bf16(F[m + 2 - 2 * ks], bf, acc[m][nt], 0, 0, 0);
      }
    }
  }
  const float skip = p.filt_bias[ORDER * 512 + c];
  const int gcol = (ORDER == 0 ? 512 : 1024) + c;
  const bf16_t* graw = hyT + (size_t)gcol * NTOK + tok0;
  const float w0 = p.hy_conv_w[gcol], w1 = p.hy_conv_w[1536 + gcol], w2 = p.hy_conv_w[3072 + gcol], b = p.hy_conv_b[gcol];
  bf16_t* outT = (bf16_t*)(p.ws + (ORDER == 0 ? OFF_ZT : OFF_Y2T)) + (size_t)c * NTOK + tok0;
#pragma unroll
  for (int nt = 0; nt < 2; ++nt) {
    const int col = nt ? col1 : col0;
#pragma unroll
    for (int m = 0; m < 4; ++m) {
      const int t = col * 64 + 16 * m + 4 * fq, pos = t & (L - 1);
      const uint2 uu = *(const uint2*)(sU + col * 64 + (((2 * m + (fq >> 1)) ^ (col & 7)) * 8) + 4 * (fq & 1));
      const uint2 gv = *(const uint2*)(graw + t);
      float x[6];
      x[0] = pos == 0 ? 0.f : bf2f(graw[t - 1]);
      x[1] = bflo(gv.x); x[2] = bfhi(gv.x); x[3] = bflo(gv.y); x[4] = bfhi(gv.y);
      x[5] = (pos + 4 == L) ? 0.f : bf2f(graw[t + 4]);
      const float u4[4] = {bflo(uu.x), bfhi(uu.x), bflo(uu.y), bfhi(uu.y)};
      float o[4];
#pragma unroll
      for (int j = 0; j < 4; ++j) {
        const float gate = w0 * x[j] + w1 * x[j + 1] + w2 * x[j + 2] + b;
        o[j] = gate * (acc[m][nt][j] + skip * u4[j]);
      }
      *(uint2*)(outT + t) = make_uint2(pack2(o[0], o[1]), pack2(o[2], o[3]));
    }
  }
}

__device__ __forceinline__ void rope32(float* y  , int pos) {
  const float prow = (float)(pos >> 6), pcol = (float)(pos & 63);
  const float fr[8] = {1.f, 0.31622776601683794f, 0.1f, 0.031622776601683794f, 0.01f, 0.0031622776601683794f, 0.001f, 0.00031622776601683794f};
#pragma unroll
  for (int i = 0; i < 8; ++i) {
    const float tr = prow * fr[i] * 0.15915494309189535f, tc = pcol * fr[i] * 0.15915494309189535f;
    const float sr = sin_turns(tr), cr = cos_turns(tr), sc = sin_turns(tc), cc = cos_turns(tc);
    const float a = y[i], b = y[8 + i], c2 = y[16 + i], d2 = y[24 + i];
    y[i] = a * cr - b * sr; y[8 + i] = b * cr + a * sr;
    y[16 + i] = c2 * cc - d2 * sc; y[24 + i] = d2 * cc + c2 * sc;
  }
}
__device__ __forceinline__ void unpack8(const uint4& v, float* x) {
  x[0] = bflo(v.x); x[1] = bfhi(v.x); x[2] = bflo(v.y); x[3] = bfhi(v.y);
  x[4] = bflo(v.z); x[5] = bfhi(v.z); x[6] = bflo(v.w); x[7] = bfhi(v.w);
}
__device__ __forceinline__ float sumsq8(const uint4& v) {
  float x[8];
  unpack8(v, x);
  return x[0] * x[0] + x[1] * x[1] + x[2] * x[2] + x[3] * x[3] + x[4] * x[4] + x[5] * x[5] + x[6] * x[6] + x[7] * x[7];
}
__device__ __forceinline__ uint4 scale8(const uint4& v, float r, const float* __restrict__ g) {
  float x[8];
  unpack8(v, x);
  const float4 g0 = *(const float4*)g, g1 = *(const float4*)(g + 4);
  return make_uint4(pack2(x[0] * r * g0.x, x[1] * r * g0.y), pack2(x[2] * r * g0.z, x[3] * r * g0.w),
                    pack2(x[4] * r * g1.x, x[5] * r * g1.y), pack2(x[6] * r * g1.z, x[7] * r * g1.w));
}
__device__ __forceinline__ void qk_item(const Params& p, int item) {
  const int tid = ltid();
  if (item < 512) {
    const int idx = item * 256 + tid, row = idx >> 3, h = idx & 7;
    const bf16_t* src = (const bf16_t*)(p.ws + OFF_QRAW) + (size_t)row * 768 + h * 96;
    bf16_t* dst = (bf16_t*)(p.ws + OFF_Q) + (size_t)row * 768 + h * 96;
    uint4 raw[12];
#pragma unroll
    for (int i = 0; i < 12; ++i) raw[i] = *(const uint4*)(src + 8 * i);
    float ss = 0.f;
#pragma unroll
    for (int i = 0; i < 12; ++i) ss += sumsq8(raw[i]);
    const float r = rsqrtf(ss * (1.f / 96.f) + 1e-6f);
    const float qs = 0.10206207261596575f * 1.4426950408889634f;
#pragma unroll
    for (int i = 0; i < 8; ++i) *(uint4*)(dst + 8 * i) = scale8(raw[i], r * qs, p.g_q + 8 * i);
    float y[32];
#pragma unroll
    for (int i = 0; i < 4; ++i) unpack8(raw[8 + i], y + 8 * i);
#pragma unroll
    for (int i = 0; i < 32; ++i) y[i] = y[i] * r * p.g_q[64 + i];
    if (row >= NCTX) rope32(y, (row - NCTX) & 4095);
#pragma unroll
    for (int i = 0; i < 4; ++i)
      *(uint4*)(dst + 64 + 8 * i) = make_uint4(pack2(y[8 * i] * qs, y[8 * i + 1] * qs), pack2(y[8 * i + 2] * qs, y[8 * i + 3] * qs),
                                               pack2(y[8 * i + 4] * qs, y[8 * i + 5] * qs), pack2(y[8 * i + 6] * qs, y[8 * i + 7] * qs));
  } else {
    const int idx = (item - 512) * 256 + tid, row = idx >> 3, h = idx & 7;
    const bf16_t* src = (const bf16_t*)(p.ws + OFF_KRAW) + (size_t)row * 512 + h * 64;
    uint4 raw[8];
#pragma unroll
    for (int i = 0; i < 8; ++i) raw[i] = *(const uint4*)(src + 8 * i);
    const float* kp = row < NTOK ? (const float*)(p.ws + OFF_KPE) + (size_t)row * 32 : p.cache_kpe + (size_t)(row - NTOK) * 32;
    float y[32];
#pragma unroll
    for (int i = 0; i < 8; ++i) {
      const float4 v = *(const float4*)(kp + 4 * i);
      y[4 * i] = v.x; y[4 * i + 1] = v.y; y[4 * i + 2] = v.z; y[4 * i + 3] = v.w;
    }
    float ss = 0.f;
#pragma unroll
    for (int i = 0; i < 8; ++i) ss += sumsq8(raw[i]);
#pragma unroll
    for (int i = 0; i < 32; ++i) ss += y[i] * y[i];
    const float r = rsqrtf(ss * (1.f / 96.f) + 1e-6f);
#pragma unroll
    for (int i = 0; i < 32; ++i) y[i] = y[i] * r * p.g_k[64 + i];
    bf16_t* dst;
    if (row < NCTX) dst = (bf16_t*)(p.ws + OFF_KC) + ((size_t)((row >> 8) * 8 + h) * 256 + (row & 255)) * 96;
    else if (row < NTOK) {
      const int rr = row - NCTX;
      rope32(y, rr & 4095);
      dst = (bf16_t*)(p.ws + OFF_KL) + ((size_t)((rr >> 12) * 8 + h) * 4608 + (rr & 4095)) * 96;
    } else {
      const int rr = row - NTOK;
      dst = (bf16_t*)(p.ws + OFF_KL) + ((size_t)((rr >> 9) * 8 + h) * 4608 + 4096 + (rr & 511)) * 96;
    }
#pragma unroll
    for (int i = 0; i < 8; ++i) *(uint4*)(dst + 8 * i) = scale8(raw[i], r, p.g_k + 8 * i);
#pragma unroll
    for (int i = 0; i < 4; ++i)
      *(uint4*)(dst + 64 + 8 * i) = make_uint4(pack2(y[8 * i], y[8 * i + 1]), pack2(y[8 * i + 2], y[8 * i + 3]),
                                               pack2(y[8 * i + 4], y[8 * i + 5]), pack2(y[8 * i + 6], y[8 * i + 7]));
  }
}

__device__ __forceinline__ void attn_item(const Params& p, int item, char* smem) {
  const int tid = ltid(), lane = tid & 63, wid = tid >> 6, lr = lane & 31, lh = lane >> 5;
  int nkeys, h, tokbase; const bf16_t *Kp, *Vp;
  if (item < 512) {
    const int b = item >> 8, rem = item & 255; h = rem >> 5; const int qb = rem & 31;
    nkeys = 4608; tokbase = NCTX + b * 4096 + qb * 128;
    Kp = (const bf16_t*)(p.ws + OFF_KL) + (size_t)(b * 8 + h) * 4608 * 96;
    Vp = (const bf16_t*)(p.ws + OFF_VTL) + (size_t)(b * 8 + h) * 64 * 4608;
  } else {
    const int it = item - 512, b = it >> 4; h = (it & 15) >> 1; const int qb = it & 1;
    nkeys = 256; tokbase = b * 256 + qb * 128;
    Kp = (const bf16_t*)(p.ws + OFF_KC) + (size_t)(b * 8 + h) * 256 * 96;
    Vp = (const bf16_t*)(p.ws + OFF_VTC) + (size_t)(b * 8 + h) * 64 * 256;
  }
  bf16_t* sK = (bf16_t*)smem;
  bf16_t* sV = sK + 64 * 104;
  const int token = tokbase + 32 * wid + lr;
  const bf16_t* qsrc = (const bf16_t*)(p.ws + OFF_Q) + (size_t)token * 768 + h * 96 + 8 * lh;
  bf16x8 qf[6];
#pragma unroll
  for (int ks = 0; ks < 6; ++ks) qf[ks] = *(const bf16x8*)(qsrc + 16 * ks);
  f32x16 oacc[2];
#pragma unroll
  for (int j = 0; j < 16; ++j) { oacc[0][j] = 0.f; oacc[1][j] = 0.f; }
  float mrun = -1e30f, lsum = 0.f;
  const int kk0 = tid / 12, kc0 = tid % 12, kk1 = (tid + 256) / 12, kc1 = (tid + 256) % 12, kk2 = (tid + 512) / 12, kc2 = (tid + 512) % 12;
  const int vd0 = tid >> 3, vc0 = tid & 7, vd1 = vd0 + 32;
  const bf16_t* gk0 = Kp + (size_t)kk0 * 96 + kc0 * 8;
  const bf16_t* gk1 = Kp + (size_t)kk1 * 96 + kc1 * 8;
  const bf16_t* gk2 = Kp + (size_t)kk2 * 96 + kc2 * 8;
  const bf16_t* gv0 = Vp + (size_t)vd0 * nkeys + vc0 * 8;
  const bf16_t* gv1 = Vp + (size_t)vd1 * nkeys + vc0 * 8;
  uint4 rk0 = *(const uint4*)gk0, rk1 = *(const uint4*)gk1, rk2 = *(const uint4*)gk2;
  uint4 rv0 = *(const uint4*)gv0, rv1 = *(const uint4*)gv1;
  const int nt = nkeys >> 6;
  for (int kt = 0; kt < nt; ++kt) {
    __syncthreads();
    *(uint4*)(sK + kk0 * 104 + kc0 * 8) = rk0; *(uint4*)(sK + kk1 * 104 + kc1 * 8) = rk1; *(uint4*)(sK + kk2 * 104 + kc2 * 8) = rk2;
    *(uint4*)(sV + vd0 * 72 + vc0 * 8) = rv0; *(uint4*)(sV + vd1 * 72 + vc0 * 8) = rv1;
    __syncthreads();
    if (kt + 1 < nt) {
      gk0 += 64 * 96; gk1 += 64 * 96; gk2 += 64 * 96; gv0 += 64; gv1 += 64;
      rk0 = *(const uint4*)gk0; rk1 = *(const uint4*)gk1; rk2 = *(const uint4*)gk2;
      rv0 = *(const uint4*)gv0; rv1 = *(const uint4*)gv1;
    }
    __builtin_amdgcn_sched_barrier(0);
    f32x16 sacc[2];
#pragma unroll
    for (int kb = 0; kb < 2; ++kb) {
#pragma unroll
      for (int j = 0; j < 16; ++j) sacc[kb][j] = 0.f;
#pragma unroll
      for (int ks = 0; ks < 6; ++ks) {
        const bf16x8 a = *(const bf16x8*)(sK + (32 * kb + lr) * 104 + 16 * ks + 8 * lh);
        sacc[kb] = __builtin_amdgcn_mfma_f32_32x32x16_bf16(a, qf[ks], sacc[kb], 0, 0, 0);
      }
    }
    float mx = sacc[0][0];
#pragma unroll
    for (int j = 1; j < 16; ++j) mx = fmaxf(mx, sacc[0][j]);
#pragma unroll
    for (int j = 0; j < 16; ++j) mx = fmaxf(mx, sacc[1][j]);
    mx = fmaxf(mx, __shfl_xor(mx, 32));
    const float mnew = fmaxf(mrun, mx);
    const float alpha = __builtin_amdgcn_exp2f(mrun - mnew);
    mrun = mnew;
    float ps = 0.f;
#pragma unroll
    for (int kb = 0; kb < 2; ++kb)
#pragma unroll
      for (int j = 0; j < 16; ++j) { const float e = __builtin_amdgcn_exp2f(sacc[kb][j] - mnew); sacc[kb][j] = e; ps += e; }
    lsum = lsum * alpha + ps;
    if (__ballot(alpha != 1.f) != 0ull) {
#pragma unroll
      for (int j = 0; j < 16; ++j) { oacc[0][j] *= alpha; oacc[1][j] *= alpha; }
    }
#pragma unroll
    for (int s = 0; s < 4; ++s) {
      const int kb = s >> 1, jb = 8 * (s & 1);
      union { unsigned u[4]; bf16x8 v; } pf;
      pf.u[0] = pack2(sacc[kb][jb + 0], sacc[kb][jb + 1]); pf.u[1] = pack2(sacc[kb][jb + 2], sacc[kb][jb + 3]);
      pf.u[2] = pack2(sacc[kb][jb + 4], sacc[kb][jb + 5]); pf.u[3] = pack2(sacc[kb][jb + 6], sacc[kb][jb + 7]);
#pragma unroll
      for (int mt = 0; mt < 2; ++mt) {
        const bf16_t* vp = sV + (32 * mt + lr) * 72 + 16 * s + 4 * lh;
        union { uint2 d[2]; bf16x8 v; } av;
        av.d[0] = *(const uint2*)vp;
        av.d[1] = *(const uint2*)(vp + 8);
        oacc[mt] = __builtin_amdgcn_mfma_f32_32x32x16_bf16(av.v, pf.v, oacc[mt], 0, 0, 0);
      }
    }
  }
  lsum += __shfl_xor(lsum, 32);
  const float inv = 1.f / lsum;
  bf16_t* dst = (bf16_t*)(p.ws + OFF_ATTN) + (size_t)token * 512 + h * 64;
#pragma unroll
  for (int mt = 0; mt < 2; ++mt)
#pragma unroll
    for (int jg = 0; jg < 4; ++jg) {
      const int dv0 = 32 * mt + 8 * jg + 4 * lh;
      *(uint2*)(dst + dv0) = make_uint2(pack2(oacc[mt][4 * jg] * inv, oacc[mt][4 * jg + 1] * inv),
                                        pack2(oacc[mt][4 * jg + 2] * inv, oacc[mt][4 * jg + 3] * inv));
    }
}

__device__ __forceinline__ void merge_item(const Params& p, int item, char* smem) {
  const int tid = ltid(), lane = tid & 63, wid = tid >> 6, t0 = item * 32;
  bf16_t* mix = (bf16_t*)(p.ws + OFF_H);
  const bf16_t* attn = (const bf16_t*)(p.ws + OFF_ATTN);
  for (int tt = 0; tt < 8; ++tt) {
    const int token = t0 + wid * 8 + tt;
    float x[8];
    unpack8(*(const uint4*)(attn + (size_t)token * 512 + lane * 8), x);
    float ss = 0.f;
#pragma unroll
    for (int i = 0; i < 8; ++i) ss += x[i] * x[i];
    ss = wave_sum(ss);
    const float r = rsqrtf(ss * (1.f / 512.f) + 1e-6f);
    const float4 g0 = *(const float4*)(p.g_out_att + lane * 8), g1 = *(const float4*)(p.g_out_att + lane * 8 + 4);
    *(uint4*)(mix + (size_t)token * D + lane * 8) =
        make_uint4(pack2(x[0] * r * g0.x, x[1] * r * g0.y), pack2(x[2] * r * g0.z, x[3] * r * g0.w),
                   pack2(x[4] * r * g1.x, x[5] * r * g1.y), pack2(x[6] * r * g1.z, x[7] * r * g1.w));
  }
  bf16_t* sT = (bf16_t*)smem;
  const bf16_t* y2T = (const bf16_t*)(p.ws + OFF_Y2T);
  __syncthreads();
  for (int ch = tid; ch < 2048; ch += 256) {
    const int c = ch >> 2, q4 = ch & 3;
    const uint4 v = *(const uint4*)(y2T + (size_t)c * NTOK + t0 + q4 * 8);
    bf16_t* d = sT + (q4 * 8) * 520 + c;
    d[0 * 520] = (bf16_t)(v.x & 0xffff); d[1 * 520] = (bf16_t)(v.x >> 16);
    d[2 * 520] = (bf16_t)(v.y & 0xffff); d[3 * 520] = (bf16_t)(v.y >> 16);
    d[4 * 520] = (bf16_t)(v.z & 0xffff); d[5 * 520] = (bf16_t)(v.z >> 16);
    d[6 * 520] = (bf16_t)(v.w & 0xffff); d[7 * 520] = (bf16_t)(v.w >> 16);
  }
  __syncthreads();
  {
    const int tt = tid >> 3, part = tid & 7;
    uint4 v[8];
    float ss = 0.f;
#pragma unroll
    for (int i = 0; i < 8; ++i) {
      v[i] = *(const uint4*)(sT + tt * 520 + part * 64 + 8 * i);
      float x[8];
      unpack8(v[i], x);
#pragma unroll
      for (int e = 0; e < 8; ++e) ss += x[e] * x[e];
    }
    ss += __shfl_xor(ss, 1); ss += __shfl_xor(ss, 2); ss += __shfl_xor(ss, 4);
    const float r = rsqrtf(ss * (1.f / 512.f) + 1e-6f);
#pragma unroll
    for (int i = 0; i < 8; ++i) {
      float x[8];
      unpack8(v[i], x);
      const int c0 = part * 64 + 8 * i;
      const float4 g0 = *(const float4*)(p.g_out_hy + c0), g1 = *(const float4*)(p.g_out_hy + c0 + 4);
      *(uint4*)(mix + (size_t)(t0 + tt) * D + 512 + c0) =
          make_uint4(pack2(x[0] * r * g0.x, x[1] * r * g0.y), pack2(x[2] * r * g0.z, x[3] * r * g0.w),
                     pack2(x[4] * r * g1.x, x[5] * r * g1.y), pack2(x[6] * r * g1.z, x[7] * r * g1.w));
    }
  }
}

__device__ __forceinline__ void actfix_item(const Params& p, int item) {
  const int idx = item * 256 + ltid();
  if (idx >= 512 * 352) return;
  const int j = (idx % 352) * 8, rowi = idx / 352, wt = rowi >> 1, which = rowi & 1;
  const int t = 64 * wt + 63 * which, L = t < NCTX ? SEQC : SEQL, pos = t & (L - 1);
  const bf16_t* edge = (const bf16_t*)(p.ws + OFF_EDGE);
  bf16_t* act = (bf16_t*)(p.ws + OFF_U);
  const bf16_t *pr, *cu, *nx;
  bool zp = false, zn = false;
  if (which == 0) { zp = pos == 0; pr = edge + (size_t)((zp ? wt : wt - 1) * 4 + 3) * 5632; cu = edge + (size_t)(wt * 4 + 0) * 5632; nx = edge + (size_t)(wt * 4 + 1) * 5632; }
  else { zn = pos == L - 1; pr = edge + (size_t)(wt * 4 + 2) * 5632; cu = edge + (size_t)(wt * 4 + 3) * 5632; nx = edge + (size_t)((zn ? wt : wt + 1) * 4 + 0) * 5632; }
  float pa[8], pg[8], ca[8], cgv[8], na[8], ng[8];
  unpack8(*(const uint4*)(pr + j), pa); unpack8(*(const uint4*)(pr + 2816 + j), pg);
  unpack8(*(const uint4*)(cu + j), ca); unpack8(*(const uint4*)(cu + 2816 + j), cgv);
  unpack8(*(const uint4*)(nx + j), na); unpack8(*(const uint4*)(nx + 2816 + j), ng);
  float o[8];
#pragma unroll
  for (int e = 0; e < 8; ++e) {
    const float pae = zp ? 0.f : pa[e], pge = zp ? 0.f : pg[e], nae = zn ? 0.f : na[e], nge = zn ? 0.f : ng[e];
    const float a = p.ffn_conv_w[j + e] * pae + p.ffn_conv_w[5632 + j + e] * ca[e] + p.ffn_conv_w[11264 + j + e] * nae + p.ffn_conv_b[j + e];
    const float g = p.ffn_conv_w[2816 + j + e] * pge + p.ffn_conv_w[5632 + 2816 + j + e] * cgv[e] + p.ffn_conv_w[11264 + 2816 + j + e] * nge + p.ffn_conv_b[2816 + j + e];
    o[e] = a * __builtin_amdgcn_rcpf(1.f + __expf(-a)) * g;
  }
  *(uint4*)(act + (size_t)t * 2816 + j) = make_uint4(pack2(o[0], o[1]), pack2(o[2], o[3]), pack2(o[4], o[5]), pack2(o[6], o[7]));
}

#define XB_TMO      128
#define XB_XCNT(j)  (256  + 64 * (j))
#define XB_XSUB(j)  (1280 + 64 * (j))
#define XB_XGEN(j)  (2304 + 64 * (j))
#define XB_TOP      3328
#define XB_TOPGEN   3392
#define XCD_BAR_WORDS 3456
#define XB_SPIN_CAP (1u << 20)
#define LAS __attribute__((address_space(3)))
__device__ __forceinline__ unsigned xb_ld(unsigned* p) { return __hip_atomic_load(p, __ATOMIC_RELAXED, __HIP_MEMORY_SCOPE_AGENT); }
__device__ __forceinline__ unsigned xb_add(unsigned* p, unsigned v) { return __hip_atomic_fetch_add(p, v, __ATOMIC_RELAXED, __HIP_MEMORY_SCOPE_AGENT); }
__device__ __forceinline__ unsigned xb_xcc_id() { return (unsigned)__builtin_amdgcn_s_getreg((3 << 11) | 20) & 0xFu; }
#define XB_SPIN(cond, bar) do { unsigned _sp = 0; while (cond) { __builtin_amdgcn_s_sleep(1); \
    if ((++_sp & 255u) == 0u) { if (xb_ld(&(bar)[XB_TMO])) break; if (_sp > XB_SPIN_CAP) { atomicAdd(&(bar)[XB_TMO], 1u); break; } } } } while (0)
struct XcdBarrier { unsigned* bar; unsigned x; volatile LAS unsigned* st; };
__device__ __forceinline__ XcdBarrier xcd_barrier_post(unsigned* bar, volatile LAS unsigned* st) {
  XcdBarrier b; b.bar = bar; b.x = xb_xcc_id(); b.st = st;
  if (threadIdx.x == 0) (void)xb_add(&bar[XB_XCNT(b.x)], 1u);
  return b;
}
__device__ __forceinline__ void xcd_barrier_complete(unsigned* bar, unsigned x, unsigned& nloc, unsigned& nx) {
  const unsigned G = gridDim.x * gridDim.y * gridDim.z;
  unsigned sum, cnt, mine, sp = 0u;
  for (;;) {
    sum = 0u; cnt = 0u; mine = 0u;
#pragma unroll
    for (unsigned j = 0; j < 16; ++j) { const unsigned c = xb_ld(&bar[XB_XCNT(j)]); sum += c; cnt += (c > 0u) ? 1u : 0u; mine = (j == x) ? c : mine; }
    if (sum == G) break;
    __builtin_amdgcn_s_sleep(1);
    if ((++sp & 255u) == 0u) { if (xb_ld(&bar[XB_TMO])) break; if (sp > XB_SPIN_CAP) { atomicAdd(&bar[XB_TMO], 1u); break; } }
  }
  nloc = mine > 0u ? mine : 1u; nx = cnt > 0u ? cnt : 1u;
}
__device__ __forceinline__ void xcd_barrier(const XcdBarrier& b) {
  asm volatile("s_waitcnt vmcnt(0)" ::: "memory");
  __syncthreads();
  if (threadIdx.x == 0) {
    unsigned* bar = b.bar;
    __builtin_amdgcn_s_waitcnt(0);
    unsigned nloc = b.st[0], nx = b.st[1];
    if (nloc == 0u) { xcd_barrier_complete(bar, b.x, nloc, nx); b.st[0] = nloc; b.st[1] = nx; }
    const unsigned old = xb_add(&bar[XB_XSUB(b.x)], 1u);
    const unsigned gen = old / nloc;
    if (old + 1u == (gen + 1u) * nloc) {
      __builtin_amdgcn_fence(__ATOMIC_RELEASE, "agent");
      asm volatile("s_waitcnt vmcnt(0)" ::: "memory");
      const unsigned og = xb_add(&bar[XB_TOP], 1u);
      const unsigned tg = og / nx;
      if (og + 1u == (tg + 1u) * nx) xb_add(&bar[XB_TOPGEN], 1u);
      else XB_SPIN(xb_ld(&bar[XB_TOPGEN]) == tg, bar);
      __builtin_amdgcn_fence(__ATOMIC_ACQUIRE, "agent");
      xb_add(&bar[XB_XGEN(b.x)], 1u);
      asm volatile("s_waitcnt vmcnt(0)" ::: "memory");
    } else {
      XB_SPIN(xb_ld(&bar[XB_XGEN(b.x)]) == gen, bar);
      __builtin_amdgcn_fence(__ATOMIC_ACQUIRE, "agent");
      asm volatile("s_waitcnt vmcnt(0)" ::: "memory");
    }
  }
  __syncthreads();
}
constexpr size_t OFF_BAR = 25 * MiB - 16384;
static_assert(OFF_MOD + 3 * 6144 * 4 <= OFF_BAR, "bar");

template <int ph>
__device__ __forceinline__ void run_phase(const Params& p, char* smem) {
  const int bid = blockIdx.x, G = gridDim.x;
  char* ws = p.ws;
  if constexpr (ph == 0) {
    for (int it = bid; it < 272 + 96 + 32 + 3080; it += G) {
      if (it < 272) filter_item(p, it, smem);
      else if (it < 368) mod_item(p, it - 272, smem);
      else if (it < 400) cache_item(p, it - 368);
      else {
        int t = it - 400;
        if (t < 576) transpose_item(p.w_in, 1024, DIN, (bf16_t*)(ws + OFF_WIN), t, 36, smem);
        else if ((t -= 576) < 72) transpose_item(p.w_uq, 384, 768, (bf16_t*)(ws + OFF_WUQ), t, 12, smem);
        else if ((t -= 72) < 64) transpose_item(p.w_ukv, 256, 1024, (bf16_t*)(ws + OFF_WUKV), t, 16, smem);
        else if ((t -= 64) < 256) transpose_item(p.w_out, 1024, 1024, (bf16_t*)(ws + OFF_WOUT), t, 16, smem);
        else if ((t -= 256) < 1408) transpose_item(p.w_up, 1024, 5632, (bf16_t*)(ws + OFF_WUP), t, 88, smem, true);
        else { t -= 1408; transpose_item(p.w_down, 2816, 1024, (bf16_t*)(ws + OFF_WDOWN), t, 16, smem); }
      }
    }
  } else if constexpr (ph == 1) {
    rmsmod_phase<0>(p);
  } else if constexpr (ph == 2) {
    EpiIn epi{(float*)(ws + OFF_PROJ), (bf16_t*)(ws + OFF_HYT)};
    EpiProj epr{(float*)(ws + OFF_PROJ)};
    for (int t = bid; t < 128 * 18; t += G) {
      const int nt = t % 18;
      if (nt < 5) gemm_tile<true>((const bf16_t*)(ws + OFF_H), 1024, (const bf16_t*)(ws + OFF_WIN), 1024, 1024, (t / 18) * 128, nt * 128, smem, epr);
      else gemm_tile<false>((const bf16_t*)(ws + OFF_H), 1024, (const bf16_t*)(ws + OFF_WIN), 1024, 1024, (t / 18) * 128, nt * 128, smem, epi);
    }
  } else if constexpr (ph == 3) {
    for (int it = bid; it < 512; it += G) hyena_item<0>(p, 1, it, smem);
    for (int it = bid; it < 512; it += G) hyena_item<0>(p, 0, it, smem);
    for (int it = G - 1 - bid; it < 512; it += G) token_item(p, it);
  } else if constexpr (ph == 4) {
    EpiQ eq{(bf16_t*)(ws + OFF_QRAW)};
    EpiKV ekv{(bf16_t*)(ws + OFF_KRAW), (bf16_t*)(ws + OFF_VTC), (bf16_t*)(ws + OFF_VTL)};
    for (int it = bid; it < 512; it += G) hyena_item<1>(p, 1, it, smem);
    for (int t = bid; t < 768; t += G) gemm_tile<true>((const bf16_t*)(ws + OFF_QA), 384, (const bf16_t*)(ws + OFF_WUQ), 384, 384, (t / 6) * 128, (t % 6) * 128, smem, eq);
    for (int t = bid; t < 1088; t += G) gemm_tile<false>((const bf16_t*)(ws + OFF_CKVN), 256, (const bf16_t*)(ws + OFF_WUKV), 256, 256, (t / 8) * 128, (t % 8) * 128, smem, ekv);
    for (int it = bid; it < 512; it += G) hyena_item<1>(p, 0, it, smem);
  } else if constexpr (ph == 5) {
    for (int it = bid; it < 512 + 544; it += G) qk_item(p, it);
  } else if constexpr (ph == 6) {
    for (int it = bid; it < 1024; it += G) attn_item(p, it, smem);
  } else if constexpr (ph == 7) {
    for (int it = bid; it < 512; it += G) merge_item(p, it, smem);
  } else if constexpr (ph == 8) {
    EpiOut epi{&p};
    for (int t = bid; t < 128 * 8; t += G)
      gemm_tile<true>((const bf16_t*)(ws + OFF_H), 1024, (const bf16_t*)(ws + OFF_WOUT), 1024, 1024, (t / 8) * 128, (t % 8) * 128, smem, epi);
  } else if constexpr (ph == 9) {
    rmsmod_phase<1>(p);
  } else if constexpr (ph == 10) {
    for (int t = bid; t < 128 * 44; t += G) gemm_up_act_tile(p, (t / 44) * 128, (t % 44) * 128, smem);
  } else if constexpr (ph == 11) {
    for (int it = bid; it < 704; it += G) actfix_item(p, it);
  } else if constexpr (ph == 12) {
    EpiY epi{&p, 0};
    for (int t = bid; t < 128 * 8; t += G)
      gemm_tile<true>((const bf16_t*)(ws + OFF_U), 2816, (const bf16_t*)(ws + OFF_WDOWN), 2816, 2816, (t / 8) * 128, (t % 8) * 128, smem, epi);
  }
}

#if ONE_LAUNCH
template <int PH>
__device__ __forceinline__ void run_all(const Params& p, char* smem, cg::grid_group& grid, const XcdBarrier& xb) {
  run_phase<PH>(p, smem);
  if constexpr (((DBL_MASK >> PH) & 1) != 0) { xcd_barrier(xb); run_phase<PH>(p, smem); }
  if constexpr (PH < 12) {
    xcd_barrier(xb);
    run_all<PH + 1>(p, smem, grid, xb);
  }
}
constexpr int DYN_LDS = 65536 + 64;
__global__ void __launch_bounds__(256, 2) mega_kernel(Params p) {
  extern __shared__ __attribute__((aligned(16))) char smem[];
  uint4* xb_words = (uint4*)(smem + 65536);
  cg::grid_group grid = cg::this_grid();
  if (threadIdx.x == 0) *xb_words = make_uint4(0u, 0u, 0u, 0u);
  __syncthreads();
  XcdBarrier xb = xcd_barrier_post((unsigned*)(p.ws + OFF_BAR), (volatile LAS unsigned*)xb_words);
  if (p.ws == nullptr) grid.sync();
  run_all<0>(p, smem, grid, xb);
}
#else
template <int PH>
__global__ void __launch_bounds__(256, 2) phase_kernel(Params p) {
  __shared__ __attribute__((aligned(16))) char smem[SMEM_BYTES];
  run_phase<PH>(p, smem);
}
#ifndef DBG_STOP
#define DBG_STOP 15
#endif
__global__ void dump_kernel(Params p, size_t off, int count) {
  const bf16_t* src = (const bf16_t*)(p.ws + off);
  const bf16_t* src2 = (const bf16_t*)(p.ws + DBG_OFF2);
  for (int i = blockIdx.x * 256 + threadIdx.x; i < 16777216; i += gridDim.x * 256)
    p.out[i] = i < DBG_CNT ? bf2f(src[i]) : (i - DBG_CNT < DBG_CNT2 ? bf2f(src2[i - DBG_CNT]) : 0.f);
}
template <int PH>
static void launch_all(const Params& p, hipStream_t stream) {
  phase_kernel<PH><<<512, 256, 0, stream>>>(p);
  if constexpr (PH < 12) launch_all<PH + 1>(p, stream);
}
#endif

extern "C" void kernel_launch(void* const* d_in, const int* in_sizes, int n_in, void* d_out, int out_size, void* d_ws,
                              size_t ws_size, hipStream_t stream) {
  Params p{};
  const float** pp = (const float**)&p;
  for (int i = 0; i < 34; ++i) pp[i] = (const float*)d_in[i];
  p.out = (float*)d_out;
  p.ws = (char*)d_ws;
#if ONE_LAUNCH
  (void)hipMemsetAsync((char*)d_ws + OFF_BAR, 0, XCD_BAR_WORDS * 4, stream);
  static int grid_blocks = 0;
  if (!grid_blocks) {
    int dev = 0, cus = 0, per_cu = 0;
    hipGetDevice(&dev);
    hipDeviceGetAttribute(&cus, hipDeviceAttributeMultiprocessorCount, dev);
    (void)hipFuncSetAttribute((const void*)mega_kernel, hipFuncAttributeMaxDynamicSharedMemorySize, DYN_LDS);
    (void)hipOccupancyMaxActiveBlocksPerMultiprocessor(&per_cu, mega_kernel, 256, DYN_LDS);
    if (per_cu > 2) per_cu = 2;
    grid_blocks = cus * per_cu;
  }
  void* args[] = {&p};
  hipError_t e = hipLaunchCooperativeKernel((void*)mega_kernel, dim3(grid_blocks), dim3(256), args, DYN_LDS, stream);
  if (e != hipSuccess) fprintf(stderr, "cooperative launch failed: %s (grid %d)\n", hipGetErrorString(e), grid_blocks);
#else
  launch_all<0>(p, stream);
#if DBG_STOP < 15
  dump_kernel<<<1024, 256, 0, stream>>>(p, DBG_OFF, DBG_CNT);
#endif
#endif
}
```

```cpp
#include <hip/hip_runtime.h>
#include <hip/hip_cooperative_groups.h>
#include <cstdio>
namespace cg = cooperative_groups;

#define DBG_STOP 15
#define DBG_NOHY 0
#ifndef DBL_MASK
#define DBL_MASK 0
#endif
#define DBG_OFF OFF_QRAW
#define DBG_OFF2 OFF_KRAW
#define DBG_CNT 12582912
#define DBG_CNT2 0
#ifndef ONE_LAUNCH
#define ONE_LAUNCH 1
#endif

typedef unsigned short bf16_t;
typedef short bf16x8 __attribute__((ext_vector_type(8)));
typedef float f32x4 __attribute__((ext_vector_type(4)));
typedef float f32x16 __attribute__((ext_vector_type(16)));

constexpr int D = 1024, NTOK = 16384, NCTX = 8192, SEQC = 256, SEQL = 4096;
constexpr int DIN = 2208, DINP = 2304, QL = 384, KVL = 256, DFF = 2816;
constexpr int NROWKV = 17408;
constexpr size_t MiB = 1048576;

constexpr size_t OFF_WIN = 0;
constexpr size_t OFF_WUQ = OFF_WIN + (size_t)DINP * 1024 * 2;
constexpr size_t OFF_WUKV = OFF_WUQ + (size_t)768 * 384 * 2;
constexpr size_t OFF_WOUT = OFF_WUKV + (size_t)1024 * 256 * 2;
constexpr size_t OFF_WUP = OFF_WOUT + (size_t)1024 * 1024 * 2;
constexpr size_t OFF_WDOWN = OFF_WUP + (size_t)5632 * 1024 * 2;
constexpr size_t OFF_MOD = OFF_WDOWN + (size_t)1024 * 2816 * 2;
static_assert(OFF_MOD + 3 * 6144 * 4 <= 25 * MiB, "A region");
constexpr size_t OFF_RLAT = 25 * MiB;
constexpr size_t OFF_RCTX = 41 * MiB;
constexpr size_t OFF_H = 42 * MiB;
constexpr size_t OFF_ZT = 42 * MiB;
constexpr size_t OFF_QA = 58 * MiB;
constexpr size_t OFF_KPE = 70 * MiB;
constexpr size_t OFF_PROJ = 74 * MiB;
constexpr size_t OFF_QRAW = 74 * MiB;
constexpr size_t OFF_Y2T = 98 * MiB;
constexpr size_t OFF_ATTN = 116 * MiB;
constexpr size_t OFF_U = 74 * MiB;
constexpr size_t OFF_HYT = 116 * MiB;
constexpr size_t OFF_Q = 116 * MiB;
constexpr size_t OFF_KC = 140 * MiB;
constexpr size_t OFF_KL = 152 * MiB;
constexpr size_t OFF_CKVN = 164 * MiB;
constexpr size_t OFF_KRAW = 173 * MiB;
constexpr size_t OFF_VTC = 190 * MiB;
constexpr size_t OFF_VTL = 198 * MiB;
constexpr size_t OFF_ACT = 162 * MiB;

constexpr int OUT_YS = 0;
constexpr int OUT_CKV = 16777216;
constexpr int OUT_KPE = 16777216 + 2097152;

constexpr int SMEM_BYTES = 51200;

struct Params {
  const float *x_prompt, *x_sample, *cache_ckv, *cache_kpe, *c, *c_ctx, *w_ada, *b_ada, *g_mix, *w_in, *g_qa, *w_uq,
      *g_kva, *w_ukv, *g_q, *g_k, *hy_conv_w, *hy_conv_b, *filt_w1, *filt_b1, *filt_freq1, *filt_w2, *filt_b2,
      *filt_freq2, *filt_w3, *filt_bias, *g_out_att, *g_out_hy, *w_out, *g_ffn, *w_up, *ffn_conv_w, *ffn_conv_b, *w_down;
  float* out;
  char* ws;
};

typedef __bf16 bf16x2_t __attribute__((ext_vector_type(2)));
__device__ __forceinline__ unsigned pack2(float lo, float hi) {
  bf16x2_t v;
  v[0] = (__bf16)lo;
  v[1] = (__bf16)hi;
  return __builtin_bit_cast(unsigned, v);
}
__device__ __forceinline__ float bflo(unsigned u) { return __uint_as_float(u << 16); }
__device__ __forceinline__ float bfhi(unsigned u) { return __uint_as_float(u & 0xffff0000u); }
__device__ __forceinline__ float bf2f(bf16_t h) { return __uint_as_float(((unsigned)h) << 16); }
__device__ __forceinline__ bf16_t f2bf(float f) { return (bf16_t)(pack2(f, 0.f) & 0xffffu); }
__device__ __forceinline__ float wave_sum(float v) {
#pragma unroll
  for (int o = 32; o >= 1; o >>= 1) v += __shfl_xor(v, o);
  return v;
}
__device__ __forceinline__ int ltid() { int t = threadIdx.x; asm volatile("" : "+v"(t)); return t; }
__device__ __forceinline__ float sin_turns(float t) { t -= floorf(t); return __builtin_amdgcn_sinf(t); }
__device__ __forceinline__ float cos_turns(float t) { t -= floorf(t); return __builtin_amdgcn_cosf(t); }
__device__ __forceinline__ float sin_rad(float x) { return sin_turns(x * 0.15915494309189535f); }
__device__ __forceinline__ const float* xrow(const Params& p, int row) {
  return row < NCTX ? p.x_prompt + (size_t)row * D : p.x_sample + (size_t)(row - NCTX) * D;
}
__device__ __forceinline__ int modidx(int row) { return row < NCTX ? 0 : 1 + ((row - NCTX) >> 12); }

template <bool SWAP>
__device__ __forceinline__ void gemm_main(const bf16_t* __restrict__ A, int lda, const bf16_t* __restrict__ Bt, int ldb,
                                          int K, int m0, int n0, char* smem, f32x4 (&acc)[4][4]) {
  const int tid = ltid(), lane = tid & 63, wid = tid >> 6, wr = wid >> 1, wc = wid & 1;
  const int fr = lane & 15, fq = lane >> 4;
  bf16_t* sbase = (bf16_t*)smem;
#pragma unroll
  for (int m = 0; m < 4; ++m)
#pragma unroll
    for (int n = 0; n < 4; ++n) acc[m][n] = (f32x4){0.f, 0.f, 0.f, 0.f};
  const int lr = tid >> 3, lc = (tid & 7) * 8;
  const bf16_t* ga = A + (size_t)(m0 + lr) * lda + lc;
  const bf16_t* gb = Bt + (size_t)(n0 + lr) * ldb + lc;
  const size_t sa32 = (size_t)32 * lda, sb32 = (size_t)32 * ldb;
  uint4 ra0 = *(const uint4*)(ga), ra1 = *(const uint4*)(ga + sa32), ra2 = *(const uint4*)(ga + 2 * sa32), ra3 = *(const uint4*)(ga + 3 * sa32);
  uint4 rb0 = *(const uint4*)(gb), rb1 = *(const uint4*)(gb + sb32), rb2 = *(const uint4*)(gb + 2 * sb32), rb3 = *(const uint4*)(gb + 3 * sb32);
  const int nk = K >> 6;
  const int woff = lr * 64 + (((tid & 7) ^ (lr & 7)) * 8);
  const int aoff = (wr * 64 + fr) * 64, boff = 8192 + (wc * 64 + fr) * 64;
  __syncthreads();
  {
    bf16_t* wa = sbase + woff;
    *(uint4*)(wa) = ra0; *(uint4*)(wa + 32 * 64) = ra1; *(uint4*)(wa + 64 * 64) = ra2; *(uint4*)(wa + 96 * 64) = ra3;
    *(uint4*)(wa + 8192) = rb0; *(uint4*)(wa + 8192 + 32 * 64) = rb1; *(uint4*)(wa + 8192 + 64 * 64) = rb2; *(uint4*)(wa + 8192 + 96 * 64) = rb3;
  }
  if (nk > 1) {
    ga += 64; gb += 64;
    ra0 = *(const uint4*)(ga); ra1 = *(const uint4*)(ga + sa32); ra2 = *(const uint4*)(ga + 2 * sa32); ra3 = *(const uint4*)(ga + 3 * sa32);
    rb0 = *(const uint4*)(gb); rb1 = *(const uint4*)(gb + sb32); rb2 = *(const uint4*)(gb + 2 * sb32); rb3 = *(const uint4*)(gb + 3 * sb32);
  }
  __syncthreads();
  for (int kt = 0; kt < nk; ++kt) {
    const bf16_t* cur = sbase + (kt & 1) * 16384;
    bf16x8 af[2][4], bfr[2][4];
#pragma unroll
    for (int ks = 0; ks < 2; ++ks) {
#pragma unroll
      for (int m = 0; m < 4; ++m) af[ks][m] = *(const bf16x8*)(cur + aoff + m * 16 * 64 + (((ks * 4 + fq) ^ (fr & 7)) * 8));
#pragma unroll
      for (int n = 0; n < 4; ++n) bfr[ks][n] = *(const bf16x8*)(cur + boff + n * 16 * 64 + (((ks * 4 + fq) ^ (fr & 7)) * 8));
    }
    __builtin_amdgcn_sched_barrier(0);
    {
      bf16_t* wa = sbase + ((kt + 1) & 1) * 16384 + woff;
      *(uint4*)(wa) = ra0; *(uint4*)(wa + 32 * 64) = ra1; *(uint4*)(wa + 64 * 64) = ra2; *(uint4*)(wa + 96 * 64) = ra3;
      *(uint4*)(wa + 8192) = rb0; *(uint4*)(wa + 8192 + 32 * 64) = rb1; *(uint4*)(wa + 8192 + 64 * 64) = rb2; *(uint4*)(wa + 8192 + 96 * 64) = rb3;
      const int adv = (kt + 2 < nk) ? 64 : 0;
      ga += adv; gb += adv;
      ra0 = *(const uint4*)(ga); ra1 = *(const uint4*)(ga + sa32); ra2 = *(const uint4*)(ga + 2 * sa32); ra3 = *(const uint4*)(ga + 3 * sa32);
      rb0 = *(const uint4*)(gb); rb1 = *(const uint4*)(gb + sb32); rb2 = *(const uint4*)(gb + 2 * sb32); rb3 = *(const uint4*)(gb + 3 * sb32);
    }
#pragma unroll
    for (int ks = 0; ks < 2; ++ks)
#pragma unroll
      for (int m = 0; m < 4; ++m)
#pragma unroll
        for (int n = 0; n < 4; ++n) {
          if (SWAP) acc[m][n] = __builtin_amdgcn_mfma_f32_16x16x32_bf16(bfr[ks][n], af[ks][m], acc[m][n], 0, 0, 0);
          else acc[m][n] = __builtin_amdgcn_mfma_f32_16x16x32_bf16(af[ks][m], bfr[ks][n], acc[m][n], 0, 0, 0);
        }
#pragma unroll
    for (int i = 0; i < 8; ++i) { __builtin_amdgcn_sched_group_barrier(0x008, 2, 0); __builtin_amdgcn_sched_group_barrier(0x200, 1, 0); }
#pragma unroll
    for (int i = 0; i < 8; ++i) { __builtin_amdgcn_sched_group_barrier(0x008, 2, 0); __builtin_amdgcn_sched_group_barrier(0x020, 1, 0); }
    __builtin_amdgcn_sched_barrier(0);
    if (kt + 1 < nk) __syncthreads();
  }
}
template <bool SWAP, class Epi>
__device__ __forceinline__ void gemm_tile(const bf16_t* __restrict__ A, int lda, const bf16_t* __restrict__ Bt, int ldb,
                                          int K, int m0, int n0, char* smem, const Epi& epi) {
  f32x4 acc[4][4];
  gemm_main<SWAP>(A, lda, Bt, ldb, K, m0, n0, smem, acc);
  const int tid = ltid(), lane = tid & 63, wid = tid >> 6, wr = wid >> 1, wc = wid & 1;
  const int fr = lane & 15, fq = lane >> 4;
#pragma unroll
  for (int m = 0; m < 4; ++m)
#pragma unroll
    for (int n = 0; n < 4; ++n) {
      if (SWAP) epi(m0 + wr * 64 + m * 16 + fr, n0 + wc * 64 + n * 16 + fq * 4, acc[m][n]);
      else epi(m0 + wr * 64 + m * 16 + fq * 4, n0 + wc * 64 + n * 16 + fr, acc[m][n]);
    }
}

template <int CTRL>
__device__ __forceinline__ float dpp_ror(float v) {
  return __int_as_float(__builtin_amdgcn_update_dpp(0, __float_as_int(v), CTRL, 0xF, 0xF, false));
}
constexpr size_t OFF_EDGE = 162 * MiB;
__device__ __forceinline__ void gemm_up_act_tile(const Params& p, int m0, int n0, char* smem) {
  f32x4 acc[4][4];
  gemm_main<true>((const bf16_t*)(p.ws + OFF_H), 1024, (const bf16_t*)(p.ws + OFF_WUP), 1024, 1024, m0, n0, smem, acc);
  const int tid = ltid(), lane = tid & 63, wid = tid >> 6, wr = wid >> 1, wc = wid & 1;
  const int fr = lane & 15, fq = lane >> 4;
  bf16_t* act = (bf16_t*)(p.ws + OFF_U);
  bf16_t* edge = (bf16_t*)(p.ws + OFF_EDGE);
  const int rowbase = m0 + wr * 64, wt = rowbase >> 6;
#pragma unroll
  for (int i = 0; i < 2; ++i) {
    const int cperm = n0 + wc * 64 + 32 * i;
    const int j0 = (cperm >> 5) * 16 + 4 * fq;
    const float4 wa0 = *(const float4*)(p.ffn_conv_w + j0), wa1 = *(const float4*)(p.ffn_conv_w + 5632 + j0), wa2 = *(const float4*)(p.ffn_conv_w + 11264 + j0);
    const float4 wg0 = *(const float4*)(p.ffn_conv_w + 2816 + j0), wg1 = *(const float4*)(p.ffn_conv_w + 5632 + 2816 + j0), wg2 = *(const float4*)(p.ffn_conv_w + 11264 + 2816 + j0);
    const float4 ba = *(const float4*)(p.ffn_conv_b + j0), bg = *(const float4*)(p.ffn_conv_b + 2816 + j0);
    const float w0a[4] = {wa0.x, wa0.y, wa0.z, wa0.w}, w1a[4] = {wa1.x, wa1.y, wa1.z, wa1.w}, w2a[4] = {wa2.x, wa2.y, wa2.z, wa2.w};
    const float w0g[4] = {wg0.x, wg0.y, wg0.z, wg0.w}, w1g[4] = {wg1.x, wg1.y, wg1.z, wg1.w}, w2g[4] = {wg2.x, wg2.y, wg2.z, wg2.w};
    const float bba[4] = {ba.x, ba.y, ba.z, ba.w}, bbg[4] = {bg.x, bg.y, bg.z, bg.w};
#pragma unroll
    for (int m = 0; m < 4; ++m) {
      float o[4];
#pragma unroll
      for (int e = 0; e < 4; ++e) {
        const float a = acc[m][2 * i][e], g = acc[m][2 * i + 1][e];
        const float au1 = dpp_ror<0x121>(a), gu1 = dpp_ror<0x121>(g), ad1 = dpp_ror<0x12F>(a), gd1 = dpp_ror<0x12F>(g);
        float au2 = 0.f, gu2 = 0.f, ad2 = 0.f, gd2 = 0.f;
        if (m > 0) { au2 = dpp_ror<0x121>(acc[m - 1][2 * i][e]); gu2 = dpp_ror<0x121>(acc[m - 1][2 * i + 1][e]); }
        if (m < 3) { ad2 = dpp_ror<0x12F>(acc[m + 1][2 * i][e]); gd2 = dpp_ror<0x12F>(acc[m + 1][2 * i + 1][e]); }
        const float au = fr > 0 ? au1 : au2, gu = fr > 0 ? gu1 : gu2, ad = fr < 15 ? ad1 : ad2, gd = fr < 15 ? gd1 : gd2;
        const float ca = w0a[e] * au + w1a[e] * a + w2a[e] * ad + bba[e];
        const float cgv = w0g[e] * gu + w1g[e] * g + w2g[e] * gd + bbg[e];
        o[e] = ca * __builtin_amdgcn_rcpf(1.f + __expf(-ca)) * cgv;
      }
      const int lr64 = m * 16 + fr, row = rowbase + lr64;
      if (lr64 >= 1 && lr64 <= 62) *(uint2*)(act + (size_t)row * 2816 + j0) = make_uint2(pack2(o[0], o[1]), pack2(o[2], o[3]));
      if (lr64 <= 1 || lr64 >= 62) {
        const int slot = lr64 <= 1 ? lr64 : lr64 - 60;
        bf16_t* er = edge + (size_t)(wt * 4 + slot) * 5632;
        *(uint2*)(er + j0) = make_uint2(pack2(acc[m][2 * i][0], acc[m][2 * i][1]), pack2(acc[m][2 * i][2], acc[m][2 * i][3]));
        *(uint2*)(er + 2816 + j0) = make_uint2(pack2(acc[m][2 * i + 1][0], acc[m][2 * i + 1][1]), pack2(acc[m][2 * i + 1][2], acc[m][2 * i + 1][3]));
      }
    }
  }
}

__device__ __forceinline__ void transpose_item(const float* __restrict__ W, int K, int N, bf16_t* __restrict__ WT, int tile, int ntn, char* smem, bool perm = false) {
  float* s = (float*)smem;
  const int tk = tile / ntn, tn = tile % ntn, tid = ltid();
  const int k0 = tk * 64, n0 = tn * 64;
  __syncthreads();
  {
    const int r = tid >> 4, c4 = (tid & 15) * 4;
#pragma unroll
    for (int i = 0; i < 4; ++i) {
      const int k = r + 16 * i;
      float4 v = make_float4(0.f, 0.f, 0.f, 0.f);
      if (n0 + c4 < N) v = *(const float4*)(W + (size_t)(k0 + k) * N + n0 + c4);
      s[k * 65 + c4 + 0] = v.x; s[k * 65 + c4 + 1] = v.y; s[k * 65 + c4 + 2] = v.z; s[k * 65 + c4 + 3] = v.w;
    }
  }
  __syncthreads();
  {
    const int n = tid >> 2, kc = (tid & 3) * 16;
    unsigned o[8];
#pragma unroll
    for (int i = 0; i < 8; ++i) o[i] = pack2(s[(kc + 2 * i) * 65 + n], s[(kc + 2 * i + 1) * 65 + n]);
    int nr = n0 + n;
    if (perm) { const int hf = nr >= 2816 ? 1 : 0, cc = nr - hf * 2816; nr = 32 * (cc >> 4) + 16 * hf + (cc & 15); }
    uint4* dst = (uint4*)(WT + (size_t)nr * K + k0 + kc);
    dst[0] = make_uint4(o[0], o[1], o[2], o[3]);
    dst[1] = make_uint4(o[4], o[5], o[6], o[7]);
  }
}

__device__ __forceinline__ void mod_item(const Params& p, int item, char* smem) {
  float* s = (float*)smem;
  float* red = s + 3072;
  const int tid = ltid();
  __syncthreads();
  for (int e = tid; e < 3072; e += 256) {
    const int v = e >> 10, k = e & 1023;
    const float x = (v == 0) ? p.c_ctx[k] : p.c[(v - 1) * D + k];
    s[e] = x / (1.f + __expf(-x));
  }
  __syncthreads();
  const int jl = tid & 63, kq = tid >> 6, j = item * 64 + jl, k0 = kq * 256;
  float a0 = 0.f, a1 = 0.f, a2 = 0.f;
#pragma unroll 8
  for (int k = 0; k < 256; ++k) {
    const float w = p.w_ada[(size_t)(k0 + k) * 6144 + j];
    a0 += s[k0 + k] * w; a1 += s[1024 + k0 + k] * w; a2 += s[2048 + k0 + k] * w;
  }
  red[(kq * 3 + 0) * 64 + jl] = a0; red[(kq * 3 + 1) * 64 + jl] = a1; red[(kq * 3 + 2) * 64 + jl] = a2;
  __syncthreads();
  if (tid < 192) {
    const int v = tid >> 6;
    const float r = red[(0 * 3 + v) * 64 + jl] + red[(1 * 3 + v) * 64 + jl] + red[(2 * 3 + v) * 64 + jl] + red[(3 * 3 + v) * 64 + jl];
    ((float*)(p.ws + OFF_MOD))[v * 6144 + j] = r + p.b_ada[j];
  }
}

__device__ __forceinline__ void filter_item(const Params& p, int item, char* smem) {
  int n, p0; bf16_t* R;
  if (item < 256) { n = 4096; p0 = item * 16; R = (bf16_t*)(p.ws + OFF_RLAT); }
  else { n = 256; p0 = (item - 256) * 16; R = (bf16_t*)(p.ws + OFF_RCTX); }
  const int n2 = 2 * n, tid = ltid();
  float* z = (float*)smem;
  float* h1 = z + 16 * 36;
  float* h2 = h1 + 16 * 64;
  __syncthreads();
#pragma unroll 1
  for (int e = tid; e < 16 * 33; e += 256) {
    const int pp = e / 33, f = e % 33, pos = p0 + pp;
    float val;
    if (f == 0) val = (float)pos / (float)(n - 1);
    else {
      const int k = (f - 1) & 15;
      const float band = 1e-4f + (float)k * ((15.f - 1e-4f) / 15.f);
      const float turns = band * ((float)pos / (float)n);
      val = (f <= 16) ? cos_turns(turns) : -sin_turns(turns);
    }
    z[pp * 36 + f] = val;
  }
  __syncthreads();
#pragma unroll 1
  for (int e = tid; e < 1024; e += 256) {
    const int pp = e >> 6, j = e & 63;
    float a = p.filt_b1[j];
#pragma unroll 3
    for (int f = 0; f < 33; ++f) a += z[pp * 36 + f] * p.filt_w1[f * 64 + j];
    h1[e] = sin_rad(p.filt_freq1[j] * a);
  }
  __syncthreads();
#pragma unroll 1
  for (int e = tid; e < 1024; e += 256) {
    const int pp = e >> 6, j = e & 63;
    float a = p.filt_b2[j];
#pragma unroll 4
    for (int k = 0; k < 64; ++k) a += h1[pp * 64 + k] * p.filt_w2[k * 64 + j];
    h2[j * 16 + pp] = sin_rad(p.filt_freq2[j] * a);
  }
  __syncthreads();
  const float mind = -3.0701134573253946f, maxd = -15.350567286626973f;
#pragma unroll 1
  for (int ci = 0; ci < 8; ++ci) {
    const int col = tid + 256 * ci, o = col >> 10, dir = (col >> 9) & 1, c = col & 511;
    float acc[16];
#pragma unroll
    for (int i = 0; i < 16; ++i) acc[i] = 0.f;
#pragma unroll 4
    for (int k = 0; k < 64; ++k) {
      const float w = p.filt_w3[k * 2048 + col];
      const float4 ha = *(const float4*)(h2 + k * 16), hb = *(const float4*)(h2 + k * 16 + 4), hc = *(const float4*)(h2 + k * 16 + 8), hd = *(const float4*)(h2 + k * 16 + 12);
      acc[0] += ha.x * w; acc[1] += ha.y * w; acc[2] += ha.z * w; acc[3] += ha.w * w;
      acc[4] += hb.x * w; acc[5] += hb.y * w; acc[6] += hb.z * w; acc[7] += hb.w * w;
      acc[8] += hc.x * w; acc[9] += hc.y * w; acc[10] += hc.z * w; acc[11] += hc.w * w;
      acc[12] += hd.x * w; acc[13] += hd.y * w; acc[14] += hd.z * w; acc[15] += hd.w * w;
    }
    const float delta = fabsf(mind + (float)c * ((maxd - mind) / 511.f));
    bf16_t* Rrow = R + (size_t)(o * 512 + c) * n2;
#pragma unroll
    for (int i = 0; i < 16; ++i) {
      const int pos = p0 + i;
      const float t = (float)pos / (float)(n - 1);
      float val = acc[i] * (__expf(-t * delta) + 0.05f);
      int idx = dir == 0 ? (n - 1 - pos) : (n - 1 + pos);
      if (dir == 1 && pos == 0) { idx = n2 - 1; val = 0.f; }
      Rrow[idx] = f2bf(val);
    }
  }
}

__device__ __forceinline__ void cache_item(const Params& p, int item) {
  const int tid = ltid(), r0 = item * 32;
  bf16_t* ckvn = (bf16_t*)(p.ws + OFF_CKVN);
#pragma unroll 2
  for (int e = tid; e < 32 * 64; e += 256) {
    const int r = r0 + (e >> 6), c4 = (e & 63) * 4;
    const float4 v = *(const float4*)(p.cache_ckv + (size_t)r * 256 + c4);
    *(uint2*)(ckvn + (size_t)(NTOK + r) * 256 + c4) = make_uint2(pack2(v.x, v.y), pack2(v.z, v.w));
  }
}

template <int WHICH>
__device__ __forceinline__ void rmsmod_phase(const Params& p) {
  const int tid = ltid(), lane = tid & 63, wid = tid >> 6;
  const int gw = blockIdx.x * 4 + wid, tw = gridDim.x * 4;
  const float* g = WHICH == 0 ? p.g_mix : p.g_ffn;
  const float* mod = (const float*)(p.ws + OFF_MOD);
  bf16_t* h = (bf16_t*)(p.ws + OFF_H);
  float4 nv0, nv1, nv2, nv3;
  {
    const float* src = WHICH == 0 ? xrow(p, gw) : p.out + (size_t)gw * D;
    nv0 = ((const float4*)src)[lane]; nv1 = ((const float4*)src)[lane + 64]; nv2 = ((const float4*)src)[lane + 128]; nv3 = ((const float4*)src)[lane + 192];
  }
  for (int row = gw; row < NTOK; row += tw) {
    float4 v[4] = {nv0, nv1, nv2, nv3};
    if (row + tw < NTOK) {
      const float* src = WHICH == 0 ? xrow(p, row + tw) : p.out + (size_t)(row + tw) * D;
      nv0 = ((const float4*)src)[lane]; nv1 = ((const float4*)src)[lane + 64]; nv2 = ((const float4*)src)[lane + 128]; nv3 = ((const float4*)src)[lane + 192];
    }
    float ss = 0.f;
#pragma unroll
    for (int i = 0; i < 4; ++i) ss += v[i].x * v[i].x + v[i].y * v[i].y + v[i].z * v[i].z + v[i].w * v[i].w;
    ss = wave_sum(ss);
    const float r = rsqrtf(ss * (1.f / 1024.f) + 1e-6f);
    const float* mv = mod + modidx(row) * 6144 + (WHICH == 0 ? 0 : 3 * 1024);
#pragma unroll
    for (int i = 0; i < 4; ++i) {
      const int e = 4 * (lane + 64 * i);
      const float4 g4 = *(const float4*)(g + e), sh = *(const float4*)(mv + e), sc = *(const float4*)(mv + 1024 + e);
      const float y0 = v[i].x * r * g4.x * (1.f + sc.x) + sh.x, y1 = v[i].y * r * g4.y * (1.f + sc.y) + sh.y;
      const float y2 = v[i].z * r * g4.z * (1.f + sc.z) + sh.z, y3 = v[i].w * r * g4.w * (1.f + sc.w) + sh.w;
      *(uint2*)(h + (size_t)row * D + e) = make_uint2(pack2(y0, y1), pack2(y2, y3));
    }
  }
}

struct EpiIn {
  float* proj; bf16_t* hyT;
  __device__ __forceinline__ void operator()(int row0, int col, const f32x4& v) const {
    if (col < 672) {
#pragma unroll
      for (int j = 0; j < 4; ++j) proj[(size_t)(row0 + j) * 672 + col] = v[j];
    } else if (col < DIN) {
      *(uint2*)(hyT + (size_t)(col - 672) * NTOK + row0) = make_uint2(pack2(v[0], v[1]), pack2(v[2], v[3]));
    }
  }
};
struct EpiProj {
  float* proj;
  __device__ __forceinline__ void operator()(int row, int col0, const f32x4& v) const { *(f32x4*)(proj + (size_t)row * 672 + col0) = v; }
};
struct EpiQ {
  bf16_t* q;
  __device__ __forceinline__ void operator()(int row, int col0, const f32x4& v) const {
    *(uint2*)(q + (size_t)row * 768 + col0) = make_uint2(pack2(v[0], v[1]), pack2(v[2], v[3]));
  }
};
struct EpiKV {
  bf16_t *kraw, *vtc, *vtl;
  __device__ __forceinline__ void operator()(int row0, int col, const f32x4& v) const {
    const int head = col >> 7, cc = col & 127;
    if (cc < 64) {
#pragma unroll
      for (int j = 0; j < 4; ++j) kraw[(size_t)(row0 + j) * 512 + head * 64 + cc] = f2bf(v[j]);
    } else {
      const int dv = cc - 64;
      bf16_t* dst;
      if (row0 < NCTX) dst = vtc + ((size_t)((row0 >> 8) * 8 + head) * 64 + dv) * 256 + (row0 & 255);
      else if (row0 < NTOK) { const int r = row0 - NCTX; dst = vtl + ((size_t)((r >> 12) * 8 + head) * 64 + dv) * 4608 + (r & 4095); }
      else { const int r = row0 - NTOK; dst = vtl + ((size_t)((r >> 9) * 8 + head) * 64 + dv) * 4608 + 4096 + (r & 511); }
      *(uint2*)dst = make_uint2(pack2(v[0], v[1]), pack2(v[2], v[3]));
    }
  }
};
struct EpiOut {
  const Params* p;
  __device__ __forceinline__ void operator()(int row, int col0, const f32x4& v) const {
    const float4 x = *(const float4*)(xrow(*p, row) + col0);
    const float4 m = *(const float4*)((const float*)(p->ws + OFF_MOD) + modidx(row) * 6144 + 2 * 1024 + col0);
    *(float4*)(p->out + (size_t)row * D + col0) = make_float4(x.x + m.x * v[0], x.y + m.y * v[1], x.z + m.z * v[2], x.w + m.w * v[3]);
  }
};
struct EpiU {
  bf16_t* u;
  __device__ __forceinline__ void operator()(int row, int col0, const f32x4& v) const {
    *(uint2*)(u + (size_t)row * 5632 + col0) = make_uint2(pack2(v[0], v[1]), pack2(v[2], v[3]));
  }
};
struct EpiY {
  const Params* p; int half;
  __device__ __forceinline__ void operator()(int row, int col0, const f32x4& v) const {
    const int grow = half * 8192 + row;
    float4* dst = (float4*)(p->out + (size_t)grow * D + col0);
    const float4 x = *dst;
    const float4 m = *(const float4*)((const float*)(p->ws + OFF_MOD) + modidx(grow) * 6144 + 5 * 1024 + col0);
    *dst = make_float4(x.x + m.x * v[0], x.y + m.y * v[1], x.z + m.z * v[2], x.w + m.w * v[3]);
  }
};

__device__ __forceinline__ void token_item(const Params& p, int item) {
  const int tid = ltid(), lane = tid & 63, wid = tid >> 6;
  const float* proj = (const float*)(p.ws + OFF_PROJ);
  bf16_t* qa = (bf16_t*)(p.ws + OFF_QA);
  bf16_t* ckvn = (bf16_t*)(p.ws + OFF_CKVN);
  float* kpe = (float*)(p.ws + OFF_KPE);
  for (int tt = 0; tt < 8; ++tt) {
    const int token = item * 32 + wid * 8 + tt;
    const float* pr = proj + (size_t)token * 672;
    float2 q[3];
    float ss = 0.f;
#pragma unroll
    for (int i = 0; i < 3; ++i) { q[i] = *(const float2*)(pr + lane * 2 + 128 * i); ss += q[i].x * q[i].x + q[i].y * q[i].y; }
    ss = wave_sum(ss);
    const float r = rsqrtf(ss * (1.f / 384.f) + 1e-6f);
#pragma unroll
    for (int i = 0; i < 3; ++i) {
      const int e = lane * 2 + 128 * i;
      *(unsigned*)(qa + (size_t)token * 384 + e) = pack2(q[i].x * r * p.g_qa[e], q[i].y * r * p.g_qa[e + 1]);
    }
    const float4 kv = *(const float4*)(pr + 384 + lane * 4);
    float s2 = wave_sum(kv.x * kv.x + kv.y * kv.y + kv.z * kv.z + kv.w * kv.w);
    const float r2 = rsqrtf(s2 * (1.f / 256.f) + 1e-6f);
    const float4 g = *(const float4*)(p.g_kva + lane * 4);
    const float4 y = make_float4(kv.x * r2 * g.x, kv.y * r2 * g.y, kv.z * r2 * g.z, kv.w * r2 * g.w);
    *(uint2*)(ckvn + (size_t)token * 256 + lane * 4) = make_uint2(pack2(y.x, y.y), pack2(y.z, y.w));
    if (token < NCTX) *(float4*)(p.out + OUT_CKV + (size_t)token * 256 + lane * 4) = y;
    if (lane < 32) {
      const float kp = pr[640 + lane];
      kpe[(size_t)token * 32 + lane] = kp;
      if (token < NCTX) p.out[OUT_KPE + (size_t)token * 32 + lane] = kp;
    }
  }
}

template <int ORDER>
__device__ __forceinline__ void hyena_item(const Params& p, int grp, int c, char* smem) {
  const int tid = ltid(), lane = tid & 63, wid = tid >> 6, fr = lane & 15, fq = lane >> 4;
  const int n = grp ? SEQL : SEQC, nb = n >> 6, L = n;
  const bf16_t* Rrow = (const bf16_t*)(p.ws + (grp ? OFF_RLAT : OFF_RCTX)) + (size_t)(ORDER * 512 + c) * (2 * n);
  const bf16_t* hyT = (const bf16_t*)(p.ws + OFF_HYT);
  bf16_t* sU = (bf16_t*)smem;
  unsigned* sR0 = (unsigned*)(smem + 18432);
  unsigned* sR1 = (unsigned*)(smem + 18432 + 16384);
  const int tok0 = grp * 8192;
  __syncthreads();
  for (int ch = tid; ch < (2 * n) / 8; ch += 256) *(uint4*)((bf16_t*)sR0 + ch * 8) = *(const uint4*)(Rrow + ch * 8);
  if (ORDER == 0) {
    const bf16_t* raw = hyT + (size_t)c * NTOK + tok0;
    const float w0 = p.hy_conv_w[c], w1 = p.hy_conv_w[1536 + c], w2 = p.hy_conv_w[3072 + c], b = p.hy_conv_b[c];
    for (int ch = tid; ch < 1024; ch += 256) {
      const int t = ch * 8, pos = t & (L - 1);
      const uint4 rv = *(const uint4*)(raw + t);
      float x[10];
      x[0] = pos == 0 ? 0.f : bf2f(raw[t - 1]);
      x[1] = bflo(rv.x); x[2] = bfhi(rv.x); x[3] = bflo(rv.y); x[4] = bfhi(rv.y);
      x[5] = bflo(rv.z); x[6] = bfhi(rv.z); x[7] = bflo(rv.w); x[8] = bfhi(rv.w);
      x[9] = (pos + 8 == L) ? 0.f : bf2f(raw[t + 8]);
      float u[8];
#pragma unroll
      for (int i = 0; i < 8; ++i) u[i] = w0 * x[i] + w1 * x[i + 1] + w2 * x[i + 2] + b;
      *(uint4*)(sU + (ch >> 3) * 64 + (((ch & 7) ^ ((ch >> 3) & 7)) * 8)) = make_uint4(pack2(u[0], u[1]), pack2(u[2], u[3]), pack2(u[4], u[5]), pack2(u[6], u[7]));
    }
  } else {
    const bf16_t* zr = (const bf16_t*)(p.ws + OFF_ZT) + (size_t)c * NTOK + tok0;
    for (int ch = tid; ch < 1024; ch += 256) *(uint4*)(sU + (ch >> 3) * 64 + (((ch & 7) ^ ((ch >> 3) & 7)) * 8)) = *(const uint4*)(zr + ch * 8);
  }
  __syncthreads();
  for (int k = tid; k < n; k += 256) {
    const unsigned a = sR0[k], b2 = (k + 1 < n) ? sR0[k + 1] : 0u;
    sR1[k] = (a >> 16) | (b2 << 16);
  }
  __syncthreads();

  f32x4 acc[4][2];
#pragma unroll
  for (int m = 0; m < 4; ++m) { acc[m][0] = (f32x4){0.f, 0.f, 0.f, 0.f}; acc[m][1] = (f32x4){0.f, 0.f, 0.f, 0.f}; }
  const unsigned* abase = (fr & 1) ? (sR0 + ((n - 1 - fr) >> 1) + 4 * fq) : (sR1 + ((n - 2 - fr) >> 1) + 4 * fq);
  const int col0 = 32 * wid + fr, col1 = col0 + 16;
  const int i0 = col0 & (nb - 1), i1 = col1 & (nb - 1);
  for (int d = -(nb - 1); d <= nb - 1; ++d) {
    const bool v0 = (unsigned)(i0 - d) < (unsigned)nb, v1 = (unsigned)(i1 - d) < (unsigned)nb;
    const bool any0 = __ballot(v0) != 0ull, any1 = __ballot(v1) != 0ull;
    if (!any0 && !any1) continue;
    bf16x8 F[6];
    const unsigned* ap = abase - 32 * d + 16;
#pragma unroll
    for (int idx = 0; idx < 6; ++idx) {
      const unsigned* q = ap - 8 * idx;
      union { unsigned u[4]; bf16x8 v; } cv;
      cv.u[0] = q[0]; cv.u[1] = q[1]; cv.u[2] = q[2]; cv.u[3] = q[3];
      F[idx] = cv.v;
    }
#pragma unroll
    for (int nt = 0; nt < 2; ++nt) {
      if (!(nt ? any1 : any0)) continue;
      const bool vv = nt ? v1 : v0;
      const int srow = (nt ? col1 : col0) - d;
      const bf16_t* up = sU + srow * 64;
#pragma unroll
      for (int ks = 0; ks < 2; ++ks) {
        bf16x8 bf = (bf16x8){0, 0, 0, 0, 0, 0, 0, 0};
        if (vv) bf = *(const bf16x8*)(up + (((ks * 4 + fq) ^ (srow & 7)) * 8));
#pragma unroll
        for (int m = 0; m < 4; ++m)
          acc[m][nt] = __builtin_amdgcn_mfma_f32_16x16x32_bf16(F[m + 2 - 2 * ks], bf, acc[m][nt], 0, 0, 0);
      }
    }
  }
  const float skip = p.filt_bias[ORDER * 512 + c];
  const int gcol = (ORDER == 0 ? 512 : 1024) + c;
  const bf16_t* graw = hyT + (size_t)gcol * NTOK + tok0;
  const float w0 = p.hy_conv_w[gcol], w1 = p.hy_conv_w[1536 + gcol], w2 = p.hy_conv_w[3072 + gcol], b = p.hy_conv_b[gcol];
  bf16_t* outT = (bf16_t*)(p.ws + (ORDER == 0 ? OFF_ZT : OFF_Y2T)) + (size_t)c * NTOK + tok0;
#pragma unroll
  for (int nt = 0; nt < 2; ++nt) {
    const int col = nt ? col1 : col0;
#pragma unroll
    for (int m = 0; m < 4; ++m) {
      const int t = col * 64 + 16 * m + 4 * fq, pos = t & (L - 1);
      const uint2 uu = *(const uint2*)(sU + col * 64 + (((2 * m + (fq >> 1)) ^ (col & 7)) * 8) + 4 * (fq & 1));
      const uint2 gv = *(const uint2*)(graw + t);
      float x[6];
      x[0] = pos == 0 ? 0.f : bf2f(graw[t - 1]);
      x[1] = bflo(gv.x); x[2] = bfhi(gv.x); x[3] = bflo(gv.y); x[4] = bfhi(gv.y);
      x[5] = (pos + 4 == L) ? 0.f : bf2f(graw[t + 4]);
      const float u4[4] = {bflo(uu.x), bfhi(uu.x), bflo(uu.y), bfhi(uu.y)};
      float o[4];
#pragma unroll
      for (int j = 0; j < 4; ++j) {
        const float gate = w0 * x[j] + w1 * x[j + 1] + w2 * x[j + 2] + b;
        o[j] = gate * (acc[m][nt][j] + skip * u4[j]);
      }
      *(uint2*)(outT + t) = make_uint2(pack2(o[0], o[1]), pack2(o[2], o[3]));
    }
  }
}

__device__ __forceinline__ void rope32(float* y  , int pos) {
  const float prow = (float)(pos >> 6), pcol = (float)(pos & 63);
  const float fr[8] = {1.f, 0.31622776601683794f, 0.1f, 0.031622776601683794f, 0.01f, 0.0031622776601683794f, 0.001f, 0.00031622776601683794f};
#pragma unroll
  for (int i = 0; i < 8; ++i) {
    const float tr = prow * fr[i] * 0.15915494309189535f, tc = pcol * fr[i] * 0.15915494309189535f;
    const float sr = sin_turns(tr), cr = cos_turns(tr), sc = sin_turns(tc), cc = cos_turns(tc);
    const float a = y[i], b = y[8 + i], c2 = y[16 + i], d2 = y[24 + i];
    y[i] = a * cr - b * sr; y[8 + i] = b * cr + a * sr;
    y[16 + i] = c2 * cc - d2 * sc; y[24 + i] = d2 * cc + c2 * sc;
  }
}
__device__ __forceinline__ void unpack8(const uint4& v, float* x) {
  x[0] = bflo(v.x); x[1] = bfhi(v.x); x[2] = bflo(v.y); x[3] = bfhi(v.y);
  x[4] = bflo(v.z); x[5] = bfhi(v.z); x[6] = bflo(v.w); x[7] = bfhi(v.w);
}
__device__ __forceinline__ float sumsq8(const uint4& v) {
  float x[8];
  unpack8(v, x);
  return x[0] * x[0] + x[1] * x[1] + x[2] * x[2] + x[3] * x[3] + x[4] * x[4] + x[5] * x[5] + x[6] * x[6] + x[7] * x[7];
}
__device__ __forceinline__ uint4 scale8(const uint4& v, float r, const float* __restrict__ g) {
  float x[8];
  unpack8(v, x);
  const float4 g0 = *(const float4*)g, g1 = *(const float4*)(g + 4);
  return make_uint4(pack2(x[0] * r * g0.x, x[1] * r * g0.y), pack2(x[2] * r * g0.z, x[3] * r * g0.w),
                    pack2(x[4] * r * g1.x, x[5] * r * g1.y), pack2(x[6] * r * g1.z, x[7] * r * g1.w));
}
__device__ __forceinline__ void qk_item(const Params& p, int item) {
  const int tid = ltid();
  if (item < 512) {
    const int idx = item * 256 + tid, row = idx >> 3, h = idx & 7;
    const bf16_t* src = (const bf16_t*)(p.ws + OFF_QRAW) + (size_t)row * 768 + h * 96;
    bf16_t* dst = (bf16_t*)(p.ws + OFF_Q) + (size_t)row * 768 + h * 96;
    uint4 raw[12];
#pragma unroll
    for (int i = 0; i < 12; ++i) raw[i] = *(const uint4*)(src + 8 * i);
    float ss = 0.f;
#pragma unroll
    for (int i = 0; i < 12; ++i) ss += sumsq8(raw[i]);
    const float r = rsqrtf(ss * (1.f / 96.f) + 1e-6f);
    const float qs = 0.10206207261596575f * 1.4426950408889634f;
#pragma unroll
    for (int i = 0; i < 8; ++i) *(uint4*)(dst + 8 * i) = scale8(raw[i], r * qs, p.g_q + 8 * i);
    float y[32];
#pragma unroll
    for (int i = 0; i < 4; ++i) unpack8(raw[8 + i], y + 8 * i);
#pragma unroll
    for (int i = 0; i < 32; ++i) y[i] = y[i] * r * p.g_q[64 + i];
    if (row >= NCTX) rope32(y, (row - NCTX) & 4095);
#pragma unroll
    for (int i = 0; i < 4; ++i)
      *(uint4*)(dst + 64 + 8 * i) = make_uint4(pack2(y[8 * i] * qs, y[8 * i + 1] * qs), pack2(y[8 * i + 2] * qs, y[8 * i + 3] * qs),
                                               pack2(y[8 * i + 4] * qs, y[8 * i + 5] * qs), pack2(y[8 * i + 6] * qs, y[8 * i + 7] * qs));
  } else {
    const int idx = (item - 512) * 256 + tid, row = idx >> 3, h = idx & 7;
    const bf16_t* src = (const bf16_t*)(p.ws + OFF_KRAW) + (size_t)row * 512 + h * 64;
    uint4 raw[8];
#pragma unroll
    for (int i = 0; i < 8; ++i) raw[i] = *(const uint4*)(src + 8 * i);
    const float* kp = row < NTOK ? (const float*)(p.ws + OFF_KPE) + (size_t)row * 32 : p.cache_kpe + (size_t)(row - NTOK) * 32;
    float y[32];
#pragma unroll
    for (int i = 0; i < 8; ++i) {
      const float4 v = *(const float4*)(kp + 4 * i);
      y[4 * i] = v.x; y[4 * i + 1] = v.y; y[4 * i + 2] = v.z; y[4 * i + 3] = v.w;
    }
    float ss = 0.f;
#pragma unroll
    for (int i = 0; i < 8; ++i) ss += sumsq8(raw[i]);
#pragma unroll
    for (int i = 0; i < 32; ++i) ss += y[i] * y[i];
    const float r = rsqrtf(ss * (1.f / 96.f) + 1e-6f);
#pragma unroll
    for (int i = 0; i < 32; ++i) y[i] = y[i] * r * p.g_k[64 + i];
    bf16_t* dst;
    if (row < NCTX) dst = (bf16_t*)(p.ws + OFF_KC) + ((size_t)((row >> 8) * 8 + h) * 256 + (row & 255)) * 96;
    else if (row < NTOK) {
      const int rr = row - NCTX;
      rope32(y, rr & 4095);
      dst = (bf16_t*)(p.ws + OFF_KL) + ((size_t)((rr >> 12) * 8 + h) * 4608 + (rr & 4095)) * 96;
    } else {
      const int rr = row - NTOK;
      dst = (bf16_t*)(p.ws + OFF_KL) + ((size_t)((rr >> 9) * 8 + h) * 4608 + 4096 + (rr & 511)) * 96;
    }
#pragma unroll
    for (int i = 0; i < 8; ++i) *(uint4*)(dst + 8 * i) = scale8(raw[i], r, p.g_k + 8 * i);
#pragma unroll
    for (int i = 0; i < 4; ++i)
      *(uint4*)(dst + 64 + 8 * i) = make_uint4(pack2(y[8 * i], y[8 * i + 1]), pack2(y[8 * i + 2], y[8 * i + 3]),
                                               pack2(y[8 * i + 4], y[8 * i + 5]), pack2(y[8 * i + 6], y[8 * i + 7]));
  }
}

__device__ __forceinline__ void attn_item(const Params& p, int item, char* smem) {
  const int tid = ltid(), lane = tid & 63, wid = tid >> 6, lr = lane & 31, lh = lane >> 5;
  int nkeys, h, tokbase; const bf16_t *Kp, *Vp;
  if (item < 512) {
    const int b = item >> 8, rem = item & 255; h = rem >> 5; const int qb = rem & 31;
    nkeys = 4608; tokbase = NCTX + b * 4096 + qb * 128;
    Kp = (const bf16_t*)(p.ws + OFF_KL) + (size_t)(b * 8 + h) * 4608 * 96;
    Vp = (const bf16_t*)(p.ws + OFF_VTL) + (size_t)(b * 8 + h) * 64 * 4608;
  } else {
    const int it = item - 512, b = it >> 4; h = (it & 15) >> 1; const int qb = it & 1;
    nkeys = 256; tokbase = b * 256 + qb * 128;
    Kp = (const bf16_t*)(p.ws + OFF_KC) + (size_t)(b * 8 + h) * 256 * 96;
    Vp = (const bf16_t*)(p.ws + OFF_VTC) + (size_t)(b * 8 + h) * 64 * 256;
  }
  bf16_t* sK = (bf16_t*)smem;
  bf16_t* sV = sK + 64 * 104;
  const int token = tokbase + 32 * wid + lr;
  bf16x8 qf[6];
  {
    const bf16_t* qsrc = (const bf16_t*)(p.ws + OFF_QRAW) + (size_t)token * 768 + h * 96 + 8 * lh;
    uint4 qr[6];
#pragma unroll
    for (int ks = 0; ks < 6; ++ks) qr[ks] = *(const uint4*)(qsrc + 16 * ks);
    float ss = 0.f;
#pragma unroll
    for (int ks = 0; ks < 6; ++ks) ss += sumsq8(qr[ks]);
    ss += __shfl_xor(ss, 32);
    const float r = rsqrtf(ss * (1.f / 96.f) + 1e-6f);
    const float qs = 0.10206207261596575f * 1.4426950408889634f;
    const bool lat = item < 512;
    const int pos = (token - NCTX) & 4095;
    const float prow = (float)(pos >> 6), pcol = (float)(pos & 63);
    const float frq[8] = {1.f, 0.31622776601683794f, 0.1f, 0.031622776601683794f, 0.01f, 0.0031622776601683794f, 0.001f, 0.00031622776601683794f};
#pragma unroll
    for (int ks = 0; ks < 6; ++ks) {
      float y[8];
      unpack8(qr[ks], y);
      const float* gq = p.g_q + 16 * ks + 8 * lh;
#pragma unroll
      for (int e = 0; e < 8; ++e) y[e] = y[e] * r * gq[e];
      if (ks >= 4) {
#pragma unroll
        for (int e = 0; e < 8; ++e) {
          const float other = __shfl_xor(y[e], 32);
          const float t = (ks == 4 ? prow : pcol) * frq[e] * 0.15915494309189535f;
          const float sn = sin_turns(t), cs = cos_turns(t);
          const float rot = y[e] * cs + (lh ? other : -other) * sn;
          y[e] = lat ? rot : y[e];
        }
      }
      union { unsigned u[4]; bf16x8 v; } pk;
      pk.u[0] = pack2(y[0] * qs, y[1] * qs); pk.u[1] = pack2(y[2] * qs, y[3] * qs); pk.u[2] = pack2(y[4] * qs, y[5] * qs); pk.u[3] = pack2(y[6] * qs, y[7] * qs);
      qf[ks] = pk.v;
    }
  }
  f32x16 oacc[2];
#pragma unroll
  for (int j = 0; j < 16; ++j) { oacc[0][j] = 0.f; oacc[1][j] = 0.f; }
  float mrun = -1e30f, lsum = 0.f;
  const int kk0 = tid / 12, kc0 = tid % 12, kk1 = (tid + 256) / 12, kc1 = (tid + 256) % 12, kk2 = (tid + 512) / 12, kc2 = (tid + 512) % 12;
  const int vd0 = tid >> 3, vc0 = tid & 7, vd1 = vd0 + 32;
  const bf16_t* gk0 = Kp + (size_t)kk0 * 96 + kc0 * 8;
  const bf16_t* gk1 = Kp + (size_t)kk1 * 96 + kc1 * 8;
  const bf16_t* gk2 = Kp + (size_t)kk2 * 96 + kc2 * 8;
  const bf16_t* gv0 = Vp + (size_t)vd0 * nkeys + vc0 * 8;
  const bf16_t* gv1 = Vp + (size_t)vd1 * nkeys + vc0 * 8;
  uint4 rk0 = *(const uint4*)gk0, rk1 = *(const uint4*)gk1, rk2 = *(const uint4*)gk2;
  uint4 rv0 = *(const uint4*)gv0, rv1 = *(const uint4*)gv1;
  const int nt = nkeys >> 6;
  for (int kt = 0; kt < nt; ++kt) {
    __syncthreads();
    *(uint4*)(sK + kk0 * 104 + kc0 * 8) = rk0; *(uint4*)(sK + kk1 * 104 + kc1 * 8) = rk1; *(uint4*)(sK + kk2 * 104 + kc2 * 8) = rk2;
    *(uint4*)(sV + vd0 * 72 + vc0 * 8) = rv0; *(uint4*)(sV + vd1 * 72 + vc0 * 8) = rv1;
    __syncthreads();
    if (kt + 1 < nt) {
      gk0 += 64 * 96; gk1 += 64 * 96; gk2 += 64 * 96; gv0 += 64; gv1 += 64;
      rk0 = *(const uint4*)gk0; rk1 = *(const uint4*)gk1; rk2 = *(const uint4*)gk2;
      rv0 = *(const uint4*)gv0; rv1 = *(const uint4*)gv1;
    }
    __builtin_amdgcn_sched_barrier(0);
    f32x16 sacc[2];
#pragma unroll
    for (int kb = 0; kb < 2; ++kb) {
#pragma unroll
      for (int j = 0; j < 16; ++j) sacc[kb][j] = 0.f;
#pragma unroll
      for (int ks = 0; ks < 6; ++ks) {
        const bf16x8 a = *(const bf16x8*)(sK + (32 * kb + lr) * 104 + 16 * ks + 8 * lh);
        sacc[kb] = __builtin_amdgcn_mfma_f32_32x32x16_bf16(a, qf[ks], sacc[kb], 0, 0, 0);
      }
    }
    float mx = sacc[0][0];
#pragma unroll
    for (int j = 1; j < 16; ++j) mx = fmaxf(mx, sacc[0][j]);
#pragma unroll
    for (int j = 0; j < 16; ++j) mx = fmaxf(mx, sacc[1][j]);
    mx = fmaxf(mx, __shfl_xor(mx, 32));
    const float mnew = fmaxf(mrun, mx);
    const float alpha = __builtin_amdgcn_exp2f(mrun - mnew);
    mrun = mnew;
    float ps = 0.f;
#pragma unroll
    for (int kb = 0; kb < 2; ++kb)
#pragma unroll
      for (int j = 0; j < 16; ++j) { const float e = __builtin_amdgcn_exp2f(sacc[kb][j] - mnew); sacc[kb][j] = e; ps += e; }
    lsum = lsum * alpha + ps;
    if (__ballot(alpha != 1.f) != 0ull) {
#pragma unroll
      for (int j = 0; j < 16; ++j) { oacc[0][j] *= alpha; oacc[1][j] *= alpha; }
    }
#pragma unroll
    for (int s = 0; s < 4; ++s) {
      const int kb = s >> 1, jb = 8 * (s & 1);
      union { unsigned u[4]; bf16x8 v; } pf;
      pf.u[0] = pack2(sacc[kb][jb + 0], sacc[kb][jb + 1]); pf.u[1] = pack2(sacc[kb][jb + 2], sacc[kb][jb + 3]);
      pf.u[2] = pack2(sacc[kb][jb + 4], sacc[kb][jb + 5]); pf.u[3] = pack2(sacc[kb][jb + 6], sacc[kb][jb + 7]);
#pragma unroll
      for (int mt = 0; mt < 2; ++mt) {
        const bf16_t* vp = sV + (32 * mt + lr) * 72 + 16 * s + 4 * lh;
        union { uint2 d[2]; bf16x8 v; } av;
        av.d[0] = *(const uint2*)vp;
        av.d[1] = *(const uint2*)(vp + 8);
        oacc[mt] = __builtin_amdgcn_mfma_f32_32x32x16_bf16(av.v, pf.v, oacc[mt], 0, 0, 0);
      }
    }
  }
  lsum += __shfl_xor(lsum, 32);
  const float inv = 1.f / lsum;
  bf16_t* dst = (bf16_t*)(p.ws + OFF_ATTN) + (size_t)token * 512 + h * 64;
#pragma unroll
  for (int mt = 0; mt < 2; ++mt)
#pragma unroll
    for (int jg = 0; jg < 4; ++jg) {
      const int dv0 = 32 * mt + 8 * jg + 4 * lh;
      *(uint2*)(dst + dv0) = make_uint2(pack2(oacc[mt][4 * jg] * inv, oacc[mt][4 * jg + 1] * inv),
                                        pack2(oacc[mt][4 * jg + 2] * inv, oacc[mt][4 * jg + 3] * inv));
    }
}

__device__ __forceinline__ void merge_item(const Params& p, int item, char* smem) {
  const int tid = ltid(), lane = tid & 63, wid = tid >> 6, t0 = item * 32;
  bf16_t* mix = (bf16_t*)(p.ws + OFF_H);
  const bf16_t* attn = (const bf16_t*)(p.ws + OFF_ATTN);
  for (int tt = 0; tt < 8; ++tt) {
    const int token = t0 + wid * 8 + tt;
    float x[8];
    unpack8(*(const uint4*)(attn + (size_t)token * 512 + lane * 8), x);
    float ss = 0.f;
#pragma unroll
    for (int i = 0; i < 8; ++i) ss += x[i] * x[i];
    ss = wave_sum(ss);
    const float r = rsqrtf(ss * (1.f / 512.f) + 1e-6f);
    const float4 g0 = *(const float4*)(p.g_out_att + lane * 8), g1 = *(const float4*)(p.g_out_att + lane * 8 + 4);
    *(uint4*)(mix + (size_t)token * D + lane * 8) =
        make_uint4(pack2(x[0] * r * g0.x, x[1] * r * g0.y), pack2(x[2] * r * g0.z, x[3] * r * g0.w),
                   pack2(x[4] * r * g1.x, x[5] * r * g1.y), pack2(x[6] * r * g1.z, x[7] * r * g1.w));
  }
  bf16_t* sT = (bf16_t*)smem;
  const bf16_t* y2T = (const bf16_t*)(p.ws + OFF_Y2T);
  __syncthreads();
  for (int ch = tid; ch < 2048; ch += 256) {
    const int c = ch >> 2, q4 = ch & 3;
    const uint4 v = *(const uint4*)(y2T + (size_t)c * NTOK + t0 + q4 * 8);
    bf16_t* d = sT + (q4 * 8) * 520 + c;
    d[0 * 520] = (bf16_t)(v.x & 0xffff); d[1 * 520] = (bf16_t)(v.x >> 16);
    d[2 * 520] = (bf16_t)(v.y & 0xffff); d[3 * 520] = (bf16_t)(v.y >> 16);
    d[4 * 520] = (bf16_t)(v.z & 0xffff); d[5 * 520] = (bf16_t)(v.z >> 16);
    d[6 * 520] = (bf16_t)(v.w & 0xffff); d[7 * 520] = (bf16_t)(v.w >> 16);
  }
  __syncthreads();
  {
    const int tt = tid >> 3, part = tid & 7;
    uint4 v[8];
    float ss = 0.f;
#pragma unroll
    for (int i = 0; i < 8; ++i) {
      v[i] = *(const uint4*)(sT + tt * 520 + part * 64 + 8 * i);
      float x[8];
      unpack8(v[i], x);
#pragma unroll
      for (int e = 0; e < 8; ++e) ss += x[e] * x[e];
    }
    ss += __shfl_xor(ss, 1); ss += __shfl_xor(ss, 2); ss += __shfl_xor(ss, 4);
    const float r = rsqrtf(ss * (1.f / 512.f) + 1e-6f);
#pragma unroll
    for (int i = 0; i < 8; ++i) {
      float x[8];
      unpack8(v[i], x);
      const int c0 = part * 64 + 8 * i;
      const float4 g0 = *(const float4*)(p.g_out_hy + c0), g1 = *(const float4*)(p.g_out_hy + c0 + 4);
      *(uint4*)(mix + (size_t)(t0 + tt) * D + 512 + c0) =
          make_uint4(pack2(x[0] * r * g0.x, x[1] * r * g0.y), pack2(x[2] * r * g0.z, x[3] * r * g0.w),
                     pack2(x[4] * r * g1.x, x[5] * r * g1.y), pack2(x[6] * r * g1.z, x[7] * r * g1.w));
    }
  }
}

__device__ __forceinline__ void actfix_item(const Params& p, int item) {
  const int idx = item * 256 + ltid();
  if (idx >= 512 * 352) return;
  const int j = (idx % 352) * 8, rowi = idx / 352, wt = rowi >> 1, which = rowi & 1;
  const int t = 64 * wt + 63 * which, L = t < NCTX ? SEQC : SEQL, pos = t & (L - 1);
  const bf16_t* edge = (const bf16_t*)(p.ws + OFF_EDGE);
  bf16_t* act = (bf16_t*)(p.ws + OFF_U);
  const bf16_t *pr, *cu, *nx;
  bool zp = false, zn = false;
  if (which == 0) { zp = pos == 0; pr = edge + (size_t)((zp ? wt : wt - 1) * 4 + 3) * 5632; cu = edge + (size_t)(wt * 4 + 0) * 5632; nx = edge + (size_t)(wt * 4 + 1) * 5632; }
  else { zn = pos == L - 1; pr = edge + (size_t)(wt * 4 + 2) * 5632; cu = edge + (size_t)(wt * 4 + 3) * 5632; nx = edge + (size_t)((zn ? wt : wt + 1) * 4 + 0) * 5632; }
  float pa[8], pg[8], ca[8], cgv[8], na[8], ng[8];
  unpack8(*(const uint4*)(pr + j), pa); unpack8(*(const uint4*)(pr + 2816 + j), pg);
  unpack8(*(const uint4*)(cu + j), ca); unpack8(*(const uint4*)(cu + 2816 + j), cgv);
  unpack8(*(const uint4*)(nx + j), na); unpack8(*(const uint4*)(nx + 2816 + j), ng);
  float o[8];
#pragma unroll
  for (int e = 0; e < 8; ++e) {
    const float pae = zp ? 0.f : pa[e], pge = zp ? 0.f : pg[e], nae = zn ? 0.f : na[e], nge = zn ? 0.f : ng[e];
    const float a = p.ffn_conv_w[j + e] * pae + p.ffn_conv_w[5632 + j + e] * ca[e] + p.ffn_conv_w[11264 + j + e] * nae + p.ffn_conv_b[j + e];
    const float g = p.ffn_conv_w[2816 + j + e] * pge + p.ffn_conv_w[5632 + 2816 + j + e] * cgv[e] + p.ffn_conv_w[11264 + 2816 + j + e] * nge + p.ffn_conv_b[2816 + j + e];
    o[e] = a * __builtin_amdgcn_rcpf(1.f + __expf(-a)) * g;
  }
  *(uint4*)(act + (size_t)t * 2816 + j) = make_uint4(pack2(o[0], o[1]), pack2(o[2], o[3]), pack2(o[4], o[5]), pack2(o[6], o[7]));
}

#define XB_TMO      128
#define XB_XCNT(j)  (256  + 64 * (j))
#define XB_XSUB(j)  (1280 + 64 * (j))
#define XB_XGEN(j)  (2304 + 64 * (j))
#define XB_TOP      3328
#define XB_TOPGEN   3392
#define XCD_BAR_WORDS 3456
#define XB_SPIN_CAP (1u << 20)
#define LAS __attribute__((address_space(3)))
__device__ __forceinline__ unsigned xb_ld(unsigned* p) { return __hip_atomic_load(p, __ATOMIC_RELAXED, __HIP_MEMORY_SCOPE_AGENT); }
__device__ __forceinline__ unsigned xb_add(unsigned* p, unsigned v) { return __hip_atomic_fetch_add(p, v, __ATOMIC_RELAXED, __HIP_MEMORY_SCOPE_AGENT); }
__device__ __forceinline__ unsigned xb_xcc_id() { return (unsigned)__builtin_amdgcn_s_getreg((3 << 11) | 20) & 0xFu; }
#define XB_SPIN(cond, bar) do { unsigned _sp = 0; while (cond) { __builtin_amdgcn_s_sleep(1); \
    if ((++_sp & 255u) == 0u) { if (xb_ld(&(bar)[XB_TMO])) break; if (_sp > XB_SPIN_CAP) { atomicAdd(&(bar)[XB_TMO], 1u); break; } } } } while (0)
struct XcdBarrier { unsigned* bar; unsigned x; volatile LAS unsigned* st; };
__device__ __forceinline__ XcdBarrier xcd_barrier_post(unsigned* bar, volatile LAS unsigned* st) {
  XcdBarrier b; b.bar = bar; b.x = xb_xcc_id(); b.st = st;
  if (threadIdx.x == 0) (void)xb_add(&bar[XB_XCNT(b.x)], 1u);
  return b;
}
__device__ __forceinline__ void xcd_barrier_complete(unsigned* bar, unsigned x, unsigned& nloc, unsigned& nx) {
  const unsigned G = gridDim.x * gridDim.y * gridDim.z;
  unsigned sum, cnt, mine, sp = 0u;
  for (;;) {
    sum = 0u; cnt = 0u; mine = 0u;
#pragma unroll
    for (unsigned j = 0; j < 16; ++j) { const unsigned c = xb_ld(&bar[XB_XCNT(j)]); sum += c; cnt += (c > 0u) ? 1u : 0u; mine = (j == x) ? c : mine; }
    if (sum == G) break;
    __builtin_amdgcn_s_sleep(1);
    if ((++sp & 255u) == 0u) { if (xb_ld(&bar[XB_TMO])) break; if (sp > XB_SPIN_CAP) { atomicAdd(&bar[XB_TMO], 1u); break; } }
  }
  nloc = mine > 0u ? mine : 1u; nx = cnt > 0u ? cnt : 1u;
}
__device__ __forceinline__ void xcd_barrier(const XcdBarrier& b) {
  asm volatile("s_waitcnt vmcnt(0)" ::: "memory");
  __syncthreads();
  if (threadIdx.x == 0) {
    unsigned* bar = b.bar;
    __builtin_amdgcn_s_waitcnt(0);
    unsigned nloc = b.st[0], nx = b.st[1];
    if (nloc == 0u) { xcd_barrier_complete(bar, b.x, nloc, nx); b.st[0] = nloc; b.st[1] = nx; }
    const unsigned old = xb_add(&bar[XB_XSUB(b.x)], 1u);
    const unsigned gen = old / nloc;
    if (old + 1u == (gen + 1u) * nloc) {
      __builtin_amdgcn_fence(__ATOMIC_RELEASE, "agent");
      asm volatile("s_waitcnt vmcnt(0)" ::: "memory");
      const unsigned og = xb_add(&bar[XB_TOP], 1u);
      const unsigned tg = og / nx;
      if (og + 1u == (tg + 1u) * nx) xb_add(&bar[XB_TOPGEN], 1u);
      else XB_SPIN(xb_ld(&bar[XB_TOPGEN]) == tg, bar);
      __builtin_amdgcn_fence(__ATOMIC_ACQUIRE, "agent");
      xb_add(&bar[XB_XGEN(b.x)], 1u);
      asm volatile("s_waitcnt vmcnt(0)" ::: "memory");
    } else {
      XB_SPIN(xb_ld(&bar[XB_XGEN(b.x)]) == gen, bar);
      __builtin_amdgcn_fence(__ATOMIC_ACQUIRE, "agent");
      asm volatile("s_waitcnt vmcnt(0)" ::: "memory");
    }
  }
  __syncthreads();
}
constexpr size_t OFF_BAR = 25 * MiB - 16384;
static_assert(OFF_MOD + 3 * 6144 * 4 <= OFF_BAR, "bar");

template <int ph>
__device__ __forceinline__ void run_phase(const Params& p, char* smem) {
  const int bid = blockIdx.x, G = gridDim.x;
  char* ws = p.ws;
  if constexpr (ph == 0) {
    for (int it = bid; it < 272 + 96 + 32 + 3080; it += G) {
      if (it < 272) filter_item(p, it, smem);
      else if (it < 368) mod_item(p, it - 272, smem);
      else if (it < 400) cache_item(p, it - 368);
      else {
        int t = it - 400;
        if (t < 576) transpose_item(p.w_in, 1024, DIN, (bf16_t*)(ws + OFF_WIN), t, 36, smem);
        else if ((t -= 576) < 72) transpose_item(p.w_uq, 384, 768, (bf16_t*)(ws + OFF_WUQ), t, 12, smem);
        else if ((t -= 72) < 64) transpose_item(p.w_ukv, 256, 1024, (bf16_t*)(ws + OFF_WUKV), t, 16, smem);
        else if ((t -= 64) < 256) transpose_item(p.w_out, 1024, 1024, (bf16_t*)(ws + OFF_WOUT), t, 16, smem);
        else if ((t -= 256) < 1408) transpose_item(p.w_up, 1024, 5632, (bf16_t*)(ws + OFF_WUP), t, 88, smem, true);
        else { t -= 1408; transpose_item(p.w_down, 2816, 1024, (bf16_t*)(ws + OFF_WDOWN), t, 16, smem); }
      }
    }
  } else if constexpr (ph == 1) {
    rmsmod_phase<0>(p);
  } else if constexpr (ph == 2) {
    EpiIn epi{(float*)(ws + OFF_PROJ), (bf16_t*)(ws + OFF_HYT)};
    EpiProj epr{(float*)(ws + OFF_PROJ)};
    for (int t = bid; t < 128 * 18; t += G) {
      const int nt = t % 18;
      if (nt < 5) gemm_tile<true>((const bf16_t*)(ws + OFF_H), 1024, (const bf16_t*)(ws + OFF_WIN), 1024, 1024, (t / 18) * 128, nt * 128, smem, epr);
      else gemm_tile<false>((const bf16_t*)(ws + OFF_H), 1024, (const bf16_t*)(ws + OFF_WIN), 1024, 1024, (t / 18) * 128, nt * 128, smem, epi);
    }
  } else if constexpr (ph == 3) {
    for (int it = bid; it < 512; it += G) hyena_item<0>(p, 1, it, smem);
    for (int it = bid; it < 512; it += G) hyena_item<0>(p, 0, it, smem);
    for (int it = G - 1 - bid; it < 512; it += G) token_item(p, it);
  } else if constexpr (ph == 4) {
    EpiQ eq{(bf16_t*)(ws + OFF_QRAW)};
    EpiKV ekv{(bf16_t*)(ws + OFF_KRAW), (bf16_t*)(ws + OFF_VTC), (bf16_t*)(ws + OFF_VTL)};
    for (int it = bid; it < 512; it += G) hyena_item<1>(p, 1, it, smem);
    for (int t = bid; t < 768; t += G) gemm_tile<true>((const bf16_t*)(ws + OFF_QA), 384, (const bf16_t*)(ws + OFF_WUQ), 384, 384, (t / 6) * 128, (t % 6) * 128, smem, eq);
    for (int t = bid; t < 1088; t += G) gemm_tile<false>((const bf16_t*)(ws + OFF_CKVN), 256, (const bf16_t*)(ws + OFF_WUKV), 256, 256, (t / 8) * 128, (t % 8) * 128, smem, ekv);
    for (int it = bid; it < 512; it += G) hyena_item<1>(p, 0, it, smem);
  } else if constexpr (ph == 5) {
    for (int it = bid; it < 544; it += G) qk_item(p, 512 + it);
  } else if constexpr (ph == 6) {
    for (int it = bid; it < 1024; it += G) attn_item(p, it, smem);
  } else if constexpr (ph == 7) {
    for (int it = bid; it < 512; it += G) merge_item(p, it, smem);
  } else if constexpr (ph == 8) {
    EpiOut epi{&p};
    for (int t = bid; t < 128 * 8; t += G)
      gemm_tile<true>((const bf16_t*)(ws + OFF_H), 1024, (const bf16_t*)(ws + OFF_WOUT), 1024, 1024, (t / 8) * 128, (t % 8) * 128, smem, epi);
  } else if constexpr (ph == 9) {
    rmsmod_phase<1>(p);
  } else if constexpr (ph == 10) {
    for (int t = bid; t < 128 * 44; t += G) gemm_up_act_tile(p, (t / 44) * 128, (t % 44) * 128, smem);
  } else if constexpr (ph == 11) {
    for (int it = bid; it < 704; it += G) actfix_item(p, it);
  } else if constexpr (ph == 12) {
    EpiY epi{&p, 0};
    for (int t = bid; t < 128 * 8; t += G)
      gemm_tile<true>((const bf16_t*)(ws + OFF_U), 2816, (const bf16_t*)(ws + OFF_WDOWN), 2816, 2816, (t / 8) * 128, (t % 8) * 128, smem, epi);
  }
}

#if ONE_LAUNCH
template <int PH>
__device__ __forceinline__ void run_all(const Params& p, char* smem, cg::grid_group& grid, const XcdBarrier& xb) {
  run_phase<PH>(p, smem);
  if constexpr (((DBL_MASK >> PH) & 1) != 0) { xcd_barrier(xb); run_phase<PH>(p, smem); }
  if constexpr (PH < 12) {
    xcd_barrier(xb);
    run_all<PH + 1>(p, smem, grid, xb);
  }
}
constexpr int DYN_LDS = 65536 + 64;
__global__ void __launch_bounds__(256, 2) mega_kernel(Params p) {
  extern __shared__ __attribute__((aligned(16))) char smem[];
  uint4* xb_words = (uint4*)(smem + 65536);
  cg::grid_group grid = cg::this_grid();
  if (threadIdx.x == 0) *xb_words = make_uint4(0u, 0u, 0u, 0u);
  __syncthreads();
  XcdBarrier xb = xcd_barrier_post((unsigned*)(p.ws + OFF_BAR), (volatile LAS unsigned*)xb_words);
  if (p.ws == nullptr) grid.sync();
  run_all<0>(p, smem, grid, xb);
}
#else
template <int PH>
__global__ void __launch_bounds__(256, 2) phase_kernel(Params p) {
  __shared__ __attribute__((aligned(16))) char smem[SMEM_BYTES];
  run_phase<PH>(p, smem);
}
#ifndef DBG_STOP
#define DBG_STOP 15
#endif
__global__ void dump_kernel(Params p, size_t off, int count) {
  const bf16_t* src = (const bf16_t*)(p.ws + off);
  const bf16_t* src2 = (const bf16_t*)(p.ws + DBG_OFF2);
  for (int i = blockIdx.x * 256 + threadIdx.x; i < 16777216; i += gridDim.x * 256)
    p.out[i] = i < DBG_CNT ? bf2f(src[i]) : (i - DBG_CNT < DBG_CNT2 ? bf2f(src2[i - DBG_CNT]) : 0.f);
}
template <int PH>
static void launch_all(const Params& p, hipStream_t stream) {
  phase_kernel<PH><<<512, 256, 0, stream>>>(p);
  if constexpr (PH < 12) launch_all<PH + 1>(p, stream);
}
#endif

extern "C" void kernel_launch(void* const* d_in, const int* in_sizes, int n_in, void* d_out, int out_size, void* d_ws,
                              size_t ws_size, hipStream_t stream) {
  Params p{};
  const float** pp = (const float**)&p;
  for (int i = 0; i < 34; ++i) pp[i] = (const float*)d_in[i];
  p.out = (float*)d_out;
  p.ws = (char*)d_ws;
#if ONE_LAUNCH
  (void)hipMemsetAsync((char*)d_ws + OFF_BAR, 0, XCD_BAR_WORDS * 4, stream);
  static int grid_blocks = 0;
  if (!grid_blocks) {
    int dev = 0, cus = 0, per_cu = 0;
    hipGetDevice(&dev);
    hipDeviceGetAttribute(&cus, hipDeviceAttributeMultiprocessorCount, dev);
    (void)hipFuncSetAttribute((const void*)mega_kernel, hipFuncAttributeMaxDynamicSharedMemorySize, DYN_LDS);
    (void)hipOccupancyMaxActiveBlocksPerMultiprocessor(&per_cu, mega_kernel, 256, DYN_LDS);
    if (per_cu > 2) per_cu = 2;
    grid_blocks = cus * per_cu;
  }
  void* args[] = {&p};
  hipError_t e = hipLaunchCooperativeKernel((void*)mega_kernel, dim3(grid_blocks), dim3(256), args, DYN_LDS, stream);
  if (e != hipSuccess) fprintf(stderr, "cooperative launch failed: %s (grid %d)\n", hipGetErrorString(e), grid_blocks);
#else
  launch_all<0>(p, stream);
#if DBG_STOP < 15
  dump_kernel<<<1024, 256, 0, stream>>>(p, DBG_OFF, DBG_CNT);
#endif
#endif
}
```

```cpp
#include <hip/hip_runtime.h>
#include <hip/hip_cooperative_groups.h>
#include <cstdio>
namespace cg = cooperative_groups;

#define DBG_STOP 15
#define DBG_NOHY 0
#ifndef DBL_MASK
#define DBL_MASK 0
#endif
#define DBG_OFF OFF_QRAW
#define DBG_OFF2 OFF_KRAW
#define DBG_CNT 12582912
#define DBG_CNT2 0
#ifndef ONE_LAUNCH
#define ONE_LAUNCH 1
#endif

typedef unsigned short bf16_t;
typedef short bf16x8 __attribute__((ext_vector_type(8)));
typedef float f32x4 __attribute__((ext_vector_type(4)));
typedef float f32x16 __attribute__((ext_vector_type(16)));

constexpr int D = 1024, NTOK = 16384, NCTX = 8192, SEQC = 256, SEQL = 4096;
constexpr int DIN = 2208, DINP = 2304, QL = 384, KVL = 256, DFF = 2816;
constexpr int NROWKV = 17408;
constexpr size_t MiB = 1048576;

constexpr size_t OFF_WIN = 0;
constexpr size_t OFF_WUQ = OFF_WIN + (size_t)DINP * 1024 * 2;
constexpr size_t OFF_WUKV = OFF_WUQ + (size_t)768 * 384 * 2;
constexpr size_t OFF_WOUT = OFF_WUKV + (size_t)1024 * 256 * 2;
constexpr size_t OFF_WUP = OFF_WOUT + (size_t)1024 * 1024 * 2;
constexpr size_t OFF_WDOWN = OFF_WUP + (size_t)5632 * 1024 * 2;
constexpr size_t OFF_MOD = OFF_WDOWN + (size_t)1024 * 2816 * 2;
static_assert(OFF_MOD + 3 * 6144 * 4 <= 25 * MiB, "A region");
constexpr size_t OFF_RLAT = 25 * MiB;
constexpr size_t OFF_RCTX = 41 * MiB;
constexpr size_t OFF_H = 42 * MiB;
constexpr size_t OFF_ZT = 42 * MiB;
constexpr size_t OFF_QA = 58 * MiB;
constexpr size_t OFF_KPE = 70 * MiB;
constexpr size_t OFF_PROJ = 74 * MiB;
constexpr size_t OFF_QRAW = 74 * MiB;
constexpr size_t OFF_Y2T = 98 * MiB;
constexpr size_t OFF_ATTN = 116 * MiB;
constexpr size_t OFF_U = 74 * MiB;
constexpr size_t OFF_HYT = 116 * MiB;
constexpr size_t OFF_Q = 116 * MiB;
constexpr size_t OFF_KC = 140 * MiB;
constexpr size_t OFF_KL = 152 * MiB;
constexpr size_t OFF_CKVN = 164 * MiB;
constexpr size_t OFF_KRAW = 173 * MiB;
constexpr size_t OFF_VTC = 190 * MiB;
constexpr size_t OFF_VTL = 198 * MiB;
constexpr size_t OFF_ACT = 162 * MiB;

constexpr int OUT_YS = 0;
constexpr int OUT_CKV = 16777216;
constexpr int OUT_KPE = 16777216 + 2097152;

constexpr int SMEM_BYTES = 51200;

struct Params {
  const float *x_prompt, *x_sample, *cache_ckv, *cache_kpe, *c, *c_ctx, *w_ada, *b_ada, *g_mix, *w_in, *g_qa, *w_uq,
      *g_kva, *w_ukv, *g_q, *g_k, *hy_conv_w, *hy_conv_b, *filt_w1, *filt_b1, *filt_freq1, *filt_w2, *filt_b2,
      *filt_freq2, *filt_w3, *filt_bias, *g_out_att, *g_out_hy, *w_out, *g_ffn, *w_up, *ffn_conv_w, *ffn_conv_b, *w_down;
  float* out;
  char* ws;
};

typedef __bf16 bf16x2_t __attribute__((ext_vector_type(2)));
__device__ __forceinline__ unsigned pack2(float lo, float hi) {
  bf16x2_t v;
  v[0] = (__bf16)lo;
  v[1] = (__bf16)hi;
  return __builtin_bit_cast(unsigned, v);
}
__device__ __forceinline__ float bflo(unsigned u) { return __uint_as_float(u << 16); }
__device__ __forceinline__ float bfhi(unsigned u) { return __uint_as_float(u & 0xffff0000u); }
__device__ __forceinline__ float bf2f(bf16_t h) { return __uint_as_float(((unsigned)h) << 16); }
__device__ __forceinline__ bf16_t f2bf(float f) { return (bf16_t)(pack2(f, 0.f) & 0xffffu); }
__device__ __forceinline__ float wave_sum(float v) {
#pragma unroll
  for (int o = 32; o >= 1; o >>= 1) v += __shfl_xor(v, o);
  return v;
}
__device__ __forceinline__ int ltid() { int t = threadIdx.x; asm volatile("" : "+v"(t)); return t; }
__device__ __forceinline__ float sin_turns(float t) { t -= floorf(t); return __builtin_amdgcn_sinf(t); }
__device__ __forceinline__ float cos_turns(float t) { t -= floorf(t); return __builtin_amdgcn_cosf(t); }
__device__ __forceinline__ float sin_rad(float x) { return sin_turns(x * 0.15915494309189535f); }
__device__ __forceinline__ const float* xrow(const Params& p, int row) {
  return row < NCTX ? p.x_prompt + (size_t)row * D : p.x_sample + (size_t)(row - NCTX) * D;
}
__device__ __forceinline__ int modidx(int row) { return row < NCTX ? 0 : 1 + ((row - NCTX) >> 12); }

template <bool SWAP>
__device__ __forceinline__ void gemm_main(const bf16_t* __restrict__ A, int lda, const bf16_t* __restrict__ Bt, int ldb,
                                          int K, int m0, int n0, char* smem, f32x4 (&acc)[4][4]) {
  const int tid = ltid(), lane = tid & 63, wid = tid >> 6, wr = wid >> 1, wc = wid & 1;
  const int fr = lane & 15, fq = lane >> 4;
  bf16_t* sbase = (bf16_t*)smem;
#pragma unroll
  for (int m = 0; m < 4; ++m)
#pragma unroll
    for (int n = 0; n < 4; ++n) acc[m][n] = (f32x4){0.f, 0.f, 0.f, 0.f};
  const int lr = tid >> 3, lc = (tid & 7) * 8;
  const bf16_t* ga = A + (size_t)(m0 + lr) * lda + lc;
  const bf16_t* gb = Bt + (size_t)(n0 + lr) * ldb + lc;
  const size_t sa32 = (size_t)32 * lda, sb32 = (size_t)32 * ldb;
  uint4 ra0 = *(const uint4*)(ga), ra1 = *(const uint4*)(ga + sa32), ra2 = *(const uint4*)(ga + 2 * sa32), ra3 = *(const uint4*)(ga + 3 * sa32);
  uint4 rb0 = *(const uint4*)(gb), rb1 = *(const uint4*)(gb + sb32), rb2 = *(const uint4*)(gb + 2 * sb32), rb3 = *(const uint4*)(gb + 3 * sb32);
  const int nk = K >> 6;
  const int woff = lr * 64 + (((tid & 7) ^ (lr & 7)) * 8);
  const int aoff = (wr * 64 + fr) * 64, boff = 8192 + (wc * 64 + fr) * 64;
  __syncthreads();
  {
    bf16_t* wa = sbase + woff;
    *(uint4*)(wa) = ra0; *(uint4*)(wa + 32 * 64) = ra1; *(uint4*)(wa + 64 * 64) = ra2; *(uint4*)(wa + 96 * 64) = ra3;
    *(uint4*)(wa + 8192) = rb0; *(uint4*)(wa + 8192 + 32 * 64) = rb1; *(uint4*)(wa + 8192 + 64 * 64) = rb2; *(uint4*)(wa + 8192 + 96 * 64) = rb3;
  }
  if (nk > 1) {
    ga += 64; gb += 64;
    ra0 = *(const uint4*)(ga); ra1 = *(const uint4*)(ga + sa32); ra2 = *(const uint4*)(ga + 2 * sa32); ra3 = *(const uint4*)(ga + 3 * sa32);
    rb0 = *(const uint4*)(gb); rb1 = *(const uint4*)(gb + sb32); rb2 = *(const uint4*)(gb + 2 * sb32); rb3 = *(const uint4*)(gb + 3 * sb32);
  }
  __syncthreads();
  for (int kt = 0; kt < nk; ++kt) {
    const bf16_t* cur = sbase + (kt & 1) * 16384;
    bf16x8 af[2][4], bfr[2][4];
#pragma unroll
    for (int ks = 0; ks < 2; ++ks) {
#pragma unroll
      for (int m = 0; m < 4; ++m) af[ks][m] = *(const bf16x8*)(cur + aoff + m * 16 * 64 + (((ks * 4 + fq) ^ (fr & 7)) * 8));
#pragma unroll
      for (int n = 0; n < 4; ++n) bfr[ks][n] = *(const bf16x8*)(cur + boff + n * 16 * 64 + (((ks * 4 + fq) ^ (fr & 7)) * 8));
    }
    __builtin_amdgcn_sched_barrier(0);
    {
      bf16_t* wa = sbase + ((kt + 1) & 1) * 16384 + woff;
      *(uint4*)(wa) = ra0; *(uint4*)(wa + 32 * 64) = ra1; *(uint4*)(wa + 64 * 64) = ra2; *(uint4*)(wa + 96 * 64) = ra3;
      *(uint4*)(wa + 8192) = rb0; *(uint4*)(wa + 8192 + 32 * 64) = rb1; *(uint4*)(wa + 8192 + 64 * 64) = rb2; *(uint4*)(wa + 8192 + 96 * 64) = rb3;
      const int adv = (kt + 2 < nk) ? 64 : 0;
      ga += adv; gb += adv;
      ra0 = *(const uint4*)(ga); ra1 = *(const uint4*)(ga + sa32); ra2 = *(const uint4*)(ga + 2 * sa32); ra3 = *(const uint4*)(ga + 3 * sa32);
      rb0 = *(const uint4*)(gb); rb1 = *(const uint4*)(gb + sb32); rb2 = *(const uint4*)(gb + 2 * sb32); rb3 = *(const uint4*)(gb + 3 * sb32);
    }
#pragma unroll
    for (int ks = 0; ks < 2; ++ks)
#pragma unroll
      for (int m = 0; m < 4; ++m)
#pragma unroll
        for (int n = 0; n < 4; ++n) {
          if (SWAP) acc[m][n] = __builtin_amdgcn_mfma_f32_16x16x32_bf16(bfr[ks][n], af[ks][m], acc[m][n], 0, 0, 0);
          else acc[m][n] = __builtin_amdgcn_mfma_f32_16x16x32_bf16(af[ks][m], bfr[ks][n], acc[m][n], 0, 0, 0);
        }
#pragma unroll
    for (int i = 0; i < 8; ++i) { __builtin_amdgcn_sched_group_barrier(0x008, 2, 0); __builtin_amdgcn_sched_group_barrier(0x200, 1, 0); }
#pragma unroll
    for (int i = 0; i < 8; ++i) { __builtin_amdgcn_sched_group_barrier(0x008, 2, 0); __builtin_amdgcn_sched_group_barrier(0x020, 1, 0); }
    __builtin_amdgcn_sched_barrier(0);
    if (kt + 1 < nk) __syncthreads();
  }
}
template <bool SWAP, class Epi>
__device__ __forceinline__ void gemm_tile(const bf16_t* __restrict__ A, int lda, const bf16_t* __restrict__ Bt, int ldb,
                                          int K, int m0, int n0, char* smem, const Epi& epi) {
  f32x4 acc[4][4];
  gemm_main<SWAP>(A, lda, Bt, ldb, K, m0, n0, smem, acc);
  const int tid = ltid(), lane = tid & 63, wid = tid >> 6, wr = wid >> 1, wc = wid & 1;
  const int fr = lane & 15, fq = lane >> 4;
#pragma unroll
  for (int m = 0; m < 4; ++m)
#pragma unroll
    for (int n = 0; n < 4; ++n) {
      if (SWAP) epi(m0 + wr * 64 + m * 16 + fr, n0 + wc * 64 + n * 16 + fq * 4, acc[m][n]);
      else epi(m0 + wr * 64 + m * 16 + fq * 4, n0 + wc * 64 + n * 16 + fr, acc[m][n]);
    }
}

template <int CTRL>
__device__ __forceinline__ float dpp_ror(float v) {
  return __int_as_float(__builtin_amdgcn_update_dpp(0, __float_as_int(v), CTRL, 0xF, 0xF, false));
}
constexpr size_t OFF_EDGE = 162 * MiB;
__device__ __forceinline__ void gemm_up_act_tile(const Params& p, int m0, int n0, char* smem) {
  f32x4 acc[4][4];
  gemm_main<true>((const bf16_t*)(p.ws + OFF_H), 1024, (const bf16_t*)(p.ws + OFF_WUP), 1024, 1024, m0, n0, smem, acc);
  const int tid = ltid(), lane = tid & 63, wid = tid >> 6, wr = wid >> 1, wc = wid & 1;
  const int fr = lane & 15, fq = lane >> 4;
  bf16_t* act = (bf16_t*)(p.ws + OFF_U);
  bf16_t* edge = (bf16_t*)(p.ws + OFF_EDGE);
  const int rowbase = m0 + wr * 64, wt = rowbase >> 6;
#pragma unroll
  for (int i = 0; i < 2; ++i) {
    const int cperm = n0 + wc * 64 + 32 * i;
    const int j0 = (cperm >> 5) * 16 + 4 * fq;
    const float4 wa0 = *(const float4*)(p.ffn_conv_w + j0), wa1 = *(const float4*)(p.ffn_conv_w + 5632 + j0), wa2 = *(const float4*)(p.ffn_conv_w + 11264 + j0);
    const float4 wg0 = *(const float4*)(p.ffn_conv_w + 2816 + j0), wg1 = *(const float4*)(p.ffn_conv_w + 5632 + 2816 + j0), wg2 = *(const float4*)(p.ffn_conv_w + 11264 + 2816 + j0);
    const float4 ba = *(const float4*)(p.ffn_conv_b + j0), bg = *(const float4*)(p.ffn_conv_b + 2816 + j0);
    const float w0a[4] = {wa0.x, wa0.y, wa0.z, wa0.w}, w1a[4] = {wa1.x, wa1.y, wa1.z, wa1.w}, w2a[4] = {wa2.x, wa2.y, wa2.z, wa2.w};
    const float w0g[4] = {wg0.x, wg0.y, wg0.z, wg0.w}, w1g[4] = {wg1.x, wg1.y, wg1.z, wg1.w}, w2g[4] = {wg2.x, wg2.y, wg2.z, wg2.w};
    const float bba[4] = {ba.x, ba.y, ba.z, ba.w}, bbg[4] = {bg.x, bg.y, bg.z, bg.w};
#pragma unroll
    for (int m = 0; m < 4; ++m) {
      float o[4];
#pragma unroll
      for (int e = 0; e < 4; ++e) {
        const float a = acc[m][2 * i][e], g = acc[m][2 * i + 1][e];
        const float au1 = dpp_ror<0x121>(a), gu1 = dpp_ror<0x121>(g), ad1 = dpp_ror<0x12F>(a), gd1 = dpp_ror<0x12F>(g);
        float au2 = 0.f, gu2 = 0.f, ad2 = 0.f, gd2 = 0.f;
        if (m > 0) { au2 = dpp_ror<0x121>(acc[m - 1][2 * i][e]); gu2 = dpp_ror<0x121>(acc[m - 1][2 * i + 1][e]); }
        if (m < 3) { ad2 = dpp_ror<0x12F>(acc[m + 1][2 * i][e]); gd2 = dpp_ror<0x12F>(acc[m + 1][2 * i + 1][e]); }
        const float au = fr > 0 ? au1 : au2, gu = fr > 0 ? gu1 : gu2, ad = fr < 15 ? ad1 : ad2, gd = fr < 15 ? gd1 : gd2;
        const float ca = w0a[e] * au + w1a[e] * a + w2a[e] * ad + bba[e];
        const float cgv = w0g[e] * gu + w1g[e] * g + w2g[e] * gd + bbg[e];
        o[e] = ca * __builtin_amdgcn_rcpf(1.f + __expf(-ca)) * cgv;
      }
      const int lr64 = m * 16 + fr, row = rowbase + lr64;
      if (lr64 >= 1 && lr64 <= 62) *(uint2*)(act + (size_t)row * 2816 + j0) = make_uint2(pack2(o[0], o[1]), pack2(o[2], o[3]));
      if (lr64 <= 1 || lr64 >= 62) {
        const int slot = lr64 <= 1 ? lr64 : lr64 - 60;
        bf16_t* er = edge + (size_t)(wt * 4 + slot) * 5632;
        *(uint2*)(er + j0) = make_uint2(pack2(acc[m][2 * i][0], acc[m][2 * i][1]), pack2(acc[m][2 * i][2], acc[m][2 * i][3]));
        *(uint2*)(er + 2816 + j0) = make_uint2(pack2(acc[m][2 * i + 1][0], acc[m][2 * i + 1][1]), pack2(acc[m][2 * i + 1][2], acc[m][2 * i + 1][3]));
      }
    }
  }
}

__device__ __forceinline__ void transpose_item(const float* __restrict__ W, int K, int N, bf16_t* __restrict__ WT, int tile, int ntn, char* smem, bool perm = false) {
  float* s = (float*)smem;
  const int tk = tile / ntn, tn = tile % ntn, tid = ltid();
  const int k0 = tk * 64, n0 = tn * 64;
  __syncthreads();
  {
    const int r = tid >> 4, c4 = (tid & 15) * 4;
#pragma unroll
    for (int i = 0; i < 4; ++i) {
      const int k = r + 16 * i;
      float4 v = make_float4(0.f, 0.f, 0.f, 0.f);
      if (n0 + c4 < N) v = *(const float4*)(W + (size_t)(k0 + k) * N + n0 + c4);
      s[k * 65 + c4 + 0] = v.x; s[k * 65 + c4 + 1] = v.y; s[k * 65 + c4 + 2] = v.z; s[k * 65 + c4 + 3] = v.w;
    }
  }
  __syncthreads();
  {
    const int n = tid >> 2, kc = (tid & 3) * 16;
    unsigned o[8];
#pragma unroll
    for (int i = 0; i < 8; ++i) o[i] = pack2(s[(kc + 2 * i) * 65 + n], s[(kc + 2 * i + 1) * 65 + n]);
    int nr = n0 + n;
    if (perm) { const int hf = nr >= 2816 ? 1 : 0, cc = nr - hf * 2816; nr = 32 * (cc >> 4) + 16 * hf + (cc & 15); }
    uint4* dst = (uint4*)(WT + (size_t)nr * K + k0 + kc);
    dst[0] = make_uint4(o[0], o[1], o[2], o[3]);
    dst[1] = make_uint4(o[4], o[5], o[6], o[7]);
  }
}

__device__ __forceinline__ void mod_item(const Params& p, int item, char* smem) {
  float* s = (float*)smem;
  float* red = s + 3072;
  const int tid = ltid();
  __syncthreads();
  for (int e = tid; e < 3072; e += 256) {
    const int v = e >> 10, k = e & 1023;
    const float x = (v == 0) ? p.c_ctx[k] : p.c[(v - 1) * D + k];
    s[e] = x / (1.f + __expf(-x));
  }
  __syncthreads();
  const int jl = tid & 63, kq = tid >> 6, j = item * 64 + jl, k0 = kq * 256;
  float a0 = 0.f, a1 = 0.f, a2 = 0.f;
#pragma unroll 8
  for (int k = 0; k < 256; ++k) {
    const float w = p.w_ada[(size_t)(k0 + k) * 6144 + j];
    a0 += s[k0 + k] * w; a1 += s[1024 + k0 + k] * w; a2 += s[2048 + k0 + k] * w;
  }
  red[(kq * 3 + 0) * 64 + jl] = a0; red[(kq * 3 + 1) * 64 + jl] = a1; red[(kq * 3 + 2) * 64 + jl] = a2;
  __syncthreads();
  if (tid < 192) {
    const int v = tid >> 6;
    const float r = red[(0 * 3 + v) * 64 + jl] + red[(1 * 3 + v) * 64 + jl] + red[(2 * 3 + v) * 64 + jl] + red[(3 * 3 + v) * 64 + jl];
    ((float*)(p.ws + OFF_MOD))[v * 6144 + j] = r + p.b_ada[j];
  }
}

__device__ __forceinline__ void filter_item(const Params& p, int item, char* smem) {
  int n, p0; bf16_t* R;
  if (item < 256) { n = 4096; p0 = item * 16; R = (bf16_t*)(p.ws + OFF_RLAT); }
  else { n = 256; p0 = (item - 256) * 16; R = (bf16_t*)(p.ws + OFF_RCTX); }
  const int n2 = 2 * n, tid = ltid();
  float* z = (float*)smem;
  float* h1 = z + 16 * 36;
  float* h2 = h1 + 16 * 64;
  __syncthreads();
#pragma unroll 1
  for (int e = tid; e < 16 * 33; e += 256) {
    const int pp = e / 33, f = e % 33, pos = p0 + pp;
    float val;
    if (f == 0) val = (float)pos / (float)(n - 1);
    else {
      const int k = (f - 1) & 15;
      const float band = 1e-4f + (float)k * ((15.f - 1e-4f) / 15.f);
      const float turns = band * ((float)pos / (float)n);
      val = (f <= 16) ? cos_turns(turns) : -sin_turns(turns);
    }
    z[pp * 36 + f] = val;
  }
  __syncthreads();
#pragma unroll 1
  for (int e = tid; e < 1024; e += 256) {
    const int pp = e >> 6, j = e & 63;
    float a = p.filt_b1[j];
#pragma unroll 3
    for (int f = 0; f < 33; ++f) a += z[pp * 36 + f] * p.filt_w1[f * 64 + j];
    h1[e] = sin_rad(p.filt_freq1[j] * a);
  }
  __syncthreads();
#pragma unroll 1
  for (int e = tid; e < 1024; e += 256) {
    const int pp = e >> 6, j = e & 63;
    float a = p.filt_b2[j];
#pragma unroll 4
    for (int k = 0; k < 64; ++k) a += h1[pp * 64 + k] * p.filt_w2[k * 64 + j];
    h2[j * 16 + pp] = sin_rad(p.filt_freq2[j] * a);
  }
  __syncthreads();
  const float mind = -3.0701134573253946f, maxd = -15.350567286626973f;
#pragma unroll 1
  for (int ci = 0; ci < 8; ++ci) {
    const int col = tid + 256 * ci, o = col >> 10, dir = (col >> 9) & 1, c = col & 511;
    float acc[16];
#pragma unroll
    for (int i = 0; i < 16; ++i) acc[i] = 0.f;
#pragma unroll 4
    for (int k = 0; k < 64; ++k) {
      const float w = p.filt_w3[k * 2048 + col];
      const float4 ha = *(const float4*)(h2 + k * 16), hb = *(const float4*)(h2 + k * 16 + 4), hc = *(const float4*)(h2 + k * 16 + 8), hd = *(const float4*)(h2 + k * 16 + 12);
      acc[0] += ha.x * w; acc[1] += ha.y * w; acc[2] += ha.z * w; acc[3] += ha.w * w;
      acc[4] += hb.x * w; acc[5] += hb.y * w; acc[6] += hb.z * w; acc[7] += hb.w * w;
      acc[8] += hc.x * w; acc[9] += hc.y * w; acc[10] += hc.z * w; acc[11] += hc.w * w;
      acc[12] += hd.x * w; acc[13] += hd.y * w; acc[14] += hd.z * w; acc[15] += hd.w * w;
    }
    const float delta = fabsf(mind + (float)c * ((maxd - mind) / 511.f));
    bf16_t* Rrow = R + (size_t)(o * 512 + c) * n2;
#pragma unroll
    for (int i = 0; i < 16; ++i) {
      const int pos = p0 + i;
      const float t = (float)pos / (float)(n - 1);
      float val = acc[i] * (__expf(-t * delta) + 0.05f);
      int idx = dir == 0 ? (n - 1 - pos) : (n - 1 + pos);
      if (dir == 1 && pos == 0) { idx = n2 - 1; val = 0.f; }
      Rrow[idx] = f2bf(val);
    }
  }
}

__device__ __forceinline__ void cache_item(const Params& p, int item) {
  const int tid = ltid(), r0 = item * 32;
  bf16_t* ckvn = (bf16_t*)(p.ws + OFF_CKVN);
#pragma unroll 2
  for (int e = tid; e < 32 * 64; e += 256) {
    const int r = r0 + (e >> 6), c4 = (e & 63) * 4;
    const float4 v = *(const float4*)(p.cache_ckv + (size_t)r * 256 + c4);
    *(uint2*)(ckvn + (size_t)(NTOK + r) * 256 + c4) = make_uint2(pack2(v.x, v.y), pack2(v.z, v.w));
  }
}

template <int WHICH>
__device__ __forceinline__ void rmsmod_phase(const Params& p) {
  const int tid = ltid(), lane = tid & 63, wid = tid >> 6;
  const int gw = blockIdx.x * 4 + wid, tw = gridDim.x * 4;
  const float* g = WHICH == 0 ? p.g_mix : p.g_ffn;
  const float* mod = (const float*)(p.ws + OFF_MOD);
  bf16_t* h = (bf16_t*)(p.ws + OFF_H);
  float4 nv0, nv1, nv2, nv3;
  {
    const float* src = WHICH == 0 ? xrow(p, gw) : p.out + (size_t)gw * D;
    nv0 = ((const float4*)src)[lane]; nv1 = ((const float4*)src)[lane + 64]; nv2 = ((const float4*)src)[lane + 128]; nv3 = ((const float4*)src)[lane + 192];
  }
  for (int row = gw; row < NTOK; row += tw) {
    float4 v[4] = {nv0, nv1, nv2, nv3};
    if (row + tw < NTOK) {
      const float* src = WHICH == 0 ? xrow(p, row + tw) : p.out + (size_t)(row + tw) * D;
      nv0 = ((const float4*)src)[lane]; nv1 = ((const float4*)src)[lane + 64]; nv2 = ((const float4*)src)[lane + 128]; nv3 = ((const float4*)src)[lane + 192];
    }
    float ss = 0.f;
#pragma unroll
    for (int i = 0; i < 4; ++i) ss += v[i].x * v[i].x + v[i].y * v[i].y + v[i].z * v[i].z + v[i].w * v[i].w;
    ss = wave_sum(ss);
    const float r = rsqrtf(ss * (1.f / 1024.f) + 1e-6f);
    const float* mv = mod + modidx(row) * 6144 + (WHICH == 0 ? 0 : 3 * 1024);
#pragma unroll
    for (int i = 0; i < 4; ++i) {
      const int e = 4 * (lane + 64 * i);
      const float4 g4 = *(const float4*)(g + e), sh = *(const float4*)(mv + e), sc = *(const float4*)(mv + 1024 + e);
      const float y0 = v[i].x * r * g4.x * (1.f + sc.x) + sh.x, y1 = v[i].y * r * g4.y * (1.f + sc.y) + sh.y;
      const float y2 = v[i].z * r * g4.z * (1.f + sc.z) + sh.z, y3 = v[i].w * r * g4.w * (1.f + sc.w) + sh.w;
      *(uint2*)(h + (size_t)row * D + e) = make_uint2(pack2(y0, y1), pack2(y2, y3));
    }
  }
}

struct EpiIn {
  float* proj; bf16_t* hyT;
  __device__ __forceinline__ void operator()(int row0, int col, const f32x4& v) const {
    if (col < 672) {
#pragma unroll
      for (int j = 0; j < 4; ++j) proj[(size_t)(row0 + j) * 672 + col] = v[j];
    } else if (col < DIN) {
      *(uint2*)(hyT + (size_t)(col - 672) * NTOK + row0) = make_uint2(pack2(v[0], v[1]), pack2(v[2], v[3]));
    }
  }
};
struct EpiProj {
  float* proj;
  __device__ __forceinline__ void operator()(int row, int col0, const f32x4& v) const { *(f32x4*)(proj + (size_t)row * 672 + col0) = v; }
};
struct EpiQ {
  bf16_t* q;
  __device__ __forceinline__ void operator()(int row, int col0, const f32x4& v) const {
    *(uint2*)(q + (size_t)row * 768 + col0) = make_uint2(pack2(v[0], v[1]), pack2(v[2], v[3]));
  }
};
struct EpiKV {
  bf16_t *kraw, *vtc, *vtl;
  __device__ __forceinline__ void operator()(int row0, int col, const f32x4& v) const {
    const int head = col >> 7, cc = col & 127;
    if (cc < 64) {
#pragma unroll
      for (int j = 0; j < 4; ++j) kraw[(size_t)(row0 + j) * 512 + head * 64 + cc] = f2bf(v[j]);
    } else {
      const int dv = cc - 64;
      bf16_t* dst;
      if (row0 < NCTX) dst = vtc + ((size_t)((row0 >> 8) * 8 + head) * 64 + dv) * 256 + (row0 & 255);
      else if (row0 < NTOK) { const int r = row0 - NCTX; dst = vtl + ((size_t)((r >> 12) * 8 + head) * 64 + dv) * 4608 + (r & 4095); }
      else { const int r = row0 - NTOK; dst = vtl + ((size_t)((r >> 9) * 8 + head) * 64 + dv) * 4608 + 4096 + (r & 511); }
      *(uint2*)dst = make_uint2(pack2(v[0], v[1]), pack2(v[2], v[3]));
    }
  }
};
struct EpiOut {
  const Params* p;
  __device__ __forceinline__ void operator()(int row, int col0, const f32x4& v) const {
    const float4 x = *(const float4*)(xrow(*p, row) + col0);
    const float4 m = *(const float4*)((const float*)(p->ws + OFF_MOD) + modidx(row) * 6144 + 2 * 1024 + col0);
    *(float4*)(p->out + (size_t)row * D + col0) = make_float4(x.x + m.x * v[0], x.y + m.y * v[1], x.z + m.z * v[2], x.w + m.w * v[3]);
  }
};
struct EpiU {
  bf16_t* u;
  __device__ __forceinline__ void operator()(int row, int col0, const f32x4& v) const {
    *(uint2*)(u + (size_t)row * 5632 + col0) = make_uint2(pack2(v[0], v[1]), pack2(v[2], v[3]));
  }
};
struct EpiY {
  const Params* p; int half;
  __device__ __forceinline__ void operator()(int row, int col0, const f32x4& v) const {
    const int grow = half * 8192 + row;
    float4* dst = (float4*)(p->out + (size_t)grow * D + col0);
    const float4 x = *dst;
    const float4 m = *(const float4*)((const float*)(p->ws + OFF_MOD) + modidx(grow) * 6144 + 5 * 1024 + col0);
    *dst = make_float4(x.x + m.x * v[0], x.y + m.y * v[1], x.z + m.z * v[2], x.w + m.w * v[3]);
  }
};

__device__ __forceinline__ void token_item(const Params& p, int item) {
  const int tid = ltid(), lane = tid & 63, wid = tid >> 6;
  const float* proj = (const float*)(p.ws + OFF_PROJ);
  bf16_t* qa = (bf16_t*)(p.ws + OFF_QA);
  bf16_t* ckvn = (bf16_t*)(p.ws + OFF_CKVN);
  float* kpe = (float*)(p.ws + OFF_KPE);
  for (int tt = 0; tt < 8; ++tt) {
    const int token = item * 32 + wid * 8 + tt;
    const float* pr = proj + (size_t)token * 672;
    float2 q[3];
    float ss = 0.f;
#pragma unroll
    for (int i = 0; i < 3; ++i) { q[i] = *(const float2*)(pr + lane * 2 + 128 * i); ss += q[i].x * q[i].x + q[i].y * q[i].y; }
    ss = wave_sum(ss);
    const float r = rsqrtf(ss * (1.f / 384.f) + 1e-6f);
#pragma unroll
    for (int i = 0; i < 3; ++i) {
      const int e = lane * 2 + 128 * i;
      *(unsigned*)(qa + (size_t)token * 384 + e) = pack2(q[i].x * r * p.g_qa[e], q[i].y * r * p.g_qa[e + 1]);
    }
    const float4 kv = *(const float4*)(pr + 384 + lane * 4);
    float s2 = wave_sum(kv.x * kv.x + kv.y * kv.y + kv.z * kv.z + kv.w * kv.w);
    const float r2 = rsqrtf(s2 * (1.f / 256.f) + 1e-6f);
    const float4 g = *(const float4*)(p.g_kva + lane * 4);
    const float4 y = make_float4(kv.x * r2 * g.x, kv.y * r2 * g.y, kv.z * r2 * g.z, kv.w * r2 * g.w);
    *(uint2*)(ckvn + (size_t)token * 256 + lane * 4) = make_uint2(pack2(y.x, y.y), pack2(y.z, y.w));
    if (token < NCTX) *(float4*)(p.out + OUT_CKV + (size_t)token * 256 + lane * 4) = y;
    if (lane < 32) {
      const float kp = pr[640 + lane];
      kpe[(size_t)token * 32 + lane] = kp;
      if (token < NCTX) p.out[OUT_KPE + (size_t)token * 32 + lane] = kp;
    }
  }
}

template <int ORDER>
__device__ __forceinline__ void hyena_item(const Params& p, int grp, int c, char* smem) {
  const int tid = ltid(), lane = tid & 63, wid = tid >> 6, fr = lane & 15, fq = lane >> 4;
  const int n = grp ? SEQL : SEQC, nb = n >> 6, L = n;
  const bf16_t* Rrow = (const bf16_t*)(p.ws + (grp ? OFF_RLAT : OFF_RCTX)) + (size_t)(ORDER * 512 + c) * (2 * n);
  const bf16_t* hyT = (const bf16_t*)(p.ws + OFF_HYT);
  bf16_t* sU = (bf16_t*)smem;
  unsigned* sR0 = (unsigned*)(smem + 18432);
  unsigned* sR1 = (unsigned*)(smem + 18432 + 16384);
  const int tok0 = grp * 8192;
  __syncthreads();
  for (int ch = tid; ch < (2 * n) / 8; ch += 256) *(uint4*)((bf16_t*)sR0 + ch * 8) = *(const uint4*)(Rrow + ch * 8);
  if (ORDER == 0) {
    const bf16_t* raw = hyT + (size_t)c * NTOK + tok0;
    const float w0 = p.hy_conv_w[c], w1 = p.hy_conv_w[1536 + c], w2 = p.hy_conv_w[3072 + c], b = p.hy_conv_b[c];
    for (int ch = tid; ch < 1024; ch += 256) {
      const int t = ch * 8, pos = t & (L - 1);
      const uint4 rv = *(const uint4*)(raw + t);
      float x[10];
      x[0] = pos == 0 ? 0.f : bf2f(raw[t - 1]);
      x[1] = bflo(rv.x); x[2] = bfhi(rv.x); x[3] = bflo(rv.y); x[4] = bfhi(rv.y);
      x[5] = bflo(rv.z); x[6] = bfhi(rv.z); x[7] = bflo(rv.w); x[8] = bfhi(rv.w);
      x[9] = (pos + 8 == L) ? 0.f : bf2f(raw[t + 8]);
      float u[8];
#pragma unroll
      for (int i = 0; i < 8; ++i) u[i] = w0 * x[i] + w1 * x[i + 1] + w2 * x[i + 2] + b;
      *(uint4*)(sU + (ch >> 3) * 64 + (((ch & 7) ^ ((ch >> 3) & 7)) * 8)) = make_uint4(pack2(u[0], u[1]), pack2(u[2], u[3]), pack2(u[4], u[5]), pack2(u[6], u[7]));
    }
  } else {
    const bf16_t* zr = (const bf16_t*)(p.ws + OFF_ZT) + (size_t)c * NTOK + tok0;
    for (int ch = tid; ch < 1024; ch += 256) *(uint4*)(sU + (ch >> 3) * 64 + (((ch & 7) ^ ((ch >> 3) & 7)) * 8)) = *(const uint4*)(zr + ch * 8);
  }
  __syncthreads();
  for (int k = tid; k < n; k += 256) {
    const unsigned a = sR0[k], b2 = (k + 1 < n) ? sR0[k + 1] : 0u;
    sR1[k] = (a >> 16) | (b2 << 16);
  }
  __syncthreads();

  f32x4 acc[4][2];
#pragma unroll
  for (int m = 0; m < 4; ++m) { acc[m][0] = (f32x4){0.f, 0.f, 0.f, 0.f}; acc[m][1] = (f32x4){0.f, 0.f, 0.f, 0.f}; }
  const unsigned* abase = (fr & 1) ? (sR0 + ((n - 1 - fr) >> 1) + 4 * fq) : (sR1 + ((n - 2 - fr) >> 1) + 4 * fq);
  const int col0 = 32 * wid + fr, col1 = col0 + 16;
  const int i0 = col0 & (nb - 1), i1 = col1 & (nb - 1);
  for (int d = -(nb - 1); d <= nb - 1; ++d) {
    const bool v0 = (unsigned)(i0 - d) < (unsigned)nb, v1 = (unsigned)(i1 - d) < (unsigned)nb;
    const bool any0 = __ballot(v0) != 0ull, any1 = __ballot(v1) != 0ull;
    if (!any0 && !any1) continue;
    bf16x8 F[6];
    const unsigned* ap = abase - 32 * d + 16;
#pragma unroll
    for (int idx = 0; idx < 6; ++idx) {
      const unsigned* q = ap - 8 * idx;
      union { unsigned u[4]; bf16x8 v; } cv;
      cv.u[0] = q[0]; cv.u[1] = q[1]; cv.u[2] = q[2]; cv.u[3] = q[3];
      F[idx] = cv.v;
    }
#pragma unroll
    for (int nt = 0; nt < 2; ++nt) {
      if (!(nt ? any1 : any0)) continue;
      const bool vv = nt ? v1 : v0;
      const int srow = (nt ? col1 : col0) - d;
      const bf16_t* up = sU + srow * 64;
#pragma unroll
      for (int ks = 0; ks < 2; ++ks) {
        bf16x8 bf = (bf16x8){0, 0, 0, 0, 0, 0, 0, 0};
        if (vv) bf = *(const bf16x8*)(up + (((ks * 4 + fq) ^ (srow & 7)) * 8));
#pragma unroll
        for (int m = 0; m < 4; ++m)
          acc[m][nt] = __builtin_amdgcn_mfma_f32_16x16x32_bf16(F[m + 2 - 2 * ks], bf, acc[m][nt], 0, 0, 0);
      }
    }
  }
  const float skip = p.filt_bias[ORDER * 512 + c];
  const int gcol = (ORDER == 0 ? 512 : 1024) + c;
  const bf16_t* graw = hyT + (size_t)gcol * NTOK + tok0;
  const float w0 = p.hy_conv_w[gcol], w1 = p.hy_conv_w[1536 + gcol], w2 = p.hy_conv_w[3072 + gcol], b = p.hy_conv_b[gcol];
  bf16_t* outT = (bf16_t*)(p.ws + (ORDER == 0 ? OFF_ZT : OFF_Y2T)) + (size_t)c * NTOK + tok0;
#pragma unroll
  for (int nt = 0; nt < 2; ++nt) {
    const int col = nt ? col1 : col0;
#pragma unroll
    for (int m = 0; m < 4; ++m) {
      const int t = col * 64 + 16 * m + 4 * fq, pos = t & (L - 1);
      const uint2 uu = *(const uint2*)(sU + col * 64 + (((2 * m + (fq >> 1)) ^ (col & 7)) * 8) + 4 * (fq & 1));
      const uint2 gv = *(const uint2*)(graw + t);
      float x[6];
      x[0] = pos == 0 ? 0.f : bf2f(graw[t - 1]);
      x[1] = bflo(gv.x); x[2] = bfhi(gv.x); x[3] = bflo(gv.y); x[4] = bfhi(gv.y);
      x[5] = (pos + 4 == L) ? 0.f : bf2f(graw[t + 4]);
      const float u4[4] = {bflo(uu.x), bfhi(uu.x), bflo(uu.y), bfhi(uu.y)};
      float o[4];
#pragma unroll
      for (int j = 0; j < 4; ++j) {
        const float gate = w0 * x[j] + w1 * x[j + 1] + w2 * x[j + 2] + b;
        o[j] = gate * (acc[m][nt][j] + skip * u4[j]);
      }
      *(uint2*)(outT + t) = make_uint2(pack2(o[0], o[1]), pack2(o[2], o[3]));
    }
  }
}

__device__ __forceinline__ void rope32(float* y  , int pos) {
  const float prow = (float)(pos >> 6), pcol = (float)(pos & 63);
  const float fr[8] = {1.f, 0.31622776601683794f, 0.1f, 0.031622776601683794f, 0.01f, 0.0031622776601683794f, 0.001f, 0.00031622776601683794f};
#pragma unroll
  for (int i = 0; i < 8; ++i) {
    const float tr = prow * fr[i] * 0.15915494309189535f, tc = pcol * fr[i] * 0.15915494309189535f;
    const float sr = sin_turns(tr), cr = cos_turns(tr), sc = sin_turns(tc), cc = cos_turns(tc);
    const float a = y[i], b = y[8 + i], c2 = y[16 + i], d2 = y[24 + i];
    y[i] = a * cr - b * sr; y[8 + i] = b * cr + a * sr;
    y[16 + i] = c2 * cc - d2 * sc; y[24 + i] = d2 * cc + c2 * sc;
  }
}
__device__ __forceinline__ void unpack8(const uint4& v, float* x) {
  x[0] = bflo(v.x); x[1] = bfhi(v.x); x[2] = bflo(v.y); x[3] = bfhi(v.y);
  x[4] = bflo(v.z); x[5] = bfhi(v.z); x[6] = bflo(v.w); x[7] = bfhi(v.w);
}
__device__ __forceinline__ float sumsq8(const uint4& v) {
  float x[8];
  unpack8(v, x);
  return x[0] * x[0] + x[1] * x[1] + x[2] * x[2] + x[3] * x[3] + x[4] * x[4] + x[5] * x[5] + x[6] * x[6] + x[7] * x[7];
}
__device__ __forceinline__ uint4 scale8(const uint4& v, float r, const float* __restrict__ g) {
  float x[8];
  unpack8(v, x);
  const float4 g0 = *(const float4*)g, g1 = *(const float4*)(g + 4);
  return make_uint4(pack2(x[0] * r * g0.x, x[1] * r * g0.y), pack2(x[2] * r * g0.z, x[3] * r * g0.w),
                    pack2(x[4] * r * g1.x, x[5] * r * g1.y), pack2(x[6] * r * g1.z, x[7] * r * g1.w));
}
__device__ __forceinline__ void qk_item(const Params& p, int item) {
  const int tid = ltid();
  if (item < 512) {
    const int idx = item * 256 + tid, row = idx >> 3, h = idx & 7;
    const bf16_t* src = (const bf16_t*)(p.ws + OFF_QRAW) + (size_t)row * 768 + h * 96;
    bf16_t* dst = (bf16_t*)(p.ws + OFF_Q) + (size_t)row * 768 + h * 96;
    uint4 raw[12];
#pragma unroll
    for (int i = 0; i < 12; ++i) raw[i] = *(const uint4*)(src + 8 * i);
    float ss = 0.f;
#pragma unroll
    for (int i = 0; i < 12; ++i) ss += sumsq8(raw[i]);
    const float r = rsqrtf(ss * (1.f / 96.f) + 1e-6f);
    const float qs = 0.10206207261596575f * 1.4426950408889634f;
#pragma unroll
    for (int i = 0; i < 8; ++i) *(uint4*)(dst + 8 * i) = scale8(raw[i], r * qs, p.g_q + 8 * i);
    float y[32];
#pragma unroll
    for (int i = 0; i < 4; ++i) unpack8(raw[8 + i], y + 8 * i);
#pragma unroll
    for (int i = 0; i < 32; ++i) y[i] = y[i] * r * p.g_q[64 + i];
    if (row >= NCTX) rope32(y, (row - NCTX) & 4095);
#pragma unroll
    for (int i = 0; i < 4; ++i)
      *(uint4*)(dst + 64 + 8 * i) = make_uint4(pack2(y[8 * i] * qs, y[8 * i + 1] * qs), pack2(y[8 * i + 2] * qs, y[8 * i + 3] * qs),
                                               pack2(y[8 * i + 4] * qs, y[8 * i + 5] * qs), pack2(y[8 * i + 6] * qs, y[8 * i + 7] * qs));
  } else {
    const int idx = (item - 512) * 256 + tid, row = idx >> 3, h = idx & 7;
    const bf16_t* src = (const bf16_t*)(p.ws + OFF_KRAW) + (size_t)row * 512 + h * 64;
    uint4 raw[8];
#pragma unroll
    for (int i = 0; i < 8; ++i) raw[i] = *(const uint4*)(src + 8 * i);
    const float* kp = row < NTOK ? (const float*)(p.ws + OFF_KPE) + (size_t)row * 32 : p.cache_kpe + (size_t)(row - NTOK) * 32;
    float y[32];
#pragma unroll
    for (int i = 0; i < 8; ++i) {
      const float4 v = *(const float4*)(kp + 4 * i);
      y[4 * i] = v.x; y[4 * i + 1] = v.y; y[4 * i + 2] = v.z; y[4 * i + 3] = v.w;
    }
    float ss = 0.f;
#pragma unroll
    for (int i = 0; i < 8; ++i) ss += sumsq8(raw[i]);
#pragma unroll
    for (int i = 0; i < 32; ++i) ss += y[i] * y[i];
    const float r = rsqrtf(ss * (1.f / 96.f) + 1e-6f);
#pragma unroll
    for (int i = 0; i < 32; ++i) y[i] = y[i] * r * p.g_k[64 + i];
    bf16_t* dst;
    if (row < NCTX) dst = (bf16_t*)(p.ws + OFF_KC) + ((size_t)((row >> 8) * 8 + h) * 256 + (row & 255)) * 96;
    else if (row < NTOK) {
      const int rr = row - NCTX;
      rope32(y, rr & 4095);
      dst = (bf16_t*)(p.ws + OFF_KL) + ((size_t)((rr >> 12) * 8 + h) * 4608 + (rr & 4095)) * 96;
    } else {
      const int rr = row - NTOK;
      dst = (bf16_t*)(p.ws + OFF_KL) + ((size_t)((rr >> 9) * 8 + h) * 4608 + 4096 + (rr & 511)) * 96;
    }
#pragma unroll
    for (int i = 0; i < 8; ++i) *(uint4*)(dst + 8 * i) = scale8(raw[i], r, p.g_k + 8 * i);
#pragma unroll
    for (int i = 0; i < 4; ++i)
      *(uint4*)(dst + 64 + 8 * i) = make_uint4(pack2(y[8 * i], y[8 * i + 1]), pack2(y[8 * i + 2], y[8 * i + 3]),
                                               pack2(y[8 * i + 4], y[8 * i + 5]), pack2(y[8 * i + 6], y[8 * i + 7]));
  }
}

__device__ __forceinline__ void attn_item(const Params& p, int item, char* smem) {
  const int tid = ltid(), lane = tid & 63, wid = tid >> 6, lr = lane & 31, lh = lane >> 5;
  int nkeys, h, tokbase; const bf16_t *Kp, *Vp;
  if (item < 512) {
    const int b = item >> 8, rem = item & 255; h = rem >> 5; const int qb = rem & 31;
    nkeys = 4608; tokbase = NCTX + b * 4096 + qb * 128;
    Kp = (const bf16_t*)(p.ws + OFF_KL) + (size_t)(b * 8 + h) * 4608 * 96;
    Vp = (const bf16_t*)(p.ws + OFF_VTL) + (size_t)(b * 8 + h) * 64 * 4608;
  } else {
    const int it = item - 512, b = it >> 4; h = (it & 15) >> 1; const int qb = it & 1;
    nkeys = 256; tokbase = b * 256 + qb * 128;
    Kp = (const bf16_t*)(p.ws + OFF_KC) + (size_t)(b * 8 + h) * 256 * 96;
    Vp = (const bf16_t*)(p.ws + OFF_VTC) + (size_t)(b * 8 + h) * 64 * 256;
  }
  bf16_t* sK = (bf16_t*)smem;
  bf16_t* sV = sK + 64 * 104;
  const int token = tokbase + 32 * wid + lr;
  bf16x8 qf[6];
  {
    const bf16_t* qsrc = (const bf16_t*)(p.ws + OFF_QRAW) + (size_t)token * 768 + h * 96 + 8 * lh;
    uint4 qr[6];
#pragma unroll
    for (int ks = 0; ks < 6; ++ks) qr[ks] = *(const uint4*)(qsrc + 16 * ks);
    float ss = 0.f;
#pragma unroll
    for (int ks = 0; ks < 6; ++ks) ss += sumsq8(qr[ks]);
    ss += __shfl_xor(ss, 32);
    const float r = rsqrtf(ss * (1.f / 96.f) + 1e-6f);
    const float qs = 0.10206207261596575f * 1.4426950408889634f;
    const bool lat = item < 512;
    const int pos = (token - NCTX) & 4095;
    const float prow = (float)(pos >> 6), pcol = (float)(pos & 63);
    const float frq[8] = {1.f, 0.31622776601683794f, 0.1f, 0.031622776601683794f, 0.01f, 0.0031622776601683794f, 0.001f, 0.00031622776601683794f};
#pragma unroll
    for (int ks = 0; ks < 6; ++ks) {
      float y[8];
      unpack8(qr[ks], y);
      const float* gq = p.g_q + 16 * ks + 8 * lh;
#pragma unroll
      for (int e = 0; e < 8; ++e) y[e] = y[e] * r * gq[e];
      if (ks >= 4) {
#pragma unroll
        for (int e = 0; e < 8; ++e) {
          const float other = __shfl_xor(y[e], 32);
          const float t = (ks == 4 ? prow : pcol) * frq[e] * 0.15915494309189535f;
          const float sn = sin_turns(t), cs = cos_turns(t);
          const float rot = y[e] * cs + (lh ? other : -other) * sn;
          y[e] = lat ? rot : y[e];
        }
      }
      union { unsigned u[4]; bf16x8 v; } pk;
      pk.u[0] = pack2(y[0] * qs, y[1] * qs); pk.u[1] = pack2(y[2] * qs, y[3] * qs); pk.u[2] = pack2(y[4] * qs, y[5] * qs); pk.u[3] = pack2(y[6] * qs, y[7] * qs);
      qf[ks] = pk.v;
    }
  }
  f32x16 oacc[2];
#pragma unroll
  for (int j = 0; j < 16; ++j) { oacc[0][j] = 0.f; oacc[1][j] = 0.f; }
  float mrun = -1e30f, lsum = 0.f;
  const int kk0 = tid / 12, kc0 = tid % 12, kk1 = (tid + 256) / 12, kc1 = (tid + 256) % 12, kk2 = (tid + 512) / 12, kc2 = (tid + 512) % 12;
  const int vd0 = tid >> 3, vc0 = tid & 7, vd1 = vd0 + 32;
  const bf16_t* gk0 = Kp + (size_t)kk0 * 96 + kc0 * 8;
  const bf16_t* gk1 = Kp + (size_t)kk1 * 96 + kc1 * 8;
  const bf16_t* gk2 = Kp + (size_t)kk2 * 96 + kc2 * 8;
  const bf16_t* gv0 = Vp + (size_t)vd0 * nkeys + vc0 * 8;
  const bf16_t* gv1 = Vp + (size_t)vd1 * nkeys + vc0 * 8;
  uint4 rk0 = *(const uint4*)gk0, rk1 = *(const uint4*)gk1, rk2 = *(const uint4*)gk2;
  uint4 rv0 = *(const uint4*)gv0, rv1 = *(const uint4*)gv1;
  const int nt = nkeys >> 6;
  for (int kt = 0; kt < nt; ++kt) {
    __syncthreads();
    *(uint4*)(sK + kk0 * 104 + kc0 * 8) = rk0; *(uint4*)(sK + kk1 * 104 + kc1 * 8) = rk1; *(uint4*)(sK + kk2 * 104 + kc2 * 8) = rk2;
    *(uint4*)(sV + vd0 * 72 + vc0 * 8) = rv0; *(uint4*)(sV + vd1 * 72 + vc0 * 8) = rv1;
    __syncthreads();
    if (kt + 1 < nt) {
      gk0 += 64 * 96; gk1 += 64 * 96; gk2 += 64 * 96; gv0 += 64; gv1 += 64;
      rk0 = *(const uint4*)gk0; rk1 = *(const uint4*)gk1; rk2 = *(const uint4*)gk2;
      rv0 = *(const uint4*)gv0; rv1 = *(const uint4*)gv1;
    }
    __builtin_amdgcn_sched_barrier(0);
    f32x16 sacc[2];
#pragma unroll
    for (int kb = 0; kb < 2; ++kb) {
#pragma unroll
      for (int j = 0; j < 16; ++j) sacc[kb][j] = 0.f;
#pragma unroll
      for (int ks = 0; ks < 6; ++ks) {
        const bf16x8 a = *(const bf16x8*)(sK + (32 * kb + lr) * 104 + 16 * ks + 8 * lh);
        sacc[kb] = __builtin_amdgcn_mfma_f32_32x32x16_bf16(a, qf[ks], sacc[kb], 0, 0, 0);
      }
    }
    float mx = sacc[0][0];
#pragma unroll
    for (int j = 1; j < 16; ++j) mx = fmaxf(mx, sacc[0][j]);
#pragma unroll
    for (int j = 0; j < 16; ++j) mx = fmaxf(mx, sacc[1][j]);
    mx = fmaxf(mx, __shfl_xor(mx, 32));
    const float mnew = fmaxf(mrun, mx);
    const float alpha = __builtin_amdgcn_exp2f(mrun - mnew);
    mrun = mnew;
    float ps = 0.f;
#pragma unroll
    for (int kb = 0; kb < 2; ++kb)
#pragma unroll
      for (int j = 0; j < 16; ++j) { const float e = __builtin_amdgcn_exp2f(sacc[kb][j] - mnew); sacc[kb][j] = e; ps += e; }
    lsum = lsum * alpha + ps;
    if (__ballot(alpha != 1.f) != 0ull) {
#pragma unroll
      for (int j = 0; j < 16; ++j) { oacc[0][j] *= alpha; oacc[1][j] *= alpha; }
    }
#pragma unroll
    for (int s = 0; s < 4; ++s) {
      const int kb = s >> 1, jb = 8 * (s & 1);
      union { unsigned u[4]; bf16x8 v; } pf;
      pf.u[0] = pack2(sacc[kb][jb + 0], sacc[kb][jb + 1]); pf.u[1] = pack2(sacc[kb][jb + 2], sacc[kb][jb + 3]);
      pf.u[2] = pack2(sacc[kb][jb + 4], sacc[kb][jb + 5]); pf.u[3] = pack2(sacc[kb][jb + 6], sacc[kb][jb + 7]);
#pragma unroll
      for (int mt = 0; mt < 2; ++mt) {
        const bf16_t* vp = sV + (32 * mt + lr) * 72 + 16 * s + 4 * lh;
        union { uint2 d[2]; bf16x8 v; } av;
        av.d[0] = *(const uint2*)vp;
        av.d[1] = *(const uint2*)(vp + 8);
        oacc[mt] = __builtin_amdgcn_mfma_f32_32x32x16_bf16(av.v, pf.v, oacc[mt], 0, 0, 0);
      }
    }
  }
  lsum += __shfl_xor(lsum, 32);
  const float inv = 1.f / lsum;
  bf16_t* dst = (bf16_t*)(p.ws + OFF_ATTN) + (size_t)token * 512 + h * 64;
#pragma unroll
  for (int mt = 0; mt < 2; ++mt)
#pragma unroll
    for (int jg = 0; jg < 4; ++jg) {
      const int dv0 = 32 * mt + 8 * jg + 4 * lh;
      *(uint2*)(dst + dv0) = make_uint2(pack2(oacc[mt][4 * jg] * inv, oacc[mt][4 * jg + 1] * inv),
                                        pack2(oacc[mt][4 * jg + 2] * inv, oacc[mt][4 * jg + 3] * inv));
    }
}

__device__ __forceinline__ void merge_item(const Params& p, int item, char* smem) {
  const int tid = ltid(), lane = tid & 63, wid = tid >> 6, t0 = item * 32;
  bf16_t* mix = (bf16_t*)(p.ws + OFF_H);
  const bf16_t* attn = (const bf16_t*)(p.ws + OFF_ATTN);
  for (int tt = 0; tt < 8; ++tt) {
    const int token = t0 + wid * 8 + tt;
    float x[8];
    unpack8(*(const uint4*)(attn + (size_t)token * 512 + lane * 8), x);
    float ss = 0.f;
#pragma unroll
    for (int i = 0; i < 8; ++i) ss += x[i] * x[i];
    ss = wave_sum(ss);
    const float r = rsqrtf(ss * (1.f / 512.f) + 1e-6f);
    const float4 g0 = *(const float4*)(p.g_out_att + lane * 8), g1 = *(const float4*)(p.g_out_att + lane * 8 + 4);
    *(uint4*)(mix + (size_t)token * D + lane * 8) =
        make_uint4(pack2(x[0] * r * g0.x, x[1] * r * g0.y), pack2(x[2] * r * g0.z, x[3] * r * g0.w),
                   pack2(x[4] * r * g1.x, x[5] * r * g1.y), pack2(x[6] * r * g1.z, x[7] * r * g1.w));
  }
  bf16_t* sT = (bf16_t*)smem;
  const bf16_t* y2T = (const bf16_t*)(p.ws + OFF_Y2T);
  __syncthreads();
  for (int ch = tid; ch < 2048; ch += 256) {
    const int c = ch >> 2, q4 = ch & 3;
    const uint4 v = *(const uint4*)(y2T + (size_t)c * NTOK + t0 + q4 * 8);
    bf16_t* d = sT + (q4 * 8) * 520 + c;
    d[0 * 520] = (bf16_t)(v.x & 0xffff); d[1 * 520] = (bf16_t)(v.x >> 16);
    d[2 * 520] = (bf16_t)(v.y & 0xffff); d[3 * 520] = (bf16_t)(v.y >> 16);
    d[4 * 520] = (bf16_t)(v.z & 0xffff); d[5 * 520] = (bf16_t)(v.z >> 16);
    d[6 * 520] = (bf16_t)(v.w & 0xffff); d[7 * 520] = (bf16_t)(v.w >> 16);
  }
  __syncthreads();
  {
    const int tt = tid >> 3, part = tid & 7;
    uint4 v[8];
    float ss = 0.f;
#pragma unroll
    for (int i = 0; i < 8; ++i) {
      v[i] = *(const uint4*)(sT + tt * 520 + part * 64 + 8 * i);
      float x[8];
      unpack8(v[i], x);
#pragma unroll
      for (int e = 0; e < 8; ++e) ss += x[e] * x[e];
    }
    ss += __shfl_xor(ss, 1); ss += __shfl_xor(ss, 2); ss += __shfl_xor(ss, 4);
    const float r = rsqrtf(ss * (1.f / 512.f) + 1e-6f);
#pragma unroll
    for (int i = 0; i < 8; ++i) {
      float x[8];
      unpack8(v[i], x);
      const int c0 = part * 64 + 8 * i;
      const float4 g0 = *(const float4*)(p.g_out_hy + c0), g1 = *(const float4*)(p.g_out_hy + c0 + 4);
      *(uint4*)(mix + (size_t)(t0 + tt) * D + 512 + c0) =
          make_uint4(pack2(x[0] * r * g0.x, x[1] * r * g0.y), pack2(x[2] * r * g0.z, x[3] * r * g0.w),
                     pack2(x[4] * r * g1.x, x[5] * r * g1.y), pack2(x[6] * r * g1.z, x[7] * r * g1.w));
    }
  }
}

__device__ __forceinline__ void actfix_item(const Params& p, int item) {
  const int idx = item * 256 + ltid();
  if (idx >= 512 * 352) return;
  const int j = (idx % 352) * 8, rowi = idx / 352, wt = rowi >> 1, which = rowi & 1;
  const int t = 64 * wt + 63 * which, L = t < NCTX ? SEQC : SEQL, pos = t & (L - 1);
  const bf16_t* edge = (const bf16_t*)(p.ws + OFF_EDGE);
  bf16_t* act = (bf16_t*)(p.ws + OFF_U);
  const bf16_t *pr, *cu, *nx;
  bool zp = false, zn = false;
  if (which == 0) { zp = pos == 0; pr = edge + (size_t)((zp ? wt : wt - 1) * 4 + 3) * 5632; cu = edge + (size_t)(wt * 4 + 0) * 5632; nx = edge + (size_t)(wt * 4 + 1) * 5632; }
  else { zn = pos == L - 1; pr = edge + (size_t)(wt * 4 + 2) * 5632; cu = edge + (size_t)(wt * 4 + 3) * 5632; nx = edge + (size_t)((zn ? wt : wt + 1) * 4 + 0) * 5632; }
  float pa[8], pg[8], ca[8], cgv[8], na[8], ng[8];
  unpack8(*(const uint4*)(pr + j), pa); unpack8(*(const uint4*)(pr + 2816 + j), pg);
  unpack8(*(const uint4*)(cu + j), ca); unpack8(*(const uint4*)(cu + 2816 + j), cgv);
  unpack8(*(const uint4*)(nx + j), na); unpack8(*(const uint4*)(nx + 2816 + j), ng);
  float o[8];
#pragma unroll
  for (int e = 0; e < 8; ++e) {
    const float pae = zp ? 0.f : pa[e], pge = zp ? 0.f : pg[e], nae = zn ? 0.f : na[e], nge = zn ? 0.f : ng[e];
    const float a = p.ffn_conv_w[j + e] * pae + p.ffn_conv_w[5632 + j + e] * ca[e] + p.ffn_conv_w[11264 + j + e] * nae + p.ffn_conv_b[j + e];
    const float g = p.ffn_conv_w[2816 + j + e] * pge + p.ffn_conv_w[5632 + 2816 + j + e] * cgv[e] + p.ffn_conv_w[11264 + 2816 + j + e] * nge + p.ffn_conv_b[2816 + j + e];
    o[e] = a * __builtin_amdgcn_rcpf(1.f + __expf(-a)) * g;
  }
  *(uint4*)(act + (size_t)t * 2816 + j) = make_uint4(pack2(o[0], o[1]), pack2(o[2], o[3]), pack2(o[4], o[5]), pack2(o[6], o[7]));
}

#define XB_TMO      128
#define XB_XCNT(j)  (256  + 64 * (j))
#define XB_XSUB(j)  (1280 + 64 * (j))
#define XB_XGEN(j)  (2304 + 64 * (j))
#define XB_TOP      3328
#define XB_TOPGEN   3392
#define XCD_BAR_WORDS 3456
#define XB_SPIN_CAP (1u << 20)
#define LAS __attribute__((address_space(3)))
__device__ __forceinline__ unsigned xb_ld(unsigned* p) { return __hip_atomic_load(p, __ATOMIC_RELAXED, __HIP_MEMORY_SCOPE_AGENT); }
__device__ __forceinline__ unsigned xb_add(unsigned* p, unsigned v) { return __hip_atomic_fetch_add(p, v, __ATOMIC_RELAXED, __HIP_MEMORY_SCOPE_AGENT); }
__device__ __forceinline__ unsigned xb_xcc_id() { return (unsigned)__builtin_amdgcn_s_getreg((3 << 11) | 20) & 0xFu; }
#define XB_SPIN(cond, bar) do { unsigned _sp = 0; while (cond) { __builtin_amdgcn_s_sleep(1); \
    if ((++_sp & 255u) == 0u) { if (xb_ld(&(bar)[XB_TMO])) break; if (_sp > XB_SPIN_CAP) { atomicAdd(&(bar)[XB_TMO], 1u); break; } } } } while (0)
struct XcdBarrier { unsigned* bar; unsigned x; volatile LAS unsigned* st; };
__device__ __forceinline__ XcdBarrier xcd_barrier_post(unsigned* bar, volatile LAS unsigned* st) {
  XcdBarrier b; b.bar = bar; b.x = xb_xcc_id(); b.st = st;
  if (threadIdx.x == 0) (void)xb_add(&bar[XB_XCNT(b.x)], 1u);
  return b;
}
__device__ __forceinline__ void xcd_barrier_complete(unsigned* bar, unsigned x, unsigned& nloc, unsigned& nx) {
  const unsigned G = gridDim.x * gridDim.y * gridDim.z;
  unsigned sum, cnt, mine, sp = 0u;
  for (;;) {
    sum = 0u; cnt = 0u; mine = 0u;
#pragma unroll
    for (unsigned j = 0; j < 16; ++j) { const unsigned c = xb_ld(&bar[XB_XCNT(j)]); sum += c; cnt += (c > 0u) ? 1u : 0u; mine = (j == x) ? c : mine; }
    if (sum == G) break;
    __builtin_amdgcn_s_sleep(1);
    if ((++sp & 255u) == 0u) { if (xb_ld(&bar[XB_TMO])) break; if (sp > XB_SPIN_CAP) { atomicAdd(&bar[XB_TMO], 1u); break; } }
  }
  nloc = mine > 0u ? mine : 1u; nx = cnt > 0u ? cnt : 1u;
}
__device__ __forceinline__ void xcd_barrier(const XcdBarrier& b) {
  asm volatile("s_waitcnt vmcnt(0)" ::: "memory");
  __syncthreads();
  if (threadIdx.x == 0) {
    unsigned* bar = b.bar;
    __builtin_amdgcn_s_waitcnt(0);
    unsigned nloc = b.st[0], nx = b.st[1];
    if (nloc == 0u) { xcd_barrier_complete(bar, b.x, nloc, nx); b.st[0] = nloc; b.st[1] = nx; }
    const unsigned old = xb_add(&bar[XB_XSUB(b.x)], 1u);
    const unsigned gen = old / nloc;
    if (old + 1u == (gen + 1u) * nloc) {
      __builtin_amdgcn_fence(__ATOMIC_RELEASE, "agent");
      asm volatile("s_waitcnt vmcnt(0)" ::: "memory");
      const unsigned og = xb_add(&bar[XB_TOP], 1u);
      const unsigned tg = og / nx;
      if (og + 1u == (tg + 1u) * nx) xb_add(&bar[XB_TOPGEN], 1u);
      else XB_SPIN(xb_ld(&bar[XB_TOPGEN]) == tg, bar);
      __builtin_amdgcn_fence(__ATOMIC_ACQUIRE, "agent");
      xb_add(&bar[XB_XGEN(b.x)], 1u);
      asm volatile("s_waitcnt vmcnt(0)" ::: "memory");
    } else {
      XB_SPIN(xb_ld(&bar[XB_XGEN(b.x)]) == gen, bar);
      __builtin_amdgcn_fence(__ATOMIC_ACQUIRE, "agent");
      asm volatile("s_waitcnt vmcnt(0)" ::: "memory");
    }
  }
  __syncthreads();
}
constexpr size_t OFF_BAR = 25 * MiB - 16384;
static_assert(OFF_MOD + 3 * 6144 * 4 <= OFF_BAR, "bar");

template <int ph>
__device__ __forceinline__ void run_phase(const Params& p, char* smem) {
  const int bid = blockIdx.x, G = gridDim.x;
  char* ws = p.ws;
  if constexpr (ph == 0) {
    for (int it = bid; it < 272 + 96 + 32 + 3080; it += G) {
      if (it < 272) filter_item(p, it, smem);
      else if (it < 368) mod_item(p, it - 272, smem);
      else if (it < 400) cache_item(p, it - 368);
      else {
        int t = it - 400;
        if (t < 576) transpose_item(p.w_in, 1024, DIN, (bf16_t*)(ws + OFF_WIN), t, 36, smem);
        else if ((t -= 576) < 72) transpose_item(p.w_uq, 384, 768, (bf16_t*)(ws + OFF_WUQ), t, 12, smem);
        else if ((t -= 72) < 64) transpose_item(p.w_ukv, 256, 1024, (bf16_t*)(ws + OFF_WUKV), t, 16, smem);
        else if ((t -= 64) < 256) transpose_item(p.w_out, 1024, 1024, (bf16_t*)(ws + OFF_WOUT), t, 16, smem);
        else if ((t -= 256) < 1408) transpose_item(p.w_up, 1024, 5632, (bf16_t*)(ws + OFF_WUP), t, 88, smem, true);
        else { t -= 1408; transpose_item(p.w_down, 2816, 1024, (bf16_t*)(ws + OFF_WDOWN), t, 16, smem); }
      }
    }
  } else if constexpr (ph == 1) {
    rmsmod_phase<0>(p);
  } else if constexpr (ph == 2) {
    EpiIn epi{(float*)(ws + OFF_PROJ), (bf16_t*)(ws + OFF_HYT)};
    EpiProj epr{(float*)(ws + OFF_PROJ)};
    for (int t = bid; t < 128 * 18; t += G) {
      const int nt = t % 18;
      if (nt < 5) gemm_tile<true>((const bf16_t*)(ws + OFF_H), 1024, (const bf16_t*)(ws + OFF_WIN), 1024, 1024, (t / 18) * 128, nt * 128, smem, epr);
      else gemm_tile<false>((const bf16_t*)(ws + OFF_H), 1024, (const bf16_t*)(ws + OFF_WIN), 1024, 1024, (t / 18) * 128, nt * 128, smem, epi);
    }
  } else if constexpr (ph == 3) {
    for (int it = bid; it < 512; it += G) hyena_item<0>(p, 1, it, smem);
    for (int it = bid; it < 512; it += G) hyena_item<0>(p, 0, it, smem);
    for (int it = G - 1 - bid; it < 512; it += G) token_item(p, it);
  } else if constexpr (ph == 4) {
    EpiQ eq{(bf16_t*)(ws + OFF_QRAW)};
    EpiKV ekv{(bf16_t*)(ws + OFF_KRAW), (bf16_t*)(ws + OFF_VTC), (bf16_t*)(ws + OFF_VTL)};
    for (int it = bid; it < 512; it += G) hyena_item<1>(p, 1, it, smem);
    for (int t = bid; t < 768; t += G) gemm_tile<true>((const bf16_t*)(ws + OFF_QA), 384, (const bf16_t*)(ws + OFF_WUQ), 384, 384, (t / 6) * 128, (t % 6) * 128, smem, eq);
    for (int t = bid; t < 1088; t += G) gemm_tile<false>((const bf16_t*)(ws + OFF_CKVN), 256, (const bf16_t*)(ws + OFF_WUKV), 256, 256, (t / 8) * 128, (t % 8) * 128, smem, ekv);
    for (int it = bid; it < 512; it += G) hyena_item<1>(p, 0, it, smem);
  } else if constexpr (ph == 5) {
    for (int it = bid; it < 544; it += G) qk_item(p, 512 + it);
  } else if constexpr (ph == 6) {
    for (int it = bid; it < 1024; it += G) attn_item(p, it, smem);
  } else if constexpr (ph == 7) {
    for (int it = bid; it < 512; it += G) merge_item(p, it, smem);
  } else if constexpr (ph == 8) {
    EpiOut epi{&p};
    if (G == 512) {
      const int x = bid & 7, j = bid >> 3;
      for (int r = 0; r < 2; ++r)
        gemm_tile<true>((const bf16_t*)(ws + OFF_H), 1024, (const bf16_t*)(ws + OFF_WOUT), 1024, 1024, (x * 16 + r * 8 + (j >> 3)) * 128, (j & 7) * 128, smem, epi);
    } else {
      for (int t = bid; t < 128 * 8; t += G)
        gemm_tile<true>((const bf16_t*)(ws + OFF_H), 1024, (const bf16_t*)(ws + OFF_WOUT), 1024, 1024, (t / 8) * 128, (t % 8) * 128, smem, epi);
    }
  } else if constexpr (ph == 9) {
    rmsmod_phase<1>(p);
  } else if constexpr (ph == 10) {
    for (int t = bid; t < 128 * 44; t += G) gemm_up_act_tile(p, (t / 44) * 128, (t % 44) * 128, smem);
  } else if constexpr (ph == 11) {
    for (int it = bid; it < 704; it += G) actfix_item(p, it);
  } else if constexpr (ph == 12) {
    EpiY epi{&p, 0};
    if (G == 512) {
      const int x = bid & 7, j = bid >> 3;
      for (int r = 0; r < 2; ++r)
        gemm_tile<true>((const bf16_t*)(ws + OFF_U), 2816, (const bf16_t*)(ws + OFF_WDOWN), 2816, 2816, (x * 16 + r * 8 + (j >> 3)) * 128, (j & 7) * 128, smem, epi);
    } else {
      for (int t = bid; t < 128 * 8; t += G)
        gemm_tile<true>((const bf16_t*)(ws + OFF_U), 2816, (const bf16_t*)(ws + OFF_WDOWN), 2816, 2816, (t / 8) * 128, (t % 8) * 128, smem, epi);
    }
  }
}

#if ONE_LAUNCH
template <int PH>
__device__ __forceinline__ void run_all(const Params& p, char* smem, cg::grid_group& grid, const XcdBarrier& xb) {
  run_phase<PH>(p, smem);
  if constexpr (((DBL_MASK >> PH) & 1) != 0) { xcd_barrier(xb); run_phase<PH>(p, smem); }
  if constexpr (PH < 12) {
    xcd_barrier(xb);
    run_all<PH + 1>(p, smem, grid, xb);
  }
}
constexpr int DYN_LDS = 65536 + 64;
__global__ void __launch_bounds__(256, 2) mega_kernel(Params p) {
  extern __shared__ __attribute__((aligned(16))) char smem[];
  uint4* xb_words = (uint4*)(smem + 65536);
  cg::grid_group grid = cg::this_grid();
  if (threadIdx.x == 0) *xb_words = make_uint4(0u, 0u, 0u, 0u);
  __syncthreads();
  XcdBarrier xb = xcd_barrier_post((unsigned*)(p.ws + OFF_BAR), (volatile LAS unsigned*)xb_words);
  if (p.ws == nullptr) grid.sync();
  run_all<0>(p, smem, grid, xb);
}
#else
template <int PH>
__global__ void __launch_bounds__(256, 2) phase_kernel(Params p) {
  __shared__ __attribute__((aligned(16))) char smem[SMEM_BYTES];
  run_phase<PH>(p, smem);
}
#ifndef DBG_STOP
#define DBG_STOP 15
#endif
__global__ void dump_kernel(Params p, size_t off, int count) {
  const bf16_t* src = (const bf16_t*)(p.ws + off);
  const bf16_t* src2 = (const bf16_t*)(p.ws + DBG_OFF2);
  for (int i = blockIdx.x * 256 + threadIdx.x; i < 16777216; i += gridDim.x * 256)
    p.out[i] = i < DBG_CNT ? bf2f(src[i]) : (i - DBG_CNT < DBG_CNT2 ? bf2f(src2[i - DBG_CNT]) : 0.f);
}
template <int PH>
static void launch_all(const Params& p, hipStream_t stream) {
  phase_kernel<PH><<<512, 256, 0, stream>>>(p);
  if constexpr (PH < 12) launch_all<PH + 1>(p, stream);
}
#endif

extern "C" void kernel_launch(void* const* d_in, const int* in_sizes, int n_in, void* d_out, int out_size, void* d_ws,
                              size_t ws_size, hipStream_t stream) {
  Params p{};
  const float** pp = (const float**)&p;
  for (int i = 0; i < 34; ++i) pp[i] = (const float*)d_in[i];
  p.out = (float*)d_out;
  p.ws = (char*)d_ws;
#if ONE_LAUNCH
  (void)hipMemsetAsync((char*)d_ws + OFF_BAR, 0, XCD_BAR_WORDS * 4, stream);
  static int grid_blocks = 0;
  if (!grid_blocks) {
    int dev = 0, cus = 0, per_cu = 0;
    hipGetDevice(&dev);
    hipDeviceGetAttribute(&cus, hipDeviceAttributeMultiprocessorCount, dev);
    (void)hipFuncSetAttribute((const void*)mega_kernel, hipFuncAttributeMaxDynamicSharedMemorySize, DYN_LDS);
    (void)hipOccupancyMaxActiveBlocksPerMultiprocessor(&per_cu, mega_kernel, 256, DYN_LDS);
    if (per_cu > 2) per_cu = 2;
    grid_blocks = cus * per_cu;
  }
  void* args[] = {&p};
  hipError_t e = hipLaunchCooperativeKernel((void*)mega_kernel, dim3(grid_blocks), dim3(256), args, DYN_LDS, stream);
  if (e != hipSuccess) fprintf(stderr, "cooperative launch failed: %s (grid %d)\n", hipGetErrorString(e), grid_blocks);
#else
  launch_all<0>(p, stream);
#if DBG_STOP < 15
  dump_kernel<<<1024, 256, 0, stream>>>(p, DBG_OFF, DBG_CNT);
#endif
#endif
}
```

```cpp
#include <hip/hip_runtime.h>
#include <hip/hip_cooperative_groups.h>
#include <cstdio>
namespace cg = cooperative_groups;

#define DBG_STOP 15
#define DBG_NOHY 0
#ifndef DBL_MASK
#define DBL_MASK 0
#endif
#define DBG_OFF OFF_QRAW
#define DBG_OFF2 OFF_KRAW
#define DBG_CNT 12582912
#define DBG_CNT2 0
#ifndef ONE_LAUNCH
#define ONE_LAUNCH 1
#endif

typedef unsigned short bf16_t;
typedef short bf16x8 __attribute__((ext_vector_type(8)));
typedef float f32x4 __attribute__((ext_vector_type(4)));
typedef float f32x16 __attribute__((ext_vector_type(16)));

constexpr int D = 1024, NTOK = 16384, NCTX = 8192, SEQC = 256, SEQL = 4096;
constexpr int DIN = 2208, DINP = 2304, QL = 384, KVL = 256, DFF = 2816;
constexpr int NROWKV = 17408;
constexpr size_t MiB = 1048576;

constexpr size_t OFF_WIN = 0;
constexpr size_t OFF_WUQ = OFF_WIN + (size_t)DINP * 1024 * 2;
constexpr size_t OFF_WUKV = OFF_WUQ + (size_t)768 * 384 * 2;
constexpr size_t OFF_WOUT = OFF_WUKV + (size_t)1024 * 256 * 2;
constexpr size_t OFF_WUP = OFF_WOUT + (size_t)1024 * 1024 * 2;
constexpr size_t OFF_WDOWN = OFF_WUP + (size_t)5632 * 1024 * 2;
constexpr size_t OFF_MOD = OFF_WDOWN + (size_t)1024 * 2816 * 2;
static_assert(OFF_MOD + 3 * 6144 * 4 <= 25 * MiB, "A region");
constexpr size_t OFF_RLAT = 25 * MiB;
constexpr size_t OFF_RCTX = 41 * MiB;
constexpr size_t OFF_H = 42 * MiB;
constexpr size_t OFF_ZT = 42 * MiB;
constexpr size_t OFF_QA = 58 * MiB;
constexpr size_t OFF_KPE = 70 * MiB;
constexpr size_t OFF_PROJ = 74 * MiB;
constexpr size_t OFF_QRAW = 74 * MiB;
constexpr size_t OFF_Y2T = 98 * MiB;
constexpr size_t OFF_ATTN = 116 * MiB;
constexpr size_t OFF_U = 74 * MiB;
constexpr size_t OFF_HYT = 116 * MiB;
constexpr size_t OFF_Q = 116 * MiB;
constexpr size_t OFF_KC = 140 * MiB;
constexpr size_t OFF_KL = 152 * MiB;
constexpr size_t OFF_CKVN = 164 * MiB;
constexpr size_t OFF_KRAW = 173 * MiB;
constexpr size_t OFF_VTC = 190 * MiB;
constexpr size_t OFF_VTL = 198 * MiB;
constexpr size_t OFF_ACT = 162 * MiB;

constexpr int OUT_YS = 0;
constexpr int OUT_CKV = 16777216;
constexpr int OUT_KPE = 16777216 + 2097152;

constexpr int SMEM_BYTES = 51200;

struct Params {
  const float *x_prompt, *x_sample, *cache_ckv, *cache_kpe, *c, *c_ctx, *w_ada, *b_ada, *g_mix, *w_in, *g_qa, *w_uq,
      *g_kva, *w_ukv, *g_q, *g_k, *hy_conv_w, *hy_conv_b, *filt_w1, *filt_b1, *filt_freq1, *filt_w2, *filt_b2,
      *filt_freq2, *filt_w3, *filt_bias, *g_out_att, *g_out_hy, *w_out, *g_ffn, *w_up, *ffn_conv_w, *ffn_conv_b, *w_down;
  float* out;
  char* ws;
};

typedef __bf16 bf16x2_t __attribute__((ext_vector_type(2)));
__device__ __forceinline__ unsigned pack2(float lo, float hi) {
  bf16x2_t v;
  v[0] = (__bf16)lo;
  v[1] = (__bf16)hi;
  return __builtin_bit_cast(unsigned, v);
}
__device__ __forceinline__ float bflo(unsigned u) { return __uint_as_float(u << 16); }
__device__ __forceinline__ float bfhi(unsigned u) { return __uint_as_float(u & 0xffff0000u); }
__device__ __forceinline__ float bf2f(bf16_t h) { return __uint_as_float(((unsigned)h) << 16); }
__device__ __forceinline__ bf16_t f2bf(float f) { return (bf16_t)(pack2(f, 0.f) & 0xffffu); }
__device__ __forceinline__ float wave_sum(float v) {
#pragma unroll
  for (int o = 32; o >= 1; o >>= 1) v += __shfl_xor(v, o);
  return v;
}
__device__ __forceinline__ int ltid() { int t = threadIdx.x; asm volatile("" : "+v"(t)); return t; }
__device__ __forceinline__ float sin_turns(float t) { t -= floorf(t); return __builtin_amdgcn_sinf(t); }
__device__ __forceinline__ float cos_turns(float t) { t -= floorf(t); return __builtin_amdgcn_cosf(t); }
__device__ __forceinline__ float sin_rad(float x) { return sin_turns(x * 0.15915494309189535f); }
__device__ __forceinline__ const float* xrow(const Params& p, int row) {
  return row < NCTX ? p.x_prompt + (size_t)row * D : p.x_sample + (size_t)(row - NCTX) * D;
}
__device__ __forceinline__ int modidx(int row) { return row < NCTX ? 0 : 1 + ((row - NCTX) >> 12); }

template <bool SWAP>
__device__ __forceinline__ void gemm_main(const bf16_t* __restrict__ A, int lda, const bf16_t* __restrict__ Bt, int ldb,
                                          int K, int m0, int n0, char* smem, f32x4 (&acc)[4][4]) {
  const int tid = ltid(), lane = tid & 63, wid = tid >> 6, wr = wid >> 1, wc = wid & 1;
  const int fr = lane & 15, fq = lane >> 4;
  bf16_t* sbase = (bf16_t*)smem;
#pragma unroll
  for (int m = 0; m < 4; ++m)
#pragma unroll
    for (int n = 0; n < 4; ++n) acc[m][n] = (f32x4){0.f, 0.f, 0.f, 0.f};
  const int lr = tid >> 3, lc = (tid & 7) * 8;
  const bf16_t* ga = A + (size_t)(m0 + lr) * lda + lc;
  const bf16_t* gb = Bt + (size_t)(n0 + lr) * ldb + lc;
  const size_t sa32 = (size_t)32 * lda, sb32 = (size_t)32 * ldb;
  uint4 ra0 = *(const uint4*)(ga), ra1 = *(const uint4*)(ga + sa32), ra2 = *(const uint4*)(ga + 2 * sa32), ra3 = *(const uint4*)(ga + 3 * sa32);
  uint4 rb0 = *(const uint4*)(gb), rb1 = *(const uint4*)(gb + sb32), rb2 = *(const uint4*)(gb + 2 * sb32), rb3 = *(const uint4*)(gb + 3 * sb32);
  const int nk = K >> 6;
  const int woff = lr * 64 + (((tid & 7) ^ (lr & 7)) * 8);
  const int aoff = (wr * 64 + fr) * 64, boff = 8192 + (wc * 64 + fr) * 64;
  __syncthreads();
  {
    bf16_t* wa = sbase + woff;
    *(uint4*)(wa) = ra0; *(uint4*)(wa + 32 * 64) = ra1; *(uint4*)(wa + 64 * 64) = ra2; *(uint4*)(wa + 96 * 64) = ra3;
    *(uint4*)(wa + 8192) = rb0; *(uint4*)(wa + 8192 + 32 * 64) = rb1; *(uint4*)(wa + 8192 + 64 * 64) = rb2; *(uint4*)(wa + 8192 + 96 * 64) = rb3;
  }
  if (nk > 1) {
    ga += 64; gb += 64;
    ra0 = *(const uint4*)(ga); ra1 = *(const uint4*)(ga + sa32); ra2 = *(const uint4*)(ga + 2 * sa32); ra3 = *(const uint4*)(ga + 3 * sa32);
    rb0 = *(const uint4*)(gb); rb1 = *(const uint4*)(gb + sb32); rb2 = *(const uint4*)(gb + 2 * sb32); rb3 = *(const uint4*)(gb + 3 * sb32);
  }
  __syncthreads();
  for (int kt = 0; kt < nk; ++kt) {
    const bf16_t* cur = sbase + (kt & 1) * 16384;
    bf16x8 af[2][4], bfr[2][4];
#pragma unroll
    for (int ks = 0; ks < 2; ++ks) {
#pragma unroll
      for (int m = 0; m < 4; ++m) af[ks][m] = *(const bf16x8*)(cur + aoff + m * 16 * 64 + (((ks * 4 + fq) ^ (fr & 7)) * 8));
#pragma unroll
      for (int n = 0; n < 4; ++n) bfr[ks][n] = *(const bf16x8*)(cur + boff + n * 16 * 64 + (((ks * 4 + fq) ^ (fr & 7)) * 8));
    }
    __builtin_amdgcn_sched_barrier(0);
    {
      bf16_t* wa = sbase + ((kt + 1) & 1) * 16384 + woff;
      *(uint4*)(wa) = ra0; *(uint4*)(wa + 32 * 64) = ra1; *(uint4*)(wa + 64 * 64) = ra2; *(uint4*)(wa + 96 * 64) = ra3;
      *(uint4*)(wa + 8192) = rb0; *(uint4*)(wa + 8192 + 32 * 64) = rb1; *(uint4*)(wa + 8192 + 64 * 64) = rb2; *(uint4*)(wa + 8192 + 96 * 64) = rb3;
      const int adv = (kt + 2 < nk) ? 64 : 0;
      ga += adv; gb += adv;
      ra0 = *(const uint4*)(ga); ra1 = *(const uint4*)(ga + sa32); ra2 = *(const uint4*)(ga + 2 * sa32); ra3 = *(const uint4*)(ga + 3 * sa32);
      rb0 = *(const uint4*)(gb); rb1 = *(const uint4*)(gb + sb32); rb2 = *(const uint4*)(gb + 2 * sb32); rb3 = *(const uint4*)(gb + 3 * sb32);
    }
#pragma unroll
    for (int ks = 0; ks < 2; ++ks)
#pragma unroll
      for (int m = 0; m < 4; ++m)
#pragma unroll
        for (int n = 0; n < 4; ++n) {
          if (SWAP) acc[m][n] = __builtin_amdgcn_mfma_f32_16x16x32_bf16(bfr[ks][n], af[ks][m], acc[m][n], 0, 0, 0);
          else acc[m][n] = __builtin_amdgcn_mfma_f32_16x16x32_bf16(af[ks][m], bfr[ks][n], acc[m][n], 0, 0, 0);
        }
#pragma unroll
    for (int i = 0; i < 8; ++i) { __builtin_amdgcn_sched_group_barrier(0x008, 2, 0); __builtin_amdgcn_sched_group_barrier(0x200, 1, 0); }
#pragma unroll
    for (int i = 0; i < 8; ++i) { __builtin_amdgcn_sched_group_barrier(0x008, 2, 0); __builtin_amdgcn_sched_group_barrier(0x020, 1, 0); }
    __builtin_amdgcn_sched_barrier(0);
    if (kt + 1 < nk) __syncthreads();
  }
}
template <bool SWAP, class Epi>
__device__ __forceinline__ void gemm_tile(const bf16_t* __restrict__ A, int lda, const bf16_t* __restrict__ Bt, int ldb,
                                          int K, int m0, int n0, char* smem, const Epi& epi) {
  f32x4 acc[4][4];
  gemm_main<SWAP>(A, lda, Bt, ldb, K, m0, n0, smem, acc);
  const int tid = ltid(), lane = tid & 63, wid = tid >> 6, wr = wid >> 1, wc = wid & 1;
  const int fr = lane & 15, fq = lane >> 4;
#pragma unroll
  for (int m = 0; m < 4; ++m)
#pragma unroll
    for (int n = 0; n < 4; ++n) {
      if (SWAP) epi(m0 + wr * 64 + m * 16 + fr, n0 + wc * 64 + n * 16 + fq * 4, acc[m][n]);
      else epi(m0 + wr * 64 + m * 16 + fq * 4, n0 + wc * 64 + n * 16 + fr, acc[m][n]);
    }
}

template <int CTRL>
__device__ __forceinline__ float dpp_ror(float v) {
  return __int_as_float(__builtin_amdgcn_update_dpp(0, __float_as_int(v), CTRL, 0xF, 0xF, false));
}
constexpr size_t OFF_EDGE = 162 * MiB;
__device__ __forceinline__ void gemm_up_act_tile(const Params& p, int m0, int n0, char* smem) {
  f32x4 acc[4][4];
  gemm_main<true>((const bf16_t*)(p.ws + OFF_H), 1024, (const bf16_t*)(p.ws + OFF_WUP), 1024, 1024, m0, n0, smem, acc);
  const int tid = ltid(), lane = tid & 63, wid = tid >> 6, wr = wid >> 1, wc = wid & 1;
  const int fr = lane & 15, fq = lane >> 4;
  bf16_t* act = (bf16_t*)(p.ws + OFF_U);
  bf16_t* edge = (bf16_t*)(p.ws + OFF_EDGE);
  const int rowbase = m0 + wr * 64, wt = rowbase >> 6;
#pragma unroll
  for (int i = 0; i < 2; ++i) {
    const int cperm = n0 + wc * 64 + 32 * i;
    const int j0 = (cperm >> 5) * 16 + 4 * fq;
    const float4 wa0 = *(const float4*)(p.ffn_conv_w + j0), wa1 = *(const float4*)(p.ffn_conv_w + 5632 + j0), wa2 = *(const float4*)(p.ffn_conv_w + 11264 + j0);
    const float4 wg0 = *(const float4*)(p.ffn_conv_w + 2816 + j0), wg1 = *(const float4*)(p.ffn_conv_w + 5632 + 2816 + j0), wg2 = *(const float4*)(p.ffn_conv_w + 11264 + 2816 + j0);
    const float4 ba = *(const float4*)(p.ffn_conv_b + j0), bg = *(const float4*)(p.ffn_conv_b + 2816 + j0);
    const float w0a[4] = {wa0.x, wa0.y, wa0.z, wa0.w}, w1a[4] = {wa1.x, wa1.y, wa1.z, wa1.w}, w2a[4] = {wa2.x, wa2.y, wa2.z, wa2.w};
    const float w0g[4] = {wg0.x, wg0.y, wg0.z, wg0.w}, w1g[4] = {wg1.x, wg1.y, wg1.z, wg1.w}, w2g[4] = {wg2.x, wg2.y, wg2.z, wg2.w};
    const float bba[4] = {ba.x, ba.y, ba.z, ba.w}, bbg[4] = {bg.x, bg.y, bg.z, bg.w};
#pragma unroll
    for (int m = 0; m < 4; ++m) {
      float o[4];
#pragma unroll
      for (int e = 0; e < 4; ++e) {
        const float a = acc[m][2 * i][e], g = acc[m][2 * i + 1][e];
        const float au1 = dpp_ror<0x121>(a), gu1 = dpp_ror<0x121>(g), ad1 = dpp_ror<0x12F>(a), gd1 = dpp_ror<0x12F>(g);
        float au2 = 0.f, gu2 = 0.f, ad2 = 0.f, gd2 = 0.f;
        if (m > 0) { au2 = dpp_ror<0x121>(acc[m - 1][2 * i][e]); gu2 = dpp_ror<0x121>(acc[m - 1][2 * i + 1][e]); }
        if (m < 3) { ad2 = dpp_ror<0x12F>(acc[m + 1][2 * i][e]); gd2 = dpp_ror<0x12F>(acc[m + 1][2 * i + 1][e]); }
        const float au = fr > 0 ? au1 : au2, gu = fr > 0 ? gu1 : gu2, ad = fr < 15 ? ad1 : ad2, gd = fr < 15 ? gd1 : gd2;
        const float ca = w0a[e] * au + w1a[e] * a + w2a[e] * ad + bba[e];
        const float cgv = w0g[e] * gu + w1g[e] * g + w2g[e] * gd + bbg[e];
        o[e] = ca * __builtin_amdgcn_rcpf(1.f + __expf(-ca)) * cgv;
      }
      const int lr64 = m * 16 + fr, row = rowbase + lr64;
      if (lr64 >= 1 && lr64 <= 62) *(uint2*)(act + (size_t)row * 2816 + j0) = make_uint2(pack2(o[0], o[1]), pack2(o[2], o[3]));
      if (lr64 <= 1 || lr64 >= 62) {
        const int slot = lr64 <= 1 ? lr64 : lr64 - 60;
        bf16_t* er = edge + (size_t)(wt * 4 + slot) * 5632;
        *(uint2*)(er + j0) = make_uint2(pack2(acc[m][2 * i][0], acc[m][2 * i][1]), pack2(acc[m][2 * i][2], acc[m][2 * i][3]));
        *(uint2*)(er + 2816 + j0) = make_uint2(pack2(acc[m][2 * i + 1][0], acc[m][2 * i + 1][1]), pack2(acc[m][2 * i + 1][2], acc[m][2 * i + 1][3]));
      }
    }
  }
}

__device__ __forceinline__ void transpose_item(const float* __restrict__ W, int K, int N, bf16_t* __restrict__ WT, int tile, int ntn, char* smem, bool perm = false) {
  float* s = (float*)smem;
  const int tk = tile / ntn, tn = tile % ntn, tid = ltid();
  const int k0 = tk * 64, n0 = tn * 64;
  __syncthreads();
  {
    const int r = tid >> 4, c4 = (tid & 15) * 4;
#pragma unroll
    for (int i = 0; i < 4; ++i) {
      const int k = r + 16 * i;
      float4 v = make_float4(0.f, 0.f, 0.f, 0.f);
      if (n0 + c4 < N) v = *(const float4*)(W + (size_t)(k0 + k) * N + n0 + c4);
      s[k * 65 + c4 + 0] = v.x; s[k * 65 + c4 + 1] = v.y; s[k * 65 + c4 + 2] = v.z; s[k * 65 + c4 + 3] = v.w;
    }
  }
  __syncthreads();
  {
    const int n = tid >> 2, kc = (tid & 3) * 16;
    unsigned o[8];
#pragma unroll
    for (int i = 0; i < 8; ++i) o[i] = pack2(s[(kc + 2 * i) * 65 + n], s[(kc + 2 * i + 1) * 65 + n]);
    int nr = n0 + n;
    if (perm) { const int hf = nr >= 2816 ? 1 : 0, cc = nr - hf * 2816; nr = 32 * (cc >> 4) + 16 * hf + (cc & 15); }
    uint4* dst = (uint4*)(WT + (size_t)nr * K + k0 + kc);
    dst[0] = make_uint4(o[0], o[1], o[2], o[3]);
    dst[1] = make_uint4(o[4], o[5], o[6], o[7]);
  }
}

__device__ __forceinline__ void mod_item(const Params& p, int item, char* smem) {
  float* s = (float*)smem;
  float* red = s + 3072;
  const int tid = ltid();
  __syncthreads();
  for (int e = tid; e < 3072; e += 256) {
    const int v = e >> 10, k = e & 1023;
    const float x = (v == 0) ? p.c_ctx[k] : p.c[(v - 1) * D + k];
    s[e] = x / (1.f + __expf(-x));
  }
  __syncthreads();
  const int jl = tid & 63, kq = tid >> 6, j = item * 64 + jl, k0 = kq * 256;
  float a0 = 0.f, a1 = 0.f, a2 = 0.f;
#pragma unroll 8
  for (int k = 0; k < 256; ++k) {
    const float w = p.w_ada[(size_t)(k0 + k) * 6144 + j];
    a0 += s[k0 + k] * w; a1 += s[1024 + k0 + k] * w; a2 += s[2048 + k0 + k] * w;
  }
  red[(kq * 3 + 0) * 64 + jl] = a0; red[(kq * 3 + 1) * 64 + jl] = a1; red[(kq * 3 + 2) * 64 + jl] = a2;
  __syncthreads();
  if (tid < 192) {
    const int v = tid >> 6;
    const float r = red[(0 * 3 + v) * 64 + jl] + red[(1 * 3 + v) * 64 + jl] + red[(2 * 3 + v) * 64 + jl] + red[(3 * 3 + v) * 64 + jl];
    ((float*)(p.ws + OFF_MOD))[v * 6144 + j] = r + p.b_ada[j];
  }
}

__device__ __forceinline__ void filter_item(const Params& p, int item, char* smem) {
  int n, p0; bf16_t* R;
  if (item < 256) { n = 4096; p0 = item * 16; R = (bf16_t*)(p.ws + OFF_RLAT); }
  else { n = 256; p0 = (item - 256) * 16; R = (bf16_t*)(p.ws + OFF_RCTX); }
  const int n2 = 2 * n, tid = ltid();
  float* z = (float*)smem;
  float* h1 = z + 16 * 36;
  float* h2 = h1 + 16 * 64;
  __syncthreads();
#pragma unroll 1
  for (int e = tid; e < 16 * 33; e += 256) {
    const int pp = e / 33, f = e % 33, pos = p0 + pp;
    float val;
    if (f == 0) val = (float)pos / (float)(n - 1);
    else {
      const int k = (f - 1) & 15;
      const float band = 1e-4f + (float)k * ((15.f - 1e-4f) / 15.f);
      const float turns = band * ((float)pos / (float)n);
      val = (f <= 16) ? cos_turns(turns) : -sin_turns(turns);
    }
    z[pp * 36 + f] = val;
  }
  __syncthreads();
#pragma unroll 1
  for (int e = tid; e < 1024; e += 256) {
    const int pp = e >> 6, j = e & 63;
    float a = p.filt_b1[j];
#pragma unroll 11
    for (int f = 0; f < 33; ++f) a += z[pp * 36 + f] * p.filt_w1[f * 64 + j];
    h1[e] = sin_rad(p.filt_freq1[j] * a);
  }
  __syncthreads();
#pragma unroll 1
  for (int e = tid; e < 1024; e += 256) {
    const int pp = e >> 6, j = e & 63;
    float a = p.filt_b2[j];
#pragma unroll 16
    for (int k = 0; k < 64; ++k) a += h1[pp * 64 + k] * p.filt_w2[k * 64 + j];
    h2[j * 16 + pp] = sin_rad(p.filt_freq2[j] * a);
  }
  __syncthreads();
  const float mind = -3.0701134573253946f, maxd = -15.350567286626973f;
#pragma unroll 1
  for (int ci = 0; ci < 8; ++ci) {
    const int col = tid + 256 * ci, o = col >> 10, dir = (col >> 9) & 1, c = col & 511;
    float acc[16];
#pragma unroll
    for (int i = 0; i < 16; ++i) acc[i] = 0.f;
#pragma unroll 16
    for (int k = 0; k < 64; ++k) {
      const float w = p.filt_w3[k * 2048 + col];
      const float4 ha = *(const float4*)(h2 + k * 16), hb = *(const float4*)(h2 + k * 16 + 4), hc = *(const float4*)(h2 + k * 16 + 8), hd = *(const float4*)(h2 + k * 16 + 12);
      acc[0] += ha.x * w; acc[1] += ha.y * w; acc[2] += ha.z * w; acc[3] += ha.w * w;
      acc[4] += hb.x * w; acc[5] += hb.y * w; acc[6] += hb.z * w; acc[7] += hb.w * w;
      acc[8] += hc.x * w; acc[9] += hc.y * w; acc[10] += hc.z * w; acc[11] += hc.w * w;
      acc[12] += hd.x * w; acc[13] += hd.y * w; acc[14] += hd.z * w; acc[15] += hd.w * w;
    }
    const float delta = fabsf(mind + (float)c * ((maxd - mind) / 511.f));
    bf16_t* Rrow = R + (size_t)(o * 512 + c) * n2;
#pragma unroll
    for (int i = 0; i < 16; ++i) {
      const int pos = p0 + i;
      const float t = (float)pos / (float)(n - 1);
      float val = acc[i] * (__expf(-t * delta) + 0.05f);
      int idx = dir == 0 ? (n - 1 - pos) : (n - 1 + pos);
      if (dir == 1 && pos == 0) { idx = n2 - 1; val = 0.f; }
      Rrow[idx] = f2bf(val);
    }
  }
}

__device__ __forceinline__ void cache_item(const Params& p, int item) {
  const int tid = ltid(), r0 = item * 32;
  bf16_t* ckvn = (bf16_t*)(p.ws + OFF_CKVN);
#pragma unroll 2
  for (int e = tid; e < 32 * 64; e += 256) {
    const int r = r0 + (e >> 6), c4 = (e & 63) * 4;
    const float4 v = *(const float4*)(p.cache_ckv + (size_t)r * 256 + c4);
    *(uint2*)(ckvn + (size_t)(NTOK + r) * 256 + c4) = make_uint2(pack2(v.x, v.y), pack2(v.z, v.w));
  }
}

template <int WHICH>
__device__ __forceinline__ void rmsmod_phase(const Params& p) {
  const int tid = ltid(), lane = tid & 63, wid = tid >> 6;
  const int gw = blockIdx.x * 4 + wid, tw = gridDim.x * 4;
  const float* g = WHICH == 0 ? p.g_mix : p.g_ffn;
  const float* mod = (const float*)(p.ws + OFF_MOD);
  bf16_t* h = (bf16_t*)(p.ws + OFF_H);
  float4 nv0, nv1, nv2, nv3;
  {
    const float* src = WHICH == 0 ? xrow(p, gw) : p.out + (size_t)gw * D;
    nv0 = ((const float4*)src)[lane]; nv1 = ((const float4*)src)[lane + 64]; nv2 = ((const float4*)src)[lane + 128]; nv3 = ((const float4*)src)[lane + 192];
  }
  for (int row = gw; row < NTOK; row += tw) {
    float4 v[4] = {nv0, nv1, nv2, nv3};
    if (row + tw < NTOK) {
      const float* src = WHICH == 0 ? xrow(p, row + tw) : p.out + (size_t)(row + tw) * D;
      nv0 = ((const float4*)src)[lane]; nv1 = ((const float4*)src)[lane + 64]; nv2 = ((const float4*)src)[lane + 128]; nv3 = ((const float4*)src)[lane + 192];
    }
    float ss = 0.f;
#pragma unroll
    for (int i = 0; i < 4; ++i) ss += v[i].x * v[i].x + v[i].y * v[i].y + v[i].z * v[i].z + v[i].w * v[i].w;
    ss = wave_sum(ss);
    const float r = rsqrtf(ss * (1.f / 1024.f) + 1e-6f);
    const float* mv = mod + modidx(row) * 6144 + (WHICH == 0 ? 0 : 3 * 1024);
#pragma unroll
    for (int i = 0; i < 4; ++i) {
      const int e = 4 * (lane + 64 * i);
      const float4 g4 = *(const float4*)(g + e), sh = *(const float4*)(mv + e), sc = *(const float4*)(mv + 1024 + e);
      const float y0 = v[i].x * r * g4.x * (1.f + sc.x) + sh.x, y1 = v[i].y * r * g4.y * (1.f + sc.y) + sh.y;
      const float y2 = v[i].z * r * g4.z * (1.f + sc.z) + sh.z, y3 = v[i].w * r * g4.w * (1.f + sc.w) + sh.w;
      *(uint2*)(h + (size_t)row * D + e) = make_uint2(pack2(y0, y1), pack2(y2, y3));
    }
  }
}

struct EpiIn {
  float* proj; bf16_t* hyT;
  __device__ __forceinline__ void operator()(int row0, int col, const f32x4& v) const {
    if (col < 672) {
#pragma unroll
      for (int j = 0; j < 4; ++j) proj[(size_t)(row0 + j) * 672 + col] = v[j];
    } else if (col < DIN) {
      *(uint2*)(hyT + (size_t)(col - 672) * NTOK + row0) = make_uint2(pack2(v[0], v[1]), pack2(v[2], v[3]));
    }
  }
};
struct EpiProj {
  float* proj;
  __device__ __forceinline__ void operator()(int row, int col0, const f32x4& v) const { *(f32x4*)(proj + (size_t)row * 672 + col0) = v; }
};
struct EpiQ {
  bf16_t* q;
  __device__ __forceinline__ void operator()(int row, int col0, const f32x4& v) const {
    *(uint2*)(q + (size_t)row * 768 + col0) = make_uint2(pack2(v[0], v[1]), pack2(v[2], v[3]));
  }
};
struct EpiKV {
  bf16_t *kraw, *vtc, *vtl;
  __device__ __forceinline__ void operator()(int row0, int col, const f32x4& v) const {
    const int head = col >> 7, cc = col & 127;
    if (cc < 64) {
#pragma unroll
      for (int j = 0; j < 4; ++j) kraw[(size_t)(row0 + j) * 512 + head * 64 + cc] = f2bf(v[j]);
    } else {
      const int dv = cc - 64;
      bf16_t* dst;
      if (row0 < NCTX) dst = vtc + ((size_t)((row0 >> 8) * 8 + head) * 64 + dv) * 256 + (row0 & 255);
      else if (row0 < NTOK) { const int r = row0 - NCTX; dst = vtl + ((size_t)((r >> 12) * 8 + head) * 64 + dv) * 4608 + (r & 4095); }
      else { const int r = row0 - NTOK; dst = vtl + ((size_t)((r >> 9) * 8 + head) * 64 + dv) * 4608 + 4096 + (r & 511); }
      *(uint2*)dst = make_uint2(pack2(v[0], v[1]), pack2(v[2], v[3]));
    }
  }
};
struct EpiOut {
  const Params* p;
  __device__ __forceinline__ void operator()(int row, int col0, const f32x4& v) const {
    const float4 x = *(const float4*)(xrow(*p, row) + col0);
    const float4 m = *(const float4*)((const float*)(p->ws + OFF_MOD) + modidx(row) * 6144 + 2 * 1024 + col0);
    *(float4*)(p->out + (size_t)row * D + col0) = make_float4(x.x + m.x * v[0], x.y + m.y * v[1], x.z + m.z * v[2], x.w + m.w * v[3]);
  }
};
struct EpiU {
  bf16_t* u;
  __device__ __forceinline__ void operator()(int row, int col0, const f32x4& v) const {
    *(uint2*)(u + (size_t)row * 5632 + col0) = make_uint2(pack2(v[0], v[1]), pack2(v[2], v[3]));
  }
};
struct EpiY {
  const Params* p; int half;
  __device__ __forceinline__ void operator()(int row, int col0, const f32x4& v) const {
    const int grow = half * 8192 + row;
    float4* dst = (float4*)(p->out + (size_t)grow * D + col0);
    const float4 x = *dst;
    const float4 m = *(const float4*)((const float*)(p->ws + OFF_MOD) + modidx(grow) * 6144 + 5 * 1024 + col0);
    *dst = make_float4(x.x + m.x * v[0], x.y + m.y * v[1], x.z + m.z * v[2], x.w + m.w * v[3]);
  }
};

__device__ __forceinline__ void token_item(const Params& p, int item) {
  const int tid = ltid(), lane = tid & 63, wid = tid >> 6;
  const float* proj = (const float*)(p.ws + OFF_PROJ);
  bf16_t* qa = (bf16_t*)(p.ws + OFF_QA);
  bf16_t* ckvn = (bf16_t*)(p.ws + OFF_CKVN);
  float* kpe = (float*)(p.ws + OFF_KPE);
  for (int tt = 0; tt < 8; ++tt) {
    const int token = item * 32 + wid * 8 + tt;
    const float* pr = proj + (size_t)token * 672;
    float2 q[3];
    float ss = 0.f;
#pragma unroll
    for (int i = 0; i < 3; ++i) { q[i] = *(const float2*)(pr + lane * 2 + 128 * i); ss += q[i].x * q[i].x + q[i].y * q[i].y; }
    ss = wave_sum(ss);
    const float r = rsqrtf(ss * (1.f / 384.f) + 1e-6f);
#pragma unroll
    for (int i = 0; i < 3; ++i) {
      const int e = lane * 2 + 128 * i;
      *(unsigned*)(qa + (size_t)token * 384 + e) = pack2(q[i].x * r * p.g_qa[e], q[i].y * r * p.g_qa[e + 1]);
    }
    const float4 kv = *(const float4*)(pr + 384 + lane * 4);
    float s2 = wave_sum(kv.x * kv.x + kv.y * kv.y + kv.z * kv.z + kv.w * kv.w);
    const float r2 = rsqrtf(s2 * (1.f / 256.f) + 1e-6f);
    const float4 g = *(const float4*)(p.g_kva + lane * 4);
    const float4 y = make_float4(kv.x * r2 * g.x, kv.y * r2 * g.y, kv.z * r2 * g.z, kv.w * r2 * g.w);
    *(uint2*)(ckvn + (size_t)token * 256 + lane * 4) = make_uint2(pack2(y.x, y.y), pack2(y.z, y.w));
    if (token < NCTX) *(float4*)(p.out + OUT_CKV + (size_t)token * 256 + lane * 4) = y;
    if (lane < 32) {
      const float kp = pr[640 + lane];
      kpe[(size_t)token * 32 + lane] = kp;
      if (token < NCTX) p.out[OUT_KPE + (size_t)token * 32 + lane] = kp;
    }
  }
}

template <int ORDER>
__device__ __forceinline__ void hyena_item(const Params& p, int grp, int c, char* smem) {
  const int tid = ltid(), lane = tid & 63, wid = tid >> 6, fr = lane & 15, fq = lane >> 4;
  const int n = grp ? SEQL : SEQC, nb = n >> 6, L = n;
  const bf16_t* Rrow = (const bf16_t*)(p.ws + (grp ? OFF_RLAT : OFF_RCTX)) + (size_t)(ORDER * 512 + c) * (2 * n);
  const bf16_t* hyT = (const bf16_t*)(p.ws + OFF_HYT);
  bf16_t* sU = (bf16_t*)smem;
  unsigned* sR0 = (unsigned*)(smem + 18432);
  unsigned* sR1 = (unsigned*)(smem + 18432 + 16384);
  const int tok0 = grp * 8192;
  __syncthreads();
  for (int ch = tid; ch < (2 * n) / 8; ch += 256) *(uint4*)((bf16_t*)sR0 + ch * 8) = *(const uint4*)(Rrow + ch * 8);
  if (ORDER == 0) {
    const bf16_t* raw = hyT + (size_t)c * NTOK + tok0;
    const float w0 = p.hy_conv_w[c], w1 = p.hy_conv_w[1536 + c], w2 = p.hy_conv_w[3072 + c], b = p.hy_conv_b[c];
    for (int ch = tid; ch < 1024; ch += 256) {
      const int t = ch * 8, pos = t & (L - 1);
      const uint4 rv = *(const uint4*)(raw + t);
      float x[10];
      x[0] = pos == 0 ? 0.f : bf2f(raw[t - 1]);
      x[1] = bflo(rv.x); x[2] = bfhi(rv.x); x[3] = bflo(rv.y); x[4] = bfhi(rv.y);
      x[5] = bflo(rv.z); x[6] = bfhi(rv.z); x[7] = bflo(rv.w); x[8] = bfhi(rv.w);
      x[9] = (pos + 8 == L) ? 0.f : bf2f(raw[t + 8]);
      float u[8];
#pragma unroll
      for (int i = 0; i < 8; ++i) u[i] = w0 * x[i] + w1 * x[i + 1] + w2 * x[i + 2] + b;
      *(uint4*)(sU + (ch >> 3) * 64 + (((ch & 7) ^ ((ch >> 3) & 7)) * 8)) = make_uint4(pack2(u[0], u[1]), pack2(u[2], u[3]), pack2(u[4], u[5]), pack2(u[6], u[7]));
    }
  } else {
    const bf16_t* zr = (const bf16_t*)(p.ws + OFF_ZT) + (size_t)c * NTOK + tok0;
    for (int ch = tid; ch < 1024; ch += 256) *(uint4*)(sU + (ch >> 3) * 64 + (((ch & 7) ^ ((ch >> 3) & 7)) * 8)) = *(const uint4*)(zr + ch * 8);
  }
  __syncthreads();
  for (int k = tid; k < n; k += 256) {
    const unsigned a = sR0[k], b2 = (k + 1 < n) ? sR0[k + 1] : 0u;
    sR1[k] = (a >> 16) | (b2 << 16);
  }
  __syncthreads();

  f32x4 acc[4][2];
#pragma unroll
  for (int m = 0; m < 4; ++m) { acc[m][0] = (f32x4){0.f, 0.f, 0.f, 0.f}; acc[m][1] = (f32x4){0.f, 0.f, 0.f, 0.f}; }
  const unsigned* abase = (fr & 1) ? (sR0 + ((n - 1 - fr) >> 1) + 4 * fq) : (sR1 + ((n - 2 - fr) >> 1) + 4 * fq);
  const int col0 = 32 * wid + fr, col1 = col0 + 16;
  const int i0 = col0 & (nb - 1), i1 = col1 & (nb - 1);
  for (int d = -(nb - 1); d <= nb - 1; ++d) {
    const bool v0 = (unsigned)(i0 - d) < (unsigned)nb, v1 = (unsigned)(i1 - d) < (unsigned)nb;
    const bool any0 = __ballot(v0) != 0ull, any1 = __ballot(v1) != 0ull;
    if (!any0 && !any1) continue;
    bf16x8 F[6];
    const unsigned* ap = abase - 32 * d + 16;
#pragma unroll
    for (int idx = 0; idx < 6; ++idx) {
      const unsigned* q = ap - 8 * idx;
      union { unsigned u[4]; bf16x8 v; } cv;
      cv.u[0] = q[0]; cv.u[1] = q[1]; cv.u[2] = q[2]; cv.u[3] = q[3];
      F[idx] = cv.v;
    }
#pragma unroll
    for (int nt = 0; nt < 2; ++nt) {
      if (!(nt ? any1 : any0)) continue;
      const bool vv = nt ? v1 : v0;
      const int srow = (nt ? col1 : col0) - d;
      const bf16_t* up = sU + srow * 64;
#pragma unroll
      for (int ks = 0; ks < 2; ++ks) {
        bf16x8 bf = (bf16x8){0, 0, 0, 0, 0, 0, 0, 0};
        if (vv) bf = *(const bf16x8*)(up + (((ks * 4 + fq) ^ (srow & 7)) * 8));
#pragma unroll
        for (int m = 0; m < 4; ++m)
          acc[m][nt] = __builtin_amdgcn_mfma_f32_16x16x32_bf16(F[m + 2 - 2 * ks], bf, acc[m][nt], 0, 0, 0);
      }
    }
  }
  const float skip = p.filt_bias[ORDER * 512 + c];
  const int gcol = (ORDER == 0 ? 512 : 1024) + c;
  const bf16_t* graw = hyT + (size_t)gcol * NTOK + tok0;
  const float w0 = p.hy_conv_w[gcol], w1 = p.hy_conv_w[1536 + gcol], w2 = p.hy_conv_w[3072 + gcol], b = p.hy_conv_b[gcol];
  bf16_t* outT = (bf16_t*)(p.ws + (ORDER == 0 ? OFF_ZT : OFF_Y2T)) + (size_t)c * NTOK + tok0;
#pragma unroll
  for (int nt = 0; nt < 2; ++nt) {
    const int col = nt ? col1 : col0;
#pragma unroll
    for (int m = 0; m < 4; ++m) {
      const int t = col * 64 + 16 * m + 4 * fq, pos = t & (L - 1);
      const uint2 uu = *(const uint2*)(sU + col * 64 + (((2 * m + (fq >> 1)) ^ (col & 7)) * 8) + 4 * (fq & 1));
      const uint2 gv = *(const uint2*)(graw + t);
      float x[6];
      x[0] = pos == 0 ? 0.f : bf2f(graw[t - 1]);
      x[1] = bflo(gv.x); x[2] = bfhi(gv.x); x[3] = bflo(gv.y); x[4] = bfhi(gv.y);
      x[5] = (pos + 4 == L) ? 0.f : bf2f(graw[t + 4]);
      const float u4[4] = {bflo(uu.x), bfhi(uu.x), bflo(uu.y), bfhi(uu.y)};
      float o[4];
#pragma unroll
      for (int j = 0; j < 4; ++j) {
        const float gate = w0 * x[j] + w1 * x[j + 1] + w2 * x[j + 2] + b;
        o[j] = gate * (acc[m][nt][j] + skip * u4[j]);
      }
      *(uint2*)(outT + t) = make_uint2(pack2(o[0], o[1]), pack2(o[2], o[3]));
    }
  }
}

__device__ __forceinline__ void rope32(float* y  , int pos) {
  const float prow = (float)(pos >> 6), pcol = (float)(pos & 63);
  const float fr[8] = {1.f, 0.31622776601683794f, 0.1f, 0.031622776601683794f, 0.01f, 0.0031622776601683794f, 0.001f, 0.00031622776601683794f};
#pragma unroll
  for (int i = 0; i < 8; ++i) {
    const float tr = prow * fr[i] * 0.15915494309189535f, tc = pcol * fr[i] * 0.15915494309189535f;
    const float sr = sin_turns(tr), cr = cos_turns(tr), sc = sin_turns(tc), cc = cos_turns(tc);
    const float a = y[i], b = y[8 + i], c2 = y[16 + i], d2 = y[24 + i];
    y[i] = a * cr - b * sr; y[8 + i] = b * cr + a * sr;
    y[16 + i] = c2 * cc - d2 * sc; y[24 + i] = d2 * cc + c2 * sc;
  }
}
__device__ __forceinline__ void unpack8(const uint4& v, float* x) {
  x[0] = bflo(v.x); x[1] = bfhi(v.x); x[2] = bflo(v.y); x[3] = bfhi(v.y);
  x[4] = bflo(v.z); x[5] = bfhi(v.z); x[6] = bflo(v.w); x[7] = bfhi(v.w);
}
__device__ __forceinline__ float sumsq8(const uint4& v) {
  float x[8];
  unpack8(v, x);
  return x[0] * x[0] + x[1] * x[1] + x[2] * x[2] + x[3] * x[3] + x[4] * x[4] + x[5] * x[5] + x[6] * x[6] + x[7] * x[7];
}
__device__ __forceinline__ uint4 scale8(const uint4& v, float r, const float* __restrict__ g) {
  float x[8];
  unpack8(v, x);
  const float4 g0 = *(const float4*)g, g1 = *(const float4*)(g + 4);
  return make_uint4(pack2(x[0] * r * g0.x, x[1] * r * g0.y), pack2(x[2] * r * g0.z, x[3] * r * g0.w),
                    pack2(x[4] * r * g1.x, x[5] * r * g1.y), pack2(x[6] * r * g1.z, x[7] * r * g1.w));
}
__device__ __forceinline__ void qk_item(const Params& p, int item) {
  const int tid = ltid();
  if (item < 512) {
    const int idx = item * 256 + tid, row = idx >> 3, h = idx & 7;
    const bf16_t* src = (const bf16_t*)(p.ws + OFF_QRAW) + (size_t)row * 768 + h * 96;
    bf16_t* dst = (bf16_t*)(p.ws + OFF_Q) + (size_t)row * 768 + h * 96;
    uint4 raw[12];
#pragma unroll
    for (int i = 0; i < 12; ++i) raw[i] = *(const uint4*)(src + 8 * i);
    float ss = 0.f;
#pragma unroll
    for (int i = 0; i < 12; ++i) ss += sumsq8(raw[i]);
    const float r = rsqrtf(ss * (1.f / 96.f) + 1e-6f);
    const float qs = 0.10206207261596575f * 1.4426950408889634f;
#pragma unroll
    for (int i = 0; i < 8; ++i) *(uint4*)(dst + 8 * i) = scale8(raw[i], r * qs, p.g_q + 8 * i);
    float y[32];
#pragma unroll
    for (int i = 0; i < 4; ++i) unpack8(raw[8 + i], y + 8 * i);
#pragma unroll
    for (int i = 0; i < 32; ++i) y[i] = y[i] * r * p.g_q[64 + i];
    if (row >= NCTX) rope32(y, (row - NCTX) & 4095);
#pragma unroll
    for (int i = 0; i < 4; ++i)
      *(uint4*)(dst + 64 + 8 * i) = make_uint4(pack2(y[8 * i] * qs, y[8 * i + 1] * qs), pack2(y[8 * i + 2] * qs, y[8 * i + 3] * qs),
                                               pack2(y[8 * i + 4] * qs, y[8 * i + 5] * qs), pack2(y[8 * i + 6] * qs, y[8 * i + 7] * qs));
  } else {
    const int idx = (item - 512) * 256 + tid, row = idx >> 3, h = idx & 7;
    const bf16_t* src = (const bf16_t*)(p.ws + OFF_KRAW) + (size_t)row * 512 + h * 64;
    uint4 raw[8];
#pragma unroll
    for (int i = 0; i < 8; ++i) raw[i] = *(const uint4*)(src + 8 * i);
    const float* kp = row < NTOK ? (const float*)(p.ws + OFF_KPE) + (size_t)row * 32 : p.cache_kpe + (size_t)(row - NTOK) * 32;
    float y[32];
#pragma unroll
    for (int i = 0; i < 8; ++i) {
      const float4 v = *(const float4*)(kp + 4 * i);
      y[4 * i] = v.x; y[4 * i + 1] = v.y; y[4 * i + 2] = v.z; y[4 * i + 3] = v.w;
    }
    float ss = 0.f;
#pragma unroll
    for (int i = 0; i < 8; ++i) ss += sumsq8(raw[i]);
#pragma unroll
    for (int i = 0; i < 32; ++i) ss += y[i] * y[i];
    const float r = rsqrtf(ss * (1.f / 96.f) + 1e-6f);
#pragma unroll
    for (int i = 0; i < 32; ++i) y[i] = y[i] * r * p.g_k[64 + i];
    bf16_t* dst;
    if (row < NCTX) dst = (bf16_t*)(p.ws + OFF_KC) + ((size_t)((row >> 8) * 8 + h) * 256 + (row & 255)) * 96;
    else if (row < NTOK) {
      const int rr = row - NCTX;
      rope32(y, rr & 4095);
      dst = (bf16_t*)(p.ws + OFF_KL) + ((size_t)((rr >> 12) * 8 + h) * 4608 + (rr & 4095)) * 96;
    } else {
      const int rr = row - NTOK;
      dst = (bf16_t*)(p.ws + OFF_KL) + ((size_t)((rr >> 9) * 8 + h) * 4608 + 4096 + (rr & 511)) * 96;
    }
#pragma unroll
    for (int i = 0; i < 8; ++i) *(uint4*)(dst + 8 * i) = scale8(raw[i], r, p.g_k + 8 * i);
#pragma unroll
    for (int i = 0; i < 4; ++i)
      *(uint4*)(dst + 64 + 8 * i) = make_uint4(pack2(y[8 * i], y[8 * i + 1]), pack2(y[8 * i + 2], y[8 * i + 3]),
                                               pack2(y[8 * i + 4], y[8 * i + 5]), pack2(y[8 * i + 6], y[8 * i + 7]));
  }
}

__device__ __forceinline__ void attn_item(const Params& p, int item, char* smem) {
  const int tid = ltid(), lane = tid & 63, wid = tid >> 6, lr = lane & 31, lh = lane >> 5;
  int nkeys, h, tokbase; const bf16_t *Kp, *Vp;
  if (item < 512) {
    const int b = item >> 8, rem = item & 255; h = rem >> 5; const int qb = rem & 31;
    nkeys = 4608; tokbase = NCTX + b * 4096 + qb * 128;
    Kp = (const bf16_t*)(p.ws + OFF_KL) + (size_t)(b * 8 + h) * 4608 * 96;
    Vp = (const bf16_t*)(p.ws + OFF_VTL) + (size_t)(b * 8 + h) * 64 * 4608;
  } else {
    const int it = item - 512, b = it >> 4; h = (it & 15) >> 1; const int qb = it & 1;
    nkeys = 256; tokbase = b * 256 + qb * 128;
    Kp = (const bf16_t*)(p.ws + OFF_KC) + (size_t)(b * 8 + h) * 256 * 96;
    Vp = (const bf16_t*)(p.ws + OFF_VTC) + (size_t)(b * 8 + h) * 64 * 256;
  }
  bf16_t* sK = (bf16_t*)smem;
  bf16_t* sV = sK + 64 * 104;
  const int token = tokbase + 32 * wid + lr;
  bf16x8 qf[6];
  {
    const bf16_t* qsrc = (const bf16_t*)(p.ws + OFF_QRAW) + (size_t)token * 768 + h * 96 + 8 * lh;
    uint4 qr[6];
#pragma unroll
    for (int ks = 0; ks < 6; ++ks) qr[ks] = *(const uint4*)(qsrc + 16 * ks);
    float ss = 0.f;
#pragma unroll
    for (int ks = 0; ks < 6; ++ks) ss += sumsq8(qr[ks]);
    ss += __shfl_xor(ss, 32);
    const float r = rsqrtf(ss * (1.f / 96.f) + 1e-6f);
    const float qs = 0.10206207261596575f * 1.4426950408889634f;
    const bool lat = item < 512;
    const int pos = (token - NCTX) & 4095;
    const float prow = (float)(pos >> 6), pcol = (float)(pos & 63);
    const float frq[8] = {1.f, 0.31622776601683794f, 0.1f, 0.031622776601683794f, 0.01f, 0.0031622776601683794f, 0.001f, 0.00031622776601683794f};
#pragma unroll
    for (int ks = 0; ks < 6; ++ks) {
      float y[8];
      unpack8(qr[ks], y);
      const float* gq = p.g_q + 16 * ks + 8 * lh;
#pragma unroll
      for (int e = 0; e < 8; ++e) y[e] = y[e] * r * gq[e];
      if (ks >= 4) {
#pragma unroll
        for (int e = 0; e < 8; ++e) {
          const float other = __shfl_xor(y[e], 32);
          const float t = (ks == 4 ? prow : pcol) * frq[e] * 0.15915494309189535f;
          const float sn = sin_turns(t), cs = cos_turns(t);
          const float rot = y[e] * cs + (lh ? other : -other) * sn;
          y[e] = lat ? rot : y[e];
        }
      }
      union { unsigned u[4]; bf16x8 v; } pk;
      pk.u[0] = pack2(y[0] * qs, y[1] * qs); pk.u[1] = pack2(y[2] * qs, y[3] * qs); pk.u[2] = pack2(y[4] * qs, y[5] * qs); pk.u[3] = pack2(y[6] * qs, y[7] * qs);
      qf[ks] = pk.v;
    }
  }
  f32x16 oacc[2];
#pragma unroll
  for (int j = 0; j < 16; ++j) { oacc[0][j] = 0.f; oacc[1][j] = 0.f; }
  float mrun = -1e30f, lsum = 0.f;
  const int kk0 = tid / 12, kc0 = tid % 12, kk1 = (tid + 256) / 12, kc1 = (tid + 256) % 12, kk2 = (tid + 512) / 12, kc2 = (tid + 512) % 12;
  const int vd0 = tid >> 3, vc0 = tid & 7, vd1 = vd0 + 32;
  const bf16_t* gk0 = Kp + (size_t)kk0 * 96 + kc0 * 8;
  const bf16_t* gk1 = Kp + (size_t)kk1 * 96 + kc1 * 8;
  const bf16_t* gk2 = Kp + (size_t)kk2 * 96 + kc2 * 8;
  const bf16_t* gv0 = Vp + (size_t)vd0 * nkeys + vc0 * 8;
  const bf16_t* gv1 = Vp + (size_t)vd1 * nkeys + vc0 * 8;
  uint4 rk0 = *(const uint4*)gk0, rk1 = *(const uint4*)gk1, rk2 = *(const uint4*)gk2;
  uint4 rv0 = *(const uint4*)gv0, rv1 = *(const uint4*)gv1;
  const int nt = nkeys >> 6;
  for (int kt = 0; kt < nt; ++kt) {
    __syncthreads();
    *(uint4*)(sK + kk0 * 104 + kc0 * 8) = rk0; *(uint4*)(sK + kk1 * 104 + kc1 * 8) = rk1; *(uint4*)(sK + kk2 * 104 + kc2 * 8) = rk2;
    *(uint4*)(sV + vd0 * 72 + vc0 * 8) = rv0; *(uint4*)(sV + vd1 * 72 + vc0 * 8) = rv1;
    __syncthreads();
    if (kt + 1 < nt) {
      gk0 += 64 * 96; gk1 += 64 * 96; gk2 += 64 * 96; gv0 += 64; gv1 += 64;
      rk0 = *(const uint4*)gk0; rk1 = *(const uint4*)gk1; rk2 = *(const uint4*)gk2;
      rv0 = *(const uint4*)gv0; rv1 = *(const uint4*)gv1;
    }
    __builtin_amdgcn_sched_barrier(0);
    f32x16 sacc[2];
#pragma unroll
    for (int kb = 0; kb < 2; ++kb) {
#pragma unroll
      for (int j = 0; j < 16; ++j) sacc[kb][j] = 0.f;
#pragma unroll
      for (int ks = 0; ks < 6; ++ks) {
        const bf16x8 a = *(const bf16x8*)(sK + (32 * kb + lr) * 104 + 16 * ks + 8 * lh);
        sacc[kb] = __builtin_amdgcn_mfma_f32_32x32x16_bf16(a, qf[ks], sacc[kb], 0, 0, 0);
      }
    }
    float mx = sacc[0][0];
#pragma unroll
    for (int j = 1; j < 16; ++j) mx = fmaxf(mx, sacc[0][j]);
#pragma unroll
    for (int j = 0; j < 16; ++j) mx = fmaxf(mx, sacc[1][j]);
    mx = fmaxf(mx, __shfl_xor(mx, 32));
    const float mnew = fmaxf(mrun, mx);
    const float alpha = __builtin_amdgcn_exp2f(mrun - mnew);
    mrun = mnew;
    float ps = 0.f;
#pragma unroll
    for (int kb = 0; kb < 2; ++kb)
#pragma unroll
      for (int j = 0; j < 16; ++j) { const float e = __builtin_amdgcn_exp2f(sacc[kb][j] - mnew); sacc[kb][j] = e; ps += e; }
    lsum = lsum * alpha + ps;
    if (__ballot(alpha != 1.f) != 0ull) {
#pragma unroll
      for (int j = 0; j < 16; ++j) { oacc[0][j] *= alpha; oacc[1][j] *= alpha; }
    }
#pragma unroll
    for (int s = 0; s < 4; ++s) {
      const int kb = s >> 1, jb = 8 * (s & 1);
      union { unsigned u[4]; bf16x8 v; } pf;
      pf.u[0] = pack2(sacc[kb][jb + 0], sacc[kb][jb + 1]); pf.u[1] = pack2(sacc[kb][jb + 2], sacc[kb][jb + 3]);
      pf.u[2] = pack2(sacc[kb][jb + 4], sacc[kb][jb + 5]); pf.u[3] = pack2(sacc[kb][jb + 6], sacc[kb][jb + 7]);
#pragma unroll
      for (int mt = 0; mt < 2; ++mt) {
        const bf16_t* vp = sV + (32 * mt + lr) * 72 + 16 * s + 4 * lh;
        union { uint2 d[2]; bf16x8 v; } av;
        av.d[0] = *(const uint2*)vp;
        av.d[1] = *(const uint2*)(vp + 8);
        oacc[mt] = __builtin_amdgcn_mfma_f32_32x32x16_bf16(av.v, pf.v, oacc[mt], 0, 0, 0);
      }
    }
  }
  lsum += __shfl_xor(lsum, 32);
  const float inv = 1.f / lsum;
  bf16_t* dst = (bf16_t*)(p.ws + OFF_ATTN) + (size_t)token * 512 + h * 64;
#pragma unroll
  for (int mt = 0; mt < 2; ++mt)
#pragma unroll
    for (int jg = 0; jg < 4; ++jg) {
      const int dv0 = 32 * mt + 8 * jg + 4 * lh;
      *(uint2*)(dst + dv0) = make_uint2(pack2(oacc[mt][4 * jg] * inv, oacc[mt][4 * jg + 1] * inv),
                                        pack2(oacc[mt][4 * jg + 2] * inv, oacc[mt][4 * jg + 3] * inv));
    }
}

__device__ __forceinline__ void merge_item(const Params& p, int item, char* smem) {
  const int tid = ltid(), lane = tid & 63, wid = tid >> 6, t0 = item * 32;
  bf16_t* mix = (bf16_t*)(p.ws + OFF_H);
  const bf16_t* attn = (const bf16_t*)(p.ws + OFF_ATTN);
  for (int tt = 0; tt < 8; ++tt) {
    const int token = t0 + wid * 8 + tt;
    float x[8];
    unpack8(*(const uint4*)(attn + (size_t)token * 512 + lane * 8), x);
    float ss = 0.f;
#pragma unroll
    for (int i = 0; i < 8; ++i) ss += x[i] * x[i];
    ss = wave_sum(ss);
    const float r = rsqrtf(ss * (1.f / 512.f) + 1e-6f);
    const float4 g0 = *(const float4*)(p.g_out_att + lane * 8), g1 = *(const float4*)(p.g_out_att + lane * 8 + 4);
    *(uint4*)(mix + (size_t)token * D + lane * 8) =
        make_uint4(pack2(x[0] * r * g0.x, x[1] * r * g0.y), pack2(x[2] * r * g0.z, x[3] * r * g0.w),
                   pack2(x[4] * r * g1.x, x[5] * r * g1.y), pack2(x[6] * r * g1.z, x[7] * r * g1.w));
  }
  bf16_t* sT = (bf16_t*)smem;
  const bf16_t* y2T = (const bf16_t*)(p.ws + OFF_Y2T);
  __syncthreads();
  for (int ch = tid; ch < 2048; ch += 256) {
    const int c = ch >> 2, q4 = ch & 3;
    const uint4 v = *(const uint4*)(y2T + (size_t)c * NTOK + t0 + q4 * 8);
    bf16_t* d = sT + (q4 * 8) * 520 + c;
    d[0 * 520] = (bf16_t)(v.x & 0xffff); d[1 * 520] = (bf16_t)(v.x >> 16);
    d[2 * 520] = (bf16_t)(v.y & 0xffff); d[3 * 520] = (bf16_t)(v.y >> 16);
    d[4 * 520] = (bf16_t)(v.z & 0xffff); d[5 * 520] = (bf16_t)(v.z >> 16);
    d[6 * 520] = (bf16_t)(v.w & 0xffff); d[7 * 520] = (bf16_t)(v.w >> 16);
  }
  __syncthreads();
  {
    const int tt = tid >> 3, part = tid & 7;
    uint4 v[8];
    float ss = 0.f;
#pragma unroll
    for (int i = 0; i < 8; ++i) {
      v[i] = *(const uint4*)(sT + tt * 520 + part * 64 + 8 * i);
      float x[8];
      unpack8(v[i], x);
#pragma unroll
      for (int e = 0; e < 8; ++e) ss += x[e] * x[e];
    }
    ss += __shfl_xor(ss, 1); ss += __shfl_xor(ss, 2); ss += __shfl_xor(ss, 4);
    const float r = rsqrtf(ss * (1.f / 512.f) + 1e-6f);
#pragma unroll
    for (int i = 0; i < 8; ++i) {
      float x[8];
      unpack8(v[i], x);
      const int c0 = part * 64 + 8 * i;
      const float4 g0 = *(const float4*)(p.g_out_hy + c0), g1 = *(const float4*)(p.g_out_hy + c0 + 4);
      *(uint4*)(mix + (size_t)(t0 + tt) * D + 512 + c0) =
          make_uint4(pack2(x[0] * r * g0.x, x[1] * r * g0.y), pack2(x[2] * r * g0.z, x[3] * r * g0.w),
                     pack2(x[4] * r * g1.x, x[5] * r * g1.y), pack2(x[6] * r * g1.z, x[7] * r * g1.w));
    }
  }
}

__device__ __forceinline__ void actfix_item(const Params& p, int item) {
  const int idx = item * 256 + ltid();
  if (idx >= 512 * 352) return;
  const int j = (idx % 352) * 8, rowi = idx / 352, wt = rowi >> 1, which = rowi & 1;
  const int t = 64 * wt + 63 * which, L = t < NCTX ? SEQC : SEQL, pos = t & (L - 1);
  const bf16_t* edge = (const bf16_t*)(p.ws + OFF_EDGE);
  bf16_t* act = (bf16_t*)(p.ws + OFF_U);
  const bf16_t *pr, *cu, *nx;
  bool zp = false, zn = false;
  if (which == 0) { zp = pos == 0; pr = edge + (size_t)((zp ? wt : wt - 1) * 4 + 3) * 5632; cu = edge + (size_t)(wt * 4 + 0) * 5632; nx = edge + (size_t)(wt * 4 + 1) * 5632; }
  else { zn = pos == L - 1; pr = edge + (size_t)(wt * 4 + 2) * 5632; cu = edge + (size_t)(wt * 4 + 3) * 5632; nx = edge + (size_t)((zn ? wt : wt + 1) * 4 + 0) * 5632; }
  float pa[8], pg[8], ca[8], cgv[8], na[8], ng[8];
  unpack8(*(const uint4*)(pr + j), pa); unpack8(*(const uint4*)(pr + 2816 + j), pg);
  unpack8(*(const uint4*)(cu + j), ca); unpack8(*(const uint4*)(cu + 2816 + j), cgv);
  unpack8(*(const uint4*)(nx + j), na); unpack8(*(const uint4*)(nx + 2816 + j), ng);
  float o[8];
#pragma unroll
  for (int e = 0; e < 8; ++e) {
    const float pae = zp ? 0.f : pa[e], pge = zp ? 0.f : pg[e], nae = zn ? 0.f : na[e], nge = zn ? 0.f : ng[e];
    const float a = p.ffn_conv_w[j + e] * pae + p.ffn_conv_w[5632 + j + e] * ca[e] + p.ffn_conv_w[11264 + j + e] * nae + p.ffn_conv_b[j + e];
    const float g = p.ffn_conv_w[2816 + j + e] * pge + p.ffn_conv_w[5632 + 2816 + j + e] * cgv[e] + p.ffn_conv_w[11264 + 2816 + j + e] * nge + p.ffn_conv_b[2816 + j + e];
    o[e] = a * __builtin_amdgcn_rcpf(1.f + __expf(-a)) * g;
  }
  *(uint4*)(act + (size_t)t * 2816 + j) = make_uint4(pack2(o[0], o[1]), pack2(o[2], o[3]), pack2(o[4], o[5]), pack2(o[6], o[7]));
}

#define XB_TMO      128
#define XB_XCNT(j)  (256  + 64 * (j))
#define XB_XSUB(j)  (1280 + 64 * (j))
#define XB_XGEN(j)  (2304 + 64 * (j))
#define XB_TOP      3328
#define XB_TOPGEN   3392
#define XCD_BAR_WORDS 3456
#define XB_SPIN_CAP (1u << 20)
#define LAS __attribute__((address_space(3)))
__device__ __forceinline__ unsigned xb_ld(unsigned* p) { return __hip_atomic_load(p, __ATOMIC_RELAXED, __HIP_MEMORY_SCOPE_AGENT); }
__device__ __forceinline__ unsigned xb_add(unsigned* p, unsigned v) { return __hip_atomic_fetch_add(p, v, __ATOMIC_RELAXED, __HIP_MEMORY_SCOPE_AGENT); }
__device__ __forceinline__ unsigned xb_xcc_id() { return (unsigned)__builtin_amdgcn_s_getreg((3 << 11) | 20) & 0xFu; }
#define XB_SPIN(cond, bar) do { unsigned _sp = 0; while (cond) { __builtin_amdgcn_s_sleep(1); \
    if ((++_sp & 255u) == 0u) { if (xb_ld(&(bar)[XB_TMO])) break; if (_sp > XB_SPIN_CAP) { atomicAdd(&(bar)[XB_TMO], 1u); break; } } } } while (0)
struct XcdBarrier { unsigned* bar; unsigned x; volatile LAS unsigned* st; };
__device__ __forceinline__ XcdBarrier xcd_barrier_post(unsigned* bar, volatile LAS unsigned* st) {
  XcdBarrier b; b.bar = bar; b.x = xb_xcc_id(); b.st = st;
  if (threadIdx.x == 0) (void)xb_add(&bar[XB_XCNT(b.x)], 1u);
  return b;
}
__device__ __forceinline__ void xcd_barrier_complete(unsigned* bar, unsigned x, unsigned& nloc, unsigned& nx) {
  const unsigned G = gridDim.x * gridDim.y * gridDim.z;
  unsigned sum, cnt, mine, sp = 0u;
  for (;;) {
    sum = 0u; cnt = 0u; mine = 0u;
#pragma unroll
    for (unsigned j = 0; j < 16; ++j) { const unsigned c = xb_ld(&bar[XB_XCNT(j)]); sum += c; cnt += (c > 0u) ? 1u : 0u; mine = (j == x) ? c : mine; }
    if (sum == G) break;
    __builtin_amdgcn_s_sleep(1);
    if ((++sp & 255u) == 0u) { if (xb_ld(&bar[XB_TMO])) break; if (sp > XB_SPIN_CAP) { atomicAdd(&bar[XB_TMO], 1u); break; } }
  }
  nloc = mine > 0u ? mine : 1u; nx = cnt > 0u ? cnt : 1u;
}
__device__ __forceinline__ void xcd_barrier(const XcdBarrier& b) {
  asm volatile("s_waitcnt vmcnt(0)" ::: "memory");
  __syncthreads();
  if (threadIdx.x == 0) {
    unsigned* bar = b.bar;
    __builtin_amdgcn_s_waitcnt(0);
    unsigned nloc = b.st[0], nx = b.st[1];
    if (nloc == 0u) { xcd_barrier_complete(bar, b.x, nloc, nx); b.st[0] = nloc; b.st[1] = nx; }
    const unsigned old = xb_add(&bar[XB_XSUB(b.x)], 1u);
    const unsigned gen = old / nloc;
    if (old + 1u == (gen + 1u) * nloc) {
      __builtin_amdgcn_fence(__ATOMIC_RELEASE, "agent");
      asm volatile("s_waitcnt vmcnt(0)" ::: "memory");
      const unsigned og = xb_add(&bar[XB_TOP], 1u);
      const unsigned tg = og / nx;
      if (og + 1u == (tg + 1u) * nx) xb_add(&bar[XB_TOPGEN], 1u);
      else XB_SPIN(xb_ld(&bar[XB_TOPGEN]) == tg, bar);
      __builtin_amdgcn_fence(__ATOMIC_ACQUIRE, "agent");
      xb_add(&bar[XB_XGEN(b.x)], 1u);
      asm volatile("s_waitcnt vmcnt(0)" ::: "memory");
    } else {
      XB_SPIN(xb_ld(&bar[XB_XGEN(b.x)]) == gen, bar);
      __builtin_amdgcn_fence(__ATOMIC_ACQUIRE, "agent");
      asm volatile("s_waitcnt vmcnt(0)" ::: "memory");
    }
  }
  __syncthreads();
}
constexpr size_t OFF_BAR = 25 * MiB - 16384;
static_assert(OFF_MOD + 3 * 6144 * 4 <= OFF_BAR, "bar");

template <int ph>
__device__ __forceinline__ void run_phase(const Params& p, char* smem) {
  const int bid = blockIdx.x, G = gridDim.x;
  char* ws = p.ws;
  if constexpr (ph == 0) {
    for (int it = bid; it < 272 + 96 + 32 + 3080; it += G) {
      if (it < 272) filter_item(p, it, smem);
      else if (it < 368) mod_item(p, it - 272, smem);
      else if (it < 400) cache_item(p, it - 368);
      else {
        int t = it - 400;
        if (t < 576) transpose_item(p.w_in, 1024, DIN, (bf16_t*)(ws + OFF_WIN), t, 36, smem);
        else if ((t -= 576) < 72) transpose_item(p.w_uq, 384, 768, (bf16_t*)(ws + OFF_WUQ), t, 12, smem);
        else if ((t -= 72) < 64) transpose_item(p.w_ukv, 256, 1024, (bf16_t*)(ws + OFF_WUKV), t, 16, smem);
        else if ((t -= 64) < 256) transpose_item(p.w_out, 1024, 1024, (bf16_t*)(ws + OFF_WOUT), t, 16, smem);
        else if ((t -= 256) < 1408) transpose_item(p.w_up, 1024, 5632, (bf16_t*)(ws + OFF_WUP), t, 88, smem, true);
        else { t -= 1408; transpose_item(p.w_down, 2816, 1024, (bf16_t*)(ws + OFF_WDOWN), t, 16, smem); }
      }
    }
  } else if constexpr (ph == 1) {
    rmsmod_phase<0>(p);
  } else if constexpr (ph == 2) {
    EpiIn epi{(float*)(ws + OFF_PROJ), (bf16_t*)(ws + OFF_HYT)};
    EpiProj epr{(float*)(ws + OFF_PROJ)};
    for (int t = bid; t < 128 * 18; t += G) {
      const int nt = t % 18;
      if (nt < 5) gemm_tile<true>((const bf16_t*)(ws + OFF_H), 1024, (const bf16_t*)(ws + OFF_WIN), 1024, 1024, (t / 18) * 128, nt * 128, smem, epr);
      else gemm_tile<false>((const bf16_t*)(ws + OFF_H), 1024, (const bf16_t*)(ws + OFF_WIN), 1024, 1024, (t / 18) * 128, nt * 128, smem, epi);
    }
  } else if constexpr (ph == 3) {
    for (int it = bid; it < 512; it += G) hyena_item<0>(p, 1, it, smem);
    for (int it = bid; it < 512; it += G) hyena_item<0>(p, 0, it, smem);
    for (int it = G - 1 - bid; it < 512; it += G) token_item(p, it);
  } else if constexpr (ph == 4) {
    EpiQ eq{(bf16_t*)(ws + OFF_QRAW)};
    EpiKV ekv{(bf16_t*)(ws + OFF_KRAW), (bf16_t*)(ws + OFF_VTC), (bf16_t*)(ws + OFF_VTL)};
    for (int it = bid; it < 512; it += G) hyena_item<1>(p, 1, it, smem);
    for (int t = bid; t < 768; t += G) gemm_tile<true>((const bf16_t*)(ws + OFF_QA), 384, (const bf16_t*)(ws + OFF_WUQ), 384, 384, (t / 6) * 128, (t % 6) * 128, smem, eq);
    for (int t = bid; t < 1088; t += G) gemm_tile<false>((const bf16_t*)(ws + OFF_CKVN), 256, (const bf16_t*)(ws + OFF_WUKV), 256, 256, (t / 8) * 128, (t % 8) * 128, smem, ekv);
    for (int it = bid; it < 512; it += G) hyena_item<1>(p, 0, it, smem);
  } else if constexpr (ph == 5) {
    for (int it = bid; it < 544; it += G) qk_item(p, 512 + it);
  } else if constexpr (ph == 6) {
    for (int it = bid; it < 1024; it += G) attn_item(p, it, smem);
  } else if constexpr (ph == 7) {
    for (int it = bid; it < 512; it += G) merge_item(p, it, smem);
  } else if constexpr (ph == 8) {
    EpiOut epi{&p};
    if (G == 512) {
      const int x = bid & 7, j = bid >> 3;
      for (int r = 0; r < 2; ++r)
        gemm_tile<true>((const bf16_t*)(ws + OFF_H), 1024, (const bf16_t*)(ws + OFF_WOUT), 1024, 1024, (x * 16 + r * 8 + (j >> 3)) * 128, (j & 7) * 128, smem, epi);
    } else {
      for (int t = bid; t < 128 * 8; t += G)
        gemm_tile<true>((const bf16_t*)(ws + OFF_H), 1024, (const bf16_t*)(ws + OFF_WOUT), 1024, 1024, (t / 8) * 128, (t % 8) * 128, smem, epi);
    }
  } else if constexpr (ph == 9) {
    rmsmod_phase<1>(p);
  } else if constexpr (ph == 10) {
    for (int t = bid; t < 128 * 44; t += G) gemm_up_act_tile(p, (t / 44) * 128, (t % 44) * 128, smem);
  } else if constexpr (ph == 11) {
    for (int it = bid; it < 704; it += G) actfix_item(p, it);
  } else if constexpr (ph == 12) {
    EpiY epi{&p, 0};
    if (G == 512) {
      const int x = bid & 7, j = bid >> 3;
      for (int r = 0; r < 2; ++r)
        gemm_tile<true>((const bf16_t*)(ws + OFF_U), 2816, (const bf16_t*)(ws + OFF_WDOWN), 2816, 2816, (x * 16 + r * 8 + (j >> 3)) * 128, (j & 7) * 128, smem, epi);
    } else {
      for (int t = bid; t < 128 * 8; t += G)
        gemm_tile<true>((const bf16_t*)(ws + OFF_U), 2816, (const bf16_t*)(ws + OFF_WDOWN), 2816, 2816, (t / 8) * 128, (t % 8) * 128, smem, epi);
    }
  }
}

#if ONE_LAUNCH
template <int PH>
__device__ __forceinline__ void run_all(const Params& p, char* smem, cg::grid_group& grid, const XcdBarrier& xb) {
  run_phase<PH>(p, smem);
  if constexpr (((DBL_MASK >> PH) & 1) != 0) { xcd_barrier(xb); run_phase<PH>(p, smem); }
  if constexpr (PH < 12) {
    xcd_barrier(xb);
    run_all<PH + 1>(p, smem, grid, xb);
  }
}
constexpr int DYN_LDS = 65536 + 64;
__global__ void __launch_bounds__(256, 2) mega_kernel(Params p) {
  extern __shared__ __attribute__((aligned(16))) char smem[];
  uint4* xb_words = (uint4*)(smem + 65536);
  cg::grid_group grid = cg::this_grid();
  if (threadIdx.x == 0) *xb_words = make_uint4(0u, 0u, 0u, 0u);
  __syncthreads();
  XcdBarrier xb = xcd_barrier_post((unsigned*)(p.ws + OFF_BAR), (volatile LAS unsigned*)xb_words);
  if (p.ws == nullptr) grid.sync();
  run_all<0>(p, smem, grid, xb);
}
#else
template <int PH>
__global__ void __launch_bounds__(256, 2) phase_kernel(Params p) {
  __shared__ __attribute__((aligned(16))) char smem[SMEM_BYTES];
  run_phase<PH>(p, smem);
}
#ifndef DBG_STOP
#define DBG_STOP 15
#endif
__global__ void dump_kernel(Params p, size_t off, int count) {
  const bf16_t* src = (const bf16_t*)(p.ws + off);
  const bf16_t* src2 = (const bf16_t*)(p.ws + DBG_OFF2);
  for (int i = blockIdx.x * 256 + threadIdx.x; i < 16777216; i += gridDim.x * 256)
    p.out[i] = i < DBG_CNT ? bf2f(src[i]) : (i - DBG_CNT < DBG_CNT2 ? bf2f(src2[i - DBG_CNT]) : 0.f);
}
template <int PH>
static void launch_all(const Params& p, hipStream_t stream) {
  phase_kernel<PH><<<512, 256, 0, stream>>>(p);
  if constexpr (PH < 12) launch_all<PH + 1>(p, stream);
}
#endif

extern "C" void kernel_launch(void* const* d_in, const int* in_sizes, int n_in, void* d_out, int out_size, void* d_ws,
                              size_t ws_size, hipStream_t stream) {
  Params p{};
  const float** pp = (const float**)&p;
  for (int i = 0; i < 34; ++i) pp[i] = (const float*)d_in[i];
  p.out = (float*)d_out;
  p.ws = (char*)d_ws;
#if ONE_LAUNCH
  (void)hipMemsetAsync((char*)d_ws + OFF_BAR, 0, XCD_BAR_WORDS * 4, stream);
  static int grid_blocks = 0;
  if (!grid_blocks) {
    int dev = 0, cus = 0, per_cu = 0;
    hipGetDevice(&dev);
    hipDeviceGetAttribute(&cus, hipDeviceAttributeMultiprocessorCount, dev);
    (void)hipFuncSetAttribute((const void*)mega_kernel, hipFuncAttributeMaxDynamicSharedMemorySize, DYN_LDS);
    (void)hipOccupancyMaxActiveBlocksPerMultiprocessor(&per_cu, mega_kernel, 256, DYN_LDS);
    if (per_cu > 2) per_cu = 2;
    grid_blocks = cus * per_cu;
  }
  void* args[] = {&p};
  hipError_t e = hipLaunchCooperativeKernel((void*)mega_kernel, dim3(grid_blocks), dim3(256), args, DYN_LDS, stream);
  if (e != hipSuccess) fprintf(stderr, "cooperative launch failed: %s (grid %d)\n", hipGetErrorString(e), grid_blocks);
#else
  launch_all<0>(p, stream);
#if DBG_STOP < 15
  dump_kernel<<<1024, 256, 0, stream>>>(p, DBG_OFF, DBG_CNT);
#endif
#endif
}
```

```cpp
#include <hip/hip_runtime.h>
#include <hip/hip_cooperative_groups.h>
#include <cstdio>
namespace cg = cooperative_groups;

#define DBG_STOP 15
#define DBG_NOHY 0
#ifndef DBL_MASK
#define DBL_MASK 0
#endif
#define DBG_OFF OFF_QRAW
#define DBG_OFF2 OFF_KRAW
#define DBG_CNT 12582912
#define DBG_CNT2 0
#ifndef ONE_LAUNCH
#define ONE_LAUNCH 1
#endif

typedef unsigned short bf16_t;
typedef short bf16x8 __attribute__((ext_vector_type(8)));
typedef float f32x4 __attribute__((ext_vector_type(4)));
typedef float f32x16 __attribute__((ext_vector_type(16)));

constexpr int D = 1024, NTOK = 16384, NCTX = 8192, SEQC = 256, SEQL = 4096;
constexpr int DIN = 2208, DINP = 2304, QL = 384, KVL = 256, DFF = 2816;
constexpr int NROWKV = 17408;
constexpr size_t MiB = 1048576;

constexpr size_t OFF_WIN = 0;
constexpr size_t OFF_WUQ = OFF_WIN + (size_t)DINP * 1024 * 2;
constexpr size_t OFF_WUKV = OFF_WUQ + (size_t)768 * 384 * 2;
constexpr size_t OFF_WOUT = OFF_WUKV + (size_t)1024 * 256 * 2;
constexpr size_t OFF_WUP = OFF_WOUT + (size_t)1024 * 1024 * 2;
constexpr size_t OFF_WDOWN = OFF_WUP + (size_t)5632 * 1024 * 2;
constexpr size_t OFF_MOD = OFF_WDOWN + (size_t)1024 * 2816 * 2;
static_assert(OFF_MOD + 3 * 6144 * 4 <= 25 * MiB, "A region");
constexpr size_t OFF_RLAT = 25 * MiB;
constexpr size_t OFF_RCTX = 41 * MiB;
constexpr size_t OFF_H = 42 * MiB;
constexpr size_t OFF_ZT = 42 * MiB;
constexpr size_t OFF_QA = 58 * MiB;
constexpr size_t OFF_KPE = 70 * MiB;
constexpr size_t OFF_PROJ = 74 * MiB;
constexpr size_t OFF_QRAW = 74 * MiB;
constexpr size_t OFF_Y2T = 98 * MiB;
constexpr size_t OFF_ATTN = 116 * MiB;
constexpr size_t OFF_U = 74 * MiB;
constexpr size_t OFF_HYT = 116 * MiB;
constexpr size_t OFF_Q = 116 * MiB;
constexpr size_t OFF_KC = 140 * MiB;
constexpr size_t OFF_KL = 152 * MiB;
constexpr size_t OFF_CKVN = 164 * MiB;
constexpr size_t OFF_KRAW = 173 * MiB;
constexpr size_t OFF_VTC = 190 * MiB;
constexpr size_t OFF_VTL = 198 * MiB;
constexpr size_t OFF_ACT = 162 * MiB;

constexpr int OUT_YS = 0;
constexpr int OUT_CKV = 16777216;
constexpr int OUT_KPE = 16777216 + 2097152;

constexpr int SMEM_BYTES = 51200;

struct Params {
  const float *x_prompt, *x_sample, *cache_ckv, *cache_kpe, *c, *c_ctx, *w_ada, *b_ada, *g_mix, *w_in, *g_qa, *w_uq,
      *g_kva, *w_ukv, *g_q, *g_k, *hy_conv_w, *hy_conv_b, *filt_w1, *filt_b1, *filt_freq1, *filt_w2, *filt_b2,
      *filt_freq2, *filt_w3, *filt_bias, *g_out_att, *g_out_hy, *w_out, *g_ffn, *w_up, *ffn_conv_w, *ffn_conv_b, *w_down;
  float* out;
  char* ws;
};

typedef __bf16 bf16x2_t __attribute__((ext_vector_type(2)));
__device__ __forceinline__ unsigned pack2(float lo, float hi) {
  bf16x2_t v;
  v[0] = (__bf16)lo;
  v[1] = (__bf16)hi;
  return __builtin_bit_cast(unsigned, v);
}
__device__ __forceinline__ float bflo(unsigned u) { return __uint_as_float(u << 16); }
__device__ __forceinline__ float bfhi(unsigned u) { return __uint_as_float(u & 0xffff0000u); }
__device__ __forceinline__ float bf2f(bf16_t h) { return __uint_as_float(((unsigned)h) << 16); }
__device__ __forceinline__ bf16_t f2bf(float f) { return (bf16_t)(pack2(f, 0.f) & 0xffffu); }
__device__ __forceinline__ float wave_sum(float v) {
#pragma unroll
  for (int o = 32; o >= 1; o >>= 1) v += __shfl_xor(v, o);
  return v;
}
__device__ __forceinline__ int ltid() { int t = threadIdx.x; asm volatile("" : "+v"(t)); return t; }
__device__ __forceinline__ float sin_turns(float t) { t -= floorf(t); return __builtin_amdgcn_sinf(t); }
__device__ __forceinline__ float cos_turns(float t) { t -= floorf(t); return __builtin_amdgcn_cosf(t); }
__device__ __forceinline__ float sin_rad(float x) { return sin_turns(x * 0.15915494309189535f); }
__device__ __forceinline__ const float* xrow(const Params& p, int row) {
  return row < NCTX ? p.x_prompt + (size_t)row * D : p.x_sample + (size_t)(row - NCTX) * D;
}
__device__ __forceinline__ int modidx(int row) { return row < NCTX ? 0 : 1 + ((row - NCTX) >> 12); }

template <bool SWAP>
__device__ __forceinline__ void gemm_main(const bf16_t* __restrict__ A, int lda, const bf16_t* __restrict__ Bt, int ldb,
                                          int K, int m0, int n0, char* smem, f32x4 (&acc)[4][4]) {
  const int tid = ltid(), lane = tid & 63, wid = tid >> 6, wr = wid >> 1, wc = wid & 1;
  const int fr = lane & 15, fq = lane >> 4;
  bf16_t* sbase = (bf16_t*)smem;
#pragma unroll
  for (int m = 0; m < 4; ++m)
#pragma unroll
    for (int n = 0; n < 4; ++n) acc[m][n] = (f32x4){0.f, 0.f, 0.f, 0.f};
  const int lr = tid >> 3, lc = (tid & 7) * 8;
  const bf16_t* ga = A + (size_t)(m0 + lr) * lda + lc;
  const bf16_t* gb = Bt + (size_t)(n0 + lr) * ldb + lc;
  const size_t sa32 = (size_t)32 * lda, sb32 = (size_t)32 * ldb;
  uint4 ra0 = *(const uint4*)(ga), ra1 = *(const uint4*)(ga + sa32), ra2 = *(const uint4*)(ga + 2 * sa32), ra3 = *(const uint4*)(ga + 3 * sa32);
  uint4 rb0 = *(const uint4*)(gb), rb1 = *(const uint4*)(gb + sb32), rb2 = *(const uint4*)(gb + 2 * sb32), rb3 = *(const uint4*)(gb + 3 * sb32);
  const int nk = K >> 6;
  const int woff = lr * 64 + (((tid & 7) ^ (lr & 7)) * 8);
  const int aoff = (wr * 64 + fr) * 64, boff = 8192 + (wc * 64 + fr) * 64;
  __syncthreads();
  {
    bf16_t* wa = sbase + woff;
    *(uint4*)(wa) = ra0; *(uint4*)(wa + 32 * 64) = ra1; *(uint4*)(wa + 64 * 64) = ra2; *(uint4*)(wa + 96 * 64) = ra3;
    *(uint4*)(wa + 8192) = rb0; *(uint4*)(wa + 8192 + 32 * 64) = rb1; *(uint4*)(wa + 8192 + 64 * 64) = rb2; *(uint4*)(wa + 8192 + 96 * 64) = rb3;
  }
  if (nk > 1) {
    ga += 64; gb += 64;
    ra0 = *(const uint4*)(ga); ra1 = *(const uint4*)(ga + sa32); ra2 = *(const uint4*)(ga + 2 * sa32); ra3 = *(const uint4*)(ga + 3 * sa32);
    rb0 = *(const uint4*)(gb); rb1 = *(const uint4*)(gb + sb32); rb2 = *(const uint4*)(gb + 2 * sb32); rb3 = *(const uint4*)(gb + 3 * sb32);
  }
  __syncthreads();
  for (int kt = 0; kt < nk; ++kt) {
    const bf16_t* cur = sbase + (kt & 1) * 16384;
    bf16x8 af[2][4], bfr[2][4];
#pragma unroll
    for (int ks = 0; ks < 2; ++ks) {
#pragma unroll
      for (int m = 0; m < 4; ++m) af[ks][m] = *(const bf16x8*)(cur + aoff + m * 16 * 64 + (((ks * 4 + fq) ^ (fr & 7)) * 8));
#pragma unroll
      for (int n = 0; n < 4; ++n) bfr[ks][n] = *(const bf16x8*)(cur + boff + n * 16 * 64 + (((ks * 4 + fq) ^ (fr & 7)) * 8));
    }
    __builtin_amdgcn_sched_barrier(0);
    {
      bf16_t* wa = sbase + ((kt + 1) & 1) * 16384 + woff;
      *(uint4*)(wa) = ra0; *(uint4*)(wa + 32 * 64) = ra1; *(uint4*)(wa + 64 * 64) = ra2; *(uint4*)(wa + 96 * 64) = ra3;
      *(uint4*)(wa + 8192) = rb0; *(uint4*)(wa + 8192 + 32 * 64) = rb1; *(uint4*)(wa + 8192 + 64 * 64) = rb2; *(uint4*)(wa + 8192 + 96 * 64) = rb3;
      const int adv = (kt + 2 < nk) ? 64 : 0;
      ga += adv; gb += adv;
      ra0 = *(const uint4*)(ga); ra1 = *(const uint4*)(ga + sa32); ra2 = *(const uint4*)(ga + 2 * sa32); ra3 = *(const uint4*)(ga + 3 * sa32);
      rb0 = *(const uint4*)(gb); rb1 = *(const uint4*)(gb + sb32); rb2 = *(const uint4*)(gb + 2 * sb32); rb3 = *(const uint4*)(gb + 3 * sb32);
    }
#pragma unroll
    for (int ks = 0; ks < 2; ++ks)
#pragma unroll
      for (int m = 0; m < 4; ++m)
#pragma unroll
        for (int n = 0; n < 4; ++n) {
          if (SWAP) acc[m][n] = __builtin_amdgcn_mfma_f32_16x16x32_bf16(bfr[ks][n], af[ks][m], acc[m][n], 0, 0, 0);
          else acc[m][n] = __builtin_amdgcn_mfma_f32_16x16x32_bf16(af[ks][m], bfr[ks][n], acc[m][n], 0, 0, 0);
        }
#pragma unroll
    for (int i = 0; i < 8; ++i) { __builtin_amdgcn_sched_group_barrier(0x008, 2, 0); __builtin_amdgcn_sched_group_barrier(0x200, 1, 0); }
#pragma unroll
    for (int i = 0; i < 8; ++i) { __builtin_amdgcn_sched_group_barrier(0x008, 2, 0); __builtin_amdgcn_sched_group_barrier(0x020, 1, 0); }
    __builtin_amdgcn_sched_barrier(0);
    if (kt + 1 < nk) __syncthreads();
  }
}
template <bool SWAP, class Epi>
__device__ __forceinline__ void gemm_tile(const bf16_t* __restrict__ A, int lda, const bf16_t* __restrict__ Bt, int ldb,
                                          int K, int m0, int n0, char* smem, const Epi& epi) {
  f32x4 acc[4][4];
  gemm_main<SWAP>(A, lda, Bt, ldb, K, m0, n0, smem, acc);
  const int tid = ltid(), lane = tid & 63, wid = tid >> 6, wr = wid >> 1, wc = wid & 1;
  const int fr = lane & 15, fq = lane >> 4;
#pragma unroll
  for (int m = 0; m < 4; ++m)
#pragma unroll
    for (int n = 0; n < 4; ++n) {
      if (SWAP) epi(m0 + wr * 64 + m * 16 + fr, n0 + wc * 64 + n * 16 + fq * 4, acc[m][n]);
      else epi(m0 + wr * 64 + m * 16 + fq * 4, n0 + wc * 64 + n * 16 + fr, acc[m][n]);
    }
}

template <int CTRL>
__device__ __forceinline__ float dpp_ror(float v) {
  return __int_as_float(__builtin_amdgcn_update_dpp(0, __float_as_int(v), CTRL, 0xF, 0xF, false));
}
constexpr size_t OFF_EDGE = 162 * MiB;
__device__ __forceinline__ void gemm_up_act_tile(const Params& p, int m0, int n0, char* smem) {
  f32x4 acc[4][4];
  gemm_main<true>((const bf16_t*)(p.ws + OFF_H), 1024, (const bf16_t*)(p.ws + OFF_WUP), 1024, 1024, m0, n0, smem, acc);
  const int tid = ltid(), lane = tid & 63, wid = tid >> 6, wr = wid >> 1, wc = wid & 1;
  const int fr = lane & 15, fq = lane >> 4;
  bf16_t* act = (bf16_t*)(p.ws + OFF_U);
  bf16_t* edge = (bf16_t*)(p.ws + OFF_EDGE);
  const int rowbase = m0 + wr * 64, wt = rowbase >> 6;
#pragma unroll
  for (int i = 0; i < 2; ++i) {
    const int cperm = n0 + wc * 64 + 32 * i;
    const int j0 = (cperm >> 5) * 16 + 4 * fq;
    const float4 wa0 = *(const float4*)(p.ffn_conv_w + j0), wa1 = *(const float4*)(p.ffn_conv_w + 5632 + j0), wa2 = *(const float4*)(p.ffn_conv_w + 11264 + j0);
    const float4 wg0 = *(const float4*)(p.ffn_conv_w + 2816 + j0), wg1 = *(const float4*)(p.ffn_conv_w + 5632 + 2816 + j0), wg2 = *(const float4*)(p.ffn_conv_w + 11264 + 2816 + j0);
    const float4 ba = *(const float4*)(p.ffn_conv_b + j0), bg = *(const float4*)(p.ffn_conv_b + 2816 + j0);
    const float w0a[4] = {wa0.x, wa0.y, wa0.z, wa0.w}, w1a[4] = {wa1.x, wa1.y, wa1.z, wa1.w}, w2a[4] = {wa2.x, wa2.y, wa2.z, wa2.w};
    const float w0g[4] = {wg0.x, wg0.y, wg0.z, wg0.w}, w1g[4] = {wg1.x, wg1.y, wg1.z, wg1.w}, w2g[4] = {wg2.x, wg2.y, wg2.z, wg2.w};
    const float bba[4] = {ba.x, ba.y, ba.z, ba.w}, bbg[4] = {bg.x, bg.y, bg.z, bg.w};
#pragma unroll
    for (int m = 0; m < 4; ++m) {
      float o[4];
#pragma unroll
      for (int e = 0; e < 4; ++e) {
        const float a = acc[m][2 * i][e], g = acc[m][2 * i + 1][e];
        const float au1 = dpp_ror<0x121>(a), gu1 = dpp_ror<0x121>(g), ad1 = dpp_ror<0x12F>(a), gd1 = dpp_ror<0x12F>(g);
        float au2 = 0.f, gu2 = 0.f, ad2 = 0.f, gd2 = 0.f;
        if (m > 0) { au2 = dpp_ror<0x121>(acc[m - 1][2 * i][e]); gu2 = dpp_ror<0x121>(acc[m - 1][2 * i + 1][e]); }
        if (m < 3) { ad2 = dpp_ror<0x12F>(acc[m + 1][2 * i][e]); gd2 = dpp_ror<0x12F>(acc[m + 1][2 * i + 1][e]); }
        const float au = fr > 0 ? au1 : au2, gu = fr > 0 ? gu1 : gu2, ad = fr < 15 ? ad1 : ad2, gd = fr < 15 ? gd1 : gd2;
        const float ca = w0a[e] * au + w1a[e] * a + w2a[e] * ad + bba[e];
        const float cgv = w0g[e] * gu + w1g[e] * g + w2g[e] * gd + bbg[e];
        o[e] = ca * __builtin_amdgcn_rcpf(1.f + __expf(-ca)) * cgv;
      }
      const int lr64 = m * 16 + fr, row = rowbase + lr64;
      if (lr64 >= 1 && lr64 <= 62) *(uint2*)(act + (size_t)row * 2816 + j0) = make_uint2(pack2(o[0], o[1]), pack2(o[2], o[3]));
      if (lr64 <= 1 || lr64 >= 62) {
        const int slot = lr64 <= 1 ? lr64 : lr64 - 60;
        bf16_t* er = edge + (size_t)(wt * 4 + slot) * 5632;
        *(uint2*)(er + j0) = make_uint2(pack2(acc[m][2 * i][0], acc[m][2 * i][1]), pack2(acc[m][2 * i][2], acc[m][2 * i][3]));
        *(uint2*)(er + 2816 + j0) = make_uint2(pack2(acc[m][2 * i + 1][0], acc[m][2 * i + 1][1]), pack2(acc[m][2 * i + 1][2], acc[m][2 * i + 1][3]));
      }
    }
  }
}

__device__ __forceinline__ void transpose_item(const float* __restrict__ W, int K, int N, bf16_t* __restrict__ WT, int tile, int ntn, char* smem, bool perm = false) {
  float* s = (float*)smem;
  const int tk = tile / ntn, tn = tile % ntn, tid = ltid();
  const int k0 = tk * 64, n0 = tn * 64;
  __syncthreads();
  {
    const int r = tid >> 4, c4 = (tid & 15) * 4;
#pragma unroll
    for (int i = 0; i < 4; ++i) {
      const int k = r + 16 * i;
      float4 v = make_float4(0.f, 0.f, 0.f, 0.f);
      if (n0 + c4 < N) v = *(const float4*)(W + (size_t)(k0 + k) * N + n0 + c4);
      s[k * 65 + c4 + 0] = v.x; s[k * 65 + c4 + 1] = v.y; s[k * 65 + c4 + 2] = v.z; s[k * 65 + c4 + 3] = v.w;
    }
  }
  __syncthreads();
  {
    const int n = tid >> 2, kc = (tid & 3) * 16;
    unsigned o[8];
#pragma unroll
    for (int i = 0; i < 8; ++i) o[i] = pack2(s[(kc + 2 * i) * 65 + n], s[(kc + 2 * i + 1) * 65 + n]);
    int nr = n0 + n;
    if (perm) { const int hf = nr >= 2816 ? 1 : 0, cc = nr - hf * 2816; nr = 32 * (cc >> 4) + 16 * hf + (cc & 15); }
    uint4* dst = (uint4*)(WT + (size_t)nr * K + k0 + kc);
    dst[0] = make_uint4(o[0], o[1], o[2], o[3]);
    dst[1] = make_uint4(o[4], o[5], o[6], o[7]);
  }
}

__device__ __forceinline__ void mod_item(const Params& p, int item, char* smem) {
  float* s = (float*)smem;
  float* red = s + 3072;
  const int tid = ltid();
  __syncthreads();
  for (int e = tid; e < 3072; e += 256) {
    const int v = e >> 10, k = e & 1023;
    const float x = (v == 0) ? p.c_ctx[k] : p.c[(v - 1) * D + k];
    s[e] = x / (1.f + __expf(-x));
  }
  __syncthreads();
  const int jl = tid & 63, kq = tid >> 6, j = item * 64 + jl, k0 = kq * 256;
  float a0 = 0.f, a1 = 0.f, a2 = 0.f;
#pragma unroll 32
  for (int k = 0; k < 256; ++k) {
    const float w = p.w_ada[(size_t)(k0 + k) * 6144 + j];
    a0 += s[k0 + k] * w; a1 += s[1024 + k0 + k] * w; a2 += s[2048 + k0 + k] * w;
  }
  red[(kq * 3 + 0) * 64 + jl] = a0; red[(kq * 3 + 1) * 64 + jl] = a1; red[(kq * 3 + 2) * 64 + jl] = a2;
  __syncthreads();
  if (tid < 192) {
    const int v = tid >> 6;
    const float r = red[(0 * 3 + v) * 64 + jl] + red[(1 * 3 + v) * 64 + jl] + red[(2 * 3 + v) * 64 + jl] + red[(3 * 3 + v) * 64 + jl];
    ((float*)(p.ws + OFF_MOD))[v * 6144 + j] = r + p.b_ada[j];
  }
}

__device__ __forceinline__ void filter_item(const Params& p, int item2, char* smem) {
  const int item = item2 >> 1, chalf = item2 & 1;
  int n, p0; bf16_t* R;
  if (item < 256) { n = 4096; p0 = item * 16; R = (bf16_t*)(p.ws + OFF_RLAT); }
  else { n = 256; p0 = (item - 256) * 16; R = (bf16_t*)(p.ws + OFF_RCTX); }
  const int n2 = 2 * n, tid = ltid();
  float* z = (float*)smem;
  float* h1 = z + 16 * 36;
  float* h2 = h1 + 16 * 64;
  __syncthreads();
#pragma unroll 1
  for (int e = tid; e < 16 * 33; e += 256) {
    const int pp = e / 33, f = e % 33, pos = p0 + pp;
    float val;
    if (f == 0) val = (float)pos / (float)(n - 1);
    else {
      const int k = (f - 1) & 15;
      const float band = 1e-4f + (float)k * ((15.f - 1e-4f) / 15.f);
      const float turns = band * ((float)pos / (float)n);
      val = (f <= 16) ? cos_turns(turns) : -sin_turns(turns);
    }
    z[pp * 36 + f] = val;
  }
  __syncthreads();
#pragma unroll 1
  for (int e = tid; e < 1024; e += 256) {
    const int pp = e >> 6, j = e & 63;
    float a = p.filt_b1[j];
#pragma unroll 11
    for (int f = 0; f < 33; ++f) a += z[pp * 36 + f] * p.filt_w1[f * 64 + j];
    h1[e] = sin_rad(p.filt_freq1[j] * a);
  }
  __syncthreads();
#pragma unroll 1
  for (int e = tid; e < 1024; e += 256) {
    const int pp = e >> 6, j = e & 63;
    float a = p.filt_b2[j];
#pragma unroll 16
    for (int k = 0; k < 64; ++k) a += h1[pp * 64 + k] * p.filt_w2[k * 64 + j];
    h2[j * 16 + pp] = sin_rad(p.filt_freq2[j] * a);
  }
  __syncthreads();
  const float mind = -3.0701134573253946f, maxd = -15.350567286626973f;
#pragma unroll 1
  for (int ci = 4 * chalf; ci < 4 * chalf + 4; ++ci) {
    const int col = tid + 256 * ci, o = col >> 10, dir = (col >> 9) & 1, c = col & 511;
    float acc[16];
#pragma unroll
    for (int i = 0; i < 16; ++i) acc[i] = 0.f;
#pragma unroll 16
    for (int k = 0; k < 64; ++k) {
      const float w = p.filt_w3[k * 2048 + col];
      const float4 ha = *(const float4*)(h2 + k * 16), hb = *(const float4*)(h2 + k * 16 + 4), hc = *(const float4*)(h2 + k * 16 + 8), hd = *(const float4*)(h2 + k * 16 + 12);
      acc[0] += ha.x * w; acc[1] += ha.y * w; acc[2] += ha.z * w; acc[3] += ha.w * w;
      acc[4] += hb.x * w; acc[5] += hb.y * w; acc[6] += hb.z * w; acc[7] += hb.w * w;
      acc[8] += hc.x * w; acc[9] += hc.y * w; acc[10] += hc.z * w; acc[11] += hc.w * w;
      acc[12] += hd.x * w; acc[13] += hd.y * w; acc[14] += hd.z * w; acc[15] += hd.w * w;
    }
    const float delta = fabsf(mind + (float)c * ((maxd - mind) / 511.f));
    bf16_t* Rrow = R + (size_t)(o * 512 + c) * n2;
#pragma unroll
    for (int i = 0; i < 16; ++i) {
      const int pos = p0 + i;
      const float t = (float)pos / (float)(n - 1);
      float val = acc[i] * (__expf(-t * delta) + 0.05f);
      int idx = dir == 0 ? (n - 1 - pos) : (n - 1 + pos);
      if (dir == 1 && pos == 0) { idx = n2 - 1; val = 0.f; }
      Rrow[idx] = f2bf(val);
    }
  }
}

__device__ __forceinline__ void cache_item(const Params& p, int item) {
  const int tid = ltid(), r0 = item * 32;
  bf16_t* ckvn = (bf16_t*)(p.ws + OFF_CKVN);
#pragma unroll 2
  for (int e = tid; e < 32 * 64; e += 256) {
    const int r = r0 + (e >> 6), c4 = (e & 63) * 4;
    const float4 v = *(const float4*)(p.cache_ckv + (size_t)r * 256 + c4);
    *(uint2*)(ckvn + (size_t)(NTOK + r) * 256 + c4) = make_uint2(pack2(v.x, v.y), pack2(v.z, v.w));
  }
}

template <int WHICH>
__device__ __forceinline__ void rmsmod_phase(const Params& p) {
  const int tid = ltid(), lane = tid & 63, wid = tid >> 6;
  const int gw = blockIdx.x * 4 + wid, tw = gridDim.x * 4;
  const float* g = WHICH == 0 ? p.g_mix : p.g_ffn;
  const float* mod = (const float*)(p.ws + OFF_MOD);
  bf16_t* h = (bf16_t*)(p.ws + OFF_H);
  float4 nv0, nv1, nv2, nv3;
  {
    const float* src = WHICH == 0 ? xrow(p, gw) : p.out + (size_t)gw * D;
    nv0 = ((const float4*)src)[lane]; nv1 = ((const float4*)src)[lane + 64]; nv2 = ((const float4*)src)[lane + 128]; nv3 = ((const float4*)src)[lane + 192];
  }
  for (int row = gw; row < NTOK; row += tw) {
    float4 v[4] = {nv0, nv1, nv2, nv3};
    if (row + tw < NTOK) {
      const float* src = WHICH == 0 ? xrow(p, row + tw) : p.out + (size_t)(row + tw) * D;
      nv0 = ((const float4*)src)[lane]; nv1 = ((const float4*)src)[lane + 64]; nv2 = ((const float4*)src)[lane + 128]; nv3 = ((const float4*)src)[lane + 192];
    }
    float ss = 0.f;
#pragma unroll
    for (int i = 0; i < 4; ++i) ss += v[i].x * v[i].x + v[i].y * v[i].y + v[i].z * v[i].z + v[i].w * v[i].w;
    ss = wave_sum(ss);
    const float r = rsqrtf(ss * (1.f / 1024.f) + 1e-6f);
    const float* mv = mod + modidx(row) * 6144 + (WHICH == 0 ? 0 : 3 * 1024);
#pragma unroll
    for (int i = 0; i < 4; ++i) {
      const int e = 4 * (lane + 64 * i);
      const float4 g4 = *(const float4*)(g + e), sh = *(const float4*)(mv + e), sc = *(const float4*)(mv + 1024 + e);
      const float y0 = v[i].x * r * g4.x * (1.f + sc.x) + sh.x, y1 = v[i].y * r * g4.y * (1.f + sc.y) + sh.y;
      const float y2 = v[i].z * r * g4.z * (1.f + sc.z) + sh.z, y3 = v[i].w * r * g4.w * (1.f + sc.w) + sh.w;
      *(uint2*)(h + (size_t)row * D + e) = make_uint2(pack2(y0, y1), pack2(y2, y3));
    }
  }
}

struct EpiIn {
  float* proj; bf16_t* hyT;
  __device__ __forceinline__ void operator()(int row0, int col, const f32x4& v) const {
    if (col < 672) {
#pragma unroll
      for (int j = 0; j < 4; ++j) proj[(size_t)(row0 + j) * 672 + col] = v[j];
    } else if (col < DIN) {
      *(uint2*)(hyT + (size_t)(col - 672) * NTOK + row0) = make_uint2(pack2(v[0], v[1]), pack2(v[2], v[3]));
    }
  }
};
struct EpiProj {
  float* proj;
  __device__ __forceinline__ void operator()(int row, int col0, const f32x4& v) const { *(f32x4*)(proj + (size_t)row * 672 + col0) = v; }
};
struct EpiQ {
  bf16_t* q;
  __device__ __forceinline__ void operator()(int row, int col0, const f32x4& v) const {
    *(uint2*)(q + (size_t)row * 768 + col0) = make_uint2(pack2(v[0], v[1]), pack2(v[2], v[3]));
  }
};
struct EpiKV {
  bf16_t *kraw, *vtc, *vtl;
  __device__ __forceinline__ void operator()(int row0, int col, const f32x4& v) const {
    const int head = col >> 7, cc = col & 127;
    if (cc < 64) {
#pragma unroll
      for (int j = 0; j < 4; ++j) kraw[(size_t)(row0 + j) * 512 + head * 64 + cc] = f2bf(v[j]);
    } else {
      const int dv = cc - 64;
      bf16_t* dst;
      if (row0 < NCTX) dst = vtc + ((size_t)((row0 >> 8) * 8 + head) * 64 + dv) * 256 + (row0 & 255);
      else if (row0 < NTOK) { const int r = row0 - NCTX; dst = vtl + ((size_t)((r >> 12) * 8 + head) * 64 + dv) * 4608 + (r & 4095); }
      else { const int r = row0 - NTOK; dst = vtl + ((size_t)((r >> 9) * 8 + head) * 64 + dv) * 4608 + 4096 + (r & 511); }
      *(uint2*)dst = make_uint2(pack2(v[0], v[1]), pack2(v[2], v[3]));
    }
  }
};
struct EpiOut {
  const Params* p;
  __device__ __forceinline__ void operator()(int row, int col0, const f32x4& v) const {
    const float4 x = *(const float4*)(xrow(*p, row) + col0);
    const float4 m = *(const float4*)((const float*)(p->ws + OFF_MOD) + modidx(row) * 6144 + 2 * 1024 + col0);
    *(float4*)(p->out + (size_t)row * D + col0) = make_float4(x.x + m.x * v[0], x.y + m.y * v[1], x.z + m.z * v[2], x.w + m.w * v[3]);
  }
};
struct EpiU {
  bf16_t* u;
  __device__ __forceinline__ void operator()(int row, int col0, const f32x4& v) const {
    *(uint2*)(u + (size_t)row * 5632 + col0) = make_uint2(pack2(v[0], v[1]), pack2(v[2], v[3]));
  }
};
struct EpiY {
  const Params* p; int half;
  __device__ __forceinline__ void operator()(int row, int col0, const f32x4& v) const {
    const int grow = half * 8192 + row;
    float4* dst = (float4*)(p->out + (size_t)grow * D + col0);
    const float4 x = *dst;
    const float4 m = *(const float4*)((const float*)(p->ws + OFF_MOD) + modidx(grow) * 6144 + 5 * 1024 + col0);
    *dst = make_float4(x.x + m.x * v[0], x.y + m.y * v[1], x.z + m.z * v[2], x.w + m.w * v[3]);
  }
};

__device__ __forceinline__ void token_item(const Params& p, int item) {
  const int tid = ltid(), lane = tid & 63, wid = tid >> 6;
  const float* proj = (const float*)(p.ws + OFF_PROJ);
  bf16_t* qa = (bf16_t*)(p.ws + OFF_QA);
  bf16_t* ckvn = (bf16_t*)(p.ws + OFF_CKVN);
  float* kpe = (float*)(p.ws + OFF_KPE);
  for (int tt = 0; tt < 8; ++tt) {
    const int token = item * 32 + wid * 8 + tt;
    const float* pr = proj + (size_t)token * 672;
    float2 q[3];
    float ss = 0.f;
#pragma unroll
    for (int i = 0; i < 3; ++i) { q[i] = *(const float2*)(pr + lane * 2 + 128 * i); ss += q[i].x * q[i].x + q[i].y * q[i].y; }
    ss = wave_sum(ss);
    const float r = rsqrtf(ss * (1.f / 384.f) + 1e-6f);
#pragma unroll
    for (int i = 0; i < 3; ++i) {
      const int e = lane * 2 + 128 * i;
      *(unsigned*)(qa + (size_t)token * 384 + e) = pack2(q[i].x * r * p.g_qa[e], q[i].y * r * p.g_qa[e + 1]);
    }
    const float4 kv = *(const float4*)(pr + 384 + lane * 4);
    float s2 = wave_sum(kv.x * kv.x + kv.y * kv.y + kv.z * kv.z + kv.w * kv.w);
    const float r2 = rsqrtf(s2 * (1.f / 256.f) + 1e-6f);
    const float4 g = *(const float4*)(p.g_kva + lane * 4);
    const float4 y = make_float4(kv.x * r2 * g.x, kv.y * r2 * g.y, kv.z * r2 * g.z, kv.w * r2 * g.w);
    *(uint2*)(ckvn + (size_t)token * 256 + lane * 4) = make_uint2(pack2(y.x, y.y), pack2(y.z, y.w));
    if (token < NCTX) *(float4*)(p.out + OUT_CKV + (size_t)token * 256 + lane * 4) = y;
    if (lane < 32) {
      const float kp = pr[640 + lane];
      kpe[(size_t)token * 32 + lane] = kp;
      if (token < NCTX) p.out[OUT_KPE + (size_t)token * 32 + lane] = kp;
    }
  }
}

template <int ORDER>
__device__ __forceinline__ void hyena_item(const Params& p, int grp, int c, char* smem) {
  const int tid = ltid(), lane = tid & 63, wid = tid >> 6, fr = lane & 15, fq = lane >> 4;
  const int n = grp ? SEQL : SEQC, nb = n >> 6, L = n;
  const bf16_t* Rrow = (const bf16_t*)(p.ws + (grp ? OFF_RLAT : OFF_RCTX)) + (size_t)(ORDER * 512 + c) * (2 * n);
  const bf16_t* hyT = (const bf16_t*)(p.ws + OFF_HYT);
  bf16_t* sU = (bf16_t*)smem;
  unsigned* sR0 = (unsigned*)(smem + 18432);
  unsigned* sR1 = (unsigned*)(smem + 18432 + 16384);
  const int tok0 = grp * 8192;
  __syncthreads();
  for (int ch = tid; ch < (2 * n) / 8; ch += 256) *(uint4*)((bf16_t*)sR0 + ch * 8) = *(const uint4*)(Rrow + ch * 8);
  if (ORDER == 0) {
    const bf16_t* raw = hyT + (size_t)c * NTOK + tok0;
    const float w0 = p.hy_conv_w[c], w1 = p.hy_conv_w[1536 + c], w2 = p.hy_conv_w[3072 + c], b = p.hy_conv_b[c];
    for (int ch = tid; ch < 1024; ch += 256) {
      const int t = ch * 8, pos = t & (L - 1);
      const uint4 rv = *(const uint4*)(raw + t);
      float x[10];
      x[0] = pos == 0 ? 0.f : bf2f(raw[t - 1]);
      x[1] = bflo(rv.x); x[2] = bfhi(rv.x); x[3] = bflo(rv.y); x[4] = bfhi(rv.y);
      x[5] = bflo(rv.z); x[6] = bfhi(rv.z); x[7] = bflo(rv.w); x[8] = bfhi(rv.w);
      x[9] = (pos + 8 == L) ? 0.f : bf2f(raw[t + 8]);
      float u[8];
#pragma unroll
      for (int i = 0; i < 8; ++i) u[i] = w0 * x[i] + w1 * x[i + 1] + w2 * x[i + 2] + b;
      *(uint4*)(sU + (ch >> 3) * 64 + (((ch & 7) ^ ((ch >> 3) & 7)) * 8)) = make_uint4(pack2(u[0], u[1]), pack2(u[2], u[3]), pack2(u[4], u[5]), pack2(u[6], u[7]));
    }
  } else {
    const bf16_t* zr = (const bf16_t*)(p.ws + OFF_ZT) + (size_t)c * NTOK + tok0;
    for (int ch = tid; ch < 1024; ch += 256) *(uint4*)(sU + (ch >> 3) * 64 + (((ch & 7) ^ ((ch >> 3) & 7)) * 8)) = *(const uint4*)(zr + ch * 8);
  }
  __syncthreads();
  for (int k = tid; k < n; k += 256) {
    const unsigned a = sR0[k], b2 = (k + 1 < n) ? sR0[k + 1] : 0u;
    sR1[k] = (a >> 16) | (b2 << 16);
  }
  __syncthreads();

  f32x4 acc[4][2];
#pragma unroll
  for (int m = 0; m < 4; ++m) { acc[m][0] = (f32x4){0.f, 0.f, 0.f, 0.f}; acc[m][1] = (f32x4){0.f, 0.f, 0.f, 0.f}; }
  const unsigned* abase = (fr & 1) ? (sR0 + ((n - 1 - fr) >> 1) + 4 * fq) : (sR1 + ((n - 2 - fr) >> 1) + 4 * fq);
  const int col0 = 32 * wid + fr, col1 = col0 + 16;
  const int i0 = col0 & (nb - 1), i1 = col1 & (nb - 1);
  for (int d = -(nb - 1); d <= nb - 1; ++d) {
    const bool v0 = (unsigned)(i0 - d) < (unsigned)nb, v1 = (unsigned)(i1 - d) < (unsigned)nb;
    const bool any0 = __ballot(v0) != 0ull, any1 = __ballot(v1) != 0ull;
    if (!any0 && !any1) continue;
    bf16x8 F[6];
    const unsigned* ap = abase - 32 * d + 16;
#pragma unroll
    for (int idx = 0; idx < 6; ++idx) {
      const unsigned* q = ap - 8 * idx;
      union { unsigned u[4]; bf16x8 v; } cv;
      cv.u[0] = q[0]; cv.u[1] = q[1]; cv.u[2] = q[2]; cv.u[3] = q[3];
      F[idx] = cv.v;
    }
#pragma unroll
    for (int nt = 0; nt < 2; ++nt) {
      if (!(nt ? any1 : any0)) continue;
      const bool vv = nt ? v1 : v0;
      const int srow = (nt ? col1 : col0) - d;
      const bf16_t* up = sU + srow * 64;
#pragma unroll
      for (int ks = 0; ks < 2; ++ks) {
        bf16x8 bf = (bf16x8){0, 0, 0, 0, 0, 0, 0, 0};
        if (vv) bf = *(const bf16x8*)(up + (((ks * 4 + fq) ^ (srow & 7)) * 8));
#pragma unroll
        for (int m = 0; m < 4; ++m)
          acc[m][nt] = __builtin_amdgcn_mfma_f32_16x16x32_bf16(F[m + 2 - 2 * ks], bf, acc[m][nt], 0, 0, 0);
      }
    }
  }
  const float skip = p.filt_bias[ORDER * 512 + c];
  const int gcol = (ORDER == 0 ? 512 : 1024) + c;
  const bf16_t* graw = hyT + (size_t)gcol * NTOK + tok0;
  const float w0 = p.hy_conv_w[gcol], w1 = p.hy_conv_w[1536 + gcol], w2 = p.hy_conv_w[3072 + gcol], b = p.hy_conv_b[gcol];
  bf16_t* outT = (bf16_t*)(p.ws + (ORDER == 0 ? OFF_ZT : OFF_Y2T)) + (size_t)c * NTOK + tok0;
#pragma unroll
  for (int nt = 0; nt < 2; ++nt) {
    const int col = nt ? col1 : col0;
#pragma unroll
    for (int m = 0; m < 4; ++m) {
      const int t = col * 64 + 16 * m + 4 * fq, pos = t & (L - 1);
      const uint2 uu = *(const uint2*)(sU + col * 64 + (((2 * m + (fq >> 1)) ^ (col & 7)) * 8) + 4 * (fq & 1));
      const uint2 gv = *(const uint2*)(graw + t);
      float x[6];
      x[0] = pos == 0 ? 0.f : bf2f(graw[t - 1]);
      x[1] = bflo(gv.x); x[2] = bfhi(gv.x); x[3] = bflo(gv.y); x[4] = bfhi(gv.y);
      x[5] = (pos + 4 == L) ? 0.f : bf2f(graw[t + 4]);
      const float u4[4] = {bflo(uu.x), bfhi(uu.x), bflo(uu.y), bfhi(uu.y)};
      float o[4];
#pragma unroll
      for (int j = 0; j < 4; ++j) {
        const float gate = w0 * x[j] + w1 * x[j + 1] + w2 * x[j + 2] + b;
        o[j] = gate * (acc[m][nt][j] + skip * u4[j]);
      }
      *(uint2*)(outT + t) = make_uint2(pack2(o[0], o[1]), pack2(o[2], o[3]));
    }
  }
}

__device__ __forceinline__ void rope32(float* y  , int pos) {
  const float prow = (float)(pos >> 6), pcol = (float)(pos & 63);
  const float fr[8] = {1.f, 0.31622776601683794f, 0.1f, 0.031622776601683794f, 0.01f, 0.0031622776601683794f, 0.001f, 0.00031622776601683794f};
#pragma unroll
  for (int i = 0; i < 8; ++i) {
    const float tr = prow * fr[i] * 0.15915494309189535f, tc = pcol * fr[i] * 0.15915494309189535f;
    const float sr = sin_turns(tr), cr = cos_turns(tr), sc = sin_turns(tc), cc = cos_turns(tc);
    const float a = y[i], b = y[8 + i], c2 = y[16 + i], d2 = y[24 + i];
    y[i] = a * cr - b * sr; y[8 + i] = b * cr + a * sr;
    y[16 + i] = c2 * cc - d2 * sc; y[24 + i] = d2 * cc + c2 * sc;
  }
}
__device__ __forceinline__ void unpack8(const uint4& v, float* x) {
  x[0] = bflo(v.x); x[1] = bfhi(v.x); x[2] = bflo(v.y); x[3] = bfhi(v.y);
  x[4] = bflo(v.z); x[5] = bfhi(v.z); x[6] = bflo(v.w); x[7] = bfhi(v.w);
}
__device__ __forceinline__ float sumsq8(const uint4& v) {
  float x[8];
  unpack8(v, x);
  return x[0] * x[0] + x[1] * x[1] + x[2] * x[2] + x[3] * x[3] + x[4] * x[4] + x[5] * x[5] + x[6] * x[6] + x[7] * x[7];
}
__device__ __forceinline__ uint4 scale8(const uint4& v, float r, const float* __restrict__ g) {
  float x[8];
  unpack8(v, x);
  const float4 g0 = *(const float4*)g, g1 = *(const float4*)(g + 4);
  return make_uint4(pack2(x[0] * r * g0.x, x[1] * r * g0.y), pack2(x[2] * r * g0.z, x[3] * r * g0.w),
                    pack2(x[4] * r * g1.x, x[5] * r * g1.y), pack2(x[6] * r * g1.z, x[7] * r * g1.w));
}
__device__ __forceinline__ void qk_item(const Params& p, int item) {
  const int tid = ltid();
  if (item < 512) {
    const int idx = item * 256 + tid, row = idx >> 3, h = idx & 7;
    const bf16_t* src = (const bf16_t*)(p.ws + OFF_QRAW) + (size_t)row * 768 + h * 96;
    bf16_t* dst = (bf16_t*)(p.ws + OFF_Q) + (size_t)row * 768 + h * 96;
    uint4 raw[12];
#pragma unroll
    for (int i = 0; i < 12; ++i) raw[i] = *(const uint4*)(src + 8 * i);
    float ss = 0.f;
#pragma unroll
    for (int i = 0; i < 12; ++i) ss += sumsq8(raw[i]);
    const float r = rsqrtf(ss * (1.f / 96.f) + 1e-6f);
    const float qs = 0.10206207261596575f * 1.4426950408889634f;
#pragma unroll
    for (int i = 0; i < 8; ++i) *(uint4*)(dst + 8 * i) = scale8(raw[i], r * qs, p.g_q + 8 * i);
    float y[32];
#pragma unroll
    for (int i = 0; i < 4; ++i) unpack8(raw[8 + i], y + 8 * i);
#pragma unroll
    for (int i = 0; i < 32; ++i) y[i] = y[i] * r * p.g_q[64 + i];
    if (row >= NCTX) rope32(y, (row - NCTX) & 4095);
#pragma unroll
    for (int i = 0; i < 4; ++i)
      *(uint4*)(dst + 64 + 8 * i) = make_uint4(pack2(y[8 * i] * qs, y[8 * i + 1] * qs), pack2(y[8 * i + 2] * qs, y[8 * i + 3] * qs),
                                               pack2(y[8 * i + 4] * qs, y[8 * i + 5] * qs), pack2(y[8 * i + 6] * qs, y[8 * i + 7] * qs));
  } else {
    const int idx = (item - 512) * 256 + tid, row = idx >> 3, h = idx & 7;
    const bf16_t* src = (const bf16_t*)(p.ws + OFF_KRAW) + (size_t)row * 512 + h * 64;
    uint4 raw[8];
#pragma unroll
    for (int i = 0; i < 8; ++i) raw[i] = *(const uint4*)(src + 8 * i);
    const float* kp = row < NTOK ? (const float*)(p.ws + OFF_KPE) + (size_t)row * 32 : p.cache_kpe + (size_t)(row - NTOK) * 32;
    float y[32];
#pragma unroll
    for (int i = 0; i < 8; ++i) {
      const float4 v = *(const float4*)(kp + 4 * i);
      y[4 * i] = v.x; y[4 * i + 1] = v.y; y[4 * i + 2] = v.z; y[4 * i + 3] = v.w;
    }
    float ss = 0.f;
#pragma unroll
    for (int i = 0; i < 8; ++i) ss += sumsq8(raw[i]);
#pragma unroll
    for (int i = 0; i < 32; ++i) ss += y[i] * y[i];
    const float r = rsqrtf(ss * (1.f / 96.f) + 1e-6f);
#pragma unroll
    for (int i = 0; i < 32; ++i) y[i] = y[i] * r * p.g_k[64 + i];
    bf16_t* dst;
    if (row < NCTX) dst = (bf16_t*)(p.ws + OFF_KC) + ((size_t)((row >> 8) * 8 + h) * 256 + (row & 255)) * 96;
    else if (row < NTOK) {
      const int rr = row - NCTX;
      rope32(y, rr & 4095);
      dst = (bf16_t*)(p.ws + OFF_KL) + ((size_t)((rr >> 12) * 8 + h) * 4608 + (rr & 4095)) * 96;
    } else {
      const int rr = row - NTOK;
      dst = (bf16_t*)(p.ws + OFF_KL) + ((size_t)((rr >> 9) * 8 + h) * 4608 + 4096 + (rr & 511)) * 96;
    }
#pragma unroll
    for (int i = 0; i < 8; ++i) *(uint4*)(dst + 8 * i) = scale8(raw[i], r, p.g_k + 8 * i);
#pragma unroll
    for (int i = 0; i < 4; ++i)
      *(uint4*)(dst + 64 + 8 * i) = make_uint4(pack2(y[8 * i], y[8 * i + 1]), pack2(y[8 * i + 2], y[8 * i + 3]),
                                               pack2(y[8 * i + 4], y[8 * i + 5]), pack2(y[8 * i + 6], y[8 * i + 7]));
  }
}

__device__ __forceinline__ void attn_item(const Params& p, int item, char* smem) {
  const int tid = ltid(), lane = tid & 63, wid = tid >> 6, lr = lane & 31, lh = lane >> 5;
  int nkeys, h, tokbase; const bf16_t *Kp, *Vp;
  if (item < 512) {
    const int b = item >> 8, rem = item & 255; h = rem >> 5; const int qb = rem & 31;
    nkeys = 4608; tokbase = NCTX + b * 4096 + qb * 128;
    Kp = (const bf16_t*)(p.ws + OFF_KL) + (size_t)(b * 8 + h) * 4608 * 96;
    Vp = (const bf16_t*)(p.ws + OFF_VTL) + (size_t)(b * 8 + h) * 64 * 4608;
  } else {
    const int it = item - 512, b = it >> 4; h = (it & 15) >> 1; const int qb = it & 1;
    nkeys = 256; tokbase = b * 256 + qb * 128;
    Kp = (const bf16_t*)(p.ws + OFF_KC) + (size_t)(b * 8 + h) * 256 * 96;
    Vp = (const bf16_t*)(p.ws + OFF_VTC) + (size_t)(b * 8 + h) * 64 * 256;
  }
  bf16_t* sK = (bf16_t*)smem;
  bf16_t* sV = sK + 64 * 104;
  const int token = tokbase + 32 * wid + lr;
  bf16x8 qf[6];
  {
    const bf16_t* qsrc = (const bf16_t*)(p.ws + OFF_QRAW) + (size_t)token * 768 + h * 96 + 8 * lh;
    uint4 qr[6];
#pragma unroll
    for (int ks = 0; ks < 6; ++ks) qr[ks] = *(const uint4*)(qsrc + 16 * ks);
    float ss = 0.f;
#pragma unroll
    for (int ks = 0; ks < 6; ++ks) ss += sumsq8(qr[ks]);
    ss += __shfl_xor(ss, 32);
    const float r = rsqrtf(ss * (1.f / 96.f) + 1e-6f);
    const float qs = 0.10206207261596575f * 1.4426950408889634f;
    const bool lat = item < 512;
    const int pos = (token - NCTX) & 4095;
    const float prow = (float)(pos >> 6), pcol = (float)(pos & 63);
    const float frq[8] = {1.f, 0.31622776601683794f, 0.1f, 0.031622776601683794f, 0.01f, 0.0031622776601683794f, 0.001f, 0.00031622776601683794f};
#pragma unroll
    for (int ks = 0; ks < 6; ++ks) {
      float y[8];
      unpack8(qr[ks], y);
      const float* gq = p.g_q + 16 * ks + 8 * lh;
#pragma unroll
      for (int e = 0; e < 8; ++e) y[e] = y[e] * r * gq[e];
      if (ks >= 4) {
#pragma unroll
        for (int e = 0; e < 8; ++e) {
          const float other = __shfl_xor(y[e], 32);
          const float t = (ks == 4 ? prow : pcol) * frq[e] * 0.15915494309189535f;
          const float sn = sin_turns(t), cs = cos_turns(t);
          const float rot = y[e] * cs + (lh ? other : -other) * sn;
          y[e] = lat ? rot : y[e];
        }
      }
      union { unsigned u[4]; bf16x8 v; } pk;
      pk.u[0] = pack2(y[0] * qs, y[1] * qs); pk.u[1] = pack2(y[2] * qs, y[3] * qs); pk.u[2] = pack2(y[4] * qs, y[5] * qs); pk.u[3] = pack2(y[6] * qs, y[7] * qs);
      qf[ks] = pk.v;
    }
  }
  f32x16 oacc[2];
#pragma unroll
  for (int j = 0; j < 16; ++j) { oacc[0][j] = 0.f; oacc[1][j] = 0.f; }
  float mrun = -1e30f, lsum = 0.f;
  const int kk0 = tid / 12, kc0 = tid % 12, kk1 = (tid + 256) / 12, kc1 = (tid + 256) % 12, kk2 = (tid + 512) / 12, kc2 = (tid + 512) % 12;
  const int vd0 = tid >> 3, vc0 = tid & 7, vd1 = vd0 + 32;
  const bf16_t* gk0 = Kp + (size_t)kk0 * 96 + kc0 * 8;
  const bf16_t* gk1 = Kp + (size_t)kk1 * 96 + kc1 * 8;
  const bf16_t* gk2 = Kp + (size_t)kk2 * 96 + kc2 * 8;
  const bf16_t* gv0 = Vp + (size_t)vd0 * nkeys + vc0 * 8;
  const bf16_t* gv1 = Vp + (size_t)vd1 * nkeys + vc0 * 8;
  uint4 rk0 = *(const uint4*)gk0, rk1 = *(const uint4*)gk1, rk2 = *(const uint4*)gk2;
  uint4 rv0 = *(const uint4*)gv0, rv1 = *(const uint4*)gv1;
  const int nt = nkeys >> 6;
  for (int kt = 0; kt < nt; ++kt) {
    __syncthreads();
    *(uint4*)(sK + kk0 * 104 + kc0 * 8) = rk0; *(uint4*)(sK + kk1 * 104 + kc1 * 8) = rk1; *(uint4*)(sK + kk2 * 104 + kc2 * 8) = rk2;
    *(uint4*)(sV + vd0 * 72 + vc0 * 8) = rv0; *(uint4*)(sV + vd1 * 72 + vc0 * 8) = rv1;
    __syncthreads();
    if (kt + 1 < nt) {
      gk0 += 64 * 96; gk1 += 64 * 96; gk2 += 64 * 96; gv0 += 64; gv1 += 64;
      rk0 = *(const uint4*)gk0; rk1 = *(const uint4*)gk1; rk2 = *(const uint4*)gk2;
      rv0 = *(const uint4*)gv0; rv1 = *(const uint4*)gv1;
    }
    __builtin_amdgcn_sched_barrier(0);
    f32x16 sacc[2];
#pragma unroll
    for (int kb = 0; kb < 2; ++kb) {
#pragma unroll
      for (int j = 0; j < 16; ++j) sacc[kb][j] = 0.f;
#pragma unroll
      for (int ks = 0; ks < 6; ++ks) {
        const bf16x8 a = *(const bf16x8*)(sK + (32 * kb + lr) * 104 + 16 * ks + 8 * lh);
        sacc[kb] = __builtin_amdgcn_mfma_f32_32x32x16_bf16(a, qf[ks], sacc[kb], 0, 0, 0);
      }
    }
    float mx = sacc[0][0];
#pragma unroll
    for (int j = 1; j < 16; ++j) mx = fmaxf(mx, sacc[0][j]);
#pragma unroll
    for (int j = 0; j < 16; ++j) mx = fmaxf(mx, sacc[1][j]);
    mx = fmaxf(mx, __shfl_xor(mx, 32));
    const float mnew = fmaxf(mrun, mx);
    const float alpha = __builtin_amdgcn_exp2f(mrun - mnew);
    mrun = mnew;
    float ps = 0.f;
#pragma unroll
    for (int kb = 0; kb < 2; ++kb)
#pragma unroll
      for (int j = 0; j < 16; ++j) { const float e = __builtin_amdgcn_exp2f(sacc[kb][j] - mnew); sacc[kb][j] = e; ps += e; }
    lsum = lsum * alpha + ps;
    if (__ballot(alpha != 1.f) != 0ull) {
#pragma unroll
      for (int j = 0; j < 16; ++j) { oacc[0][j] *= alpha; oacc[1][j] *= alpha; }
    }
#pragma unroll
    for (int s = 0; s < 4; ++s) {
      const int kb = s >> 1, jb = 8 * (s & 1);
      union { unsigned u[4]; bf16x8 v; } pf;
      pf.u[0] = pack2(sacc[kb][jb + 0], sacc[kb][jb + 1]); pf.u[1] = pack2(sacc[kb][jb + 2], sacc[kb][jb + 3]);
      pf.u[2] = pack2(sacc[kb][jb + 4], sacc[kb][jb + 5]); pf.u[3] = pack2(sacc[kb][jb + 6], sacc[kb][jb + 7]);
#pragma unroll
      for (int mt = 0; mt < 2; ++mt) {
        const bf16_t* vp = sV + (32 * mt + lr) * 72 + 16 * s + 4 * lh;
        union { uint2 d[2]; bf16x8 v; } av;
        av.d[0] = *(const uint2*)vp;
        av.d[1] = *(const uint2*)(vp + 8);
        oacc[mt] = __builtin_amdgcn_mfma_f32_32x32x16_bf16(av.v, pf.v, oacc[mt], 0, 0, 0);
      }
    }
  }
  lsum += __shfl_xor(lsum, 32);
  const float inv = 1.f / lsum;
  bf16_t* dst = (bf16_t*)(p.ws + OFF_ATTN) + (size_t)token * 512 + h * 64;
#pragma unroll
  for (int mt = 0; mt < 2; ++mt)
#pragma unroll
    for (int jg = 0; jg < 4; ++jg) {
      const int dv0 = 32 * mt + 8 * jg + 4 * lh;
      *(uint2*)(dst + dv0) = make_uint2(pack2(oacc[mt][4 * jg] * inv, oacc[mt][4 * jg + 1] * inv),
                                        pack2(oacc[mt][4 * jg + 2] * inv, oacc[mt][4 * jg + 3] * inv));
    }
}

__device__ __forceinline__ void merge_item(const Params& p, int item, char* smem) {
  const int tid = ltid(), lane = tid & 63, wid = tid >> 6, t0 = item * 32;
  bf16_t* mix = (bf16_t*)(p.ws + OFF_H);
  const bf16_t* attn = (const bf16_t*)(p.ws + OFF_ATTN);
  for (int tt = 0; tt < 8; ++tt) {
    const int token = t0 + wid * 8 + tt;
    float x[8];
    unpack8(*(const uint4*)(attn + (size_t)token * 512 + lane * 8), x);
    float ss = 0.f;
#pragma unroll
    for (int i = 0; i < 8; ++i) ss += x[i] * x[i];
    ss = wave_sum(ss);
    const float r = rsqrtf(ss * (1.f / 512.f) + 1e-6f);
    const float4 g0 = *(const float4*)(p.g_out_att + lane * 8), g1 = *(const float4*)(p.g_out_att + lane * 8 + 4);
    *(uint4*)(mix + (size_t)token * D + lane * 8) =
        make_uint4(pack2(x[0] * r * g0.x, x[1] * r * g0.y), pack2(x[2] * r * g0.z, x[3] * r * g0.w),
                   pack2(x[4] * r * g1.x, x[5] * r * g1.y), pack2(x[6] * r * g1.z, x[7] * r * g1.w));
  }
  bf16_t* sT = (bf16_t*)smem;
  const bf16_t* y2T = (const bf16_t*)(p.ws + OFF_Y2T);
  __syncthreads();
  for (int ch = tid; ch < 2048; ch += 256) {
    const int c = ch >> 2, q4 = ch & 3;
    const uint4 v = *(const uint4*)(y2T + (size_t)c * NTOK + t0 + q4 * 8);
    bf16_t* d = sT + (q4 * 8) * 520 + c;
    d[0 * 520] = (bf16_t)(v.x & 0xffff); d[1 * 520] = (bf16_t)(v.x >> 16);
    d[2 * 520] = (bf16_t)(v.y & 0xffff); d[3 * 520] = (bf16_t)(v.y >> 16);
    d[4 * 520] = (bf16_t)(v.z & 0xffff); d[5 * 520] = (bf16_t)(v.z >> 16);
    d[6 * 520] = (bf16_t)(v.w & 0xffff); d[7 * 520] = (bf16_t)(v.w >> 16);
  }
  __syncthreads();
  {
    const int tt = tid >> 3, part = tid & 7;
    uint4 v[8];
    float ss = 0.f;
#pragma unroll
    for (int i = 0; i < 8; ++i) {
      v[i] = *(const uint4*)(sT + tt * 520 + part * 64 + 8 * i);
      float x[8];
      unpack8(v[i], x);
#pragma unroll
      for (int e = 0; e < 8; ++e) ss += x[e] * x[e];
    }
    ss += __shfl_xor(ss, 1); ss += __shfl_xor(ss, 2); ss += __shfl_xor(ss, 4);
    const float r = rsqrtf(ss * (1.f / 512.f) + 1e-6f);
#pragma unroll
    for (int i = 0; i < 8; ++i) {
      float x[8];
      unpack8(v[i], x);
      const int c0 = part * 64 + 8 * i;
      const float4 g0 = *(const float4*)(p.g_out_hy + c0), g1 = *(const float4*)(p.g_out_hy + c0 + 4);
      *(uint4*)(mix + (size_t)(t0 + tt) * D + 512 + c0) =
          make_uint4(pack2(x[0] * r * g0.x, x[1] * r * g0.y), pack2(x[2] * r * g0.z, x[3] * r * g0.w),
                     pack2(x[4] * r * g1.x, x[5] * r * g1.y), pack2(x[6] * r * g1.z, x[7] * r * g1.w));
    }
  }
}

__device__ __forceinline__ void actfix_item(const Params& p, int item) {
  const int idx = item * 256 + ltid();
  if (idx >= 512 * 352) return;
  const int j = (idx % 352) * 8, rowi = idx / 352, wt = rowi >> 1, which = rowi & 1;
  const int t = 64 * wt + 63 * which, L = t < NCTX ? SEQC : SEQL, pos = t & (L - 1);
  const bf16_t* edge = (const bf16_t*)(p.ws + OFF_EDGE);
  bf16_t* act = (bf16_t*)(p.ws + OFF_U);
  const bf16_t *pr, *cu, *nx;
  bool zp = false, zn = false;
  if (which == 0) { zp = pos == 0; pr = edge + (size_t)((zp ? wt : wt - 1) * 4 + 3) * 5632; cu = edge + (size_t)(wt * 4 + 0) * 5632; nx = edge + (size_t)(wt * 4 + 1) * 5632; }
  else { zn = pos == L - 1; pr = edge + (size_t)(wt * 4 + 2) * 5632; cu = edge + (size_t)(wt * 4 + 3) * 5632; nx = edge + (size_t)((zn ? wt : wt + 1) * 4 + 0) * 5632; }
  float pa[8], pg[8], ca[8], cgv[8], na[8], ng[8];
  unpack8(*(const uint4*)(pr + j), pa); unpack8(*(const uint4*)(pr + 2816 + j), pg);
  unpack8(*(const uint4*)(cu + j), ca); unpack8(*(const uint4*)(cu + 2816 + j), cgv);
  unpack8(*(const uint4*)(nx + j), na); unpack8(*(const uint4*)(nx + 2816 + j), ng);
  float o[8];
#pragma unroll
  for (int e = 0; e < 8; ++e) {
    const float pae = zp ? 0.f : pa[e], pge = zp ? 0.f : pg[e], nae = zn ? 0.f : na[e], nge = zn ? 0.f : ng[e];
    const float a = p.ffn_conv_w[j + e] * pae + p.ffn_conv_w[5632 + j + e] * ca[e] + p.ffn_conv_w[11264 + j + e] * nae + p.ffn_conv_b[j + e];
    const float g = p.ffn_conv_w[2816 + j + e] * pge + p.ffn_conv_w[5632 + 2816 + j + e] * cgv[e] + p.ffn_conv_w[11264 + 2816 + j + e] * nge + p.ffn_conv_b[2816 + j + e];
    o[e] = a * __builtin_amdgcn_rcpf(1.f + __expf(-a)) * g;
  }
  *(uint4*)(act + (size_t)t * 2816 + j) = make_uint4(pack2(o[0], o[1]), pack2(o[2], o[3]), pack2(o[4], o[5]), pack2(o[6], o[7]));
}

#define XB_TMO      128
#define XB_XCNT(j)  (256  + 64 * (j))
#define XB_XSUB(j)  (1280 + 64 * (j))
#define XB_XGEN(j)  (2304 + 64 * (j))
#define XB_TOP      3328
#define XB_TOPGEN   3392
#define XCD_BAR_WORDS 3456
#define XB_SPIN_CAP (1u << 20)
#define LAS __attribute__((address_space(3)))
__device__ __forceinline__ unsigned xb_ld(unsigned* p) { return __hip_atomic_load(p, __ATOMIC_RELAXED, __HIP_MEMORY_SCOPE_AGENT); }
__device__ __forceinline__ unsigned xb_add(unsigned* p, unsigned v) { return __hip_atomic_fetch_add(p, v, __ATOMIC_RELAXED, __HIP_MEMORY_SCOPE_AGENT); }
__device__ __forceinline__ unsigned xb_xcc_id() { return (unsigned)__builtin_amdgcn_s_getreg((3 << 11) | 20) & 0xFu; }
#define XB_SPIN(cond, bar) do { unsigned _sp = 0; while (cond) { __builtin_amdgcn_s_sleep(1); \
    if ((++_sp & 255u) == 0u) { if (xb_ld(&(bar)[XB_TMO])) break; if (_sp > XB_SPIN_CAP) { atomicAdd(&(bar)[XB_TMO], 1u); break; } } } } while (0)
struct XcdBarrier { unsigned* bar; unsigned x; volatile LAS unsigned* st; };
__device__ __forceinline__ XcdBarrier xcd_barrier_post(unsigned* bar, volatile LAS unsigned* st) {
  XcdBarrier b; b.bar = bar; b.x = xb_xcc_id(); b.st = st;
  if (threadIdx.x == 0) (void)xb_add(&bar[XB_XCNT(b.x)], 1u);
  return b;
}
__device__ __forceinline__ void xcd_barrier_complete(unsigned* bar, unsigned x, unsigned& nloc, unsigned& nx) {
  const unsigned G = gridDim.x * gridDim.y * gridDim.z;
  unsigned sum, cnt, mine, sp = 0u;
  for (;;) {
    sum = 0u; cnt = 0u; mine = 0u;
#pragma unroll
    for (unsigned j = 0; j < 16; ++j) { const unsigned c = xb_ld(&bar[XB_XCNT(j)]); sum += c; cnt += (c > 0u) ? 1u : 0u; mine = (j == x) ? c : mine; }
    if (sum == G) break;
    __builtin_amdgcn_s_sleep(1);
    if ((++sp & 255u) == 0u) { if (xb_ld(&bar[XB_TMO])) break; if (sp > XB_SPIN_CAP) { atomicAdd(&bar[XB_TMO], 1u); break; } }
  }
  nloc = mine > 0u ? mine : 1u; nx = cnt > 0u ? cnt : 1u;
}
__device__ __forceinline__ void xcd_barrier(const XcdBarrier& b) {
  asm volatile("s_waitcnt vmcnt(0)" ::: "memory");
  __syncthreads();
  if (threadIdx.x == 0) {
    unsigned* bar = b.bar;
    __builtin_amdgcn_s_waitcnt(0);
    unsigned nloc = b.st[0], nx = b.st[1];
    if (nloc == 0u) { xcd_barrier_complete(bar, b.x, nloc, nx); b.st[0] = nloc; b.st[1] = nx; }
    const unsigned old = xb_add(&bar[XB_XSUB(b.x)], 1u);
    const unsigned gen = old / nloc;
    if (old + 1u == (gen + 1u) * nloc) {
      __builtin_amdgcn_fence(__ATOMIC_RELEASE, "agent");
      asm volatile("s_waitcnt vmcnt(0)" ::: "memory");
      const unsigned og = xb_add(&bar[XB_TOP], 1u);
      const unsigned tg = og / nx;
      if (og + 1u == (tg + 1u) * nx) xb_add(&bar[XB_TOPGEN], 1u);
      else XB_SPIN(xb_ld(&bar[XB_TOPGEN]) == tg, bar);
      __builtin_amdgcn_fence(__ATOMIC_ACQUIRE, "agent");
      xb_add(&bar[XB_XGEN(b.x)], 1u);
      asm volatile("s_waitcnt vmcnt(0)" ::: "memory");
    } else {
      XB_SPIN(xb_ld(&bar[XB_XGEN(b.x)]) == gen, bar);
      __builtin_amdgcn_fence(__ATOMIC_ACQUIRE, "agent");
      asm volatile("s_waitcnt vmcnt(0)" ::: "memory");
    }
  }
  __syncthreads();
}
constexpr size_t OFF_BAR = 25 * MiB - 16384;
static_assert(OFF_MOD + 3 * 6144 * 4 <= OFF_BAR, "bar");

template <int ph>
__device__ __forceinline__ void run_phase(const Params& p, char* smem) {
  const int bid = blockIdx.x, G = gridDim.x;
  char* ws = p.ws;
  if constexpr (ph == 0) {
    for (int it = bid; it < 544 + 96 + 32 + 3080; it += G) {
      if (it < 544) filter_item(p, it, smem);
      else if (it < 640) mod_item(p, it - 544, smem);
      else if (it < 672) cache_item(p, it - 640);
      else {
        int t = it - 672;
        if (t < 576) transpose_item(p.w_in, 1024, DIN, (bf16_t*)(ws + OFF_WIN), t, 36, smem);
        else if ((t -= 576) < 72) transpose_item(p.w_uq, 384, 768, (bf16_t*)(ws + OFF_WUQ), t, 12, smem);
        else if ((t -= 72) < 64) transpose_item(p.w_ukv, 256, 1024, (bf16_t*)(ws + OFF_WUKV), t, 16, smem);
        else if ((t -= 64) < 256) transpose_item(p.w_out, 1024, 1024, (bf16_t*)(ws + OFF_WOUT), t, 16, smem);
        else if ((t -= 256) < 1408) transpose_item(p.w_up, 1024, 5632, (bf16_t*)(ws + OFF_WUP), t, 88, smem, true);
        else { t -= 1408; transpose_item(p.w_down, 2816, 1024, (bf16_t*)(ws + OFF_WDOWN), t, 16, smem); }
      }
    }
  } else if constexpr (ph == 1) {
    rmsmod_phase<0>(p);
  } else if constexpr (ph == 2) {
    EpiIn epi{(float*)(ws + OFF_PROJ), (bf16_t*)(ws + OFF_HYT)};
    EpiProj epr{(float*)(ws + OFF_PROJ)};
    for (int t = bid; t < 128 * 18; t += G) {
      const int nt = t % 18;
      if (nt < 5) gemm_tile<true>((const bf16_t*)(ws + OFF_H), 1024, (const bf16_t*)(ws + OFF_WIN), 1024, 1024, (t / 18) * 128, nt * 128, smem, epr);
      else gemm_tile<false>((const bf16_t*)(ws + OFF_H), 1024, (const bf16_t*)(ws + OFF_WIN), 1024, 1024, (t / 18) * 128, nt * 128, smem, epi);
    }
  } else if constexpr (ph == 3) {
    for (int it = bid; it < 512; it += G) hyena_item<0>(p, 1, it, smem);
    for (int it = bid; it < 512; it += G) hyena_item<0>(p, 0, it, smem);
    for (int it = G - 1 - bid; it < 512; it += G) token_item(p, it);
  } else if constexpr (ph == 4) {
    EpiQ eq{(bf16_t*)(ws + OFF_QRAW)};
    EpiKV ekv{(bf16_t*)(ws + OFF_KRAW), (bf16_t*)(ws + OFF_VTC), (bf16_t*)(ws + OFF_VTL)};
    for (int it = bid; it < 512; it += G) hyena_item<1>(p, 1, it, smem);
    for (int t = bid; t < 768; t += G) gemm_tile<true>((const bf16_t*)(ws + OFF_QA), 384, (const bf16_t*)(ws + OFF_WUQ), 384, 384, (t / 6) * 128, (t % 6) * 128, smem, eq);
    for (int t = bid; t < 1088; t += G) gemm_tile<false>((const bf16_t*)(ws + OFF_CKVN), 256, (const bf16_t*)(ws + OFF_WUKV), 256, 256, (t / 8) * 128, (t % 8) * 128, smem, ekv);
    for (int it = bid; it < 512; it += G) hyena_item<1>(p, 0, it, smem);
  } else if constexpr (ph == 5) {
    for (int it = bid; it < 544; it += G) qk_item(p, 512 + it);
  } else if constexpr (ph == 6) {
    for (int it = bid; it < 1024; it += G) attn_item(p, it, smem);
  } else if constexpr (ph == 7) {
    for (int it = bid; it < 512; it += G) merge_item(p, it, smem);
  } else if constexpr (ph == 8) {
    EpiOut epi{&p};
    if (G == 512) {
      const int x = bid & 7, j = bid >> 3;
      for (int r = 0; r < 2; ++r)
        gemm_tile<true>((const bf16_t*)(ws + OFF_H), 1024, (const bf16_t*)(ws + OFF_WOUT), 1024, 1024, (x * 16 + r * 8 + (j >> 3)) * 128, (j & 7) * 128, smem, epi);
    } else {
      for (int t = bid; t < 128 * 8; t += G)
        gemm_tile<true>((const bf16_t*)(ws + OFF_H), 1024, (const bf16_t*)(ws + OFF_WOUT), 1024, 1024, (t / 8) * 128, (t % 8) * 128, smem, epi);
    }
  } else if constexpr (ph == 9) {
    rmsmod_phase<1>(p);
  } else if constexpr (ph == 10) {
    for (int t = bid; t < 128 * 44; t += G) gemm_up_act_tile(p, (t / 44) * 128, (t % 44) * 128, smem);
  } else if constexpr (ph == 11) {
    for (int it = bid; it < 704; it += G) actfix_item(p, it);
  } else if constexpr (ph == 12) {
    EpiY epi{&p, 0};
    if (G == 512) {
      const int x = bid & 7, j = bid >> 3;
      for (int r = 0; r < 2; ++r)
        gemm_tile<true>((const bf16_t*)(ws + OFF_U), 2816, (const bf16_t*)(ws + OFF_WDOWN), 2816, 2816, (x * 16 + r * 8 + (j >> 3)) * 128, (j & 7) * 128, smem, epi);
    } else {
      for (int t = bid; t < 128 * 8; t += G)
        gemm_tile<true>((const bf16_t*)(ws + OFF_U), 2816, (const bf16_t*)(ws + OFF_WDOWN), 2816, 2816, (t / 8) * 128, (t % 8) * 128, smem, epi);
    }
  }
}

#if ONE_LAUNCH
template <int PH>
__device__ __forceinline__ void run_all(const Params& p, char* smem, cg::grid_group& grid, const XcdBarrier& xb) {
  run_phase<PH>(p, smem);
  if constexpr (((DBL_MASK >> PH) & 1) != 0) { xcd_barrier(xb); run_phase<PH>(p, smem); }
  if constexpr (PH < 12) {
    xcd_barrier(xb);
    run_all<PH + 1>(p, smem, grid, xb);
  }
}
constexpr int DYN_LDS = 65536 + 64;
__global__ void __launch_bounds__(256, 2) mega_kernel(Params p) {
  extern __shared__ __attribute__((aligned(16))) char smem[];
  uint4* xb_words = (uint4*)(smem + 65536);
  cg::grid_group grid = cg::this_grid();
  if (threadIdx.x == 0) *xb_words = make_uint4(0u, 0u, 0u, 0u);
  __syncthreads();
  XcdBarrier xb = xcd_barrier_post((unsigned*)(p.ws + OFF_BAR), (volatile LAS unsigned*)xb_words);
  if (p.ws == nullptr) grid.sync();
  run_all<0>(p, smem, grid, xb);
}
#else
template <int PH>
__global__ void __launch_bounds__(256, 2) phase_kernel(Params p) {
  __shared__ __attribute__((aligned(16))) char smem[SMEM_BYTES];
  run_phase<PH>(p, smem);
}
#ifndef DBG_STOP
#define DBG_STOP 15
#endif
__global__ void dump_kernel(Params p, size_t off, int count) {
  const bf16_t* src = (const bf16_t*)(p.ws + off);
  const bf16_t* src2 = (const bf16_t*)(p.ws + DBG_OFF2);
  for (int i = blockIdx.x * 256 + threadIdx.x; i < 16777216; i += gridDim.x * 256)
    p.out[i] = i < DBG_CNT ? bf2f(src[i]) : (i - DBG_CNT < DBG_CNT2 ? bf2f(src2[i - DBG_CNT]) : 0.f);
}
template <int PH>
static void launch_all(const Params& p, hipStream_t stream) {
  phase_kernel<PH><<<512, 256, 0, stream>>>(p);
  if constexpr (PH < 12) launch_all<PH + 1>(p, stream);
}
#endif

extern "C" void kernel_launch(void* const* d_in, const int* in_sizes, int n_in, void* d_out, int out_size, void* d_ws,
                              size_t ws_size, hipStream_t stream) {
  Params p{};
  const float** pp = (const float**)&p;
  for (int i = 0; i < 34; ++i) pp[i] = (const float*)d_in[i];
  p.out = (float*)d_out;
  p.ws = (char*)d_ws;
#if ONE_LAUNCH
  (void)hipMemsetAsync((char*)d_ws + OFF_BAR, 0, XCD_BAR_WORDS * 4, stream);
  static int grid_blocks = 0;
  if (!grid_blocks) {
    int dev = 0, cus = 0, per_cu = 0;
    hipGetDevice(&dev);
    hipDeviceGetAttribute(&cus, hipDeviceAttributeMultiprocessorCount, dev);
    (void)hipFuncSetAttribute((const void*)mega_kernel, hipFuncAttributeMaxDynamicSharedMemorySize, DYN_LDS);
    (void)hipOccupancyMaxActiveBlocksPerMultiprocessor(&per_cu, mega_kernel, 256, DYN_LDS);
    if (per_cu > 2) per_cu = 2;
    grid_blocks = cus * per_cu;
  }
  void* args[] = {&p};
  hipError_t e = hipLaunchCooperativeKernel((void*)mega_kernel, dim3(grid_blocks), dim3(256), args, DYN_LDS, stream);
  if (e != hipSuccess) fprintf(stderr, "cooperative launch failed: %s (grid %d)\n", hipGetErrorString(e), grid_blocks);
#else
  launch_all<0>(p, stream);
#if DBG_STOP < 15
  dump_kernel<<<1024, 256, 0, stream>>>(p, DBG_OFF, DBG_CNT);
#endif
#endif
}
```

```cpp
#include <hip/hip_runtime.h>
#include <hip/hip_cooperative_groups.h>
#include <cstdio>
namespace cg = cooperative_groups;

#define DBG_STOP 15
#define DBG_NOHY 0
#ifndef DBL_MASK
#define DBL_MASK 0
#endif
#define DBG_OFF OFF_QRAW
#define DBG_OFF2 OFF_KRAW
#define DBG_CNT 12582912
#define DBG_CNT2 0
#ifndef ONE_LAUNCH
#define ONE_LAUNCH 1
#endif

typedef unsigned short bf16_t;
typedef short bf16x8 __attribute__((ext_vector_type(8)));
typedef float f32x4 __attribute__((ext_vector_type(4)));
typedef float f32x16 __attribute__((ext_vector_type(16)));

constexpr int D = 1024, NTOK = 16384, NCTX = 8192, SEQC = 256, SEQL = 4096;
constexpr int DIN = 2208, DINP = 2304, QL = 384, KVL = 256, DFF = 2816;
constexpr int NROWKV = 17408;
constexpr size_t MiB = 1048576;

constexpr size_t OFF_WIN = 0;
constexpr size_t OFF_WUQ = OFF_WIN + (size_t)DINP * 1024 * 2;
constexpr size_t OFF_WUKV = OFF_WUQ + (size_t)768 * 384 * 2;
constexpr size_t OFF_WOUT = OFF_WUKV + (size_t)1024 * 256 * 2;
constexpr size_t OFF_WUP = OFF_WOUT + (size_t)1024 * 1024 * 2;
constexpr size_t OFF_WDOWN = OFF_WUP + (size_t)5632 * 1024 * 2;
constexpr size_t OFF_MOD = OFF_WDOWN + (size_t)1024 * 2816 * 2;
static_assert(OFF_MOD + 3 * 6144 * 4 <= 25 * MiB, "A region");
constexpr size_t OFF_RLAT = 25 * MiB;
constexpr size_t OFF_RCTX = 41 * MiB;
constexpr size_t OFF_H = 42 * MiB;
constexpr size_t OFF_ZT = 42 * MiB;
constexpr size_t OFF_QA = 58 * MiB;
constexpr size_t OFF_KPE = 70 * MiB;
constexpr size_t OFF_PROJ = 74 * MiB;
constexpr size_t OFF_QRAW = 74 * MiB;
constexpr size_t OFF_Y2T = 98 * MiB;
constexpr size_t OFF_ATTN = 116 * MiB;
constexpr size_t OFF_U = 74 * MiB;
constexpr size_t OFF_HYT = 116 * MiB;
constexpr size_t OFF_Q = 116 * MiB;
constexpr size_t OFF_KC = 140 * MiB;
constexpr size_t OFF_KL = 152 * MiB;
constexpr size_t OFF_CKVN = 164 * MiB;
constexpr size_t OFF_KRAW = 173 * MiB;
constexpr size_t OFF_VTC = 190 * MiB;
constexpr size_t OFF_VTL = 198 * MiB;
constexpr size_t OFF_ACT = 162 * MiB;

constexpr int OUT_YS = 0;
constexpr int OUT_CKV = 16777216;
constexpr int OUT_KPE = 16777216 + 2097152;

constexpr int SMEM_BYTES = 51200;

struct Params {
  const float *x_prompt, *x_sample, *cache_ckv, *cache_kpe, *c, *c_ctx, *w_ada, *b_ada, *g_mix, *w_in, *g_qa, *w_uq,
      *g_kva, *w_ukv, *g_q, *g_k, *hy_conv_w, *hy_conv_b, *filt_w1, *filt_b1, *filt_freq1, *filt_w2, *filt_b2,
      *filt_freq2, *filt_w3, *filt_bias, *g_out_att, *g_out_hy, *w_out, *g_ffn, *w_up, *ffn_conv_w, *ffn_conv_b, *w_down;
  float* out;
  char* ws;
};

typedef __bf16 bf16x2_t __attribute__((ext_vector_type(2)));
__device__ __forceinline__ unsigned pack2(float lo, float hi) {
  bf16x2_t v;
  v[0] = (__bf16)lo;
  v[1] = (__bf16)hi;
  return __builtin_bit_cast(unsigned, v);
}
__device__ __forceinline__ float bflo(unsigned u) { return __uint_as_float(u << 16); }
__device__ __forceinline__ float bfhi(unsigned u) { return __uint_as_float(u & 0xffff0000u); }
__device__ __forceinline__ float bf2f(bf16_t h) { return __uint_as_float(((unsigned)h) << 16); }
__device__ __forceinline__ bf16_t f2bf(float f) { return (bf16_t)(pack2(f, 0.f) & 0xffffu); }
__device__ __forceinline__ float wave_sum(float v) {
#pragma unroll
  for (int o = 32; o >= 1; o >>= 1) v += __shfl_xor(v, o);
  return v;
}
__device__ __forceinline__ int ltid() { int t = threadIdx.x; asm volatile("" : "+v"(t)); return t; }
__device__ __forceinline__ float sin_turns(float t) { t -= floorf(t); return __builtin_amdgcn_sinf(t); }
__device__ __forceinline__ float cos_turns(float t) { t -= floorf(t); return __builtin_amdgcn_cosf(t); }
__device__ __forceinline__ float sin_rad(float x) { return sin_turns(x * 0.15915494309189535f); }
__device__ __forceinline__ const float* xrow(const Params& p, int row) {
  return row < NCTX ? p.x_prompt + (size_t)row * D : p.x_sample + (size_t)(row - NCTX) * D;
}
__device__ __forceinline__ int modidx(int row) { return row < NCTX ? 0 : 1 + ((row - NCTX) >> 12); }

template <bool SWAP>
__device__ __forceinline__ void gemm_main(const bf16_t* __restrict__ A, int lda, const bf16_t* __restrict__ Bt, int ldb,
                                          int K, int m0, int n0, char* smem, f32x4 (&acc)[4][4]) {
  const int tid = ltid(), lane = tid & 63, wid = tid >> 6, wr = wid >> 1, wc = wid & 1;
  const int fr = lane & 15, fq = lane >> 4;
  bf16_t* sbase = (bf16_t*)smem;
#pragma unroll
  for (int m = 0; m < 4; ++m)
#pragma unroll
    for (int n = 0; n < 4; ++n) acc[m][n] = (f32x4){0.f, 0.f, 0.f, 0.f};
  const int lr = tid >> 3, lc = (tid & 7) * 8;
  const bf16_t* ga = A + (size_t)(m0 + lr) * lda + lc;
  const bf16_t* gb = Bt + (size_t)(n0 + lr) * ldb + lc;
  const size_t sa32 = (size_t)32 * lda, sb32 = (size_t)32 * ldb;
  uint4 ra0 = *(const uint4*)(ga), ra1 = *(const uint4*)(ga + sa32), ra2 = *(const uint4*)(ga + 2 * sa32), ra3 = *(const uint4*)(ga + 3 * sa32);
  uint4 rb0 = *(const uint4*)(gb), rb1 = *(const uint4*)(gb + sb32), rb2 = *(const uint4*)(gb + 2 * sb32), rb3 = *(const uint4*)(gb + 3 * sb32);
  const int nk = K >> 6;
  const int woff = lr * 64 + (((tid & 7) ^ (lr & 7)) * 8);
  const int aoff = (wr * 64 + fr) * 64, boff = 8192 + (wc * 64 + fr) * 64;
  __syncthreads();
  {
    bf16_t* wa = sbase + woff;
    *(uint4*)(wa) = ra0; *(uint4*)(wa + 32 * 64) = ra1; *(uint4*)(wa + 64 * 64) = ra2; *(uint4*)(wa + 96 * 64) = ra3;
    *(uint4*)(wa + 8192) = rb0; *(uint4*)(wa + 8192 + 32 * 64) = rb1; *(uint4*)(wa + 8192 + 64 * 64) = rb2; *(uint4*)(wa + 8192 + 96 * 64) = rb3;
  }
  if (nk > 1) {
    ga += 64; gb += 64;
    ra0 = *(const uint4*)(ga); ra1 = *(const uint4*)(ga + sa32); ra2 = *(const uint4*)(ga + 2 * sa32); ra3 = *(const uint4*)(ga + 3 * sa32);
    rb0 = *(const uint4*)(gb); rb1 = *(const uint4*)(gb + sb32); rb2 = *(const uint4*)(gb + 2 * sb32); rb3 = *(const uint4*)(gb + 3 * sb32);
  }
  __syncthreads();
  for (int kt = 0; kt < nk; ++kt) {
    const bf16_t* cur = sbase + (kt & 1) * 16384;
    bf16x8 af[2][4], bfr[2][4];
#pragma unroll
    for (int ks = 0; ks < 2; ++ks) {
#pragma unroll
      for (int m = 0; m < 4; ++m) af[ks][m] = *(const bf16x8*)(cur + aoff + m * 16 * 64 + (((ks * 4 + fq) ^ (fr & 7)) * 8));
#pragma unroll
      for (int n = 0; n < 4; ++n) bfr[ks][n] = *(const bf16x8*)(cur + boff + n * 16 * 64 + (((ks * 4 + fq) ^ (fr & 7)) * 8));
    }
    __builtin_amdgcn_sched_barrier(0);
    {
      bf16_t* wa = sbase + ((kt + 1) & 1) * 16384 + woff;
      *(uint4*)(wa) = ra0; *(uint4*)(wa + 32 * 64) = ra1; *(uint4*)(wa + 64 * 64) = ra2; *(uint4*)(wa + 96 * 64) = ra3;
      *(uint4*)(wa + 8192) = rb0; *(uint4*)(wa + 8192 + 32 * 64) = rb1; *(uint4*)(wa + 8192 + 64 * 64) = rb2; *(uint4*)(wa + 8192 + 96 * 64) = rb3;
      const int adv = (kt + 2 < nk) ? 64 : 0;
      ga += adv; gb += adv;
      ra0 = *(const uint4*)(ga); ra1 = *(const uint4*)(ga + sa32); ra2 = *(const uint4*)(ga + 2 * sa32); ra3 = *(const uint4*)(ga + 3 * sa32);
      rb0 = *(const uint4*)(gb); rb1 = *(const uint4*)(gb + sb32); rb2 = *(const uint4*)(gb + 2 * sb32); rb3 = *(const uint4*)(gb + 3 * sb32);
    }
#pragma unroll
    for (int ks = 0; ks < 2; ++ks)
#pragma unroll
      for (int m = 0; m < 4; ++m)
#pragma unroll
        for (int n = 0; n < 4; ++n) {
          if (SWAP) acc[m][n] = __builtin_amdgcn_mfma_f32_16x16x32_bf16(bfr[ks][n], af[ks][m], acc[m][n], 0, 0, 0);
          else acc[m][n] = __builtin_amdgcn_mfma_f32_16x16x32_bf16(af[ks][m], bfr[ks][n], acc[m][n], 0, 0, 0);
        }
#pragma unroll
    for (int i = 0; i < 8; ++i) { __builtin_amdgcn_sched_group_barrier(0x008, 2, 0); __builtin_amdgcn_sched_group_barrier(0x200, 1, 0); }
#pragma unroll
    for (int i = 0; i < 8; ++i) { __builtin_amdgcn_sched_group_barrier(0x008, 2, 0); __builtin_amdgcn_sched_group_barrier(0x020, 1, 0); }
    __builtin_amdgcn_sched_barrier(0);
    if (kt + 1 < nk) __syncthreads();
  }
}
template <bool SWAP, class Epi>
__device__ __forceinline__ void gemm_tile(const bf16_t* __restrict__ A, int lda, const bf16_t* __restrict__ Bt, int ldb,
                                          int K, int m0, int n0, char* smem, const Epi& epi) {
  f32x4 acc[4][4];
  gemm_main<SWAP>(A, lda, Bt, ldb, K, m0, n0, smem, acc);
  const int tid = ltid(), lane = tid & 63, wid = tid >> 6, wr = wid >> 1, wc = wid & 1;
  const int fr = lane & 15, fq = lane >> 4;
#pragma unroll
  for (int m = 0; m < 4; ++m)
#pragma unroll
    for (int n = 0; n < 4; ++n) {
      if (SWAP) epi(m0 + wr * 64 + m * 16 + fr, n0 + wc * 64 + n * 16 + fq * 4, acc[m][n]);
      else epi(m0 + wr * 64 + m * 16 + fq * 4, n0 + wc * 64 + n * 16 + fr, acc[m][n]);
    }
}

template <int CTRL>
__device__ __forceinline__ float dpp_ror(float v) {
  return __int_as_float(__builtin_amdgcn_update_dpp(0, __float_as_int(v), CTRL, 0xF, 0xF, false));
}
constexpr size_t OFF_EDGE = 162 * MiB;
__device__ __forceinline__ void gemm_up_act_tile(const Params& p, int m0, int n0, char* smem) {
  f32x4 acc[4][4];
  gemm_main<true>((const bf16_t*)(p.ws + OFF_H), 1024, (const bf16_t*)(p.ws + OFF_WUP), 1024, 1024, m0, n0, smem, acc);
  const int tid = ltid(), lane = tid & 63, wid = tid >> 6, wr = wid >> 1, wc = wid & 1;
  const int fr = lane & 15, fq = lane >> 4;
  bf16_t* act = (bf16_t*)(p.ws + OFF_U);
  bf16_t* edge = (bf16_t*)(p.ws + OFF_EDGE);
  const int rowbase = m0 + wr * 64, wt = rowbase >> 6;
#pragma unroll
  for (int i = 0; i < 2; ++i) {
    const int cperm = n0 + wc * 64 + 32 * i;
    const int j0 = (cperm >> 5) * 16 + 4 * fq;
    const float4 wa0 = *(const float4*)(p.ffn_conv_w + j0), wa1 = *(const float4*)(p.ffn_conv_w + 5632 + j0), wa2 = *(const float4*)(p.ffn_conv_w + 11264 + j0);
    const float4 wg0 = *(const float4*)(p.ffn_conv_w + 2816 + j0), wg1 = *(const float4*)(p.ffn_conv_w + 5632 + 2816 + j0), wg2 = *(const float4*)(p.ffn_conv_w + 11264 + 2816 + j0);
    const float4 ba = *(const float4*)(p.ffn_conv_b + j0), bg = *(const float4*)(p.ffn_conv_b + 2816 + j0);
    const float w0a[4] = {wa0.x, wa0.y, wa0.z, wa0.w}, w1a[4] = {wa1.x, wa1.y, wa1.z, wa1.w}, w2a[4] = {wa2.x, wa2.y, wa2.z, wa2.w};
    const float w0g[4] = {wg0.x, wg0.y, wg0.z, wg0.w}, w1g[4] = {wg1.x, wg1.y, wg1.z, wg1.w}, w2g[4] = {wg2.x, wg2.y, wg2.z, wg2.w};
    const float bba[4] = {ba.x, ba.y, ba.z, ba.w}, bbg[4] = {bg.x, bg.y, bg.z, bg.w};
#pragma unroll
    for (int m = 0; m < 4; ++m) {
      float o[4];
#pragma unroll
      for (int e = 0; e < 4; ++e) {
        const float a = acc[m][2 * i][e], g = acc[m][2 * i + 1][e];
        const float au1 = dpp_ror<0x121>(a), gu1 = dpp_ror<0x121>(g), ad1 = dpp_ror<0x12F>(a), gd1 = dpp_ror<0x12F>(g);
        float au2 = 0.f, gu2 = 0.f, ad2 = 0.f, gd2 = 0.f;
        if (m > 0) { au2 = dpp_ror<0x121>(acc[m - 1][2 * i][e]); gu2 = dpp_ror<0x121>(acc[m - 1][2 * i + 1][e]); }
        if (m < 3) { ad2 = dpp_ror<0x12F>(acc[m + 1][2 * i][e]); gd2 = dpp_ror<0x12F>(acc[m + 1][2 * i + 1][e]); }
        const float au = fr > 0 ? au1 : au2, gu = fr > 0 ? gu1 : gu2, ad = fr < 15 ? ad1 : ad2, gd = fr < 15 ? gd1 : gd2;
        const float ca = w0a[e] * au + w1a[e] * a + w2a[e] * ad + bba[e];
        const float cgv = w0g[e] * gu + w1g[e] * g + w2g[e] * gd + bbg[e];
        o[e] = ca * __builtin_amdgcn_rcpf(1.f + __expf(-ca)) * cgv;
      }
      const int lr64 = m * 16 + fr, row = rowbase + lr64;
      if (lr64 >= 1 && lr64 <= 62) *(uint2*)(act + (size_t)row * 2816 + j0) = make_uint2(pack2(o[0], o[1]), pack2(o[2], o[3]));
      if (lr64 <= 1 || lr64 >= 62) {
        const int slot = lr64 <= 1 ? lr64 : lr64 - 60;
        bf16_t* er = edge + (size_t)(wt * 4 + slot) * 5632;
        *(uint2*)(er + j0) = make_uint2(pack2(acc[m][2 * i][0], acc[m][2 * i][1]), pack2(acc[m][2 * i][2], acc[m][2 * i][3]));
        *(uint2*)(er + 2816 + j0) = make_uint2(pack2(acc[m][2 * i + 1][0], acc[m][2 * i + 1][1]), pack2(acc[m][2 * i + 1][2], acc[m][2 * i + 1][3]));
      }
    }
  }
}

__device__ __forceinline__ void transpose_item(const float* __restrict__ W, int K, int N, bf16_t* __restrict__ WT, int tile, int ntn, char* smem, bool perm = false) {
  float* s = (float*)smem;
  const int tk = tile / ntn, tn = tile % ntn, tid = ltid();
  const int k0 = tk * 64, n0 = tn * 64;
  __syncthreads();
  {
    const int r = tid >> 4, c4 = (tid & 15) * 4;
#pragma unroll
    for (int i = 0; i < 4; ++i) {
      const int k = r + 16 * i;
      float4 v = make_float4(0.f, 0.f, 0.f, 0.f);
      if (n0 + c4 < N) v = *(const float4*)(W + (size_t)(k0 + k) * N + n0 + c4);
      s[k * 65 + c4 + 0] = v.x; s[k * 65 + c4 + 1] = v.y; s[k * 65 + c4 + 2] = v.z; s[k * 65 + c4 + 3] = v.w;
    }
  }
  __syncthreads();
  {
    const int n = tid >> 2, kc = (tid & 3) * 16;
    unsigned o[8];
#pragma unroll
    for (int i = 0; i < 8; ++i) o[i] = pack2(s[(kc + 2 * i) * 65 + n], s[(kc + 2 * i + 1) * 65 + n]);
    int nr = n0 + n;
    if (perm) { const int hf = nr >= 2816 ? 1 : 0, cc = nr - hf * 2816; nr = 32 * (cc >> 4) + 16 * hf + (cc & 15); }
    uint4* dst = (uint4*)(WT + (size_t)nr * K + k0 + kc);
    dst[0] = make_uint4(o[0], o[1], o[2], o[3]);
    dst[1] = make_uint4(o[4], o[5], o[6], o[7]);
  }
}

__device__ __forceinline__ void mod_item(const Params& p, int item, char* smem) {
  float* s = (float*)smem;
  float* red = s + 3072;
  const int tid = ltid();
  __syncthreads();
  for (int e = tid; e < 3072; e += 256) {
    const int v = e >> 10, k = e & 1023;
    const float x = (v == 0) ? p.c_ctx[k] : p.c[(v - 1) * D + k];
    s[e] = x / (1.f + __expf(-x));
  }
  __syncthreads();
  const int jl = tid & 63, kq = tid >> 6, j = item * 64 + jl, k0 = kq * 256;
  float a0 = 0.f, a1 = 0.f, a2 = 0.f;
#pragma unroll 32
  for (int k = 0; k < 256; ++k) {
    const float w = p.w_ada[(size_t)(k0 + k) * 6144 + j];
    a0 += s[k0 + k] * w; a1 += s[1024 + k0 + k] * w; a2 += s[2048 + k0 + k] * w;
  }
  red[(kq * 3 + 0) * 64 + jl] = a0; red[(kq * 3 + 1) * 64 + jl] = a1; red[(kq * 3 + 2) * 64 + jl] = a2;
  __syncthreads();
  if (tid < 192) {
    const int v = tid >> 6;
    const float r = red[(0 * 3 + v) * 64 + jl] + red[(1 * 3 + v) * 64 + jl] + red[(2 * 3 + v) * 64 + jl] + red[(3 * 3 + v) * 64 + jl];
    ((float*)(p.ws + OFF_MOD))[v * 6144 + j] = r + p.b_ada[j];
  }
}

__device__ __forceinline__ void filter_item(const Params& p, int item2, char* smem) {
  const int item = item2 >> 1, chalf = item2 & 1;
  int n, p0; bf16_t* R;
  if (item < 256) { n = 4096; p0 = item * 16; R = (bf16_t*)(p.ws + OFF_RLAT); }
  else { n = 256; p0 = (item - 256) * 16; R = (bf16_t*)(p.ws + OFF_RCTX); }
  const int n2 = 2 * n, tid = ltid();
  float* z = (float*)smem;
  float* h1 = z + 16 * 36;
  float* h2 = h1 + 16 * 64;
  __syncthreads();
#pragma unroll 1
  for (int e = tid; e < 16 * 33; e += 256) {
    const int pp = e / 33, f = e % 33, pos = p0 + pp;
    float val;
    if (f == 0) val = (float)pos / (float)(n - 1);
    else {
      const int k = (f - 1) & 15;
      const float band = 1e-4f + (float)k * ((15.f - 1e-4f) / 15.f);
      const float turns = band * ((float)pos / (float)n);
      val = (f <= 16) ? cos_turns(turns) : -sin_turns(turns);
    }
    z[pp * 36 + f] = val;
  }
  __syncthreads();
  {
    const int j = tid & 63, ppb = tid >> 6;
    float a0, a1, a2, a3;
    a0 = a1 = a2 = a3 = p.filt_b1[j];
#pragma unroll
    for (int f = 0; f < 33; ++f) {
      const float w = p.filt_w1[f * 64 + j];
      a0 += z[(ppb + 0) * 36 + f] * w; a1 += z[(ppb + 4) * 36 + f] * w; a2 += z[(ppb + 8) * 36 + f] * w; a3 += z[(ppb + 12) * 36 + f] * w;
    }
    const float fq1 = p.filt_freq1[j];
    h1[(ppb + 0) * 64 + j] = sin_rad(fq1 * a0); h1[(ppb + 4) * 64 + j] = sin_rad(fq1 * a1);
    h1[(ppb + 8) * 64 + j] = sin_rad(fq1 * a2); h1[(ppb + 12) * 64 + j] = sin_rad(fq1 * a3);
    __syncthreads();
    a0 = a1 = a2 = a3 = p.filt_b2[j];
#pragma unroll 32
    for (int k = 0; k < 64; ++k) {
      const float w = p.filt_w2[k * 64 + j];
      a0 += h1[(ppb + 0) * 64 + k] * w; a1 += h1[(ppb + 4) * 64 + k] * w; a2 += h1[(ppb + 8) * 64 + k] * w; a3 += h1[(ppb + 12) * 64 + k] * w;
    }
    const float fq2 = p.filt_freq2[j];
    h2[j * 16 + ppb + 0] = sin_rad(fq2 * a0); h2[j * 16 + ppb + 4] = sin_rad(fq2 * a1);
    h2[j * 16 + ppb + 8] = sin_rad(fq2 * a2); h2[j * 16 + ppb + 12] = sin_rad(fq2 * a3);
  }
  __syncthreads();
  const float mind = -3.0701134573253946f, maxd = -15.350567286626973f;
#pragma unroll 1
  for (int ci = 4 * chalf; ci < 4 * chalf + 4; ++ci) {
    const int col = tid + 256 * ci, o = col >> 10, dir = (col >> 9) & 1, c = col & 511;
    float acc[16];
#pragma unroll
    for (int i = 0; i < 16; ++i) acc[i] = 0.f;
#pragma unroll 16
    for (int k = 0; k < 64; ++k) {
      const float w = p.filt_w3[k * 2048 + col];
      const float4 ha = *(const float4*)(h2 + k * 16), hb = *(const float4*)(h2 + k * 16 + 4), hc = *(const float4*)(h2 + k * 16 + 8), hd = *(const float4*)(h2 + k * 16 + 12);
      acc[0] += ha.x * w; acc[1] += ha.y * w; acc[2] += ha.z * w; acc[3] += ha.w * w;
      acc[4] += hb.x * w; acc[5] += hb.y * w; acc[6] += hb.z * w; acc[7] += hb.w * w;
      acc[8] += hc.x * w; acc[9] += hc.y * w; acc[10] += hc.z * w; acc[11] += hc.w * w;
      acc[12] += hd.x * w; acc[13] += hd.y * w; acc[14] += hd.z * w; acc[15] += hd.w * w;
    }
    const float delta = fabsf(mind + (float)c * ((maxd - mind) / 511.f));
    bf16_t* Rrow = R + (size_t)(o * 512 + c) * n2;
#pragma unroll
    for (int i = 0; i < 16; ++i) {
      const int pos = p0 + i;
      const float t = (float)pos / (float)(n - 1);
      float val = acc[i] * (__expf(-t * delta) + 0.05f);
      int idx = dir == 0 ? (n - 1 - pos) : (n - 1 + pos);
      if (dir == 1 && pos == 0) { idx = n2 - 1; val = 0.f; }
      Rrow[idx] = f2bf(val);
    }
  }
}

__device__ __forceinline__ void cache_item(const Params& p, int item) {
  const int tid = ltid(), r0 = item * 32;
  bf16_t* ckvn = (bf16_t*)(p.ws + OFF_CKVN);
#pragma unroll 2
  for (int e = tid; e < 32 * 64; e += 256) {
    const int r = r0 + (e >> 6), c4 = (e & 63) * 4;
    const float4 v = *(const float4*)(p.cache_ckv + (size_t)r * 256 + c4);
    *(uint2*)(ckvn + (size_t)(NTOK + r) * 256 + c4) = make_uint2(pack2(v.x, v.y), pack2(v.z, v.w));
  }
}

template <int WHICH>
__device__ __forceinline__ void rmsmod_phase(const Params& p) {
  const int tid = ltid(), lane = tid & 63, wid = tid >> 6;
  const int gw = blockIdx.x * 4 + wid, tw = gridDim.x * 4;
  const float* g = WHICH == 0 ? p.g_mix : p.g_ffn;
  const float* mod = (const float*)(p.ws + OFF_MOD);
  bf16_t* h = (bf16_t*)(p.ws + OFF_H);
  float4 nv0, nv1, nv2, nv3;
  {
    const float* src = WHICH == 0 ? xrow(p, gw) : p.out + (size_t)gw * D;
    nv0 = ((const float4*)src)[lane]; nv1 = ((const float4*)src)[lane + 64]; nv2 = ((const float4*)src)[lane + 128]; nv3 = ((const float4*)src)[lane + 192];
  }
  for (int row = gw; row < NTOK; row += tw) {
    float4 v[4] = {nv0, nv1, nv2, nv3};
    if (row + tw < NTOK) {
      const float* src = WHICH == 0 ? xrow(p, row + tw) : p.out + (size_t)(row + tw) * D;
      nv0 = ((const float4*)src)[lane]; nv1 = ((const float4*)src)[lane + 64]; nv2 = ((const float4*)src)[lane + 128]; nv3 = ((const float4*)src)[lane + 192];
    }
    float ss = 0.f;
#pragma unroll
    for (int i = 0; i < 4; ++i) ss += v[i].x * v[i].x + v[i].y * v[i].y + v[i].z * v[i].z + v[i].w * v[i].w;
    ss = wave_sum(ss);
    const float r = rsqrtf(ss * (1.f / 1024.f) + 1e-6f);
    const float* mv = mod + modidx(row) * 6144 + (WHICH == 0 ? 0 : 3 * 1024);
#pragma unroll
    for (int i = 0; i < 4; ++i) {
      const int e = 4 * (lane + 64 * i);
      const float4 g4 = *(const float4*)(g + e), sh = *(const float4*)(mv + e), sc = *(const float4*)(mv + 1024 + e);
      const float y0 = v[i].x * r * g4.x * (1.f + sc.x) + sh.x, y1 = v[i].y * r * g4.y * (1.f + sc.y) + sh.y;
      const float y2 = v[i].z * r * g4.z * (1.f + sc.z) + sh.z, y3 = v[i].w * r * g4.w * (1.f + sc.w) + sh.w;
      *(uint2*)(h + (size_t)row * D + e) = make_uint2(pack2(y0, y1), pack2(y2, y3));
    }
  }
}

struct EpiIn {
  float* proj; bf16_t* hyT;
  __device__ __forceinline__ void operator()(int row0, int col, const f32x4& v) const {
    if (col < 672) {
#pragma unroll
      for (int j = 0; j < 4; ++j) proj[(size_t)(row0 + j) * 672 + col] = v[j];
    } else if (col < DIN) {
      *(uint2*)(hyT + (size_t)(col - 672) * NTOK + row0) = make_uint2(pack2(v[0], v[1]), pack2(v[2], v[3]));
    }
  }
};
struct EpiProj {
  float* proj;
  __device__ __forceinline__ void operator()(int row, int col0, const f32x4& v) const { *(f32x4*)(proj + (size_t)row * 672 + col0) = v; }
};
struct EpiQ {
  bf16_t* q;
  __device__ __forceinline__ void operator()(int row, int col0, const f32x4& v) const {
    *(uint2*)(q + (size_t)row * 768 + col0) = make_uint2(pack2(v[0], v[1]), pack2(v[2], v[3]));
  }
};
struct EpiKV {
  bf16_t *kraw, *vtc, *vtl;
  __device__ __forceinline__ void operator()(int row0, int col, const f32x4& v) const {
    const int head = col >> 7, cc = col & 127;
    if (cc < 64) {
#pragma unroll
      for (int j = 0; j < 4; ++j) kraw[(size_t)(row0 + j) * 512 + head * 64 + cc] = f2bf(v[j]);
    } else {
      const int dv = cc - 64;
      bf16_t* dst;
      if (row0 < NCTX) dst = vtc + ((size_t)((row0 >> 8) * 8 + head) * 64 + dv) * 256 + (row0 & 255);
      else if (row0 < NTOK) { const int r = row0 - NCTX; dst = vtl + ((size_t)((r >> 12) * 8 + head) * 64 + dv) * 4608 + (r & 4095); }
      else { const int r = row0 - NTOK; dst = vtl + ((size_t)((r >> 9) * 8 + head) * 64 + dv) * 4608 + 4096 + (r & 511); }
      *(uint2*)dst = make_uint2(pack2(v[0], v[1]), pack2(v[2], v[3]));
    }
  }
};
struct EpiOut {
  const Params* p;
  __device__ __forceinline__ void operator()(int row, int col0, const f32x4& v) const {
    const float4 x = *(const float4*)(xrow(*p, row) + col0);
    const float4 m = *(const float4*)((const float*)(p->ws + OFF_MOD) + modidx(row) * 6144 + 2 * 1024 + col0);
    *(float4*)(p->out + (size_t)row * D + col0) = make_float4(x.x + m.x * v[0], x.y + m.y * v[1], x.z + m.z * v[2], x.w + m.w * v[3]);
  }
};
struct EpiU {
  bf16_t* u;
  __device__ __forceinline__ void operator()(int row, int col0, const f32x4& v) const {
    *(uint2*)(u + (size_t)row * 5632 + col0) = make_uint2(pack2(v[0], v[1]), pack2(v[2], v[3]));
  }
};
struct EpiY {
  const Params* p; int half;
  __device__ __forceinline__ void operator()(int row, int col0, const f32x4& v) const {
    const int grow = half * 8192 + row;
    float4* dst = (float4*)(p->out + (size_t)grow * D + col0);
    const float4 x = *dst;
    const float4 m = *(const float4*)((const float*)(p->ws + OFF_MOD) + modidx(grow) * 6144 + 5 * 1024 + col0);
    *dst = make_float4(x.x + m.x * v[0], x.y + m.y * v[1], x.z + m.z * v[2], x.w + m.w * v[3]);
  }
};

__device__ __forceinline__ void token_item(const Params& p, int item) {
  const int tid = ltid(), lane = tid & 63, wid = tid >> 6;
  const float* proj = (const float*)(p.ws + OFF_PROJ);
  bf16_t* qa = (bf16_t*)(p.ws + OFF_QA);
  bf16_t* ckvn = (bf16_t*)(p.ws + OFF_CKVN);
  float* kpe = (float*)(p.ws + OFF_KPE);
  for (int tt = 0; tt < 8; ++tt) {
    const int token = item * 32 + wid * 8 + tt;
    const float* pr = proj + (size_t)token * 672;
    float2 q[3];
    float ss = 0.f;
#pragma unroll
    for (int i = 0; i < 3; ++i) { q[i] = *(const float2*)(pr + lane * 2 + 128 * i); ss += q[i].x * q[i].x + q[i].y * q[i].y; }
    ss = wave_sum(ss);
    const float r = rsqrtf(ss * (1.f / 384.f) + 1e-6f);
#pragma unroll
    for (int i = 0; i < 3; ++i) {
      const int e = lane * 2 + 128 * i;
      *(unsigned*)(qa + (size_t)token * 384 + e) = pack2(q[i].x * r * p.g_qa[e], q[i].y * r * p.g_qa[e + 1]);
    }
    const float4 kv = *(const float4*)(pr + 384 + lane * 4);
    float s2 = wave_sum(kv.x * kv.x + kv.y * kv.y + kv.z * kv.z + kv.w * kv.w);
    const float r2 = rsqrtf(s2 * (1.f / 256.f) + 1e-6f);
    const float4 g = *(const float4*)(p.g_kva + lane * 4);
    const float4 y = make_float4(kv.x * r2 * g.x, kv.y * r2 * g.y, kv.z * r2 * g.z, kv.w * r2 * g.w);
    *(uint2*)(ckvn + (size_t)token * 256 + lane * 4) = make_uint2(pack2(y.x, y.y), pack2(y.z, y.w));
    if (token < NCTX) *(float4*)(p.out + OUT_CKV + (size_t)token * 256 + lane * 4) = y;
    if (lane < 32) {
      const float kp = pr[640 + lane];
      kpe[(size_t)token * 32 + lane] = kp;
      if (token < NCTX) p.out[OUT_KPE + (size_t)token * 32 + lane] = kp;
    }
  }
}

template <int ORDER>
__device__ __forceinline__ void hyena_item(const Params& p, int grp, int c, char* smem) {
  const int tid = ltid(), lane = tid & 63, wid = tid >> 6, fr = lane & 15, fq = lane >> 4;
  const int n = grp ? SEQL : SEQC, nb = n >> 6, L = n;
  const bf16_t* Rrow = (const bf16_t*)(p.ws + (grp ? OFF_RLAT : OFF_RCTX)) + (size_t)(ORDER * 512 + c) * (2 * n);
  const bf16_t* hyT = (const bf16_t*)(p.ws + OFF_HYT);
  bf16_t* sU = (bf16_t*)smem;
  unsigned* sR0 = (unsigned*)(smem + 18432);
  unsigned* sR1 = (unsigned*)(smem + 18432 + 16384);
  const int tok0 = grp * 8192;
  __syncthreads();
  for (int ch = tid; ch < (2 * n) / 8; ch += 256) *(uint4*)((bf16_t*)sR0 + ch * 8) = *(const uint4*)(Rrow + ch * 8);
  if (ORDER == 0) {
    const bf16_t* raw = hyT + (size_t)c * NTOK + tok0;
    const float w0 = p.hy_conv_w[c], w1 = p.hy_conv_w[1536 + c], w2 = p.hy_conv_w[3072 + c], b = p.hy_conv_b[c];
    for (int ch = tid; ch < 1024; ch += 256) {
      const int t = ch * 8, pos = t & (L - 1);
      const uint4 rv = *(const uint4*)(raw + t);
      float x[10];
      x[0] = pos == 0 ? 0.f : bf2f(raw[t - 1]);
      x[1] = bflo(rv.x); x[2] = bfhi(rv.x); x[3] = bflo(rv.y); x[4] = bfhi(rv.y);
      x[5] = bflo(rv.z); x[6] = bfhi(rv.z); x[7] = bflo(rv.w); x[8] = bfhi(rv.w);
      x[9] = (pos + 8 == L) ? 0.f : bf2f(raw[t + 8]);
      float u[8];
#pragma unroll
      for (int i = 0; i < 8; ++i) u[i] = w0 * x[i] + w1 * x[i + 1] + w2 * x[i + 2] + b;
      *(uint4*)(sU + (ch >> 3) * 64 + (((ch & 7) ^ ((ch >> 3) & 7)) * 8)) = make_uint4(pack2(u[0], u[1]), pack2(u[2], u[3]), pack2(u[4], u[5]), pack2(u[6], u[7]));
    }
  } else {
    const bf16_t* zr = (const bf16_t*)(p.ws + OFF_ZT) + (size_t)c * NTOK + tok0;
    for (int ch = tid; ch < 1024; ch += 256) *(uint4*)(sU + (ch >> 3) * 64 + (((ch & 7) ^ ((ch >> 3) & 7)) * 8)) = *(const uint4*)(zr + ch * 8);
  }
  __syncthreads();
  for (int k = tid; k < n; k += 256) {
    const unsigned a = sR0[k], b2 = (k + 1 < n) ? sR0[k + 1] : 0u;
    sR1[k] = (a >> 16) | (b2 << 16);
  }
  __syncthreads();

  f32x4 acc[4][2];
#pragma unroll
  for (int m = 0; m < 4; ++m) { acc[m][0] = (f32x4){0.f, 0.f, 0.f, 0.f}; acc[m][1] = (f32x4){0.f, 0.f, 0.f, 0.f}; }
  const unsigned* abase = (fr & 1) ? (sR0 + ((n - 1 - fr) >> 1) + 4 * fq) : (sR1 + ((n - 2 - fr) >> 1) + 4 * fq);
  const int col0 = 32 * wid + fr, col1 = col0 + 16;
  const int i0 = col0 & (nb - 1), i1 = col1 & (nb - 1);
  for (int d = -(nb - 1); d <= nb - 1; ++d) {
    const bool v0 = (unsigned)(i0 - d) < (unsigned)nb, v1 = (unsigned)(i1 - d) < (unsigned)nb;
    const bool any0 = __ballot(v0) != 0ull, any1 = __ballot(v1) != 0ull;
    if (!any0 && !any1) continue;
    bf16x8 F[6];
    const unsigned* ap = abase - 32 * d + 16;
#pragma unroll
    for (int idx = 0; idx < 6; ++idx) {
      const unsigned* q = ap - 8 * idx;
      union { unsigned u[4]; bf16x8 v; } cv;
      cv.u[0] = q[0]; cv.u[1] = q[1]; cv.u[2] = q[2]; cv.u[3] = q[3];
      F[idx] = cv.v;
    }
#pragma unroll
    for (int nt = 0; nt < 2; ++nt) {
      if (!(nt ? any1 : any0)) continue;
      const bool vv = nt ? v1 : v0;
      const int srow = (nt ? col1 : col0) - d;
      const bf16_t* up = sU + srow * 64;
#pragma unroll
      for (int ks = 0; ks < 2; ++ks) {
        bf16x8 bf = (bf16x8){0, 0, 0, 0, 0, 0, 0, 0};
        if (vv) bf = *(const bf16x8*)(up + (((ks * 4 + fq) ^ (srow & 7)) * 8));
#pragma unroll
        for (int m = 0; m < 4; ++m)
          acc[m][nt] = __builtin_amdgcn_mfma_f32_16x16x32_bf16(F[m + 2 - 2 * ks], bf, acc[m][nt], 0, 0, 0);
      }
    }
  }
  const float skip = p.filt_bias[ORDER * 512 + c];
  const int gcol = (ORDER == 0 ? 512 : 1024) + c;
  const bf16_t* graw = hyT + (size_t)gcol * NTOK + tok0;
  const float w0 = p.hy_conv_w[gcol], w1 = p.hy_conv_w[1536 + gcol], w2 = p.hy_conv_w[3072 + gcol], b = p.hy_conv_b[gcol];
  bf16_t* outT = (bf16_t*)(p.ws + (ORDER == 0 ? OFF_ZT : OFF_Y2T)) + (size_t)c * NTOK + tok0;
#pragma unroll
  for (int nt = 0; nt < 2; ++nt) {
    const int col = nt ? col1 : col0;
#pragma unroll
    for (int m = 0; m < 4; ++m) {
      const int t = col * 64 + 16 * m + 4 * fq, pos = t & (L - 1);
      const uint2 uu = *(const uint2*)(sU + col * 64 + (((2 * m + (fq >> 1)) ^ (col & 7)) * 8) + 4 * (fq & 1));
      const uint2 gv = *(const uint2*)(graw + t);
      float x[6];
      x[0] = pos == 0 ? 0.f : bf2f(graw[t - 1]);
      x[1] = bflo(gv.x); x[2] = bfhi(gv.x); x[3] = bflo(gv.y); x[4] = bfhi(gv.y);
      x[5] = (pos + 4 == L) ? 0.f : bf2f(graw[t + 4]);
      const float u4[4] = {bflo(uu.x), bfhi(uu.x), bflo(uu.y), bfhi(uu.y)};
      float o[4];
#pragma unroll
      for (int j = 0; j < 4; ++j) {
        const float gate = w0 * x[j] + w1 * x[j + 1] + w2 * x[j + 2] + b;
        o[j] = gate * (acc[m][nt][j] + skip * u4[j]);
      }
      *(uint2*)(outT + t) = make_uint2(pack2(o[0], o[1]), pack2(o[2], o[3]));
    }
  }
}

__device__ __forceinline__ void rope32(float* y  , int pos) {
  const float prow = (float)(pos >> 6), pcol = (float)(pos & 63);
  const float fr[8] = {1.f, 0.31622776601683794f, 0.1f, 0.031622776601683794f, 0.01f, 0.0031622776601683794f, 0.001f, 0.00031622776601683794f};
#pragma unroll
  for (int i = 0; i < 8; ++i) {
    const float tr = prow * fr[i] * 0.15915494309189535f, tc = pcol * fr[i] * 0.15915494309189535f;
    const float sr = sin_turns(tr), cr = cos_turns(tr), sc = sin_turns(tc), cc = cos_turns(tc);
    const float a = y[i], b = y[8 + i], c2 = y[16 + i], d2 = y[24 + i];
    y[i] = a * cr - b * sr; y[8 + i] = b * cr + a * sr;
    y[16 + i] = c2 * cc - d2 * sc; y[24 + i] = d2 * cc + c2 * sc;
  }
}
__device__ __forceinline__ void unpack8(const uint4& v, float* x) {
  x[0] = bflo(v.x); x[1] = bfhi(v.x); x[2] = bflo(v.y); x[3] = bfhi(v.y);
  x[4] = bflo(v.z); x[5] = bfhi(v.z); x[6] = bflo(v.w); x[7] = bfhi(v.w);
}
__device__ __forceinline__ float sumsq8(const uint4& v) {
  float x[8];
  unpack8(v, x);
  return x[0] * x[0] + x[1] * x[1] + x[2] * x[2] + x[3] * x[3] + x[4] * x[4] + x[5] * x[5] + x[6] * x[6] + x[7] * x[7];
}
__device__ __forceinline__ uint4 scale8(const uint4& v, float r, const float* __restrict__ g) {
  float x[8];
  unpack8(v, x);
  const float4 g0 = *(const float4*)g, g1 = *(const float4*)(g + 4);
  return make_uint4(pack2(x[0] * r * g0.x, x[1] * r * g0.y), pack2(x[2] * r * g0.z, x[3] * r * g0.w),
                    pack2(x[4] * r * g1.x, x[5] * r * g1.y), pack2(x[6] * r * g1.z, x[7] * r * g1.w));
}
__device__ __forceinline__ void qk_item(const Params& p, int item) {
  const int tid = ltid();
  if (item < 512) {
    const int idx = item * 256 + tid, row = idx >> 3, h = idx & 7;
    const bf16_t* src = (const bf16_t*)(p.ws + OFF_QRAW) + (size_t)row * 768 + h * 96;
    bf16_t* dst = (bf16_t*)(p.ws + OFF_Q) + (size_t)row * 768 + h * 96;
    uint4 raw[12];
#pragma unroll
    for (int i = 0; i < 12; ++i) raw[i] = *(const uint4*)(src + 8 * i);
    float ss = 0.f;
#pragma unroll
    for (int i = 0; i < 12; ++i) ss += sumsq8(raw[i]);
    const float r = rsqrtf(ss * (1.f / 96.f) + 1e-6f);
    const float qs = 0.10206207261596575f * 1.4426950408889634f;
#pragma unroll
    for (int i = 0; i < 8; ++i) *(uint4*)(dst + 8 * i) = scale8(raw[i], r * qs, p.g_q + 8 * i);
    float y[32];
#pragma unroll
    for (int i = 0; i < 4; ++i) unpack8(raw[8 + i], y + 8 * i);
#pragma unroll
    for (int i = 0; i < 32; ++i) y[i] = y[i] * r * p.g_q[64 + i];
    if (row >= NCTX) rope32(y, (row - NCTX) & 4095);
#pragma unroll
    for (int i = 0; i < 4; ++i)
      *(uint4*)(dst + 64 + 8 * i) = make_uint4(pack2(y[8 * i] * qs, y[8 * i + 1] * qs), pack2(y[8 * i + 2] * qs, y[8 * i + 3] * qs),
                                               pack2(y[8 * i + 4] * qs, y[8 * i + 5] * qs), pack2(y[8 * i + 6] * qs, y[8 * i + 7] * qs));
  } else {
    const int idx = (item - 512) * 256 + tid, row = idx >> 3, h = idx & 7;
    const bf16_t* src = (const bf16_t*)(p.ws + OFF_KRAW) + (size_t)row * 512 + h * 64;
    uint4 raw[8];
#pragma unroll
    for (int i = 0; i < 8; ++i) raw[i] = *(const uint4*)(src + 8 * i);
    const float* kp = row < NTOK ? (const float*)(p.ws + OFF_KPE) + (size_t)row * 32 : p.cache_kpe + (size_t)(row - NTOK) * 32;
    float y[32];
#pragma unroll
    for (int i = 0; i < 8; ++i) {
      const float4 v = *(const float4*)(kp + 4 * i);
      y[4 * i] = v.x; y[4 * i + 1] = v.y; y[4 * i + 2] = v.z; y[4 * i + 3] = v.w;
    }
    float ss = 0.f;
#pragma unroll
    for (int i = 0; i < 8; ++i) ss += sumsq8(raw[i]);
#pragma unroll
    for (int i = 0; i < 32; ++i) ss += y[i] * y[i];
    const float r = rsqrtf(ss * (1.f / 96.f) + 1e-6f);
#pragma unroll
    for (int i = 0; i < 32; ++i) y[i] = y[i] * r * p.g_k[64 + i];
    bf16_t* dst;
    if (row < NCTX) dst = (bf16_t*)(p.ws + OFF_KC) + ((size_t)((row >> 8) * 8 + h) * 256 + (row & 255)) * 96;
    else if (row < NTOK) {
      const int rr = row - NCTX;
      rope32(y, rr & 4095);
      dst = (bf16_t*)(p.ws + OFF_KL) + ((size_t)((rr >> 12) * 8 + h) * 4608 + (rr & 4095)) * 96;
    } else {
      const int rr = row - NTOK;
      dst = (bf16_t*)(p.ws + OFF_KL) + ((size_t)((rr >> 9) * 8 + h) * 4608 + 4096 + (rr & 511)) * 96;
    }
#pragma unroll
    for (int i = 0; i < 8; ++i) *(uint4*)(dst + 8 * i) = scale8(raw[i], r, p.g_k + 8 * i);
#pragma unroll
    for (int i = 0; i < 4; ++i)
      *(uint4*)(dst + 64 + 8 * i) = make_uint4(pack2(y[8 * i], y[8 * i + 1]), pack2(y[8 * i + 2], y[8 * i + 3]),
                                               pack2(y[8 * i + 4], y[8 * i + 5]), pack2(y[8 * i + 6], y[8 * i + 7]));
  }
}

__device__ __forceinline__ void attn_item(const Params& p, int item, char* smem) {
  const int tid = ltid(), lane = tid & 63, wid = tid >> 6, lr = lane & 31, lh = lane >> 5;
  int nkeys, h, tokbase; const bf16_t *Kp, *Vp;
  if (item < 512) {
    const int b = item >> 8, rem = item & 255; h = rem >> 5; const int qb = rem & 31;
    nkeys = 4608; tokbase = NCTX + b * 4096 + qb * 128;
    Kp = (const bf16_t*)(p.ws + OFF_KL) + (size_t)(b * 8 + h) * 4608 * 96;
    Vp = (const bf16_t*)(p.ws + OFF_VTL) + (size_t)(b * 8 + h) * 64 * 4608;
  } else {
    const int it = item - 512, b = it >> 4; h = (it & 15) >> 1; const int qb = it & 1;
    nkeys = 256; tokbase = b * 256 + qb * 128;
    Kp = (const bf16_t*)(p.ws + OFF_KC) + (size_t)(b * 8 + h) * 256 * 96;
    Vp = (const bf16_t*)(p.ws + OFF_VTC) + (size_t)(b * 8 + h) * 64 * 256;
  }
  bf16_t* sK = (bf16_t*)smem;
  bf16_t* sV = sK + 64 * 104;
  const int token = tokbase + 32 * wid + lr;
  bf16x8 qf[6];
  {
    const bf16_t* qsrc = (const bf16_t*)(p.ws + OFF_QRAW) + (size_t)token * 768 + h * 96 + 8 * lh;
    uint4 qr[6];
#pragma unroll
    for (int ks = 0; ks < 6; ++ks) qr[ks] = *(const uint4*)(qsrc + 16 * ks);
    float ss = 0.f;
#pragma unroll
    for (int ks = 0; ks < 6; ++ks) ss += sumsq8(qr[ks]);
    ss += __shfl_xor(ss, 32);
    const float r = rsqrtf(ss * (1.f / 96.f) + 1e-6f);
    const float qs = 0.10206207261596575f * 1.4426950408889634f;
    const bool lat = item < 512;
    const int pos = (token - NCTX) & 4095;
    const float prow = (float)(pos >> 6), pcol = (float)(pos & 63);
    const float frq[8] = {1.f, 0.31622776601683794f, 0.1f, 0.031622776601683794f, 0.01f, 0.0031622776601683794f, 0.001f, 0.00031622776601683794f};
#pragma unroll
    for (int ks = 0; ks < 6; ++ks) {
      float y[8];
      unpack8(qr[ks], y);
      const float* gq = p.g_q + 16 * ks + 8 * lh;
#pragma unroll
      for (int e = 0; e < 8; ++e) y[e] = y[e] * r * gq[e];
      if (ks >= 4) {
#pragma unroll
        for (int e = 0; e < 8; ++e) {
          const float other = __shfl_xor(y[e], 32);
          const float t = (ks == 4 ? prow : pcol) * frq[e] * 0.15915494309189535f;
          const float sn = sin_turns(t), cs = cos_turns(t);
          const float rot = y[e] * cs + (lh ? other : -other) * sn;
          y[e] = lat ? rot : y[e];
        }
      }
      union { unsigned u[4]; bf16x8 v; } pk;
      pk.u[0] = pack2(y[0] * qs, y[1] * qs); pk.u[1] = pack2(y[2] * qs, y[3] * qs); pk.u[2] = pack2(y[4] * qs, y[5] * qs); pk.u[3] = pack2(y[6] * qs, y[7] * qs);
      qf[ks] = pk.v;
    }
  }
  f32x16 oacc[2];
#pragma unroll
  for (int j = 0; j < 16; ++j) { oacc[0][j] = 0.f; oacc[1][j] = 0.f; }
  float mrun = -1e30f, lsum = 0.f;
  const int kk0 = tid / 12, kc0 = tid % 12, kk1 = (tid + 256) / 12, kc1 = (tid + 256) % 12, kk2 = (tid + 512) / 12, kc2 = (tid + 512) % 12;
  const int vd0 = tid >> 3, vc0 = tid & 7, vd1 = vd0 + 32;
  const bf16_t* gk0 = Kp + (size_t)kk0 * 96 + kc0 * 8;
  const bf16_t* gk1 = Kp + (size_t)kk1 * 96 + kc1 * 8;
  const bf16_t* gk2 = Kp + (size_t)kk2 * 96 + kc2 * 8;
  const bf16_t* gv0 = Vp + (size_t)vd0 * nkeys + vc0 * 8;
  const bf16_t* gv1 = Vp + (size_t)vd1 * nkeys + vc0 * 8;
  uint4 rk0 = *(const uint4*)gk0, rk1 = *(const uint4*)gk1, rk2 = *(const uint4*)gk2;
  uint4 rv0 = *(const uint4*)gv0, rv1 = *(const uint4*)gv1;
  const int nt = nkeys >> 6;
  for (int kt = 0; kt < nt; ++kt) {
    __syncthreads();
    *(uint4*)(sK + kk0 * 104 + kc0 * 8) = rk0; *(uint4*)(sK + kk1 * 104 + kc1 * 8) = rk1; *(uint4*)(sK + kk2 * 104 + kc2 * 8) = rk2;
    *(uint4*)(sV + vd0 * 72 + vc0 * 8) = rv0; *(uint4*)(sV + vd1 * 72 + vc0 * 8) = rv1;
    __syncthreads();
    if (kt + 1 < nt) {
      gk0 += 64 * 96; gk1 += 64 * 96; gk2 += 64 * 96; gv0 += 64; gv1 += 64;
      rk0 = *(const uint4*)gk0; rk1 = *(const uint4*)gk1; rk2 = *(const uint4*)gk2;
      rv0 = *(const uint4*)gv0; rv1 = *(const uint4*)gv1;
    }
    __builtin_amdgcn_sched_barrier(0);
    f32x16 sacc[2];
#pragma unroll
    for (int kb = 0; kb < 2; ++kb) {
#pragma unroll
      for (int j = 0; j < 16; ++j) sacc[kb][j] = 0.f;
#pragma unroll
      for (int ks = 0; ks < 6; ++ks) {
        const bf16x8 a = *(const bf16x8*)(sK + (32 * kb + lr) * 104 + 16 * ks + 8 * lh);
        sacc[kb] = __builtin_amdgcn_mfma_f32_32x32x16_bf16(a, qf[ks], sacc[kb], 0, 0, 0);
      }
    }
    float mx = sacc[0][0];
#pragma unroll
    for (int j = 1; j < 16; ++j) mx = fmaxf(mx, sacc[0][j]);
#pragma unroll
    for (int j = 0; j < 16; ++j) mx = fmaxf(mx, sacc[1][j]);
    mx = fmaxf(mx, __shfl_xor(mx, 32));
    const float mnew = fmaxf(mrun, mx);
    const float alpha = __builtin_amdgcn_exp2f(mrun - mnew);
    mrun = mnew;
    float ps = 0.f;
#pragma unroll
    for (int kb = 0; kb < 2; ++kb)
#pragma unroll
      for (int j = 0; j < 16; ++j) { const float e = __builtin_amdgcn_exp2f(sacc[kb][j] - mnew); sacc[kb][j] = e; ps += e; }
    lsum = lsum * alpha + ps;
    if (__ballot(alpha != 1.f) != 0ull) {
#pragma unroll
      for (int j = 0; j < 16; ++j) { oacc[0][j] *= alpha; oacc[1][j] *= alpha; }
    }
#pragma unroll
    for (int s = 0; s < 4; ++s) {
      const int kb = s >> 1, jb = 8 * (s & 1);
      union { unsigned u[4]; bf16x8 v; } pf;
      pf.u[0] = pack2(sacc[kb][jb + 0], sacc[kb][jb + 1]); pf.u[1] = pack2(sacc[kb][jb + 2], sacc[kb][jb + 3]);
      pf.u[2] = pack2(sacc[kb][jb + 4], sacc[kb][jb + 5]); pf.u[3] = pack2(sacc[kb][jb + 6], sacc[kb][jb + 7]);
#pragma unroll
      for (int mt = 0; mt < 2; ++mt) {
        const bf16_t* vp = sV + (32 * mt + lr) * 72 + 16 * s + 4 * lh;
        union { uint2 d[2]; bf16x8 v; } av;
        av.d[0] = *(const uint2*)vp;
        av.d[1] = *(const uint2*)(vp + 8);
        oacc[mt] = __builtin_amdgcn_mfma_f32_32x32x16_bf16(av.v, pf.v, oacc[mt], 0, 0, 0);
      }
    }
  }
  lsum += __shfl_xor(lsum, 32);
  const float inv = 1.f / lsum;
  bf16_t* dst = (bf16_t*)(p.ws + OFF_ATTN) + (size_t)token * 512 + h * 64;
#pragma unroll
  for (int mt = 0; mt < 2; ++mt)
#pragma unroll
    for (int jg = 0; jg < 4; ++jg) {
      const int dv0 = 32 * mt + 8 * jg + 4 * lh;
      *(uint2*)(dst + dv0) = make_uint2(pack2(oacc[mt][4 * jg] * inv, oacc[mt][4 * jg + 1] * inv),
                                        pack2(oacc[mt][4 * jg + 2] * inv, oacc[mt][4 * jg + 3] * inv));
    }
}

__device__ __forceinline__ void merge_item(const Params& p, int item, char* smem) {
  const int tid = ltid(), lane = tid & 63, wid = tid >> 6, t0 = item * 32;
  bf16_t* mix = (bf16_t*)(p.ws + OFF_H);
  const bf16_t* attn = (const bf16_t*)(p.ws + OFF_ATTN);
  for (int tt = 0; tt < 8; ++tt) {
    const int token = t0 + wid * 8 + tt;
    float x[8];
    unpack8(*(const uint4*)(attn + (size_t)token * 512 + lane * 8), x);
    float ss = 0.f;
#pragma unroll
    for (int i = 0; i < 8; ++i) ss += x[i] * x[i];
    ss = wave_sum(ss);
    const float r = rsqrtf(ss * (1.f / 512.f) + 1e-6f);
    const float4 g0 = *(const float4*)(p.g_out_att + lane * 8), g1 = *(const float4*)(p.g_out_att + lane * 8 + 4);
    *(uint4*)(mix + (size_t)token * D + lane * 8) =
        make_uint4(pack2(x[0] * r * g0.x, x[1] * r * g0.y), pack2(x[2] * r * g0.z, x[3] * r * g0.w),
                   pack2(x[4] * r * g1.x, x[5] * r * g1.y), pack2(x[6] * r * g1.z, x[7] * r * g1.w));
  }
  bf16_t* sT = (bf16_t*)smem;
  const bf16_t* y2T = (const bf16_t*)(p.ws + OFF_Y2T);
  __syncthreads();
  for (int ch = tid; ch < 2048; ch += 256) {
    const int c = ch >> 2, q4 = ch & 3;
    const uint4 v = *(const uint4*)(y2T + (size_t)c * NTOK + t0 + q4 * 8);
    bf16_t* d = sT + (q4 * 8) * 520 + c;
    d[0 * 520] = (bf16_t)(v.x & 0xffff); d[1 * 520] = (bf16_t)(v.x >> 16);
    d[2 * 520] = (bf16_t)(v.y & 0xffff); d[3 * 520] = (bf16_t)(v.y >> 16);
    d[4 * 520] = (bf16_t)(v.z & 0xffff); d[5 * 520] = (bf16_t)(v.z >> 16);
    d[6 * 520] = (bf16_t)(v.w & 0xffff); d[7 * 520] = (bf16_t)(v.w >> 16);
  }
  __syncthreads();
  {
    const int tt = tid >> 3, part = tid & 7;
    uint4 v[8];
    float ss = 0.f;
#pragma unroll
    for (int i = 0; i < 8; ++i) {
      v[i] = *(const uint4*)(sT + tt * 520 + part * 64 + 8 * i);
      float x[8];
      unpack8(v[i], x);
#pragma unroll
      for (int e = 0; e < 8; ++e) ss += x[e] * x[e];
    }
    ss += __shfl_xor(ss, 1); ss += __shfl_xor(ss, 2); ss += __shfl_xor(ss, 4);
    const float r = rsqrtf(ss * (1.f / 512.f) + 1e-6f);
#pragma unroll
    for (int i = 0; i < 8; ++i) {
      float x[8];
      unpack8(v[i], x);
      const int c0 = part * 64 + 8 * i;
      const float4 g0 = *(const float4*)(p.g_out_hy + c0), g1 = *(const float4*)(p.g_out_hy + c0 + 4);
      *(uint4*)(mix + (size_t)(t0 + tt) * D + 512 + c0) =
          make_uint4(pack2(x[0] * r * g0.x, x[1] * r * g0.y), pack2(x[2] * r * g0.z, x[3] * r * g0.w),
                     pack2(x[4] * r * g1.x, x[5] * r * g1.y), pack2(x[6] * r * g1.z, x[7] * r * g1.w));
    }
  }
}

__device__ __forceinline__ void actfix_item(const Params& p, int item) {
  const int idx = item * 256 + ltid();
  if (idx >= 512 * 352) return;
  const int j = (idx % 352) * 8, rowi = idx / 352, wt = rowi >> 1, which = rowi & 1;
  const int t = 64 * wt + 63 * which, L = t < NCTX ? SEQC : SEQL, pos = t & (L - 1);
  const bf16_t* edge = (const bf16_t*)(p.ws + OFF_EDGE);
  bf16_t* act = (bf16_t*)(p.ws + OFF_U);
  const bf16_t *pr, *cu, *nx;
  bool zp = false, zn = false;
  if (which == 0) { zp = pos == 0; pr = edge + (size_t)((zp ? wt : wt - 1) * 4 + 3) * 5632; cu = edge + (size_t)(wt * 4 + 0) * 5632; nx = edge + (size_t)(wt * 4 + 1) * 5632; }
  else { zn = pos == L - 1; pr = edge + (size_t)(wt * 4 + 2) * 5632; cu = edge + (size_t)(wt * 4 + 3) * 5632; nx = edge + (size_t)((zn ? wt : wt + 1) * 4 + 0) * 5632; }
  float pa[8], pg[8], ca[8], cgv[8], na[8], ng[8];
  unpack8(*(const uint4*)(pr + j), pa); unpack8(*(const uint4*)(pr + 2816 + j), pg);
  unpack8(*(const uint4*)(cu + j), ca); unpack8(*(const uint4*)(cu + 2816 + j), cgv);
  unpack8(*(const uint4*)(nx + j), na); unpack8(*(const uint4*)(nx + 2816 + j), ng);
  float o[8];
#pragma unroll
  for (int e = 0; e < 8; ++e) {
    const float pae = zp ? 0.f : pa[e], pge = zp ? 0.f : pg[e], nae = zn ? 0.f : na[e], nge = zn ? 0.f : ng[e];
    const float a = p.ffn_conv_w[j + e] * pae + p.ffn_conv_w[5632 + j + e] * ca[e] + p.ffn_conv_w[11264 + j + e] * nae + p.ffn_conv_b[j + e];
    const float g = p.ffn_conv_w[2816 + j + e] * pge + p.ffn_conv_w[5632 + 2816 + j + e] * cgv[e] + p.ffn_conv_w[11264 + 2816 + j + e] * nge + p.ffn_conv_b[2816 + j + e];
    o[e] = a * __builtin_amdgcn_rcpf(1.f + __expf(-a)) * g;
  }
  *(uint4*)(act + (size_t)t * 2816 + j) = make_uint4(pack2(o[0], o[1]), pack2(o[2], o[3]), pack2(o[4], o[5]), pack2(o[6], o[7]));
}

#define XB_TMO      128
#define XB_XCNT(j)  (256  + 64 * (j))
#define XB_XSUB(j)  (1280 + 64 * (j))
#define XB_XGEN(j)  (2304 + 64 * (j))
#define XB_TOP      3328
#define XB_TOPGEN   3392
#define XCD_BAR_WORDS 3456
#define XB_SPIN_CAP (1u << 20)
#define LAS __attribute__((address_space(3)))
__device__ __forceinline__ unsigned xb_ld(unsigned* p) { return __hip_atomic_load(p, __ATOMIC_RELAXED, __HIP_MEMORY_SCOPE_AGENT); }
__device__ __forceinline__ unsigned xb_add(unsigned* p, unsigned v) { return __hip_atomic_fetch_add(p, v, __ATOMIC_RELAXED, __HIP_MEMORY_SCOPE_AGENT); }
__device__ __forceinline__ unsigned xb_xcc_id() { return (unsigned)__builtin_amdgcn_s_getreg((3 << 11) | 20) & 0xFu; }
#define XB_SPIN(cond, bar) do { unsigned _sp = 0; while (cond) { __builtin_amdgcn_s_sleep(1); \
    if ((++_sp & 255u) == 0u) { if (xb_ld(&(bar)[XB_TMO])) break; if (_sp > XB_SPIN_CAP) { atomicAdd(&(bar)[XB_TMO], 1u); break; } } } } while (0)
struct XcdBarrier { unsigned* bar; unsigned x; volatile LAS unsigned* st; };
__device__ __forceinline__ XcdBarrier xcd_barrier_post(unsigned* bar, volatile LAS unsigned* st) {
  XcdBarrier b; b.bar = bar; b.x = xb_xcc_id(); b.st = st;
  if (threadIdx.x == 0) (void)xb_add(&bar[XB_XCNT(b.x)], 1u);
  return b;
}
__device__ __forceinline__ void xcd_barrier_complete(unsigned* bar, unsigned x, unsigned& nloc, unsigned& nx) {
  const unsigned G = gridDim.x * gridDim.y * gridDim.z;
  unsigned sum, cnt, mine, sp = 0u;
  for (;;) {
    sum = 0u; cnt = 0u; mine = 0u;
#pragma unroll
    for (unsigned j = 0; j < 16; ++j) { const unsigned c = xb_ld(&bar[XB_XCNT(j)]); sum += c; cnt += (c > 0u) ? 1u : 0u; mine = (j == x) ? c : mine; }
    if (sum == G) break;
    __builtin_amdgcn_s_sleep(1);
    if ((++sp & 255u) == 0u) { if (xb_ld(&bar[XB_TMO])) break; if (sp > XB_SPIN_CAP) { atomicAdd(&bar[XB_TMO], 1u); break; } }
  }
  nloc = mine > 0u ? mine : 1u; nx = cnt > 0u ? cnt : 1u;
}
__device__ __forceinline__ void xcd_barrier(const XcdBarrier& b) {
  asm volatile("s_waitcnt vmcnt(0)" ::: "memory");
  __syncthreads();
  if (threadIdx.x == 0) {
    unsigned* bar = b.bar;
    __builtin_amdgcn_s_waitcnt(0);
    unsigned nloc = b.st[0], nx = b.st[1];
    if (nloc == 0u) { xcd_barrier_complete(bar, b.x, nloc, nx); b.st[0] = nloc; b.st[1] = nx; }
    const unsigned old = xb_add(&bar[XB_XSUB(b.x)], 1u);
    const unsigned gen = old / nloc;
    if (old + 1u == (gen + 1u) * nloc) {
      __builtin_amdgcn_fence(__ATOMIC_RELEASE, "agent");
      asm volatile("s_waitcnt vmcnt(0)" ::: "memory");
      const unsigned og = xb_add(&bar[XB_TOP], 1u);
      const unsigned tg = og / nx;
      if (og + 1u == (tg + 1u) * nx) xb_add(&bar[XB_TOPGEN], 1u);
      else XB_SPIN(xb_ld(&bar[XB_TOPGEN]) == tg, bar);
      __builtin_amdgcn_fence(__ATOMIC_ACQUIRE, "agent");
      xb_add(&bar[XB_XGEN(b.x)], 1u);
      asm volatile("s_waitcnt vmcnt(0)" ::: "memory");
    } else {
      XB_SPIN(xb_ld(&bar[XB_XGEN(b.x)]) == gen, bar);
      __builtin_amdgcn_fence(__ATOMIC_ACQUIRE, "agent");
      asm volatile("s_waitcnt vmcnt(0)" ::: "memory");
    }
  }
  __syncthreads();
}
constexpr size_t OFF_BAR = 25 * MiB - 16384;
static_assert(OFF_MOD + 3 * 6144 * 4 <= OFF_BAR, "bar");

template <int ph>
__device__ __forceinline__ void run_phase(const Params& p, char* smem) {
  const int bid = blockIdx.x, G = gridDim.x;
  char* ws = p.ws;
  if constexpr (ph == 0) {
    for (int it = bid; it < 544 + 96 + 32 + 3080; it += G) {
      if (it < 544) filter_item(p, it, smem);
      else if (it < 640) mod_item(p, it - 544, smem);
      else if (it < 672) cache_item(p, it - 640);
      else {
        int t = it - 672;
        if (t < 576) transpose_item(p.w_in, 1024, DIN, (bf16_t*)(ws + OFF_WIN), t, 36, smem);
        else if ((t -= 576) < 72) transpose_item(p.w_uq, 384, 768, (bf16_t*)(ws + OFF_WUQ), t, 12, smem);
        else if ((t -= 72) < 64) transpose_item(p.w_ukv, 256, 1024, (bf16_t*)(ws + OFF_WUKV), t, 16, smem);
        else if ((t -= 64) < 256) transpose_item(p.w_out, 1024, 1024, (bf16_t*)(ws + OFF_WOUT), t, 16, smem);
        else if ((t -= 256) < 1408) transpose_item(p.w_up, 1024, 5632, (bf16_t*)(ws + OFF_WUP), t, 88, smem, true);
        else { t -= 1408; transpose_item(p.w_down, 2816, 1024, (bf16_t*)(ws + OFF_WDOWN), t, 16, smem); }
      }
    }
  } else if constexpr (ph == 1) {
    rmsmod_phase<0>(p);
  } else if constexpr (ph == 2) {
    EpiIn epi{(float*)(ws + OFF_PROJ), (bf16_t*)(ws + OFF_HYT)};
    EpiProj epr{(float*)(ws + OFF_PROJ)};
    for (int t = bid; t < 128 * 18; t += G) {
      const int nt = t % 18;
      if (nt < 5) gemm_tile<true>((const bf16_t*)(ws + OFF_H), 1024, (const bf16_t*)(ws + OFF_WIN), 1024, 1024, (t / 18) * 128, nt * 128, smem, epr);
      else gemm_tile<false>((const bf16_t*)(ws + OFF_H), 1024, (const bf16_t*)(ws + OFF_WIN), 1024, 1024, (t / 18) * 128, nt * 128, smem, epi);
    }
  } else if constexpr (ph == 3) {
    for (int it = bid; it < 512; it += G) hyena_item<0>(p, 1, it, smem);
    for (int it = bid; it < 512; it += G) hyena_item<0>(p, 0, it, smem);
    for (int it = G - 1 - bid; it < 512; it += G) token_item(p, it);
  } else if constexpr (ph == 4) {
    EpiQ eq{(bf16_t*)(ws + OFF_QRAW)};
    EpiKV ekv{(bf16_t*)(ws + OFF_KRAW), (bf16_t*)(ws + OFF_VTC), (bf16_t*)(ws + OFF_VTL)};
    for (int it = bid; it < 512; it += G) hyena_item<1>(p, 1, it, smem);
    for (int t = bid; t < 768; t += G) gemm_tile<true>((const bf16_t*)(ws + OFF_QA), 384, (const bf16_t*)(ws + OFF_WUQ), 384, 384, (t / 6) * 128, (t % 6) * 128, smem, eq);
    for (int t = bid; t < 1088; t += G) gemm_tile<false>((const bf16_t*)(ws + OFF_CKVN), 256, (const bf16_t*)(ws + OFF_WUKV), 256, 256, (t / 8) * 128, (t % 8) * 128, smem, ekv);
    for (int it = bid; it < 512; it += G) hyena_item<1>(p, 0, it, smem);
  } else if constexpr (ph == 5) {
    for (int it = bid; it < 544; it += G) qk_item(p, 512 + it);
  } else if constexpr (ph == 6) {
    for (int it = bid; it < 1024; it += G) attn_item(p, it, smem);
  } else if constexpr (ph == 7) {
    for (int it = bid; it < 512; it += G) merge_item(p, it, smem);
  } else if constexpr (ph == 8) {
    EpiOut epi{&p};
    if (G == 512) {
      const int x = bid & 7, j = bid >> 3;
      for (int r = 0; r < 2; ++r)
        gemm_tile<true>((const bf16_t*)(ws + OFF_H), 1024, (const bf16_t*)(ws + OFF_WOUT), 1024, 1024, (x * 16 + r * 8 + (j >> 3)) * 128, (j & 7) * 128, smem, epi);
    } else {
      for (int t = bid; t < 128 * 8; t += G)
        gemm_tile<true>((const bf16_t*)(ws + OFF_H), 1024, (const bf16_t*)(ws + OFF_WOUT), 1024, 1024, (t / 8) * 128, (t % 8) * 128, smem, epi);
    }
  } else if constexpr (ph == 9) {
    rmsmod_phase<1>(p);
  } else if constexpr (ph == 10) {
    for (int t = bid; t < 128 * 44; t += G) gemm_up_act_tile(p, (t / 44) * 128, (t % 44) * 128, smem);
  } else if constexpr (ph == 11) {
    for (int it = bid; it < 704; it += G) actfix_item(p, it);
  } else if constexpr (ph == 12) {
    EpiY epi{&p, 0};
    if (G == 512) {
      const int x = bid & 7, j = bid >> 3;
      for (int r = 0; r < 2; ++r)
        gemm_tile<true>((const bf16_t*)(ws + OFF_U), 2816, (const bf16_t*)(ws + OFF_WDOWN), 2816, 2816, (x * 16 + r * 8 + (j >> 3)) * 128, (j & 7) * 128, smem, epi);
    } else {
      for (int t = bid; t < 128 * 8; t += G)
        gemm_tile<true>((const bf16_t*)(ws + OFF_U), 2816, (const bf16_t*)(ws + OFF_WDOWN), 2816, 2816, (t / 8) * 128, (t % 8) * 128, smem, epi);
    }
  }
}

#if ONE_LAUNCH
template <int PH>
__device__ __forceinline__ void run_all(const Params& p, char* smem, cg::grid_group& grid, const XcdBarrier& xb) {
  run_phase<PH>(p, smem);
  if constexpr (((DBL_MASK >> PH) & 1) != 0) { xcd_barrier(xb); run_phase<PH>(p, smem); }
  if constexpr (PH < 12) {
    xcd_barrier(xb);
    run_all<PH + 1>(p, smem, grid, xb);
  }
}
constexpr int DYN_LDS = 65536 + 64;
__global__ void __launch_bounds__(256, 2) mega_kernel(Params p) {
  extern __shared__ __attribute__((aligned(16))) char smem[];
  uint4* xb_words = (uint4*)(smem + 65536);
  cg::grid_group grid = cg::this_grid();
  if (threadIdx.x == 0) *xb_words = make_uint4(0u, 0u, 0u, 0u);
  __syncthreads();
  XcdBarrier xb = xcd_barrier_post((unsigned*)(p.ws + OFF_BAR), (volatile LAS unsigned*)xb_words);
  if (p.ws == nullptr) grid.sync();
  run_all<0>(p, smem, grid, xb);
}
#else
template <int PH>
__global__ void __launch_bounds__(256, 2) phase_kernel(Params p) {
  __shared__ __attribute__((aligned(16))) char smem[SMEM_BYTES];
  run_phase<PH>(p, smem);
}
#ifndef DBG_STOP
#define DBG_STOP 15
#endif
__global__ void dump_kernel(Params p, size_t off, int count) {
  const bf16_t* src = (const bf16_t*)(p.ws + off);
  const bf16_t* src2 = (const bf16_t*)(p.ws + DBG_OFF2);
  for (int i = blockIdx.x * 256 + threadIdx.x; i < 16777216; i += gridDim.x * 256)
    p.out[i] = i < DBG_CNT ? bf2f(src[i]) : (i - DBG_CNT < DBG_CNT2 ? bf2f(src2[i - DBG_CNT]) : 0.f);
}
template <int PH>
static void launch_all(const Params& p, hipStream_t stream) {
  phase_kernel<PH><<<512, 256, 0, stream>>>(p);
  if constexpr (PH < 12) launch_all<PH + 1>(p, stream);
}
#endif

extern "C" void kernel_launch(void* const* d_in, const int* in_sizes, int n_in, void* d_out, int out_size, void* d_ws,
                              size_t ws_size, hipStream_t stream) {
  Params p{};
  const float** pp = (const float**)&p;
  for (int i = 0; i < 34; ++i) pp[i] = (const float*)d_in[i];
  p.out = (float*)d_out;
  p.ws = (char*)d_ws;
#if ONE_LAUNCH
  (void)hipMemsetAsync((char*)d_ws + OFF_BAR, 0, XCD_BAR_WORDS * 4, stream);
  static int grid_blocks = 0;
  if (!grid_blocks) {
    int dev = 0, cus = 0, per_cu = 0;
    hipGetDevice(&dev);
    hipDeviceGetAttribute(&cus, hipDeviceAttributeMultiprocessorCount, dev);
    (void)hipFuncSetAttribute((const void*)mega_kernel, hipFuncAttributeMaxDynamicSharedMemorySize, DYN_LDS);
    (void)hipOccupancyMaxActiveBlocksPerMultiprocessor(&per_cu, mega_kernel, 256, DYN_LDS);
    if (per_cu > 2) per_cu = 2;
    grid_blocks = cus * per_cu;
  }
  void* args[] = {&p};
  hipError_t e = hipLaunchCooperativeKernel((void*)mega_kernel, dim3(grid_blocks), dim3(256), args, DYN_LDS, stream);
  if (e != hipSuccess) fprintf(stderr, "cooperative launch failed: %s (grid %d)\n", hipGetErrorString(e), grid_blocks);
#else
  launch_all<0>(p, stream);
#if DBG_STOP < 15
  dump_kernel<<<1024, 256, 0, stream>>>(p, DBG_OFF, DBG_CNT);
#endif
#endif
}
```

```cpp
#include <hip/hip_runtime.h>
#include <hip/hip_cooperative_groups.h>
#include <cstdio>
namespace cg = cooperative_groups;

#define DBG_STOP 15
#define DBG_NOHY 0
#ifndef DBL_MASK
#define DBL_MASK 0
#endif
#define DBG_OFF OFF_QRAW
#define DBG_OFF2 OFF_KRAW
#define DBG_CNT 12582912
#define DBG_CNT2 0
#ifndef ONE_LAUNCH
#define ONE_LAUNCH 1
#endif

typedef unsigned short bf16_t;
typedef short bf16x8 __attribute__((ext_vector_type(8)));
typedef float f32x4 __attribute__((ext_vector_type(4)));
typedef float f32x16 __attribute__((ext_vector_type(16)));

constexpr int D = 1024, NTOK = 16384, NCTX = 8192, SEQC = 256, SEQL = 4096;
constexpr int DIN = 2208, DINP = 2304, QL = 384, KVL = 256, DFF = 2816;
constexpr int NROWKV = 17408;
constexpr size_t MiB = 1048576;

constexpr size_t OFF_WIN = 0;
constexpr size_t OFF_WUQ = OFF_WIN + (size_t)DINP * 1024 * 2;
constexpr size_t OFF_WUKV = OFF_WUQ + (size_t)768 * 384 * 2;
constexpr size_t OFF_WOUT = OFF_WUKV + (size_t)1024 * 256 * 2;
constexpr size_t OFF_WUP = OFF_WOUT + (size_t)1024 * 1024 * 2;
constexpr size_t OFF_WDOWN = OFF_WUP + (size_t)5632 * 1024 * 2;
constexpr size_t OFF_MOD = OFF_WDOWN + (size_t)1024 * 2816 * 2;
static_assert(OFF_MOD + 3 * 6144 * 4 <= 25 * MiB, "A region");
constexpr size_t OFF_RLAT = 25 * MiB;
constexpr size_t OFF_RCTX = 41 * MiB;
constexpr size_t OFF_H = 42 * MiB;
constexpr size_t OFF_ZT = 42 * MiB;
constexpr size_t OFF_QA = 58 * MiB;
constexpr size_t OFF_KPE = 70 * MiB;
constexpr size_t OFF_PROJ = 74 * MiB;
constexpr size_t OFF_QRAW = 74 * MiB;
constexpr size_t OFF_Y2T = 98 * MiB;
constexpr size_t OFF_ATTN = 116 * MiB;
constexpr size_t OFF_U = 74 * MiB;
constexpr size_t OFF_HYT = 116 * MiB;
constexpr size_t OFF_Q = 116 * MiB;
constexpr size_t OFF_KC = 140 * MiB;
constexpr size_t OFF_KL = 152 * MiB;
constexpr size_t OFF_CKVN = 164 * MiB;
constexpr size_t OFF_KRAW = 173 * MiB;
constexpr size_t OFF_VTC = 190 * MiB;
constexpr size_t OFF_VTL = 198 * MiB;
constexpr size_t OFF_ACT = 162 * MiB;

constexpr int OUT_YS = 0;
constexpr int OUT_CKV = 16777216;
constexpr int OUT_KPE = 16777216 + 2097152;

constexpr int SMEM_BYTES = 51200;

struct Params {
  const float *x_prompt, *x_sample, *cache_ckv, *cache_kpe, *c, *c_ctx, *w_ada, *b_ada, *g_mix, *w_in, *g_qa, *w_uq,
      *g_kva, *w_ukv, *g_q, *g_k, *hy_conv_w, *hy_conv_b, *filt_w1, *filt_b1, *filt_freq1, *filt_w2, *filt_b2,
      *filt_freq2, *filt_w3, *filt_bias, *g_out_att, *g_out_hy, *w_out, *g_ffn, *w_up, *ffn_conv_w, *ffn_conv_b, *w_down;
  float* out;
  char* ws;
};

typedef __bf16 bf16x2_t __attribute__((ext_vector_type(2)));
__device__ __forceinline__ unsigned pack2(float lo, float hi) {
  bf16x2_t v;
  v[0] = (__bf16)lo;
  v[1] = (__bf16)hi;
  return __builtin_bit_cast(unsigned, v);
}
__device__ __forceinline__ float bflo(unsigned u) { return __uint_as_float(u << 16); }
__device__ __forceinline__ float bfhi(unsigned u) { return __uint_as_float(u & 0xffff0000u); }
__device__ __forceinline__ float bf2f(bf16_t h) { return __uint_as_float(((unsigned)h) << 16); }
__device__ __forceinline__ bf16_t f2bf(float f) { return (bf16_t)(pack2(f, 0.f) & 0xffffu); }
__device__ __forceinline__ float wave_sum(float v) {
#pragma unroll
  for (int o = 32; o >= 1; o >>= 1) v += __shfl_xor(v, o);
  return v;
}
__device__ __forceinline__ int ltid() { int t = threadIdx.x; asm volatile("" : "+v"(t)); return t; }
__device__ __forceinline__ float sin_turns(float t) { t -= floorf(t); return __builtin_amdgcn_sinf(t); }
__device__ __forceinline__ float cos_turns(float t) { t -= floorf(t); return __builtin_amdgcn_cosf(t); }
__device__ __forceinline__ float sin_rad(float x) { return sin_turns(x * 0.15915494309189535f); }
__device__ __forceinline__ const float* xrow(const Params& p, int row) {
  return row < NCTX ? p.x_prompt + (size_t)row * D : p.x_sample + (size_t)(row - NCTX) * D;
}
__device__ __forceinline__ int modidx(int row) { return row < NCTX ? 0 : 1 + ((row - NCTX) >> 12); }

template <bool SWAP>
__device__ __forceinline__ void gemm_main(const bf16_t* __restrict__ A, int lda, const bf16_t* __restrict__ Bt, int ldb,
                                          int K, int m0, int n0, char* smem, f32x4 (&acc)[4][4]) {
  const int tid = ltid(), lane = tid & 63, wid = tid >> 6, wr = wid >> 1, wc = wid & 1;
  const int fr = lane & 15, fq = lane >> 4;
  bf16_t* sbase = (bf16_t*)smem;
#pragma unroll
  for (int m = 0; m < 4; ++m)
#pragma unroll
    for (int n = 0; n < 4; ++n) acc[m][n] = (f32x4){0.f, 0.f, 0.f, 0.f};
  const int lr = tid >> 3, lc = (tid & 7) * 8;
  const bf16_t* ga = A + (size_t)(m0 + lr) * lda + lc;
  const bf16_t* gb = Bt + (size_t)(n0 + lr) * ldb + lc;
  const size_t sa32 = (size_t)32 * lda, sb32 = (size_t)32 * ldb;
  uint4 ra0 = *(const uint4*)(ga), ra1 = *(const uint4*)(ga + sa32), ra2 = *(const uint4*)(ga + 2 * sa32), ra3 = *(const uint4*)(ga + 3 * sa32);
  uint4 rb0 = *(const uint4*)(gb), rb1 = *(const uint4*)(gb + sb32), rb2 = *(const uint4*)(gb + 2 * sb32), rb3 = *(const uint4*)(gb + 3 * sb32);
  const int nk = K >> 6;
  const int woff = lr * 64 + (((tid & 7) ^ (lr & 7)) * 8);
  const int aoff = (wr * 64 + fr) * 64, boff = 8192 + (wc * 64 + fr) * 64;
  __syncthreads();
  {
    bf16_t* wa = sbase + woff;
    *(uint4*)(wa) = ra0; *(uint4*)(wa + 32 * 64) = ra1; *(uint4*)(wa + 64 * 64) = ra2; *(uint4*)(wa + 96 * 64) = ra3;
    *(uint4*)(wa + 8192) = rb0; *(uint4*)(wa + 8192 + 32 * 64) = rb1; *(uint4*)(wa + 8192 + 64 * 64) = rb2; *(uint4*)(wa + 8192 + 96 * 64) = rb3;
  }
  if (nk > 1) {
    ga += 64; gb += 64;
    ra0 = *(const uint4*)(ga); ra1 = *(const uint4*)(ga + sa32); ra2 = *(const uint4*)(ga + 2 * sa32); ra3 = *(const uint4*)(ga + 3 * sa32);
    rb0 = *(const uint4*)(gb); rb1 = *(const uint4*)(gb + sb32); rb2 = *(const uint4*)(gb + 2 * sb32); rb3 = *(const uint4*)(gb + 3 * sb32);
  }
  __syncthreads();
  for (int kt = 0; kt < nk; ++kt) {
    const bf16_t* cur = sbase + (kt & 1) * 16384;
    bf16x8 af[2][4], bfr[2][4];
#pragma unroll
    for (int ks = 0; ks < 2; ++ks) {
#pragma unroll
      for (int m = 0; m < 4; ++m) af[ks][m] = *(const bf16x8*)(cur + aoff + m * 16 * 64 + (((ks * 4 + fq) ^ (fr & 7)) * 8));
#pragma unroll
      for (int n = 0; n < 4; ++n) bfr[ks][n] = *(const bf16x8*)(cur + boff + n * 16 * 64 + (((ks * 4 + fq) ^ (fr & 7)) * 8));
    }
    __builtin_amdgcn_sched_barrier(0);
    {
      bf16_t* wa = sbase + ((kt + 1) & 1) * 16384 + woff;
      *(uint4*)(wa) = ra0; *(uint4*)(wa + 32 * 64) = ra1; *(uint4*)(wa + 64 * 64) = ra2; *(uint4*)(wa + 96 * 64) = ra3;
      *(uint4*)(wa + 8192) = rb0; *(uint4*)(wa + 8192 + 32 * 64) = rb1; *(uint4*)(wa + 8192 + 64 * 64) = rb2; *(uint4*)(wa + 8192 + 96 * 64) = rb3;
      const int adv = (kt + 2 < nk) ? 64 : 0;
      ga += adv; gb += adv;
      ra0 = *(const uint4*)(ga); ra1 = *(const uint4*)(ga + sa32); ra2 = *(const uint4*)(ga + 2 * sa32); ra3 = *(const uint4*)(ga + 3 * sa32);
      rb0 = *(const uint4*)(gb); rb1 = *(const uint4*)(gb + sb32); rb2 = *(const uint4*)(gb + 2 * sb32); rb3 = *(const uint4*)(gb + 3 * sb32);
    }
#pragma unroll
    for (int ks = 0; ks < 2; ++ks)
#pragma unroll
      for (int m = 0; m < 4; ++m)
#pragma unroll
        for (int n = 0; n < 4; ++n) {
          if (SWAP) acc[m][n] = __builtin_amdgcn_mfma_f32_16x16x32_bf16(bfr[ks][n], af[ks][m], acc[m][n], 0, 0, 0);
          else acc[m][n] = __builtin_amdgcn_mfma_f32_16x16x32_bf16(af[ks][m], bfr[ks][n], acc[m][n], 0, 0, 0);
        }
#pragma unroll
    for (int i = 0; i < 8; ++i) { __builtin_amdgcn_sched_group_barrier(0x008, 2, 0); __builtin_amdgcn_sched_group_barrier(0x200, 1, 0); }
#pragma unroll
    for (int i = 0; i < 8; ++i) { __builtin_amdgcn_sched_group_barrier(0x008, 2, 0); __builtin_amdgcn_sched_group_barrier(0x020, 1, 0); }
    __builtin_amdgcn_sched_barrier(0);
    if (kt + 1 < nk) __syncthreads();
  }
}
template <bool SWAP, class Epi>
__device__ __forceinline__ void gemm_tile(const bf16_t* __restrict__ A, int lda, const bf16_t* __restrict__ Bt, int ldb,
                                          int K, int m0, int n0, char* smem, const Epi& epi) {
  f32x4 acc[4][4];
  gemm_main<SWAP>(A, lda, Bt, ldb, K, m0, n0, smem, acc);
  const int tid = ltid(), lane = tid & 63, wid = tid >> 6, wr = wid >> 1, wc = wid & 1;
  const int fr = lane & 15, fq = lane >> 4;
#pragma unroll
  for (int m = 0; m < 4; ++m)
#pragma unroll
    for (int n = 0; n < 4; ++n) {
      if (SWAP) epi(m0 + wr * 64 + m * 16 + fr, n0 + wc * 64 + n * 16 + fq * 4, acc[m][n]);
      else epi(m0 + wr * 64 + m * 16 + fq * 4, n0 + wc * 64 + n * 16 + fr, acc[m][n]);
    }
}

template <int CTRL>
__device__ __forceinline__ float dpp_ror(float v) {
  return __int_as_float(__builtin_amdgcn_update_dpp(0, __float_as_int(v), CTRL, 0xF, 0xF, false));
}
constexpr size_t OFF_EDGE = 162 * MiB;
__device__ __forceinline__ void gemm_up_act_tile(const Params& p, int m0, int n0, char* smem) {
  f32x4 acc[4][4];
  gemm_main<true>((const bf16_t*)(p.ws + OFF_H), 1024, (const bf16_t*)(p.ws + OFF_WUP), 1024, 1024, m0, n0, smem, acc);
  const int tid = ltid(), lane = tid & 63, wid = tid >> 6, wr = wid >> 1, wc = wid & 1;
  const int fr = lane & 15, fq = lane >> 4;
  bf16_t* act = (bf16_t*)(p.ws + OFF_U);
  bf16_t* edge = (bf16_t*)(p.ws + OFF_EDGE);
  const int rowbase = m0 + wr * 64, wt = rowbase >> 6;
#pragma unroll
  for (int i = 0; i < 2; ++i) {
    const int cperm = n0 + wc * 64 + 32 * i;
    const int j0 = (cperm >> 5) * 16 + 4 * fq;
    const float4 wa0 = *(const float4*)(p.ffn_conv_w + j0), wa1 = *(const float4*)(p.ffn_conv_w + 5632 + j0), wa2 = *(const float4*)(p.ffn_conv_w + 11264 + j0);
    const float4 wg0 = *(const float4*)(p.ffn_conv_w + 2816 + j0), wg1 = *(const float4*)(p.ffn_conv_w + 5632 + 2816 + j0), wg2 = *(const float4*)(p.ffn_conv_w + 11264 + 2816 + j0);
    const float4 ba = *(const float4*)(p.ffn_conv_b + j0), bg = *(const float4*)(p.ffn_conv_b + 2816 + j0);
    const float w0a[4] = {wa0.x, wa0.y, wa0.z, wa0.w}, w1a[4] = {wa1.x, wa1.y, wa1.z, wa1.w}, w2a[4] = {wa2.x, wa2.y, wa2.z, wa2.w};
    const float w0g[4] = {wg0.x, wg0.y, wg0.z, wg0.w}, w1g[4] = {wg1.x, wg1.y, wg1.z, wg1.w}, w2g[4] = {wg2.x, wg2.y, wg2.z, wg2.w};
    const float bba[4] = {ba.x, ba.y, ba.z, ba.w}, bbg[4] = {bg.x, bg.y, bg.z, bg.w};
#pragma unroll
    for (int m = 0; m < 4; ++m) {
      float o[4];
#pragma unroll
      for (int e = 0; e < 4; ++e) {
        const float a = acc[m][2 * i][e], g = acc[m][2 * i + 1][e];
        const float au1 = dpp_ror<0x121>(a), gu1 = dpp_ror<0x121>(g), ad1 = dpp_ror<0x12F>(a), gd1 = dpp_ror<0x12F>(g);
        float au2 = 0.f, gu2 = 0.f, ad2 = 0.f, gd2 = 0.f;
        if (m > 0) { au2 = dpp_ror<0x121>(acc[m - 1][2 * i][e]); gu2 = dpp_ror<0x121>(acc[m - 1][2 * i + 1][e]); }
        if (m < 3) { ad2 = dpp_ror<0x12F>(acc[m + 1][2 * i][e]); gd2 = dpp_ror<0x12F>(acc[m + 1][2 * i + 1][e]); }
        const float au = fr > 0 ? au1 : au2, gu = fr > 0 ? gu1 : gu2, ad = fr < 15 ? ad1 : ad2, gd = fr < 15 ? gd1 : gd2;
        const float ca = w0a[e] * au + w1a[e] * a + w2a[e] * ad + bba[e];
        const float cgv = w0g[e] * gu + w1g[e] * g + w2g[e] * gd + bbg[e];
        o[e] = ca * __builtin_amdgcn_rcpf(1.f + __expf(-ca)) * cgv;
      }
      const int lr64 = m * 16 + fr, row = rowbase + lr64;
      if (lr64 >= 1 && lr64 <= 62) *(uint2*)(act + (size_t)row * 2816 + j0) = make_uint2(pack2(o[0], o[1]), pack2(o[2], o[3]));
      if (lr64 <= 1 || lr64 >= 62) {
        const int slot = lr64 <= 1 ? lr64 : lr64 - 60;
        bf16_t* er = edge + (size_t)(wt * 4 + slot) * 5632;
        *(uint2*)(er + j0) = make_uint2(pack2(acc[m][2 * i][0], acc[m][2 * i][1]), pack2(acc[m][2 * i][2], acc[m][2 * i][3]));
        *(uint2*)(er + 2816 + j0) = make_uint2(pack2(acc[m][2 * i + 1][0], acc[m][2 * i + 1][1]), pack2(acc[m][2 * i + 1][2], acc[m][2 * i + 1][3]));
      }
    }
  }
}

__device__ __forceinline__ void transpose_item(const float* __restrict__ W, int K, int N, bf16_t* __restrict__ WT, int tile, int ntn, char* smem, bool perm = false) {
  float* s = (float*)smem;
  const int tk = tile / ntn, tn = tile % ntn, tid = ltid();
  const int k0 = tk * 64, n0 = tn * 64;
  __syncthreads();
  {
    const int r = tid >> 4, c4 = (tid & 15) * 4;
#pragma unroll
    for (int i = 0; i < 4; ++i) {
      const int k = r + 16 * i;
      float4 v = make_float4(0.f, 0.f, 0.f, 0.f);
      if (n0 + c4 < N) v = *(const float4*)(W + (size_t)(k0 + k) * N + n0 + c4);
      s[k * 65 + c4 + 0] = v.x; s[k * 65 + c4 + 1] = v.y; s[k * 65 + c4 + 2] = v.z; s[k * 65 + c4 + 3] = v.w;
    }
  }
  __syncthreads();
  {
    const int n = tid >> 2, kc = (tid & 3) * 16;
    unsigned o[8];
#pragma unroll
    for (int i = 0; i < 8; ++i) o[i] = pack2(s[(kc + 2 * i) * 65 + n], s[(kc + 2 * i + 1) * 65 + n]);
    int nr = n0 + n;
    if (perm) { const int hf = nr >= 2816 ? 1 : 0, cc = nr - hf * 2816; nr = 32 * (cc >> 4) + 16 * hf + (cc & 15); }
    uint4* dst = (uint4*)(WT + (size_t)nr * K + k0 + kc);
    dst[0] = make_uint4(o[0], o[1], o[2], o[3]);
    dst[1] = make_uint4(o[4], o[5], o[6], o[7]);
  }
}

__device__ __forceinline__ void mod_item(const Params& p, int item, char* smem) {
  float* s = (float*)smem;
  float* red = s + 3072;
  const int tid = ltid();
  __syncthreads();
  for (int e = tid; e < 3072; e += 256) {
    const int v = e >> 10, k = e & 1023;
    const float x = (v == 0) ? p.c_ctx[k] : p.c[(v - 1) * D + k];
    s[e] = x / (1.f + __expf(-x));
  }
  __syncthreads();
  const int jl = tid & 63, kq = tid >> 6, j = item * 64 + jl, k0 = kq * 256;
  float a0 = 0.f, a1 = 0.f, a2 = 0.f;
#pragma unroll 32
  for (int k = 0; k < 256; ++k) {
    const float w = p.w_ada[(size_t)(k0 + k) * 6144 + j];
    a0 += s[k0 + k] * w; a1 += s[1024 + k0 + k] * w; a2 += s[2048 + k0 + k] * w;
  }
  red[(kq * 3 + 0) * 64 + jl] = a0; red[(kq * 3 + 1) * 64 + jl] = a1; red[(kq * 3 + 2) * 64 + jl] = a2;
  __syncthreads();
  if (tid < 192) {
    const int v = tid >> 6;
    const float r = red[(0 * 3 + v) * 64 + jl] + red[(1 * 3 + v) * 64 + jl] + red[(2 * 3 + v) * 64 + jl] + red[(3 * 3 + v) * 64 + jl];
    ((float*)(p.ws + OFF_MOD))[v * 6144 + j] = r + p.b_ada[j];
  }
}

__device__ __forceinline__ void filter_item(const Params& p, int item2, char* smem) {
  const int item = item2 >> 1, chalf = item2 & 1;
  int n, p0; bf16_t* R;
  if (item < 256) { n = 4096; p0 = item * 16; R = (bf16_t*)(p.ws + OFF_RLAT); }
  else { n = 256; p0 = (item - 256) * 16; R = (bf16_t*)(p.ws + OFF_RCTX); }
  const int n2 = 2 * n, tid = ltid();
  float* z = (float*)smem;
  float* h1 = z + 16 * 36;
  float* h2 = h1 + 16 * 64;
  __syncthreads();
#pragma unroll 1
  for (int e = tid; e < 16 * 33; e += 256) {
    const int pp = e / 33, f = e % 33, pos = p0 + pp;
    float val;
    if (f == 0) val = (float)pos / (float)(n - 1);
    else {
      const int k = (f - 1) & 15;
      const float band = 1e-4f + (float)k * ((15.f - 1e-4f) / 15.f);
      const float turns = band * ((float)pos / (float)n);
      val = (f <= 16) ? cos_turns(turns) : -sin_turns(turns);
    }
    z[pp * 36 + f] = val;
  }
  __syncthreads();
  {
    const int j = tid & 63, ppb = tid >> 6;
    float a0, a1, a2, a3;
    a0 = a1 = a2 = a3 = p.filt_b1[j];
#pragma unroll
    for (int f = 0; f < 33; ++f) {
      const float w = p.filt_w1[f * 64 + j];
      a0 += z[(ppb + 0) * 36 + f] * w; a1 += z[(ppb + 4) * 36 + f] * w; a2 += z[(ppb + 8) * 36 + f] * w; a3 += z[(ppb + 12) * 36 + f] * w;
    }
    const float fq1 = p.filt_freq1[j];
    h1[(ppb + 0) * 64 + j] = sin_rad(fq1 * a0); h1[(ppb + 4) * 64 + j] = sin_rad(fq1 * a1);
    h1[(ppb + 8) * 64 + j] = sin_rad(fq1 * a2); h1[(ppb + 12) * 64 + j] = sin_rad(fq1 * a3);
    __syncthreads();
    a0 = a1 = a2 = a3 = p.filt_b2[j];
#pragma unroll 32
    for (int k = 0; k < 64; ++k) {
      const float w = p.filt_w2[k * 64 + j];
      a0 += h1[(ppb + 0) * 64 + k] * w; a1 += h1[(ppb + 4) * 64 + k] * w; a2 += h1[(ppb + 8) * 64 + k] * w; a3 += h1[(ppb + 12) * 64 + k] * w;
    }
    const float fq2 = p.filt_freq2[j];
    h2[j * 16 + ppb + 0] = sin_rad(fq2 * a0); h2[j * 16 + ppb + 4] = sin_rad(fq2 * a1);
    h2[j * 16 + ppb + 8] = sin_rad(fq2 * a2); h2[j * 16 + ppb + 12] = sin_rad(fq2 * a3);
  }
  __syncthreads();
  const float mind = -3.0701134573253946f, maxd = -15.350567286626973f;
  {
    const int colb = tid + 256 * 4 * chalf;
    float acc[4][16];
#pragma unroll
    for (int c4 = 0; c4 < 4; ++c4)
#pragma unroll
      for (int i = 0; i < 16; ++i) acc[c4][i] = 0.f;
#pragma unroll 8
    for (int k = 0; k < 64; ++k) {
      const float4 ha = *(const float4*)(h2 + k * 16), hb = *(const float4*)(h2 + k * 16 + 4), hc = *(const float4*)(h2 + k * 16 + 8), hd = *(const float4*)(h2 + k * 16 + 12);
#pragma unroll
      for (int c4 = 0; c4 < 4; ++c4) {
        const float w = p.filt_w3[k * 2048 + colb + 256 * c4];
        acc[c4][0] += ha.x * w; acc[c4][1] += ha.y * w; acc[c4][2] += ha.z * w; acc[c4][3] += ha.w * w;
        acc[c4][4] += hb.x * w; acc[c4][5] += hb.y * w; acc[c4][6] += hb.z * w; acc[c4][7] += hb.w * w;
        acc[c4][8] += hc.x * w; acc[c4][9] += hc.y * w; acc[c4][10] += hc.z * w; acc[c4][11] += hc.w * w;
        acc[c4][12] += hd.x * w; acc[c4][13] += hd.y * w; acc[c4][14] += hd.z * w; acc[c4][15] += hd.w * w;
      }
    }
#pragma unroll
    for (int c4 = 0; c4 < 4; ++c4) {
      const int col = colb + 256 * c4, o = col >> 10, dir = (col >> 9) & 1, c = col & 511;
      const float delta = fabsf(mind + (float)c * ((maxd - mind) / 511.f));
      bf16_t* Rrow = R + (size_t)(o * 512 + c) * n2;
#pragma unroll
      for (int i = 0; i < 16; ++i) {
        const int pos = p0 + i;
        const float t = (float)pos / (float)(n - 1);
        float val = acc[c4][i] * (__expf(-t * delta) + 0.05f);
        int idx = dir == 0 ? (n - 1 - pos) : (n - 1 + pos);
        if (dir == 1 && pos == 0) { idx = n2 - 1; val = 0.f; }
        Rrow[idx] = f2bf(val);
      }
    }
  }
}

__device__ __forceinline__ void cache_item(const Params& p, int item) {
  const int tid = ltid(), r0 = item * 32;
  bf16_t* ckvn = (bf16_t*)(p.ws + OFF_CKVN);
#pragma unroll 2
  for (int e = tid; e < 32 * 64; e += 256) {
    const int r = r0 + (e >> 6), c4 = (e & 63) * 4;
    const float4 v = *(const float4*)(p.cache_ckv + (size_t)r * 256 + c4);
    *(uint2*)(ckvn + (size_t)(NTOK + r) * 256 + c4) = make_uint2(pack2(v.x, v.y), pack2(v.z, v.w));
  }
}

template <int WHICH>
__device__ __forceinline__ void rmsmod_phase(const Params& p) {
  const int tid = ltid(), lane = tid & 63, wid = tid >> 6;
  const int gw = blockIdx.x * 4 + wid, tw = gridDim.x * 4;
  const float* g = WHICH == 0 ? p.g_mix : p.g_ffn;
  const float* mod = (const float*)(p.ws + OFF_MOD);
  bf16_t* h = (bf16_t*)(p.ws + OFF_H);
  float4 nv0, nv1, nv2, nv3;
  {
    const float* src = WHICH == 0 ? xrow(p, gw) : p.out + (size_t)gw * D;
    nv0 = ((const float4*)src)[lane]; nv1 = ((const float4*)src)[lane + 64]; nv2 = ((const float4*)src)[lane + 128]; nv3 = ((const float4*)src)[lane + 192];
  }
  for (int row = gw; row < NTOK; row += tw) {
    float4 v[4] = {nv0, nv1, nv2, nv3};
    if (row + tw < NTOK) {
      const float* src = WHICH == 0 ? xrow(p, row + tw) : p.out + (size_t)(row + tw) * D;
      nv0 = ((const float4*)src)[lane]; nv1 = ((const float4*)src)[lane + 64]; nv2 = ((const float4*)src)[lane + 128]; nv3 = ((const float4*)src)[lane + 192];
    }
    float ss = 0.f;
#pragma unroll
    for (int i = 0; i < 4; ++i) ss += v[i].x * v[i].x + v[i].y * v[i].y + v[i].z * v[i].z + v[i].w * v[i].w;
    ss = wave_sum(ss);
    const float r = rsqrtf(ss * (1.f / 1024.f) + 1e-6f);
    const float* mv = mod + modidx(row) * 6144 + (WHICH == 0 ? 0 : 3 * 1024);
#pragma unroll
    for (int i = 0; i < 4; ++i) {
      const int e = 4 * (lane + 64 * i);
      const float4 g4 = *(const float4*)(g + e), sh = *(const float4*)(mv + e), sc = *(const float4*)(mv + 1024 + e);
      const float y0 = v[i].x * r * g4.x * (1.f + sc.x) + sh.x, y1 = v[i].y * r * g4.y * (1.f + sc.y) + sh.y;
      const float y2 = v[i].z * r * g4.z * (1.f + sc.z) + sh.z, y3 = v[i].w * r * g4.w * (1.f + sc.w) + sh.w;
      *(uint2*)(h + (size_t)row * D + e) = make_uint2(pack2(y0, y1), pack2(y2, y3));
    }
  }
}

struct EpiIn {
  float* proj; bf16_t* hyT;
  __device__ __forceinline__ void operator()(int row0, int col, const f32x4& v) const {
    if (col < 672) {
#pragma unroll
      for (int j = 0; j < 4; ++j) proj[(size_t)(row0 + j) * 672 + col] = v[j];
    } else if (col < DIN) {
      *(uint2*)(hyT + (size_t)(col - 672) * NTOK + row0) = make_uint2(pack2(v[0], v[1]), pack2(v[2], v[3]));
    }
  }
};
struct EpiProj {
  float* proj;
  __device__ __forceinline__ void operator()(int row, int col0, const f32x4& v) const { *(f32x4*)(proj + (size_t)row * 672 + col0) = v; }
};
struct EpiQ {
  bf16_t* q;
  __device__ __forceinline__ void operator()(int row, int col0, const f32x4& v) const {
    *(uint2*)(q + (size_t)row * 768 + col0) = make_uint2(pack2(v[0], v[1]), pack2(v[2], v[3]));
  }
};
struct EpiKV {
  bf16_t *kraw, *vtc, *vtl;
  __device__ __forceinline__ void operator()(int row0, int col, const f32x4& v) const {
    const int head = col >> 7, cc = col & 127;
    if (cc < 64) {
#pragma unroll
      for (int j = 0; j < 4; ++j) kraw[(size_t)(row0 + j) * 512 + head * 64 + cc] = f2bf(v[j]);
    } else {
      const int dv = cc - 64;
      bf16_t* dst;
      if (row0 < NCTX) dst = vtc + ((size_t)((row0 >> 8) * 8 + head) * 64 + dv) * 256 + (row0 & 255);
      else if (row0 < NTOK) { const int r = row0 - NCTX; dst = vtl + ((size_t)((r >> 12) * 8 + head) * 64 + dv) * 4608 + (r & 4095); }
      else { const int r = row0 - NTOK; dst = vtl + ((size_t)((r >> 9) * 8 + head) * 64 + dv) * 4608 + 4096 + (r & 511); }
      *(uint2*)dst = make_uint2(pack2(v[0], v[1]), pack2(v[2], v[3]));
    }
  }
};
struct EpiOut {
  const Params* p;
  __device__ __forceinline__ void operator()(int row, int col0, const f32x4& v) const {
    const float4 x = *(const float4*)(xrow(*p, row) + col0);
    const float4 m = *(const float4*)((const float*)(p->ws + OFF_MOD) + modidx(row) * 6144 + 2 * 1024 + col0);
    *(float4*)(p->out + (size_t)row * D + col0) = make_float4(x.x + m.x * v[0], x.y + m.y * v[1], x.z + m.z * v[2], x.w + m.w * v[3]);
  }
};
struct EpiU {
  bf16_t* u;
  __device__ __forceinline__ void operator()(int row, int col0, const f32x4& v) const {
    *(uint2*)(u + (size_t)row * 5632 + col0) = make_uint2(pack2(v[0], v[1]), pack2(v[2], v[3]));
  }
};
struct EpiY {
  const Params* p; int half;
  __device__ __forceinline__ void operator()(int row, int col0, const f32x4& v) const {
    const int grow = half * 8192 + row;
    float4* dst = (float4*)(p->out + (size_t)grow * D + col0);
    const float4 x = *dst;
    const float4 m = *(const float4*)((const float*)(p->ws + OFF_MOD) + modidx(grow) * 6144 + 5 * 1024 + col0);
    *dst = make_float4(x.x + m.x * v[0], x.y + m.y * v[1], x.z + m.z * v[2], x.w + m.w * v[3]);
  }
};

__device__ __forceinline__ void token_item(const Params& p, int item) {
  const int tid = ltid(), lane = tid & 63, wid = tid >> 6;
  const float* proj = (const float*)(p.ws + OFF_PROJ);
  bf16_t* qa = (bf16_t*)(p.ws + OFF_QA);
  bf16_t* ckvn = (bf16_t*)(p.ws + OFF_CKVN);
  float* kpe = (float*)(p.ws + OFF_KPE);
  for (int tt = 0; tt < 8; ++tt) {
    const int token = item * 32 + wid * 8 + tt;
    const float* pr = proj + (size_t)token * 672;
    float2 q[3];
    float ss = 0.f;
#pragma unroll
    for (int i = 0; i < 3; ++i) { q[i] = *(const float2*)(pr + lane * 2 + 128 * i); ss += q[i].x * q[i].x + q[i].y * q[i].y; }
    ss = wave_sum(ss);
    const float r = rsqrtf(ss * (1.f / 384.f) + 1e-6f);
#pragma unroll
    for (int i = 0; i < 3; ++i) {
      const int e = lane * 2 + 128 * i;
      *(unsigned*)(qa + (size_t)token * 384 + e) = pack2(q[i].x * r * p.g_qa[e], q[i].y * r * p.g_qa[e + 1]);
    }
    const float4 kv = *(const float4*)(pr + 384 + lane * 4);
    float s2 = wave_sum(kv.x * kv.x + kv.y * kv.y + kv.z * kv.z + kv.w * kv.w);
    const float r2 = rsqrtf(s2 * (1.f / 256.f) + 1e-6f);
    const float4 g = *(const float4*)(p.g_kva + lane * 4);
    const float4 y = make_float4(kv.x * r2 * g.x, kv.y * r2 * g.y, kv.z * r2 * g.z, kv.w * r2 * g.w);
    *(uint2*)(ckvn + (size_t)token * 256 + lane * 4) = make_uint2(pack2(y.x, y.y), pack2(y.z, y.w));
    if (token < NCTX) *(float4*)(p.out + OUT_CKV + (size_t)token * 256 + lane * 4) = y;
    if (lane < 32) {
      const float kp = pr[640 + lane];
      kpe[(size_t)token * 32 + lane] = kp;
      if (token < NCTX) p.out[OUT_KPE + (size_t)token * 32 + lane] = kp;
    }
  }
}

template <int ORDER>
__device__ __forceinline__ void hyena_item(const Params& p, int grp, int c, char* smem) {
  const int tid = ltid(), lane = tid & 63, wid = tid >> 6, fr = lane & 15, fq = lane >> 4;
  const int n = grp ? SEQL : SEQC, nb = n >> 6, L = n;
  const bf16_t* Rrow = (const bf16_t*)(p.ws + (grp ? OFF_RLAT : OFF_RCTX)) + (size_t)(ORDER * 512 + c) * (2 * n);
  const bf16_t* hyT = (const bf16_t*)(p.ws + OFF_HYT);
  bf16_t* sU = (bf16_t*)smem;
  unsigned* sR0 = (unsigned*)(smem + 18432);
  unsigned* sR1 = (unsigned*)(smem + 18432 + 16384);
  const int tok0 = grp * 8192;
  __syncthreads();
  for (int ch = tid; ch < (2 * n) / 8; ch += 256) *(uint4*)((bf16_t*)sR0 + ch * 8) = *(const uint4*)(Rrow + ch * 8);
  if (ORDER == 0) {
    const bf16_t* raw = hyT + (size_t)c * NTOK + tok0;
    const float w0 = p.hy_conv_w[c], w1 = p.hy_conv_w[1536 + c], w2 = p.hy_conv_w[3072 + c], b = p.hy_conv_b[c];
    for (int ch = tid; ch < 1024; ch += 256) {
      const int t = ch * 8, pos = t & (L - 1);
      const uint4 rv = *(const uint4*)(raw + t);
      float x[10];
      x[0] = pos == 0 ? 0.f : bf2f(raw[t - 1]);
      x[1] = bflo(rv.x); x[2] = bfhi(rv.x); x[3] = bflo(rv.y); x[4] = bfhi(rv.y);
      x[5] = bflo(rv.z); x[6] = bfhi(rv.z); x[7] = bflo(rv.w); x[8] = bfhi(rv.w);
      x[9] = (pos + 8 == L) ? 0.f : bf2f(raw[t + 8]);
      float u[8];
#pragma unroll
      for (int i = 0; i < 8; ++i) u[i] = w0 * x[i] + w1 * x[i + 1] + w2 * x[i + 2] + b;
      *(uint4*)(sU + (ch >> 3) * 64 + (((ch & 7) ^ ((ch >> 3) & 7)) * 8)) = make_uint4(pack2(u[0], u[1]), pack2(u[2], u[3]), pack2(u[4], u[5]), pack2(u[6], u[7]));
    }
  } else {
    const bf16_t* zr = (const bf16_t*)(p.ws + OFF_ZT) + (size_t)c * NTOK + tok0;
    for (int ch = tid; ch < 1024; ch += 256) *(uint4*)(sU + (ch >> 3) * 64 + (((ch & 7) ^ ((ch >> 3) & 7)) * 8)) = *(const uint4*)(zr + ch * 8);
  }
  __syncthreads();
  for (int k = tid; k < n; k += 256) {
    const unsigned a = sR0[k], b2 = (k + 1 < n) ? sR0[k + 1] : 0u;
    sR1[k] = (a >> 16) | (b2 << 16);
  }
  __syncthreads();

  f32x4 acc[4][2];
#pragma unroll
  for (int m = 0; m < 4; ++m) { acc[m][0] = (f32x4){0.f, 0.f, 0.f, 0.f}; acc[m][1] = (f32x4){0.f, 0.f, 0.f, 0.f}; }
  const unsigned* abase = (fr & 1) ? (sR0 + ((n - 1 - fr) >> 1) + 4 * fq) : (sR1 + ((n - 2 - fr) >> 1) + 4 * fq);
  const int col0 = 32 * wid + fr, col1 = col0 + 16;
  const int i0 = col0 & (nb - 1), i1 = col1 & (nb - 1);
  for (int d = -(nb - 1); d <= nb - 1; ++d) {
    const bool v0 = (unsigned)(i0 - d) < (unsigned)nb, v1 = (unsigned)(i1 - d) < (unsigned)nb;
    const bool any0 = __ballot(v0) != 0ull, any1 = __ballot(v1) != 0ull;
    if (!any0 && !any1) continue;
    bf16x8 F[6];
    const unsigned* ap = abase - 32 * d + 16;
#pragma unroll
    for (int idx = 0; idx < 6; ++idx) {
      const unsigned* q = ap - 8 * idx;
      union { unsigned u[4]; bf16x8 v; } cv;
      cv.u[0] = q[0]; cv.u[1] = q[1]; cv.u[2] = q[2]; cv.u[3] = q[3];
      F[idx] = cv.v;
    }
#pragma unroll
    for (int nt = 0; nt < 2; ++nt) {
      if (!(nt ? any1 : any0)) continue;
      const bool vv = nt ? v1 : v0;
      const int srow = (nt ? col1 : col0) - d;
      const bf16_t* up = sU + srow * 64;
#pragma unroll
      for (int ks = 0; ks < 2; ++ks) {
        bf16x8 bf = (bf16x8){0, 0, 0, 0, 0, 0, 0, 0};
        if (vv) bf = *(const bf16x8*)(up + (((ks * 4 + fq) ^ (srow & 7)) * 8));
#pragma unroll
        for (int m = 0; m < 4; ++m)
          acc[m][nt] = __builtin_amdgcn_mfma_f32_16x16x32_bf16(F[m + 2 - 2 * ks], bf, acc[m][nt], 0, 0, 0);
      }
    }
  }
  const float skip = p.filt_bias[ORDER * 512 + c];
  const int gcol = (ORDER == 0 ? 512 : 1024) + c;
  const bf16_t* graw = hyT + (size_t)gcol * NTOK + tok0;
  const float w0 = p.hy_conv_w[gcol], w1 = p.hy_conv_w[1536 + gcol], w2 = p.hy_conv_w[3072 + gcol], b = p.hy_conv_b[gcol];
  bf16_t* outT = (bf16_t*)(p.ws + (ORDER == 0 ? OFF_ZT : OFF_Y2T)) + (size_t)c * NTOK + tok0;
#pragma unroll
  for (int nt = 0; nt < 2; ++nt) {
    const int col = nt ? col1 : col0;
#pragma unroll
    for (int m = 0; m < 4; ++m) {
      const int t = col * 64 + 16 * m + 4 * fq, pos = t & (L - 1);
      const uint2 uu = *(const uint2*)(sU + col * 64 + (((2 * m + (fq >> 1)) ^ (col & 7)) * 8) + 4 * (fq & 1));
      const uint2 gv = *(const uint2*)(graw + t);
      float x[6];
      x[0] = pos == 0 ? 0.f : bf2f(graw[t - 1]);
      x[1] = bflo(gv.x); x[2] = bfhi(gv.x); x[3] = bflo(gv.y); x[4] = bfhi(gv.y);
      x[5] = (pos + 4 == L) ? 0.f : bf2f(graw[t + 4]);
      const float u4[4] = {bflo(uu.x), bfhi(uu.x), bflo(uu.y), bfhi(uu.y)};
      float o[4];
#pragma unroll
      for (int j = 0; j < 4; ++j) {
        const float gate = w0 * x[j] + w1 * x[j + 1] + w2 * x[j + 2] + b;
        o[j] = gate * (acc[m][nt][j] + skip * u4[j]);
      }
      *(uint2*)(outT + t) = make_uint2(pack2(o[0], o[1]), pack2(o[2], o[3]));
    }
  }
}

__device__ __forceinline__ void rope32(float* y  , int pos) {
  const float prow = (float)(pos >> 6), pcol = (float)(pos & 63);
  const float fr[8] = {1.f, 0.31622776601683794f, 0.1f, 0.031622776601683794f, 0.01f, 0.0031622776601683794f, 0.001f, 0.00031622776601683794f};
#pragma unroll
  for (int i = 0; i < 8; ++i) {
    const float tr = prow * fr[i] * 0.15915494309189535f, tc = pcol * fr[i] * 0.15915494309189535f;
    const float sr = sin_turns(tr), cr = cos_turns(tr), sc = sin_turns(tc), cc = cos_turns(tc);
    const float a = y[i], b = y[8 + i], c2 = y[16 + i], d2 = y[24 + i];
    y[i] = a * cr - b * sr; y[8 + i] = b * cr + a * sr;
    y[16 + i] = c2 * cc - d2 * sc; y[24 + i] = d2 * cc + c2 * sc;
  }
}
__device__ __forceinline__ void unpack8(const uint4& v, float* x) {
  x[0] = bflo(v.x); x[1] = bfhi(v.x); x[2] = bflo(v.y); x[3] = bfhi(v.y);
  x[4] = bflo(v.z); x[5] = bfhi(v.z); x[6] = bflo(v.w); x[7] = bfhi(v.w);
}
__device__ __forceinline__ float sumsq8(const uint4& v) {
  float x[8];
  unpack8(v, x);
  return x[0] * x[0] + x[1] * x[1] + x[2] * x[2] + x[3] * x[3] + x[4] * x[4] + x[5] * x[5] + x[6] * x[6] + x[7] * x[7];
}
__device__ __forceinline__ uint4 scale8(const uint4& v, float r, const float* __restrict__ g) {
  float x[8];
  unpack8(v, x);
  const float4 g0 = *(const float4*)g, g1 = *(const float4*)(g + 4);
  return make_uint4(pack2(x[0] * r * g0.x, x[1] * r * g0.y), pack2(x[2] * r * g0.z, x[3] * r * g0.w),
                    pack2(x[4] * r * g1.x, x[5] * r * g1.y), pack2(x[6] * r * g1.z, x[7] * r * g1.w));
}
__device__ __forceinline__ void qk_item(const Params& p, int item) {
  const int tid = ltid();
  if (item < 512) {
    const int idx = item * 256 + tid, row = idx >> 3, h = idx & 7;
    const bf16_t* src = (const bf16_t*)(p.ws + OFF_QRAW) + (size_t)row * 768 + h * 96;
    bf16_t* dst = (bf16_t*)(p.ws + OFF_Q) + (size_t)row * 768 + h * 96;
    uint4 raw[12];
#pragma unroll
    for (int i = 0; i < 12; ++i) raw[i] = *(const uint4*)(src + 8 * i);
    float ss = 0.f;
#pragma unroll
    for (int i = 0; i < 12; ++i) ss += sumsq8(raw[i]);
    const float r = rsqrtf(ss * (1.f / 96.f) + 1e-6f);
    const float qs = 0.10206207261596575f * 1.4426950408889634f;
#pragma unroll
    for (int i = 0; i < 8; ++i) *(uint4*)(dst + 8 * i) = scale8(raw[i], r * qs, p.g_q + 8 * i);
    float y[32];
#pragma unroll
    for (int i = 0; i < 4; ++i) unpack8(raw[8 + i], y + 8 * i);
#pragma unroll
    for (int i = 0; i < 32; ++i) y[i] = y[i] * r * p.g_q[64 + i];
    if (row >= NCTX) rope32(y, (row - NCTX) & 4095);
#pragma unroll
    for (int i = 0; i < 4; ++i)
      *(uint4*)(dst + 64 + 8 * i) = make_uint4(pack2(y[8 * i] * qs, y[8 * i + 1] * qs), pack2(y[8 * i + 2] * qs, y[8 * i + 3] * qs),
                                               pack2(y[8 * i + 4] * qs, y[8 * i + 5] * qs), pack2(y[8 * i + 6] * qs, y[8 * i + 7] * qs));
  } else {
    const int idx = (item - 512) * 256 + tid, row = idx >> 3, h = idx & 7;
    const bf16_t* src = (const bf16_t*)(p.ws + OFF_KRAW) + (size_t)row * 512 + h * 64;
    uint4 raw[8];
#pragma unroll
    for (int i = 0; i < 8; ++i) raw[i] = *(const uint4*)(src + 8 * i);
    const float* kp = row < NTOK ? (const float*)(p.ws + OFF_KPE) + (size_t)row * 32 : p.cache_kpe + (size_t)(row - NTOK) * 32;
    float y[32];
#pragma unroll
    for (int i = 0; i < 8; ++i) {
      const float4 v = *(const float4*)(kp + 4 * i);
      y[4 * i] = v.x; y[4 * i + 1] = v.y; y[4 * i + 2] = v.z; y[4 * i + 3] = v.w;
    }
    float ss = 0.f;
#pragma unroll
    for (int i = 0; i < 8; ++i) ss += sumsq8(raw[i]);
#pragma unroll
    for (int i = 0; i < 32; ++i) ss += y[i] * y[i];
    const float r = rsqrtf(ss * (1.f / 96.f) + 1e-6f);
#pragma unroll
    for (int i = 0; i < 32; ++i) y[i] = y[i] * r * p.g_k[64 + i];
    bf16_t* dst;
    if (row < NCTX) dst = (bf16_t*)(p.ws + OFF_KC) + ((size_t)((row >> 8) * 8 + h) * 256 + (row & 255)) * 96;
    else if (row < NTOK) {
      const int rr = row - NCTX;
      rope32(y, rr & 4095);
      dst = (bf16_t*)(p.ws + OFF_KL) + ((size_t)((rr >> 12) * 8 + h) * 4608 + (rr & 4095)) * 96;
    } else {
      const int rr = row - NTOK;
      dst = (bf16_t*)(p.ws + OFF_KL) + ((size_t)((rr >> 9) * 8 + h) * 4608 + 4096 + (rr & 511)) * 96;
    }
#pragma unroll
    for (int i = 0; i < 8; ++i) *(uint4*)(dst + 8 * i) = scale8(raw[i], r, p.g_k + 8 * i);
#pragma unroll
    for (int i = 0; i < 4; ++i)
      *(uint4*)(dst + 64 + 8 * i) = make_uint4(pack2(y[8 * i], y[8 * i + 1]), pack2(y[8 * i + 2], y[8 * i + 3]),
                                               pack2(y[8 * i + 4], y[8 * i + 5]), pack2(y[8 * i + 6], y[8 * i + 7]));
  }
}

__device__ __forceinline__ void attn_item(const Params& p, int item, char* smem) {
  const int tid = ltid(), lane = tid & 63, wid = tid >> 6, lr = lane & 31, lh = lane >> 5;
  int nkeys, h, tokbase; const bf16_t *Kp, *Vp;
  if (item < 512) {
    const int b = item >> 8, rem = item & 255; h = rem >> 5; const int qb = rem & 31;
    nkeys = 4608; tokbase = NCTX + b * 4096 + qb * 128;
    Kp = (const bf16_t*)(p.ws + OFF_KL) + (size_t)(b * 8 + h) * 4608 * 96;
    Vp = (const bf16_t*)(p.ws + OFF_VTL) + (size_t)(b * 8 + h) * 64 * 4608;
  } else {
    const int it = item - 512, b = it >> 4; h = (it & 15) >> 1; const int qb = it & 1;
    nkeys = 256; tokbase = b * 256 + qb * 128;
    Kp = (const bf16_t*)(p.ws + OFF_KC) + (size_t)(b * 8 + h) * 256 * 96;
    Vp = (const bf16_t*)(p.ws + OFF_VTC) + (size_t)(b * 8 + h) * 64 * 256;
  }
  bf16_t* sK = (bf16_t*)smem;
  bf16_t* sV = sK + 64 * 104;
  const int token = tokbase + 32 * wid + lr;
  bf16x8 qf[6];
  {
    const bf16_t* qsrc = (const bf16_t*)(p.ws + OFF_QRAW) + (size_t)token * 768 + h * 96 + 8 * lh;
    uint4 qr[6];
#pragma unroll
    for (int ks = 0; ks < 6; ++ks) qr[ks] = *(const uint4*)(qsrc + 16 * ks);
    float ss = 0.f;
#pragma unroll
    for (int ks = 0; ks < 6; ++ks) ss += sumsq8(qr[ks]);
    ss += __shfl_xor(ss, 32);
    const float r = rsqrtf(ss * (1.f / 96.f) + 1e-6f);
    const float qs = 0.10206207261596575f * 1.4426950408889634f;
    const bool lat = item < 512;
    const int pos = (token - NCTX) & 4095;
    const float prow = (float)(pos >> 6), pcol = (float)(pos & 63);
    const float frq[8] = {1.f, 0.31622776601683794f, 0.1f, 0.031622776601683794f, 0.01f, 0.0031622776601683794f, 0.001f, 0.00031622776601683794f};
#pragma unroll
    for (int ks = 0; ks < 6; ++ks) {
      float y[8];
      unpack8(qr[ks], y);
      const float* gq = p.g_q + 16 * ks + 8 * lh;
#pragma unroll
      for (int e = 0; e < 8; ++e) y[e] = y[e] * r * gq[e];
      if (ks >= 4) {
#pragma unroll
        for (int e = 0; e < 8; ++e) {
          const float other = __shfl_xor(y[e], 32);
          const float t = (ks == 4 ? prow : pcol) * frq[e] * 0.15915494309189535f;
          const float sn = sin_turns(t), cs = cos_turns(t);
          const float rot = y[e] * cs + (lh ? other : -other) * sn;
          y[e] = lat ? rot : y[e];
        }
      }
      union { unsigned u[4]; bf16x8 v; } pk;
      pk.u[0] = pack2(y[0] * qs, y[1] * qs); pk.u[1] = pack2(y[2] * qs, y[3] * qs); pk.u[2] = pack2(y[4] * qs, y[5] * qs); pk.u[3] = pack2(y[6] * qs, y[7] * qs);
      qf[ks] = pk.v;
    }
  }
  f32x16 oacc[2];
#pragma unroll
  for (int j = 0; j < 16; ++j) { oacc[0][j] = 0.f; oacc[1][j] = 0.f; }
  float mrun = -1e30f, lsum = 0.f;
  const int kk0 = tid / 12, kc0 = tid % 12, kk1 = (tid + 256) / 12, kc1 = (tid + 256) % 12, kk2 = (tid + 512) / 12, kc2 = (tid + 512) % 12;
  const int vd0 = tid >> 3, vc0 = tid & 7, vd1 = vd0 + 32;
  const bf16_t* gk0 = Kp + (size_t)kk0 * 96 + kc0 * 8;
  const bf16_t* gk1 = Kp + (size_t)kk1 * 96 + kc1 * 8;
  const bf16_t* gk2 = Kp + (size_t)kk2 * 96 + kc2 * 8;
  const bf16_t* gv0 = Vp + (size_t)vd0 * nkeys + vc0 * 8;
  const bf16_t* gv1 = Vp + (size_t)vd1 * nkeys + vc0 * 8;
  uint4 rk0 = *(const uint4*)gk0, rk1 = *(const uint4*)gk1, rk2 = *(const uint4*)gk2;
  uint4 rv0 = *(const uint4*)gv0, rv1 = *(const uint4*)gv1;
  const int nt = nkeys >> 6;
  for (int kt = 0; kt < nt; ++kt) {
    __syncthreads();
    *(uint4*)(sK + kk0 * 104 + kc0 * 8) = rk0; *(uint4*)(sK + kk1 * 104 + kc1 * 8) = rk1; *(uint4*)(sK + kk2 * 104 + kc2 * 8) = rk2;
    *(uint4*)(sV + vd0 * 72 + vc0 * 8) = rv0; *(uint4*)(sV + vd1 * 72 + vc0 * 8) = rv1;
    __syncthreads();
    if (kt + 1 < nt) {
      gk0 += 64 * 96; gk1 += 64 * 96; gk2 += 64 * 96; gv0 += 64; gv1 += 64;
      rk0 = *(const uint4*)gk0; rk1 = *(const uint4*)gk1; rk2 = *(const uint4*)gk2;
      rv0 = *(const uint4*)gv0; rv1 = *(const uint4*)gv1;
    }
    __builtin_amdgcn_sched_barrier(0);
    f32x16 sacc[2];
#pragma unroll
    for (int kb = 0; kb < 2; ++kb) {
#pragma unroll
      for (int j = 0; j < 16; ++j) sacc[kb][j] = 0.f;
#pragma unroll
      for (int ks = 0; ks < 6; ++ks) {
        const bf16x8 a = *(const bf16x8*)(sK + (32 * kb + lr) * 104 + 16 * ks + 8 * lh);
        sacc[kb] = __builtin_amdgcn_mfma_f32_32x32x16_bf16(a, qf[ks], sacc[kb], 0, 0, 0);
      }
    }
    float mx = sacc[0][0];
#pragma unroll
    for (int j = 1; j < 16; ++j) mx = fmaxf(mx, sacc[0][j]);
#pragma unroll
    for (int j = 0; j < 16; ++j) mx = fmaxf(mx, sacc[1][j]);
    mx = fmaxf(mx, __shfl_xor(mx, 32));
    const float mnew = fmaxf(mrun, mx);
    const float alpha = __builtin_amdgcn_exp2f(mrun - mnew);
    mrun = mnew;
    float ps = 0.f;
#pragma unroll
    for (int kb = 0; kb < 2; ++kb)
#pragma unroll
      for (int j = 0; j < 16; ++j) { const float e = __builtin_amdgcn_exp2f(sacc[kb][j] - mnew); sacc[kb][j] = e; ps += e; }
    lsum = lsum * alpha + ps;
    if (__ballot(alpha != 1.f) != 0ull) {
#pragma unroll
      for (int j = 0; j < 16; ++j) { oacc[0][j] *= alpha; oacc[1][j] *= alpha; }
    }
#pragma unroll
    for (int s = 0; s < 4; ++s) {
      const int kb = s >> 1, jb = 8 * (s & 1);
      union { unsigned u[4]; bf16x8 v; } pf;
      pf.u[0] = pack2(sacc[kb][jb + 0], sacc[kb][jb + 1]); pf.u[1] = pack2(sacc[kb][jb + 2], sacc[kb][jb + 3]);
      pf.u[2] = pack2(sacc[kb][jb + 4], sacc[kb][jb + 5]); pf.u[3] = pack2(sacc[kb][jb + 6], sacc[kb][jb + 7]);
#pragma unroll
      for (int mt = 0; mt < 2; ++mt) {
        const bf16_t* vp = sV + (32 * mt + lr) * 72 + 16 * s + 4 * lh;
        union { uint2 d[2]; bf16x8 v; } av;
        av.d[0] = *(const uint2*)vp;
        av.d[1] = *(const uint2*)(vp + 8);
        oacc[mt] = __builtin_amdgcn_mfma_f32_32x32x16_bf16(av.v, pf.v, oacc[mt], 0, 0, 0);
      }
    }
  }
  lsum += __shfl_xor(lsum, 32);
  const float inv = 1.f / lsum;
  bf16_t* dst = (bf16_t*)(p.ws + OFF_ATTN) + (size_t)token * 512 + h * 64;
#pragma unroll
  for (int mt = 0; mt < 2; ++mt)
#pragma unroll
    for (int jg = 0; jg < 4; ++jg) {
      const int dv0 = 32 * mt + 8 * jg + 4 * lh;
      *(uint2*)(dst + dv0) = make_uint2(pack2(oacc[mt][4 * jg] * inv, oacc[mt][4 * jg + 1] * inv),
                                        pack2(oacc[mt][4 * jg + 2] * inv, oacc[mt][4 * jg + 3] * inv));
    }
}

__device__ __forceinline__ void merge_item(const Params& p, int item, char* smem) {
  const int tid = ltid(), lane = tid & 63, wid = tid >> 6, t0 = item * 32;
  bf16_t* mix = (bf16_t*)(p.ws + OFF_H);
  const bf16_t* attn = (const bf16_t*)(p.ws + OFF_ATTN);
  for (int tt = 0; tt < 8; ++tt) {
    const int token = t0 + wid * 8 + tt;
    float x[8];
    unpack8(*(const uint4*)(attn + (size_t)token * 512 + lane * 8), x);
    float ss = 0.f;
#pragma unroll
    for (int i = 0; i < 8; ++i) ss += x[i] * x[i];
    ss = wave_sum(ss);
    const float r = rsqrtf(ss * (1.f / 512.f) + 1e-6f);
    const float4 g0 = *(const float4*)(p.g_out_att + lane * 8), g1 = *(const float4*)(p.g_out_att + lane * 8 + 4);
    *(uint4*)(mix + (size_t)token * D + lane * 8) =
        make_uint4(pack2(x[0] * r * g0.x, x[1] * r * g0.y), pack2(x[2] * r * g0.z, x[3] * r * g0.w),
                   pack2(x[4] * r * g1.x, x[5] * r * g1.y), pack2(x[6] * r * g1.z, x[7] * r * g1.w));
  }
  bf16_t* sT = (bf16_t*)smem;
  const bf16_t* y2T = (const bf16_t*)(p.ws + OFF_Y2T);
  __syncthreads();
  for (int ch = tid; ch < 2048; ch += 256) {
    const int c = ch >> 2, q4 = ch & 3;
    const uint4 v = *(const uint4*)(y2T + (size_t)c * NTOK + t0 + q4 * 8);
    bf16_t* d = sT + (q4 * 8) * 520 + c;
    d[0 * 520] = (bf16_t)(v.x & 0xffff); d[1 * 520] = (bf16_t)(v.x >> 16);
    d[2 * 520] = (bf16_t)(v.y & 0xffff); d[3 * 520] = (bf16_t)(v.y >> 16);
    d[4 * 520] = (bf16_t)(v.z & 0xffff); d[5 * 520] = (bf16_t)(v.z >> 16);
    d[6 * 520] = (bf16_t)(v.w & 0xffff); d[7 * 520] = (bf16_t)(v.w >> 16);
  }
  __syncthreads();
  {
    const int tt = tid >> 3, part = tid & 7;
    uint4 v[8];
    float ss = 0.f;
#pragma unroll
    for (int i = 0; i < 8; ++i) {
      v[i] = *(const uint4*)(sT + tt * 520 + part * 64 + 8 * i);
      float x[8];
      unpack8(v[i], x);
#pragma unroll
      for (int e = 0; e < 8; ++e) ss += x[e] * x[e];
    }
    ss += __shfl_xor(ss, 1); ss += __shfl_xor(ss, 2); ss += __shfl_xor(ss, 4);
    const float r = rsqrtf(ss * (1.f / 512.f) + 1e-6f);
#pragma unroll
    for (int i = 0; i < 8; ++i) {
      float x[8];
      unpack8(v[i], x);
      const int c0 = part * 64 + 8 * i;
      const float4 g0 = *(const float4*)(p.g_out_hy + c0), g1 = *(const float4*)(p.g_out_hy + c0 + 4);
      *(uint4*)(mix + (size_t)(t0 + tt) * D + 512 + c0) =
          make_uint4(pack2(x[0] * r * g0.x, x[1] * r * g0.y), pack2(x[2] * r * g0.z, x[3] * r * g0.w),
                     pack2(x[4] * r * g1.x, x[5] * r * g1.y), pack2(x[6] * r * g1.z, x[7] * r * g1.w));
    }
  }
}

__device__ __forceinline__ void actfix_item(const Params& p, int item) {
  const int idx = item * 256 + ltid();
  if (idx >= 512 * 352) return;
  const int j = (idx % 352) * 8, rowi = idx / 352, wt = rowi >> 1, which = rowi & 1;
  const int t = 64 * wt + 63 * which, L = t < NCTX ? SEQC : SEQL, pos = t & (L - 1);
  const bf16_t* edge = (const bf16_t*)(p.ws + OFF_EDGE);
  bf16_t* act = (bf16_t*)(p.ws + OFF_U);
  const bf16_t *pr, *cu, *nx;
  bool zp = false, zn = false;
  if (which == 0) { zp = pos == 0; pr = edge + (size_t)((zp ? wt : wt - 1) * 4 + 3) * 5632; cu = edge + (size_t)(wt * 4 + 0) * 5632; nx = edge + (size_t)(wt * 4 + 1) * 5632; }
  else { zn = pos == L - 1; pr = edge + (size_t)(wt * 4 + 2) * 5632; cu = edge + (size_t)(wt * 4 + 3) * 5632; nx = edge + (size_t)((zn ? wt : wt + 1) * 4 + 0) * 5632; }
  float pa[8], pg[8], ca[8], cgv[8], na[8], ng[8];
  unpack8(*(const uint4*)(pr + j), pa); unpack8(*(const uint4*)(pr + 2816 + j), pg);
  unpack8(*(const uint4*)(cu + j), ca); unpack8(*(const uint4*)(cu + 2816 + j), cgv);
  unpack8(*(const uint4*)(nx + j), na); unpack8(*(const uint4*)(nx + 2816 + j), ng);
  float o[8];
#pragma unroll
  for (int e = 0; e < 8; ++e) {
    const float pae = zp ? 0.f : pa[e], pge = zp ? 0.f : pg[e], nae = zn ? 0.f : na[e], nge = zn ? 0.f : ng[e];
    const float a = p.ffn_conv_w[j + e] * pae + p.ffn_conv_w[5632 + j + e] * ca[e] + p.ffn_conv_w[11264 + j + e] * nae + p.ffn_conv_b[j + e];
    const float g = p.ffn_conv_w[2816 + j + e] * pge + p.ffn_conv_w[5632 + 2816 + j + e] * cgv[e] + p.ffn_conv_w[11264 + 2816 + j + e] * nge + p.ffn_conv_b[2816 + j + e];
    o[e] = a * __builtin_amdgcn_rcpf(1.f + __expf(-a)) * g;
  }
  *(uint4*)(act + (size_t)t * 2816 + j) = make_uint4(pack2(o[0], o[1]), pack2(o[2], o[3]), pack2(o[4], o[5]), pack2(o[6], o[7]));
}

#define XB_TMO      128
#define XB_XCNT(j)  (256  + 64 * (j))
#define XB_XSUB(j)  (1280 + 64 * (j))
#define XB_XGEN(j)  (2304 + 64 * (j))
#define XB_TOP      3328
#define XB_TOPGEN   3392
#define XCD_BAR_WORDS 3456
#define XB_SPIN_CAP (1u << 20)
#define LAS __attribute__((address_space(3)))
__device__ __forceinline__ unsigned xb_ld(unsigned* p) { return __hip_atomic_load(p, __ATOMIC_RELAXED, __HIP_MEMORY_SCOPE_AGENT); }
__device__ __forceinline__ unsigned xb_add(unsigned* p, unsigned v) { return __hip_atomic_fetch_add(p, v, __ATOMIC_RELAXED, __HIP_MEMORY_SCOPE_AGENT); }
__device__ __forceinline__ unsigned xb_xcc_id() { return (unsigned)__builtin_amdgcn_s_getreg((3 << 11) | 20) & 0xFu; }
#define XB_SPIN(cond, bar) do { unsigned _sp = 0; while (cond) { __builtin_amdgcn_s_sleep(1); \
    if ((++_sp & 255u) == 0u) { if (xb_ld(&(bar)[XB_TMO])) break; if (_sp > XB_SPIN_CAP) { atomicAdd(&(bar)[XB_TMO], 1u); break; } } } } while (0)
struct XcdBarrier { unsigned* bar; unsigned x; volatile LAS unsigned* st; };
__device__ __forceinline__ XcdBarrier xcd_barrier_post(unsigned* bar, volatile LAS unsigned* st) {
  XcdBarrier b; b.bar = bar; b.x = xb_xcc_id(); b.st = st;
  if (threadIdx.x == 0) (void)xb_add(&bar[XB_XCNT(b.x)], 1u);
  return b;
}
__device__ __forceinline__ void xcd_barrier_complete(unsigned* bar, unsigned x, unsigned& nloc, unsigned& nx) {
  const unsigned G = gridDim.x * gridDim.y * gridDim.z;
  unsigned sum, cnt, mine, sp = 0u;
  for (;;) {
    sum = 0u; cnt = 0u; mine = 0u;
#pragma unroll
    for (unsigned j = 0; j < 16; ++j) { const unsigned c = xb_ld(&bar[XB_XCNT(j)]); sum += c; cnt += (c > 0u) ? 1u : 0u; mine = (j == x) ? c : mine; }
    if (sum == G) break;
    __builtin_amdgcn_s_sleep(1);
    if ((++sp & 255u) == 0u) { if (xb_ld(&bar[XB_TMO])) break; if (sp > XB_SPIN_CAP) { atomicAdd(&bar[XB_TMO], 1u); break; } }
  }
  nloc = mine > 0u ? mine : 1u; nx = cnt > 0u ? cnt : 1u;
}
__device__ __forceinline__ void xcd_barrier(const XcdBarrier& b) {
  asm volatile("s_waitcnt vmcnt(0)" ::: "memory");
  __syncthreads();
  if (threadIdx.x == 0) {
    unsigned* bar = b.bar;
    __builtin_amdgcn_s_waitcnt(0);
    unsigned nloc = b.st[0], nx = b.st[1];
    if (nloc == 0u) { xcd_barrier_complete(bar, b.x, nloc, nx); b.st[0] = nloc; b.st[1] = nx; }
    const unsigned old = xb_add(&bar[XB_XSUB(b.x)], 1u);
    const unsigned gen = old / nloc;
    if (old + 1u == (gen + 1u) * nloc) {
      __builtin_amdgcn_fence(__ATOMIC_RELEASE, "agent");
      asm volatile("s_waitcnt vmcnt(0)" ::: "memory");
      const unsigned og = xb_add(&bar[XB_TOP], 1u);
      const unsigned tg = og / nx;
      if (og + 1u == (tg + 1u) * nx) xb_add(&bar[XB_TOPGEN], 1u);
      else XB_SPIN(xb_ld(&bar[XB_TOPGEN]) == tg, bar);
      __builtin_amdgcn_fence(__ATOMIC_ACQUIRE, "agent");
      xb_add(&bar[XB_XGEN(b.x)], 1u);
      asm volatile("s_waitcnt vmcnt(0)" ::: "memory");
    } else {
      XB_SPIN(xb_ld(&bar[XB_XGEN(b.x)]) == gen, bar);
      __builtin_amdgcn_fence(__ATOMIC_ACQUIRE, "agent");
      asm volatile("s_waitcnt vmcnt(0)" ::: "memory");
    }
  }
  __syncthreads();
}
constexpr size_t OFF_BAR = 25 * MiB - 16384;
static_assert(OFF_MOD + 3 * 6144 * 4 <= OFF_BAR, "bar");

template <int ph>
__device__ __forceinline__ void run_phase(const Params& p, char* smem) {
  const int bid = blockIdx.x, G = gridDim.x;
  char* ws = p.ws;
  if constexpr (ph == 0) {
    for (int it = bid; it < 544 + 96 + 32 + 3080; it += G) {
      if (it < 544) filter_item(p, it, smem);
      else if (it < 640) mod_item(p, it - 544, smem);
      else if (it < 672) cache_item(p, it - 640);
      else {
        int t = it - 672;
        if (t < 576) transpose_item(p.w_in, 1024, DIN, (bf16_t*)(ws + OFF_WIN), t, 36, smem);
        else if ((t -= 576) < 72) transpose_item(p.w_uq, 384, 768, (bf16_t*)(ws + OFF_WUQ), t, 12, smem);
        else if ((t -= 72) < 64) transpose_item(p.w_ukv, 256, 1024, (bf16_t*)(ws + OFF_WUKV), t, 16, smem);
        else if ((t -= 64) < 256) transpose_item(p.w_out, 1024, 1024, (bf16_t*)(ws + OFF_WOUT), t, 16, smem);
        else if ((t -= 256) < 1408) transpose_item(p.w_up, 1024, 5632, (bf16_t*)(ws + OFF_WUP), t, 88, smem, true);
        else { t -= 1408; transpose_item(p.w_down, 2816, 1024, (bf16_t*)(ws + OFF_WDOWN), t, 16, smem); }
      }
    }
  } else if constexpr (ph == 1) {
    rmsmod_phase<0>(p);
  } else if constexpr (ph == 2) {
    EpiIn epi{(float*)(ws + OFF_PROJ), (bf16_t*)(ws + OFF_HYT)};
    EpiProj epr{(float*)(ws + OFF_PROJ)};
    for (int t = bid; t < 128 * 18; t += G) {
      const int nt = t % 18;
      if (nt < 5) gemm_tile<true>((const bf16_t*)(ws + OFF_H), 1024, (const bf16_t*)(ws + OFF_WIN), 1024, 1024, (t / 18) * 128, nt * 128, smem, epr);
      else gemm_tile<false>((const bf16_t*)(ws + OFF_H), 1024, (const bf16_t*)(ws + OFF_WIN), 1024, 1024, (t / 18) * 128, nt * 128, smem, epi);
    }
  } else if constexpr (ph == 3) {
    for (int it = bid; it < 512; it += G) hyena_item<0>(p, 1, it, smem);
    for (int it = bid; it < 512; it += G) hyena_item<0>(p, 0, it, smem);
    for (int it = G - 1 - bid; it < 512; it += G) token_item(p, it);
  } else if constexpr (ph == 4) {
    EpiQ eq{(bf16_t*)(ws + OFF_QRAW)};
    EpiKV ekv{(bf16_t*)(ws + OFF_KRAW), (bf16_t*)(ws + OFF_VTC), (bf16_t*)(ws + OFF_VTL)};
    for (int it = bid; it < 512; it += G) hyena_item<1>(p, 1, it, smem);
    for (int t = bid; t < 768; t += G) gemm_tile<true>((const bf16_t*)(ws + OFF_QA), 384, (const bf16_t*)(ws + OFF_WUQ), 384, 384, (t / 6) * 128, (t % 6) * 128, smem, eq);
    for (int t = bid; t < 1088; t += G) gemm_tile<false>((const bf16_t*)(ws + OFF_CKVN), 256, (const bf16_t*)(ws + OFF_WUKV), 256, 256, (t / 8) * 128, (t % 8) * 128, smem, ekv);
    for (int it = bid; it < 512; it += G) hyena_item<1>(p, 0, it, smem);
  } else if constexpr (ph == 5) {
    for (int it = bid; it < 544; it += G) qk_item(p, 512 + it);
  } else if constexpr (ph == 6) {
    for (int it = bid; it < 1024; it += G) attn_item(p, it, smem);
  } else if constexpr (ph == 7) {
    for (int it = bid; it < 512; it += G) merge_item(p, it, smem);
  } else if constexpr (ph == 8) {
    EpiOut epi{&p};
    if (G == 512) {
      const int x = bid & 7, j = bid >> 3;
      for (int r = 0; r < 2; ++r)
        gemm_tile<true>((const bf16_t*)(ws + OFF_H), 1024, (const bf16_t*)(ws + OFF_WOUT), 1024, 1024, (x * 16 + r * 8 + (j >> 3)) * 128, (j & 7) * 128, smem, epi);
    } else {
      for (int t = bid; t < 128 * 8; t += G)
        gemm_tile<true>((const bf16_t*)(ws + OFF_H), 1024, (const bf16_t*)(ws + OFF_WOUT), 1024, 1024, (t / 8) * 128, (t % 8) * 128, smem, epi);
    }
  } else if constexpr (ph == 9) {
    rmsmod_phase<1>(p);
  } else if constexpr (ph == 10) {
    for (int t = bid; t < 128 * 44; t += G) gemm_up_act_tile(p, (t / 44) * 128, (t % 44) * 128, smem);
  } else if constexpr (ph == 11) {
    for (int it = bid; it < 704; it += G) actfix_item(p, it);
  } else if constexpr (ph == 12) {
    EpiY epi{&p, 0};
    if (G == 512) {
      const int x = bid & 7, j = bid >> 3;
      for (int r = 0; r < 2; ++r)
        gemm_tile<true>((const bf16_t*)(ws + OFF_U), 2816, (const bf16_t*)(ws + OFF_WDOWN), 2816, 2816, (x * 16 + r * 8 + (j >> 3)) * 128, (j & 7) * 128, smem, epi);
    } else {
      for (int t = bid; t < 128 * 8; t += G)
        gemm_tile<true>((const bf16_t*)(ws + OFF_U), 2816, (const bf16_t*)(ws + OFF_WDOWN), 2816, 2816, (t / 8) * 128, (t % 8) * 128, smem, epi);
    }
  }
}

#if ONE_LAUNCH
template <int PH>
__device__ __forceinline__ void run_all(const Params& p, char* smem, cg::grid_group& grid, const XcdBarrier& xb) {
  run_phase<PH>(p, smem);
  if constexpr (((DBL_MASK >> PH) & 1) != 0) { xcd_barrier(xb); run_phase<PH>(p, smem); }
  if constexpr (PH < 12) {
    xcd_barrier(xb);
    run_all<PH + 1>(p, smem, grid, xb);
  }
}
constexpr int DYN_LDS = 65536 + 64;
__global__ void __launch_bounds__(256, 2) mega_kernel(Params p) {
  extern __shared__ __attribute__((aligned(16))) char smem[];
  uint4* xb_words = (uint4*)(smem + 65536);
  cg::grid_group grid = cg::this_grid();
  if (threadIdx.x == 0) *xb_words = make_uint4(0u, 0u, 0u, 0u);
  __syncthreads();
  XcdBarrier xb = xcd_barrier_post((unsigned*)(p.ws + OFF_BAR), (volatile LAS unsigned*)xb_words);
  if (p.ws == nullptr) grid.sync();
  run_all<0>(p, smem, grid, xb);
}
#else
template <int PH>
__global__ void __launch_bounds__(256, 2) phase_kernel(Params p) {
  __shared__ __attribute__((aligned(16))) char smem[SMEM_BYTES];
  run_phase<PH>(p, smem);
}
#ifndef DBG_STOP
#define DBG_STOP 15
#endif
__global__ void dump_kernel(Params p, size_t off, int count) {
  const bf16_t* src = (const bf16_t*)(p.ws + off);
  const bf16_t* src2 = (const bf16_t*)(p.ws + DBG_OFF2);
  for (int i = blockIdx.x * 256 + threadIdx.x; i < 16777216; i += gridDim.x * 256)
    p.out[i] = i < DBG_CNT ? bf2f(src[i]) : (i - DBG_CNT < DBG_CNT2 ? bf2f(src2[i - DBG_CNT]) : 0.f);
}
template <int PH>
static void launch_all(const Params& p, hipStream_t stream) {
  phase_kernel<PH><<<512, 256, 0, stream>>>(p);
  if constexpr (PH < 12) launch_all<PH + 1>(p, stream);
}
#endif

extern "C" void kernel_launch(void* const* d_in, const int* in_sizes, int n_in, void* d_out, int out_size, void* d_ws,
                              size_t ws_size, hipStream_t stream) {
  Params p{};
  const float** pp = (const float**)&p;
  for (int i = 0; i < 34; ++i) pp[i] = (const float*)d_in[i];
  p.out = (float*)d_out;
  p.ws = (char*)d_ws;
#if ONE_LAUNCH
  (void)hipMemsetAsync((char*)d_ws + OFF_BAR, 0, XCD_BAR_WORDS * 4, stream);
  static int grid_blocks = 0;
  if (!grid_blocks) {
    int dev = 0, cus = 0, per_cu = 0;
    hipGetDevice(&dev);
    hipDeviceGetAttribute(&cus, hipDeviceAttributeMultiprocessorCount, dev);
    (void)hipFuncSetAttribute((const void*)mega_kernel, hipFuncAttributeMaxDynamicSharedMemorySize, DYN_LDS);
    (void)hipOccupancyMaxActiveBlocksPerMultiprocessor(&per_cu, mega_kernel, 256, DYN_LDS);
    if (per_cu > 2) per_cu = 2;
    grid_blocks = cus * per_cu;
  }
  void* args[] = {&p};
  hipError_t e = hipLaunchCooperativeKernel((void*)mega_kernel, dim3(grid_blocks), dim3(256), args, DYN_LDS, stream);
  if (e != hipSuccess) fprintf(stderr, "cooperative launch failed: %s (grid %d)\n", hipGetErrorString(e), grid_blocks);
#else
  launch_all<0>(p, stream);
#if DBG_STOP < 15
  dump_kernel<<<1024, 256, 0, stream>>>(p, DBG_OFF, DBG_CNT);
#endif
#endif
}
```

```cpp
#include <hip/hip_runtime.h>
#include <hip/hip_cooperative_groups.h>
#include <cstdio>
namespace cg = cooperative_groups;

#define DBG_STOP 15
#define DBG_NOHY 0
#ifndef DBL_MASK
#define DBL_MASK 0
#endif
#define DBG_OFF OFF_QRAW
#define DBG_OFF2 OFF_KRAW
#define DBG_CNT 12582912
#define DBG_CNT2 0
#ifndef ONE_LAUNCH
#define ONE_LAUNCH 1
#endif

typedef unsigned short bf16_t;
typedef short bf16x8 __attribute__((ext_vector_type(8)));
typedef float f32x4 __attribute__((ext_vector_type(4)));
typedef float f32x16 __attribute__((ext_vector_type(16)));

constexpr int D = 1024, NTOK = 16384, NCTX = 8192, SEQC = 256, SEQL = 4096;
constexpr int DIN = 2208, DINP = 2304, QL = 384, KVL = 256, DFF = 2816;
constexpr int NROWKV = 17408;
constexpr size_t MiB = 1048576;

constexpr size_t OFF_WIN = 0;
constexpr size_t OFF_WUQ = OFF_WIN + (size_t)DINP * 1024 * 2;
constexpr size_t OFF_WUKV = OFF_WUQ + (size_t)768 * 384 * 2;
constexpr size_t OFF_WOUT = OFF_WUKV + (size_t)1024 * 256 * 2;
constexpr size_t OFF_WUP = OFF_WOUT + (size_t)1024 * 1024 * 2;
constexpr size_t OFF_WDOWN = OFF_WUP + (size_t)5632 * 1024 * 2;
constexpr size_t OFF_MOD = OFF_WDOWN + (size_t)1024 * 2816 * 2;
static_assert(OFF_MOD + 3 * 6144 * 4 <= 25 * MiB, "A region");
constexpr size_t OFF_RLAT = 25 * MiB;
constexpr size_t OFF_RCTX = 41 * MiB;
constexpr size_t OFF_H = 42 * MiB;
constexpr size_t OFF_ZT = 42 * MiB;
constexpr size_t OFF_QA = 58 * MiB;
constexpr size_t OFF_KPE = 70 * MiB;
constexpr size_t OFF_PROJ = 74 * MiB;
constexpr size_t OFF_QRAW = 74 * MiB;
constexpr size_t OFF_Y2T = 98 * MiB;
constexpr size_t OFF_ATTN = 116 * MiB;
constexpr size_t OFF_U = 74 * MiB;
constexpr size_t OFF_HYT = 116 * MiB;
constexpr size_t OFF_Q = 116 * MiB;
constexpr size_t OFF_KC = 140 * MiB;
constexpr size_t OFF_KL = 152 * MiB;
constexpr size_t OFF_CKVN = 164 * MiB;
constexpr size_t OFF_KRAW = 173 * MiB;
constexpr size_t OFF_VTC = 190 * MiB;
constexpr size_t OFF_VTL = 198 * MiB;
constexpr size_t OFF_ACT = 162 * MiB;

constexpr int OUT_YS = 0;
constexpr int OUT_CKV = 16777216;
constexpr int OUT_KPE = 16777216 + 2097152;

constexpr int SMEM_BYTES = 51200;

struct Params {
  const float *x_prompt, *x_sample, *cache_ckv, *cache_kpe, *c, *c_ctx, *w_ada, *b_ada, *g_mix, *w_in, *g_qa, *w_uq,
      *g_kva, *w_ukv, *g_q, *g_k, *hy_conv_w, *hy_conv_b, *filt_w1, *filt_b1, *filt_freq1, *filt_w2, *filt_b2,
      *filt_freq2, *filt_w3, *filt_bias, *g_out_att, *g_out_hy, *w_out, *g_ffn, *w_up, *ffn_conv_w, *ffn_conv_b, *w_down;
  float* out;
  char* ws;
};

typedef __bf16 bf16x2_t __attribute__((ext_vector_type(2)));
__device__ __forceinline__ unsigned pack2(float lo, float hi) {
  bf16x2_t v;
  v[0] = (__bf16)lo;
  v[1] = (__bf16)hi;
  return __builtin_bit_cast(unsigned, v);
}
__device__ __forceinline__ float bflo(unsigned u) { return __uint_as_float(u << 16); }
__device__ __forceinline__ float bfhi(unsigned u) { return __uint_as_float(u & 0xffff0000u); }
__device__ __forceinline__ float bf2f(bf16_t h) { return __uint_as_float(((unsigned)h) << 16); }
__device__ __forceinline__ bf16_t f2bf(float f) { return (bf16_t)(pack2(f, 0.f) & 0xffffu); }
__device__ __forceinline__ float wave_sum(float v) {
#pragma unroll
  for (int o = 32; o >= 1; o >>= 1) v += __shfl_xor(v, o);
  return v;
}
__device__ __forceinline__ int ltid() { int t = threadIdx.x; asm volatile("" : "+v"(t)); return t; }
__device__ __forceinline__ float sin_turns(float t) { t -= floorf(t); return __builtin_amdgcn_sinf(t); }
__device__ __forceinline__ float cos_turns(float t) { t -= floorf(t); return __builtin_amdgcn_cosf(t); }
__device__ __forceinline__ float sin_rad(float x) { return sin_turns(x * 0.15915494309189535f); }
__device__ __forceinline__ const float* xrow(const Params& p, int row) {
  return row < NCTX ? p.x_prompt + (size_t)row * D : p.x_sample + (size_t)(row - NCTX) * D;
}
__device__ __forceinline__ int modidx(int row) { return row < NCTX ? 0 : 1 + ((row - NCTX) >> 12); }

template <bool SWAP>
__device__ __forceinline__ void gemm_main(const bf16_t* __restrict__ A, int lda, const bf16_t* __restrict__ Bt, int ldb,
                                          int K, int m0, int n0, char* smem, f32x4 (&acc)[4][4]) {
  const int tid = ltid(), lane = tid & 63, wid = tid >> 6, wr = wid >> 1, wc = wid & 1;
  const int fr = lane & 15, fq = lane >> 4;
  bf16_t* sbase = (bf16_t*)smem;
#pragma unroll
  for (int m = 0; m < 4; ++m)
#pragma unroll
    for (int n = 0; n < 4; ++n) acc[m][n] = (f32x4){0.f, 0.f, 0.f, 0.f};
  const int lr = tid >> 3, lc = (tid & 7) * 8;
  const bf16_t* ga = A + (size_t)(m0 + lr) * lda + lc;
  const bf16_t* gb = Bt + (size_t)(n0 + lr) * ldb + lc;
  const size_t sa32 = (size_t)32 * lda, sb32 = (size_t)32 * ldb;
  uint4 ra0 = *(const uint4*)(ga), ra1 = *(const uint4*)(ga + sa32), ra2 = *(const uint4*)(ga + 2 * sa32), ra3 = *(const uint4*)(ga + 3 * sa32);
  uint4 rb0 = *(const uint4*)(gb), rb1 = *(const uint4*)(gb + sb32), rb2 = *(const uint4*)(gb + 2 * sb32), rb3 = *(const uint4*)(gb + 3 * sb32);
  const int nk = K >> 6;
  const int woff = lr * 64 + (((tid & 7) ^ (lr & 7)) * 8);
  const int aoff = (wr * 64 + fr) * 64, boff = 8192 + (wc * 64 + fr) * 64;
  __syncthreads();
  {
    bf16_t* wa = sbase + woff;
    *(uint4*)(wa) = ra0; *(uint4*)(wa + 32 * 64) = ra1; *(uint4*)(wa + 64 * 64) = ra2; *(uint4*)(wa + 96 * 64) = ra3;
    *(uint4*)(wa + 8192) = rb0; *(uint4*)(wa + 8192 + 32 * 64) = rb1; *(uint4*)(wa + 8192 + 64 * 64) = rb2; *(uint4*)(wa + 8192 + 96 * 64) = rb3;
  }
  if (nk > 1) {
    ga += 64; gb += 64;
    ra0 = *(const uint4*)(ga); ra1 = *(const uint4*)(ga + sa32); ra2 = *(const uint4*)(ga + 2 * sa32); ra3 = *(const uint4*)(ga + 3 * sa32);
    rb0 = *(const uint4*)(gb); rb1 = *(const uint4*)(gb + sb32); rb2 = *(const uint4*)(gb + 2 * sb32); rb3 = *(const uint4*)(gb + 3 * sb32);
  }
  __syncthreads();
  for (int kt = 0; kt < nk; ++kt) {
    const bf16_t* cur = sbase + (kt & 1) * 16384;
    bf16x8 af[2][4], bfr[2][4];
#pragma unroll
    for (int ks = 0; ks < 2; ++ks) {
#pragma unroll
      for (int m = 0; m < 4; ++m) af[ks][m] = *(const bf16x8*)(cur + aoff + m * 16 * 64 + (((ks * 4 + fq) ^ (fr & 7)) * 8));
#pragma unroll
      for (int n = 0; n < 4; ++n) bfr[ks][n] = *(const bf16x8*)(cur + boff + n * 16 * 64 + (((ks * 4 + fq) ^ (fr & 7)) * 8));
    }
    __builtin_amdgcn_sched_barrier(0);
    {
      bf16_t* wa = sbase + ((kt + 1) & 1) * 16384 + woff;
      *(uint4*)(wa) = ra0; *(uint4*)(wa + 32 * 64) = ra1; *(uint4*)(wa + 64 * 64) = ra2; *(uint4*)(wa + 96 * 64) = ra3;
      *(uint4*)(wa + 8192) = rb0; *(uint4*)(wa + 8192 + 32 * 64) = rb1; *(uint4*)(wa + 8192 + 64 * 64) = rb2; *(uint4*)(wa + 8192 + 96 * 64) = rb3;
      const int adv = (kt + 2 < nk) ? 64 : 0;
      ga += adv; gb += adv;
      ra0 = *(const uint4*)(ga); ra1 = *(const uint4*)(ga + sa32); ra2 = *(const uint4*)(ga + 2 * sa32); ra3 = *(const uint4*)(ga + 3 * sa32);
      rb0 = *(const uint4*)(gb); rb1 = *(const uint4*)(gb + sb32); rb2 = *(const uint4*)(gb + 2 * sb32); rb3 = *(const uint4*)(gb + 3 * sb32);
    }
#pragma unroll
    for (int ks = 0; ks < 2; ++ks)
#pragma unroll
      for (int m = 0; m < 4; ++m)
#pragma unroll
        for (int n = 0; n < 4; ++n) {
          if (SWAP) acc[m][n] = __builtin_amdgcn_mfma_f32_16x16x32_bf16(bfr[ks][n], af[ks][m], acc[m][n], 0, 0, 0);
          else acc[m][n] = __builtin_amdgcn_mfma_f32_16x16x32_bf16(af[ks][m], bfr[ks][n], acc[m][n], 0, 0, 0);
        }
#pragma unroll
    for (int i = 0; i < 8; ++i) { __builtin_amdgcn_sched_group_barrier(0x008, 2, 0); __builtin_amdgcn_sched_group_barrier(0x200, 1, 0); }
#pragma unroll
    for (int i = 0; i < 8; ++i) { __builtin_amdgcn_sched_group_barrier(0x008, 2, 0); __builtin_amdgcn_sched_group_barrier(0x020, 1, 0); }
    __builtin_amdgcn_sched_barrier(0);
    if (kt + 1 < nk) __syncthreads();
  }
}
template <bool SWAP, class Epi>
__device__ __forceinline__ void gemm_tile(const bf16_t* __restrict__ A, int lda, const bf16_t* __restrict__ Bt, int ldb,
                                          int K, int m0, int n0, char* smem, const Epi& epi) {
  f32x4 acc[4][4];
  gemm_main<SWAP>(A, lda, Bt, ldb, K, m0, n0, smem, acc);
  const int tid = ltid(), lane = tid & 63, wid = tid >> 6, wr = wid >> 1, wc = wid & 1;
  const int fr = lane & 15, fq = lane >> 4;
#pragma unroll
  for (int m = 0; m < 4; ++m)
#pragma unroll
    for (int n = 0; n < 4; ++n) {
      if (SWAP) epi(m0 + wr * 64 + m * 16 + fr, n0 + wc * 64 + n * 16 + fq * 4, acc[m][n]);
      else epi(m0 + wr * 64 + m * 16 + fq * 4, n0 + wc * 64 + n * 16 + fr, acc[m][n]);
    }
}

template <int CTRL>
__device__ __forceinline__ float dpp_ror(float v) {
  return __int_as_float(__builtin_amdgcn_update_dpp(0, __float_as_int(v), CTRL, 0xF, 0xF, false));
}
constexpr size_t OFF_EDGE = 162 * MiB;
__device__ __forceinline__ void gemm_up_act_tile(const Params& p, int m0, int n0, char* smem) {
  f32x4 acc[4][4];
  gemm_main<true>((const bf16_t*)(p.ws + OFF_H), 1024, (const bf16_t*)(p.ws + OFF_WUP), 1024, 1024, m0, n0, smem, acc);
  const int tid = ltid(), lane = tid & 63, wid = tid >> 6, wr = wid >> 1, wc = wid & 1;
  const int fr = lane & 15, fq = lane >> 4;
  bf16_t* act = (bf16_t*)(p.ws + OFF_U);
  bf16_t* edge = (bf16_t*)(p.ws + OFF_EDGE);
  const int rowbase = m0 + wr * 64, wt = rowbase >> 6;
#pragma unroll
  for (int i = 0; i < 2; ++i) {
    const int cperm = n0 + wc * 64 + 32 * i;
    const int j0 = (cperm >> 5) * 16 + 4 * fq;
    const float4 wa0 = *(const float4*)(p.ffn_conv_w + j0), wa1 = *(const float4*)(p.ffn_conv_w + 5632 + j0), wa2 = *(const float4*)(p.ffn_conv_w + 11264 + j0);
    const float4 wg0 = *(const float4*)(p.ffn_conv_w + 2816 + j0), wg1 = *(const float4*)(p.ffn_conv_w + 5632 + 2816 + j0), wg2 = *(const float4*)(p.ffn_conv_w + 11264 + 2816 + j0);
    const float4 ba = *(const float4*)(p.ffn_conv_b + j0), bg = *(const float4*)(p.ffn_conv_b + 2816 + j0);
    const float w0a[4] = {wa0.x, wa0.y, wa0.z, wa0.w}, w1a[4] = {wa1.x, wa1.y, wa1.z, wa1.w}, w2a[4] = {wa2.x, wa2.y, wa2.z, wa2.w};
    const float w0g[4] = {wg0.x, wg0.y, wg0.z, wg0.w}, w1g[4] = {wg1.x, wg1.y, wg1.z, wg1.w}, w2g[4] = {wg2.x, wg2.y, wg2.z, wg2.w};
    const float bba[4] = {ba.x, ba.y, ba.z, ba.w}, bbg[4] = {bg.x, bg.y, bg.z, bg.w};
#pragma unroll
    for (int m = 0; m < 4; ++m) {
      float o[4];
#pragma unroll
      for (int e = 0; e < 4; ++e) {
        const float a = acc[m][2 * i][e], g = acc[m][2 * i + 1][e];
        const float au1 = dpp_ror<0x121>(a), gu1 = dpp_ror<0x121>(g), ad1 = dpp_ror<0x12F>(a), gd1 = dpp_ror<0x12F>(g);
        float au2 = 0.f, gu2 = 0.f, ad2 = 0.f, gd2 = 0.f;
        if (m > 0) { au2 = dpp_ror<0x121>(acc[m - 1][2 * i][e]); gu2 = dpp_ror<0x121>(acc[m - 1][2 * i + 1][e]); }
        if (m < 3) { ad2 = dpp_ror<0x12F>(acc[m + 1][2 * i][e]); gd2 = dpp_ror<0x12F>(acc[m + 1][2 * i + 1][e]); }
        const float au = fr > 0 ? au1 : au2, gu = fr > 0 ? gu1 : gu2, ad = fr < 15 ? ad1 : ad2, gd = fr < 15 ? gd1 : gd2;
        const float ca = w0a[e] * au + w1a[e] * a + w2a[e] * ad + bba[e];
        const float cgv = w0g[e] * gu + w1g[e] * g + w2g[e] * gd + bbg[e];
        o[e] = ca * __builtin_amdgcn_rcpf(1.f + __expf(-ca)) * cgv;
      }
      const int lr64 = m * 16 + fr, row = rowbase + lr64;
      if (lr64 >= 1 && lr64 <= 62) *(uint2*)(act + (size_t)row * 2816 + j0) = make_uint2(pack2(o[0], o[1]), pack2(o[2], o[3]));
      if (lr64 <= 1 || lr64 >= 62) {
        const int slot = lr64 <= 1 ? lr64 : lr64 - 60;
        bf16_t* er = edge + (size_t)(wt * 4 + slot) * 5632;
        *(uint2*)(er + j0) = make_uint2(pack2(acc[m][2 * i][0], acc[m][2 * i][1]), pack2(acc[m][2 * i][2], acc[m][2 * i][3]));
        *(uint2*)(er + 2816 + j0) = make_uint2(pack2(acc[m][2 * i + 1][0], acc[m][2 * i + 1][1]), pack2(acc[m][2 * i + 1][2], acc[m][2 * i + 1][3]));
      }
    }
  }
}

__device__ __forceinline__ void transpose_item(const float* __restrict__ W, int K, int N, bf16_t* __restrict__ WT, int tile, int ntn, char* smem, bool perm = false) {
  float* s = (float*)smem;
  const int tk = tile / ntn, tn = tile % ntn, tid = ltid();
  const int k0 = tk * 64, n0 = tn * 64;
  __syncthreads();
  {
    const int r = tid >> 4, c4 = (tid & 15) * 4;
#pragma unroll
    for (int i = 0; i < 4; ++i) {
      const int k = r + 16 * i;
      float4 v = make_float4(0.f, 0.f, 0.f, 0.f);
      if (n0 + c4 < N) v = *(const float4*)(W + (size_t)(k0 + k) * N + n0 + c4);
      s[k * 65 + c4 + 0] = v.x; s[k * 65 + c4 + 1] = v.y; s[k * 65 + c4 + 2] = v.z; s[k * 65 + c4 + 3] = v.w;
    }
  }
  __syncthreads();
  {
    const int n = tid >> 2, kc = (tid & 3) * 16;
    unsigned o[8];
#pragma unroll
    for (int i = 0; i < 8; ++i) o[i] = pack2(s[(kc + 2 * i) * 65 + n], s[(kc + 2 * i + 1) * 65 + n]);
    int nr = n0 + n;
    if (perm) { const int hf = nr >= 2816 ? 1 : 0, cc = nr - hf * 2816; nr = 32 * (cc >> 4) + 16 * hf + (cc & 15); }
    uint4* dst = (uint4*)(WT + (size_t)nr * K + k0 + kc);
    dst[0] = make_uint4(o[0], o[1], o[2], o[3]);
    dst[1] = make_uint4(o[4], o[5], o[6], o[7]);
  }
}

__device__ __forceinline__ void mod_item(const Params& p, int item, char* smem) {
  float* s = (float*)smem;
  float* red = s + 3072;
  const int tid = ltid();
  __syncthreads();
  for (int e = tid; e < 3072; e += 256) {
    const int v = e >> 10, k = e & 1023;
    const float x = (v == 0) ? p.c_ctx[k] : p.c[(v - 1) * D + k];
    s[e] = x / (1.f + __expf(-x));
  }
  __syncthreads();
  const int jl = tid & 63, kq = tid >> 6, j = item * 64 + jl, k0 = kq * 256;
  float a0 = 0.f, a1 = 0.f, a2 = 0.f;
#pragma unroll 32
  for (int k = 0; k < 256; ++k) {
    const float w = p.w_ada[(size_t)(k0 + k) * 6144 + j];
    a0 += s[k0 + k] * w; a1 += s[1024 + k0 + k] * w; a2 += s[2048 + k0 + k] * w;
  }
  red[(kq * 3 + 0) * 64 + jl] = a0; red[(kq * 3 + 1) * 64 + jl] = a1; red[(kq * 3 + 2) * 64 + jl] = a2;
  __syncthreads();
  if (tid < 192) {
    const int v = tid >> 6;
    const float r = red[(0 * 3 + v) * 64 + jl] + red[(1 * 3 + v) * 64 + jl] + red[(2 * 3 + v) * 64 + jl] + red[(3 * 3 + v) * 64 + jl];
    ((float*)(p.ws + OFF_MOD))[v * 6144 + j] = r + p.b_ada[j];
  }
}

__device__ __forceinline__ void filter_item(const Params& p, int item2, char* smem) {
  const int item = item2 >> 1, chalf = item2 & 1;
  int n, p0; bf16_t* R;
  if (item < 256) { n = 4096; p0 = item * 16; R = (bf16_t*)(p.ws + OFF_RLAT); }
  else { n = 256; p0 = (item - 256) * 16; R = (bf16_t*)(p.ws + OFF_RCTX); }
  const int n2 = 2 * n, tid = ltid();
  float* z = (float*)smem;
  float* h1 = z + 16 * 36;
  float* h2 = h1 + 16 * 64;
  __syncthreads();
#pragma unroll 1
  for (int e = tid; e < 16 * 33; e += 256) {
    const int pp = e / 33, f = e % 33, pos = p0 + pp;
    float val;
    if (f == 0) val = (float)pos / (float)(n - 1);
    else {
      const int k = (f - 1) & 15;
      const float band = 1e-4f + (float)k * ((15.f - 1e-4f) / 15.f);
      const float turns = band * ((float)pos / (float)n);
      val = (f <= 16) ? cos_turns(turns) : -sin_turns(turns);
    }
    z[pp * 36 + f] = val;
  }
  __syncthreads();
  {
    const int j = tid & 63, ppb = tid >> 6;
    float a0, a1, a2, a3;
    a0 = a1 = a2 = a3 = p.filt_b1[j];
#pragma unroll
    for (int f = 0; f < 33; ++f) {
      const float w = p.filt_w1[f * 64 + j];
      a0 += z[(ppb + 0) * 36 + f] * w; a1 += z[(ppb + 4) * 36 + f] * w; a2 += z[(ppb + 8) * 36 + f] * w; a3 += z[(ppb + 12) * 36 + f] * w;
    }
    const float fq1 = p.filt_freq1[j];
    h1[(ppb + 0) * 64 + j] = sin_rad(fq1 * a0); h1[(ppb + 4) * 64 + j] = sin_rad(fq1 * a1);
    h1[(ppb + 8) * 64 + j] = sin_rad(fq1 * a2); h1[(ppb + 12) * 64 + j] = sin_rad(fq1 * a3);
    __syncthreads();
    a0 = a1 = a2 = a3 = p.filt_b2[j];
#pragma unroll 32
    for (int k = 0; k < 64; ++k) {
      const float w = p.filt_w2[k * 64 + j];
      a0 += h1[(ppb + 0) * 64 + k] * w; a1 += h1[(ppb + 4) * 64 + k] * w; a2 += h1[(ppb + 8) * 64 + k] * w; a3 += h1[(ppb + 12) * 64 + k] * w;
    }
    const float fq2 = p.filt_freq2[j];
    h2[j * 16 + ppb + 0] = sin_rad(fq2 * a0); h2[j * 16 + ppb + 4] = sin_rad(fq2 * a1);
    h2[j * 16 + ppb + 8] = sin_rad(fq2 * a2); h2[j * 16 + ppb + 12] = sin_rad(fq2 * a3);
  }
  __syncthreads();
  const float mind = -3.0701134573253946f, maxd = -15.350567286626973f;
  {
    const int colb = tid + 256 * 4 * chalf;
    float acc[4][16];
#pragma unroll
    for (int c4 = 0; c4 < 4; ++c4)
#pragma unroll
      for (int i = 0; i < 16; ++i) acc[c4][i] = 0.f;
#pragma unroll 8
    for (int k = 0; k < 64; ++k) {
      const float4 ha = *(const float4*)(h2 + k * 16), hb = *(const float4*)(h2 + k * 16 + 4), hc = *(const float4*)(h2 + k * 16 + 8), hd = *(const float4*)(h2 + k * 16 + 12);
#pragma unroll
      for (int c4 = 0; c4 < 4; ++c4) {
        const float w = p.filt_w3[k * 2048 + colb + 256 * c4];
        acc[c4][0] += ha.x * w; acc[c4][1] += ha.y * w; acc[c4][2] += ha.z * w; acc[c4][3] += ha.w * w;
        acc[c4][4] += hb.x * w; acc[c4][5] += hb.y * w; acc[c4][6] += hb.z * w; acc[c4][7] += hb.w * w;
        acc[c4][8] += hc.x * w; acc[c4][9] += hc.y * w; acc[c4][10] += hc.z * w; acc[c4][11] += hc.w * w;
        acc[c4][12] += hd.x * w; acc[c4][13] += hd.y * w; acc[c4][14] += hd.z * w; acc[c4][15] += hd.w * w;
      }
    }
#pragma unroll
    for (int c4 = 0; c4 < 4; ++c4) {
      const int col = colb + 256 * c4, o = col >> 10, c = col & 511;
      const float delta = fabsf(mind + (float)c * ((maxd - mind) / 511.f));
      bf16_t* Rrow = R + (size_t)(o * 512 + c) * n2;
      float v[16];
#pragma unroll
      for (int i = 0; i < 16; ++i) {
        const float t = (float)(p0 + i) / (float)(n - 1);
        v[i] = acc[c4][i] * (__expf(-t * delta) + 0.05f);
      }
      if (c4 < 2) {
        uint4* dst = (uint4*)(Rrow + (n - 16 - p0));
        dst[0] = make_uint4(pack2(v[15], v[14]), pack2(v[13], v[12]), pack2(v[11], v[10]), pack2(v[9], v[8]));
        dst[1] = make_uint4(pack2(v[7], v[6]), pack2(v[5], v[4]), pack2(v[3], v[2]), pack2(v[1], v[0]));
      } else {
        if (p0 == 0) Rrow[n2 - 1] = 0; else Rrow[n - 1 + p0] = f2bf(v[0]);
        bf16_t* d = Rrow + n + p0;
        *(uint4*)d = make_uint4(pack2(v[1], v[2]), pack2(v[3], v[4]), pack2(v[5], v[6]), pack2(v[7], v[8]));
        *(uint2*)(d + 8) = make_uint2(pack2(v[9], v[10]), pack2(v[11], v[12]));
        *(unsigned*)(d + 12) = pack2(v[13], v[14]);
        d[14] = f2bf(v[15]);
      }
    }
  }
}

__device__ __forceinline__ void cache_item(const Params& p, int item) {
  const int tid = ltid(), r0 = item * 32;
  bf16_t* ckvn = (bf16_t*)(p.ws + OFF_CKVN);
#pragma unroll 2
  for (int e = tid; e < 32 * 64; e += 256) {
    const int r = r0 + (e >> 6), c4 = (e & 63) * 4;
    const float4 v = *(const float4*)(p.cache_ckv + (size_t)r * 256 + c4);
    *(uint2*)(ckvn + (size_t)(NTOK + r) * 256 + c4) = make_uint2(pack2(v.x, v.y), pack2(v.z, v.w));
  }
}

template <int WHICH>
__device__ __forceinline__ void rmsmod_phase(const Params& p) {
  const int tid = ltid(), lane = tid & 63, wid = tid >> 6;
  const int gw = blockIdx.x * 4 + wid, tw = gridDim.x * 4;
  const float* g = WHICH == 0 ? p.g_mix : p.g_ffn;
  const float* mod = (const float*)(p.ws + OFF_MOD);
  bf16_t* h = (bf16_t*)(p.ws + OFF_H);
  float4 nv0, nv1, nv2, nv3;
  {
    const float* src = WHICH == 0 ? xrow(p, gw) : p.out + (size_t)gw * D;
    nv0 = ((const float4*)src)[lane]; nv1 = ((const float4*)src)[lane + 64]; nv2 = ((const float4*)src)[lane + 128]; nv3 = ((const float4*)src)[lane + 192];
  }
  for (int row = gw; row < NTOK; row += tw) {
    float4 v[4] = {nv0, nv1, nv2, nv3};
    if (row + tw < NTOK) {
      const float* src = WHICH == 0 ? xrow(p, row + tw) : p.out + (size_t)(row + tw) * D;
      nv0 = ((const float4*)src)[lane]; nv1 = ((const float4*)src)[lane + 64]; nv2 = ((const float4*)src)[lane + 128]; nv3 = ((const float4*)src)[lane + 192];
    }
    float ss = 0.f;
#pragma unroll
    for (int i = 0; i < 4; ++i) ss += v[i].x * v[i].x + v[i].y * v[i].y + v[i].z * v[i].z + v[i].w * v[i].w;
    ss = wave_sum(ss);
    const float r = rsqrtf(ss * (1.f / 1024.f) + 1e-6f);
    const float* mv = mod + modidx(row) * 6144 + (WHICH == 0 ? 0 : 3 * 1024);
#pragma unroll
    for (int i = 0; i < 4; ++i) {
      const int e = 4 * (lane + 64 * i);
      const float4 g4 = *(const float4*)(g + e), sh = *(const float4*)(mv + e), sc = *(const float4*)(mv + 1024 + e);
      const float y0 = v[i].x * r * g4.x * (1.f + sc.x) + sh.x, y1 = v[i].y * r * g4.y * (1.f + sc.y) + sh.y;
      const float y2 = v[i].z * r * g4.z * (1.f + sc.z) + sh.z, y3 = v[i].w * r * g4.w * (1.f + sc.w) + sh.w;
      *(uint2*)(h + (size_t)row * D + e) = make_uint2(pack2(y0, y1), pack2(y2, y3));
    }
  }
}

struct EpiIn {
  float* proj; bf16_t* hyT;
  __device__ __forceinline__ void operator()(int row0, int col, const f32x4& v) const {
    if (col < 672) {
#pragma unroll
      for (int j = 0; j < 4; ++j) proj[(size_t)(row0 + j) * 672 + col] = v[j];
    } else if (col < DIN) {
      *(uint2*)(hyT + (size_t)(col - 672) * NTOK + row0) = make_uint2(pack2(v[0], v[1]), pack2(v[2], v[3]));
    }
  }
};
struct EpiProj {
  float* proj;
  __device__ __forceinline__ void operator()(int row, int col0, const f32x4& v) const { *(f32x4*)(proj + (size_t)row * 672 + col0) = v; }
};
struct EpiQ {
  bf16_t* q;
  __device__ __forceinline__ void operator()(int row, int col0, const f32x4& v) const {
    *(uint2*)(q + (size_t)row * 768 + col0) = make_uint2(pack2(v[0], v[1]), pack2(v[2], v[3]));
  }
};
struct EpiKV {
  bf16_t *kraw, *vtc, *vtl;
  __device__ __forceinline__ void operator()(int row0, int col, const f32x4& v) const {
    const int head = col >> 7, cc = col & 127;
    if (cc < 64) {
#pragma unroll
      for (int j = 0; j < 4; ++j) kraw[(size_t)(row0 + j) * 512 + head * 64 + cc] = f2bf(v[j]);
    } else {
      const int dv = cc - 64;
      bf16_t* dst;
      if (row0 < NCTX) dst = vtc + ((size_t)((row0 >> 8) * 8 + head) * 64 + dv) * 256 + (row0 & 255);
      else if (row0 < NTOK) { const int r = row0 - NCTX; dst = vtl + ((size_t)((r >> 12) * 8 + head) * 64 + dv) * 4608 + (r & 4095); }
      else { const int r = row0 - NTOK; dst = vtl + ((size_t)((r >> 9) * 8 + head) * 64 + dv) * 4608 + 4096 + (r & 511); }
      *(uint2*)dst = make_uint2(pack2(v[0], v[1]), pack2(v[2], v[3]));
    }
  }
};
struct EpiOut {
  const Params* p;
  __device__ __forceinline__ void operator()(int row, int col0, const f32x4& v) const {
    const float4 x = *(const float4*)(xrow(*p, row) + col0);
    const float4 m = *(const float4*)((const float*)(p->ws + OFF_MOD) + modidx(row) * 6144 + 2 * 1024 + col0);
    *(float4*)(p->out + (size_t)row * D + col0) = make_float4(x.x + m.x * v[0], x.y + m.y * v[1], x.z + m.z * v[2], x.w + m.w * v[3]);
  }
};
struct EpiU {
  bf16_t* u;
  __device__ __forceinline__ void operator()(int row, int col0, const f32x4& v) const {
    *(uint2*)(u + (size_t)row * 5632 + col0) = make_uint2(pack2(v[0], v[1]), pack2(v[2], v[3]));
  }
};
struct EpiY {
  const Params* p; int half;
  __device__ __forceinline__ void operator()(int row, int col0, const f32x4& v) const {
    const int grow = half * 8192 + row;
    float4* dst = (float4*)(p->out + (size_t)grow * D + col0);
    const float4 x = *dst;
    const float4 m = *(const float4*)((const float*)(p->ws + OFF_MOD) + modidx(grow) * 6144 + 5 * 1024 + col0);
    *dst = make_float4(x.x + m.x * v[0], x.y + m.y * v[1], x.z + m.z * v[2], x.w + m.w * v[3]);
  }
};

__device__ __forceinline__ void token_item(const Params& p, int item) {
  const int tid = ltid(), lane = tid & 63, wid = tid >> 6;
  const float* proj = (const float*)(p.ws + OFF_PROJ);
  bf16_t* qa = (bf16_t*)(p.ws + OFF_QA);
  bf16_t* ckvn = (bf16_t*)(p.ws + OFF_CKVN);
  float* kpe = (float*)(p.ws + OFF_KPE);
  for (int tt = 0; tt < 8; ++tt) {
    const int token = item * 32 + wid * 8 + tt;
    const float* pr = proj + (size_t)token * 672;
    float2 q[3];
    float ss = 0.f;
#pragma unroll
    for (int i = 0; i < 3; ++i) { q[i] = *(const float2*)(pr + lane * 2 + 128 * i); ss += q[i].x * q[i].x + q[i].y * q[i].y; }
    ss = wave_sum(ss);
    const float r = rsqrtf(ss * (1.f / 384.f) + 1e-6f);
#pragma unroll
    for (int i = 0; i < 3; ++i) {
      const int e = lane * 2 + 128 * i;
      *(unsigned*)(qa + (size_t)token * 384 + e) = pack2(q[i].x * r * p.g_qa[e], q[i].y * r * p.g_qa[e + 1]);
    }
    const float4 kv = *(const float4*)(pr + 384 + lane * 4);
    float s2 = wave_sum(kv.x * kv.x + kv.y * kv.y + kv.z * kv.z + kv.w * kv.w);
    const float r2 = rsqrtf(s2 * (1.f / 256.f) + 1e-6f);
    const float4 g = *(const float4*)(p.g_kva + lane * 4);
    const float4 y = make_float4(kv.x * r2 * g.x, kv.y * r2 * g.y, kv.z * r2 * g.z, kv.w * r2 * g.w);
    *(uint2*)(ckvn + (size_t)token * 256 + lane * 4) = make_uint2(pack2(y.x, y.y), pack2(y.z, y.w));
    if (token < NCTX) *(float4*)(p.out + OUT_CKV + (size_t)token * 256 + lane * 4) = y;
    if (lane < 32) {
      const float kp = pr[640 + lane];
      kpe[(size_t)token * 32 + lane] = kp;
      if (token < NCTX) p.out[OUT_KPE + (size_t)token * 32 + lane] = kp;
    }
  }
}

template <int ORDER>
__device__ __forceinline__ void hyena_item(const Params& p, int grp, int c, char* smem) {
  const int tid = ltid(), lane = tid & 63, wid = tid >> 6, fr = lane & 15, fq = lane >> 4;
  const int n = grp ? SEQL : SEQC, nb = n >> 6, L = n;
  const bf16_t* Rrow = (const bf16_t*)(p.ws + (grp ? OFF_RLAT : OFF_RCTX)) + (size_t)(ORDER * 512 + c) * (2 * n);
  const bf16_t* hyT = (const bf16_t*)(p.ws + OFF_HYT);
  bf16_t* sU = (bf16_t*)smem;
  unsigned* sR0 = (unsigned*)(smem + 18432);
  unsigned* sR1 = (unsigned*)(smem + 18432 + 16384);
  const int tok0 = grp * 8192;
  __syncthreads();
  for (int ch = tid; ch < (2 * n) / 8; ch += 256) *(uint4*)((bf16_t*)sR0 + ch * 8) = *(const uint4*)(Rrow + ch * 8);
  if (ORDER == 0) {
    const bf16_t* raw = hyT + (size_t)c * NTOK + tok0;
    const float w0 = p.hy_conv_w[c], w1 = p.hy_conv_w[1536 + c], w2 = p.hy_conv_w[3072 + c], b = p.hy_conv_b[c];
    for (int ch = tid; ch < 1024; ch += 256) {
      const int t = ch * 8, pos = t & (L - 1);
      const uint4 rv = *(const uint4*)(raw + t);
      float x[10];
      x[0] = pos == 0 ? 0.f : bf2f(raw[t - 1]);
      x[1] = bflo(rv.x); x[2] = bfhi(rv.x); x[3] = bflo(rv.y); x[4] = bfhi(rv.y);
      x[5] = bflo(rv.z); x[6] = bfhi(rv.z); x[7] = bflo(rv.w); x[8] = bfhi(rv.w);
      x[9] = (pos + 8 == L) ? 0.f : bf2f(raw[t + 8]);
      float u[8];
#pragma unroll
      for (int i = 0; i < 8; ++i) u[i] = w0 * x[i] + w1 * x[i + 1] + w2 * x[i + 2] + b;
      *(uint4*)(sU + (ch >> 3) * 64 + (((ch & 7) ^ ((ch >> 3) & 7)) * 8)) = make_uint4(pack2(u[0], u[1]), pack2(u[2], u[3]), pack2(u[4], u[5]), pack2(u[6], u[7]));
    }
  } else {
    const bf16_t* zr = (const bf16_t*)(p.ws + OFF_ZT) + (size_t)c * NTOK + tok0;
    for (int ch = tid; ch < 1024; ch += 256) *(uint4*)(sU + (ch >> 3) * 64 + (((ch & 7) ^ ((ch >> 3) & 7)) * 8)) = *(const uint4*)(zr + ch * 8);
  }
  __syncthreads();
  for (int k = tid; k < n; k += 256) {
    const unsigned a = sR0[k], b2 = (k + 1 < n) ? sR0[k + 1] : 0u;
    sR1[k] = (a >> 16) | (b2 << 16);
  }
  __syncthreads();

  f32x4 acc[4][2];
#pragma unroll
  for (int m = 0; m < 4; ++m) { acc[m][0] = (f32x4){0.f, 0.f, 0.f, 0.f}; acc[m][1] = (f32x4){0.f, 0.f, 0.f, 0.f}; }
  const unsigned* abase = (fr & 1) ? (sR0 + ((n - 1 - fr) >> 1) + 4 * fq) : (sR1 + ((n - 2 - fr) >> 1) + 4 * fq);
  const int col0 = 32 * wid + fr, col1 = col0 + 16;
  const int i0 = col0 & (nb - 1), i1 = col1 & (nb - 1);
  for (int d = -(nb - 1); d <= nb - 1; ++d) {
    const bool v0 = (unsigned)(i0 - d) < (unsigned)nb, v1 = (unsigned)(i1 - d) < (unsigned)nb;
    const bool any0 = __ballot(v0) != 0ull, any1 = __ballot(v1) != 0ull;
    if (!any0 && !any1) continue;
    bf16x8 F[6];
    const unsigned* ap = abase - 32 * d + 16;
#pragma unroll
    for (int idx = 0; idx < 6; ++idx) {
      const unsigned* q = ap - 8 * idx;
      union { unsigned u[4]; bf16x8 v; } cv;
      cv.u[0] = q[0]; cv.u[1] = q[1]; cv.u[2] = q[2]; cv.u[3] = q[3];
      F[idx] = cv.v;
    }
#pragma unroll
    for (int nt = 0; nt < 2; ++nt) {
      if (!(nt ? any1 : any0)) continue;
      const bool vv = nt ? v1 : v0;
      const int srow = (nt ? col1 : col0) - d;
      const bf16_t* up = sU + srow * 64;
#pragma unroll
      for (int ks = 0; ks < 2; ++ks) {
        bf16x8 bf = (bf16x8){0, 0, 0, 0, 0, 0, 0, 0};
        if (vv) bf = *(const bf16x8*)(up + (((ks * 4 + fq) ^ (srow & 7)) * 8));
#pragma unroll
        for (int m = 0; m < 4; ++m)
          acc[m][nt] = __builtin_amdgcn_mfma_f32_16x16x32_bf16(F[m + 2 - 2 * ks], bf, acc[m][nt], 0, 0, 0);
      }
    }
  }
  const float skip = p.filt_bias[ORDER * 512 + c];
  const int gcol = (ORDER == 0 ? 512 : 1024) + c;
  const bf16_t* graw = hyT + (size_t)gcol * NTOK + tok0;
  const float w0 = p.hy_conv_w[gcol], w1 = p.hy_conv_w[1536 + gcol], w2 = p.hy_conv_w[3072 + gcol], b = p.hy_conv_b[gcol];
  bf16_t* outT = (bf16_t*)(p.ws + (ORDER == 0 ? OFF_ZT : OFF_Y2T)) + (size_t)c * NTOK + tok0;
#pragma unroll
  for (int nt = 0; nt < 2; ++nt) {
    const int col = nt ? col1 : col0;
#pragma unroll
    for (int m = 0; m < 4; ++m) {
      const int t = col * 64 + 16 * m + 4 * fq, pos = t & (L - 1);
      const uint2 uu = *(const uint2*)(sU + col * 64 + (((2 * m + (fq >> 1)) ^ (col & 7)) * 8) + 4 * (fq & 1));
      const uint2 gv = *(const uint2*)(graw + t);
      float x[6];
      x[0] = pos == 0 ? 0.f : bf2f(graw[t - 1]);
      x[1] = bflo(gv.x); x[2] = bfhi(gv.x); x[3] = bflo(gv.y); x[4] = bfhi(gv.y);
      x[5] = (pos + 4 == L) ? 0.f : bf2f(graw[t + 4]);
      const float u4[4] = {bflo(uu.x), bfhi(uu.x), bflo(uu.y), bfhi(uu.y)};
      float o[4];
#pragma unroll
      for (int j = 0; j < 4; ++j) {
        const float gate = w0 * x[j] + w1 * x[j + 1] + w2 * x[j + 2] + b;
        o[j] = gate * (acc[m][nt][j] + skip * u4[j]);
      }
      *(uint2*)(outT + t) = make_uint2(pack2(o[0], o[1]), pack2(o[2], o[3]));
    }
  }
}

__device__ __forceinline__ void rope32(float* y  , int pos) {
  const float prow = (float)(pos >> 6), pcol = (float)(pos & 63);
  const float fr[8] = {1.f, 0.31622776601683794f, 0.1f, 0.031622776601683794f, 0.01f, 0.0031622776601683794f, 0.001f, 0.00031622776601683794f};
#pragma unroll
  for (int i = 0; i < 8; ++i) {
    const float tr = prow * fr[i] * 0.15915494309189535f, tc = pcol * fr[i] * 0.15915494309189535f;
    const float sr = sin_turns(tr), cr = cos_turns(tr), sc = sin_turns(tc), cc = cos_turns(tc);
    const float a = y[i], b = y[8 + i], c2 = y[16 + i], d2 = y[24 + i];
    y[i] = a * cr - b * sr; y[8 + i] = b * cr + a * sr;
    y[16 + i] = c2 * cc - d2 * sc; y[24 + i] = d2 * cc + c2 * sc;
  }
}
__device__ __forceinline__ void unpack8(const uint4& v, float* x) {
  x[0] = bflo(v.x); x[1] = bfhi(v.x); x[2] = bflo(v.y); x[3] = bfhi(v.y);
  x[4] = bflo(v.z); x[5] = bfhi(v.z); x[6] = bflo(v.w); x[7] = bfhi(v.w);
}
__device__ __forceinline__ float sumsq8(const uint4& v) {
  float x[8];
  unpack8(v, x);
  return x[0] * x[0] + x[1] * x[1] + x[2] * x[2] + x[3] * x[3] + x[4] * x[4] + x[5] * x[5] + x[6] * x[6] + x[7] * x[7];
}
__device__ __forceinline__ uint4 scale8(const uint4& v, float r, const float* __restrict__ g) {
  float x[8];
  unpack8(v, x);
  const float4 g0 = *(const float4*)g, g1 = *(const float4*)(g + 4);
  return make_uint4(pack2(x[0] * r * g0.x, x[1] * r * g0.y), pack2(x[2] * r * g0.z, x[3] * r * g0.w),
                    pack2(x[4] * r * g1.x, x[5] * r * g1.y), pack2(x[6] * r * g1.z, x[7] * r * g1.w));
}
__device__ __forceinline__ void qk_item(const Params& p, int item) {
  const int tid = ltid();
  if (item < 512) {
    const int idx = item * 256 + tid, row = idx >> 3, h = idx & 7;
    const bf16_t* src = (const bf16_t*)(p.ws + OFF_QRAW) + (size_t)row * 768 + h * 96;
    bf16_t* dst = (bf16_t*)(p.ws + OFF_Q) + (size_t)row * 768 + h * 96;
    uint4 raw[12];
#pragma unroll
    for (int i = 0; i < 12; ++i) raw[i] = *(const uint4*)(src + 8 * i);
    float ss = 0.f;
#pragma unroll
    for (int i = 0; i < 12; ++i) ss += sumsq8(raw[i]);
    const float r = rsqrtf(ss * (1.f / 96.f) + 1e-6f);
    const float qs = 0.10206207261596575f * 1.4426950408889634f;
#pragma unroll
    for (int i = 0; i < 8; ++i) *(uint4*)(dst + 8 * i) = scale8(raw[i], r * qs, p.g_q + 8 * i);
    float y[32];
#pragma unroll
    for (int i = 0; i < 4; ++i) unpack8(raw[8 + i], y + 8 * i);
#pragma unroll
    for (int i = 0; i < 32; ++i) y[i] = y[i] * r * p.g_q[64 + i];
    if (row >= NCTX) rope32(y, (row - NCTX) & 4095);
#pragma unroll
    for (int i = 0; i < 4; ++i)
      *(uint4*)(dst + 64 + 8 * i) = make_uint4(pack2(y[8 * i] * qs, y[8 * i + 1] * qs), pack2(y[8 * i + 2] * qs, y[8 * i + 3] * qs),
                                               pack2(y[8 * i + 4] * qs, y[8 * i + 5] * qs), pack2(y[8 * i + 6] * qs, y[8 * i + 7] * qs));
  } else {
    const int idx = (item - 512) * 256 + tid, row = idx >> 3, h = idx & 7;
    const bf16_t* src = (const bf16_t*)(p.ws + OFF_KRAW) + (size_t)row * 512 + h * 64;
    uint4 raw[8];
#pragma unroll
    for (int i = 0; i < 8; ++i) raw[i] = *(const uint4*)(src + 8 * i);
    const float* kp = row < NTOK ? (const float*)(p.ws + OFF_KPE) + (size_t)row * 32 : p.cache_kpe + (size_t)(row - NTOK) * 32;
    float y[32];
#pragma unroll
    for (int i = 0; i < 8; ++i) {
      const float4 v = *(const float4*)(kp + 4 * i);
      y[4 * i] = v.x; y[4 * i + 1] = v.y; y[4 * i + 2] = v.z; y[4 * i + 3] = v.w;
    }
    float ss = 0.f;
#pragma unroll
    for (int i = 0; i < 8; ++i) ss += sumsq8(raw[i]);
#pragma unroll
    for (int i = 0; i < 32; ++i) ss += y[i] * y[i];
    const float r = rsqrtf(ss * (1.f / 96.f) + 1e-6f);
#pragma unroll
    for (int i = 0; i < 32; ++i) y[i] = y[i] * r * p.g_k[64 + i];
    bf16_t* dst;
    if (row < NCTX) dst = (bf16_t*)(p.ws + OFF_KC) + ((size_t)((row >> 8) * 8 + h) * 256 + (row & 255)) * 96;
    else if (row < NTOK) {
      const int rr = row - NCTX;
      rope32(y, rr & 4095);
      dst = (bf16_t*)(p.ws + OFF_KL) + ((size_t)((rr >> 12) * 8 + h) * 4608 + (rr & 4095)) * 96;
    } else {
      const int rr = row - NTOK;
      dst = (bf16_t*)(p.ws + OFF_KL) + ((size_t)((rr >> 9) * 8 + h) * 4608 + 4096 + (rr & 511)) * 96;
    }
#pragma unroll
    for (int i = 0; i < 8; ++i) *(uint4*)(dst + 8 * i) = scale8(raw[i], r, p.g_k + 8 * i);
#pragma unroll
    for (int i = 0; i < 4; ++i)
      *(uint4*)(dst + 64 + 8 * i) = make_uint4(pack2(y[8 * i], y[8 * i + 1]), pack2(y[8 * i + 2], y[8 * i + 3]),
                                               pack2(y[8 * i + 4], y[8 * i + 5]), pack2(y[8 * i + 6], y[8 * i + 7]));
  }
}

__device__ __forceinline__ void attn_item(const Params& p, int item, char* smem) {
  const int tid = ltid(), lane = tid & 63, wid = tid >> 6, lr = lane & 31, lh = lane >> 5;
  int nkeys, h, tokbase; const bf16_t *Kp, *Vp;
  if (item < 512) {
    const int b = item >> 8, rem = item & 255; h = rem >> 5; const int qb = rem & 31;
    nkeys = 4608; tokbase = NCTX + b * 4096 + qb * 128;
    Kp = (const bf16_t*)(p.ws + OFF_KL) + (size_t)(b * 8 + h) * 4608 * 96;
    Vp = (const bf16_t*)(p.ws + OFF_VTL) + (size_t)(b * 8 + h) * 64 * 4608;
  } else {
    const int it = item - 512, b = it >> 4; h = (it & 15) >> 1; const int qb = it & 1;
    nkeys = 256; tokbase = b * 256 + qb * 128;
    Kp = (const bf16_t*)(p.ws + OFF_KC) + (size_t)(b * 8 + h) * 256 * 96;
    Vp = (const bf16_t*)(p.ws + OFF_VTC) + (size_t)(b * 8 + h) * 64 * 256;
  }
  bf16_t* sK = (bf16_t*)smem;
  bf16_t* sV = sK + 64 * 104;
  const int token = tokbase + 32 * wid + lr;
  bf16x8 qf[6];
  {
    const bf16_t* qsrc = (const bf16_t*)(p.ws + OFF_QRAW) + (size_t)token * 768 + h * 96 + 8 * lh;
    uint4 qr[6];
#pragma unroll
    for (int ks = 0; ks < 6; ++ks) qr[ks] = *(const uint4*)(qsrc + 16 * ks);
    float ss = 0.f;
#pragma unroll
    for (int ks = 0; ks < 6; ++ks) ss += sumsq8(qr[ks]);
    ss += __shfl_xor(ss, 32);
    const float r = rsqrtf(ss * (1.f / 96.f) + 1e-6f);
    const float qs = 0.10206207261596575f * 1.4426950408889634f;
    const bool lat = item < 512;
    const int pos = (token - NCTX) & 4095;
    const float prow = (float)(pos >> 6), pcol = (float)(pos & 63);
    const float frq[8] = {1.f, 0.31622776601683794f, 0.1f, 0.031622776601683794f, 0.01f, 0.0031622776601683794f, 0.001f, 0.00031622776601683794f};
#pragma unroll
    for (int ks = 0; ks < 6; ++ks) {
      float y[8];
      unpack8(qr[ks], y);
      const float* gq = p.g_q + 16 * ks + 8 * lh;
#pragma unroll
      for (int e = 0; e < 8; ++e) y[e] = y[e] * r * gq[e];
      if (ks >= 4) {
#pragma unroll
        for (int e = 0; e < 8; ++e) {
          const float other = __shfl_xor(y[e], 32);
          const float t = (ks == 4 ? prow : pcol) * frq[e] * 0.15915494309189535f;
          const float sn = sin_turns(t), cs = cos_turns(t);
          const float rot = y[e] * cs + (lh ? other : -other) * sn;
          y[e] = lat ? rot : y[e];
        }
      }
      union { unsigned u[4]; bf16x8 v; } pk;
      pk.u[0] = pack2(y[0] * qs, y[1] * qs); pk.u[1] = pack2(y[2] * qs, y[3] * qs); pk.u[2] = pack2(y[4] * qs, y[5] * qs); pk.u[3] = pack2(y[6] * qs, y[7] * qs);
      qf[ks] = pk.v;
    }
  }
  f32x16 oacc[2];
#pragma unroll
  for (int j = 0; j < 16; ++j) { oacc[0][j] = 0.f; oacc[1][j] = 0.f; }
  float mrun = -1e30f, lsum = 0.f;
  const int kk0 = tid / 12, kc0 = tid % 12, kk1 = (tid + 256) / 12, kc1 = (tid + 256) % 12, kk2 = (tid + 512) / 12, kc2 = (tid + 512) % 12;
  const int vd0 = tid >> 3, vc0 = tid & 7, vd1 = vd0 + 32;
  const bf16_t* gk0 = Kp + (size_t)kk0 * 96 + kc0 * 8;
  const bf16_t* gk1 = Kp + (size_t)kk1 * 96 + kc1 * 8;
  const bf16_t* gk2 = Kp + (size_t)kk2 * 96 + kc2 * 8;
  const bf16_t* gv0 = Vp + (size_t)vd0 * nkeys + vc0 * 8;
  const bf16_t* gv1 = Vp + (size_t)vd1 * nkeys + vc0 * 8;
  uint4 rk0 = *(const uint4*)gk0, rk1 = *(const uint4*)gk1, rk2 = *(const uint4*)gk2;
  uint4 rv0 = *(const uint4*)gv0, rv1 = *(const uint4*)gv1;
  const int nt = nkeys >> 6;
  for (int kt = 0; kt < nt; ++kt) {
    __syncthreads();
    *(uint4*)(sK + kk0 * 104 + kc0 * 8) = rk0; *(uint4*)(sK + kk1 * 104 + kc1 * 8) = rk1; *(uint4*)(sK + kk2 * 104 + kc2 * 8) = rk2;
    *(uint4*)(sV + vd0 * 72 + vc0 * 8) = rv0; *(uint4*)(sV + vd1 * 72 + vc0 * 8) = rv1;
    __syncthreads();
    if (kt + 1 < nt) {
      gk0 += 64 * 96; gk1 += 64 * 96; gk2 += 64 * 96; gv0 += 64; gv1 += 64;
      rk0 = *(const uint4*)gk0; rk1 = *(const uint4*)gk1; rk2 = *(const uint4*)gk2;
      rv0 = *(const uint4*)gv0; rv1 = *(const uint4*)gv1;
    }
    __builtin_amdgcn_sched_barrier(0);
    f32x16 sacc[2];
#pragma unroll
    for (int kb = 0; kb < 2; ++kb) {
#pragma unroll
      for (int j = 0; j < 16; ++j) sacc[kb][j] = 0.f;
#pragma unroll
      for (int ks = 0; ks < 6; ++ks) {
        const bf16x8 a = *(const bf16x8*)(sK + (32 * kb + lr) * 104 + 16 * ks + 8 * lh);
        sacc[kb] = __builtin_amdgcn_mfma_f32_32x32x16_bf16(a, qf[ks], sacc[kb], 0, 0, 0);
      }
    }
    float mx = sacc[0][0];
#pragma unroll
    for (int j = 1; j < 16; ++j) mx = fmaxf(mx, sacc[0][j]);
#pragma unroll
    for (int j = 0; j < 16; ++j) mx = fmaxf(mx, sacc[1][j]);
    mx = fmaxf(mx, __shfl_xor(mx, 32));
    const float mnew = fmaxf(mrun, mx);
    const float alpha = __builtin_amdgcn_exp2f(mrun - mnew);
    mrun = mnew;
    float ps = 0.f;
#pragma unroll
    for (int kb = 0; kb < 2; ++kb)
#pragma unroll
      for (int j = 0; j < 16; ++j) { const float e = __builtin_amdgcn_exp2f(sacc[kb][j] - mnew); sacc[kb][j] = e; ps += e; }
    lsum = lsum * alpha + ps;
    if (__ballot(alpha != 1.f) != 0ull) {
#pragma unroll
      for (int j = 0; j < 16; ++j) { oacc[0][j] *= alpha; oacc[1][j] *= alpha; }
    }
#pragma unroll
    for (int s = 0; s < 4; ++s) {
      const int kb = s >> 1, jb = 8 * (s & 1);
      union { unsigned u[4]; bf16x8 v; } pf;
      pf.u[0] = pack2(sacc[kb][jb + 0], sacc[kb][jb + 1]); pf.u[1] = pack2(sacc[kb][jb + 2], sacc[kb][jb + 3]);
      pf.u[2] = pack2(sacc[kb][jb + 4], sacc[kb][jb + 5]); pf.u[3] = pack2(sacc[kb][jb + 6], sacc[kb][jb + 7]);
#pragma unroll
      for (int mt = 0; mt < 2; ++mt) {
        const bf16_t* vp = sV + (32 * mt + lr) * 72 + 16 * s + 4 * lh;
        union { uint2 d[2]; bf16x8 v; } av;
        av.d[0] = *(const uint2*)vp;
        av.d[1] = *(const uint2*)(vp + 8);
        oacc[mt] = __builtin_amdgcn_mfma_f32_32x32x16_bf16(av.v, pf.v, oacc[mt], 0, 0, 0);
      }
    }
  }
  lsum += __shfl_xor(lsum, 32);
  const float inv = 1.f / lsum;
  bf16_t* dst = (bf16_t*)(p.ws + OFF_ATTN) + (size_t)token * 512 + h * 64;
#pragma unroll
  for (int mt = 0; mt < 2; ++mt)
#pragma unroll
    for (int jg = 0; jg < 4; ++jg) {
      const int dv0 = 32 * mt + 8 * jg + 4 * lh;
      *(uint2*)(dst + dv0) = make_uint2(pack2(oacc[mt][4 * jg] * inv, oacc[mt][4 * jg + 1] * inv),
                                        pack2(oacc[mt][4 * jg + 2] * inv, oacc[mt][4 * jg + 3] * inv));
    }
}

__device__ __forceinline__ void merge_item(const Params& p, int item, char* smem) {
  const int tid = ltid(), lane = tid & 63, wid = tid >> 6, t0 = item * 32;
  bf16_t* mix = (bf16_t*)(p.ws + OFF_H);
  const bf16_t* attn = (const bf16_t*)(p.ws + OFF_ATTN);
  for (int tt = 0; tt < 8; ++tt) {
    const int token = t0 + wid * 8 + tt;
    float x[8];
    unpack8(*(const uint4*)(attn + (size_t)token * 512 + lane * 8), x);
    float ss = 0.f;
#pragma unroll
    for (int i = 0; i < 8; ++i) ss += x[i] * x[i];
    ss = wave_sum(ss);
    const float r = rsqrtf(ss * (1.f / 512.f) + 1e-6f);
    const float4 g0 = *(const float4*)(p.g_out_att + lane * 8), g1 = *(const float4*)(p.g_out_att + lane * 8 + 4);
    *(uint4*)(mix + (size_t)token * D + lane * 8) =
        make_uint4(pack2(x[0] * r * g0.x, x[1] * r * g0.y), pack2(x[2] * r * g0.z, x[3] * r * g0.w),
                   pack2(x[4] * r * g1.x, x[5] * r * g1.y), pack2(x[6] * r * g1.z, x[7] * r * g1.w));
  }
  bf16_t* sT = (bf16_t*)smem;
  const bf16_t* y2T = (const bf16_t*)(p.ws + OFF_Y2T);
  __syncthreads();
  for (int ch = tid; ch < 2048; ch += 256) {
    const int c = ch >> 2, q4 = ch & 3;
    const uint4 v = *(const uint4*)(y2T + (size_t)c * NTOK + t0 + q4 * 8);
    bf16_t* d = sT + (q4 * 8) * 520 + c;
    d[0 * 520] = (bf16_t)(v.x & 0xffff); d[1 * 520] = (bf16_t)(v.x >> 16);
    d[2 * 520] = (bf16_t)(v.y & 0xffff); d[3 * 520] = (bf16_t)(v.y >> 16);
    d[4 * 520] = (bf16_t)(v.z & 0xffff); d[5 * 520] = (bf16_t)(v.z >> 16);
    d[6 * 520] = (bf16_t)(v.w & 0xffff); d[7 * 520] = (bf16_t)(v.w >> 16);
  }
  __syncthreads();
  {
    const int tt = tid >> 3, part = tid & 7;
    uint4 v[8];
    float ss = 0.f;
#pragma unroll
    for (int i = 0; i < 8; ++i) {
      v[i] = *(const uint4*)(sT + tt * 520 + part * 64 + 8 * i);
      float x[8];
      unpack8(v[i], x);
#pragma unroll
      for (int e = 0; e < 8; ++e) ss += x[e] * x[e];
    }
    ss += __shfl_xor(ss, 1); ss += __shfl_xor(ss, 2); ss += __shfl_xor(ss, 4);
    const float r = rsqrtf(ss * (1.f / 512.f) + 1e-6f);
#pragma unroll
    for (int i = 0; i < 8; ++i) {
      float x[8];
      unpack8(v[i], x);
      const int c0 = part * 64 + 8 * i;
      const float4 g0 = *(const float4*)(p.g_out_hy + c0), g1 = *(const float4*)(p.g_out_hy + c0 + 4);
      *(uint4*)(mix + (size_t)(t0 + tt) * D + 512 + c0) =
          make_uint4(pack2(x[0] * r * g0.x, x[1] * r * g0.y), pack2(x[2] * r * g0.z, x[3] * r * g0.w),
                     pack2(x[4] * r * g1.x, x[5] * r * g1.y), pack2(x[6] * r * g1.z, x[7] * r * g1.w));
    }
  }
}

__device__ __forceinline__ void actfix_item(const Params& p, int item) {
  const int idx = item * 256 + ltid();
  if (idx >= 512 * 352) return;
  const int j = (idx % 352) * 8, rowi = idx / 352, wt = rowi >> 1, which = rowi & 1;
  const int t = 64 * wt + 63 * which, L = t < NCTX ? SEQC : SEQL, pos = t & (L - 1);
  const bf16_t* edge = (const bf16_t*)(p.ws + OFF_EDGE);
  bf16_t* act = (bf16_t*)(p.ws + OFF_U);
  const bf16_t *pr, *cu, *nx;
  bool zp = false, zn = false;
  if (which == 0) { zp = pos == 0; pr = edge + (size_t)((zp ? wt : wt - 1) * 4 + 3) * 5632; cu = edge + (size_t)(wt * 4 + 0) * 5632; nx = edge + (size_t)(wt * 4 + 1) * 5632; }
  else { zn = pos == L - 1; pr = edge + (size_t)(wt * 4 + 2) * 5632; cu = edge + (size_t)(wt * 4 + 3) * 5632; nx = edge + (size_t)((zn ? wt : wt + 1) * 4 + 0) * 5632; }
  float pa[8], pg[8], ca[8], cgv[8], na[8], ng[8];
  unpack8(*(const uint4*)(pr + j), pa); unpack8(*(const uint4*)(pr + 2816 + j), pg);
  unpack8(*(const uint4*)(cu + j), ca); unpack8(*(const uint4*)(cu + 2816 + j), cgv);
  unpack8(*(const uint4*)(nx + j), na); unpack8(*(const uint4*)(nx + 2816 + j), ng);
  float o[8];
#pragma unroll
  for (int e = 0; e < 8; ++e) {
    const float pae = zp ? 0.f : pa[e], pge = zp ? 0.f : pg[e], nae = zn ? 0.f : na[e], nge = zn ? 0.f : ng[e];
    const float a = p.ffn_conv_w[j + e] * pae + p.ffn_conv_w[5632 + j + e] * ca[e] + p.ffn_conv_w[11264 + j + e] * nae + p.ffn_conv_b[j + e];
    const float g = p.ffn_conv_w[2816 + j + e] * pge + p.ffn_conv_w[5632 + 2816 + j + e] * cgv[e] + p.ffn_conv_w[11264 + 2816 + j + e] * nge + p.ffn_conv_b[2816 + j + e];
    o[e] = a * __builtin_amdgcn_rcpf(1.f + __expf(-a)) * g;
  }
  *(uint4*)(act + (size_t)t * 2816 + j) = make_uint4(pack2(o[0], o[1]), pack2(o[2], o[3]), pack2(o[4], o[5]), pack2(o[6], o[7]));
}

#define XB_TMO      128
#define XB_XCNT(j)  (256  + 64 * (j))
#define XB_XSUB(j)  (1280 + 64 * (j))
#define XB_XGEN(j)  (2304 + 64 * (j))
#define XB_TOP      3328
#define XB_TOPGEN   3392
#define XCD_BAR_WORDS 3456
#define XB_SPIN_CAP (1u << 20)
#define LAS __attribute__((address_space(3)))
__device__ __forceinline__ unsigned xb_ld(unsigned* p) { return __hip_atomic_load(p, __ATOMIC_RELAXED, __HIP_MEMORY_SCOPE_AGENT); }
__device__ __forceinline__ unsigned xb_add(unsigned* p, unsigned v) { return __hip_atomic_fetch_add(p, v, __ATOMIC_RELAXED, __HIP_MEMORY_SCOPE_AGENT); }
__device__ __forceinline__ unsigned xb_xcc_id() { return (unsigned)__builtin_amdgcn_s_getreg((3 << 11) | 20) & 0xFu; }
#define XB_SPIN(cond, bar) do { unsigned _sp = 0; while (cond) { __builtin_amdgcn_s_sleep(1); \
    if ((++_sp & 255u) == 0u) { if (xb_ld(&(bar)[XB_TMO])) break; if (_sp > XB_SPIN_CAP) { atomicAdd(&(bar)[XB_TMO], 1u); break; } } } } while (0)
struct XcdBarrier { unsigned* bar; unsigned x; volatile LAS unsigned* st; };
__device__ __forceinline__ XcdBarrier xcd_barrier_post(unsigned* bar, volatile LAS unsigned* st) {
  XcdBarrier b; b.bar = bar; b.x = xb_xcc_id(); b.st = st;
  if (threadIdx.x == 0) (void)xb_add(&bar[XB_XCNT(b.x)], 1u);
  return b;
}
__device__ __forceinline__ void xcd_barrier_complete(unsigned* bar, unsigned x, unsigned& nloc, unsigned& nx) {
  const unsigned G = gridDim.x * gridDim.y * gridDim.z;
  unsigned sum, cnt, mine, sp = 0u;
  for (;;) {
    sum = 0u; cnt = 0u; mine = 0u;
#pragma unroll
    for (unsigned j = 0; j < 16; ++j) { const unsigned c = xb_ld(&bar[XB_XCNT(j)]); sum += c; cnt += (c > 0u) ? 1u : 0u; mine = (j == x) ? c : mine; }
    if (sum == G) break;
    __builtin_amdgcn_s_sleep(1);
    if ((++sp & 255u) == 0u) { if (xb_ld(&bar[XB_TMO])) break; if (sp > XB_SPIN_CAP) { atomicAdd(&bar[XB_TMO], 1u); break; } }
  }
  nloc = mine > 0u ? mine : 1u; nx = cnt > 0u ? cnt : 1u;
}
__device__ __forceinline__ void xcd_barrier(const XcdBarrier& b) {
  asm volatile("s_waitcnt vmcnt(0)" ::: "memory");
  __syncthreads();
  if (threadIdx.x == 0) {
    unsigned* bar = b.bar;
    __builtin_amdgcn_s_waitcnt(0);
    unsigned nloc = b.st[0], nx = b.st[1];
    if (nloc == 0u) { xcd_barrier_complete(bar, b.x, nloc, nx); b.st[0] = nloc; b.st[1] = nx; }
    const unsigned old = xb_add(&bar[XB_XSUB(b.x)], 1u);
    const unsigned gen = old / nloc;
    if (old + 1u == (gen + 1u) * nloc) {
      __builtin_amdgcn_fence(__ATOMIC_RELEASE, "agent");
      asm volatile("s_waitcnt vmcnt(0)" ::: "memory");
      const unsigned og = xb_add(&bar[XB_TOP], 1u);
      const unsigned tg = og / nx;
      if (og + 1u == (tg + 1u) * nx) xb_add(&bar[XB_TOPGEN], 1u);
      else XB_SPIN(xb_ld(&bar[XB_TOPGEN]) == tg, bar);
      __builtin_amdgcn_fence(__ATOMIC_ACQUIRE, "agent");
      xb_add(&bar[XB_XGEN(b.x)], 1u);
      asm volatile("s_waitcnt vmcnt(0)" ::: "memory");
    } else {
      XB_SPIN(xb_ld(&bar[XB_XGEN(b.x)]) == gen, bar);
      __builtin_amdgcn_fence(__ATOMIC_ACQUIRE, "agent");
      asm volatile("s_waitcnt vmcnt(0)" ::: "memory");
    }
  }
  __syncthreads();
}
constexpr size_t OFF_BAR = 25 * MiB - 16384;
static_assert(OFF_MOD + 3 * 6144 * 4 <= OFF_BAR, "bar");

template <int ph>
__device__ __forceinline__ void run_phase(const Params& p, char* smem) {
  const int bid = blockIdx.x, G = gridDim.x;
  char* ws = p.ws;
  if constexpr (ph == 0) {
    for (int it = bid; it < 544 + 96 + 32 + 3080; it += G) {
      if (it < 544) filter_item(p, it, smem);
      else if (it < 640) mod_item(p, it - 544, smem);
      else if (it < 672) cache_item(p, it - 640);
      else {
        int t = it - 672;
        if (t < 576) transpose_item(p.w_in, 1024, DIN, (bf16_t*)(ws + OFF_WIN), t, 36, smem);
        else if ((t -= 576) < 72) transpose_item(p.w_uq, 384, 768, (bf16_t*)(ws + OFF_WUQ), t, 12, smem);
        else if ((t -= 72) < 64) transpose_item(p.w_ukv, 256, 1024, (bf16_t*)(ws + OFF_WUKV), t, 16, smem);
        else if ((t -= 64) < 256) transpose_item(p.w_out, 1024, 1024, (bf16_t*)(ws + OFF_WOUT), t, 16, smem);
        else if ((t -= 256) < 1408) transpose_item(p.w_up, 1024, 5632, (bf16_t*)(ws + OFF_WUP), t, 88, smem, true);
        else { t -= 1408; transpose_item(p.w_down, 2816, 1024, (bf16_t*)(ws + OFF_WDOWN), t, 16, smem); }
      }
    }
  } else if constexpr (ph == 1) {
    rmsmod_phase<0>(p);
  } else if constexpr (ph == 2) {
    EpiIn epi{(float*)(ws + OFF_PROJ), (bf16_t*)(ws + OFF_HYT)};
    EpiProj epr{(float*)(ws + OFF_PROJ)};
    for (int t = bid; t < 128 * 18; t += G) {
      const int nt = t % 18;
      if (nt < 5) gemm_tile<true>((const bf16_t*)(ws + OFF_H), 1024, (const bf16_t*)(ws + OFF_WIN), 1024, 1024, (t / 18) * 128, nt * 128, smem, epr);
      else gemm_tile<false>((const bf16_t*)(ws + OFF_H), 1024, (const bf16_t*)(ws + OFF_WIN), 1024, 1024, (t / 18) * 128, nt * 128, smem, epi);
    }
  } else if constexpr (ph == 3) {
    for (int it = bid; it < 512; it += G) hyena_item<0>(p, 1, it, smem);
    for (int it = bid; it < 512; it += G) hyena_item<0>(p, 0, it, smem);
    for (int it = G - 1 - bid; it < 512; it += G) token_item(p, it);
  } else if constexpr (ph == 4) {
    EpiQ eq{(bf16_t*)(ws + OFF_QRAW)};
    EpiKV ekv{(bf16_t*)(ws + OFF_KRAW), (bf16_t*)(ws + OFF_VTC), (bf16_t*)(ws + OFF_VTL)};
    for (int it = bid; it < 512; it += G) hyena_item<1>(p, 1, it, smem);
    for (int t = bid; t < 768; t += G) gemm_tile<true>((const bf16_t*)(ws + OFF_QA), 384, (const bf16_t*)(ws + OFF_WUQ), 384, 384, (t / 6) * 128, (t % 6) * 128, smem, eq);
    for (int t = bid; t < 1088; t += G) gemm_tile<false>((const bf16_t*)(ws + OFF_CKVN), 256, (const bf16_t*)(ws + OFF_WUKV), 256, 256, (t / 8) * 128, (t % 8) * 128, smem, ekv);
    for (int it = bid; it < 512; it += G) hyena_item<1>(p, 0, it, smem);
  } else if constexpr (ph == 5) {
    for (int it = bid; it < 544; it += G) qk_item(p, 512 + it);
  } else if constexpr (ph == 6) {
    for (int it = bid; it < 1024; it += G) attn_item(p, it, smem);
  } else if constexpr (ph == 7) {
    for (int it = bid; it < 512; it += G) merge_item(p, it, smem);
  } else if constexpr (ph == 8) {
    EpiOut epi{&p};
    if (G == 512) {
      const int x = bid & 7, j = bid >> 3;
      for (int r = 0; r < 2; ++r)
        gemm_tile<true>((const bf16_t*)(ws + OFF_H), 1024, (const bf16_t*)(ws + OFF_WOUT), 1024, 1024, (x * 16 + r * 8 + (j >> 3)) * 128, (j & 7) * 128, smem, epi);
    } else {
      for (int t = bid; t < 128 * 8; t += G)
        gemm_tile<true>((const bf16_t*)(ws + OFF_H), 1024, (const bf16_t*)(ws + OFF_WOUT), 1024, 1024, (t / 8) * 128, (t % 8) * 128, smem, epi);
    }
  } else if constexpr (ph == 9) {
    rmsmod_phase<1>(p);
  } else if constexpr (ph == 10) {
    for (int t = bid; t < 128 * 44; t += G) gemm_up_act_tile(p, (t / 44) * 128, (t % 44) * 128, smem);
  } else if constexpr (ph == 11) {
    for (int it = bid; it < 704; it += G) actfix_item(p, it);
  } else if constexpr (ph == 12) {
    EpiY epi{&p, 0};
    if (G == 512) {
      const int x = bid & 7, j = bid >> 3;
      for (int r = 0; r < 2; ++r)
        gemm_tile<true>((const bf16_t*)(ws + OFF_U), 2816, (const bf16_t*)(ws + OFF_WDOWN), 2816, 2816, (x * 16 + r * 8 + (j >> 3)) * 128, (j & 7) * 128, smem, epi);
    } else {
      for (int t = bid; t < 128 * 8; t += G)
        gemm_tile<true>((const bf16_t*)(ws + OFF_U), 2816, (const bf16_t*)(ws + OFF_WDOWN), 2816, 2816, (t / 8) * 128, (t % 8) * 128, smem, epi);
    }
  }
}

#if ONE_LAUNCH
template <int PH>
__device__ __forceinline__ void run_all(const Params& p, char* smem, cg::grid_group& grid, const XcdBarrier& xb) {
  run_phase<PH>(p, smem);
  if constexpr (((DBL_MASK >> PH) & 1) != 0) { xcd_barrier(xb); run_phase<PH>(p, smem); }
  if constexpr (PH < 12) {
    xcd_barrier(xb);
    run_all<PH + 1>(p, smem, grid, xb);
  }
}
constexpr int DYN_LDS = 65536 + 64;
__global__ void __launch_bounds__(256, 2) mega_kernel(Params p) {
  extern __shared__ __attribute__((aligned(16))) char smem[];
  uint4* xb_words = (uint4*)(smem + 65536);
  cg::grid_group grid = cg::this_grid();
  if (threadIdx.x == 0) *xb_words = make_uint4(0u, 0u, 0u, 0u);
  __syncthreads();
  XcdBarrier xb = xcd_barrier_post((unsigned*)(p.ws + OFF_BAR), (volatile LAS unsigned*)xb_words);
  if (p.ws == nullptr) grid.sync();
  run_all<0>(p, smem, grid, xb);
}
#else
template <int PH>
__global__ void __launch_bounds__(256, 2) phase_kernel(Params p) {
  __shared__ __attribute__((aligned(16))) char smem[SMEM_BYTES];
  run_phase<PH>(p, smem);
}
#ifndef DBG_STOP
#define DBG_STOP 15
#endif
__global__ void dump_kernel(Params p, size_t off, int count) {
  const bf16_t* src = (const bf16_t*)(p.ws + off);
  const bf16_t* src2 = (const bf16_t*)(p.ws + DBG_OFF2);
  for (int i = blockIdx.x * 256 + threadIdx.x; i < 16777216; i += gridDim.x * 256)
    p.out[i] = i < DBG_CNT ? bf2f(src[i]) : (i - DBG_CNT < DBG_CNT2 ? bf2f(src2[i - DBG_CNT]) : 0.f);
}
template <int PH>
static void launch_all(const Params& p, hipStream_t stream) {
  phase_kernel<PH><<<512, 256, 0, stream>>>(p);
  if constexpr (PH < 12) launch_all<PH + 1>(p, stream);
}
#endif

extern "C" void kernel_launch(void* const* d_in, const int* in_sizes, int n_in, void* d_out, int out_size, void* d_ws,
                              size_t ws_size, hipStream_t stream) {
  Params p{};
  const float** pp = (const float**)&p;
  for (int i = 0; i < 34; ++i) pp[i] = (const float*)d_in[i];
  p.out = (float*)d_out;
  p.ws = (char*)d_ws;
#if ONE_LAUNCH
  (void)hipMemsetAsync((char*)d_ws + OFF_BAR, 0, XCD_BAR_WORDS * 4, stream);
  static int grid_blocks = 0;
  if (!grid_blocks) {
    int dev = 0, cus = 0, per_cu = 0;
    hipGetDevice(&dev);
    hipDeviceGetAttribute(&cus, hipDeviceAttributeMultiprocessorCount, dev);
    (void)hipFuncSetAttribute((const void*)mega_kernel, hipFuncAttributeMaxDynamicSharedMemorySize, DYN_LDS);
    (void)hipOccupancyMaxActiveBlocksPerMultiprocessor(&per_cu, mega_kernel, 256, DYN_LDS);
    if (per_cu > 2) per_cu = 2;
    grid_blocks = cus * per_cu;
  }
  void* args[] = {&p};
  hipError_t e = hipLaunchCooperativeKernel((void*)mega_kernel, dim3(grid_blocks), dim3(256), args, DYN_LDS, stream);
  if (e != hipSuccess) fprintf(stderr, "cooperative launch failed: %s (grid %d)\n", hipGetErrorString(e), grid_blocks);
#else
  launch_all<0>(p, stream);
#if DBG_STOP < 15
  dump_kernel<<<1024, 256, 0, stream>>>(p, DBG_OFF, DBG_CNT);
#endif
#endif
}
```

```cpp
#include <hip/hip_runtime.h>
#include <hip/hip_cooperative_groups.h>
#include <cstdio>
namespace cg = cooperative_groups;

#define DBG_STOP 15
#define DBG_NOHY 0
#ifndef DBL_MASK
#define DBL_MASK 0
#endif
#define DBG_OFF OFF_QRAW
#define DBG_OFF2 OFF_KRAW
#define DBG_CNT 12582912
#define DBG_CNT2 0
#ifndef ONE_LAUNCH
#define ONE_LAUNCH 1
#endif

typedef unsigned short bf16_t;
typedef short bf16x8 __attribute__((ext_vector_type(8)));
typedef float f32x4 __attribute__((ext_vector_type(4)));
typedef float f32x16 __attribute__((ext_vector_type(16)));

constexpr int D = 1024, NTOK = 16384, NCTX = 8192, SEQC = 256, SEQL = 4096;
constexpr int DIN = 2208, DINP = 2304, QL = 384, KVL = 256, DFF = 2816;
constexpr int NROWKV = 17408;
constexpr size_t MiB = 1048576;

constexpr size_t OFF_WIN = 0;
constexpr size_t OFF_WUQ = OFF_WIN + (size_t)DINP * 1024 * 2;
constexpr size_t OFF_WUKV = OFF_WUQ + (size_t)768 * 384 * 2;
constexpr size_t OFF_WOUT = OFF_WUKV + (size_t)1024 * 256 * 2;
constexpr size_t OFF_WUP = OFF_WOUT + (size_t)1024 * 1024 * 2;
constexpr size_t OFF_WDOWN = OFF_WUP + (size_t)5632 * 1024 * 2;
constexpr size_t OFF_MOD = OFF_WDOWN + (size_t)1024 * 2816 * 2;
static_assert(OFF_MOD + 3 * 6144 * 4 <= 25 * MiB, "A region");
constexpr size_t OFF_RLAT = 25 * MiB;
constexpr size_t OFF_RCTX = 41 * MiB;
constexpr size_t OFF_H = 42 * MiB;
constexpr size_t OFF_ZT = 42 * MiB;
constexpr size_t OFF_QA = 58 * MiB;
constexpr size_t OFF_KPE = 70 * MiB;
constexpr size_t OFF_PROJ = 74 * MiB;
constexpr size_t OFF_QRAW = 74 * MiB;
constexpr size_t OFF_Y2T = 98 * MiB;
constexpr size_t OFF_ATTN = 116 * MiB;
constexpr size_t OFF_U = 74 * MiB;
constexpr size_t OFF_HYT = 116 * MiB;
constexpr size_t OFF_Q = 116 * MiB;
constexpr size_t OFF_KC = 140 * MiB;
constexpr size_t OFF_KL = 152 * MiB;
constexpr size_t OFF_CKVN = 164 * MiB;
constexpr size_t OFF_KRAW = 173 * MiB;
constexpr size_t OFF_VTC = 190 * MiB;
constexpr size_t OFF_VTL = 198 * MiB;
constexpr size_t OFF_ACT = 162 * MiB;

constexpr int OUT_YS = 0;
constexpr int OUT_CKV = 16777216;
constexpr int OUT_KPE = 16777216 + 2097152;

constexpr int SMEM_BYTES = 51200;

struct Params {
  const float *x_prompt, *x_sample, *cache_ckv, *cache_kpe, *c, *c_ctx, *w_ada, *b_ada, *g_mix, *w_in, *g_qa, *w_uq,
      *g_kva, *w_ukv, *g_q, *g_k, *hy_conv_w, *hy_conv_b, *filt_w1, *filt_b1, *filt_freq1, *filt_w2, *filt_b2,
      *filt_freq2, *filt_w3, *filt_bias, *g_out_att, *g_out_hy, *w_out, *g_ffn, *w_up, *ffn_conv_w, *ffn_conv_b, *w_down;
  float* out;
  char* ws;
};

typedef __bf16 bf16x2_t __attribute__((ext_vector_type(2)));
__device__ __forceinline__ unsigned pack2(float lo, float hi) {
  bf16x2_t v;
  v[0] = (__bf16)lo;
  v[1] = (__bf16)hi;
  return __builtin_bit_cast(unsigned, v);
}
__device__ __forceinline__ float bflo(unsigned u) { return __uint_as_float(u << 16); }
__device__ __forceinline__ float bfhi(unsigned u) { return __uint_as_float(u & 0xffff0000u); }
__device__ __forceinline__ float bf2f(bf16_t h) { return __uint_as_float(((unsigned)h) << 16); }
__device__ __forceinline__ bf16_t f2bf(float f) { return (bf16_t)(pack2(f, 0.f) & 0xffffu); }
__device__ __forceinline__ float wave_sum(float v) {
#pragma unroll
  for (int o = 32; o >= 1; o >>= 1) v += __shfl_xor(v, o);
  return v;
}
__device__ __forceinline__ int ltid() { int t = threadIdx.x; asm volatile("" : "+v"(t)); return t; }
__device__ __forceinline__ float sin_turns(float t) { t -= floorf(t); return __builtin_amdgcn_sinf(t); }
__device__ __forceinline__ float cos_turns(float t) { t -= floorf(t); return __builtin_amdgcn_cosf(t); }
__device__ __forceinline__ float sin_rad(float x) { return sin_turns(x * 0.15915494309189535f); }
__device__ __forceinline__ const float* xrow(const Params& p, int row) {
  return row < NCTX ? p.x_prompt + (size_t)row * D : p.x_sample + (size_t)(row - NCTX) * D;
}
__device__ __forceinline__ int modidx(int row) { return row < NCTX ? 0 : 1 + ((row - NCTX) >> 12); }

template <bool SWAP>
__device__ __forceinline__ void gemm_main(const bf16_t* __restrict__ A, int lda, const bf16_t* __restrict__ Bt, int ldb,
                                          int K, int m0, int n0, char* smem, f32x4 (&acc)[4][4]) {
  const int tid = ltid(), lane = tid & 63, wid = tid >> 6, wr = wid >> 1, wc = wid & 1;
  const int fr = lane & 15, fq = lane >> 4;
  bf16_t* sbase = (bf16_t*)smem;
#pragma unroll
  for (int m = 0; m < 4; ++m)
#pragma unroll
    for (int n = 0; n < 4; ++n) acc[m][n] = (f32x4){0.f, 0.f, 0.f, 0.f};
  const int lr = tid >> 3, lc = (tid & 7) * 8;
  const bf16_t* ga = A + (size_t)(m0 + lr) * lda + lc;
  const bf16_t* gb = Bt + (size_t)(n0 + lr) * ldb + lc;
  const size_t sa32 = (size_t)32 * lda, sb32 = (size_t)32 * ldb;
  uint4 ra0 = *(const uint4*)(ga), ra1 = *(const uint4*)(ga + sa32), ra2 = *(const uint4*)(ga + 2 * sa32), ra3 = *(const uint4*)(ga + 3 * sa32);
  uint4 rb0 = *(const uint4*)(gb), rb1 = *(const uint4*)(gb + sb32), rb2 = *(const uint4*)(gb + 2 * sb32), rb3 = *(const uint4*)(gb + 3 * sb32);
  const int nk = K >> 6;
  const int woff = lr * 64 + (((tid & 7) ^ (lr & 7)) * 8);
  const int aoff = (wr * 64 + fr) * 64, boff = 8192 + (wc * 64 + fr) * 64;
  __syncthreads();
  {
    bf16_t* wa = sbase + woff;
    *(uint4*)(wa) = ra0; *(uint4*)(wa + 32 * 64) = ra1; *(uint4*)(wa + 64 * 64) = ra2; *(uint4*)(wa + 96 * 64) = ra3;
    *(uint4*)(wa + 8192) = rb0; *(uint4*)(wa + 8192 + 32 * 64) = rb1; *(uint4*)(wa + 8192 + 64 * 64) = rb2; *(uint4*)(wa + 8192 + 96 * 64) = rb3;
  }
  if (nk > 1) {
    ga += 64; gb += 64;
    ra0 = *(const uint4*)(ga); ra1 = *(const uint4*)(ga + sa32); ra2 = *(const uint4*)(ga + 2 * sa32); ra3 = *(const uint4*)(ga + 3 * sa32);
    rb0 = *(const uint4*)(gb); rb1 = *(const uint4*)(gb + sb32); rb2 = *(const uint4*)(gb + 2 * sb32); rb3 = *(const uint4*)(gb + 3 * sb32);
  }
  __syncthreads();
  for (int kt = 0; kt < nk; ++kt) {
    const bf16_t* cur = sbase + (kt & 1) * 16384;
    bf16x8 af[2][4], bfr[2][4];
#pragma unroll
    for (int ks = 0; ks < 2; ++ks) {
#pragma unroll
      for (int m = 0; m < 4; ++m) af[ks][m] = *(const bf16x8*)(cur + aoff + m * 16 * 64 + (((ks * 4 + fq) ^ (fr & 7)) * 8));
#pragma unroll
      for (int n = 0; n < 4; ++n) bfr[ks][n] = *(const bf16x8*)(cur + boff + n * 16 * 64 + (((ks * 4 + fq) ^ (fr & 7)) * 8));
    }
    __builtin_amdgcn_sched_barrier(0);
    {
      bf16_t* wa = sbase + ((kt + 1) & 1) * 16384 + woff;
      *(uint4*)(wa) = ra0; *(uint4*)(wa + 32 * 64) = ra1; *(uint4*)(wa + 64 * 64) = ra2; *(uint4*)(wa + 96 * 64) = ra3;
      *(uint4*)(wa + 8192) = rb0; *(uint4*)(wa + 8192 + 32 * 64) = rb1; *(uint4*)(wa + 8192 + 64 * 64) = rb2; *(uint4*)(wa + 8192 + 96 * 64) = rb3;
      const int adv = (kt + 2 < nk) ? 64 : 0;
      ga += adv; gb += adv;
      ra0 = *(const uint4*)(ga); ra1 = *(const uint4*)(ga + sa32); ra2 = *(const uint4*)(ga + 2 * sa32); ra3 = *(const uint4*)(ga + 3 * sa32);
      rb0 = *(const uint4*)(gb); rb1 = *(const uint4*)(gb + sb32); rb2 = *(const uint4*)(gb + 2 * sb32); rb3 = *(const uint4*)(gb + 3 * sb32);
    }
#pragma unroll
    for (int ks = 0; ks < 2; ++ks)
#pragma unroll
      for (int m = 0; m < 4; ++m)
#pragma unroll
        for (int n = 0; n < 4; ++n) {
          if (SWAP) acc[m][n] = __builtin_amdgcn_mfma_f32_16x16x32_bf16(bfr[ks][n], af[ks][m], acc[m][n], 0, 0, 0);
          else acc[m][n] = __builtin_amdgcn_mfma_f32_16x16x32_bf16(af[ks][m], bfr[ks][n], acc[m][n], 0, 0, 0);
        }
#pragma unroll
    for (int i = 0; i < 8; ++i) { __builtin_amdgcn_sched_group_barrier(0x008, 2, 0); __builtin_amdgcn_sched_group_barrier(0x200, 1, 0); }
#pragma unroll
    for (int i = 0; i < 8; ++i) { __builtin_amdgcn_sched_group_barrier(0x008, 2, 0); __builtin_amdgcn_sched_group_barrier(0x020, 1, 0); }
    __builtin_amdgcn_sched_barrier(0);
    if (kt + 1 < nk) __syncthreads();
  }
}
template <bool SWAP, class Epi>
__device__ __forceinline__ void gemm_tile(const bf16_t* __restrict__ A, int lda, const bf16_t* __restrict__ Bt, int ldb,
                                          int K, int m0, int n0, char* smem, const Epi& epi) {
  f32x4 acc[4][4];
  gemm_main<SWAP>(A, lda, Bt, ldb, K, m0, n0, smem, acc);
  const int tid = ltid(), lane = tid & 63, wid = tid >> 6, wr = wid >> 1, wc = wid & 1;
  const int fr = lane & 15, fq = lane >> 4;
#pragma unroll
  for (int m = 0; m < 4; ++m)
#pragma unroll
    for (int n = 0; n < 4; ++n) {
      if (SWAP) epi(m0 + wr * 64 + m * 16 + fr, n0 + wc * 64 + n * 16 + fq * 4, acc[m][n]);
      else epi(m0 + wr * 64 + m * 16 + fq * 4, n0 + wc * 64 + n * 16 + fr, acc[m][n]);
    }
}

template <int CTRL>
__device__ __forceinline__ float dpp_keep(float keep, float v) {
  return __int_as_float(__builtin_amdgcn_update_dpp(__float_as_int(keep), __float_as_int(v), CTRL, 0xF, 0xF, false));
}
template <int CTRL>
__device__ __forceinline__ float dpp_ror(float v) {
  return __int_as_float(__builtin_amdgcn_update_dpp(0, __float_as_int(v), CTRL, 0xF, 0xF, false));
}
constexpr size_t OFF_EDGE = 162 * MiB;
__device__ __forceinline__ void gemm_up_act_tile(const Params& p, int m0, int n0, char* smem) {
  f32x4 acc[4][4];
  gemm_main<true>((const bf16_t*)(p.ws + OFF_H), 1024, (const bf16_t*)(p.ws + OFF_WUP), 1024, 1024, m0, n0, smem, acc);
  const int tid = ltid(), lane = tid & 63, wid = tid >> 6, wr = wid >> 1, wc = wid & 1;
  const int fr = lane & 15, fq = lane >> 4;
  bf16_t* act = (bf16_t*)(p.ws + OFF_U);
  bf16_t* edge = (bf16_t*)(p.ws + OFF_EDGE);
  const int rowbase = m0 + wr * 64, wt = rowbase >> 6;
#pragma unroll
  for (int i = 0; i < 2; ++i) {
    const int cperm = n0 + wc * 64 + 32 * i;
    const int j0 = (cperm >> 5) * 16 + 4 * fq;
    const float4 wa0 = *(const float4*)(p.ffn_conv_w + j0), wa1 = *(const float4*)(p.ffn_conv_w + 5632 + j0), wa2 = *(const float4*)(p.ffn_conv_w + 11264 + j0);
    const float4 wg0 = *(const float4*)(p.ffn_conv_w + 2816 + j0), wg1 = *(const float4*)(p.ffn_conv_w + 5632 + 2816 + j0), wg2 = *(const float4*)(p.ffn_conv_w + 11264 + 2816 + j0);
    const float4 ba = *(const float4*)(p.ffn_conv_b + j0), bg = *(const float4*)(p.ffn_conv_b + 2816 + j0);
    const float w0a[4] = {wa0.x, wa0.y, wa0.z, wa0.w}, w1a[4] = {wa1.x, wa1.y, wa1.z, wa1.w}, w2a[4] = {wa2.x, wa2.y, wa2.z, wa2.w};
    const float w0g[4] = {wg0.x, wg0.y, wg0.z, wg0.w}, w1g[4] = {wg1.x, wg1.y, wg1.z, wg1.w}, w2g[4] = {wg2.x, wg2.y, wg2.z, wg2.w};
    const float bba[4] = {ba.x, ba.y, ba.z, ba.w}, bbg[4] = {bg.x, bg.y, bg.z, bg.w};
#pragma unroll
    for (int m = 0; m < 4; ++m) {
      float o[4];
#pragma unroll
      for (int e = 0; e < 4; ++e) {
        const float a = acc[m][2 * i][e], g = acc[m][2 * i + 1][e];
        float au2 = 0.f, gu2 = 0.f, ad2 = 0.f, gd2 = 0.f;
        if (m > 0) { au2 = dpp_ror<0x121>(acc[m - 1][2 * i][e]); gu2 = dpp_ror<0x121>(acc[m - 1][2 * i + 1][e]); }
        if (m < 3) { ad2 = dpp_ror<0x12F>(acc[m + 1][2 * i][e]); gd2 = dpp_ror<0x12F>(acc[m + 1][2 * i + 1][e]); }
        const float au = dpp_keep<0x111>(au2, a), gu = dpp_keep<0x111>(gu2, g), ad = dpp_keep<0x101>(ad2, a), gd = dpp_keep<0x101>(gd2, g);
        const float ca = w0a[e] * au + w1a[e] * a + w2a[e] * ad + bba[e];
        const float cgv = w0g[e] * gu + w1g[e] * g + w2g[e] * gd + bbg[e];
        o[e] = ca * __builtin_amdgcn_rcpf(1.f + __expf(-ca)) * cgv;
      }
      const int lr64 = m * 16 + fr, row = rowbase + lr64;
      if (lr64 >= 1 && lr64 <= 62) *(uint2*)(act + (size_t)row * 2816 + j0) = make_uint2(pack2(o[0], o[1]), pack2(o[2], o[3]));
      if (lr64 <= 1 || lr64 >= 62) {
        const int slot = lr64 <= 1 ? lr64 : lr64 - 60;
        bf16_t* er = edge + (size_t)(wt * 4 + slot) * 5632;
        *(uint2*)(er + j0) = make_uint2(pack2(acc[m][2 * i][0], acc[m][2 * i][1]), pack2(acc[m][2 * i][2], acc[m][2 * i][3]));
        *(uint2*)(er + 2816 + j0) = make_uint2(pack2(acc[m][2 * i + 1][0], acc[m][2 * i + 1][1]), pack2(acc[m][2 * i + 1][2], acc[m][2 * i + 1][3]));
      }
    }
  }
}

__device__ __forceinline__ void transpose_item(const float* __restrict__ W, int K, int N, bf16_t* __restrict__ WT, int tile, int ntn, char* smem, bool perm = false) {
  float* s = (float*)smem;
  const int tk = tile / ntn, tn = tile % ntn, tid = ltid();
  const int k0 = tk * 64, n0 = tn * 64;
  __syncthreads();
  {
    const int r = tid >> 4, c4 = (tid & 15) * 4;
#pragma unroll
    for (int i = 0; i < 4; ++i) {
      const int k = r + 16 * i;
      float4 v = make_float4(0.f, 0.f, 0.f, 0.f);
      if (n0 + c4 < N) v = *(const float4*)(W + (size_t)(k0 + k) * N + n0 + c4);
      s[k * 65 + c4 + 0] = v.x; s[k * 65 + c4 + 1] = v.y; s[k * 65 + c4 + 2] = v.z; s[k * 65 + c4 + 3] = v.w;
    }
  }
  __syncthreads();
  {
    const int n = tid >> 2, kc = (tid & 3) * 16;
    unsigned o[8];
#pragma unroll
    for (int i = 0; i < 8; ++i) o[i] = pack2(s[(kc + 2 * i) * 65 + n], s[(kc + 2 * i + 1) * 65 + n]);
    int nr = n0 + n;
    if (perm) { const int hf = nr >= 2816 ? 1 : 0, cc = nr - hf * 2816; nr = 32 * (cc >> 4) + 16 * hf + (cc & 15); }
    uint4* dst = (uint4*)(WT + (size_t)nr * K + k0 + kc);
    dst[0] = make_uint4(o[0], o[1], o[2], o[3]);
    dst[1] = make_uint4(o[4], o[5], o[6], o[7]);
  }
}

__device__ __forceinline__ void mod_item(const Params& p, int item, char* smem) {
  float* s = (float*)smem;
  float* red = s + 3072;
  const int tid = ltid();
  __syncthreads();
  for (int e = tid; e < 3072; e += 256) {
    const int v = e >> 10, k = e & 1023;
    const float x = (v == 0) ? p.c_ctx[k] : p.c[(v - 1) * D + k];
    s[e] = x / (1.f + __expf(-x));
  }
  __syncthreads();
  const int jl = tid & 63, kq = tid >> 6, j = item * 64 + jl, k0 = kq * 256;
  float a0 = 0.f, a1 = 0.f, a2 = 0.f;
#pragma unroll 32
  for (int k = 0; k < 256; ++k) {
    const float w = p.w_ada[(size_t)(k0 + k) * 6144 + j];
    a0 += s[k0 + k] * w; a1 += s[1024 + k0 + k] * w; a2 += s[2048 + k0 + k] * w;
  }
  red[(kq * 3 + 0) * 64 + jl] = a0; red[(kq * 3 + 1) * 64 + jl] = a1; red[(kq * 3 + 2) * 64 + jl] = a2;
  __syncthreads();
  if (tid < 192) {
    const int v = tid >> 6;
    const float r = red[(0 * 3 + v) * 64 + jl] + red[(1 * 3 + v) * 64 + jl] + red[(2 * 3 + v) * 64 + jl] + red[(3 * 3 + v) * 64 + jl];
    ((float*)(p.ws + OFF_MOD))[v * 6144 + j] = r + p.b_ada[j];
  }
}

__device__ __forceinline__ void filter_item(const Params& p, int item2, char* smem) {
  const int item = item2 >> 1, chalf = item2 & 1;
  int n, p0; bf16_t* R;
  if (item < 256) { n = 4096; p0 = item * 16; R = (bf16_t*)(p.ws + OFF_RLAT); }
  else { n = 256; p0 = (item - 256) * 16; R = (bf16_t*)(p.ws + OFF_RCTX); }
  const int n2 = 2 * n, tid = ltid();
  float* z = (float*)smem;
  float* h1 = z + 16 * 36;
  float* h2 = h1 + 16 * 64;
  __syncthreads();
#pragma unroll 1
  for (int e = tid; e < 16 * 33; e += 256) {
    const int pp = e / 33, f = e % 33, pos = p0 + pp;
    float val;
    if (f == 0) val = (float)pos / (float)(n - 1);
    else {
      const int k = (f - 1) & 15;
      const float band = 1e-4f + (float)k * ((15.f - 1e-4f) / 15.f);
      const float turns = band * ((float)pos / (float)n);
      val = (f <= 16) ? cos_turns(turns) : -sin_turns(turns);
    }
    z[pp * 36 + f] = val;
  }
  __syncthreads();
  {
    const int j = tid & 63, ppb = tid >> 6;
    float a0, a1, a2, a3;
    a0 = a1 = a2 = a3 = p.filt_b1[j];
#pragma unroll
    for (int f = 0; f < 33; ++f) {
      const float w = p.filt_w1[f * 64 + j];
      a0 += z[(ppb + 0) * 36 + f] * w; a1 += z[(ppb + 4) * 36 + f] * w; a2 += z[(ppb + 8) * 36 + f] * w; a3 += z[(ppb + 12) * 36 + f] * w;
    }
    const float fq1 = p.filt_freq1[j];
    h1[(ppb + 0) * 64 + j] = sin_rad(fq1 * a0); h1[(ppb + 4) * 64 + j] = sin_rad(fq1 * a1);
    h1[(ppb + 8) * 64 + j] = sin_rad(fq1 * a2); h1[(ppb + 12) * 64 + j] = sin_rad(fq1 * a3);
    __syncthreads();
    a0 = a1 = a2 = a3 = p.filt_b2[j];
#pragma unroll 32
    for (int k = 0; k < 64; ++k) {
      const float w = p.filt_w2[k * 64 + j];
      a0 += h1[(ppb + 0) * 64 + k] * w; a1 += h1[(ppb + 4) * 64 + k] * w; a2 += h1[(ppb + 8) * 64 + k] * w; a3 += h1[(ppb + 12) * 64 + k] * w;
    }
    const float fq2 = p.filt_freq2[j];
    h2[j * 16 + ppb + 0] = sin_rad(fq2 * a0); h2[j * 16 + ppb + 4] = sin_rad(fq2 * a1);
    h2[j * 16 + ppb + 8] = sin_rad(fq2 * a2); h2[j * 16 + ppb + 12] = sin_rad(fq2 * a3);
  }
  __syncthreads();
  const float mind = -3.0701134573253946f, maxd = -15.350567286626973f;
  {
    const int colb = tid + 256 * 4 * chalf;
    float acc[4][16];
#pragma unroll
    for (int c4 = 0; c4 < 4; ++c4)
#pragma unroll
      for (int i = 0; i < 16; ++i) acc[c4][i] = 0.f;
#pragma unroll 8
    for (int k = 0; k < 64; ++k) {
      const float4 ha = *(const float4*)(h2 + k * 16), hb = *(const float4*)(h2 + k * 16 + 4), hc = *(const float4*)(h2 + k * 16 + 8), hd = *(const float4*)(h2 + k * 16 + 12);
#pragma unroll
      for (int c4 = 0; c4 < 4; ++c4) {
        const float w = p.filt_w3[k * 2048 + colb + 256 * c4];
        acc[c4][0] += ha.x * w; acc[c4][1] += ha.y * w; acc[c4][2] += ha.z * w; acc[c4][3] += ha.w * w;
        acc[c4][4] += hb.x * w; acc[c4][5] += hb.y * w; acc[c4][6] += hb.z * w; acc[c4][7] += hb.w * w;
        acc[c4][8] += hc.x * w; acc[c4][9] += hc.y * w; acc[c4][10] += hc.z * w; acc[c4][11] += hc.w * w;
        acc[c4][12] += hd.x * w; acc[c4][13] += hd.y * w; acc[c4][14] += hd.z * w; acc[c4][15] += hd.w * w;
      }
    }
#pragma unroll
    for (int c4 = 0; c4 < 4; ++c4) {
      const int col = colb + 256 * c4, o = col >> 10, c = col & 511;
      const float delta = fabsf(mind + (float)c * ((maxd - mind) / 511.f));
      bf16_t* Rrow = R + (size_t)(o * 512 + c) * n2;
      float v[16];
#pragma unroll
      for (int i = 0; i < 16; ++i) {
        const float t = (float)(p0 + i) / (float)(n - 1);
        v[i] = acc[c4][i] * (__expf(-t * delta) + 0.05f);
      }
      if (c4 < 2) {
        uint4* dst = (uint4*)(Rrow + (n - 16 - p0));
        dst[0] = make_uint4(pack2(v[15], v[14]), pack2(v[13], v[12]), pack2(v[11], v[10]), pack2(v[9], v[8]));
        dst[1] = make_uint4(pack2(v[7], v[6]), pack2(v[5], v[4]), pack2(v[3], v[2]), pack2(v[1], v[0]));
      } else {
        if (p0 == 0) Rrow[n2 - 1] = 0; else Rrow[n - 1 + p0] = f2bf(v[0]);
        bf16_t* d = Rrow + n + p0;
        *(uint4*)d = make_uint4(pack2(v[1], v[2]), pack2(v[3], v[4]), pack2(v[5], v[6]), pack2(v[7], v[8]));
        *(uint2*)(d + 8) = make_uint2(pack2(v[9], v[10]), pack2(v[11], v[12]));
        *(unsigned*)(d + 12) = pack2(v[13], v[14]);
        d[14] = f2bf(v[15]);
      }
    }
  }
}

__device__ __forceinline__ void cache_item(const Params& p, int item) {
  const int tid = ltid(), r0 = item * 32;
  bf16_t* ckvn = (bf16_t*)(p.ws + OFF_CKVN);
#pragma unroll 2
  for (int e = tid; e < 32 * 64; e += 256) {
    const int r = r0 + (e >> 6), c4 = (e & 63) * 4;
    const float4 v = *(const float4*)(p.cache_ckv + (size_t)r * 256 + c4);
    *(uint2*)(ckvn + (size_t)(NTOK + r) * 256 + c4) = make_uint2(pack2(v.x, v.y), pack2(v.z, v.w));
  }
}

template <int WHICH>
__device__ __forceinline__ void rmsmod_phase(const Params& p) {
  const int tid = ltid(), lane = tid & 63, wid = tid >> 6;
  const int gw = blockIdx.x * 4 + wid, tw = gridDim.x * 4;
  const float* g = WHICH == 0 ? p.g_mix : p.g_ffn;
  const float* mod = (const float*)(p.ws + OFF_MOD);
  bf16_t* h = (bf16_t*)(p.ws + OFF_H);
  float4 nv0, nv1, nv2, nv3;
  {
    const float* src = WHICH == 0 ? xrow(p, gw) : p.out + (size_t)gw * D;
    nv0 = ((const float4*)src)[lane]; nv1 = ((const float4*)src)[lane + 64]; nv2 = ((const float4*)src)[lane + 128]; nv3 = ((const float4*)src)[lane + 192];
  }
  for (int row = gw; row < NTOK; row += tw) {
    float4 v[4] = {nv0, nv1, nv2, nv3};
    if (row + tw < NTOK) {
      const float* src = WHICH == 0 ? xrow(p, row + tw) : p.out + (size_t)(row + tw) * D;
      nv0 = ((const float4*)src)[lane]; nv1 = ((const float4*)src)[lane + 64]; nv2 = ((const float4*)src)[lane + 128]; nv3 = ((const float4*)src)[lane + 192];
    }
    float ss = 0.f;
#pragma unroll
    for (int i = 0; i < 4; ++i) ss += v[i].x * v[i].x + v[i].y * v[i].y + v[i].z * v[i].z + v[i].w * v[i].w;
    ss = wave_sum(ss);
    const float r = rsqrtf(ss * (1.f / 1024.f) + 1e-6f);
    const float* mv = mod + modidx(row) * 6144 + (WHICH == 0 ? 0 : 3 * 1024);
#pragma unroll
    for (int i = 0; i < 4; ++i) {
      const int e = 4 * (lane + 64 * i);
      const float4 g4 = *(const float4*)(g + e), sh = *(const float4*)(mv + e), sc = *(const float4*)(mv + 1024 + e);
      const float y0 = v[i].x * r * g4.x * (1.f + sc.x) + sh.x, y1 = v[i].y * r * g4.y * (1.f + sc.y) + sh.y;
      const float y2 = v[i].z * r * g4.z * (1.f + sc.z) + sh.z, y3 = v[i].w * r * g4.w * (1.f + sc.w) + sh.w;
      *(uint2*)(h + (size_t)row * D + e) = make_uint2(pack2(y0, y1), pack2(y2, y3));
    }
  }
}

struct EpiIn {
  float* proj; bf16_t* hyT;
  __device__ __forceinline__ void operator()(int row0, int col, const f32x4& v) const {
    if (col < 672) {
#pragma unroll
      for (int j = 0; j < 4; ++j) proj[(size_t)(row0 + j) * 672 + col] = v[j];
    } else if (col < DIN) {
      *(uint2*)(hyT + (size_t)(col - 672) * NTOK + row0) = make_uint2(pack2(v[0], v[1]), pack2(v[2], v[3]));
    }
  }
};
struct EpiProj {
  float* proj;
  __device__ __forceinline__ void operator()(int row, int col0, const f32x4& v) const { *(f32x4*)(proj + (size_t)row * 672 + col0) = v; }
};
struct EpiQ {
  bf16_t* q;
  __device__ __forceinline__ void operator()(int row, int col0, const f32x4& v) const {
    *(uint2*)(q + (size_t)row * 768 + col0) = make_uint2(pack2(v[0], v[1]), pack2(v[2], v[3]));
  }
};
struct EpiKV {
  bf16_t *kraw, *vtc, *vtl;
  __device__ __forceinline__ void operator()(int row0, int col, const f32x4& v) const {
    const int head = col >> 7, cc = col & 127;
    if (cc < 64) {
#pragma unroll
      for (int j = 0; j < 4; ++j) kraw[(size_t)(row0 + j) * 512 + head * 64 + cc] = f2bf(v[j]);
    } else {
      const int dv = cc - 64;
      bf16_t* dst;
      if (row0 < NCTX) dst = vtc + ((size_t)((row0 >> 8) * 8 + head) * 64 + dv) * 256 + (row0 & 255);
      else if (row0 < NTOK) { const int r = row0 - NCTX; dst = vtl + ((size_t)((r >> 12) * 8 + head) * 64 + dv) * 4608 + (r & 4095); }
      else { const int r = row0 - NTOK; dst = vtl + ((size_t)((r >> 9) * 8 + head) * 64 + dv) * 4608 + 4096 + (r & 511); }
      *(uint2*)dst = make_uint2(pack2(v[0], v[1]), pack2(v[2], v[3]));
    }
  }
};
struct EpiOut {
  const Params* p;
  __device__ __forceinline__ void operator()(int row, int col0, const f32x4& v) const {
    const float4 x = *(const float4*)(xrow(*p, row) + col0);
    const float4 m = *(const float4*)((const float*)(p->ws + OFF_MOD) + modidx(row) * 6144 + 2 * 1024 + col0);
    *(float4*)(p->out + (size_t)row * D + col0) = make_float4(x.x + m.x * v[0], x.y + m.y * v[1], x.z + m.z * v[2], x.w + m.w * v[3]);
  }
};
struct EpiU {
  bf16_t* u;
  __device__ __forceinline__ void operator()(int row, int col0, const f32x4& v) const {
    *(uint2*)(u + (size_t)row * 5632 + col0) = make_uint2(pack2(v[0], v[1]), pack2(v[2], v[3]));
  }
};
struct EpiY {
  const Params* p; int half;
  __device__ __forceinline__ void operator()(int row, int col0, const f32x4& v) const {
    const int grow = half * 8192 + row;
    float4* dst = (float4*)(p->out + (size_t)grow * D + col0);
    const float4 x = *dst;
    const float4 m = *(const float4*)((const float*)(p->ws + OFF_MOD) + modidx(grow) * 6144 + 5 * 1024 + col0);
    *dst = make_float4(x.x + m.x * v[0], x.y + m.y * v[1], x.z + m.z * v[2], x.w + m.w * v[3]);
  }
};

__device__ __forceinline__ void token_item(const Params& p, int item) {
  const int tid = ltid(), lane = tid & 63, wid = tid >> 6;
  const float* proj = (const float*)(p.ws + OFF_PROJ);
  bf16_t* qa = (bf16_t*)(p.ws + OFF_QA);
  bf16_t* ckvn = (bf16_t*)(p.ws + OFF_CKVN);
  float* kpe = (float*)(p.ws + OFF_KPE);
  for (int tt = 0; tt < 8; ++tt) {
    const int token = item * 32 + wid * 8 + tt;
    const float* pr = proj + (size_t)token * 672;
    float2 q[3];
    float ss = 0.f;
#pragma unroll
    for (int i = 0; i < 3; ++i) { q[i] = *(const float2*)(pr + lane * 2 + 128 * i); ss += q[i].x * q[i].x + q[i].y * q[i].y; }
    ss = wave_sum(ss);
    const float r = rsqrtf(ss * (1.f / 384.f) + 1e-6f);
#pragma unroll
    for (int i = 0; i < 3; ++i) {
      const int e = lane * 2 + 128 * i;
      *(unsigned*)(qa + (size_t)token * 384 + e) = pack2(q[i].x * r * p.g_qa[e], q[i].y * r * p.g_qa[e + 1]);
    }
    const float4 kv = *(const float4*)(pr + 384 + lane * 4);
    float s2 = wave_sum(kv.x * kv.x + kv.y * kv.y + kv.z * kv.z + kv.w * kv.w);
    const float r2 = rsqrtf(s2 * (1.f / 256.f) + 1e-6f);
    const float4 g = *(const float4*)(p.g_kva + lane * 4);
    const float4 y = make_float4(kv.x * r2 * g.x, kv.y * r2 * g.y, kv.z * r2 * g.z, kv.w * r2 * g.w);
    *(uint2*)(ckvn + (size_t)token * 256 + lane * 4) = make_uint2(pack2(y.x, y.y), pack2(y.z, y.w));
    if (token < NCTX) *(float4*)(p.out + OUT_CKV + (size_t)token * 256 + lane * 4) = y;
    if (lane < 32) {
      const float kp = pr[640 + lane];
      kpe[(size_t)token * 32 + lane] = kp;
      if (token < NCTX) p.out[OUT_KPE + (size_t)token * 32 + lane] = kp;
    }
  }
}

template <int ORDER>
__device__ __forceinline__ void hyena_item(const Params& p, int grp, int c, char* smem) {
  const int tid = ltid(), lane = tid & 63, wid = tid >> 6, fr = lane & 15, fq = lane >> 4;
  const int n = grp ? SEQL : SEQC, nb = n >> 6, L = n;
  const bf16_t* Rrow = (const bf16_t*)(p.ws + (grp ? OFF_RLAT : OFF_RCTX)) + (size_t)(ORDER * 512 + c) * (2 * n);
  const bf16_t* hyT = (const bf16_t*)(p.ws + OFF_HYT);
  bf16_t* sU = (bf16_t*)smem;
  unsigned* sR0 = (unsigned*)(smem + 18432);
  unsigned* sR1 = (unsigned*)(smem + 18432 + 16384);
  const int tok0 = grp * 8192;
  __syncthreads();
  for (int ch = tid; ch < (2 * n) / 8; ch += 256) *(uint4*)((bf16_t*)sR0 + ch * 8) = *(const uint4*)(Rrow + ch * 8);
  if (ORDER == 0) {
    const bf16_t* raw = hyT + (size_t)c * NTOK + tok0;
    const float w0 = p.hy_conv_w[c], w1 = p.hy_conv_w[1536 + c], w2 = p.hy_conv_w[3072 + c], b = p.hy_conv_b[c];
    for (int ch = tid; ch < 1024; ch += 256) {
      const int t = ch * 8, pos = t & (L - 1);
      const uint4 rv = *(const uint4*)(raw + t);
      float x[10];
      x[0] = pos == 0 ? 0.f : bf2f(raw[t - 1]);
      x[1] = bflo(rv.x); x[2] = bfhi(rv.x); x[3] = bflo(rv.y); x[4] = bfhi(rv.y);
      x[5] = bflo(rv.z); x[6] = bfhi(rv.z); x[7] = bflo(rv.w); x[8] = bfhi(rv.w);
      x[9] = (pos + 8 == L) ? 0.f : bf2f(raw[t + 8]);
      float u[8];
#pragma unroll
      for (int i = 0; i < 8; ++i) u[i] = w0 * x[i] + w1 * x[i + 1] + w2 * x[i + 2] + b;
      *(uint4*)(sU + (ch >> 3) * 64 + (((ch & 7) ^ ((ch >> 3) & 7)) * 8)) = make_uint4(pack2(u[0], u[1]), pack2(u[2], u[3]), pack2(u[4], u[5]), pack2(u[6], u[7]));
    }
  } else {
    const bf16_t* zr = (const bf16_t*)(p.ws + OFF_ZT) + (size_t)c * NTOK + tok0;
    for (int ch = tid; ch < 1024; ch += 256) *(uint4*)(sU + (ch >> 3) * 64 + (((ch & 7) ^ ((ch >> 3) & 7)) * 8)) = *(const uint4*)(zr + ch * 8);
  }
  __syncthreads();
  for (int k = tid; k < n; k += 256) {
    const unsigned a = sR0[k], b2 = (k + 1 < n) ? sR0[k + 1] : 0u;
    sR1[k] = (a >> 16) | (b2 << 16);
  }
  __syncthreads();

  f32x4 acc[4][2];
#pragma unroll
  for (int m = 0; m < 4; ++m) { acc[m][0] = (f32x4){0.f, 0.f, 0.f, 0.f}; acc[m][1] = (f32x4){0.f, 0.f, 0.f, 0.f}; }
  const unsigned* abase = (fr & 1) ? (sR0 + ((n - 1 - fr) >> 1) + 4 * fq) : (sR1 + ((n - 2 - fr) >> 1) + 4 * fq);
  const int col0 = 32 * wid + fr, col1 = col0 + 16;
  const int i0 = col0 & (nb - 1), i1 = col1 & (nb - 1);
  for (int d = -(nb - 1); d <= nb - 1; ++d) {
    const bool v0 = (unsigned)(i0 - d) < (unsigned)nb, v1 = (unsigned)(i1 - d) < (unsigned)nb;
    const bool any0 = __ballot(v0) != 0ull, any1 = __ballot(v1) != 0ull;
    if (!any0 && !any1) continue;
    bf16x8 F[6];
    const unsigned* ap = abase - 32 * d + 16;
#pragma unroll
    for (int idx = 0; idx < 6; ++idx) {
      const unsigned* q = ap - 8 * idx;
      union { unsigned u[4]; bf16x8 v; } cv;
      cv.u[0] = q[0]; cv.u[1] = q[1]; cv.u[2] = q[2]; cv.u[3] = q[3];
      F[idx] = cv.v;
    }
#pragma unroll
    for (int nt = 0; nt < 2; ++nt) {
      if (!(nt ? any1 : any0)) continue;
      const bool vv = nt ? v1 : v0;
      const int srow = (nt ? col1 : col0) - d;
      const bf16_t* up = sU + srow * 64;
#pragma unroll
      for (int ks = 0; ks < 2; ++ks) {
        bf16x8 bf = (bf16x8){0, 0, 0, 0, 0, 0, 0, 0};
        if (vv) bf = *(const bf16x8*)(up + (((ks * 4 + fq) ^ (srow & 7)) * 8));
#pragma unroll
        for (int m = 0; m < 4; ++m)
          acc[m][nt] = __builtin_amdgcn_mfma_f32_16x16x32_bf16(F[m + 2 - 2 * ks], bf, acc[m][nt], 0, 0, 0);
      }
    }
  }
  const float skip = p.filt_bias[ORDER * 512 + c];
  const int gcol = (ORDER == 0 ? 512 : 1024) + c;
  const bf16_t* graw = hyT + (size_t)gcol * NTOK + tok0;
  const float w0 = p.hy_conv_w[gcol], w1 = p.hy_conv_w[1536 + gcol], w2 = p.hy_conv_w[3072 + gcol], b = p.hy_conv_b[gcol];
  bf16_t* outT = (bf16_t*)(p.ws + (ORDER == 0 ? OFF_ZT : OFF_Y2T)) + (size_t)c * NTOK + tok0;
#pragma unroll
  for (int nt = 0; nt < 2; ++nt) {
    const int col = nt ? col1 : col0;
#pragma unroll
    for (int m = 0; m < 4; ++m) {
      const int t = col * 64 + 16 * m + 4 * fq, pos = t & (L - 1);
      const uint2 uu = *(const uint2*)(sU + col * 64 + (((2 * m + (fq >> 1)) ^ (col & 7)) * 8) + 4 * (fq & 1));
      const uint2 gv = *(const uint2*)(graw + t);
      float x[6];
      x[0] = pos == 0 ? 0.f : bf2f(graw[t - 1]);
      x[1] = bflo(gv.x); x[2] = bfhi(gv.x); x[3] = bflo(gv.y); x[4] = bfhi(gv.y);
      x[5] = (pos + 4 == L) ? 0.f : bf2f(graw[t + 4]);
      const float u4[4] = {bflo(uu.x), bfhi(uu.x), bflo(uu.y), bfhi(uu.y)};
      float o[4];
#pragma unroll
      for (int j = 0; j < 4; ++j) {
        const float gate = w0 * x[j] + w1 * x[j + 1] + w2 * x[j + 2] + b;
        o[j] = gate * (acc[m][nt][j] + skip * u4[j]);
      }
      *(uint2*)(outT + t) = make_uint2(pack2(o[0], o[1]), pack2(o[2], o[3]));
    }
  }
}

__device__ __forceinline__ void rope32(float* y  , int pos) {
  const float prow = (float)(pos >> 6), pcol = (float)(pos & 63);
  const float fr[8] = {1.f, 0.31622776601683794f, 0.1f, 0.031622776601683794f, 0.01f, 0.0031622776601683794f, 0.001f, 0.00031622776601683794f};
#pragma unroll
  for (int i = 0; i < 8; ++i) {
    const float tr = prow * fr[i] * 0.15915494309189535f, tc = pcol * fr[i] * 0.15915494309189535f;
    const float sr = sin_turns(tr), cr = cos_turns(tr), sc = sin_turns(tc), cc = cos_turns(tc);
    const float a = y[i], b = y[8 + i], c2 = y[16 + i], d2 = y[24 + i];
    y[i] = a * cr - b * sr; y[8 + i] = b * cr + a * sr;
    y[16 + i] = c2 * cc - d2 * sc; y[24 + i] = d2 * cc + c2 * sc;
  }
}
__device__ __forceinline__ void unpack8(const uint4& v, float* x) {
  x[0] = bflo(v.x); x[1] = bfhi(v.x); x[2] = bflo(v.y); x[3] = bfhi(v.y);
  x[4] = bflo(v.z); x[5] = bfhi(v.z); x[6] = bflo(v.w); x[7] = bfhi(v.w);
}
__device__ __forceinline__ float sumsq8(const uint4& v) {
  float x[8];
  unpack8(v, x);
  return x[0] * x[0] + x[1] * x[1] + x[2] * x[2] + x[3] * x[3] + x[4] * x[4] + x[5] * x[5] + x[6] * x[6] + x[7] * x[7];
}
__device__ __forceinline__ uint4 scale8(const uint4& v, float r, const float* __restrict__ g) {
  float x[8];
  unpack8(v, x);
  const float4 g0 = *(const float4*)g, g1 = *(const float4*)(g + 4);
  return make_uint4(pack2(x[0] * r * g0.x, x[1] * r * g0.y), pack2(x[2] * r * g0.z, x[3] * r * g0.w),
                    pack2(x[4] * r * g1.x, x[5] * r * g1.y), pack2(x[6] * r * g1.z, x[7] * r * g1.w));
}
__device__ __forceinline__ void qk_item(const Params& p, int item) {
  const int tid = ltid();
  if (item < 512) {
    const int idx = item * 256 + tid, row = idx >> 3, h = idx & 7;
    const bf16_t* src = (const bf16_t*)(p.ws + OFF_QRAW) + (size_t)row * 768 + h * 96;
    bf16_t* dst = (bf16_t*)(p.ws + OFF_Q) + (size_t)row * 768 + h * 96;
    uint4 raw[12];
#pragma unroll
    for (int i = 0; i < 12; ++i) raw[i] = *(const uint4*)(src + 8 * i);
    float ss = 0.f;
#pragma unroll
    for (int i = 0; i < 12; ++i) ss += sumsq8(raw[i]);
    const float r = rsqrtf(ss * (1.f / 96.f) + 1e-6f);
    const float qs = 0.10206207261596575f * 1.4426950408889634f;
#pragma unroll
    for (int i = 0; i < 8; ++i) *(uint4*)(dst + 8 * i) = scale8(raw[i], r * qs, p.g_q + 8 * i);
    float y[32];
#pragma unroll
    for (int i = 0; i < 4; ++i) unpack8(raw[8 + i], y + 8 * i);
#pragma unroll
    for (int i = 0; i < 32; ++i) y[i] = y[i] * r * p.g_q[64 + i];
    if (row >= NCTX) rope32(y, (row - NCTX) & 4095);
#pragma unroll
    for (int i = 0; i < 4; ++i)
      *(uint4*)(dst + 64 + 8 * i) = make_uint4(pack2(y[8 * i] * qs, y[8 * i + 1] * qs), pack2(y[8 * i + 2] * qs, y[8 * i + 3] * qs),
                                               pack2(y[8 * i + 4] * qs, y[8 * i + 5] * qs), pack2(y[8 * i + 6] * qs, y[8 * i + 7] * qs));
  } else {
    const int idx = (item - 512) * 256 + tid, row = idx >> 3, h = idx & 7;
    const bf16_t* src = (const bf16_t*)(p.ws + OFF_KRAW) + (size_t)row * 512 + h * 64;
    uint4 raw[8];
#pragma unroll
    for (int i = 0; i < 8; ++i) raw[i] = *(const uint4*)(src + 8 * i);
    const float* kp = row < NTOK ? (const float*)(p.ws + OFF_KPE) + (size_t)row * 32 : p.cache_kpe + (size_t)(row - NTOK) * 32;
    float y[32];
#pragma unroll
    for (int i = 0; i < 8; ++i) {
      const float4 v = *(const float4*)(kp + 4 * i);
      y[4 * i] = v.x; y[4 * i + 1] = v.y; y[4 * i + 2] = v.z; y[4 * i + 3] = v.w;
    }
    float ss = 0.f;
#pragma unroll
    for (int i = 0; i < 8; ++i) ss += sumsq8(raw[i]);
#pragma unroll
    for (int i = 0; i < 32; ++i) ss += y[i] * y[i];
    const float r = rsqrtf(ss * (1.f / 96.f) + 1e-6f);
#pragma unroll
    for (int i = 0; i < 32; ++i) y[i] = y[i] * r * p.g_k[64 + i];
    bf16_t* dst;
    if (row < NCTX) dst = (bf16_t*)(p.ws + OFF_KC) + ((size_t)((row >> 8) * 8 + h) * 256 + (row & 255)) * 96;
    else if (row < NTOK) {
      const int rr = row - NCTX;
      rope32(y, rr & 4095);
      dst = (bf16_t*)(p.ws + OFF_KL) + ((size_t)((rr >> 12) * 8 + h) * 4608 + (rr & 4095)) * 96;
    } else {
      const int rr = row - NTOK;
      dst = (bf16_t*)(p.ws + OFF_KL) + ((size_t)((rr >> 9) * 8 + h) * 4608 + 4096 + (rr & 511)) * 96;
    }
#pragma unroll
    for (int i = 0; i < 8; ++i) *(uint4*)(dst + 8 * i) = scale8(raw[i], r, p.g_k + 8 * i);
#pragma unroll
    for (int i = 0; i < 4; ++i)
      *(uint4*)(dst + 64 + 8 * i) = make_uint4(pack2(y[8 * i], y[8 * i + 1]), pack2(y[8 * i + 2], y[8 * i + 3]),
                                               pack2(y[8 * i + 4], y[8 * i + 5]), pack2(y[8 * i + 6], y[8 * i + 7]));
  }
}

__device__ __forceinline__ void attn_item(const Params& p, int item, char* smem) {
  const int tid = ltid(), lane = tid & 63, wid = tid >> 6, lr = lane & 31, lh = lane >> 5;
  int nkeys, h, tokbase; const bf16_t *Kp, *Vp;
  if (item < 512) {
    const int b = item >> 8, rem = item & 255; h = rem >> 5; const int qb = rem & 31;
    nkeys = 4608; tokbase = NCTX + b * 4096 + qb * 128;
    Kp = (const bf16_t*)(p.ws + OFF_KL) + (size_t)(b * 8 + h) * 4608 * 96;
    Vp = (const bf16_t*)(p.ws + OFF_VTL) + (size_t)(b * 8 + h) * 64 * 4608;
  } else {
    const int it = item - 512, b = it >> 4; h = (it & 15) >> 1; const int qb = it & 1;
    nkeys = 256; tokbase = b * 256 + qb * 128;
    Kp = (const bf16_t*)(p.ws + OFF_KC) + (size_t)(b * 8 + h) * 256 * 96;
    Vp = (const bf16_t*)(p.ws + OFF_VTC) + (size_t)(b * 8 + h) * 64 * 256;
  }
  bf16_t* sK = (bf16_t*)smem;
  bf16_t* sV = sK + 64 * 104;
  const int token = tokbase + 32 * wid + lr;
  bf16x8 qf[6];
  {
    const bf16_t* qsrc = (const bf16_t*)(p.ws + OFF_QRAW) + (size_t)token * 768 + h * 96 + 8 * lh;
    uint4 qr[6];
#pragma unroll
    for (int ks = 0; ks < 6; ++ks) qr[ks] = *(const uint4*)(qsrc + 16 * ks);
    float ss = 0.f;
#pragma unroll
    for (int ks = 0; ks < 6; ++ks) ss += sumsq8(qr[ks]);
    ss += __shfl_xor(ss, 32);
    const float r = rsqrtf(ss * (1.f / 96.f) + 1e-6f);
    const float qs = 0.10206207261596575f * 1.4426950408889634f;
    const bool lat = item < 512;
    const int pos = (token - NCTX) & 4095;
    const float prow = (float)(pos >> 6), pcol = (float)(pos & 63);
    const float frq[8] = {1.f, 0.31622776601683794f, 0.1f, 0.031622776601683794f, 0.01f, 0.0031622776601683794f, 0.001f, 0.00031622776601683794f};
#pragma unroll
    for (int ks = 0; ks < 6; ++ks) {
      float y[8];
      unpack8(qr[ks], y);
      const float* gq = p.g_q + 16 * ks + 8 * lh;
#pragma unroll
      for (int e = 0; e < 8; ++e) y[e] = y[e] * r * gq[e];
      if (ks >= 4) {
#pragma unroll
        for (int e = 0; e < 8; ++e) {
          const float other = __shfl_xor(y[e], 32);
          const float t = (ks == 4 ? prow : pcol) * frq[e] * 0.15915494309189535f;
          const float sn = sin_turns(t), cs = cos_turns(t);
          const float rot = y[e] * cs + (lh ? other : -other) * sn;
          y[e] = lat ? rot : y[e];
        }
      }
      union { unsigned u[4]; bf16x8 v; } pk;
      pk.u[0] = pack2(y[0] * qs, y[1] * qs); pk.u[1] = pack2(y[2] * qs, y[3] * qs); pk.u[2] = pack2(y[4] * qs, y[5] * qs); pk.u[3] = pack2(y[6] * qs, y[7] * qs);
      qf[ks] = pk.v;
    }
  }
  f32x16 oacc[2];
#pragma unroll
  for (int j = 0; j < 16; ++j) { oacc[0][j] = 0.f; oacc[1][j] = 0.f; }
  float mrun = -1e30f, lsum = 0.f;
  const int kk0 = tid / 12, kc0 = tid % 12, kk1 = (tid + 256) / 12, kc1 = (tid + 256) % 12, kk2 = (tid + 512) / 12, kc2 = (tid + 512) % 12;
  const int vd0 = tid >> 3, vc0 = tid & 7, vd1 = vd0 + 32;
  const bf16_t* gk0 = Kp + (size_t)kk0 * 96 + kc0 * 8;
  const bf16_t* gk1 = Kp + (size_t)kk1 * 96 + kc1 * 8;
  const bf16_t* gk2 = Kp + (size_t)kk2 * 96 + kc2 * 8;
  const bf16_t* gv0 = Vp + (size_t)vd0 * nkeys + vc0 * 8;
  const bf16_t* gv1 = Vp + (size_t)vd1 * nkeys + vc0 * 8;
  uint4 rk0 = *(const uint4*)gk0, rk1 = *(const uint4*)gk1, rk2 = *(const uint4*)gk2;
  uint4 rv0 = *(const uint4*)gv0, rv1 = *(const uint4*)gv1;
  const int nt = nkeys >> 6;
  for (int kt = 0; kt < nt; ++kt) {
    __syncthreads();
    *(uint4*)(sK + kk0 * 104 + kc0 * 8) = rk0; *(uint4*)(sK + kk1 * 104 + kc1 * 8) = rk1; *(uint4*)(sK + kk2 * 104 + kc2 * 8) = rk2;
    *(uint4*)(sV + vd0 * 72 + vc0 * 8) = rv0; *(uint4*)(sV + vd1 * 72 + vc0 * 8) = rv1;
    __syncthreads();
    if (kt + 1 < nt) {
      gk0 += 64 * 96; gk1 += 64 * 96; gk2 += 64 * 96; gv0 += 64; gv1 += 64;
      rk0 = *(const uint4*)gk0; rk1 = *(const uint4*)gk1; rk2 = *(const uint4*)gk2;
      rv0 = *(const uint4*)gv0; rv1 = *(const uint4*)gv1;
    }
    __builtin_amdgcn_sched_barrier(0);
    f32x16 sacc[2];
#pragma unroll
    for (int kb = 0; kb < 2; ++kb) {
#pragma unroll
      for (int j = 0; j < 16; ++j) sacc[kb][j] = 0.f;
#pragma unroll
      for (int ks = 0; ks < 6; ++ks) {
        const bf16x8 a = *(const bf16x8*)(sK + (32 * kb + lr) * 104 + 16 * ks + 8 * lh);
        sacc[kb] = __builtin_amdgcn_mfma_f32_32x32x16_bf16(a, qf[ks], sacc[kb], 0, 0, 0);
      }
    }
    float mx = sacc[0][0];
#pragma unroll
    for (int j = 1; j < 16; ++j) mx = fmaxf(mx, sacc[0][j]);
#pragma unroll
    for (int j = 0; j < 16; ++j) mx = fmaxf(mx, sacc[1][j]);
    mx = fmaxf(mx, __shfl_xor(mx, 32));
    const float mnew = fmaxf(mrun, mx);
    const float alpha = __builtin_amdgcn_exp2f(mrun - mnew);
    mrun = mnew;
    float ps = 0.f;
#pragma unroll
    for (int kb = 0; kb < 2; ++kb)
#pragma unroll
      for (int j = 0; j < 16; ++j) { const float e = __builtin_amdgcn_exp2f(sacc[kb][j] - mnew); sacc[kb][j] = e; ps += e; }
    lsum = lsum * alpha + ps;
    if (__ballot(alpha != 1.f) != 0ull) {
#pragma unroll
      for (int j = 0; j < 16; ++j) { oacc[0][j] *= alpha; oacc[1][j] *= alpha; }
    }
#pragma unroll
    for (int s = 0; s < 4; ++s) {
      const int kb = s >> 1, jb = 8 * (s & 1);
      union { unsigned u[4]; bf16x8 v; } pf;
      pf.u[0] = pack2(sacc[kb][jb + 0], sacc[kb][jb + 1]); pf.u[1] = pack2(sacc[kb][jb + 2], sacc[kb][jb + 3]);
      pf.u[2] = pack2(sacc[kb][jb + 4], sacc[kb][jb + 5]); pf.u[3] = pack2(sacc[kb][jb + 6], sacc[kb][jb + 7]);
#pragma unroll
      for (int mt = 0; mt < 2; ++mt) {
        const bf16_t* vp = sV + (32 * mt + lr) * 72 + 16 * s + 4 * lh;
        union { uint2 d[2]; bf16x8 v; } av;
        av.d[0] = *(const uint2*)vp;
        av.d[1] = *(const uint2*)(vp + 8);
        oacc[mt] = __builtin_amdgcn_mfma_f32_32x32x16_bf16(av.v, pf.v, oacc[mt], 0, 0, 0);
      }
    }
  }
  lsum += __shfl_xor(lsum, 32);
  const float inv = 1.f / lsum;
  bf16_t* dst = (bf16_t*)(p.ws + OFF_ATTN) + (size_t)token * 512 + h * 64;
#pragma unroll
  for (int mt = 0; mt < 2; ++mt)
#pragma unroll
    for (int jg = 0; jg < 4; ++jg) {
      const int dv0 = 32 * mt + 8 * jg + 4 * lh;
      *(uint2*)(dst + dv0) = make_uint2(pack2(oacc[mt][4 * jg] * inv, oacc[mt][4 * jg + 1] * inv),
                                        pack2(oacc[mt][4 * jg + 2] * inv, oacc[mt][4 * jg + 3] * inv));
    }
}

__device__ __forceinline__ void merge_item(const Params& p, int item, char* smem) {
  const int tid = ltid(), lane = tid & 63, wid = tid >> 6, t0 = item * 32;
  bf16_t* mix = (bf16_t*)(p.ws + OFF_H);
  const bf16_t* attn = (const bf16_t*)(p.ws + OFF_ATTN);
  for (int tt = 0; tt < 8; ++tt) {
    const int token = t0 + wid * 8 + tt;
    float x[8];
    unpack8(*(const uint4*)(attn + (size_t)token * 512 + lane * 8), x);
    float ss = 0.f;
#pragma unroll
    for (int i = 0; i < 8; ++i) ss += x[i] * x[i];
    ss = wave_sum(ss);
    const float r = rsqrtf(ss * (1.f / 512.f) + 1e-6f);
    const float4 g0 = *(const float4*)(p.g_out_att + lane * 8), g1 = *(const float4*)(p.g_out_att + lane * 8 + 4);
    *(uint4*)(mix + (size_t)token * D + lane * 8) =
        make_uint4(pack2(x[0] * r * g0.x, x[1] * r * g0.y), pack2(x[2] * r * g0.z, x[3] * r * g0.w),
                   pack2(x[4] * r * g1.x, x[5] * r * g1.y), pack2(x[6] * r * g1.z, x[7] * r * g1.w));
  }
  bf16_t* sT = (bf16_t*)smem;
  const bf16_t* y2T = (const bf16_t*)(p.ws + OFF_Y2T);
  __syncthreads();
  for (int ch = tid; ch < 2048; ch += 256) {
    const int c = ch >> 2, q4 = ch & 3;
    const uint4 v = *(const uint4*)(y2T + (size_t)c * NTOK + t0 + q4 * 8);
    bf16_t* d = sT + (q4 * 8) * 520 + c;
    d[0 * 520] = (bf16_t)(v.x & 0xffff); d[1 * 520] = (bf16_t)(v.x >> 16);
    d[2 * 520] = (bf16_t)(v.y & 0xffff); d[3 * 520] = (bf16_t)(v.y >> 16);
    d[4 * 520] = (bf16_t)(v.z & 0xffff); d[5 * 520] = (bf16_t)(v.z >> 16);
    d[6 * 520] = (bf16_t)(v.w & 0xffff); d[7 * 520] = (bf16_t)(v.w >> 16);
  }
  __syncthreads();
  {
    const int tt = tid >> 3, part = tid & 7;
    uint4 v[8];
    float ss = 0.f;
#pragma unroll
    for (int i = 0; i < 8; ++i) {
      v[i] = *(const uint4*)(sT + tt * 520 + part * 64 + 8 * i);
      float x[8];
      unpack8(v[i], x);
#pragma unroll
      for (int e = 0; e < 8; ++e) ss += x[e] * x[e];
    }
    ss += __shfl_xor(ss, 1); ss += __shfl_xor(ss, 2); ss += __shfl_xor(ss, 4);
    const float r = rsqrtf(ss * (1.f / 512.f) + 1e-6f);
#pragma unroll
    for (int i = 0; i < 8; ++i) {
      float x[8];
      unpack8(v[i], x);
      const int c0 = part * 64 + 8 * i;
      const float4 g0 = *(const float4*)(p.g_out_hy + c0), g1 = *(const float4*)(p.g_out_hy + c0 + 4);
      *(uint4*)(mix + (size_t)(t0 + tt) * D + 512 + c0) =
          make_uint4(pack2(x[0] * r * g0.x, x[1] * r * g0.y), pack2(x[2] * r * g0.z, x[3] * r * g0.w),
                     pack2(x[4] * r * g1.x, x[5] * r * g1.y), pack2(x[6] * r * g1.z, x[7] * r * g1.w));
    }
  }
}

__device__ __forceinline__ void actfix_item(const Params& p, int item) {
  const int idx = item * 256 + ltid();
  if (idx >= 512 * 352) return;
  const int j = (idx % 352) * 8, rowi = idx / 352, wt = rowi >> 1, which = rowi & 1;
  const int t = 64 * wt + 63 * which, L = t < NCTX ? SEQC : SEQL, pos = t & (L - 1);
  const bf16_t* edge = (const bf16_t*)(p.ws + OFF_EDGE);
  bf16_t* act = (bf16_t*)(p.ws + OFF_U);
  const bf16_t *pr, *cu, *nx;
  bool zp = false, zn = false;
  if (which == 0) { zp = pos == 0; pr = edge + (size_t)((zp ? wt : wt - 1) * 4 + 3) * 5632; cu = edge + (size_t)(wt * 4 + 0) * 5632; nx = edge + (size_t)(wt * 4 + 1) * 5632; }
  else { zn = pos == L - 1; pr = edge + (size_t)(wt * 4 + 2) * 5632; cu = edge + (size_t)(wt * 4 + 3) * 5632; nx = edge + (size_t)((zn ? wt : wt + 1) * 4 + 0) * 5632; }
  float pa[8], pg[8], ca[8], cgv[8], na[8], ng[8];
  unpack8(*(const uint4*)(pr + j), pa); unpack8(*(const uint4*)(pr + 2816 + j), pg);
  unpack8(*(const uint4*)(cu + j), ca); unpack8(*(const uint4*)(cu + 2816 + j), cgv);
  unpack8(*(const uint4*)(nx + j), na); unpack8(*(const uint4*)(nx + 2816 + j), ng);
  float o[8];
#pragma unroll
  for (int e = 0; e < 8; ++e) {
    const float pae = zp ? 0.f : pa[e], pge = zp ? 0.f : pg[e], nae = zn ? 0.f : na[e], nge = zn ? 0.f : ng[e];
    const float a = p.ffn_conv_w[j + e] * pae + p.ffn_conv_w[5632 + j + e] * ca[e] + p.ffn_conv_w[11264 + j + e] * nae + p.ffn_conv_b[j + e];
    const float g = p.ffn_conv_w[2816 + j + e] * pge + p.ffn_conv_w[5632 + 2816 + j + e] * cgv[e] + p.ffn_conv_w[11264 + 2816 + j + e] * nge + p.ffn_conv_b[2816 + j + e];
    o[e] = a * __builtin_amdgcn_rcpf(1.f + __expf(-a)) * g;
  }
  *(uint4*)(act + (size_t)t * 2816 + j) = make_uint4(pack2(o[0], o[1]), pack2(o[2], o[3]), pack2(o[4], o[5]), pack2(o[6], o[7]));
}

#define XB_TMO      128
#define XB_XCNT(j)  (256  + 64 * (j))
#define XB_XSUB(j)  (1280 + 64 * (j))
#define XB_XGEN(j)  (2304 + 64 * (j))
#define XB_TOP      3328
#define XB_TOPGEN   3392
#define XCD_BAR_WORDS 3456
#define XB_SPIN_CAP (1u << 20)
#define LAS __attribute__((address_space(3)))
__device__ __forceinline__ unsigned xb_ld(unsigned* p) { return __hip_atomic_load(p, __ATOMIC_RELAXED, __HIP_MEMORY_SCOPE_AGENT); }
__device__ __forceinline__ unsigned xb_add(unsigned* p, unsigned v) { return __hip_atomic_fetch_add(p, v, __ATOMIC_RELAXED, __HIP_MEMORY_SCOPE_AGENT); }
__device__ __forceinline__ unsigned xb_xcc_id() { return (unsigned)__builtin_amdgcn_s_getreg((3 << 11) | 20) & 0xFu; }
#define XB_SPIN(cond, bar) do { unsigned _sp = 0; while (cond) { __builtin_amdgcn_s_sleep(1); \
    if ((++_sp & 255u) == 0u) { if (xb_ld(&(bar)[XB_TMO])) break; if (_sp > XB_SPIN_CAP) { atomicAdd(&(bar)[XB_TMO], 1u); break; } } } } while (0)
struct XcdBarrier { unsigned* bar; unsigned x; volatile LAS unsigned* st; };
__device__ __forceinline__ XcdBarrier xcd_barrier_post(unsigned* bar, volatile LAS unsigned* st) {
  XcdBarrier b; b.bar = bar; b.x = xb_xcc_id(); b.st = st;
  if (threadIdx.x == 0) (void)xb_add(&bar[XB_XCNT(b.x)], 1u);
  return b;
}
__device__ __forceinline__ void xcd_barrier_complete(unsigned* bar, unsigned x, unsigned& nloc, unsigned& nx) {
  const unsigned G = gridDim.x * gridDim.y * gridDim.z;
  unsigned sum, cnt, mine, sp = 0u;
  for (;;) {
    sum = 0u; cnt = 0u; mine = 0u;
#pragma unroll
    for (unsigned j = 0; j < 16; ++j) { const unsigned c = xb_ld(&bar[XB_XCNT(j)]); sum += c; cnt += (c > 0u) ? 1u : 0u; mine = (j == x) ? c : mine; }
    if (sum == G) break;
    __builtin_amdgcn_s_sleep(1);
    if ((++sp & 255u) == 0u) { if (xb_ld(&bar[XB_TMO])) break; if (sp > XB_SPIN_CAP) { atomicAdd(&bar[XB_TMO], 1u); break; } }
  }
  nloc = mine > 0u ? mine : 1u; nx = cnt > 0u ? cnt : 1u;
}
__device__ __forceinline__ void xcd_barrier(const XcdBarrier& b) {
  asm volatile("s_waitcnt vmcnt(0)" ::: "memory");
  __syncthreads();
  if (threadIdx.x == 0) {
    unsigned* bar = b.bar;
    __builtin_amdgcn_s_waitcnt(0);
    unsigned nloc = b.st[0], nx = b.st[1];
    if (nloc == 0u) { xcd_barrier_complete(bar, b.x, nloc, nx); b.st[0] = nloc; b.st[1] = nx; }
    const unsigned old = xb_add(&bar[XB_XSUB(b.x)], 1u);
    const unsigned gen = old / nloc;
    if (old + 1u == (gen + 1u) * nloc) {
      __builtin_amdgcn_fence(__ATOMIC_RELEASE, "agent");
      asm volatile("s_waitcnt vmcnt(0)" ::: "memory");
      const unsigned og = xb_add(&bar[XB_TOP], 1u);
      const unsigned tg = og / nx;
      if (og + 1u == (tg + 1u) * nx) xb_add(&bar[XB_TOPGEN], 1u);
      else XB_SPIN(xb_ld(&bar[XB_TOPGEN]) == tg, bar);
      __builtin_amdgcn_fence(__ATOMIC_ACQUIRE, "agent");
      xb_add(&bar[XB_XGEN(b.x)], 1u);
      asm volatile("s_waitcnt vmcnt(0)" ::: "memory");
    } else {
      XB_SPIN(xb_ld(&bar[XB_XGEN(b.x)]) == gen, bar);
      __builtin_amdgcn_fence(__ATOMIC_ACQUIRE, "agent");
      asm volatile("s_waitcnt vmcnt(0)" ::: "memory");
    }
  }
  __syncthreads();
}
constexpr size_t OFF_BAR = 25 * MiB - 16384;
static_assert(OFF_MOD + 3 * 6144 * 4 <= OFF_BAR, "bar");

template <int ph>
__device__ __forceinline__ void run_phase(const Params& p, char* smem) {
  const int bid = blockIdx.x, G = gridDim.x;
  char* ws = p.ws;
  if constexpr (ph == 0) {
    for (int it = bid; it < 544 + 96 + 32 + 3080; it += G) {
      if (it < 544) filter_item(p, it, smem);
      else if (it < 640) mod_item(p, it - 544, smem);
      else if (it < 672) cache_item(p, it - 640);
      else {
        int t = it - 672;
        if (t < 576) transpose_item(p.w_in, 1024, DIN, (bf16_t*)(ws + OFF_WIN), t, 36, smem);
        else if ((t -= 576) < 72) transpose_item(p.w_uq, 384, 768, (bf16_t*)(ws + OFF_WUQ), t, 12, smem);
        else if ((t -= 72) < 64) transpose_item(p.w_ukv, 256, 1024, (bf16_t*)(ws + OFF_WUKV), t, 16, smem);
        else if ((t -= 64) < 256) transpose_item(p.w_out, 1024, 1024, (bf16_t*)(ws + OFF_WOUT), t, 16, smem);
        else if ((t -= 256) < 1408) transpose_item(p.w_up, 1024, 5632, (bf16_t*)(ws + OFF_WUP), t, 88, smem, true);
        else { t -= 1408; transpose_item(p.w_down, 2816, 1024, (bf16_t*)(ws + OFF_WDOWN), t, 16, smem); }
      }
    }
  } else if constexpr (ph == 1) {
    rmsmod_phase<0>(p);
  } else if constexpr (ph == 2) {
    EpiIn epi{(float*)(ws + OFF_PROJ), (bf16_t*)(ws + OFF_HYT)};
    EpiProj epr{(float*)(ws + OFF_PROJ)};
    for (int t = bid; t < 128 * 18; t += G) {
      const int nt = t % 18;
      if (nt < 5) gemm_tile<true>((const bf16_t*)(ws + OFF_H), 1024, (const bf16_t*)(ws + OFF_WIN), 1024, 1024, (t / 18) * 128, nt * 128, smem, epr);
      else gemm_tile<false>((const bf16_t*)(ws + OFF_H), 1024, (const bf16_t*)(ws + OFF_WIN), 1024, 1024, (t / 18) * 128, nt * 128, smem, epi);
    }
  } else if constexpr (ph == 3) {
    for (int it = bid; it < 512; it += G) hyena_item<0>(p, 1, it, smem);
    for (int it = bid; it < 512; it += G) hyena_item<0>(p, 0, it, smem);
    for (int it = G - 1 - bid; it < 512; it += G) token_item(p, it);
  } else if constexpr (ph == 4) {
    EpiQ eq{(bf16_t*)(ws + OFF_QRAW)};
    EpiKV ekv{(bf16_t*)(ws + OFF_KRAW), (bf16_t*)(ws + OFF_VTC), (bf16_t*)(ws + OFF_VTL)};
    for (int it = bid; it < 512; it += G) hyena_item<1>(p, 1, it, smem);
    for (int t = bid; t < 768; t += G) gemm_tile<true>((const bf16_t*)(ws + OFF_QA), 384, (const bf16_t*)(ws + OFF_WUQ), 384, 384, (t / 6) * 128, (t % 6) * 128, smem, eq);
    for (int t = bid; t < 1088; t += G) gemm_tile<false>((const bf16_t*)(ws + OFF_CKVN), 256, (const bf16_t*)(ws + OFF_WUKV), 256, 256, (t / 8) * 128, (t % 8) * 128, smem, ekv);
    for (int it = bid; it < 512; it += G) hyena_item<1>(p, 0, it, smem);
  } else if constexpr (ph == 5) {
    for (int it = bid; it < 544; it += G) qk_item(p, 512 + it);
  } else if constexpr (ph == 6) {
    for (int it = bid; it < 1024; it += G) attn_item(p, it, smem);
  } else if constexpr (ph == 7) {
    for (int it = bid; it < 512; it += G) merge_item(p, it, smem);
  } else if constexpr (ph == 8) {
    EpiOut epi{&p};
    if (G == 512) {
      const int x = bid & 7, j = bid >> 3;
      for (int r = 0; r < 2; ++r)
        gemm_tile<true>((const bf16_t*)(ws + OFF_H), 1024, (const bf16_t*)(ws + OFF_WOUT), 1024, 1024, (x * 16 + r * 8 + (j >> 3)) * 128, (j & 7) * 128, smem, epi);
    } else {
      for (int t = bid; t < 128 * 8; t += G)
        gemm_tile<true>((const bf16_t*)(ws + OFF_H), 1024, (const bf16_t*)(ws + OFF_WOUT), 1024, 1024, (t / 8) * 128, (t % 8) * 128, smem, epi);
    }
  } else if constexpr (ph == 9) {
    rmsmod_phase<1>(p);
  } else if constexpr (ph == 10) {
    for (int t = bid; t < 128 * 44; t += G) gemm_up_act_tile(p, (t / 44) * 128, (t % 44) * 128, smem);
  } else if constexpr (ph == 11) {
    for (int it = bid; it < 704; it += G) actfix_item(p, it);
  } else if constexpr (ph == 12) {
    EpiY epi{&p, 0};
    if (G == 512) {
      const int x = bid & 7, j = bid >> 3;
      for (int r = 0; r < 2; ++r)
        gemm_tile<true>((const bf16_t*)(ws + OFF_U), 2816, (const bf16_t*)(ws + OFF_WDOWN), 2816, 2816, (x * 16 + r * 8 + (j >> 3)) * 128, (j & 7) * 128, smem, epi);
    } else {
      for (int t = bid; t < 128 * 8; t += G)
        gemm_tile<true>((const bf16_t*)(ws + OFF_U), 2816, (const bf16_t*)(ws + OFF_WDOWN), 2816, 2816, (t / 8) * 128, (t % 8) * 128, smem, epi);
    }
  }
}

#if ONE_LAUNCH
template <int PH>
__device__ __forceinline__ void run_all(const Params& p, char* smem, cg::grid_group& grid, const XcdBarrier& xb) {
  run_phase<PH>(p, smem);
  if constexpr (((DBL_MASK >> PH) & 1) != 0) { xcd_barrier(xb); run_phase<PH>(p, smem); }
  if constexpr (PH < 12) {
    xcd_barrier(xb);
    run_all<PH + 1>(p, smem, grid, xb);
  }
}
constexpr int DYN_LDS = 65536 + 64;
__global__ void __launch_bounds__(256, 2) mega_kernel(Params p) {
  extern __shared__ __attribute__((aligned(16))) char smem[];
  uint4* xb_words = (uint4*)(smem + 65536);
  cg::grid_group grid = cg::this_grid();
  if (threadIdx.x == 0) *xb_words = make_uint4(0u, 0u, 0u, 0u);
  __syncthreads();
  XcdBarrier xb = xcd_barrier_post((unsigned*)(p.ws + OFF_BAR), (volatile LAS unsigned*)xb_words);
  if (p.ws == nullptr) grid.sync();
  run_all<0>(p, smem, grid, xb);
}
#else
template <int PH>
__global__ void __launch_bounds__(256, 2) phase_kernel(Params p) {
  __shared__ __attribute__((aligned(16))) char smem[SMEM_BYTES];
  run_phase<PH>(p, smem);
}
#ifndef DBG_STOP
#define DBG_STOP 15
#endif
__global__ void dump_kernel(Params p, size_t off, int count) {
  const bf16_t* src = (const bf16_t*)(p.ws + off);
  const bf16_t* src2 = (const bf16_t*)(p.ws + DBG_OFF2);
  for (int i = blockIdx.x * 256 + threadIdx.x; i < 16777216; i += gridDim.x * 256)
    p.out[i] = i < DBG_CNT ? bf2f(src[i]) : (i - DBG_CNT < DBG_CNT2 ? bf2f(src2[i - DBG_CNT]) : 0.f);
}
template <int PH>
static void launch_all(const Params& p, hipStream_t stream) {
  phase_kernel<PH><<<512, 256, 0, stream>>>(p);
  if constexpr (PH < 12) launch_all<PH + 1>(p, stream);
}
#endif

extern "C" void kernel_launch(void* const* d_in, const int* in_sizes, int n_in, void* d_out, int out_size, void* d_ws,
                              size_t ws_size, hipStream_t stream) {
  Params p{};
  const float** pp = (const float**)&p;
  for (int i = 0; i < 34; ++i) pp[i] = (const float*)d_in[i];
  p.out = (float*)d_out;
  p.ws = (char*)d_ws;
#if ONE_LAUNCH
  (void)hipMemsetAsync((char*)d_ws + OFF_BAR, 0, XCD_BAR_WORDS * 4, stream);
  static int grid_blocks = 0;
  if (!grid_blocks) {
    int dev = 0, cus = 0, per_cu = 0;
    hipGetDevice(&dev);
    hipDeviceGetAttribute(&cus, hipDeviceAttributeMultiprocessorCount, dev);
    (void)hipFuncSetAttribute((const void*)mega_kernel, hipFuncAttributeMaxDynamicSharedMemorySize, DYN_LDS);
    (void)hipOccupancyMaxActiveBlocksPerMultiprocessor(&per_cu, mega_kernel, 256, DYN_LDS);
    if (per_cu > 2) per_cu = 2;
    grid_blocks = cus * per_cu;
  }
  void* args[] = {&p};
  hipError_t e = hipLaunchCooperativeKernel((void*)mega_kernel, dim3(grid_blocks), dim3(256), args, DYN_LDS, stream);
  if (e != hipSuccess) fprintf(stderr, "cooperative launch failed: %s (grid %d)\n", hipGetErrorString(e), grid_blocks);
#else
  launch_all<0>(p, stream);
#if DBG_STOP < 15
  dump_kernel<<<1024, 256, 0, stream>>>(p, DBG_OFF, DBG_CNT);
#endif
#endif
}
```

```cpp
#include <hip/hip_runtime.h>
#include <hip/hip_cooperative_groups.h>
#include <cstdio>
namespace cg = cooperative_groups;

#define DBG_STOP 15
#define DBG_NOHY 0
#ifndef DBL_MASK
#define DBL_MASK 0
#endif
#define DBG_OFF OFF_QRAW
#define DBG_OFF2 OFF_KRAW
#define DBG_CNT 12582912
#define DBG_CNT2 0
#ifndef ONE_LAUNCH
#define ONE_LAUNCH 1
#endif

typedef unsigned short bf16_t;
typedef short bf16x8 __attribute__((ext_vector_type(8)));
typedef float f32x4 __attribute__((ext_vector_type(4)));
typedef float f32x16 __attribute__((ext_vector_type(16)));

constexpr int D = 1024, NTOK = 16384, NCTX = 8192, SEQC = 256, SEQL = 4096;
constexpr int DIN = 2208, DINP = 2304, QL = 384, KVL = 256, DFF = 2816;
constexpr int NROWKV = 17408;
constexpr size_t MiB = 1048576;

constexpr size_t OFF_WIN = 0;
constexpr size_t OFF_WUQ = OFF_WIN + (size_t)DINP * 1024 * 2;
constexpr size_t OFF_WUKV = OFF_WUQ + (size_t)768 * 384 * 2;
constexpr size_t OFF_WOUT = OFF_WUKV + (size_t)1024 * 256 * 2;
constexpr size_t OFF_WUP = OFF_WOUT + (size_t)1024 * 1024 * 2;
constexpr size_t OFF_WDOWN = OFF_WUP + (size_t)5632 * 1024 * 2;
constexpr size_t OFF_MOD = OFF_WDOWN + (size_t)1024 * 2816 * 2;
static_assert(OFF_MOD + 3 * 6144 * 4 <= 25 * MiB, "A region");
constexpr size_t OFF_RLAT = 25 * MiB;
constexpr size_t OFF_RCTX = 41 * MiB;
constexpr size_t OFF_H = 42 * MiB;
constexpr size_t OFF_ZT = 42 * MiB;
constexpr size_t OFF_QA = 58 * MiB;
constexpr size_t OFF_KPE = 70 * MiB;
constexpr size_t OFF_PROJ = 74 * MiB;
constexpr size_t OFF_QRAW = 74 * MiB;
constexpr size_t OFF_Y2T = 98 * MiB;
constexpr size_t OFF_ATTN = 116 * MiB;
constexpr size_t OFF_U = 74 * MiB;
constexpr size_t OFF_HYT = 116 * MiB;
constexpr size_t OFF_Q = 116 * MiB;
constexpr size_t OFF_KC = 140 * MiB;
constexpr size_t OFF_KL = 152 * MiB;
constexpr size_t OFF_CKVN = 164 * MiB;
constexpr size_t OFF_KRAW = 173 * MiB;
constexpr size_t OFF_VTC = 190 * MiB;
constexpr size_t OFF_VTL = 198 * MiB;
constexpr size_t OFF_ACT = 162 * MiB;

constexpr int OUT_YS = 0;
constexpr int OUT_CKV = 16777216;
constexpr int OUT_KPE = 16777216 + 2097152;

constexpr int SMEM_BYTES = 51200;

struct Params {
  const float *x_prompt, *x_sample, *cache_ckv, *cache_kpe, *c, *c_ctx, *w_ada, *b_ada, *g_mix, *w_in, *g_qa, *w_uq,
      *g_kva, *w_ukv, *g_q, *g_k, *hy_conv_w, *hy_conv_b, *filt_w1, *filt_b1, *filt_freq1, *filt_w2, *filt_b2,
      *filt_freq2, *filt_w3, *filt_bias, *g_out_att, *g_out_hy, *w_out, *g_ffn, *w_up, *ffn_conv_w, *ffn_conv_b, *w_down;
  float* out;
  char* ws;
};

typedef __bf16 bf16x2_t __attribute__((ext_vector_type(2)));
__device__ __forceinline__ unsigned pack2(float lo, float hi) {
  bf16x2_t v;
  v[0] = (__bf16)lo;
  v[1] = (__bf16)hi;
  return __builtin_bit_cast(unsigned, v);
}
__device__ __forceinline__ float bflo(unsigned u) { return __uint_as_float(u << 16); }
__device__ __forceinline__ float bfhi(unsigned u) { return __uint_as_float(u & 0xffff0000u); }
__device__ __forceinline__ float bf2f(bf16_t h) { return __uint_as_float(((unsigned)h) << 16); }
__device__ __forceinline__ bf16_t f2bf(float f) { return (bf16_t)(pack2(f, 0.f) & 0xffffu); }
__device__ __forceinline__ float wave_sum(float v) {
#pragma unroll
  for (int o = 32; o >= 1; o >>= 1) v += __shfl_xor(v, o);
  return v;
}
__device__ __forceinline__ int ltid() { int t = threadIdx.x; asm volatile("" : "+v"(t)); return t; }
__device__ __forceinline__ float sin_turns(float t) { t -= floorf(t); return __builtin_amdgcn_sinf(t); }
__device__ __forceinline__ float cos_turns(float t) { t -= floorf(t); return __builtin_amdgcn_cosf(t); }
__device__ __forceinline__ float sin_rad(float x) { return sin_turns(x * 0.15915494309189535f); }
__device__ __forceinline__ const float* xrow(const Params& p, int row) {
  return row < NCTX ? p.x_prompt + (size_t)row * D : p.x_sample + (size_t)(row - NCTX) * D;
}
__device__ __forceinline__ int modidx(int row) { return row < NCTX ? 0 : 1 + ((row - NCTX) >> 12); }

template <bool SWAP>
__device__ __forceinline__ void gemm_main(const bf16_t* __restrict__ A, int lda, const bf16_t* __restrict__ Bt, int ldb,
                                          int K, int m0, int n0, char* smem, f32x4 (&acc)[4][4]) {
  const int tid = ltid(), lane = tid & 63, wid = tid >> 6, wr = wid >> 1, wc = wid & 1;
  const int fr = lane & 15, fq = lane >> 4;
  bf16_t* sbase = (bf16_t*)smem;
#pragma unroll
  for (int m = 0; m < 4; ++m)
#pragma unroll
    for (int n = 0; n < 4; ++n) acc[m][n] = (f32x4){0.f, 0.f, 0.f, 0.f};
  const int lr = tid >> 3, lc = (tid & 7) * 8;
  const bf16_t* ga = A + (size_t)(m0 + lr) * lda + lc;
  const bf16_t* gb = Bt + (size_t)(n0 + lr) * ldb + lc;
  const size_t sa32 = (size_t)32 * lda, sb32 = (size_t)32 * ldb;
  uint4 ra0 = *(const uint4*)(ga), ra1 = *(const uint4*)(ga + sa32), ra2 = *(const uint4*)(ga + 2 * sa32), ra3 = *(const uint4*)(ga + 3 * sa32);
  uint4 rb0 = *(const uint4*)(gb), rb1 = *(const uint4*)(gb + sb32), rb2 = *(const uint4*)(gb + 2 * sb32), rb3 = *(const uint4*)(gb + 3 * sb32);
  const int nk = K >> 6;
  const int woff = lr * 64 + (((tid & 7) ^ (lr & 7)) * 8);
  const int aoff = (wr * 64 + fr) * 64, boff = 8192 + (wc * 64 + fr) * 64;
  __syncthreads();
  {
    bf16_t* wa = sbase + woff;
    *(uint4*)(wa) = ra0; *(uint4*)(wa + 32 * 64) = ra1; *(uint4*)(wa + 64 * 64) = ra2; *(uint4*)(wa + 96 * 64) = ra3;
    *(uint4*)(wa + 8192) = rb0; *(uint4*)(wa + 8192 + 32 * 64) = rb1; *(uint4*)(wa + 8192 + 64 * 64) = rb2; *(uint4*)(wa + 8192 + 96 * 64) = rb3;
  }
  if (nk > 1) {
    ga += 64; gb += 64;
    ra0 = *(const uint4*)(ga); ra1 = *(const uint4*)(ga + sa32); ra2 = *(const uint4*)(ga + 2 * sa32); ra3 = *(const uint4*)(ga + 3 * sa32);
    rb0 = *(const uint4*)(gb); rb1 = *(const uint4*)(gb + sb32); rb2 = *(const uint4*)(gb + 2 * sb32); rb3 = *(const uint4*)(gb + 3 * sb32);
  }
  __syncthreads();
  for (int kt = 0; kt < nk; ++kt) {
    const bf16_t* cur = sbase + (kt & 1) * 16384;
    bf16x8 af[2][4], bfr[2][4];
#pragma unroll
    for (int ks = 0; ks < 2; ++ks) {
#pragma unroll
      for (int m = 0; m < 4; ++m) af[ks][m] = *(const bf16x8*)(cur + aoff + m * 16 * 64 + (((ks * 4 + fq) ^ (fr & 7)) * 8));
#pragma unroll
      for (int n = 0; n < 4; ++n) bfr[ks][n] = *(const bf16x8*)(cur + boff + n * 16 * 64 + (((ks * 4 + fq) ^ (fr & 7)) * 8));
    }
    __builtin_amdgcn_sched_barrier(0);
    {
      bf16_t* wa = sbase + ((kt + 1) & 1) * 16384 + woff;
      *(uint4*)(wa) = ra0; *(uint4*)(wa + 32 * 64) = ra1; *(uint4*)(wa + 64 * 64) = ra2; *(uint4*)(wa + 96 * 64) = ra3;
      *(uint4*)(wa + 8192) = rb0; *(uint4*)(wa + 8192 + 32 * 64) = rb1; *(uint4*)(wa + 8192 + 64 * 64) = rb2; *(uint4*)(wa + 8192 + 96 * 64) = rb3;
      const int adv = (kt + 2 < nk) ? 64 : 0;
      ga += adv; gb += adv;
      ra0 = *(const uint4*)(ga); ra1 = *(const uint4*)(ga + sa32); ra2 = *(const uint4*)(ga + 2 * sa32); ra3 = *(const uint4*)(ga + 3 * sa32);
      rb0 = *(const uint4*)(gb); rb1 = *(const uint4*)(gb + sb32); rb2 = *(const uint4*)(gb + 2 * sb32); rb3 = *(const uint4*)(gb + 3 * sb32);
    }
#pragma unroll
    for (int ks = 0; ks < 2; ++ks)
#pragma unroll
      for (int m = 0; m < 4; ++m)
#pragma unroll
        for (int n = 0; n < 4; ++n) {
          if (SWAP) acc[m][n] = __builtin_amdgcn_mfma_f32_16x16x32_bf16(bfr[ks][n], af[ks][m], acc[m][n], 0, 0, 0);
          else acc[m][n] = __builtin_amdgcn_mfma_f32_16x16x32_bf16(af[ks][m], bfr[ks][n], acc[m][n], 0, 0, 0);
        }
#pragma unroll
    for (int i = 0; i < 8; ++i) { __builtin_amdgcn_sched_group_barrier(0x008, 2, 0); __builtin_amdgcn_sched_group_barrier(0x200, 1, 0); }
#pragma unroll
    for (int i = 0; i < 8; ++i) { __builtin_amdgcn_sched_group_barrier(0x008, 2, 0); __builtin_amdgcn_sched_group_barrier(0x020, 1, 0); }
    __builtin_amdgcn_sched_barrier(0);
    if (kt + 1 < nk) __syncthreads();
  }
}
template <bool SWAP, class Epi>
__device__ __forceinline__ void gemm_tile(const bf16_t* __restrict__ A, int lda, const bf16_t* __restrict__ Bt, int ldb,
                                          int K, int m0, int n0, char* smem, const Epi& epi) {
  f32x4 acc[4][4];
  gemm_main<SWAP>(A, lda, Bt, ldb, K, m0, n0, smem, acc);
  const int tid = ltid(), lane = tid & 63, wid = tid >> 6, wr = wid >> 1, wc = wid & 1;
  const int fr = lane & 15, fq = lane >> 4;
#pragma unroll
  for (int m = 0; m < 4; ++m)
#pragma unroll
    for (int n = 0; n < 4; ++n) {
      if (SWAP) epi(m0 + wr * 64 + m * 16 + fr, n0 + wc * 64 + n * 16 + fq * 4, acc[m][n]);
      else epi(m0 + wr * 64 + m * 16 + fq * 4, n0 + wc * 64 + n * 16 + fr, acc[m][n]);
    }
}

template <int CTRL>
__device__ __forceinline__ float dpp_keep(float keep, float v) {
  return __int_as_float(__builtin_amdgcn_update_dpp(__float_as_int(keep), __float_as_int(v), CTRL, 0xF, 0xF, false));
}
template <int CTRL>
__device__ __forceinline__ float dpp_ror(float v) {
  return __int_as_float(__builtin_amdgcn_update_dpp(0, __float_as_int(v), CTRL, 0xF, 0xF, false));
}
constexpr size_t OFF_EDGE = 162 * MiB;
__device__ __forceinline__ void gemm_up_act_tile(const Params& p, int m0, int n0, char* smem) {
  f32x4 acc[4][4];
  gemm_main<true>((const bf16_t*)(p.ws + OFF_H), 1024, (const bf16_t*)(p.ws + OFF_WUP), 1024, 1024, m0, n0, smem, acc);
  const int tid = ltid(), lane = tid & 63, wid = tid >> 6, wr = wid >> 1, wc = wid & 1;
  const int fr = lane & 15, fq = lane >> 4;
  bf16_t* act = (bf16_t*)(p.ws + OFF_U);
  bf16_t* edge = (bf16_t*)(p.ws + OFF_EDGE);
  const int rowbase = m0 + wr * 64, wt = rowbase >> 6;
#pragma unroll
  for (int i = 0; i < 2; ++i) {
    const int cperm = n0 + wc * 64 + 32 * i;
    const int j0 = (cperm >> 5) * 16 + 4 * fq;
    const float4 wa0 = *(const float4*)(p.ffn_conv_w + j0), wa1 = *(const float4*)(p.ffn_conv_w + 5632 + j0), wa2 = *(const float4*)(p.ffn_conv_w + 11264 + j0);
    const float4 wg0 = *(const float4*)(p.ffn_conv_w + 2816 + j0), wg1 = *(const float4*)(p.ffn_conv_w + 5632 + 2816 + j0), wg2 = *(const float4*)(p.ffn_conv_w + 11264 + 2816 + j0);
    const float4 ba = *(const float4*)(p.ffn_conv_b + j0), bg = *(const float4*)(p.ffn_conv_b + 2816 + j0);
    const float w0a[4] = {wa0.x, wa0.y, wa0.z, wa0.w}, w1a[4] = {wa1.x, wa1.y, wa1.z, wa1.w}, w2a[4] = {wa2.x, wa2.y, wa2.z, wa2.w};
    const float w0g[4] = {wg0.x, wg0.y, wg0.z, wg0.w}, w1g[4] = {wg1.x, wg1.y, wg1.z, wg1.w}, w2g[4] = {wg2.x, wg2.y, wg2.z, wg2.w};
    const float bba[4] = {ba.x, ba.y, ba.z, ba.w}, bbg[4] = {bg.x, bg.y, bg.z, bg.w};
#pragma unroll
    for (int m = 0; m < 4; ++m) {
      float o[4];
#pragma unroll
      for (int e = 0; e < 4; ++e) {
        const float a = acc[m][2 * i][e], g = acc[m][2 * i + 1][e];
        float au2 = 0.f, gu2 = 0.f, ad2 = 0.f, gd2 = 0.f;
        if (m > 0) { au2 = dpp_ror<0x121>(acc[m - 1][2 * i][e]); gu2 = dpp_ror<0x121>(acc[m - 1][2 * i + 1][e]); }
        if (m < 3) { ad2 = dpp_ror<0x12F>(acc[m + 1][2 * i][e]); gd2 = dpp_ror<0x12F>(acc[m + 1][2 * i + 1][e]); }
        const float au = dpp_keep<0x111>(au2, a), gu = dpp_keep<0x111>(gu2, g), ad = dpp_keep<0x101>(ad2, a), gd = dpp_keep<0x101>(gd2, g);
        const float ca = w0a[e] * au + w1a[e] * a + w2a[e] * ad + bba[e];
        const float cgv = w0g[e] * gu + w1g[e] * g + w2g[e] * gd + bbg[e];
        o[e] = ca * __builtin_amdgcn_rcpf(1.f + __expf(-ca)) * cgv;
      }
      const int lr64 = m * 16 + fr, row = rowbase + lr64;
      if (lr64 >= 1 && lr64 <= 62) *(uint2*)(act + (size_t)row * 2816 + j0) = make_uint2(pack2(o[0], o[1]), pack2(o[2], o[3]));
      if (lr64 <= 1 || lr64 >= 62) {
        const int slot = lr64 <= 1 ? lr64 : lr64 - 60;
        bf16_t* er = edge + (size_t)(wt * 4 + slot) * 5632;
        *(uint2*)(er + j0) = make_uint2(pack2(acc[m][2 * i][0], acc[m][2 * i][1]), pack2(acc[m][2 * i][2], acc[m][2 * i][3]));
        *(uint2*)(er + 2816 + j0) = make_uint2(pack2(acc[m][2 * i + 1][0], acc[m][2 * i + 1][1]), pack2(acc[m][2 * i + 1][2], acc[m][2 * i + 1][3]));
      }
    }
  }
}

__device__ __forceinline__ void transpose_item(const float* __restrict__ W, int K, int N, bf16_t* __restrict__ WT, int tile, int ntn, char* smem, bool perm = false) {
  float* s = (float*)smem;
  const int tk = tile / ntn, tn = tile % ntn, tid = ltid();
  const int k0 = tk * 64, n0 = tn * 64;
  __syncthreads();
  {
    const int r = tid >> 4, c4 = (tid & 15) * 4;
#pragma unroll
    for (int i = 0; i < 4; ++i) {
      const int k = r + 16 * i;
      float4 v = make_float4(0.f, 0.f, 0.f, 0.f);
      if (n0 + c4 < N) { const f32x4 t = __builtin_nontemporal_load((const f32x4*)(W + (size_t)(k0 + k) * N + n0 + c4)); v = make_float4(t[0], t[1], t[2], t[3]); }
      s[k * 65 + c4 + 0] = v.x; s[k * 65 + c4 + 1] = v.y; s[k * 65 + c4 + 2] = v.z; s[k * 65 + c4 + 3] = v.w;
    }
  }
  __syncthreads();
  {
    const int n = tid >> 2, kc = (tid & 3) * 16;
    unsigned o[8];
#pragma unroll
    for (int i = 0; i < 8; ++i) o[i] = pack2(s[(kc + 2 * i) * 65 + n], s[(kc + 2 * i + 1) * 65 + n]);
    int nr = n0 + n;
    if (perm) { const int hf = nr >= 2816 ? 1 : 0, cc = nr - hf * 2816; nr = 32 * (cc >> 4) + 16 * hf + (cc & 15); }
    uint4* dst = (uint4*)(WT + (size_t)nr * K + k0 + kc);
    dst[0] = make_uint4(o[0], o[1], o[2], o[3]);
    dst[1] = make_uint4(o[4], o[5], o[6], o[7]);
  }
}

__device__ __forceinline__ void mod_item(const Params& p, int item, char* smem) {
  float* s = (float*)smem;
  float* red = s + 3072;
  const int tid = ltid();
  __syncthreads();
  for (int e = tid; e < 3072; e += 256) {
    const int v = e >> 10, k = e & 1023;
    const float x = (v == 0) ? p.c_ctx[k] : p.c[(v - 1) * D + k];
    s[e] = x / (1.f + __expf(-x));
  }
  __syncthreads();
  const int jl = tid & 63, kq = tid >> 6, j = item * 64 + jl, k0 = kq * 256;
  float a0 = 0.f, a1 = 0.f, a2 = 0.f;
#pragma unroll 32
  for (int k = 0; k < 256; ++k) {
    const float w = __builtin_nontemporal_load(p.w_ada + (size_t)(k0 + k) * 6144 + j);
    a0 += s[k0 + k] * w; a1 += s[1024 + k0 + k] * w; a2 += s[2048 + k0 + k] * w;
  }
  red[(kq * 3 + 0) * 64 + jl] = a0; red[(kq * 3 + 1) * 64 + jl] = a1; red[(kq * 3 + 2) * 64 + jl] = a2;
  __syncthreads();
  if (tid < 192) {
    const int v = tid >> 6;
    const float r = red[(0 * 3 + v) * 64 + jl] + red[(1 * 3 + v) * 64 + jl] + red[(2 * 3 + v) * 64 + jl] + red[(3 * 3 + v) * 64 + jl];
    ((float*)(p.ws + OFF_MOD))[v * 6144 + j] = r + p.b_ada[j];
  }
}

__device__ __forceinline__ void filter_item(const Params& p, int item2, char* smem) {
  const int item = item2 >> 1, chalf = item2 & 1;
  int n, p0; bf16_t* R;
  if (item < 256) { n = 4096; p0 = item * 16; R = (bf16_t*)(p.ws + OFF_RLAT); }
  else { n = 256; p0 = (item - 256) * 16; R = (bf16_t*)(p.ws + OFF_RCTX); }
  const int n2 = 2 * n, tid = ltid();
  float* z = (float*)smem;
  float* h1 = z + 16 * 36;
  float* h2 = h1 + 16 * 64;
  __syncthreads();
#pragma unroll 1
  for (int e = tid; e < 16 * 33; e += 256) {
    const int pp = e / 33, f = e % 33, pos = p0 + pp;
    float val;
    if (f == 0) val = (float)pos / (float)(n - 1);
    else {
      const int k = (f - 1) & 15;
      const float band = 1e-4f + (float)k * ((15.f - 1e-4f) / 15.f);
      const float turns = band * ((float)pos / (float)n);
      val = (f <= 16) ? cos_turns(turns) : -sin_turns(turns);
    }
    z[pp * 36 + f] = val;
  }
  __syncthreads();
  {
    const int j = tid & 63, ppb = tid >> 6;
    float a0, a1, a2, a3;
    a0 = a1 = a2 = a3 = p.filt_b1[j];
#pragma unroll
    for (int f = 0; f < 33; ++f) {
      const float w = p.filt_w1[f * 64 + j];
      a0 += z[(ppb + 0) * 36 + f] * w; a1 += z[(ppb + 4) * 36 + f] * w; a2 += z[(ppb + 8) * 36 + f] * w; a3 += z[(ppb + 12) * 36 + f] * w;
    }
    const float fq1 = p.filt_freq1[j];
    h1[(ppb + 0) * 64 + j] = sin_rad(fq1 * a0); h1[(ppb + 4) * 64 + j] = sin_rad(fq1 * a1);
    h1[(ppb + 8) * 64 + j] = sin_rad(fq1 * a2); h1[(ppb + 12) * 64 + j] = sin_rad(fq1 * a3);
    __syncthreads();
    a0 = a1 = a2 = a3 = p.filt_b2[j];
#pragma unroll 32
    for (int k = 0; k < 64; ++k) {
      const float w = p.filt_w2[k * 64 + j];
      a0 += h1[(ppb + 0) * 64 + k] * w; a1 += h1[(ppb + 4) * 64 + k] * w; a2 += h1[(ppb + 8) * 64 + k] * w; a3 += h1[(ppb + 12) * 64 + k] * w;
    }
    const float fq2 = p.filt_freq2[j];
    h2[j * 16 + ppb + 0] = sin_rad(fq2 * a0); h2[j * 16 + ppb + 4] = sin_rad(fq2 * a1);
    h2[j * 16 + ppb + 8] = sin_rad(fq2 * a2); h2[j * 16 + ppb + 12] = sin_rad(fq2 * a3);
  }
  __syncthreads();
  const float mind = -3.0701134573253946f, maxd = -15.350567286626973f;
  {
    const int colb = tid + 256 * 4 * chalf;
    float acc[4][16];
#pragma unroll
    for (int c4 = 0; c4 < 4; ++c4)
#pragma unroll
      for (int i = 0; i < 16; ++i) acc[c4][i] = 0.f;
#pragma unroll 8
    for (int k = 0; k < 64; ++k) {
      const float4 ha = *(const float4*)(h2 + k * 16), hb = *(const float4*)(h2 + k * 16 + 4), hc = *(const float4*)(h2 + k * 16 + 8), hd = *(const float4*)(h2 + k * 16 + 12);
#pragma unroll
      for (int c4 = 0; c4 < 4; ++c4) {
        const float w = p.filt_w3[k * 2048 + colb + 256 * c4];
        acc[c4][0] += ha.x * w; acc[c4][1] += ha.y * w; acc[c4][2] += ha.z * w; acc[c4][3] += ha.w * w;
        acc[c4][4] += hb.x * w; acc[c4][5] += hb.y * w; acc[c4][6] += hb.z * w; acc[c4][7] += hb.w * w;
        acc[c4][8] += hc.x * w; acc[c4][9] += hc.y * w; acc[c4][10] += hc.z * w; acc[c4][11] += hc.w * w;
        acc[c4][12] += hd.x * w; acc[c4][13] += hd.y * w; acc[c4][14] += hd.z * w; acc[c4][15] += hd.w * w;
      }
    }
#pragma unroll
    for (int c4 = 0; c4 < 4; ++c4) {
      const int col = colb + 256 * c4, o = col >> 10, c = col & 511;
      const float delta = fabsf(mind + (float)c * ((maxd - mind) / 511.f));
      bf16_t* Rrow = R + (size_t)(o * 512 + c) * n2;
      float v[16];
#pragma unroll
      for (int i = 0; i < 16; ++i) {
        const float t = (float)(p0 + i) / (float)(n - 1);
        v[i] = acc[c4][i] * (__expf(-t * delta) + 0.05f);
      }
      if (c4 < 2) {
        uint4* dst = (uint4*)(Rrow + (n - 16 - p0));
        dst[0] = make_uint4(pack2(v[15], v[14]), pack2(v[13], v[12]), pack2(v[11], v[10]), pack2(v[9], v[8]));
        dst[1] = make_uint4(pack2(v[7], v[6]), pack2(v[5], v[4]), pack2(v[3], v[2]), pack2(v[1], v[0]));
      } else {
        if (p0 == 0) Rrow[n2 - 1] = 0; else Rrow[n - 1 + p0] = f2bf(v[0]);
        bf16_t* d = Rrow + n + p0;
        *(uint4*)d = make_uint4(pack2(v[1], v[2]), pack2(v[3], v[4]), pack2(v[5], v[6]), pack2(v[7], v[8]));
        *(uint2*)(d + 8) = make_uint2(pack2(v[9], v[10]), pack2(v[11], v[12]));
        *(unsigned*)(d + 12) = pack2(v[13], v[14]);
        d[14] = f2bf(v[15]);
      }
    }
  }
}

__device__ __forceinline__ void cache_item(const Params& p, int item) {
  const int tid = ltid(), r0 = item * 32;
  bf16_t* ckvn = (bf16_t*)(p.ws + OFF_CKVN);
#pragma unroll 2
  for (int e = tid; e < 32 * 64; e += 256) {
    const int r = r0 + (e >> 6), c4 = (e & 63) * 4;
    const float4 v = *(const float4*)(p.cache_ckv + (size_t)r * 256 + c4);
    *(uint2*)(ckvn + (size_t)(NTOK + r) * 256 + c4) = make_uint2(pack2(v.x, v.y), pack2(v.z, v.w));
  }
}

template <int WHICH>
__device__ __forceinline__ void rmsmod_phase(const Params& p) {
  const int tid = ltid(), lane = tid & 63, wid = tid >> 6;
  const int gw = blockIdx.x * 4 + wid, tw = gridDim.x * 4;
  const float* g = WHICH == 0 ? p.g_mix : p.g_ffn;
  const float* mod = (const float*)(p.ws + OFF_MOD);
  bf16_t* h = (bf16_t*)(p.ws + OFF_H);
  float4 nv0, nv1, nv2, nv3;
  {
    const float* src = WHICH == 0 ? xrow(p, gw) : p.out + (size_t)gw * D;
    nv0 = ((const float4*)src)[lane]; nv1 = ((const float4*)src)[lane + 64]; nv2 = ((const float4*)src)[lane + 128]; nv3 = ((const float4*)src)[lane + 192];
  }
  for (int row = gw; row < NTOK; row += tw) {
    float4 v[4] = {nv0, nv1, nv2, nv3};
    if (row + tw < NTOK) {
      const float* src = WHICH == 0 ? xrow(p, row + tw) : p.out + (size_t)(row + tw) * D;
      nv0 = ((const float4*)src)[lane]; nv1 = ((const float4*)src)[lane + 64]; nv2 = ((const float4*)src)[lane + 128]; nv3 = ((const float4*)src)[lane + 192];
    }
    float ss = 0.f;
#pragma unroll
    for (int i = 0; i < 4; ++i) ss += v[i].x * v[i].x + v[i].y * v[i].y + v[i].z * v[i].z + v[i].w * v[i].w;
    ss = wave_sum(ss);
    const float r = rsqrtf(ss * (1.f / 1024.f) + 1e-6f);
    const float* mv = mod + modidx(row) * 6144 + (WHICH == 0 ? 0 : 3 * 1024);
#pragma unroll
    for (int i = 0; i < 4; ++i) {
      const int e = 4 * (lane + 64 * i);
      const float4 g4 = *(const float4*)(g + e), sh = *(const float4*)(mv + e), sc = *(const float4*)(mv + 1024 + e);
      const float y0 = v[i].x * r * g4.x * (1.f + sc.x) + sh.x, y1 = v[i].y * r * g4.y * (1.f + sc.y) + sh.y;
      const float y2 = v[i].z * r * g4.z * (1.f + sc.z) + sh.z, y3 = v[i].w * r * g4.w * (1.f + sc.w) + sh.w;
      *(uint2*)(h + (size_t)row * D + e) = make_uint2(pack2(y0, y1), pack2(y2, y3));
    }
  }
}

struct EpiIn {
  float* proj; bf16_t* hyT;
  __device__ __forceinline__ void operator()(int row0, int col, const f32x4& v) const {
    if (col < 672) {
#pragma unroll
      for (int j = 0; j < 4; ++j) proj[(size_t)(row0 + j) * 672 + col] = v[j];
    } else if (col < DIN) {
      *(uint2*)(hyT + (size_t)(col - 672) * NTOK + row0) = make_uint2(pack2(v[0], v[1]), pack2(v[2], v[3]));
    }
  }
};
struct EpiProj {
  float* proj;
  __device__ __forceinline__ void operator()(int row, int col0, const f32x4& v) const { *(f32x4*)(proj + (size_t)row * 672 + col0) = v; }
};
struct EpiQ {
  bf16_t* q;
  __device__ __forceinline__ void operator()(int row, int col0, const f32x4& v) const {
    *(uint2*)(q + (size_t)row * 768 + col0) = make_uint2(pack2(v[0], v[1]), pack2(v[2], v[3]));
  }
};
struct EpiKV {
  bf16_t *kraw, *vtc, *vtl;
  __device__ __forceinline__ void operator()(int row0, int col, const f32x4& v) const {
    const int head = col >> 7, cc = col & 127;
    if (cc < 64) {
#pragma unroll
      for (int j = 0; j < 4; ++j) kraw[(size_t)(row0 + j) * 512 + head * 64 + cc] = f2bf(v[j]);
    } else {
      const int dv = cc - 64;
      bf16_t* dst;
      if (row0 < NCTX) dst = vtc + ((size_t)((row0 >> 8) * 8 + head) * 64 + dv) * 256 + (row0 & 255);
      else if (row0 < NTOK) { const int r = row0 - NCTX; dst = vtl + ((size_t)((r >> 12) * 8 + head) * 64 + dv) * 4608 + (r & 4095); }
      else { const int r = row0 - NTOK; dst = vtl + ((size_t)((r >> 9) * 8 + head) * 64 + dv) * 4608 + 4096 + (r & 511); }
      *(uint2*)dst = make_uint2(pack2(v[0], v[1]), pack2(v[2], v[3]));
    }
  }
};
struct EpiOut {
  const Params* p;
  __device__ __forceinline__ void operator()(int row, int col0, const f32x4& v) const {
    const float4 x = *(const float4*)(xrow(*p, row) + col0);
    const float4 m = *(const float4*)((const float*)(p->ws + OFF_MOD) + modidx(row) * 6144 + 2 * 1024 + col0);
    *(float4*)(p->out + (size_t)row * D + col0) = make_float4(x.x + m.x * v[0], x.y + m.y * v[1], x.z + m.z * v[2], x.w + m.w * v[3]);
  }
};
struct EpiU {
  bf16_t* u;
  __device__ __forceinline__ void operator()(int row, int col0, const f32x4& v) const {
    *(uint2*)(u + (size_t)row * 5632 + col0) = make_uint2(pack2(v[0], v[1]), pack2(v[2], v[3]));
  }
};
struct EpiY {
  const Params* p; int half;
  __device__ __forceinline__ void operator()(int row, int col0, const f32x4& v) const {
    const int grow = half * 8192 + row;
    float4* dst = (float4*)(p->out + (size_t)grow * D + col0);
    const float4 x = *dst;
    const float4 m = *(const float4*)((const float*)(p->ws + OFF_MOD) + modidx(grow) * 6144 + 5 * 1024 + col0);
    *dst = make_float4(x.x + m.x * v[0], x.y + m.y * v[1], x.z + m.z * v[2], x.w + m.w * v[3]);
  }
};

__device__ __forceinline__ void token_item(const Params& p, int item) {
  const int tid = ltid(), lane = tid & 63, wid = tid >> 6;
  const float* proj = (const float*)(p.ws + OFF_PROJ);
  bf16_t* qa = (bf16_t*)(p.ws + OFF_QA);
  bf16_t* ckvn = (bf16_t*)(p.ws + OFF_CKVN);
  float* kpe = (float*)(p.ws + OFF_KPE);
  for (int tt = 0; tt < 8; ++tt) {
    const int token = item * 32 + wid * 8 + tt;
    const float* pr = proj + (size_t)token * 672;
    float2 q[3];
    float ss = 0.f;
#pragma unroll
    for (int i = 0; i < 3; ++i) { q[i] = *(const float2*)(pr + lane * 2 + 128 * i); ss += q[i].x * q[i].x + q[i].y * q[i].y; }
    ss = wave_sum(ss);
    const float r = rsqrtf(ss * (1.f / 384.f) + 1e-6f);
#pragma unroll
    for (int i = 0; i < 3; ++i) {
      const int e = lane * 2 + 128 * i;
      *(unsigned*)(qa + (size_t)token * 384 + e) = pack2(q[i].x * r * p.g_qa[e], q[i].y * r * p.g_qa[e + 1]);
    }
    const float4 kv = *(const float4*)(pr + 384 + lane * 4);
    float s2 = wave_sum(kv.x * kv.x + kv.y * kv.y + kv.z * kv.z + kv.w * kv.w);
    const float r2 = rsqrtf(s2 * (1.f / 256.f) + 1e-6f);
    const float4 g = *(const float4*)(p.g_kva + lane * 4);
    const float4 y = make_float4(kv.x * r2 * g.x, kv.y * r2 * g.y, kv.z * r2 * g.z, kv.w * r2 * g.w);
    *(uint2*)(ckvn + (size_t)token * 256 + lane * 4) = make_uint2(pack2(y.x, y.y), pack2(y.z, y.w));
    if (token < NCTX) *(float4*)(p.out + OUT_CKV + (size_t)token * 256 + lane * 4) = y;
    if (lane < 32) {
      const float kp = pr[640 + lane];
      kpe[(size_t)token * 32 + lane] = kp;
      if (token < NCTX) p.out[OUT_KPE + (size_t)token * 32 + lane] = kp;
    }
  }
}

template <int ORDER>
__device__ __forceinline__ void hyena_item(const Params& p, int grp, int c, char* smem) {
  const int tid = ltid(), lane = tid & 63, wid = tid >> 6, fr = lane & 15, fq = lane >> 4;
  const int n = grp ? SEQL : SEQC, nb = n >> 6, L = n;
  const bf16_t* Rrow = (const bf16_t*)(p.ws + (grp ? OFF_RLAT : OFF_RCTX)) + (size_t)(ORDER * 512 + c) * (2 * n);
  const bf16_t* hyT = (const bf16_t*)(p.ws + OFF_HYT);
  bf16_t* sU = (bf16_t*)smem;
  unsigned* sR0 = (unsigned*)(smem + 18432);
  unsigned* sR1 = (unsigned*)(smem + 18432 + 16384);
  const int tok0 = grp * 8192;
  __syncthreads();
  for (int ch = tid; ch < (2 * n) / 8; ch += 256) *(uint4*)((bf16_t*)sR0 + ch * 8) = *(const uint4*)(Rrow + ch * 8);
  if (ORDER == 0) {
    const bf16_t* raw = hyT + (size_t)c * NTOK + tok0;
    const float w0 = p.hy_conv_w[c], w1 = p.hy_conv_w[1536 + c], w2 = p.hy_conv_w[3072 + c], b = p.hy_conv_b[c];
    for (int ch = tid; ch < 1024; ch += 256) {
      const int t = ch * 8, pos = t & (L - 1);
      const uint4 rv = *(const uint4*)(raw + t);
      float x[10];
      x[0] = pos == 0 ? 0.f : bf2f(raw[t - 1]);
      x[1] = bflo(rv.x); x[2] = bfhi(rv.x); x[3] = bflo(rv.y); x[4] = bfhi(rv.y);
      x[5] = bflo(rv.z); x[6] = bfhi(rv.z); x[7] = bflo(rv.w); x[8] = bfhi(rv.w);
      x[9] = (pos + 8 == L) ? 0.f : bf2f(raw[t + 8]);
      float u[8];
#pragma unroll
      for (int i = 0; i < 8; ++i) u[i] = w0 * x[i] + w1 * x[i + 1] + w2 * x[i + 2] + b;
      *(uint4*)(sU + (ch >> 3) * 64 + (((ch & 7) ^ ((ch >> 3) & 7)) * 8)) = make_uint4(pack2(u[0], u[1]), pack2(u[2], u[3]), pack2(u[4], u[5]), pack2(u[6], u[7]));
    }
  } else {
    const bf16_t* zr = (const bf16_t*)(p.ws + OFF_ZT) + (size_t)c * NTOK + tok0;
    for (int ch = tid; ch < 1024; ch += 256) *(uint4*)(sU + (ch >> 3) * 64 + (((ch & 7) ^ ((ch >> 3) & 7)) * 8)) = *(const uint4*)(zr + ch * 8);
  }
  __syncthreads();
  for (int k = tid; k < n; k += 256) {
    const unsigned a = sR0[k], b2 = (k + 1 < n) ? sR0[k + 1] : 0u;
    sR1[k] = (a >> 16) | (b2 << 16);
  }
  __syncthreads();

  f32x4 acc[4][2];
#pragma unroll
  for (int m = 0; m < 4; ++m) { acc[m][0] = (f32x4){0.f, 0.f, 0.f, 0.f}; acc[m][1] = (f32x4){0.f, 0.f, 0.f, 0.f}; }
  const unsigned* abase = (fr & 1) ? (sR0 + ((n - 1 - fr) >> 1) + 4 * fq) : (sR1 + ((n - 2 - fr) >> 1) + 4 * fq);
  const int col0 = 32 * wid + fr, col1 = col0 + 16;
  const int i0 = col0 & (nb - 1), i1 = col1 & (nb - 1);
  for (int d = -(nb - 1); d <= nb - 1; ++d) {
    const bool v0 = (unsigned)(i0 - d) < (unsigned)nb, v1 = (unsigned)(i1 - d) < (unsigned)nb;
    const bool any0 = __ballot(v0) != 0ull, any1 = __ballot(v1) != 0ull;
    if (!any0 && !any1) continue;
    bf16x8 F[6];
    const unsigned* ap = abase - 32 * d + 16;
#pragma unroll
    for (int idx = 0; idx < 6; ++idx) {
      const unsigned* q = ap - 8 * idx;
      union { unsigned u[4]; bf16x8 v; } cv;
      cv.u[0] = q[0]; cv.u[1] = q[1]; cv.u[2] = q[2]; cv.u[3] = q[3];
      F[idx] = cv.v;
    }
#pragma unroll
    for (int nt = 0; nt < 2; ++nt) {
      if (!(nt ? any1 : any0)) continue;
      const bool vv = nt ? v1 : v0;
      const int srow = (nt ? col1 : col0) - d;
      const bf16_t* up = sU + srow * 64;
#pragma unroll
      for (int ks = 0; ks < 2; ++ks) {
        bf16x8 bf = (bf16x8){0, 0, 0, 0, 0, 0, 0, 0};
        if (vv) bf = *(const bf16x8*)(up + (((ks * 4 + fq) ^ (srow & 7)) * 8));
#pragma unroll
        for (int m = 0; m < 4; ++m)
          acc[m][nt] = __builtin_amdgcn_mfma_f32_16x16x32_bf16(F[m + 2 - 2 * ks], bf, acc[m][nt], 0, 0, 0);
      }
    }
  }
  const float skip = p.filt_bias[ORDER * 512 + c];
  const int gcol = (ORDER == 0 ? 512 : 1024) + c;
  const bf16_t* graw = hyT + (size_t)gcol * NTOK + tok0;
  const float w0 = p.hy_conv_w[gcol], w1 = p.hy_conv_w[1536 + gcol], w2 = p.hy_conv_w[3072 + gcol], b = p.hy_conv_b[gcol];
  bf16_t* outT = (bf16_t*)(p.ws + (ORDER == 0 ? OFF_ZT : OFF_Y2T)) + (size_t)c * NTOK + tok0;
#pragma unroll
  for (int nt = 0; nt < 2; ++nt) {
    const int col = nt ? col1 : col0;
#pragma unroll
    for (int m = 0; m < 4; ++m) {
      const int t = col * 64 + 16 * m + 4 * fq, pos = t & (L - 1);
      const uint2 uu = *(const uint2*)(sU + col * 64 + (((2 * m + (fq >> 1)) ^ (col & 7)) * 8) + 4 * (fq & 1));
      const uint2 gv = *(const uint2*)(graw + t);
      float x[6];
      x[0] = pos == 0 ? 0.f : bf2f(graw[t - 1]);
      x[1] = bflo(gv.x); x[2] = bfhi(gv.x); x[3] = bflo(gv.y); x[4] = bfhi(gv.y);
      x[5] = (pos + 4 == L) ? 0.f : bf2f(graw[t + 4]);
      const float u4[4] = {bflo(uu.x), bfhi(uu.x), bflo(uu.y), bfhi(uu.y)};
      float o[4];
#pragma unroll
      for (int j = 0; j < 4; ++j) {
        const float gate = w0 * x[j] + w1 * x[j + 1] + w2 * x[j + 2] + b;
        o[j] = gate * (acc[m][nt][j] + skip * u4[j]);
      }
      *(uint2*)(outT + t) = make_uint2(pack2(o[0], o[1]), pack2(o[2], o[3]));
    }
  }
}

__device__ __forceinline__ void rope32(float* y  , int pos) {
  const float prow = (float)(pos >> 6), pcol = (float)(pos & 63);
  const float fr[8] = {1.f, 0.31622776601683794f, 0.1f, 0.031622776601683794f, 0.01f, 0.0031622776601683794f, 0.001f, 0.00031622776601683794f};
#pragma unroll
  for (int i = 0; i < 8; ++i) {
    const float tr = prow * fr[i] * 0.15915494309189535f, tc = pcol * fr[i] * 0.15915494309189535f;
    const float sr = sin_turns(tr), cr = cos_turns(tr), sc = sin_turns(tc), cc = cos_turns(tc);
    const float a = y[i], b = y[8 + i], c2 = y[16 + i], d2 = y[24 + i];
    y[i] = a * cr - b * sr; y[8 + i] = b * cr + a * sr;
    y[16 + i] = c2 * cc - d2 * sc; y[24 + i] = d2 * cc + c2 * sc;
  }
}
__device__ __forceinline__ void unpack8(const uint4& v, float* x) {
  x[0] = bflo(v.x); x[1] = bfhi(v.x); x[2] = bflo(v.y); x[3] = bfhi(v.y);
  x[4] = bflo(v.z); x[5] = bfhi(v.z); x[6] = bflo(v.w); x[7] = bfhi(v.w);
}
__device__ __forceinline__ float sumsq8(const uint4& v) {
  float x[8];
  unpack8(v, x);
  return x[0] * x[0] + x[1] * x[1] + x[2] * x[2] + x[3] * x[3] + x[4] * x[4] + x[5] * x[5] + x[6] * x[6] + x[7] * x[7];
}
__device__ __forceinline__ uint4 scale8(const uint4& v, float r, const float* __restrict__ g) {
  float x[8];
  unpack8(v, x);
  const float4 g0 = *(const float4*)g, g1 = *(const float4*)(g + 4);
  return make_uint4(pack2(x[0] * r * g0.x, x[1] * r * g0.y), pack2(x[2] * r * g0.z, x[3] * r * g0.w),
                    pack2(x[4] * r * g1.x, x[5] * r * g1.y), pack2(x[6] * r * g1.z, x[7] * r * g1.w));
}
__device__ __forceinline__ void qk_item(const Params& p, int item) {
  const int tid = ltid();
  if (item < 512) {
    const int idx = item * 256 + tid, row = idx >> 3, h = idx & 7;
    const bf16_t* src = (const bf16_t*)(p.ws + OFF_QRAW) + (size_t)row * 768 + h * 96;
    bf16_t* dst = (bf16_t*)(p.ws + OFF_Q) + (size_t)row * 768 + h * 96;
    uint4 raw[12];
#pragma unroll
    for (int i = 0; i < 12; ++i) raw[i] = *(const uint4*)(src + 8 * i);
    float ss = 0.f;
#pragma unroll
    for (int i = 0; i < 12; ++i) ss += sumsq8(raw[i]);
    const float r = rsqrtf(ss * (1.f / 96.f) + 1e-6f);
    const float qs = 0.10206207261596575f * 1.4426950408889634f;
#pragma unroll
    for (int i = 0; i < 8; ++i) *(uint4*)(dst + 8 * i) = scale8(raw[i], r * qs, p.g_q + 8 * i);
    float y[32];
#pragma unroll
    for (int i = 0; i < 4; ++i) unpack8(raw[8 + i], y + 8 * i);
#pragma unroll
    for (int i = 0; i < 32; ++i) y[i] = y[i] * r * p.g_q[64 + i];
    if (row >= NCTX) rope32(y, (row - NCTX) & 4095);
#pragma unroll
    for (int i = 0; i < 4; ++i)
      *(uint4*)(dst + 64 + 8 * i) = make_uint4(pack2(y[8 * i] * qs, y[8 * i + 1] * qs), pack2(y[8 * i + 2] * qs, y[8 * i + 3] * qs),
                                               pack2(y[8 * i + 4] * qs, y[8 * i + 5] * qs), pack2(y[8 * i + 6] * qs, y[8 * i + 7] * qs));
  } else {
    const int idx = (item - 512) * 256 + tid, row = idx >> 3, h = idx & 7;
    const bf16_t* src = (const bf16_t*)(p.ws + OFF_KRAW) + (size_t)row * 512 + h * 64;
    uint4 raw[8];
#pragma unroll
    for (int i = 0; i < 8; ++i) raw[i] = *(const uint4*)(src + 8 * i);
    const float* kp = row < NTOK ? (const float*)(p.ws + OFF_KPE) + (size_t)row * 32 : p.cache_kpe + (size_t)(row - NTOK) * 32;
    float y[32];
#pragma unroll
    for (int i = 0; i < 8; ++i) {
      const float4 v = *(const float4*)(kp + 4 * i);
      y[4 * i] = v.x; y[4 * i + 1] = v.y; y[4 * i + 2] = v.z; y[4 * i + 3] = v.w;
    }
    float ss = 0.f;
#pragma unroll
    for (int i = 0; i < 8; ++i) ss += sumsq8(raw[i]);
#pragma unroll
    for (int i = 0; i < 32; ++i) ss += y[i] * y[i];
    const float r = rsqrtf(ss * (1.f / 96.f) + 1e-6f);
#pragma unroll
    for (int i = 0; i < 32; ++i) y[i] = y[i] * r * p.g_k[64 + i];
    bf16_t* dst;
    if (row < NCTX) dst = (bf16_t*)(p.ws + OFF_KC) + ((size_t)((row >> 8) * 8 + h) * 256 + (row & 255)) * 96;
    else if (row < NTOK) {
      const int rr = row - NCTX;
      rope32(y, rr & 4095);
      dst = (bf16_t*)(p.ws + OFF_KL) + ((size_t)((rr >> 12) * 8 + h) * 4608 + (rr & 4095)) * 96;
    } else {
      const int rr = row - NTOK;
      dst = (bf16_t*)(p.ws + OFF_KL) + ((size_t)((rr >> 9) * 8 + h) * 4608 + 4096 + (rr & 511)) * 96;
    }
#pragma unroll
    for (int i = 0; i < 8; ++i) *(uint4*)(dst + 8 * i) = scale8(raw[i], r, p.g_k + 8 * i);
#pragma unroll
    for (int i = 0; i < 4; ++i)
      *(uint4*)(dst + 64 + 8 * i) = make_uint4(pack2(y[8 * i], y[8 * i + 1]), pack2(y[8 * i + 2], y[8 * i + 3]),
                                               pack2(y[8 * i + 4], y[8 * i + 5]), pack2(y[8 * i + 6], y[8 * i + 7]));
  }
}

__device__ __forceinline__ void attn_item(const Params& p, int item, char* smem) {
  const int tid = ltid(), lane = tid & 63, wid = tid >> 6, lr = lane & 31, lh = lane >> 5;
  int nkeys, h, tokbase; const bf16_t *Kp, *Vp;
  if (item < 512) {
    const int b = item >> 8, rem = item & 255; h = rem >> 5; const int qb = rem & 31;
    nkeys = 4608; tokbase = NCTX + b * 4096 + qb * 128;
    Kp = (const bf16_t*)(p.ws + OFF_KL) + (size_t)(b * 8 + h) * 4608 * 96;
    Vp = (const bf16_t*)(p.ws + OFF_VTL) + (size_t)(b * 8 + h) * 64 * 4608;
  } else {
    const int it = item - 512, b = it >> 4; h = (it & 15) >> 1; const int qb = it & 1;
    nkeys = 256; tokbase = b * 256 + qb * 128;
    Kp = (const bf16_t*)(p.ws + OFF_KC) + (size_t)(b * 8 + h) * 256 * 96;
    Vp = (const bf16_t*)(p.ws + OFF_VTC) + (size_t)(b * 8 + h) * 64 * 256;
  }
  bf16_t* sK = (bf16_t*)smem;
  bf16_t* sV = sK + 64 * 104;
  const int token = tokbase + 32 * wid + lr;
  bf16x8 qf[6];
  {
    const bf16_t* qsrc = (const bf16_t*)(p.ws + OFF_QRAW) + (size_t)token * 768 + h * 96 + 8 * lh;
    uint4 qr[6];
#pragma unroll
    for (int ks = 0; ks < 6; ++ks) qr[ks] = *(const uint4*)(qsrc + 16 * ks);
    float ss = 0.f;
#pragma unroll
    for (int ks = 0; ks < 6; ++ks) ss += sumsq8(qr[ks]);
    ss += __shfl_xor(ss, 32);
    const float r = rsqrtf(ss * (1.f / 96.f) + 1e-6f);
    const float qs = 0.10206207261596575f * 1.4426950408889634f;
    const bool lat = item < 512;
    const int pos = (token - NCTX) & 4095;
    const float prow = (float)(pos >> 6), pcol = (float)(pos & 63);
    const float frq[8] = {1.f, 0.31622776601683794f, 0.1f, 0.031622776601683794f, 0.01f, 0.0031622776601683794f, 0.001f, 0.00031622776601683794f};
#pragma unroll
    for (int ks = 0; ks < 6; ++ks) {
      float y[8];
      unpack8(qr[ks], y);
      const float* gq = p.g_q + 16 * ks + 8 * lh;
#pragma unroll
      for (int e = 0; e < 8; ++e) y[e] = y[e] * r * gq[e];
      if (ks >= 4) {
#pragma unroll
        for (int e = 0; e < 8; ++e) {
          const float other = __shfl_xor(y[e], 32);
          const float t = (ks == 4 ? prow : pcol) * frq[e] * 0.15915494309189535f;
          const float sn = sin_turns(t), cs = cos_turns(t);
          const float rot = y[e] * cs + (lh ? other : -other) * sn;
          y[e] = lat ? rot : y[e];
        }
      }
      union { unsigned u[4]; bf16x8 v; } pk;
      pk.u[0] = pack2(y[0] * qs, y[1] * qs); pk.u[1] = pack2(y[2] * qs, y[3] * qs); pk.u[2] = pack2(y[4] * qs, y[5] * qs); pk.u[3] = pack2(y[6] * qs, y[7] * qs);
      qf[ks] = pk.v;
    }
  }
  f32x16 oacc[2];
#pragma unroll
  for (int j = 0; j < 16; ++j) { oacc[0][j] = 0.f; oacc[1][j] = 0.f; }
  float mrun = -1e30f, lsum = 0.f;
  const int kk0 = tid / 12, kc0 = tid % 12, kk1 = (tid + 256) / 12, kc1 = (tid + 256) % 12, kk2 = (tid + 512) / 12, kc2 = (tid + 512) % 12;
  const int vd0 = tid >> 3, vc0 = tid & 7, vd1 = vd0 + 32;
  const bf16_t* gk0 = Kp + (size_t)kk0 * 96 + kc0 * 8;
  const bf16_t* gk1 = Kp + (size_t)kk1 * 96 + kc1 * 8;
  const bf16_t* gk2 = Kp + (size_t)kk2 * 96 + kc2 * 8;
  const bf16_t* gv0 = Vp + (size_t)vd0 * nkeys + vc0 * 8;
  const bf16_t* gv1 = Vp + (size_t)vd1 * nkeys + vc0 * 8;
  uint4 rk0 = *(const uint4*)gk0, rk1 = *(const uint4*)gk1, rk2 = *(const uint4*)gk2;
  uint4 rv0 = *(const uint4*)gv0, rv1 = *(const uint4*)gv1;
  const int nt = nkeys >> 6;
  for (int kt = 0; kt < nt; ++kt) {
    __syncthreads();
    *(uint4*)(sK + kk0 * 104 + kc0 * 8) = rk0; *(uint4*)(sK + kk1 * 104 + kc1 * 8) = rk1; *(uint4*)(sK + kk2 * 104 + kc2 * 8) = rk2;
    *(uint4*)(sV + vd0 * 72 + vc0 * 8) = rv0; *(uint4*)(sV + vd1 * 72 + vc0 * 8) = rv1;
    __syncthreads();
    if (kt + 1 < nt) {
      gk0 += 64 * 96; gk1 += 64 * 96; gk2 += 64 * 96; gv0 += 64; gv1 += 64;
      rk0 = *(const uint4*)gk0; rk1 = *(const uint4*)gk1; rk2 = *(const uint4*)gk2;
      rv0 = *(const uint4*)gv0; rv1 = *(const uint4*)gv1;
    }
    __builtin_amdgcn_sched_barrier(0);
    f32x16 sacc[2];
#pragma unroll
    for (int kb = 0; kb < 2; ++kb) {
#pragma unroll
      for (int j = 0; j < 16; ++j) sacc[kb][j] = 0.f;
#pragma unroll
      for (int ks = 0; ks < 6; ++ks) {
        const bf16x8 a = *(const bf16x8*)(sK + (32 * kb + lr) * 104 + 16 * ks + 8 * lh);
        sacc[kb] = __builtin_amdgcn_mfma_f32_32x32x16_bf16(a, qf[ks], sacc[kb], 0, 0, 0);
      }
    }
    float mx = sacc[0][0];
#pragma unroll
    for (int j = 1; j < 16; ++j) mx = fmaxf(mx, sacc[0][j]);
#pragma unroll
    for (int j = 0; j < 16; ++j) mx = fmaxf(mx, sacc[1][j]);
    mx = fmaxf(mx, __shfl_xor(mx, 32));
    const float mnew = fmaxf(mrun, mx);
    const float alpha = __builtin_amdgcn_exp2f(mrun - mnew);
    mrun = mnew;
    float ps = 0.f;
#pragma unroll
    for (int kb = 0; kb < 2; ++kb)
#pragma unroll
      for (int j = 0; j < 16; ++j) { const float e = __builtin_amdgcn_exp2f(sacc[kb][j] - mnew); sacc[kb][j] = e; ps += e; }
    lsum = lsum * alpha + ps;
    if (__ballot(alpha != 1.f) != 0ull) {
#pragma unroll
      for (int j = 0; j < 16; ++j) { oacc[0][j] *= alpha; oacc[1][j] *= alpha; }
    }
#pragma unroll
    for (int s = 0; s < 4; ++s) {
      const int kb = s >> 1, jb = 8 * (s & 1);
      union { unsigned u[4]; bf16x8 v; } pf;
      pf.u[0] = pack2(sacc[kb][jb + 0], sacc[kb][jb + 1]); pf.u[1] = pack2(sacc[kb][jb + 2], sacc[kb][jb + 3]);
      pf.u[2] = pack2(sacc[kb][jb + 4], sacc[kb][jb + 5]); pf.u[3] = pack2(sacc[kb][jb + 6], sacc[kb][jb + 7]);
#pragma unroll
      for (int mt = 0; mt < 2; ++mt) {
        const bf16_t* vp = sV + (32 * mt + lr) * 72 + 16 * s + 4 * lh;
        union { uint2 d[2]; bf16x8 v; } av;
        av.d[0] = *(const uint2*)vp;
        av.d[1] = *(const uint2*)(vp + 8);
        oacc[mt] = __builtin_amdgcn_mfma_f32_32x32x16_bf16(av.v, pf.v, oacc[mt], 0, 0, 0);
      }
    }
  }
  lsum += __shfl_xor(lsum, 32);
  const float inv = 1.f / lsum;
  bf16_t* dst = (bf16_t*)(p.ws + OFF_ATTN) + (size_t)token * 512 + h * 64;
#pragma unroll
  for (int mt = 0; mt < 2; ++mt)
#pragma unroll
    for (int jg = 0; jg < 4; ++jg) {
      const int dv0 = 32 * mt + 8 * jg + 4 * lh;
      *(uint2*)(dst + dv0) = make_uint2(pack2(oacc[mt][4 * jg] * inv, oacc[mt][4 * jg + 1] * inv),
                                        pack2(oacc[mt][4 * jg + 2] * inv, oacc[mt][4 * jg + 3] * inv));
    }
}

__device__ __forceinline__ void merge_item(const Params& p, int item, char* smem) {
  const int tid = ltid(), lane = tid & 63, wid = tid >> 6, t0 = item * 32;
  bf16_t* mix = (bf16_t*)(p.ws + OFF_H);
  const bf16_t* attn = (const bf16_t*)(p.ws + OFF_ATTN);
  for (int tt = 0; tt < 8; ++tt) {
    const int token = t0 + wid * 8 + tt;
    float x[8];
    unpack8(*(const uint4*)(attn + (size_t)token * 512 + lane * 8), x);
    float ss = 0.f;
#pragma unroll
    for (int i = 0; i < 8; ++i) ss += x[i] * x[i];
    ss = wave_sum(ss);
    const float r = rsqrtf(ss * (1.f / 512.f) + 1e-6f);
    const float4 g0 = *(const float4*)(p.g_out_att + lane * 8), g1 = *(const float4*)(p.g_out_att + lane * 8 + 4);
    *(uint4*)(mix + (size_t)token * D + lane * 8) =
        make_uint4(pack2(x[0] * r * g0.x, x[1] * r * g0.y), pack2(x[2] * r * g0.z, x[3] * r * g0.w),
                   pack2(x[4] * r * g1.x, x[5] * r * g1.y), pack2(x[6] * r * g1.z, x[7] * r * g1.w));
  }
  bf16_t* sT = (bf16_t*)smem;
  const bf16_t* y2T = (const bf16_t*)(p.ws + OFF_Y2T);
  __syncthreads();
  for (int ch = tid; ch < 2048; ch += 256) {
    const int c = ch >> 2, q4 = ch & 3;
    const uint4 v = *(const uint4*)(y2T + (size_t)c * NTOK + t0 + q4 * 8);
    bf16_t* d = sT + (q4 * 8) * 520 + c;
    d[0 * 520] = (bf16_t)(v.x & 0xffff); d[1 * 520] = (bf16_t)(v.x >> 16);
    d[2 * 520] = (bf16_t)(v.y & 0xffff); d[3 * 520] = (bf16_t)(v.y >> 16);
    d[4 * 520] = (bf16_t)(v.z & 0xffff); d[5 * 520] = (bf16_t)(v.z >> 16);
    d[6 * 520] = (bf16_t)(v.w & 0xffff); d[7 * 520] = (bf16_t)(v.w >> 16);
  }
  __syncthreads();
  {
    const int tt = tid >> 3, part = tid & 7;
    uint4 v[8];
    float ss = 0.f;
#pragma unroll
    for (int i = 0; i < 8; ++i) {
      v[i] = *(const uint4*)(sT + tt * 520 + part * 64 + 8 * i);
      float x[8];
      unpack8(v[i], x);
#pragma unroll
      for (int e = 0; e < 8; ++e) ss += x[e] * x[e];
    }
    ss += __shfl_xor(ss, 1); ss += __shfl_xor(ss, 2); ss += __shfl_xor(ss, 4);
    const float r = rsqrtf(ss * (1.f / 512.f) + 1e-6f);
#pragma unroll
    for (int i = 0; i < 8; ++i) {
      float x[8];
      unpack8(v[i], x);
      const int c0 = part * 64 + 8 * i;
      const float4 g0 = *(const float4*)(p.g_out_hy + c0), g1 = *(const float4*)(p.g_out_hy + c0 + 4);
      *(uint4*)(mix + (size_t)(t0 + tt) * D + 512 + c0) =
          make_uint4(pack2(x[0] * r * g0.x, x[1] * r * g0.y), pack2(x[2] * r * g0.z, x[3] * r * g0.w),
                     pack2(x[4] * r * g1.x, x[5] * r * g1.y), pack2(x[6] * r * g1.z, x[7] * r * g1.w));
    }
  }
}

__device__ __forceinline__ void actfix_item(const Params& p, int item) {
  const int idx = item * 256 + ltid();
  if (idx >= 512 * 352) return;
  const int j = (idx % 352) * 8, rowi = idx / 352, wt = rowi >> 1, which = rowi & 1;
  const int t = 64 * wt + 63 * which, L = t < NCTX ? SEQC : SEQL, pos = t & (L - 1);
  const bf16_t* edge = (const bf16_t*)(p.ws + OFF_EDGE);
  bf16_t* act = (bf16_t*)(p.ws + OFF_U);
  const bf16_t *pr, *cu, *nx;
  bool zp = false, zn = false;
  if (which == 0) { zp = pos == 0; pr = edge + (size_t)((zp ? wt : wt - 1) * 4 + 3) * 5632; cu = edge + (size_t)(wt * 4 + 0) * 5632; nx = edge + (size_t)(wt * 4 + 1) * 5632; }
  else { zn = pos == L - 1; pr = edge + (size_t)(wt * 4 + 2) * 5632; cu = edge + (size_t)(wt * 4 + 3) * 5632; nx = edge + (size_t)((zn ? wt : wt + 1) * 4 + 0) * 5632; }
  float pa[8], pg[8], ca[8], cgv[8], na[8], ng[8];
  unpack8(*(const uint4*)(pr + j), pa); unpack8(*(const uint4*)(pr + 2816 + j), pg);
  unpack8(*(const uint4*)(cu + j), ca); unpack8(*(const uint4*)(cu + 2816 + j), cgv);
  unpack8(*(const uint4*)(nx + j), na); unpack8(*(const uint4*)(nx + 2816 + j), ng);
  float o[8];
#pragma unroll
  for (int e = 0; e < 8; ++e) {
    const float pae = zp ? 0.f : pa[e], pge = zp ? 0.f : pg[e], nae = zn ? 0.f : na[e], nge = zn ? 0.f : ng[e];
    const float a = p.ffn_conv_w[j + e] * pae + p.ffn_conv_w[5632 + j + e] * ca[e] + p.ffn_conv_w[11264 + j + e] * nae + p.ffn_conv_b[j + e];
    const float g = p.ffn_conv_w[2816 + j + e] * pge + p.ffn_conv_w[5632 + 2816 + j + e] * cgv[e] + p.ffn_conv_w[11264 + 2816 + j + e] * nge + p.ffn_conv_b[2816 + j + e];
    o[e] = a * __builtin_amdgcn_rcpf(1.f + __expf(-a)) * g;
  }
  *(uint4*)(act + (size_t)t * 2816 + j) = make_uint4(pack2(o[0], o[1]), pack2(o[2], o[3]), pack2(o[4], o[5]), pack2(o[6], o[7]));
}

#define XB_TMO      128
#define XB_XCNT(j)  (256  + 64 * (j))
#define XB_XSUB(j)  (1280 + 64 * (j))
#define XB_XGEN(j)  (2304 + 64 * (j))
#define XB_TOP      3328
#define XB_TOPGEN   3392
#define XCD_BAR_WORDS 3456
#define XB_SPIN_CAP (1u << 20)
#define LAS __attribute__((address_space(3)))
__device__ __forceinline__ unsigned xb_ld(unsigned* p) { return __hip_atomic_load(p, __ATOMIC_RELAXED, __HIP_MEMORY_SCOPE_AGENT); }
__device__ __forceinline__ unsigned xb_add(unsigned* p, unsigned v) { return __hip_atomic_fetch_add(p, v, __ATOMIC_RELAXED, __HIP_MEMORY_SCOPE_AGENT); }
__device__ __forceinline__ unsigned xb_xcc_id() { return (unsigned)__builtin_amdgcn_s_getreg((3 << 11) | 20) & 0xFu; }
#define XB_SPIN(cond, bar) do { unsigned _sp = 0; while (cond) { __builtin_amdgcn_s_sleep(1); \
    if ((++_sp & 255u) == 0u) { if (xb_ld(&(bar)[XB_TMO])) break; if (_sp > XB_SPIN_CAP) { atomicAdd(&(bar)[XB_TMO], 1u); break; } } } } while (0)
struct XcdBarrier { unsigned* bar; unsigned x; volatile LAS unsigned* st; };
__device__ __forceinline__ XcdBarrier xcd_barrier_post(unsigned* bar, volatile LAS unsigned* st) {
  XcdBarrier b; b.bar = bar; b.x = xb_xcc_id(); b.st = st;
  if (threadIdx.x == 0) (void)xb_add(&bar[XB_XCNT(b.x)], 1u);
  return b;
}
__device__ __forceinline__ void xcd_barrier_complete(unsigned* bar, unsigned x, unsigned& nloc, unsigned& nx) {
  const unsigned G = gridDim.x * gridDim.y * gridDim.z;
  unsigned sum, cnt, mine, sp = 0u;
  for (;;) {
    sum = 0u; cnt = 0u; mine = 0u;
#pragma unroll
    for (unsigned j = 0; j < 16; ++j) { const unsigned c = xb_ld(&bar[XB_XCNT(j)]); sum += c; cnt += (c > 0u) ? 1u : 0u; mine = (j == x) ? c : mine; }
    if (sum == G) break;
    __builtin_amdgcn_s_sleep(1);
    if ((++sp & 255u) == 0u) { if (xb_ld(&bar[XB_TMO])) break; if (sp > XB_SPIN_CAP) { atomicAdd(&bar[XB_TMO], 1u); break; } }
  }
  nloc = mine > 0u ? mine : 1u; nx = cnt > 0u ? cnt : 1u;
}
__device__ __forceinline__ void xcd_barrier(const XcdBarrier& b) {
  asm volatile("s_waitcnt vmcnt(0)" ::: "memory");
  __syncthreads();
  if (threadIdx.x == 0) {
    unsigned* bar = b.bar;
    __builtin_amdgcn_s_waitcnt(0);
    unsigned nloc = b.st[0], nx = b.st[1];
    if (nloc == 0u) { xcd_barrier_complete(bar, b.x, nloc, nx); b.st[0] = nloc; b.st[1] = nx; }
    const unsigned old = xb_add(&bar[XB_XSUB(b.x)], 1u);
    const unsigned gen = old / nloc;
    if (old + 1u == (gen + 1u) * nloc) {
      __builtin_amdgcn_fence(__ATOMIC_RELEASE, "agent");
      asm volatile("s_waitcnt vmcnt(0)" ::: "memory");
      const unsigned og = xb_add(&bar[XB_TOP], 1u);
      const unsigned tg = og / nx;
      if (og + 1u == (tg + 1u) * nx) xb_add(&bar[XB_TOPGEN], 1u);
      else XB_SPIN(xb_ld(&bar[XB_TOPGEN]) == tg, bar);
      __builtin_amdgcn_fence(__ATOMIC_ACQUIRE, "agent");
      xb_add(&bar[XB_XGEN(b.x)], 1u);
      asm volatile("s_waitcnt vmcnt(0)" ::: "memory");
    } else {
      XB_SPIN(xb_ld(&bar[XB_XGEN(b.x)]) == gen, bar);
      __builtin_amdgcn_fence(__ATOMIC_ACQUIRE, "agent");
      asm volatile("s_waitcnt vmcnt(0)" ::: "memory");
    }
  }
  __syncthreads();
}
constexpr size_t OFF_BAR = 25 * MiB - 16384;
static_assert(OFF_MOD + 3 * 6144 * 4 <= OFF_BAR, "bar");

template <int ph>
__device__ __forceinline__ void run_phase(const Params& p, char* smem) {
  const int bid = blockIdx.x, G = gridDim.x;
  char* ws = p.ws;
  if constexpr (ph == 0) {
    for (int it = bid; it < 544 + 96 + 32 + 3080; it += G) {
      if (it < 544) filter_item(p, it, smem);
      else if (it < 640) mod_item(p, it - 544, smem);
      else if (it < 672) cache_item(p, it - 640);
      else {
        int t = it - 672;
        if (t < 576) transpose_item(p.w_in, 1024, DIN, (bf16_t*)(ws + OFF_WIN), t, 36, smem);
        else if ((t -= 576) < 72) transpose_item(p.w_uq, 384, 768, (bf16_t*)(ws + OFF_WUQ), t, 12, smem);
        else if ((t -= 72) < 64) transpose_item(p.w_ukv, 256, 1024, (bf16_t*)(ws + OFF_WUKV), t, 16, smem);
        else if ((t -= 64) < 256) transpose_item(p.w_out, 1024, 1024, (bf16_t*)(ws + OFF_WOUT), t, 16, smem);
        else if ((t -= 256) < 1408) transpose_item(p.w_up, 1024, 5632, (bf16_t*)(ws + OFF_WUP), t, 88, smem, true);
        else { t -= 1408; transpose_item(p.w_down, 2816, 1024, (bf16_t*)(ws + OFF_WDOWN), t, 16, smem); }
      }
    }
  } else if constexpr (ph == 1) {
    rmsmod_phase<0>(p);
  } else if constexpr (ph == 2) {
    EpiIn epi{(float*)(ws + OFF_PROJ), (bf16_t*)(ws + OFF_HYT)};
    EpiProj epr{(float*)(ws + OFF_PROJ)};
    for (int t = bid; t < 128 * 18; t += G) {
      const int nt = t % 18;
      if (nt < 5) gemm_tile<true>((const bf16_t*)(ws + OFF_H), 1024, (const bf16_t*)(ws + OFF_WIN), 1024, 1024, (t / 18) * 128, nt * 128, smem, epr);
      else gemm_tile<false>((const bf16_t*)(ws + OFF_H), 1024, (const bf16_t*)(ws + OFF_WIN), 1024, 1024, (t / 18) * 128, nt * 128, smem, epi);
    }
  } else if constexpr (ph == 3) {
    for (int it = bid; it < 512; it += G) hyena_item<0>(p, 1, it, smem);
    for (int it = bid; it < 512; it += G) hyena_item<0>(p, 0, it, smem);
    for (int it = G - 1 - bid; it < 512; it += G) token_item(p, it);
  } else if constexpr (ph == 4) {
    EpiQ eq{(bf16_t*)(ws + OFF_QRAW)};
    EpiKV ekv{(bf16_t*)(ws + OFF_KRAW), (bf16_t*)(ws + OFF_VTC), (bf16_t*)(ws + OFF_VTL)};
    for (int it = bid; it < 512; it += G) hyena_item<1>(p, 1, it, smem);
    for (int t = bid; t < 768; t += G) gemm_tile<true>((const bf16_t*)(ws + OFF_QA), 384, (const bf16_t*)(ws + OFF_WUQ), 384, 384, (t / 6) * 128, (t % 6) * 128, smem, eq);
    for (int t = bid; t < 1088; t += G) gemm_tile<false>((const bf16_t*)(ws + OFF_CKVN), 256, (const bf16_t*)(ws + OFF_WUKV), 256, 256, (t / 8) * 128, (t % 8) * 128, smem, ekv);
    for (int it = bid; it < 512; it += G) hyena_item<1>(p, 0, it, smem);
  } else if constexpr (ph == 5) {
    for (int it = bid; it < 544; it += G) qk_item(p, 512 + it);
  } else if constexpr (ph == 6) {
    for (int it = bid; it < 1024; it += G) attn_item(p, it, smem);
  } else if constexpr (ph == 7) {
    for (int it = bid; it < 512; it += G) merge_item(p, it, smem);
  } else if constexpr (ph == 8) {
    EpiOut epi{&p};
    if (G == 512) {
      const int x = bid & 7, j = bid >> 3;
      for (int r = 0; r < 2; ++r)
        gemm_tile<true>((const bf16_t*)(ws + OFF_H), 1024, (const bf16_t*)(ws + OFF_WOUT), 1024, 1024, (x * 16 + r * 8 + (j >> 3)) * 128, (j & 7) * 128, smem, epi);
    } else {
      for (int t = bid; t < 128 * 8; t += G)
        gemm_tile<true>((const bf16_t*)(ws + OFF_H), 1024, (const bf16_t*)(ws + OFF_WOUT), 1024, 1024, (t / 8) * 128, (t % 8) * 128, smem, epi);
    }
  } else if constexpr (ph == 9) {
    rmsmod_phase<1>(p);
  } else if constexpr (ph == 10) {
    for (int t = bid; t < 128 * 44; t += G) gemm_up_act_tile(p, (t / 44) * 128, (t % 44) * 128, smem);
  } else if constexpr (ph == 11) {
    for (int it = bid; it < 704; it += G) actfix_item(p, it);
  } else if constexpr (ph == 12) {
    EpiY epi{&p, 0};
    if (G == 512) {
      const int x = bid & 7, j = bid >> 3;
      for (int r = 0; r < 2; ++r)
        gemm_tile<true>((const bf16_t*)(ws + OFF_U), 2816, (const bf16_t*)(ws + OFF_WDOWN), 2816, 2816, (x * 16 + r * 8 + (j >> 3)) * 128, (j & 7) * 128, smem, epi);
    } else {
      for (int t = bid; t < 128 * 8; t += G)
        gemm_tile<true>((const bf16_t*)(ws + OFF_U), 2816, (const bf16_t*)(ws + OFF_WDOWN), 2816, 2816, (t / 8) * 128, (t % 8) * 128, smem, epi);
    }
  }
}

#if ONE_LAUNCH
template <int PH>
__device__ __forceinline__ void run_all(const Params& p, char* smem, cg::grid_group& grid, const XcdBarrier& xb) {
  run_phase<PH>(p, smem);
  if constexpr (((DBL_MASK >> PH) & 1) != 0) { xcd_barrier(xb); run_phase<PH>(p, smem); }
  if constexpr (PH < 12) {
    xcd_barrier(xb);
    run_all<PH + 1>(p, smem, grid, xb);
  }
}
constexpr int DYN_LDS = 65536 + 64;
__global__ void __launch_bounds__(256, 2) mega_kernel(Params p) {
  extern __shared__ __attribute__((aligned(16))) char smem[];
  uint4* xb_words = (uint4*)(smem + 65536);
  cg::grid_group grid = cg::this_grid();
  if (threadIdx.x == 0) *xb_words = make_uint4(0u, 0u, 0u, 0u);
  __syncthreads();
  XcdBarrier xb = xcd_barrier_post((unsigned*)(p.ws + OFF_BAR), (volatile LAS unsigned*)xb_words);
  if (p.ws == nullptr) grid.sync();
  run_all<0>(p, smem, grid, xb);
}
#else
template <int PH>
__global__ void __launch_bounds__(256, 2) phase_kernel(Params p) {
  __shared__ __attribute__((aligned(16))) char smem[SMEM_BYTES];
  run_phase<PH>(p, smem);
}
#ifndef DBG_STOP
#define DBG_STOP 15
#endif
__global__ void dump_kernel(Params p, size_t off, int count) {
  const bf16_t* src = (const bf16_t*)(p.ws + off);
  const bf16_t* src2 = (const bf16_t*)(p.ws + DBG_OFF2);
  for (int i = blockIdx.x * 256 + threadIdx.x; i < 16777216; i += gridDim.x * 256)
    p.out[i] = i < DBG_CNT ? bf2f(src[i]) : (i - DBG_CNT < DBG_CNT2 ? bf2f(src2[i - DBG_CNT]) : 0.f);
}
template <int PH>
static void launch_all(const Params& p, hipStream_t stream) {
  phase_kernel<PH><<<512, 256, 0, stream>>>(p);
  if constexpr (PH < 12) launch_all<PH + 1>(p, stream);
}
#endif

extern "C" void kernel_launch(void* const* d_in, const int* in_sizes, int n_in, void* d_out, int out_size, void* d_ws,
                              size_t ws_size, hipStream_t stream) {
  Params p{};
  const float** pp = (const float**)&p;
  for (int i = 0; i < 34; ++i) pp[i] = (const float*)d_in[i];
  p.out = (float*)d_out;
  p.ws = (char*)d_ws;
#if ONE_LAUNCH
  (void)hipMemsetAsync((char*)d_ws + OFF_BAR, 0, XCD_BAR_WORDS * 4, stream);
  static int grid_blocks = 0;
  if (!grid_blocks) {
    int dev = 0, cus = 0, per_cu = 0;
    hipGetDevice(&dev);
    hipDeviceGetAttribute(&cus, hipDeviceAttributeMultiprocessorCount, dev);
    (void)hipFuncSetAttribute((const void*)mega_kernel, hipFuncAttributeMaxDynamicSharedMemorySize, DYN_LDS);
    (void)hipOccupancyMaxActiveBlocksPerMultiprocessor(&per_cu, mega_kernel, 256, DYN_LDS);
    if (per_cu > 2) per_cu = 2;
    grid_blocks = cus * per_cu;
  }
  void* args[] = {&p};
  hipError_t e = hipLaunchCooperativeKernel((void*)mega_kernel, dim3(grid_blocks), dim3(256), args, DYN_LDS, stream);
  if (e != hipSuccess) fprintf(stderr, "cooperative launch failed: %s (grid %d)\n", hipGetErrorString(e), grid_blocks);
#else
  launch_all<0>(p, stream);
#if DBG_STOP < 15
  dump_kernel<<<1024, 256, 0, stream>>>(p, DBG_OFF, DBG_CNT);
#endif
#endif
}
```
